# Optimizing an MI355X kernel written in HIP

```python
import math
import jax
import jax.numpy as jnp
from jax import lax
import numpy as np

D_MODEL = 1024
BATCH = 2
SEQ = 8192
DEPTH = 2

Q_BLOCK = 128
N_MEM = 256
EPS = 1e-6

MLA_HEADS = 8
MLA_NOPE = 64
MLA_ROPE = 32
MLA_V = 64
MLA_Q_RANK = 256
MLA_KV_RANK = 256
ROPE_THETA = 10000.0

SB_HEADS = 8
SB_DIM = 64

DIFF_HEADS = 4
DIFF_DIM = 64

N_BRANCH = 3
BRANCH_WIDTH = 512

GATE_COLS = N_BRANCH * D_MODEL
MLA_COLS = MLA_Q_RANK + MLA_KV_RANK + MLA_ROPE
SB_COLS = 3 * SB_HEADS * SB_DIM
DIFF_QK = DIFF_HEADS * 2 * DIFF_DIM
DIFF_COLS = 3 * DIFF_QK
IN_COLS = GATE_COLS + MLA_COLS + SB_COLS + DIFF_COLS

X_HEADS = 4
X_DIM = 128

N_GROUPS = 4
EXPERTS_PER_GROUP = 8
N_EXPERTS = N_GROUPS * EXPERTS_PER_GROUP
TOP_K = 2
D_EXPERT = 256

kernel_name = "hybrid_mla_stickbreak_diffattn_hmoe"

F32 = jnp.float32


def rmsnorm(x, g):
    xf = x.astype(F32)
    y = xf * lax.rsqrt(jnp.mean(xf * xf, axis=-1, keepdims=True) + EPS)
    return (y * g.astype(F32)).astype(x.dtype)


def apply_rope(x, pos):
    half = x.shape[-1] // 2
    inv_freq = ROPE_THETA ** (-jnp.arange(half, dtype=F32) / half)
    ang = pos.astype(F32)[:, None] * inv_freq[None, :]
    cos = jnp.cos(ang)[None, :, None, :]
    sin = jnp.sin(ang)[None, :, None, :]
    xf = x.astype(F32)
    x1, x2 = xf[..., :half], xf[..., half:]
    out = jnp.concatenate([x1 * cos - x2 * sin, x1 * sin + x2 * cos], axis=-1)
    return out.astype(x.dtype)


def alibi_slopes(n_heads):
    return 2.0 ** (-8.0 * jnp.arange(1, n_heads + 1, dtype=F32) / n_heads)


def _to_blocks(a, nb):
    b = a.shape[0]
    return jnp.moveaxis(a.reshape(b, nb, Q_BLOCK, *a.shape[2:]), 1, 0)


def sweep_query_blocks(block_fn, q_side):
    b, s = q_side[0].shape[:2]
    nb = s // Q_BLOCK
    xs = (jnp.arange(nb, dtype=jnp.int32) * Q_BLOCK,) + tuple(_to_blocks(a, nb) for a in q_side)
    out = lax.map(lambda args: block_fn(*args), xs)
    out = jnp.moveaxis(out, 0, 1)
    return out.reshape(b, s, *out.shape[3:])


def mla_attention(c_q, c_kv, k_r, q_norm, w_uq, kv_norm, w_ukv, pos):
    b, s, _ = c_q.shape
    q = (rmsnorm(c_q, q_norm) @ w_uq).reshape(b, s, MLA_HEADS, MLA_NOPE + MLA_ROPE)
    q_nope = q[..., :MLA_NOPE]
    q_rope = apply_rope(q[..., MLA_NOPE:], pos)
    kv = (rmsnorm(c_kv, kv_norm) @ w_ukv).reshape(b, s, MLA_HEADS, MLA_NOPE + MLA_V)
    k_nope, v = kv[..., :MLA_NOPE], kv[..., MLA_NOPE:]
    k_rope = apply_rope(k_r[:, :, None, :], pos)[:, :, 0]
    scale = (MLA_NOPE + MLA_ROPE) ** -0.5

    def block(t0, qn, qr):
        sc = (jnp.einsum("bqhd,bkhd->bhqk", qn, k_nope, preferred_element_type=F32)
              + jnp.einsum("bqhr,bkr->bhqk", qr, k_rope, preferred_element_type=F32)) * scale
        qpos = t0 + jnp.arange(Q_BLOCK, dtype=jnp.int32)
        sc = jnp.where(pos[None, :] <= qpos[:, None], sc, -jnp.inf)
        p = jax.nn.softmax(sc, axis=-1).astype(v.dtype)
        return jnp.einsum("bhqk,bkhd->bqhd", p, v)

    o = sweep_query_blocks(block, (q_nope, q_rope))
    return o.reshape(b, s, MLA_HEADS * MLA_V)


def stick_breaking_attention(qkv, pos):
    b, s, _ = qkv.shape
    qkv = qkv.reshape(b, s, 3, SB_HEADS, SB_DIM)
    q, k, v = qkv[:, :, 0], qkv[:, :, 1], qkv[:, :, 2]
    scale = SB_DIM ** -0.5

    def block(t0, qb):
        z = jnp.einsum("bqhd,bkhd->bhqk", qb, k, preferred_element_type=F32) * scale
        qpos = t0 + jnp.arange(Q_BLOCK, dtype=jnp.int32)
        strict = pos[None, :] < qpos[:, None]
        log_keep = jnp.where(strict, jax.nn.log_sigmoid(-z), 0.0)
        after = lax.cumsum(log_keep, axis=3, reverse=True) - log_keep
        a = jnp.where(strict, jnp.exp(jax.nn.log_sigmoid(z) + after), 0.0)
        return jnp.einsum("bhqk,bkhd->bqhd", a.astype(v.dtype), v)

    o = sweep_query_blocks(block, (q,))
    return o.reshape(b, s, SB_HEADS * SB_DIM)


def differential_attention(qkv, lam_params, subln, lam_init, pos):
    b, s, _ = qkv.shape
    q = qkv[..., :DIFF_QK].reshape(b, s, DIFF_HEADS, 2, DIFF_DIM)
    k = qkv[..., DIFF_QK:2 * DIFF_QK].reshape(b, s, DIFF_HEADS, 2, DIFF_DIM)
    v = qkv[..., 2 * DIFF_QK:].reshape(b, s, DIFF_HEADS, 2 * DIFF_DIM)
    k1, k2 = k[:, :, :, 0], k[:, :, :, 1]
    lp = lam_params.astype(F32)
    lam = jnp.exp(jnp.sum(lp[0] * lp[1])) - jnp.exp(jnp.sum(lp[2] * lp[3])) + lam_init
    slopes = alibi_slopes(DIFF_HEADS)
    scale = DIFF_DIM ** -0.5

    def block(t0, q1, q2):
        qpos = t0 + jnp.arange(Q_BLOCK, dtype=jnp.int32)
        dist = (qpos[:, None] - pos[None, :]).astype(F32)
        causal = dist >= 0
        bias = -slopes[:, None, None] * dist

        def probs(qh, kh):
            sc = jnp.einsum("bqhd,bkhd->bhqk", qh, kh, preferred_element_type=F32) * scale + bias
            return jax.nn.softmax(jnp.where(causal, sc, -jnp.inf), axis=-1)

        p = probs(q1, k1) - lam * probs(q2, k2)
        return jnp.einsum("bhqk,bkhd->bqhd", p.astype(v.dtype), v)

    o = sweep_query_blocks(block, (q[:, :, :, 0], q[:, :, :, 1]))
    o = rmsnorm(o, subln) * (1.0 - lam_init)
    return o.reshape(b, s, DIFF_HEADS * 2 * DIFF_DIM)


def memory_cross_attention(h, mem_n, w_xq, w_xkv, w_xo):
    b, s, _ = h.shape
    q = (h @ w_xq).reshape(b, s, X_HEADS, X_DIM)
    kv = (mem_n @ w_xkv).reshape(b, mem_n.shape[1], 2, X_HEADS, X_DIM)
    k, v = kv[:, :, 0], kv[:, :, 1]
    sc = jnp.einsum("bshd,bmhd->bhsm", q, k, preferred_element_type=F32) * (X_DIM ** -0.5)
    p = jax.nn.softmax(sc, axis=-1).astype(v.dtype)
    o = jnp.einsum("bhsm,bmhd->bshd", p, v).reshape(b, s, X_HEADS * X_DIM)
    return o @ w_xo


def hierarchical_moe(h, w_grp, b_grp, w_exp, b_exp, w_gate, w_up, w_down):
    b, s, d = h.shape
    hf = h.reshape(b * s, d)
    n = hf.shape[0]
    grp_logits = jnp.matmul(hf, w_grp, preferred_element_type=F32) + b_grp.astype(F32)
    grp_prob = jax.nn.softmax(grp_logits, axis=-1)
    g_val, g_idx = lax.top_k(grp_logits, 1)
    g_sel = g_idx[:, 0]
    exp_logits = (jnp.matmul(hf, w_exp, preferred_element_type=F32) + b_exp.astype(F32)).reshape(n, N_GROUPS, EXPERTS_PER_GROUP)
    idx = jnp.broadcast_to(g_sel[:, None, None], (n, 1, EXPERTS_PER_GROUP))
    in_grp = jnp.take_along_axis(exp_logits, idx, axis=1)[:, 0]
    top_v, top_i = lax.top_k(in_grp, TOP_K)
    p_g = jnp.take_along_axis(grp_prob, g_sel[:, None], axis=1)
    top_w = jax.nn.softmax(top_v, axis=-1) * p_g
    expert_id = g_sel[:, None] * EXPERTS_PER_GROUP + top_i
    combine = jnp.sum(jax.nn.one_hot(expert_id, N_EXPERTS, dtype=F32) * top_w[..., None], axis=1)
    combine = combine.astype(hf.dtype)
    y = jnp.zeros_like(hf)
    for grp in range(N_GROUPS):
        sl = slice(grp * EXPERTS_PER_GROUP, (grp + 1) * EXPERTS_PER_GROUP)
        a = jnp.einsum("nd,edf->nef", hf, w_gate[sl])
        u = jnp.einsum("nd,edf->nef", hf, w_up[sl])
        act = jax.nn.silu(a) * u * combine[:, sl, None]
        y = y + jnp.einsum("nef,efd->nd", act, w_down[sl])
    return y.reshape(b, s, d)


def setup_inputs(seed: int = 0) -> dict:
    key = jax.random.key(seed)
    ks = iter(jax.random.split(key, 32))

    def nrm(shape, scale):
        return jax.random.normal(next(ks), shape, F32) * scale

    def gain(shape):
        return 1.0 + nrm(shape, 0.02)

    L, D = DEPTH, D_MODEL
    return {
        "x": nrm((BATCH, SEQ, D), 1.0),
        "mem": nrm((BATCH, N_MEM, D), 1.0),
        "attn_norm": gain((L, D)),
        "w_in": nrm((L, D, IN_COLS), D ** -0.5),
        "q_norm": gain((L, MLA_Q_RANK)),
        "w_uq": nrm((L, MLA_Q_RANK, MLA_HEADS * (MLA_NOPE + MLA_ROPE)), MLA_Q_RANK ** -0.5),
        "kv_norm": gain((L, MLA_KV_RANK)),
        "w_ukv": nrm((L, MLA_KV_RANK, MLA_HEADS * (MLA_NOPE + MLA_V)), MLA_KV_RANK ** -0.5),
        "diff_lambda": nrm((L, 4, DIFF_DIM), 0.1),
        "diff_subln": gain((L, 2 * DIFF_DIM)),
        "w_branch": nrm((L, N_BRANCH, BRANCH_WIDTH, D), BRANCH_WIDTH ** -0.5),
        "w_out": nrm((L, D, D), D ** -0.5),
        "cross_norm": gain((L, D)),
        "mem_norm": gain((D,)),
        "w_xq": nrm((L, D, X_HEADS * X_DIM), D ** -0.5),
        "w_xkv": nrm((L, D, 2 * X_HEADS * X_DIM), D ** -0.5),
        "w_xo": nrm((L, X_HEADS * X_DIM, D), (X_HEADS * X_DIM) ** -0.5),
        "ffn_norm": gain((L, D)),
        "w_router_grp": nrm((L, D, N_GROUPS), D ** -0.5),
        "b_router_grp": nrm((L, N_GROUPS), 0.01),
        "w_router_exp": nrm((L, D, N_EXPERTS), D ** -0.5),
        "b_router_exp": nrm((L, N_EXPERTS), 0.01),
        "w_exp_gate": nrm((L, N_EXPERTS, D, D_EXPERT), D ** -0.5),
        "w_exp_up": nrm((L, N_EXPERTS, D, D_EXPERT), D ** -0.5),
        "w_exp_down": nrm((L, N_EXPERTS, D_EXPERT, D), D_EXPERT ** -0.5),
        "final_norm": gain((D,)),
    }


def reference(x, mem, attn_norm, w_in, q_norm, w_uq, kv_norm, w_ukv, diff_lambda, diff_subln,
              w_branch, w_out, cross_norm, mem_norm, w_xq, w_xkv, w_xo, ffn_norm,
              w_router_grp, b_router_grp, w_router_exp, b_router_exp,
              w_exp_gate, w_exp_up, w_exp_down, final_norm):
    b, s, d = x.shape
    pos = jnp.arange(s, dtype=jnp.int32)
    mem_n = rmsnorm(mem, mem_norm)
    splits = [GATE_COLS, MLA_Q_RANK, MLA_KV_RANK, MLA_ROPE, SB_COLS]
    offs = list(np.cumsum(splits))
    for l in range(DEPTH):
        h = rmsnorm(x, attn_norm[l])
        proj = h @ w_in[l]
        gates, c_q, c_kv, k_r, sb_qkv, diff_qkv = jnp.split(proj, [int(o) for o in offs], axis=-1)
        gates = jax.nn.sigmoid(gates.reshape(b, s, N_BRANCH, d))
        o_a = mla_attention(c_q, c_kv, k_r, q_norm[l], w_uq[l], kv_norm[l], w_ukv[l], pos)
        o_b = stick_breaking_attention(sb_qkv, pos)
        lam_init = 0.8 - 0.6 * math.exp(-0.3 * l)
        o_c = differential_attention(diff_qkv, diff_lambda[l], diff_subln[l], lam_init, pos)
        merged = (gates[:, :, 0] * (o_a @ w_branch[l, 0])
                  + gates[:, :, 1] * (o_b @ w_branch[l, 1])
                  + gates[:, :, 2] * (o_c @ w_branch[l, 2]))
        x = x + merged @ w_out[l]
        x = x + memory_cross_attention(rmsnorm(x, cross_norm[l]), mem_n, w_xq[l], w_xkv[l], w_xo[l])
        x = x + hierarchical_moe(rmsnorm(x, ffn_norm[l]), w_router_grp[l], b_router_grp[l],
                                 w_router_exp[l], b_router_exp[l],
                                 w_exp_gate[l], w_exp_up[l], w_exp_down[l])
    return rmsnorm(x, final_norm)
```

```cpp
#include <hip/hip_runtime.h>
#include <cstdio>
#include <cstdint>
#define LAS __attribute__((address_space(3)))
#define GAS __attribute__((address_space(1)))
#ifndef PH_A
#define PH_A 1
#endif
#ifndef PH_B
#define PH_B 1
#endif
#ifndef PH_C
#define PH_C 1
#endif
#ifndef PH_D1
#define PH_D1 1
#endif
#ifndef PH_D2
#define PH_D2 1
#endif
#ifndef PH_E1
#define PH_E1 1
#endif
#ifndef PH_E2
#define PH_E2 1
#endif
#ifndef PH_E3
#define PH_E3 1
#endif
#ifndef PH_F0A
#define PH_F0A 1
#endif
#ifndef PH_F0B
#define PH_F0B 1
#endif
#ifndef PH_F1
#define PH_F1 1
#endif
#ifndef PH_F2
#define PH_F2 1
#endif
#ifndef PH_P0
#define PH_P0 1
#endif
#ifndef PH_F3
#define PH_F3 1
#endif
#ifndef PH_C_DIFF
#define PH_C_DIFF 1
#endif
#ifndef PH_C_SB
#define PH_C_SB 1
#endif
#ifndef PH_C_MLA
#define PH_C_MLA 1
#endif
#ifndef PH_B1
#define PH_B1 1
#endif
#ifndef PH_B2
#define PH_B2 1
#endif
#ifndef PH_B3
#define PH_B3 1
#endif
#ifndef RP_A
#define RP_A 1
#endif
#ifndef RP_B
#define RP_B 1
#endif
#ifndef RP_C
#define RP_C 1
#endif
#ifndef RP_D1
#define RP_D1 1
#endif
#ifndef RP_E1
#define RP_E1 1
#endif
#ifndef RP_E2
#define RP_E2 1
#endif
#ifndef RP_F0A
#define RP_F0A 1
#endif
#ifndef RP_F0B
#define RP_F0B 1
#endif
#ifndef RP_F1
#define RP_F1 1
#endif
#ifndef RP_F2
#define RP_F2 1
#endif
#ifndef RP_P0
#define RP_P0 1
#endif
#ifndef C_REP_MASK
#define C_REP_MASK 7
#endif
#ifndef C_ABL
#define C_ABL 0
#endif
namespace pg8 {
#define PG8_LAS __attribute__((address_space(3)))
typedef unsigned short bf16_t;
typedef short bf16x8 __attribute__((ext_vector_type(8)));
typedef float f32x4 __attribute__((ext_vector_type(4)));
typedef unsigned u32x4 __attribute__((ext_vector_type(4)));
constexpr int BM = 256, BK = 64, HALF = 128, HTB = HALF * BK * 2  , STAGE_BYTES = 8 * HTB, NXCD = 8, WGM = 8;

__host__ __device__ __forceinline__ int lds_byte(int r, int c) { const int st = (r >> 4) * 2 + (c >> 5), rr = r & 15, cc = c & 31, ob = rr * 64 + cc * 2; return st * 1024 + (ob ^ (((ob >> 9) & 1) << 5)); }
__host__ __device__ __forceinline__ void stage_rc(int b, int& R, int& C) { const int st = b / 1024, sb = b % 1024, swz = sb ^ (((sb >> 9) & 1) << 5); R = (st >> 1) * 16 + swz / 64; C = (st & 1) * 32 + (swz % 64) / 2; }
__host__ __device__ __forceinline__ int perm32(int rho) { const int n = rho >> 4, i = rho & 15; return 8 * (i >> 2) + 4 * n + (i & 3); }

struct Unit { int pm, pn, sel; };
struct Gemm { const GAS bf16_t* A; const GAS bf16_t* Bt; int M, N, K, ld; const GAS int* rowidx; };

struct StaticOrder {
    int nM, nN, nwg, G, c;
    __host__ __device__ void init(int M, int N, int G_, int c_) { nM = M / BM; nN = N / BM; nwg = nM * nN; G = G_; c = c_; }
    __host__ __device__ bool next(int i, Unit& u) const {
        const long L = (long)i * G + c; if (L >= nwg) return false;
        int wgid = (int)L; { const int q = nwg / NXCD, r = nwg % NXCD, xcd = wgid % NXCD, off = wgid / NXCD; wgid = (xcd < r ? xcd * (q + 1) : r * (q + 1) + (xcd - r) * q) + off; }
        const int nig = WGM * nN, gid = wgid / nig, fm = gid * WGM, gsz = (nM - fm) < WGM ? (nM - fm) : WGM;
        u.pm = fm + ((wgid % nig) % gsz); u.pn = (wgid % nig) / gsz; u.sel = 0; return true;
    }
    __device__ __forceinline__ void a_ready(const Unit&) const {}
    __device__ __forceinline__ void done(const Unit&) const {}
    __device__ __forceinline__ size_t a_off(const Unit&) const { return 0; }
    __device__ __forceinline__ size_t b_off(const Unit&) const { return 0; }
    __device__ __forceinline__ bool keep(const Unit&) const { return false; }
};

__device__ __forceinline__ unsigned cvt_pk_bf16(float lo, float hi) { unsigned r; asm volatile("v_cvt_pk_bf16_f32 %0, %1, %2" : "=v"(r) : "v"(lo), "v"(hi)); return r; }
template <class Epi, class Sched, bool ALIGN_EPI = false, bool SP2 = false, bool GATHER = false>
__device__ __forceinline__ void gemm_phase(PG8_LAS unsigned char* lds, const Gemm g, const Sched& S, const Epi& E, const int wave_idx) {
    int tid_; asm volatile("v_mbcnt_lo_u32_b32 %0, -1, 0\n\tv_mbcnt_hi_u32_b32 %0, -1, %0" : "=v"(tid_)); tid_ += wave_idx * 64;
    const int tid = tid_, wid = __builtin_amdgcn_readfirstlane(tid >> 6), lane = tid & 63, wr = wid >> 2, wc = wid & 3, fr = lane & 15, fq = lane >> 4;
    const int K = g.K, nt = K / BK, LD = g.ld;
    unsigned voffA[2], voffB[2];
#pragma unroll
    for (int i = 0; i < 2; ++i) { int R, C; stage_rc(tid * 16 + i * 8192, R, C); const int Rb = Epi::PERM ? ((R & ~31) + perm32(R & 31)) : R;
        voffA[i] = (unsigned)(R * LD + C) * 2u; voffB[i] = (unsigned)(Rb * LD + C) * 2u; }
    const size_t kstep = (size_t)(BK * 2);
    const size_t hstep = (size_t)HALF * LD * 2;
    const size_t tstep = 2 * hstep;
    const unsigned ldsw = (unsigned)wid * 1024u;
    const int aoff = lds_byte(wr * 64 + fr, fq * 8), boff = lds_byte(wc * 32 + fr, fq * 8);
#define PG8_SA(b, h) (((b) * 2 + (h)) * HTB)
#define PG8_SB(b, h) ((4 + (b) * 2 + (h)) * HTB)
#define PG8_STAGE(bufoff, gbase, voff) do { _Pragma("unroll") for (int _i = 0; _i < 2; ++_i) \
        __builtin_amdgcn_global_load_lds((const GAS unsigned*)((const GAS char*)(gbase) + (voff)[_i]), (PG8_LAS unsigned*)(lds + (bufoff) + ldsw + _i * 8192), 16, 0, 0); } while (0)
#define PG8_LDA(dst, b, h) do { _Pragma("unroll") for (int m = 0; m < 4; ++m) _Pragma("unroll") for (int k = 0; k < 2; ++k) dst[m][k] = *(const PG8_LAS bf16x8*)(lds + PG8_SA(b, h) + aoff + m * 2048 + k * 1024); } while (0)
#define PG8_LDB(dst, b, h) do { _Pragma("unroll") for (int n = 0; n < 2; ++n) _Pragma("unroll") for (int k = 0; k < 2; ++k) dst[n][k] = *(const PG8_LAS bf16x8*)(lds + PG8_SB(b, h) + boff + n * 2048 + k * 1024); } while (0)
#define PG8_MMA(ai, bj, At, Bt) do { __builtin_amdgcn_s_setprio(1); _Pragma("unroll") for (int m = 0; m < 4; ++m) _Pragma("unroll") for (int n = 0; n < 2; ++n) _Pragma("unroll") for (int k = 0; k < 2; ++k) \
        acc[ai][bj][m][n] = __builtin_amdgcn_mfma_f32_16x16x32_bf16(Bt[n][k], At[m][k], acc[ai][bj][m][n], 0, 0, 0); __builtin_amdgcn_s_setprio(0); } while (0)
#define PG8_WAIT_V(n) asm volatile("s_waitcnt vmcnt(" #n ")" ::: "memory")
#define PG8_WAIT_L(n) asm volatile("s_waitcnt lgkmcnt(" #n ")" ::: "memory")
#define PG8_BAR __builtin_amdgcn_s_barrier()
#define PG8_SCHED __builtin_amdgcn_sched_barrier(0)
    Unit cur, nxt; int ui = 0;
    if (!S.next(0, cur)) return;
    f32x4 acc[2][2][4][2];
#pragma unroll
    for (int a = 0; a < 2; ++a)
#pragma unroll
        for (int b = 0; b < 2; ++b)
#pragma unroll
            for (int m = 0; m < 4; ++m)
#pragma unroll
                for (int n = 0; n < 2; ++n) acc[a][b][m][n] = (f32x4){0.f, 0.f, 0.f, 0.f};
    bf16x8 At[4][2], B0[2][2], B1[2][2];
    const GAS char* cA = (const GAS char*)g.A + (GATHER ? (size_t)0 : (size_t)cur.pm * tstep + S.a_off(cur)); const GAS char* cB = (const GAS char*)g.Bt + (size_t)cur.pn * tstep + S.b_off(cur);
    unsigned vC[2][2], vN[2][2];
    if constexpr (GATHER) {
#pragma unroll
        for (int h = 0; h < 2; ++h)
#pragma unroll
            for (int i = 0; i < 2; ++i) { int R, C; stage_rc(tid * 16 + i * 8192, R, C); vC[h][i] = (unsigned)(g.rowidx[cur.pm * BM + h * HALF + R] * LD + C) * 2u; vN[h][i] = vC[h][i]; }
    }
#define PG8_STAGE_A(bufoff, gb, h, nx) do { if constexpr (GATHER) { unsigned vs_[2] = {(nx) ? vN[h][0] : vC[h][0], (nx) ? vN[h][1] : vC[h][1]}; PG8_STAGE(bufoff, gb, vs_); } \
        else { PG8_STAGE(bufoff, (gb) + (h) * hstep, voffA); } } while (0)
    S.a_ready(cur);
    if constexpr (SP2) {
        PG8_STAGE(PG8_SB(0, 0), cB, voffB); PG8_STAGE(PG8_SB(0, 1), cB + hstep, voffB); PG8_STAGE_A(PG8_SA(0, 0), cA, 0, false); PG8_STAGE_A(PG8_SA(0, 1), cA, 1, false);
        if (wr == 1) PG8_BAR;
        PG8_WAIT_V(2); PG8_BAR;
        PG8_STAGE(PG8_SB(1, 0), cB + kstep, voffB); PG8_STAGE_A(PG8_SA(1, 0), cA + kstep, 0, false); PG8_STAGE(PG8_SB(1, 1), cB + hstep + kstep, voffB);
        PG8_WAIT_V(6); PG8_BAR;
    } else {
        PG8_STAGE(PG8_SB(0, 0), cB, voffB); PG8_STAGE(PG8_SA(0, 0), cA, voffA); PG8_STAGE(PG8_SB(0, 1), cB + hstep, voffB); PG8_STAGE(PG8_SA(0, 1), cA + hstep, voffA);
        if (wr == 1) PG8_BAR;
        PG8_WAIT_V(4); PG8_BAR;
        PG8_STAGE(PG8_SB(1, 0), cB + kstep, voffB); PG8_STAGE(PG8_SA(1, 0), cA + kstep, voffA); PG8_STAGE(PG8_SB(1, 1), cB + hstep + kstep, voffB);
        PG8_WAIT_V(6); PG8_BAR;
    }
    for (;;) {
        const bool has_next = S.next(ui + 1, nxt);
        if constexpr (GATHER) { if (has_next) {
#pragma unroll
            for (int h = 0; h < 2; ++h)
#pragma unroll
                for (int i = 0; i < 2; ++i) { int R, C; stage_rc(tid * 16 + i * 8192, R, C); vN[h][i] = (unsigned)(g.rowidx[nxt.pm * BM + h * HALF + R] * LD + C) * 2u; } } }
        const GAS char* nA = GATHER ? cA : has_next ? (const GAS char*)g.A + (size_t)nxt.pm * tstep + S.a_off(nxt) : cA; const GAS char* nB = has_next ? (const GAS char*)g.Bt + (size_t)nxt.pn * tstep + S.b_off(nxt) : cB;
        for (int t = 0; t < nt; t += 2) {
            const bool last = (t == nt - 2);
            const GAS char* a1 = cA + (size_t)(t + 1) * kstep;
            const GAS char* a2 = last ? nA : cA + (size_t)(t + 2) * kstep; const GAS char* b2 = last ? nB : cB + (size_t)(t + 2) * kstep;
            const GAS char* a3 = a2 + kstep; const GAS char* b3 = b2 + kstep;
            if (last && has_next) S.a_ready(nxt);
            if constexpr (SP2) {
            PG8_LDB(B0, 0, 0); PG8_LDB(B1, 0, 1); PG8_SCHED; PG8_LDA(At, 0, 0); PG8_STAGE_A(PG8_SA(1, 1), a1, 1, false);
            PG8_WAIT_V(8); PG8_WAIT_L(0); PG8_BAR; PG8_MMA(0, 0, At, B0); PG8_MMA(0, 1, At, B1); PG8_BAR; PG8_SCHED;
            PG8_LDA(At, 0, 1); PG8_STAGE(PG8_SB(0, 0), b2, voffB); PG8_STAGE(PG8_SB(0, 1), b2 + hstep, voffB); PG8_STAGE_A(PG8_SA(0, 0), a2, 0, last);
            PG8_WAIT_V(8); PG8_WAIT_L(0); PG8_BAR; PG8_MMA(1, 0, At, B0); PG8_MMA(1, 1, At, B1); PG8_BAR; PG8_SCHED;
            PG8_LDB(B0, 1, 0); PG8_LDB(B1, 1, 1); PG8_SCHED; PG8_LDA(At, 1, 0); PG8_STAGE_A(PG8_SA(0, 1), a2, 1, last);
            PG8_WAIT_V(8); PG8_WAIT_L(0); PG8_BAR; PG8_MMA(0, 0, At, B0); PG8_MMA(0, 1, At, B1); PG8_BAR; PG8_SCHED;
            PG8_LDA(At, 1, 1); PG8_STAGE(PG8_SB(1, 0), b3, voffB); PG8_STAGE(PG8_SB(1, 1), b3 + hstep, voffB); PG8_STAGE_A(PG8_SA(1, 0), a3, 0, last);
            PG8_WAIT_V(8); PG8_WAIT_L(0); PG8_BAR; PG8_MMA(1, 0, At, B0); PG8_MMA(1, 1, At, B1); PG8_BAR; PG8_SCHED;
            } else {
            PG8_LDB(B0, 0, 0); PG8_SCHED; PG8_LDA(At, 0, 0); PG8_STAGE(PG8_SA(1, 1), a1 + hstep, voffA);
            PG8_WAIT_L(8); PG8_BAR; PG8_WAIT_L(0); PG8_MMA(0, 0, At, B0); PG8_BAR; PG8_SCHED;
            PG8_LDB(B1, 0, 1); PG8_STAGE(PG8_SB(0, 0), b2, voffB);
            PG8_BAR; PG8_WAIT_L(0); PG8_MMA(0, 1, At, B1); PG8_BAR;
            PG8_LDA(At, 0, 1); PG8_STAGE(PG8_SA(0, 0), a2, voffA);
            PG8_BAR; PG8_WAIT_L(0); PG8_MMA(1, 0, At, B0); PG8_BAR; PG8_SCHED;
            PG8_STAGE(PG8_SB(0, 1), b2 + hstep, voffB);
            PG8_WAIT_V(6); PG8_BAR; PG8_MMA(1, 1, At, B1); PG8_BAR;
            PG8_LDB(B0, 1, 0); PG8_SCHED; PG8_LDA(At, 1, 0); PG8_STAGE(PG8_SA(0, 1), a2 + hstep, voffA);
            PG8_WAIT_L(8); PG8_BAR; PG8_WAIT_L(0); PG8_MMA(0, 0, At, B0); PG8_BAR; PG8_SCHED;
            PG8_LDB(B1, 1, 1); PG8_STAGE(PG8_SB(1, 0), b3, voffB);
            PG8_BAR; PG8_WAIT_L(0); PG8_MMA(0, 1, At, B1); PG8_BAR;
            PG8_LDA(At, 1, 1); PG8_STAGE(PG8_SA(1, 0), a3, voffA);
            PG8_BAR; PG8_WAIT_L(0); PG8_MMA(1, 0, At, B0); PG8_BAR; PG8_SCHED;
            PG8_STAGE(PG8_SB(1, 1), b3 + hstep, voffB);
            PG8_WAIT_V(6); PG8_BAR; PG8_MMA(1, 1, At, B1); PG8_BAR;
            }
        }
        if constexpr (ALIGN_EPI) { if (wr == 0) PG8_BAR; }
        const bool keep_ = S.keep(cur);
        if constexpr (!Epi::AFTER_DRAIN) { if (!keep_) { E(acc, cur, wr, wc, fr, fq); S.done(cur); } }
        if (!has_next) break;
        if (!keep_) {
#pragma unroll
        for (int a = 0; a < 2; ++a)
#pragma unroll
            for (int b = 0; b < 2; ++b)
#pragma unroll
                for (int m = 0; m < 4; ++m)
#pragma unroll
                    for (int n = 0; n < 2; ++n) acc[a][b][m][n] = (f32x4){0.f, 0.f, 0.f, 0.f}; }
        cur = nxt; cA = nA; cB = nB; ++ui;
        if constexpr (GATHER) { vC[0][0] = vN[0][0]; vC[0][1] = vN[0][1]; vC[1][0] = vN[1][0]; vC[1][1] = vN[1][1]; }
        if constexpr (ALIGN_EPI) { if (wr == 1) PG8_BAR; }
    }
    PG8_WAIT_V(0);
    if constexpr (!ALIGN_EPI) { if (wr == 0) PG8_BAR; }
    PG8_BAR;
    if constexpr (Epi::AFTER_DRAIN) { E.fused(acc, cur, wr, wc, fr, fq, lds, wid, lane); S.done(cur); }
#undef PG8_SA
#undef PG8_SB
#undef PG8_STAGE
#undef PG8_STAGE_A
#undef PG8_LDA
#undef PG8_LDB
#undef PG8_MMA
#undef PG8_WAIT_V
#undef PG8_WAIT_L
#undef PG8_BAR
#undef PG8_SCHED
}
typedef unsigned u32x2 __attribute__((ext_vector_type(2)));
typedef float f32x2v __attribute__((ext_vector_type(2)));
typedef __bf16 bf16x2v __attribute__((ext_vector_type(2)));
__device__ __forceinline__ unsigned pk2(float lo, float hi) { f32x2v v = {lo, hi}; bf16x2v b = __builtin_convertvector(v, bf16x2v); return __builtin_bit_cast(unsigned, b); }
__device__ __forceinline__ float bflo(unsigned w) { return __builtin_bit_cast(float, w << 16); }
__device__ __forceinline__ float bfhi(unsigned w) { return __builtin_bit_cast(float, w & 0xffff0000u); }
__device__ __forceinline__ float rstd_parts(const GAS float* base, unsigned eoff, int n4, float inv_n) {
    float s = 0.f; const GAS char* p = (const GAS char*)base + (size_t)(eoff * 4u);
    for (int i = 0; i < n4; ++i) { const f32x4 v = *(const GAS f32x4*)(p + 16 * i); s += (v[0] + v[1]) + (v[2] + v[3]); }
    return __builtin_amdgcn_rsqf(s * inv_n + 1e-6f);
}
__device__ const double kRopeRev[16] = {0.15915494309189535, 0.08949940160889101, 0.050329212104487035, 0.0283021958306234, 0.015915494309189534, 0.008949940160889102, 0.005032921210448704, 0.00283021958306234,
                                        0.0015915494309189536, 0.0008949940160889102, 0.0005032921210448703, 0.00028302195830623395, 0.00015915494309189535, 8.949940160889102e-05, 5.0329212104487035e-05, 2.8302195830623396e-05};
__device__ __forceinline__ void rope_cs(int pos, int i, float& cs, float& sn) {
    double a = (double)pos * kRopeRev[i]; a -= __builtin_floor(a);
    const float r = (float)a; sn = __builtin_amdgcn_sinf(r); cs = __builtin_amdgcn_cosf(r);
}
#define PG8_L2E 1.4426950408889634f

struct EpiA {
    static constexpr bool PERM = false, AFTER_DRAIN = false;
    const GAS float* ssq; GAS bf16_t *cq, *ckv, *krope, *qk; GAS float *ssq_cq, *ssq_ckv; float c2; GAS unsigned* kn;
    __device__ __forceinline__ void operator()(const f32x4 (&acc)[2][2][4][2], const Unit& u, int wr, int wc, int fr, int fq) const {
        const int pn = u.pn, row0 = u.pm * BM + wr * 64 + fr;
        float rs[2][4];
#pragma unroll
        for (int ai = 0; ai < 2; ++ai)
#pragma unroll
            for (int m = 0; m < 4; ++m) rs[ai][m] = rstd_parts(ssq, (unsigned)((row0 + ai * HALF + m * 16) * 16), 4, 1.f / 1024.f);
        if (pn < 2) {
            GAS bf16_t* dst = pn == 0 ? cq : ckv; GAS float* sq = pn == 0 ? ssq_cq : ssq_ckv;
#pragma unroll
            for (int ai = 0; ai < 2; ++ai)
#pragma unroll
                for (int m = 0; m < 4; ++m) { const int row = row0 + ai * HALF + m * 16; const float r = rs[ai][m]; float s2 = 0.f;
#pragma unroll
                    for (int bj = 0; bj < 2; ++bj)
#pragma unroll
                        for (int n = 0; n < 2; ++n) { const f32x4 v = acc[ai][bj][m][n] * r; s2 += (v[0] * v[0] + v[1] * v[1]) + (v[2] * v[2] + v[3] * v[3]);
                            u32x2 w; w.x = pk2(v[0], v[1]); w.y = pk2(v[2], v[3]); *(GAS u32x2*)(dst + (size_t)row * 256 + bj * HALF + wc * 32 + n * 16 + fq * 4) = w; }
                    s2 += __shfl_xor(s2, 16); s2 += __shfl_xor(s2, 32);
                    if (fq == 0) sq[(size_t)row * 4 + wc] = s2; }
        } else if (pn == 2) {
            if (wc == 0) {
#pragma unroll
                for (int ai = 0; ai < 2; ++ai)
#pragma unroll
                    for (int m = 0; m < 4; ++m) { const int row = row0 + ai * HALF + m * 16, pos = row & 8191; const float r = rs[ai][m];
                        const f32x4 v0 = acc[ai][0][m][0] * r, v1 = acc[ai][0][m][1] * r; float o0[4], o1[4];
#pragma unroll
                        for (int e = 0; e < 4; ++e) { float cs, sn; rope_cs(pos, 4 * fq + e, cs, sn); o0[e] = v0[e] * cs - v1[e] * sn; o1[e] = v0[e] * sn + v1[e] * cs; }
                        u32x2 w0, w1; w0.x = pk2(o0[0], o0[1]); w0.y = pk2(o0[2], o0[3]); w1.x = pk2(o1[0], o1[1]); w1.y = pk2(o1[2], o1[3]);
                        *(GAS u32x2*)(krope + (size_t)row * 32 + 4 * fq) = w0; *(GAS u32x2*)(krope + (size_t)row * 32 + 16 + 4 * fq) = w1; }
            }
        } else {
            const int t = pn - 3, buf = t >> 1, half = t & 1; GAS bf16_t* dst = qk + (size_t)buf * 16384 * 512; const float sc = (buf & 1) ? 1.f : c2;
#pragma unroll
            for (int ai = 0; ai < 2; ++ai)
#pragma unroll
                for (int bj = 0; bj < 2; ++bj) { float kmx = 0.f;
#pragma unroll
                    for (int m = 0; m < 4; ++m) { const int row = row0 + ai * HALF + m * 16; const float r = rs[ai][m] * sc; float s2 = 0.f;
#pragma unroll
                        for (int n = 0; n < 2; ++n) { const f32x4 v = acc[ai][bj][m][n] * r; u32x2 w; w.x = pk2(v[0], v[1]); w.y = pk2(v[2], v[3]);
                            s2 += (v[0] * v[0] + v[1] * v[1]) + (v[2] * v[2] + v[3] * v[3]);
                            *(GAS u32x2*)(dst + (size_t)row * 512 + half * 256 + bj * HALF + wc * 32 + n * 16 + fq * 4) = w; }
                        kmx = fmaxf(kmx, s2); }
                    if (pn >= 9) {
                        float s = kmx; const float q1 = __shfl_xor(s, 16), q2 = __shfl_xor(s, 32), q3 = __shfl_xor(q1, 32); s = (s + q1) + (q2 + q3);
                        s = fmaxf(s, __shfl_xor(s, 1)); s = fmaxf(s, __shfl_xor(s, 2)); s = fmaxf(s, __shfl_xor(s, 4)); s = fmaxf(s, __shfl_xor(s, 8));
                        if ((fr | fq) == 0) __hip_atomic_fetch_max(kn + (((size_t)(4 * u.pm + 2 * ai + wr) * 8 + 4 * (pn - 9) + 2 * bj + (wc >> 1)) * 2 + (wc & 1)), __builtin_bit_cast(unsigned, s), __ATOMIC_RELAXED, __HIP_MEMORY_SCOPE_AGENT); } }
        }
    }
};
struct EpiVT {
    static constexpr bool PERM = true, AFTER_DRAIN = false;
    GAS bf16_t* out; int ld; const GAS float* ssq; int n4; float inv_n;
    __device__ __forceinline__ void operator()(const f32x4 (&acc)[2][2][4][2], const Unit& u, int wr, int wc, int fr, int fq) const {
        const int col0 = u.pn * BM + wc * 32 + 8 * fq, row0 = u.pm * BM + wr * 64 + fr;
        float cs[2][8];
#pragma unroll
        for (int bj = 0; bj < 2; ++bj)
#pragma unroll
            for (int j = 0; j < 8; ++j) cs[bj][j] = rstd_parts(ssq, (unsigned)((col0 + bj * HALF + j) * (4 * n4)), n4, inv_n);
#pragma unroll
        for (int ai = 0; ai < 2; ++ai)
#pragma unroll
            for (int m = 0; m < 4; ++m) { GAS bf16_t* rowp = out + (size_t)(row0 + ai * HALF + m * 16) * ld + col0;
#pragma unroll
                for (int bj = 0; bj < 2; ++bj) { const f32x4 v0 = acc[ai][bj][m][0], v1 = acc[ai][bj][m][1]; u32x4 w;
                    w.x = pk2(v0[0] * cs[bj][0], v0[1] * cs[bj][1]); w.y = pk2(v0[2] * cs[bj][2], v0[3] * cs[bj][3]);
                    w.z = pk2(v1[0] * cs[bj][4], v1[1] * cs[bj][5]); w.w = pk2(v1[2] * cs[bj][6], v1[3] * cs[bj][7]);
                    *(GAS u32x4*)(rowp + bj * HALF) = w; } }
    }
};
struct EpiRS {
    static constexpr bool PERM = true, AFTER_DRAIN = false;
    GAS bf16_t* out; int ld; const GAS float* ssq; int n4; float inv_n; float scale; int pnmask; int pnshift; size_t zstride;
    __device__ __forceinline__ void operator()(const f32x4 (&acc)[2][2][4][2], const Unit& u, int wr, int wc, int fr, int fq) const {
        const int col0 = (u.pn & pnmask) * BM + wc * 32 + 8 * fq, row0 = u.pm * BM + wr * 64 + fr;
        float rr[2][4];
#pragma unroll
        for (int ai = 0; ai < 2; ++ai)
#pragma unroll
            for (int m = 0; m < 4; ++m) rr[ai][m] = (n4 ? rstd_parts(ssq, (unsigned)((row0 + ai * HALF + m * 16) * (4 * n4)), n4, inv_n) : 1.f) * scale;
#pragma unroll
        for (int ai = 0; ai < 2; ++ai)
#pragma unroll
            for (int m = 0; m < 4; ++m) { const int row = row0 + ai * HALF + m * 16; const float r = rr[ai][m];
                GAS bf16_t* rowp = out + (size_t)(u.pn >> pnshift) * zstride + (size_t)row * ld + col0;
#pragma unroll
                for (int bj = 0; bj < 2; ++bj) { const f32x4 v0 = acc[ai][bj][m][0] * r, v1 = acc[ai][bj][m][1] * r; u32x4 w;
                    w.x = pk2(v0[0], v0[1]); w.y = pk2(v0[2], v0[3]); w.z = pk2(v1[0], v1[1]); w.w = pk2(v1[2], v1[3]); *(GAS u32x4*)(rowp + bj * HALF) = w; } }
    }
};
struct EpiQ {
    static constexpr bool PERM = false, AFTER_DRAIN = false;
    GAS bf16_t* q; const GAS float* ssq_cq; float c2;
    __device__ __forceinline__ void operator()(const f32x4 (&acc)[2][2][4][2], const Unit& u, int wr, int wc, int fr, int fq) const {
        const int pn = u.pn, row0 = u.pm * BM + wr * 64 + fr;
        float rr[2][4];
#pragma unroll
        for (int ai = 0; ai < 2; ++ai)
#pragma unroll
            for (int m = 0; m < 4; ++m) rr[ai][m] = rstd_parts(ssq_cq, (unsigned)((row0 + ai * HALF + m * 16) * 4), 1, 1.f / 256.f) * c2;
#pragma unroll
        for (int ai = 0; ai < 2; ++ai)
#pragma unroll
            for (int m = 0; m < 4; ++m) { const int row = row0 + ai * HALF + m * 16; const float r = rr[ai][m];
                if (pn < 2) {
#pragma unroll
                    for (int bj = 0; bj < 2; ++bj)
#pragma unroll
                        for (int n = 0; n < 2; ++n) { const f32x4 v = acc[ai][bj][m][n] * r; u32x2 w; w.x = pk2(v[0], v[1]); w.y = pk2(v[2], v[3]);
                            *(GAS u32x2*)(q + (size_t)row * 768 + pn * 256 + bj * HALF + wc * 32 + n * 16 + fq * 4) = w; }
                } else { const int pos = row & 8191; float cs[4], sn[4];
#pragma unroll
                    for (int e = 0; e < 4; ++e) rope_cs(pos, 4 * fq + e, cs[e], sn[e]);
#pragma unroll
                    for (int bj = 0; bj < 2; ++bj) { const f32x4 v0 = acc[ai][bj][m][0] * r, v1 = acc[ai][bj][m][1] * r; float o0[4], o1[4];
#pragma unroll
                        for (int e = 0; e < 4; ++e) { o0[e] = v0[e] * cs[e] - v1[e] * sn[e]; o1[e] = v0[e] * sn[e] + v1[e] * cs[e]; }
                        u32x2 w0, w1; w0.x = pk2(o0[0], o0[1]); w0.y = pk2(o0[2], o0[3]); w1.x = pk2(o1[0], o1[1]); w1.y = pk2(o1[2], o1[3]);
                        GAS bf16_t* p = q + (size_t)row * 768 + 512 + (4 * bj + wc) * 32 + 4 * fq; *(GAS u32x2*)p = w0; *(GAS u32x2*)(p + 16) = w1; }
                } }
    }
};
struct D1Order {
    StaticOrder so; size_t dA, dB;
    __device__ __forceinline__ bool next(int i, Unit& u) const { if (i >= 9) return false; if (!so.next(0, u)) return false; u.sel = i; return true; }
    __device__ __forceinline__ void a_ready(const Unit&) const {}
    __device__ __forceinline__ void done(const Unit&) const {}
    __device__ __forceinline__ size_t a_off(const Unit& u) const { const int z = u.sel / 3, p = u.sel - 3 * z; return p == 2 ? dA + (size_t)(z >> 1) * 16384 * 2048 + (size_t)(z & 1) * 1024 : (size_t)p * 1024; }
    __device__ __forceinline__ size_t b_off(const Unit& u) const { const int z = u.sel / 3, p = u.sel - 3 * z; return p == 2 ? dB + (size_t)(z >> 1) * 1024 * 2048 + (size_t)(z & 1) * 1024 : (size_t)z * 1024 * 2048 + (size_t)p * 1024; }
    __device__ __forceinline__ bool keep(const Unit& u) const { return (u.sel % 3) == 0; }
};
struct EpiD1 {
    static constexpr bool PERM = true, AFTER_DRAIN = false;
    GAS bf16_t* g; GAS bf16_t* mb; const GAS float* ssq;
    __device__ __forceinline__ void operator()(const f32x4 (&acc)[2][2][4][2], const Unit& u, int wr, int wc, int fr, int fq) const {
        const int col0 = u.pn * BM + wc * 32 + 8 * fq, row0 = u.pm * BM + wr * 64 + fr, z = u.sel / 3;
        if (u.sel % 3 == 1) {
            float rr[2][4];
#pragma unroll
            for (int ai = 0; ai < 2; ++ai)
#pragma unroll
                for (int m = 0; m < 4; ++m) rr[ai][m] = -PG8_L2E * rstd_parts(ssq, (unsigned)((row0 + ai * HALF + m * 16) * 16), 4, 1.f / 1024.f);
#pragma unroll
            for (int ai = 0; ai < 2; ++ai)
#pragma unroll
                for (int m = 0; m < 4; ++m) { const int row = row0 + ai * HALF + m * 16; const float r = rr[ai][m];
#pragma unroll
                    for (int bj = 0; bj < 2; ++bj) { float s[8];
#pragma unroll
                        for (int j = 0; j < 8; ++j) s[j] = __builtin_amdgcn_rcpf(1.f + __builtin_amdgcn_exp2f(acc[ai][bj][m][j >> 2][j & 3] * r));
                        u32x4 w; w.x = pk2(s[0], s[1]); w.y = pk2(s[2], s[3]); w.z = pk2(s[4], s[5]); w.w = pk2(s[6], s[7]);
                        *(GAS u32x4*)(g + (size_t)row * 1024 + col0 + bj * HALF) = w; } }
        } else {
#pragma unroll
            for (int ai = 0; ai < 2; ++ai) {
                u32x4 gw[4][2], pw[4][2];
#pragma unroll
                for (int m = 0; m < 4; ++m)
#pragma unroll
                    for (int bj = 0; bj < 2; ++bj) { const size_t o = (size_t)(row0 + ai * HALF + m * 16) * 1024 + col0 + bj * HALF; gw[m][bj] = *(const GAS u32x4*)(g + o);
                        if (z > 0) pw[m][bj] = *(const GAS u32x4*)(mb + o); else pw[m][bj] = (u32x4){0u, 0u, 0u, 0u}; }
#pragma unroll
                for (int m = 0; m < 4; ++m)
#pragma unroll
                    for (int bj = 0; bj < 2; ++bj) { const size_t o = (size_t)(row0 + ai * HALF + m * 16) * 1024 + col0 + bj * HALF; const u32x4 gq = gw[m][bj], pm_ = pw[m][bj];
                        f32x4 a0 = acc[ai][bj][m][0], a1 = acc[ai][bj][m][1];
                        a0[0] = a0[0] * bflo(gq.x) + bflo(pm_.x); a0[1] = a0[1] * bfhi(gq.x) + bfhi(pm_.x); a0[2] = a0[2] * bflo(gq.y) + bflo(pm_.y); a0[3] = a0[3] * bfhi(gq.y) + bfhi(pm_.y);
                        a1[0] = a1[0] * bflo(gq.z) + bflo(pm_.z); a1[1] = a1[1] * bfhi(gq.z) + bfhi(pm_.z); a1[2] = a1[2] * bflo(gq.w) + bflo(pm_.w); a1[3] = a1[3] * bfhi(gq.w) + bfhi(pm_.w);
                        u32x4 w; w.x = pk2(a0[0], a0[1]); w.y = pk2(a0[2], a0[3]); w.z = pk2(a1[0], a1[1]); w.w = pk2(a1[2], a1[3]); *(GAS u32x4*)(mb + o) = w; } }
        }
    }
};
struct EpiRes {
    static constexpr bool PERM = false, AFTER_DRAIN = false;
    const GAS float* xin; GAS float* xout; GAS bf16_t* xb; GAS float* ssq;
    __device__ __forceinline__ void operator()(const f32x4 (&acc)[2][2][4][2], const Unit& u, int wr, int wc, int fr, int fq) const {
        const int col0 = u.pn * BM + wc * 32 + 4 * fq, row0 = u.pm * BM + wr * 64 + fr;
#pragma unroll
        for (int ai = 0; ai < 2; ++ai) {
            f32x4 xv[4][2][2];
#pragma unroll
            for (int m = 0; m < 4; ++m)
#pragma unroll
                for (int bj = 0; bj < 2; ++bj)
#pragma unroll
                    for (int n = 0; n < 2; ++n) xv[m][bj][n] = *(const GAS f32x4*)(xin + (size_t)(row0 + ai * HALF + m * 16) * 1024 + col0 + bj * HALF + n * 16);
#pragma unroll
            for (int m = 0; m < 4; ++m) { const int row = row0 + ai * HALF + m * 16; const size_t rb = (size_t)row * 1024 + col0; float s2 = 0.f;
#pragma unroll
                for (int bj = 0; bj < 2; ++bj)
#pragma unroll
                    for (int n = 0; n < 2; ++n) { const size_t o = rb + bj * HALF + n * 16; const f32x4 v = xv[m][bj][n] + acc[ai][bj][m][n];
                        *(GAS f32x4*)(xout + o) = v; u32x2 w; w.x = pk2(v[0], v[1]); w.y = pk2(v[2], v[3]); *(GAS u32x2*)(xb + o) = w;
                        s2 += (v[0] * v[0] + v[1] * v[1]) + (v[2] * v[2] + v[3] * v[3]); }
                s2 += __shfl_xor(s2, 16); s2 += __shfl_xor(s2, 32);
                if (fq == 0) ssq[(size_t)row * 16 + u.pn * 4 + wc] = s2; } }
    }
};
struct EpiAct {
    static constexpr bool PERM = true, AFTER_DRAIN = false;
    GAS bf16_t* act; const GAS float* s_rstd; const GAS float* s_w;
    __device__ __forceinline__ void operator()(const f32x4 (&acc)[2][2][4][2], const Unit& u, int wr, int wc, int fr, int fq) const {
        const int t = u.pn & 1, row0 = u.pm * BM + wr * 64 + fr;
        float rr[2][4], ww[2][4];
#pragma unroll
        for (int ai = 0; ai < 2; ++ai)
#pragma unroll
            for (int m = 0; m < 4; ++m) { rr[ai][m] = s_rstd[row0 + ai * HALF + m * 16]; ww[ai][m] = s_w[row0 + ai * HALF + m * 16]; }
#pragma unroll
        for (int ai = 0; ai < 2; ++ai)
#pragma unroll
            for (int m = 0; m < 4; ++m) { const int row = row0 + ai * HALF + m * 16; const float rs = rr[ai][m], w = ww[ai][m]; float o[8];
#pragma unroll
                for (int j = 0; j < 8; ++j) { const float a = acc[ai][0][m][j >> 2][j & 3] * rs, b = acc[ai][1][m][j >> 2][j & 3] * rs;
                    const float v = a * __builtin_amdgcn_rcpf(1.f + __builtin_amdgcn_exp2f(-PG8_L2E * a)) * b * w; o[j] = (w != 0.f) ? v : 0.f; }
                u32x4 pw; pw.x = pk2(o[0], o[1]); pw.y = pk2(o[2], o[3]); pw.z = pk2(o[4], o[5]); pw.w = pk2(o[6], o[7]);
                *(GAS u32x4*)(act + (size_t)row * 256 + t * 128 + wc * 32 + 8 * fq) = pw; }
    }
};
struct SplitK2Order {
    StaticOrder so; size_t tstep;
    __device__ __forceinline__ bool next(int i, Unit& u) const { return so.next(i, u); }
    __device__ __forceinline__ void a_ready(const Unit&) const {}
    __device__ __forceinline__ void done(const Unit&) const {}
    __device__ __forceinline__ size_t a_off(const Unit& u) const { return (size_t)(u.pn >> 1) * 1024; }
    __device__ __forceinline__ size_t b_off(const Unit& u) const { return (size_t)(u.pn >> 1) * 1024 - (size_t)(u.pn >> 1) * 2 * tstep; }
    __device__ __forceinline__ bool keep(const Unit&) const { return false; }
};
struct MoeOrder {
    const PG8_LAS int* tstart; int per, G, v;
    __device__ __forceinline__ bool next(int i, Unit& u) const {
        const int idx = i * G + v, tot = tstart[32] * per; if (idx >= tot) return false;
        const int ti = idx / per, ct = idx - ti * per; int e = 0;
#pragma unroll 1
        for (int k = 1; k < 32; ++k) e += (tstart[k] <= ti) ? 1 : 0;
        u.pm = ti; u.pn = e * per + ct; u.sel = 0; return true;
    }
    __device__ __forceinline__ void a_ready(const Unit&) const {}
    __device__ __forceinline__ void done(const Unit&) const {}
    __device__ __forceinline__ size_t a_off(const Unit&) const { return 0; }
    __device__ __forceinline__ size_t b_off(const Unit&) const { return 0; }
    __device__ __forceinline__ bool keep(const Unit&) const { return false; }
};
}
namespace att {
typedef unsigned short bf16;
typedef short bf16x8 __attribute__((ext_vector_type(8)));
typedef short s16x4 __attribute__((ext_vector_type(4)));
typedef float f32x16 __attribute__((ext_vector_type(16)));
typedef float f32x4 __attribute__((ext_vector_type(4)));
typedef unsigned u32x4 __attribute__((ext_vector_type(4)));
typedef unsigned u32x2 __attribute__((ext_vector_type(2)));
typedef float f32x2v __attribute__((ext_vector_type(2)));
typedef __bf16 bf16x2v __attribute__((ext_vector_type(2)));
__device__ __forceinline__ unsigned pk2(float lo, float hi) { f32x2v v = {lo, hi}; bf16x2v b = __builtin_convertvector(v, bf16x2v); return __builtin_bit_cast(unsigned, b); }
__device__ __forceinline__ float bflo(unsigned w) { return __builtin_bit_cast(float, w << 16); }
__device__ __forceinline__ float bfhi(unsigned w) { return __builtin_bit_cast(float, w & 0xffff0000u); }
__device__ __forceinline__ int crow(int r, int hi) { return (r & 3) + 8 * (r >> 2) + 4 * hi; }
__device__ __forceinline__ float xhalf(float v) {
    const unsigned u = __builtin_bit_cast(unsigned, v);
    auto rr = __builtin_amdgcn_permlane32_swap(u, u, false, false);
    const unsigned o = (rr[0] != u) ? rr[0] : rr[1];
    return __builtin_bit_cast(float, o);
}
__device__ __forceinline__ bf16x8 mk8(unsigned a, unsigned b, unsigned c, unsigned d) { u32x4 w = {a, b, c, d}; return __builtin_bit_cast(bf16x8, w); }

constexpr int VPB = 144;
template <int DK> struct KLay { static constexpr int KPB = (DK + 8) * 2, KBUF = 64 * KPB; };

template <int DK, int DV, bool KROPE> struct Stage {
    static constexpr int NK = KROPE ? 1 : DK / 64, NV = DV / 64;
    u32x4 kr[NK]; u32x4 kr2; u32x4 vr[NV];
    __device__ __forceinline__ void loadK(int tid, const GAS bf16* Kg, int ldk, const GAS bf16* K2g, int kv0) {
        const GAS char* kbase = (const GAS char*)(Kg + (size_t)kv0 * ldk);
        if constexpr (KROPE) {
            kr[0] = *(const GAS u32x4*)(kbase + (unsigned)(((tid >> 3) * ldk + 8 * (tid & 7)) * 2));
            if (tid < 256) kr2 = *(const GAS u32x4*)((const GAS char*)(K2g + (size_t)kv0 * 32) + (unsigned)(tid * 16));
        } else {
#pragma unroll
            for (int i = 0; i < NK; ++i) { const int p = tid + 512 * i, row = p / (DK / 8), ch = p % (DK / 8); kr[i] = *(const GAS u32x4*)(kbase + (unsigned)((row * ldk + 8 * ch) * 2)); }
        }
    }
    __device__ __forceinline__ void loadV(int tid, const GAS bf16* Vg, int ldv, int kv0) {
        const GAS char* vbase = (const GAS char*)(Vg + kv0);
#pragma unroll
        for (int i = 0; i < NV; ++i) { const int p = tid + 512 * i, dd = p >> 3, ch = p & 7; vr[i] = *(const GAS u32x4*)(vbase + (unsigned)((dd * ldv + 8 * ch) * 2)); }
    }
    __device__ __forceinline__ void storeK(int tid, LAS unsigned char* kb) const {
        constexpr int KPB = KLay<DK>::KPB;
        if constexpr (KROPE) {
            *(LAS u32x4*)(kb + (tid >> 3) * KPB + 16 * (tid & 7)) = kr[0];
            if (tid < 256) *(LAS u32x4*)(kb + (tid >> 2) * KPB + 128 + 16 * (tid & 3)) = kr2;
        } else {
#pragma unroll
            for (int i = 0; i < NK; ++i) { const int p = tid + 512 * i, row = p / (DK / 8), ch = p % (DK / 8); *(LAS u32x4*)(kb + row * KPB + 16 * ch) = kr[i]; }
        }
    }
    __device__ __forceinline__ void storeV(int tid, LAS unsigned char* vb) const {
#pragma unroll
        for (int i = 0; i < NV; ++i) { const int p = tid + 512 * i, dd = p >> 3, ch = p & 7; LAS unsigned char* q = vb + dd * VPB + 32 * (ch >> 1) + 8 * (ch & 1);
            *(LAS u32x2*)q = (u32x2){vr[i].x, vr[i].y}; *(LAS u32x2*)(q + 16) = (u32x2){vr[i].z, vr[i].w}; }
    }
    __device__ __forceinline__ void load(int tid, const GAS bf16* Kg, int ldk, const GAS bf16* K2g, const GAS bf16* Vg, int ldv, int kv0) { loadK(tid, Kg, ldk, K2g, kv0); loadV(tid, Vg, ldv, kv0); }
    __device__ __forceinline__ void store(int tid, LAS unsigned char* kb, LAS unsigned char* vb) const { storeK(tid, kb); storeV(tid, vb); }
};

template <int DK> __device__ __forceinline__ void qkt(f32x16& p0, f32x16& p1, const LAS unsigned char* kb, const bf16x8 (&qf)[DK / 16], int r32, int hi) {
    constexpr int KPB = KLay<DK>::KPB;
    const LAS unsigned char* k0 = kb + r32 * KPB + hi * 16;
#pragma unroll
    for (int d0 = 0; d0 < DK / 16; ++d0) {
        const bf16x8 a0 = *(const LAS bf16x8*)(k0 + d0 * 32), a1 = *(const LAS bf16x8*)(k0 + 32 * KPB + d0 * 32);
        p0 = __builtin_amdgcn_mfma_f32_32x32x16_bf16(a0, qf[d0], p0, 0, 0, 0);
        p1 = __builtin_amdgcn_mfma_f32_32x32x16_bf16(a1, qf[d0], p1, 0, 0, 0);
    }
}
template <int DK> __device__ __forceinline__ void qkt_qmem(f32x16& p0, f32x16& p1, const LAS unsigned char* kb, const bf16x8* qf, const LAS unsigned char* qlds, int r32, int hi) {
    constexpr int KPB = KLay<DK>::KPB, QR = DK / 32;
    const LAS unsigned char* k0 = kb + r32 * KPB + hi * 16;
#pragma unroll
    for (int d0 = 0; d0 < DK / 16; ++d0) {
        bf16x8 q; if (d0 < QR) q = qf[d0]; else q = *(const LAS bf16x8*)(qlds + (d0 - QR) * 1024);
        const bf16x8 a0 = *(const LAS bf16x8*)(k0 + d0 * 32), a1 = *(const LAS bf16x8*)(k0 + 32 * KPB + d0 * 32);
        p0 = __builtin_amdgcn_mfma_f32_32x32x16_bf16(a0, q, p0, 0, 0, 0);
        p1 = __builtin_amdgcn_mfma_f32_32x32x16_bf16(a1, q, p1, 0, 0, 0);
        if ((d0 & 3) == 3) __builtin_amdgcn_sched_barrier(0);
    }
}
template <int DV> __device__ __forceinline__ void pv(f32x16 (&o)[DV / 32], const LAS unsigned char* vb, const bf16x8 (&pf)[4], int r32, int hi) {
#pragma unroll
    for (int db = 0; db < DV / 32; ++db) {
        const LAS unsigned char* v0 = vb + (32 * db + r32) * VPB + 16 * hi;
#pragma unroll
        for (int s = 0; s < 4; ++s) {
            const bf16x8 vf = *(const LAS bf16x8*)(v0 + 32 * s);
            o[db] = __builtin_amdgcn_mfma_f32_32x32x16_bf16(vf, pf[s], o[db], 0, 0, 0);
        }
        if (DV > 64) __builtin_amdgcn_sched_barrier(0);
    }
}
__device__ __forceinline__ void pack_p(bf16x8 (&pf)[4], const f32x16& p0, const f32x16& p1) {
    pf[0] = mk8(pk2(p0[0], p0[1]), pk2(p0[2], p0[3]), pk2(p0[4], p0[5]), pk2(p0[6], p0[7]));
    pf[1] = mk8(pk2(p0[8], p0[9]), pk2(p0[10], p0[11]), pk2(p0[12], p0[13]), pk2(p0[14], p0[15]));
    pf[2] = mk8(pk2(p1[0], p1[1]), pk2(p1[2], p1[3]), pk2(p1[4], p1[5]), pk2(p1[6], p1[7]));
    pf[3] = mk8(pk2(p1[8], p1[9]), pk2(p1[10], p1[11]), pk2(p1[12], p1[13]), pk2(p1[14], p1[15]));
}

template <bool ALIBI> __device__ __forceinline__ void fl_init(f32x16& p0, f32x16& p1, float slope2, int kv0, int hi, int qrow) {
    if (ALIBI) {
        const float s2 = slope2 + slope2, s4 = s2 + s2, s8 = s4 + s4, s32 = (s8 + s8) + (s8 + s8);
        float g = slope2 * (float)(kv0 + 4 * hi - qrow);
#pragma unroll
        for (int c = 0; c < 4; ++c) { float v = g;
#pragma unroll
            for (int e = 0; e < 4; ++e) { p0[4 * c + e] = v; p1[4 * c + e] = v + s32; v += slope2; }
            g += s8; } }
    else {
#pragma unroll
        for (int r = 0; r < 16; ++r) { p0[r] = 0.f; p1[r] = 0.f; } }
}
__device__ __forceinline__ void fl_mask(f32x16& p0, f32x16& p1, int kv0, int hi, int qrow) {
    const int thr = qrow - kv0 - 4 * hi;
#pragma unroll
    for (int r = 0; r < 16; ++r) { const int c = (r & 3) + 8 * (r >> 2); if (c > thr) p0[r] = -INFINITY; if (c + 32 > thr) p1[r] = -INFINITY; }
}
__device__ __forceinline__ void fl_start(const f32x16& p0, const f32x16& p1, float& m, float& alpha) {
    float mx = fmaxf(p0[0], p1[0]);
#pragma unroll
    for (int r = 1; r < 16; ++r) mx = fmaxf(fmaxf(mx, p0[r]), p1[r]);
    mx = fmaxf(mx, xhalf(mx));
    const float mn = fmaxf(m, mx); alpha = __builtin_amdgcn_exp2f(m - mn); m = mn;
}
__device__ __forceinline__ void fl_finish(f32x16& p0, f32x16& p1, float m, float& l, bf16x8 (&pf)[4]) {
    float s0 = 0.f, s1 = 0.f;
#pragma unroll
    for (int r = 0; r < 16; ++r) { p0[r] = __builtin_amdgcn_exp2f(p0[r] - m); p1[r] = __builtin_amdgcn_exp2f(p1[r] - m); s0 += p0[r]; s1 += p1[r]; }
    l += s0 + s1;
    pack_p(pf, p0, p1);
}

#define FL_EL(P0, P1, e) ((e) < 16 ? P0[(e) & 15] : P1[(e) & 15])
template <int DK, bool QMEM> __device__ __forceinline__ void fl_blockX(f32x16& n0, f32x16& n1, const LAS unsigned char* kb, const bf16x8* qf, const LAS unsigned char* qlds, int r32, int hi,
                                                                         f32x16& c0, f32x16& c1, float m, float& l, bf16x8 (&pf)[4]) {
    constexpr int KPB = KLay<DK>::KPB, NS = DK / 16, CH = ((32 + NS - 1) / NS + 1) & ~1;
    const LAS unsigned char* k0 = kb + r32 * KPB + hi * 16;
    float s0 = 0.f, s1 = 0.f; unsigned pw[16];
#define FLX_K0(s) (*(const LAS bf16x8*)(k0 + ((s) < NS ? (s) : NS - 1) * 32))
#define FLX_K1(s) (*(const LAS bf16x8*)(k0 + 32 * KPB + ((s) < NS ? (s) : NS - 1) * 32))
    bf16x8 a0 = FLX_K0(0), a1 = FLX_K1(0), b0 = FLX_K0(1), b1 = FLX_K1(1), e0 = FLX_K0(2), e1 = FLX_K1(2);
    bf16x8 q, qb, qe; if constexpr (QMEM) { q = *(const LAS bf16x8*)(qlds); qb = *(const LAS bf16x8*)(qlds + (NS > 1 ? 1024 : 0)); qe = *(const LAS bf16x8*)(qlds + (NS > 2 ? 2048 : 0)); } else { q = qf[0]; qb = qf[NS > 1 ? 1 : 0]; qe = qf[NS > 2 ? 2 : 0]; }
#pragma unroll
    for (int d0 = 0; d0 < NS; ++d0) {
        bf16x8 c0n = e0, c1n = e1, qc = qe;
        if (d0 + 3 < NS) { c0n = FLX_K0(d0 + 3); c1n = FLX_K1(d0 + 3);
            if constexpr (QMEM) qc = *(const LAS bf16x8*)(qlds + (d0 + 3) * 1024); else qc = qf[d0 + 3]; }
        n0 = __builtin_amdgcn_mfma_f32_32x32x16_bf16(a0, q, n0, 0, 0, 0);
        n1 = __builtin_amdgcn_mfma_f32_32x32x16_bf16(a1, q, n1, 0, 0, 0);
#pragma unroll
        for (int e = d0 * CH; e < (d0 + 1) * CH && e < 32; e += 2) {
            float x, y;
            if (e < 16) { x = __builtin_amdgcn_exp2f(c0[e] - m); y = __builtin_amdgcn_exp2f(c0[e + 1] - m); s0 += x; s1 += y; }
            else { x = __builtin_amdgcn_exp2f(c1[e - 16] - m); y = __builtin_amdgcn_exp2f(c1[e - 15] - m); s0 += x; s1 += y; }
            pw[e >> 1] = pk2(x, y); asm volatile("" : "+v"(pw[e >> 1])); }
        asm volatile("" : "+v"(s0), "+v"(s1));
        __builtin_amdgcn_sched_barrier(0);
        a0 = b0; a1 = b1; q = qb; b0 = e0; b1 = e1; qb = qe; e0 = c0n; e1 = c1n; qe = qc;
    }
#undef FLX_K0
#undef FLX_K1
    l += s0 + s1;
    pf[0] = mk8(pw[0], pw[1], pw[2], pw[3]); pf[1] = mk8(pw[4], pw[5], pw[6], pw[7]); pf[2] = mk8(pw[8], pw[9], pw[10], pw[11]); pf[3] = mk8(pw[12], pw[13], pw[14], pw[15]);
}
template <int DV> __device__ __forceinline__ void fl_blockY(f32x16 (&o)[DV / 32], const LAS unsigned char* vb, const bf16x8 (&pf)[4], int r32, int hi, const f32x16& n0, const f32x16& n1, float& m, float& alpha) {
    constexpr int NS = DV / 8, CH = 32 / NS;
    float mx0 = -INFINITY, mx1 = -INFINITY;
    const LAS unsigned char* v0 = vb + r32 * VPB + 16 * hi;
    bf16x8 vf = *(const LAS bf16x8*)(v0), vg = *(const LAS bf16x8*)(v0 + 32);
#pragma unroll
    for (int st = 0; st < NS; ++st) {
        const int db = st >> 2, s = st & 3;
        bf16x8 vn = vg;
        if (st + 2 < NS) vn = *(const LAS bf16x8*)(v0 + ((st + 2) >> 2) * 32 * VPB + 32 * ((st + 2) & 3));
        o[db] = __builtin_amdgcn_mfma_f32_32x32x16_bf16(vf, pf[s], o[db], 0, 0, 0);
#pragma unroll
        for (int e = st * CH; e < (st + 1) * CH; ++e) { if (e < 16) mx0 = fmaxf(mx0, n0[e]); else mx1 = fmaxf(mx1, n1[e - 16]); }
        asm volatile("" : "+v"(mx0), "+v"(mx1));
        __builtin_amdgcn_sched_barrier(0);
        vf = vg; vg = vn;
    }
    float mx = fmaxf(mx0, mx1); mx = fmaxf(mx, xhalf(mx));
    const float mn = fmaxf(m, mx); alpha = __builtin_amdgcn_exp2f(m - mn); m = mn;
}

template <int DK, int DV, bool CAUSAL, bool ALIBI, bool KROPE, bool QMEM = false, bool DESC = false>
__device__ __forceinline__ void flash_pass(LAS unsigned char* lds, int tid, const GAS bf16* Qrow, const GAS bf16* Qrow2, const GAS bf16* Kg, int ldk, const GAS bf16* K2g, const GAS bf16* Vg, int ldv,
                                           int NT, int ntw, int qrow, float slope2, f32x16 (&o)[DV / 32], float& lsum, const GAS unsigned* kn = nullptr, int abl = 0) {
    constexpr int KBUF = KLay<DK>::KBUF, VBUF = DV * VPB, QOFF = 2 * KBUF + 2 * VBUF, XOFF = QOFF + 8 * (DK / 16) * 1024;
    constexpr bool CUT = DESC && ALIBI;
    const int lane = tid & 63, r32 = lane & 31, hi = lane >> 5, wid = tid >> 6;
#define FL_TI(i) (DESC ? NT - 1 - (i) : (i))
    bf16x8 qf[QMEM ? 1 : DK / 16];
    LAS unsigned char* qlds = lds + QOFF + wid * (DK / 16) * 1024 + lane * 16;
    float qn2 = 0.f;
#pragma unroll
    for (int d0 = 0; d0 < DK / 16; ++d0) {
        bf16x8 v;
        if (KROPE && d0 >= 4) v = *(const GAS bf16x8*)(Qrow2 + 16 * (d0 - 4) + 8 * hi);
        else v = *(const GAS bf16x8*)(Qrow + 16 * d0 + 8 * hi);
        if constexpr (CUT) {
#pragma unroll
            for (int j = 0; j < 8; ++j) { const float f = __builtin_bit_cast(float, (unsigned)(unsigned short)v[j] << 16); qn2 += f * f; } }
        if constexpr (QMEM) *(LAS bf16x8*)(qlds + d0 * 1024) = v; else qf[d0] = v;
    }
    volatile LAS float* kpre = (volatile LAS float*)(lds + XOFF);
    volatile LAS unsigned* dflag = (volatile LAS unsigned*)(lds + XOFF + 512);
    float qn = 0.f;
    if constexpr (CUT) {
        qn2 += xhalf(qn2); qn = sqrtf(qn2);
        if (wid == 0) {
            float v0 = 0.f, v1 = 0.f;
            if (lane < NT) v0 = sqrtf(__builtin_bit_cast(float, kn[(size_t)lane * 16]) + __builtin_bit_cast(float, kn[(size_t)lane * 16 + 1])) * 1.01f;
            if (lane + 64 < NT) v1 = sqrtf(__builtin_bit_cast(float, kn[(size_t)(lane + 64) * 16]) + __builtin_bit_cast(float, kn[(size_t)(lane + 64) * 16 + 1])) * 1.01f;
#pragma unroll
            for (int dd = 1; dd < 64; dd <<= 1) { const float u0 = __shfl_up(v0, dd), u1 = __shfl_up(v1, dd); if (lane >= dd) { v0 = fmaxf(v0, u0); v1 = fmaxf(v1, u1); } }
            v1 = fmaxf(v1, __shfl(v0, 63));
            kpre[lane] = v0; kpre[lane + 64] = v1;
        }
    }
#pragma unroll
    for (int db = 0; db < DV / 32; ++db)
#pragma unroll
        for (int r = 0; r < 16; ++r) o[db][r] = 0.f;
    float m = -INFINITY, l = 0.f, alpha = 1.0f;
    int cut = NT;
    Stage<DK, DV, KROPE> st;
    st.loadK(tid, Kg, ldk, K2g, 64 * FL_TI(0)); st.loadV(tid, Vg, ldv, 64 * FL_TI(0));
    st.storeK(tid, lds); st.storeV(tid, lds + 2 * KBUF);
    if (NT > 1) { st.loadK(tid, Kg, ldk, K2g, 64 * FL_TI(1)); st.storeK(tid, lds + KBUF); }
    __syncthreads();
    if (NT > 2) st.loadK(tid, Kg, ldk, K2g, 64 * FL_TI(2));
    if (NT > 1) st.loadV(tid, Vg, ldv, 64 * FL_TI(1));
    f32x16 pa0, pa1, pb0, pb1;
#define FL_QKT(P0, P1, KB) do { if constexpr (QMEM) { bf16x8 qt_[DK / 16]; _Pragma("unroll") for (int d0 = 0; d0 < DK / 16; ++d0) qt_[d0] = *(const LAS bf16x8*)(qlds + d0 * 1024); qkt<DK>(P0, P1, KB, qt_, r32, hi); } else qkt<DK>(P0, P1, KB, qf, r32, hi); } while (0)
#define FL_FIRST(P0, P1, KB, TILE) do { const int kv_ = 64 * (TILE); fl_init<ALIBI>(P0, P1, slope2, kv_, hi, qrow); FL_QKT(P0, P1, KB); \
        if (CAUSAL && kv_ + 63 > qrow - r32) fl_mask(P0, P1, kv_, hi, qrow); fl_start(P0, P1, m, alpha); } while (0)
    if (FL_TI(0) < ntw) FL_FIRST(pa0, pa1, lds, FL_TI(0));
    __syncthreads();
    for (int i = 0; i < NT; ++i) {
        int tq_ = tid; asm volatile("" : "+v"(tq_));
        if (!(abl & 1)) {
            if (i + 2 < NT) st.storeK(tq_, lds + (i & 1) * KBUF);
            if (i + 1 < NT) st.storeV(tq_, lds + 2 * KBUF + ((i + 1) & 1) * VBUF);
            if (i + 3 < NT) st.loadK(tq_, Kg, ldk, K2g, 64 * FL_TI(i + 3));
            if (i + 2 < NT) st.loadV(tq_, Vg, ldv, 64 * FL_TI(i + 2)); }
        const int tc = FL_TI(i), tn = FL_TI(i + 1);
        const bool ac = tc < ntw && i < cut && !(abl & 2);
        bool an = i + 1 < NT && tn < ntw && i + 1 < cut && !(abl & 2);
        if constexpr (CUT) {
            if (ac && an) {
                const bool dead = qn * kpre[tn] + slope2 * (float)(64 * tn + 63 - qrow) < m - 64.f;
                if (__all(dead)) { cut = i + 1; an = false; } } }
        const LAS unsigned char* kn_ = lds + ((i + 1) & 1) * KBUF; const LAS unsigned char* vc_ = lds + 2 * KBUF + (i & 1) * VBUF;
        if (ac) {
            l *= alpha;
            if (__any(alpha != 1.0f)) {
#pragma unroll
                for (int db = 0; db < DV / 32; ++db) asm volatile("" : "+v"(o[db]));
#pragma unroll
                for (int db = 0; db < DV / 32; ++db)
#pragma unroll
                    for (int r = 0; r < 16; ++r) o[db][r] *= alpha;
#pragma unroll
                for (int db = 0; db < DV / 32; ++db) asm volatile("" : "+v"(o[db])); }
            bf16x8 pf[4];
            if (an) {
                const int kv1_ = 64 * tn;
                const bool diag_ = CAUSAL && (kv1_ + 63 > qrow - r32);
                fl_init<ALIBI>(pb0, pb1, slope2, kv1_, hi, qrow);
                fl_blockX<DK, QMEM>(pb0, pb1, kn_, qf, qlds, r32, hi, pa0, pa1, m, l, pf);
                if (!diag_) { fl_blockY<DV>(o, vc_, pf, r32, hi, pb0, pb1, m, alpha); }
                else { pv<DV>(o, vc_, pf, r32, hi); fl_mask(pb0, pb1, kv1_, hi, qrow); fl_start(pb0, pb1, m, alpha); }
            } else {
                fl_finish(pa0, pa1, m, l, pf); pv<DV>(o, vc_, pf, r32, hi);
            }
        } else if (an) { FL_FIRST(pb0, pb1, kn_, tn); }
        if constexpr (CUT) { if (lane == 0) dflag[(i & 1) * 8 + wid] = (i + 1 >= cut) ? 1u : 0u; }
        if (!(abl & 4)) __syncthreads();
        if constexpr (CUT) { unsigned alld = 1u;
#pragma unroll
            for (int w = 0; w < 8; ++w) alld &= dflag[(i & 1) * 8 + w];
            if (alld) break; }
        if (!(abl & 8)) { pa0 = pb0; pa1 = pb1; }
    }
#undef FL_FIRST
#undef FL_QKT
#undef FL_TI
    lsum = l + xhalf(l);
}

template <int DK, int DV, bool CAUSAL, bool ALIBI, bool KROPE, bool QMEM = false>
__device__ __forceinline__ void flash_pass_simple(LAS unsigned char* lds, int tid, const GAS bf16* Qrow, const GAS bf16* Qrow2, const GAS bf16* Kg, int ldk, const GAS bf16* K2g, const GAS bf16* Vg, int ldv,
                                           int NT, int ntw, int qrow, float slope2, f32x16 (&o)[DV / 32], float& lsum) {
    constexpr int KBUF = KLay<DK>::KBUF, VBUF = DV * VPB;
    const int lane = tid & 63, r32 = lane & 31, hi = lane >> 5;
    constexpr int QR = QMEM ? DK / 32 : DK / 16;
    bf16x8 qf[QR];
    LAS unsigned char* qlds = lds + 2 * KBUF + 2 * VBUF + (tid >> 6) * (DK / 16 - QR + 1) * 1024 + lane * 16;
#pragma unroll
    for (int d0 = 0; d0 < DK / 16; ++d0) {
        bf16x8 v;
        if (KROPE && d0 >= 4) v = *(const GAS bf16x8*)(Qrow2 + 16 * (d0 - 4) + 8 * hi);
        else v = *(const GAS bf16x8*)(Qrow + 16 * d0 + 8 * hi);
        if constexpr (!KROPE && QMEM) {
            const bf16x8 w2 = *(const GAS bf16x8*)(Qrow2 + 16 * d0 + 8 * hi); const u32x4 a4 = __builtin_bit_cast(u32x4, v), b4 = __builtin_bit_cast(u32x4, w2); u32x4 r4;
            r4.x = pk2(bflo(a4.x) + bflo(b4.x), bfhi(a4.x) + bfhi(b4.x)); r4.y = pk2(bflo(a4.y) + bflo(b4.y), bfhi(a4.y) + bfhi(b4.y));
            r4.z = pk2(bflo(a4.z) + bflo(b4.z), bfhi(a4.z) + bfhi(b4.z)); r4.w = pk2(bflo(a4.w) + bflo(b4.w), bfhi(a4.w) + bfhi(b4.w)); v = __builtin_bit_cast(bf16x8, r4); }
        if (d0 < QR) qf[d0] = v; else *(LAS bf16x8*)(qlds + (d0 - QR) * 1024) = v;
    }
#pragma unroll
    for (int db = 0; db < DV / 32; ++db)
#pragma unroll
        for (int r = 0; r < 16; ++r) o[db][r] = 0.f;
    float m = -INFINITY, l = 0.f;
    Stage<DK, DV, KROPE> st;
    st.load(tid, Kg, ldk, K2g, Vg, ldv, 0);
    st.store(tid, lds, lds + 2 * KBUF);
    __syncthreads();
    for (int t = 0; t < NT; ++t) {
        const int cur = t & 1, kv0 = 64 * t;
        if (t + 1 < NT) st.load(tid, Kg, ldk, K2g, Vg, ldv, kv0 + 64);
        if (t < ntw) {
            const LAS unsigned char* kb = lds + cur * KBUF; const LAS unsigned char* vb = lds + 2 * KBUF + cur * VBUF;
            f32x16 p0, p1;
            if (ALIBI) { const float base = slope2 * (float)(kv0 + 4 * hi - qrow);
#pragma unroll
                for (int r = 0; r < 16; ++r) { p0[r] = __builtin_fmaf(slope2, (float)((r & 3) + 8 * (r >> 2)), base); p1[r] = __builtin_fmaf(slope2, (float)(32 + (r & 3) + 8 * (r >> 2)), base); } }
            else {
#pragma unroll
                for (int r = 0; r < 16; ++r) { p0[r] = 0.f; p1[r] = 0.f; } }
            if constexpr (QMEM) qkt_qmem<DK>(p0, p1, kb, qf, qlds, r32, hi); else qkt<DK>(p0, p1, kb, qf, r32, hi);
            if (CAUSAL && kv0 + 63 > qrow - r32) {
#pragma unroll
                for (int r = 0; r < 16; ++r) { const int kv = kv0 + crow(r, hi); if (kv > qrow) p0[r] = -INFINITY; if (kv + 32 > qrow) p1[r] = -INFINITY; } }
            float mx = p0[0];
#pragma unroll
            for (int r = 1; r < 16; ++r) mx = fmaxf(mx, p0[r]);
#pragma unroll
            for (int r = 0; r < 16; ++r) mx = fmaxf(mx, p1[r]);
            mx = fmaxf(mx, xhalf(mx));
            const float mn = fmaxf(m, mx), alpha = __builtin_amdgcn_exp2f(m - mn); m = mn;
            l *= alpha;
            if (__any(alpha != 1.0f)) {
#pragma unroll
                for (int db = 0; db < DV / 32; ++db)
#pragma unroll
                    for (int r = 0; r < 16; ++r) o[db][r] *= alpha; }
            float s = 0.f;
#pragma unroll
            for (int r = 0; r < 16; ++r) { p0[r] = __builtin_amdgcn_exp2f(p0[r] - mn); p1[r] = __builtin_amdgcn_exp2f(p1[r] - mn); s += p0[r] + p1[r]; }
            l += s;
            bf16x8 pf[4]; pack_p(pf, p0, p1);
            pv<DV>(o, vb, pf, r32, hi);
        }
        if (t + 1 < NT) st.store(tid, lds + (cur ^ 1) * KBUF, lds + 2 * KBUF + (cur ^ 1) * VBUF);
        __syncthreads();
    }
    lsum = l + xhalf(l);
}


template <int DV> __device__ __forceinline__ void store_o(GAS bf16* Orow, const f32x16 (&o)[DV / 32], float sc, int hi) {
#pragma unroll
    for (int db = 0; db < DV / 32; ++db)
#pragma unroll
        for (int c = 0; c < 4; ++c) { u32x2 w; w.x = pk2(o[db][4 * c] * sc, o[db][4 * c + 1] * sc); w.y = pk2(o[db][4 * c + 2] * sc, o[db][4 * c + 3] * sc);
            *(GAS u32x2*)(Orow + 32 * db + 8 * c + 4 * hi) = w; }
}

__device__ __forceinline__ void mla_unit(LAS unsigned char* lds, int tid, int b, int h, int q0, const GAS bf16* qmla, const GAS bf16* knope, const GAS bf16* krope, const GAS bf16* vT, GAS bf16* out, int abl) {
    const int lane = tid & 63, wid = tid >> 6, r32 = lane & 31, hi = lane >> 5;
    const size_t tb = (size_t)b * 8192; const int qrow = q0 + 32 * wid + r32;
    const GAS bf16* Qr = qmla + (tb + qrow) * 768;
    f32x16 o[2]; float l;
    flash_pass<96, 64, true, false, true>(lds, tid, Qr + h * 64, Qr + 512 + h * 32, knope + tb * 512 + h * 64, 512, krope + tb * 32, vT + (size_t)(h * 64) * 16384 + tb, 16384,
                                          q0 / 64 + 4, (q0 + 32 * wid + 31) / 64 + 1, qrow, 0.f, o, l, nullptr, abl);
    if (abl == 0 || l == 12345.678f) store_o<64>(out + (tb + qrow) * 1024 + h * 64, o, 1.0f / l, hi);
}
__device__ __forceinline__ void cross_unit(LAS unsigned char* lds, int tid, int b, int h, int q0, const GAS bf16* qx, const GAS bf16* xk, const GAS bf16* xvT, GAS bf16* out) {
    const int lane = tid & 63, wid = tid >> 6, r32 = lane & 31, hi = lane >> 5;
    const size_t tb = (size_t)b * 8192; const int qrow = q0 + 32 * wid + r32;
    f32x16 o[4]; float l;
    int nt = 4; asm volatile("" : "+s"(nt));
    flash_pass_simple<128, 128, false, false, false, true>(lds, tid, qx + (tb + qrow) * 512 + h * 128, qx + (size_t)16384 * 512 + (tb + qrow) * 512 + h * 128, xk + (size_t)(b * 256) * 512 + h * 128, 512, nullptr, xvT + (size_t)(h * 128) * 512 + b * 256, 512,
                                              nt, nt, qrow, 0.f, o, l);
    store_o<128>(out + (tb + qrow) * 512 + h * 128, o, 1.0f / l, hi);
}
__device__ __forceinline__ void diff_unit(LAS unsigned char* lds, int tid, int b, int h, int hf, int q0, const GAS bf16* dq, const GAS bf16* dk, const GAS bf16* vT, GAS bf16* out, int ldo, const GAS unsigned* knl, int abl) {
    const int lane = tid & 63, wid = tid >> 6, r32 = lane & 31, hi = lane >> 5;
    const size_t tb = (size_t)b * 8192; const int qrow = q0 + 32 * wid + r32;
    const float slope2 = __builtin_amdgcn_exp2f(-2.0f * (float)(h + 1)) * 1.4426950408889634f;
    const int NT = q0 / 64 + 4, ntw = (q0 + 32 * wid + 31) / 64 + 1;
    f32x16 o[4]; float l;
    flash_pass<64, 128, true, true, false, true, true>(lds, tid, dq + (tb + qrow) * 512 + h * 128 + hf * 64, nullptr, dk + tb * 512 + h * 128 + hf * 64, 512, nullptr, vT + (size_t)(512 + h * 128) * 16384 + tb, 16384,
                                                      NT, ntw, qrow, slope2, o, l, knl + ((size_t)(b * 128) * 8 + 2 * h + hf) * 2, abl);
    if (abl == 0 || l == 12345.678f) store_o<128>(out + (tb + qrow) * (size_t)ldo + h * 128, o, 1.0f / l, hi);
}
__device__ __forceinline__ void diff_lambda(const GAS float* lp, int layer, float& lam, float& post) {
    float q1 = 0.f, q2 = 0.f;
    for (int i = 0; i < 64; ++i) { q1 += lp[i] * lp[64 + i]; q2 += lp[128 + i] * lp[192 + i]; }
    const float lam_init = (layer == 0) ? 0.2f : 0.35550906759f;
    lam = expf(q1) - expf(q2) + lam_init; post = 1.f - lam_init;
}
__device__ __forceinline__ void diff_combine4(int item0, int stride, int lane, GAS bf16* o0, const GAS bf16* o1, float lam, float post, const GAS float* subln) {
    unsigned a[4], c[4]; size_t off[4];
#pragma unroll
    for (int k = 0; k < 4; ++k) { const int item = item0 + k * stride; off[k] = (size_t)(item >> 2) * 1024 + (item & 3) * 128 + 2 * lane;
        a[k] = *(const GAS unsigned*)(o0 + off[k]); c[k] = *(const GAS unsigned*)(o1 + (size_t)item * 128 + 2 * lane); }
    const f32x2v g = *(const GAS f32x2v*)(subln + 2 * lane);
#pragma unroll
    for (int k = 0; k < 4; ++k) {
        const float x = bflo(a[k]) - lam * bflo(c[k]), y = bfhi(a[k]) - lam * bfhi(c[k]);
        float s2 = x * x + y * y;
#pragma unroll
        for (int dd = 1; dd < 64; dd <<= 1) s2 += __shfl_xor(s2, dd);
        const float rs = __builtin_amdgcn_rsqf(s2 * (1.f / 128.f) + 1e-6f) * post;
        *(GAS unsigned*)(o0 + off[k]) = pk2(x * rs * g[0], y * rs * g[1]); }
}
__device__ __forceinline__ void sb_unit(LAS unsigned char* lds, int tid, int b, int h, int q0, const GAS bf16* sq, const GAS bf16* sk, const GAS bf16* vT, GAS bf16* out) {
    constexpr int KBUF = KLay<64>::KBUF, VBUF = 64 * VPB;
    const int lane = tid & 63, wid = tid >> 6, r32 = lane & 31, hi = lane >> 5;
    const size_t tb = (size_t)b * 8192; const int qrow = q0 + 32 * wid + r32;
    const GAS bf16* Kg = sk + tb * 512 + h * 64; const GAS bf16* Vg = vT + (size_t)(h * 64) * 16384 + tb;
    const int NT = q0 / 64 + 4, ntw = (q0 + 32 * wid + 30) / 64 + 1;
    bf16x8 qf[4];
#pragma unroll
    for (int d0 = 0; d0 < 4; ++d0) qf[d0] = *(const GAS bf16x8*)(sq + (tb + qrow) * 512 + h * 64 + 16 * d0 + 8 * hi);
    f32x16 o[2];
#pragma unroll
    for (int r = 0; r < 16; ++r) { o[0][r] = 0.f; o[1][r] = 0.f; }
    float R = 1.0f;
    volatile LAS unsigned* dflag = (volatile LAS unsigned*)(lds + 4 * KBUF + 1024);
    Stage<64, 64, false> st;
    st.load(tid, Kg, 512, nullptr, Vg, 16384, 64 * (NT - 1));
    st.store(tid, lds, lds + 2 * KBUF);
    __syncthreads();
    for (int i = 0; i < NT; ++i) {
        const int t = NT - 1 - i, cur = i & 1, kv0 = 64 * t;
        if (t > 0) st.load(tid, Kg, 512, nullptr, Vg, 16384, kv0 - 64);
        if (t < ntw && __any(R != 0.f)) {
            const LAS unsigned char* kb = lds + cur * KBUF; const LAS unsigned char* vb = lds + 2 * KBUF + cur * VBUF;
            f32x16 k0, k1;
#pragma unroll
            for (int r = 0; r < 16; ++r) { k0[r] = 0.f; k1[r] = 0.f; }
            qkt<64>(k0, k1, kb, qf, r32, hi);
            f32x16 b0, b1;
#pragma unroll
            for (int r = 0; r < 16; ++r) {
                const float e0 = __builtin_amdgcn_exp2f(fminf(k0[r], 115.f)), e1 = __builtin_amdgcn_exp2f(fminf(k1[r], 115.f));
                const float r0 = __builtin_amdgcn_rcpf(1.f + e0), r1 = __builtin_amdgcn_rcpf(1.f + e1);
                k0[r] = r0; b0[r] = e0 * r0; k1[r] = r1; b1[r] = e1 * r1; }
            if (kv0 + 63 >= qrow - r32) {
                const int thr = qrow - kv0 - 4 * hi;
#pragma unroll
                for (int r = 0; r < 16; ++r) { const int c = (r & 3) + 8 * (r >> 2); if (c >= thr) { k0[r] = 1.f; b0[r] = 0.f; } if (c + 32 >= thr) { k1[r] = 1.f; b1[r] = 0.f; } } }
            float gp[8], go[8];
#pragma unroll
            for (int c = 0; c < 4; ++c) { gp[c] = (k0[4 * c] * k0[4 * c + 1]) * (k0[4 * c + 2] * k0[4 * c + 3]); gp[4 + c] = (k1[4 * c] * k1[4 * c + 1]) * (k1[4 * c + 2] * k1[4 * c + 3]); }
#pragma unroll
            for (int g = 0; g < 8; ++g) go[g] = xhalf(gp[g]);
            float sp = R;
#pragma unroll
            for (int g = 7; g >= 0; --g) {
                float s = sp * (hi ? 1.0f : go[g]);
                if (g >= 4) { const int c = g - 4;
                    b1[4 * c + 3] *= s; s *= k1[4 * c + 3]; b1[4 * c + 2] *= s; s *= k1[4 * c + 2]; b1[4 * c + 1] *= s; s *= k1[4 * c + 1]; b1[4 * c] *= s; }
                else { const int c = g;
                    b0[4 * c + 3] *= s; s *= k0[4 * c + 3]; b0[4 * c + 2] *= s; s *= k0[4 * c + 2]; b0[4 * c + 1] *= s; s *= k0[4 * c + 1]; b0[4 * c] *= s; }
                sp *= gp[g] * go[g];
            }
            R = sp;
            bf16x8 pf[4]; pack_p(pf, b0, b1);
            pv<64>(o, vb, pf, r32, hi);
        }
        if (t > 0) st.store(tid, lds + (cur ^ 1) * KBUF, lds + 2 * KBUF + (cur ^ 1) * VBUF);
        if (lane == 0) dflag[(i & 1) * 8 + wid] = (t < ntw && !__any(R != 0.f)) ? 1u : 0u;
        __syncthreads();
        { unsigned alld = 1u;
#pragma unroll
          for (int w = 0; w < 8; ++w) alld &= dflag[(i & 1) * 8 + w];
          if (alld) break; }
    }
    store_o<64>(out + (tb + qrow) * 1024 + h * 64, o, 1.0f, hi);
}
}
typedef unsigned short bf16;
typedef float f32x4 __attribute__((ext_vector_type(4)));
typedef unsigned u32x4 __attribute__((ext_vector_type(4)));
typedef unsigned u32x2 __attribute__((ext_vector_type(2)));
constexpr int NWAVES = 8, NTHREADS = 512;
constexpr int M = 16384, D = 1024, SEQ = 8192, DEPTH = 2, IN_COLS = 6688;
constexpr int SROWS = 40960;
constexpr size_t MiB = 1u << 20;
constexpr size_t WS_CTL = 0, CTL_ZERO_BYTES = 128 * 1024;
constexpr size_t WS_SSQ = 1 * MiB;
constexpr size_t WS_SSQCQ = 2 * MiB, WS_SSQCKV = WS_SSQCQ + 256 * 1024, WS_SSQMEM = WS_SSQCKV + 256 * 1024;
constexpr size_t WS_TOKE = 3 * MiB, WS_TOKW = WS_TOKE + 128 * 1024, WS_HIST = WS_TOKW + 128 * 1024, WS_SLOT = WS_HIST + 64 * 1024;
constexpr size_t WS_STOK = 4 * MiB, WS_SW = WS_STOK + 256 * 1024, WS_SRSTD = WS_SW + 256 * 1024;
constexpr size_t WS_WR = 5 * MiB;
constexpr size_t WS_WRH = 5 * MiB + 256 * 1024, WS_WRL = WS_WRH + 128 * 1024;
constexpr size_t WS_MEMN = 6 * MiB, WS_XK = 7 * MiB, WS_XVT = WS_XK + 512 * 1024;
constexpr size_t WS_WIN = 8 * MiB;
constexpr size_t WS_WV = WS_WIN + (size_t)2816 * 1024 * 2;
constexpr size_t WS_WG = WS_WV + 2 * MiB;
constexpr size_t WS_WUQ = WS_WG + 6 * MiB;
constexpr size_t WS_WUKN = WS_WUQ + 768 * 256 * 2;
constexpr size_t WS_WUV = WS_WUKN + 512 * 256 * 2;
constexpr size_t WS_WB = WS_WUV + 512 * 256 * 2;
constexpr size_t WS_WOUT = WS_WB + 4 * MiB;
constexpr size_t WS_WXQ = WS_WOUT + 2 * MiB;
constexpr size_t WS_WXK = WS_WXQ + 1 * MiB, WS_WXV = WS_WXK + 1 * MiB;
constexpr size_t WS_WXO = WS_WXV + 1 * MiB;
constexpr size_t WS_WGU = WS_WXO + 1 * MiB;
constexpr size_t WS_WD = WS_WGU + 32 * MiB;
constexpr size_t WS_WEND = WS_WD + 16 * MiB;
static_assert(WS_WEND <= 81 * MiB, "weights");
constexpr size_t WS_XB = 81 * MiB;
constexpr size_t R0 = 113 * MiB;
constexpr size_t WS_CQ = R0, WS_CKV = R0 + 8 * MiB, WS_KROPE = R0 + 16 * MiB, WS_QK = R0 + 18 * MiB  , WS_VT = R0 + 82 * MiB  ;
constexpr size_t WS_QMLA = R0 + 114 * MiB, WS_KNOPE = R0 + 138 * MiB, WS_VMLAT = R0 + 154 * MiB, WS_OABC = R0 + 170 * MiB  ;
constexpr size_t WS_GSCR = R0, WS_MB = R0 + 96 * MiB;
constexpr size_t WS_QX = R0, WS_OX = R0 + 32 * MiB;
constexpr size_t WS_XG = R0, WS_ACT = R0 + 80 * MiB, WS_Y = R0 + 100 * MiB;
constexpr size_t WS_END = R0 + 234 * MiB;
static_assert(WS_MB + 32 * MiB <= WS_OABC && WS_Y + 80 * MiB <= WS_END && WS_OABC + 64 * MiB <= WS_END, "region map");
constexpr int CW_BAR = 1024, CW_Q = 8192, CW_KN = 16384;
constexpr int RING_BYTES = 131072, LDSCTL_OFF = RING_BYTES, MISC_OFF = LDSCTL_OFF + 320, TSTART_OFF = LDSCTL_OFF + 1024, HIST_OFF = LDSCTL_OFF + 2048;
constexpr int LDS_BYTES = 147456;

#define LDS_WAIT() asm volatile("s_waitcnt lgkmcnt(0)" ::: "memory")
__device__ __forceinline__ float wave_sum(float v) {
#pragma unroll
    for (int o = 1; o < 64; o <<= 1) v += __shfl_xor(v, o);
    return v;
}
__device__ __forceinline__ unsigned pk2(float lo, float hi) { return pg8::pk2(lo, hi); }
__device__ __forceinline__ int lane_id() { int r; asm volatile("v_mbcnt_lo_u32_b32 %0, -1, 0\n\tv_mbcnt_hi_u32_b32 %0, -1, %0" : "=v"(r)); return r; }
#define XB_TMO      128
#define XB_XCNT(j)  (256  + 64 * (j))
#define XB_XSUB(j)  (1280 + 64 * (j))
#define XB_XGEN(j)  (2304 + 64 * (j))
#define XB_TOP      3328
#define XB_TOPGEN   3392
#define XCD_BAR_WORDS 3456
#define XB_SPIN_CAP (1u << 18)

__device__ __forceinline__ unsigned xb_ld(unsigned* p)              { return __hip_atomic_load(p, __ATOMIC_RELAXED, __HIP_MEMORY_SCOPE_AGENT); }
__device__ __forceinline__ unsigned xb_add(unsigned* p, unsigned v) { return __hip_atomic_fetch_add(p, v, __ATOMIC_RELAXED, __HIP_MEMORY_SCOPE_AGENT); }
__device__ __forceinline__ unsigned xb_xcc_id() { return (unsigned)__builtin_amdgcn_s_getreg((3 << 11) | 20) & 0xFu; }
#define XB_SPIN(cond, bar) do { unsigned _sp = 0; while (cond) { __builtin_amdgcn_s_sleep(1); \
    if ((++_sp & 255u) == 0u) { if (xb_ld(&(bar)[XB_TMO])) break; if (_sp > XB_SPIN_CAP) { atomicAdd(&(bar)[XB_TMO], 1u); break; } } } } while (0)

struct XcdBarrier {
    unsigned* bar; unsigned x; int wid;
    volatile LAS unsigned* st;
};

__device__ __forceinline__ XcdBarrier xcd_barrier_post(unsigned* bar, volatile LAS unsigned* st, int wid) {
    XcdBarrier b; b.bar = bar; b.x = xb_xcc_id(); b.st = st; b.wid = wid;
    if (wid == 0 && lane_id() == 0) (void)xb_add(&bar[XB_XCNT(b.x)], 1u);
    return b;
}
__device__ __forceinline__ void xcd_barrier_complete(unsigned* bar, unsigned x, unsigned& nloc, unsigned& nx) {
    const unsigned G = gridDim.x * gridDim.y * gridDim.z;
    unsigned sum, cnt, mine, sp = 0u;
    for (;;) {
        sum = 0u; cnt = 0u; mine = 0u;
#pragma unroll 1
        for (unsigned j = 0; j < 16; ++j) { const unsigned c = xb_ld(&bar[XB_XCNT(j)]); sum += c; cnt += (c > 0u) ? 1u : 0u; mine = (j == x) ? c : mine; }
        if (sum == G) break;
        __builtin_amdgcn_s_sleep(1);
        if ((++sp & 255u) == 0u) { if (xb_ld(&bar[XB_TMO])) break; if (sp > XB_SPIN_CAP) { atomicAdd(&bar[XB_TMO], 1u); break; } }
    }
    nloc = mine > 0u ? mine : 1u; nx = cnt > 0u ? cnt : 1u;
}

__device__ __forceinline__ void xcd_barrier(const XcdBarrier& b) {
    asm volatile("s_waitcnt vmcnt(0)" ::: "memory");
    __syncthreads();
    if (b.wid == 0 && lane_id() == 0) {
        unsigned* bar = b.bar; asm volatile("" : "+s"(bar));
        __builtin_amdgcn_s_waitcnt(0);
        unsigned nloc = b.st[0], nx = b.st[1];
        if (nloc == 0u) { xcd_barrier_complete(bar, b.x, nloc, nx); b.st[0] = nloc; b.st[1] = nx; }
        const unsigned old = xb_add(&bar[XB_XSUB(b.x)], 1u);
        const unsigned gen = old / nloc;
        if (old + 1u == (gen + 1u) * nloc) {
            __builtin_amdgcn_fence(__ATOMIC_RELEASE, "agent");
            asm volatile("s_waitcnt vmcnt(0)" ::: "memory");
            const unsigned og = xb_add(&bar[XB_TOP], 1u);
            const unsigned tg = og / nx;
            if (og + 1u == (tg + 1u) * nx) xb_add(&bar[XB_TOPGEN], 1u);
            else XB_SPIN(xb_ld(&bar[XB_TOPGEN]) == tg, bar);
            __builtin_amdgcn_fence(__ATOMIC_ACQUIRE, "agent");
            xb_add(&bar[XB_XGEN(b.x)], 1u);
            asm volatile("s_waitcnt vmcnt(0)" ::: "memory");
        } else {
            XB_SPIN(xb_ld(&bar[XB_XGEN(b.x)]) == gen, bar);
            __builtin_amdgcn_fence(__ATOMIC_ACQUIRE, "agent");
            asm volatile("s_waitcnt vmcnt(0)" ::: "memory");
        }
    }
    __syncthreads();
}
struct TrJob { const GAS float* src; const GAS float* gain; GAS bf16* dst; int ldn, col0, k0, K, row0, dk; };
__device__ __forceinline__ void tr_load(const TrJob& j, f32x4 (&v)[8], int lane) {
    const int kr = lane >> 3, nq = lane & 7;
    if (j.col0 >= 0) {
#pragma unroll
        for (int i = 0; i < 8; ++i) v[i] = *(const GAS f32x4*)(j.src + (size_t)(j.k0 + 8 * i + kr) * j.ldn + j.col0 + 4 * nq);
    } else {
#pragma unroll
        for (int i = 0; i < 8; ++i) v[i] = (f32x4){0.f, 0.f, 0.f, 0.f};
    }
}
__device__ __forceinline__ void tr_finish(const TrJob& j, const f32x4 (&v)[8], LAS float* scr, int lane) {
    const int kr = lane >> 3, nq = lane & 7;
#pragma unroll
    for (int i = 0; i < 8; ++i) { const int kk = 8 * i + kr; const float g = j.gain ? j.gain[j.k0 + kk] : 1.f; LAS float* s = scr + kk * 33 + 4 * nq;
        s[0] = v[i][0] * g; s[1] = v[i][1] * g; s[2] = v[i][2] * g; s[3] = v[i][3] * g; }
    LDS_WAIT(); asm volatile("" ::: "memory");
    const int c = lane & 7;
#pragma unroll
    for (int q = 0; q < 4; ++q) { const int n = (lane >> 3) + 8 * q; const LAS float* s = scr + (8 * c) * 33 + n;
        u32x4 o; o.x = pk2(s[0 * 33], s[1 * 33]); o.y = pk2(s[2 * 33], s[3 * 33]); o.z = pk2(s[4 * 33], s[5 * 33]); o.w = pk2(s[6 * 33], s[7 * 33]);
        *(GAS u32x4*)(j.dst + (size_t)(j.row0 + n) * j.K + j.dk + j.k0 + 8 * c) = o; }
    LDS_WAIT(); asm volatile("" ::: "memory");
}
__device__ __forceinline__ void row_to_bf16(const GAS float* xrow, GAS bf16* orow, GAS float* ssq16, int lane) {
    const GAS f32x4* xr = (const GAS f32x4*)xrow + lane; f32x4 v[4]; float s = 0.f;
#pragma unroll
    for (int j = 0; j < 4; ++j) { v[j] = xr[64 * j]; s += (v[j][0] * v[j][0] + v[j][1] * v[j][1]) + (v[j][2] * v[j][2] + v[j][3] * v[j][3]); }
    s = wave_sum(s);
    GAS u32x2* o8 = (GAS u32x2*)orow + lane;
#pragma unroll
    for (int j = 0; j < 4; ++j) { u32x2 w; w.x = pk2(v[j][0], v[j][1]); w.y = pk2(v[j][2], v[j][3]); o8[64 * j] = w; }
    if (lane < 16) ssq16[lane] = (lane == 0) ? s : 0.f;
}

struct Args { const float* in[26]; float* out; unsigned char* ws; };
__device__ __forceinline__ int opq(int i) { asm volatile("" : "+s"(i)); return i; }
__device__ __forceinline__ GAS unsigned char* opqp(unsigned char* p0) { GAS unsigned char* p = (GAS unsigned char*)p0; asm volatile("" : "+s"(p)); return p; }
#define INP(i) ((const GAS float*)args.in[opq(i)])
#define WSB(off) (opqp(args.ws) + (off))
#define X_IN INP(0)
#define XP ((GAS float*)args.out)
#define XB ((GAS bf16*)WSB(WS_XB))
#define SSQ ((GAS float*)WSB(WS_SSQ))
#define SSQCQ ((GAS float*)WSB(WS_SSQCQ))
#define SSQCKV ((GAS float*)WSB(WS_SSQCKV))
#define SSQMEM ((GAS float*)WSB(WS_SSQMEM))
#define MEMN ((GAS bf16*)WSB(WS_MEMN))
#define XK ((GAS bf16*)WSB(WS_XK))
#define XVT ((GAS bf16*)WSB(WS_XVT))
#define WIN ((GAS bf16*)WSB(WS_WIN))
#define WV ((GAS bf16*)WSB(WS_WV))
#define WG ((GAS bf16*)WSB(WS_WG))
#define WUQ ((GAS bf16*)WSB(WS_WUQ))
#define WUKN ((GAS bf16*)WSB(WS_WUKN))
#define WUV ((GAS bf16*)WSB(WS_WUV))
#define WB ((GAS bf16*)WSB(WS_WB))
#define WOUT ((GAS bf16*)WSB(WS_WOUT))
#define WXQ ((GAS bf16*)WSB(WS_WXQ))
#define WXK ((GAS bf16*)WSB(WS_WXK))
#define WXV ((GAS bf16*)WSB(WS_WXV))
#define WXO ((GAS bf16*)WSB(WS_WXO))
#define WGU ((GAS bf16*)WSB(WS_WGU))
#define WD ((GAS bf16*)WSB(WS_WD))
#define WRH ((GAS bf16*)WSB(WS_WRH))
#define WRL ((GAS bf16*)WSB(WS_WRL))
#define CQ ((GAS bf16*)WSB(WS_CQ))
#define CKV ((GAS bf16*)WSB(WS_CKV))
#define KROPE ((GAS bf16*)WSB(WS_KROPE))
#define QK ((GAS bf16*)WSB(WS_QK))
#define VT ((GAS bf16*)WSB(WS_VT))
#define QMLA ((GAS bf16*)WSB(WS_QMLA))
#define KNOPE ((GAS bf16*)WSB(WS_KNOPE))
#define VMLAT ((GAS bf16*)WSB(WS_VMLAT))
#define OABC ((GAS bf16*)WSB(WS_OABC))
#define GSCR ((GAS bf16*)WSB(WS_GSCR))
#define MB ((GAS bf16*)WSB(WS_MB))
#define QX ((GAS bf16*)WSB(WS_QX))
#define OX ((GAS bf16*)WSB(WS_OX))
#define XG ((GAS bf16*)WSB(WS_XG))
#define ACT ((GAS bf16*)WSB(WS_ACT))
#define YB ((GAS bf16*)WSB(WS_Y))
#define TOKE ((GAS int*)WSB(WS_TOKE))
#define TOKW ((GAS float*)WSB(WS_TOKW))
#define HIST ((GAS int*)WSB(WS_HIST))
#define SLOT ((GAS int*)WSB(WS_SLOT))
#define STOK ((GAS int*)WSB(WS_STOK))
#define SW ((GAS float*)WSB(WS_SW))
#define SRSTD ((GAS float*)WSB(WS_SRSTD))


__global__ void __launch_bounds__(NTHREADS, 2) fwd(Args args) {
    extern __shared__ __attribute__((aligned(16))) unsigned char lds_raw[];
    LAS unsigned char* lds = (LAS unsigned char*)lds_raw;
    volatile LAS unsigned* MISC = (volatile LAS unsigned*)(lds + MISC_OFF);
    LAS int* TSTART = (LAS int*)(lds + TSTART_OFF);
    const int tid0 = threadIdx.x; const int wv = __builtin_amdgcn_readfirstlane(tid0 >> 6);
#define PH_BEGIN int tid_ = wv * 64 + lane_id(); asm volatile("" : "+v"(tid_)); const int tid = tid_, lane = tid & 63, wave = wv, gw = vcu * NWAVES + wave; (void)lane; (void)gw
    const int G = gridDim.x, bx = blockIdx.x, vcu = (G % 8 == 0) ? (bx % 8) * (G / 8) + bx / 8 : bx;
    unsigned* ctl = (unsigned*)(void*)(args.ws + WS_CTL);
    for (int u = tid0; u < (LDS_BYTES - LDSCTL_OFF) / 4; u += NTHREADS) ((LAS unsigned*)(lds + LDSCTL_OFF))[u] = 0u;
    __syncthreads();
    XcdBarrier bar = xcd_barrier_post(ctl + CW_BAR, MISC + 8, wv);
    const int NGW = G * NWAVES;

    constexpr float L2E = 1.4426950408889634f;

    constexpr int I_IN = 88 * 16, I_V = 32 * 16, I_G = 96 * 16, I_UQ = 24 * 4, I_UK = 16 * 4, I_B = 3 * 32 * 8, I_O = 32 * 16, I_XQ = 16 * 16, I_XO = 32 * 8, I_GU = 512 * 16, I_D = 1024 * 4;
    constexpr int NITEMS = I_IN + I_V + I_G + I_UQ + 2 * I_UK + I_B + I_O + 3 * I_XQ + I_XO + I_GU + I_D, NITEMS_P0 = NITEMS - I_GU - I_D;
    for (int l = 0; l < DEPTH; ++l) {
        for (int rp_ = 0; rp_ < RP_P0; ++rp_) {
#if PH_P0
        { PH_BEGIN;
            LAS float* scr = (LAS float*)(lds + wave * 16384);
#define w_in (INP(3) + (size_t)l * D * IN_COLS)
#define g_attn (INP(2) + l * D)
#define w_uq (INP(5) + (size_t)l * 256 * 768)
#define g_q (INP(4) + l * 256)
#define w_ukv (INP(7) + (size_t)l * 256 * 1024)
#define g_kv (INP(6) + l * 256)
#define w_br (INP(10) + (size_t)l * 3 * 512 * 1024)
#define w_out (INP(11) + (size_t)l * D * D)
#define g_cross (INP(12) + l * D)
#define g_mem (INP(13))
#define w_xq (INP(14) + (size_t)l * D * 512)
#define w_xkv (INP(15) + (size_t)l * D * 1024)
#define w_xo (INP(16) + (size_t)l * 512 * D)
#define g_ffn (INP(17) + l * D)
#define w_eg (INP(22) + (size_t)l * 32 * D * 256)
#define w_eu (INP(23) + (size_t)l * 32 * D * 256)
#define w_ed (INP(24) + (size_t)l * 32 * 256 * D)
#define TR_DECODE(itx) do { int r = (itx); \
                if (r < I_IN) { const int nb = r >> 4, kb = r & 15, n0 = nb * 32; int col; \
                    if (n0 < 544) col = 3072 + n0; else if (n0 < 768) col = -1; else if (n0 < 1792) col = 3616 + (n0 - 768); else col = 5152 + (n0 - 1792); \
                    jb = TrJob{w_in, g_attn, WIN, IN_COLS, col, kb * 64, 1024, n0, 0}; break; } r -= I_IN; \
                if (r < I_V) { const int nb = r >> 4, kb = r & 15, n0 = nb * 32; const int col = n0 < 512 ? 4640 + n0 : 6176 + (n0 - 512); \
                    jb = TrJob{w_in, g_attn, WV, IN_COLS, col, kb * 64, 1024, n0, 0}; break; } r -= I_V; \
                if (r < I_G) { const int nb = r >> 4, kb = r & 15; jb = TrJob{w_in, g_attn, WG, IN_COLS, nb * 32, kb * 64, 1024, nb * 32, 0}; break; } r -= I_G; \
                if (r < I_UQ) { const int nb = r >> 2, kb = r & 3, n0 = nb * 32; const int col = n0 < 512 ? 96 * (n0 >> 6) + (n0 & 63) : 96 * ((n0 - 512) >> 5) + 64; \
                    jb = TrJob{w_uq, g_q, WUQ, 768, col, kb * 64, 256, n0, 0}; break; } r -= I_UQ; \
                if (r < I_UK) { const int nb = r >> 2, kb = r & 3, n0 = nb * 32; jb = TrJob{w_ukv, g_kv, WUKN, 1024, 128 * (n0 >> 6) + (n0 & 63), kb * 64, 256, n0, 0}; break; } r -= I_UK; \
                if (r < I_UK) { const int nb = r >> 2, kb = r & 3, n0 = nb * 32; jb = TrJob{w_ukv, g_kv, WUV, 1024, 128 * (n0 >> 6) + 64 + (n0 & 63), kb * 64, 256, n0, 0}; break; } r -= I_UK; \
                if (r < I_B) { const int z = r / 256, q = r % 256, nb = q >> 3, kb = q & 7; jb = TrJob{w_br + (size_t)z * 512 * 1024, nullptr, WB + (size_t)(z >> 1) * 1024 * 1024, 1024, nb * 32, kb * 64, 1024, nb * 32, (z & 1) * 512}; break; } r -= I_B; \
                if (r < I_O) { const int nb = r >> 4, kb = r & 15; jb = TrJob{w_out, nullptr, WOUT, 1024, nb * 32, kb * 64, 1024, nb * 32, 0}; break; } r -= I_O; \
                if (r < I_XQ) { const int nb = r >> 4, kb = r & 15; jb = TrJob{w_xq, g_cross, WXQ, 512, nb * 32, kb * 64, 1024, nb * 32, 0}; break; } r -= I_XQ; \
                if (r < I_XQ) { const int nb = r >> 4, kb = r & 15; jb = TrJob{w_xkv, g_mem, WXK, 1024, nb * 32, kb * 64, 1024, nb * 32, 0}; break; } r -= I_XQ; \
                if (r < I_XQ) { const int nb = r >> 4, kb = r & 15; jb = TrJob{w_xkv, g_mem, WXV, 1024, 512 + nb * 32, kb * 64, 1024, nb * 32, 0}; break; } r -= I_XQ; \
                if (r < I_XO) { const int nb = r >> 3, kb = r & 7; jb = TrJob{w_xo, nullptr, WXO, 1024, nb * 32, kb * 64, 512, nb * 32, 0}; break; } r -= I_XO; \
                if (r < I_GU) { const int nb = r >> 4, kb = r & 15, n0 = nb * 32, e = n0 >> 9, rr = n0 & 511, t = rr >> 8, j = rr & 255; \
                    const GAS float* src = (j < 128 ? w_eg : w_eu) + (size_t)e * D * 256; jb = TrJob{src, g_ffn, WGU, 256, 128 * t + (j & 127), kb * 64, 1024, n0, 0}; break; } r -= I_GU; \
                { const int nb = r >> 2, kb = r & 3, n0 = nb * 32, e = n0 >> 10; jb = TrJob{w_ed + (size_t)e * 256 * 1024, nullptr, WD, 1024, n0 & 1023, kb * 64, 256, n0, 0}; } } while (0)
            for (int it = gw; it < NITEMS_P0; it += NGW) {
                TrJob jb{};
                TR_DECODE(it);
                f32x4 va[8];
                tr_load(jb, va, lane);
                tr_finish(jb, va, scr, lane);
            }
            { const GAS float* wrg = INP(18) + (size_t)l * D * 4; const GAS float* wre = INP(20) + (size_t)l * D * 32; GAS bf16* wh = WRH; GAS bf16* wl = WRL;
              for (int i = bx * NTHREADS + tid; i < 48 * 1024; i += G * NTHREADS) { const int c = i >> 10, k = i & 1023;
                  const float w = c < 36 ? (c < 4 ? wrg[k * 4 + c] : wre[k * 32 + (c - 4)]) * g_ffn[k] : 0.f; const unsigned h = pk2(w, 0.f) & 0xffffu;
                  wh[i] = (bf16)h; wl[i] = (bf16)(pk2(w - __builtin_bit_cast(float, h << 16), 0.f) & 0xffffu); } }
            if (l == 0) {
                for (int m = gw; m < M; m += NGW) row_to_bf16(X_IN + (size_t)m * D, XB + (size_t)m * D, SSQ + (size_t)m * 16, lane);
                for (int m = gw; m < 512; m += NGW) row_to_bf16(INP(1) + (size_t)m * D, MEMN + (size_t)m * D, SSQMEM + (size_t)m * 16, lane);
            }
        }
#endif
        xcd_barrier(bar);
        }
                for (int rp_ = 0; rp_ < RP_A; ++rp_) {
#if PH_A
        {
            { pg8::Gemm g{XB, WIN, M, 2816, D, D, nullptr}; pg8::StaticOrder S; S.init(M, 2816, G, bx);
              pg8::EpiA E{SSQ, CQ, CKV, KROPE, QK, SSQCQ, SSQCKV, 0.125f * L2E, (GAS unsigned*)(opqp(args.ws) + WS_CTL) + CW_KN + l * 4096};
              pg8::gemm_phase<pg8::EpiA, pg8::StaticOrder, true, true>(lds, g, S, E, wv); }
            { pg8::Gemm g{WV, XB, 1024, M, D, D, nullptr}; pg8::StaticOrder S; S.init(1024, M, G, (bx + 64) % G);
              pg8::EpiVT E{VT, M, SSQ, 4, 1.f / 1024.f};
              pg8::gemm_phase<pg8::EpiVT, pg8::StaticOrder, true, true>(lds, g, S, E, wv); }
            { pg8::Gemm g{MEMN, WXK, 512, 512, D, D, nullptr}; pg8::StaticOrder S; S.init(512, 512, G, (bx + 8) % G);
              pg8::EpiRS E{XK, 512, SSQMEM, 4, 1.f / 1024.f, 1.f, 0xffff, 31, 0};
              pg8::gemm_phase<pg8::EpiRS, pg8::StaticOrder, true, true>(lds, g, S, E, wv); }
            { pg8::Gemm g{WXV, MEMN, 512, 512, D, D, nullptr}; pg8::StaticOrder S; S.init(512, 512, G, (bx + 16) % G);
              pg8::EpiVT E{XVT, 512, SSQMEM, 4, 1.f / 1024.f};
              pg8::gemm_phase<pg8::EpiVT, pg8::StaticOrder, true, true>(lds, g, S, E, wv); }
        }
#endif
        xcd_barrier(bar);
        }
                for (int rp_ = 0; rp_ < RP_B; ++rp_) {
#if PH_B
        {
#if PH_B1
            { pg8::Gemm g{CQ, WUQ, M, 768, opq(256), opq(256), nullptr}; pg8::StaticOrder S; S.init(M, 768, G, bx);
              pg8::EpiQ E{QMLA, SSQCQ, 0.10206207261596577f * L2E};
              pg8::gemm_phase<pg8::EpiQ, pg8::StaticOrder, true, true>(lds, g, S, E, wv); }
#endif
#if PH_B2
            { pg8::Gemm g{CKV, WUKN, M, 512, opq(256), opq(256), nullptr}; pg8::StaticOrder S; S.init(M, 512, G, (bx + 64) % G);
              pg8::EpiRS E{KNOPE, 512, SSQCKV, 1, 1.f / 256.f, 1.f, 0xffff, 31, 0};
              pg8::gemm_phase<pg8::EpiRS, pg8::StaticOrder, true, true>(lds, g, S, E, wv); }
#endif
#if PH_B3
            { pg8::Gemm g{WUV, CKV, 512, M, opq(256), opq(256), nullptr}; pg8::StaticOrder S; S.init(512, M, G, (bx + 128) % G);
              pg8::EpiVT E{VMLAT, M, SSQCKV, 1, 1.f / 256.f};
              pg8::gemm_phase<pg8::EpiVT, pg8::StaticOrder, true, true>(lds, g, S, E, wv); }
#endif
        }
#endif
        xcd_barrier(bar);
        }
                for (int rp_ = 0; rp_ < RP_C; ++rp_) {
#if PH_C
        {
            unsigned* qhead = ctl + CW_Q + 64 * (l + 2 * rp_);
            for (;;) {
                if (wv == 0 && lane_id() == 0) MISC[0] = __hip_atomic_fetch_add(qhead, 1u, __ATOMIC_RELAXED, __HIP_MEMORY_SCOPE_AGENT);
                __syncthreads();
                const int idx = (int)MISC[0];
                __syncthreads();
                if (idx >= 32 * 48 + 256) break;
                if (idx >= 32 * 48) {
                    if (rp_ == 0) { const int wl = lane_id(); LAS float* scr = (LAS float*)(lds + wv * 16384);
                        for (int j = 0; j < 6; ++j) { const int it = NITEMS_P0 + (idx - 32 * 48) * 48 + j * 8 + wv; TrJob jb{}; TR_DECODE(it); f32x4 va[8]; tr_load(jb, va, wl); tr_finish(jb, va, scr, wl); } }
                    continue; }
                const int qb = 31 - idx / 48, r = idx % 48, q0 = qb * 256;
                int tu = wv * 64 + lane_id(); asm volatile("" : "+v"(tu));
#if PH_C_DIFF
                if (r < 16 && (rp_ == 0 || (C_REP_MASK & 1))) att::diff_unit(lds, tu, r >> 3, (r >> 1) & 3, r & 1, q0, QK + (size_t)2 * M * 512, QK + (size_t)3 * M * 512, VT, (r & 1) ? CQ : OABC + (size_t)M * 1024, (r & 1) ? 512 : 1024,
                                                                             (const GAS unsigned*)(opqp(args.ws) + WS_CTL) + CW_KN + l * 4096, rp_ ? C_ABL : 0);
#endif
#if PH_C_SB
                if (r >= 16 && r < 32 && (rp_ == 0 || (C_REP_MASK & 2))) att::sb_unit(lds, tu, (r - 16) >> 3, (r - 16) & 7, q0, QK, QK + (size_t)M * 512, VT, OABC + 512);
#endif
#if PH_C_MLA
                if (r >= 32 && (rp_ == 0 || (C_REP_MASK & 4))) att::mla_unit(lds, tu, (r - 32) >> 3, (r - 32) & 7, q0, QMLA, KNOPE, KROPE, VMLAT, OABC, rp_ ? C_ABL : 0);
#endif
            }
        }
#endif
        xcd_barrier(bar);
        }
        #undef TR_DECODE
#undef w_in
#undef g_attn
#undef w_uq
#undef g_q
#undef w_ukv
#undef g_kv
#undef w_br
#undef w_out
#undef g_cross
#undef g_mem
#undef w_xq
#undef w_xkv
#undef w_xo
#undef g_ffn
#undef w_eg
#undef w_eu
#undef w_ed
#if PH_C
        { PH_BEGIN;
          float lam, post; att::diff_lambda(INP(8) + l * 256, l, lam, post);
          for (int it = gw; it < M * 4; it += 4 * NGW) att::diff_combine4(it, NGW, lane, OABC + (size_t)M * 1024, CQ, lam, post, INP(9) + l * 128); }
        xcd_barrier(bar);
#endif
        for (int rp_ = 0; rp_ < RP_D1; ++rp_) {
#if PH_D1
        { pg8::Gemm g{XB, WG, M, 1024, 512, 1024, nullptr}; pg8::D1Order S; S.so.init(M, 1024, G, bx);
          const GAS char* xb_ = (const GAS char*)XB; const GAS char* oab_ = (const GAS char*)OABC; const GAS char* wg_ = (const GAS char*)WG; const GAS char* wb_ = (const GAS char*)WB;
          S.dA = (size_t)(oab_ - xb_); S.dB = (size_t)(wb_ - wg_);
          pg8::EpiD1 E{GSCR, MB, SSQ};
          pg8::gemm_phase<pg8::EpiD1, pg8::D1Order, true, true>(lds, g, S, E, wv); }
#endif
        xcd_barrier(bar);
        }
        #if PH_D2
        { pg8::Gemm g{MB, WOUT, M, 1024, D, D, nullptr}; pg8::StaticOrder S; S.init(M, 1024, G, bx);
          pg8::EpiRes E{l == 0 ? X_IN : (const GAS float*)XP, XP, XB, SSQ};
          pg8::gemm_phase<pg8::EpiRes, pg8::StaticOrder, true, true>(lds, g, S, E, wv); }
#endif
        xcd_barrier(bar);
                for (int rp_ = 0; rp_ < RP_E1; ++rp_) {
#if PH_E1
        { pg8::Gemm g{XB, WXQ, M, 512, 512, 1024, nullptr}; pg8::SplitK2Order S; S.so.init(M, 1024, G, bx); S.tstep = (size_t)256 * 1024 * 2;
          pg8::EpiRS E{QX, 512, SSQ, 4, 1.f / 1024.f, 0.08838834764831845f * L2E, 1, 1, (size_t)M * 512};
          pg8::gemm_phase<pg8::EpiRS, pg8::SplitK2Order, true, true>(lds, g, S, E, wv); }
#endif
        xcd_barrier(bar);
        }
                for (int rp_ = 0; rp_ < RP_E2; ++rp_) {
#if PH_E2
        { PH_BEGIN; for (int u = vcu; u < 256; u += G) att::cross_unit(lds, tid, u >> 7, (u >> 5) & 3, (u & 31) * 256, QX, XK, XVT, OX); }
#endif
        xcd_barrier(bar);
        }
        #if PH_E3
        { pg8::Gemm g{OX, WXO, M, 1024, 512, 512, nullptr}; pg8::StaticOrder S; S.init(M, 1024, G, bx);
          pg8::EpiRes E{XP, XP, XB, SSQ};
          pg8::gemm_phase<pg8::EpiRes, pg8::StaticOrder, true, true>(lds, g, S, E, wv); }
#endif
        xcd_barrier(bar);
                for (int rp_ = 0; rp_ < RP_F0A; ++rp_) {
#if PH_F0A
        { PH_BEGIN;
            typedef short bf16x8 __attribute__((ext_vector_type(8)));
            const GAS float* brg = INP(19) + l * 4; const GAS float* bre = INP(21) + l * 32;
            LAS float* part = (LAS float*)lds;
            const int rb = wave & 3, kh = wave >> 2, r16 = lane & 15, kq = lane >> 4;
            for (int grp = bx; grp < 256; grp += G) {
                const GAS float* xrow = XP + (size_t)(grp * 64 + 16 * rb + r16) * D + 512 * kh + 8 * kq;
                const GAS bf16* wh = WRH + (size_t)r16 * 1024 + 512 * kh + 8 * kq; const GAS bf16* wl = WRL + (size_t)r16 * 1024 + 512 * kh + 8 * kq;
                f32x4 acc[3];
#pragma unroll
                for (int cb = 0; cb < 3; ++cb) acc[cb] = (f32x4){0.f, 0.f, 0.f, 0.f};
#pragma unroll 4
                for (int st = 0; st < 16; ++st) {
                    const f32x4 x0 = *(const GAS f32x4*)(xrow + 32 * st), x1 = *(const GAS f32x4*)(xrow + 32 * st + 4);
                    u32x4 hw, lw;
                    hw.x = pk2(x0[0], x0[1]); hw.y = pk2(x0[2], x0[3]); hw.z = pk2(x1[0], x1[1]); hw.w = pk2(x1[2], x1[3]);
                    lw.x = pk2(x0[0] - pg8::bflo(hw.x), x0[1] - pg8::bfhi(hw.x)); lw.y = pk2(x0[2] - pg8::bflo(hw.y), x0[3] - pg8::bfhi(hw.y));
                    lw.z = pk2(x1[0] - pg8::bflo(hw.z), x1[1] - pg8::bfhi(hw.z)); lw.w = pk2(x1[2] - pg8::bflo(hw.w), x1[3] - pg8::bfhi(hw.w));
                    const bf16x8 ah = __builtin_bit_cast(bf16x8, hw), al = __builtin_bit_cast(bf16x8, lw);
#pragma unroll
                    for (int cb = 0; cb < 3; ++cb) {
                        const bf16x8 bh = *(const GAS bf16x8*)(wh + (size_t)cb * 16 * 1024 + 32 * st), bl = *(const GAS bf16x8*)(wl + (size_t)cb * 16 * 1024 + 32 * st);
                        acc[cb] = __builtin_amdgcn_mfma_f32_16x16x32_bf16(ah, bh, acc[cb], 0, 0, 0);
                        acc[cb] = __builtin_amdgcn_mfma_f32_16x16x32_bf16(al, bh, acc[cb], 0, 0, 0);
                        acc[cb] = __builtin_amdgcn_mfma_f32_16x16x32_bf16(ah, bl, acc[cb], 0, 0, 0);
                    }
                }
                __syncthreads();
#pragma unroll
                for (int cb = 0; cb < 3; ++cb)
#pragma unroll
                    for (int r = 0; r < 4; ++r) part[(kh * 64 + 16 * rb + 4 * kq + r) * 49 + 16 * cb + r16] = acc[cb][r];
                __syncthreads();
                if (wave == 0) {
                    const int tok = grp * 64 + lane; const float rs = pg8::rstd_parts(SSQ, (unsigned)(tok * 16), 4, 1.f / 1024.f);
                    const LAS float* p0 = part + lane * 49; const LAS float* p1 = part + (64 + lane) * 49;
                    float gl[4];
#pragma unroll
                    for (int c = 0; c < 4; ++c) gl[c] = (p0[c] + p1[c]) * rs + brg[c];
                    int gs = 0; float gm = gl[0];
#pragma unroll
                    for (int c = 1; c < 4; ++c) if (gl[c] > gm) { gm = gl[c]; gs = c; }
                    float den = 0.f;
#pragma unroll
                    for (int c = 0; c < 4; ++c) den += expf(gl[c] - gm);
                    const float pg = 1.0f / den;
                    float el[8];
#pragma unroll
                    for (int j = 0; j < 8; ++j) el[j] = (p0[4 + gs * 8 + j] + p1[4 + gs * 8 + j]) * rs + bre[gs * 8 + j];
                    int i0 = 0; float v0 = el[0];
#pragma unroll
                    for (int j = 1; j < 8; ++j) if (el[j] > v0) { v0 = el[j]; i0 = j; }
                    int i1 = -1; float v1 = -INFINITY;
#pragma unroll
                    for (int j = 0; j < 8; ++j) if (j != i0 && el[j] > v1) { v1 = el[j]; i1 = j; }
                    const float e1 = expf(v1 - v0), w0 = pg / (1.f + e1), w1 = pg * e1 / (1.f + e1);
                    const int ea = gs * 8 + i0, eb = gs * 8 + i1;
                    TOKE[tok * 2] = ea; TOKE[tok * 2 + 1] = eb; TOKW[tok * 2] = w0; TOKW[tok * 2 + 1] = w1;
                    int mycnt = 0;
#pragma unroll 1
                    for (int e = 0; e < 32; ++e) { const int c = __popcll(__ballot(ea == e)) + __popcll(__ballot(eb == e)); if (lane == e) mycnt = c; }
                    if (lane < 32) HIST[grp * 32 + lane] = mycnt;
                }
            }
            __syncthreads();
        }
#endif
        xcd_barrier(bar);
        }
                for (int rp_ = 0; rp_ < RP_F0B; ++rp_) {
#if PH_F0B
        { PH_BEGIN;
            LAS int* cnt = (LAS int*)(lds + HIST_OFF);
            for (int grp = bx; grp < 256; grp += G) {
                __syncthreads();
                { const int e = tid & 31, ch = tid >> 5; int tot = 0, before = 0;
#pragma unroll
                  for (int j = 0; j < 16; ++j) { const int g2 = ch * 16 + j; const int hv = HIST[g2 * 32 + e]; tot += hv; before += (g2 < grp) ? hv : 0; }
                  cnt[128 + ch * 32 + e] = tot; cnt[640 + ch * 32 + e] = before; }
                __syncthreads();
                if (tid < 32) { int tot = 0, before = 0;
                    for (int ch = 0; ch < 16; ++ch) { tot += cnt[128 + ch * 32 + tid]; before += cnt[640 + ch * 32 + tid]; }
                    cnt[tid] = tot; cnt[32 + tid] = before; }
                __syncthreads();
                if (tid == 0) { int ts = 0; for (int e = 0; e < 32; ++e) { TSTART[e] = ts; ts += (cnt[e] + 255) >> 8; } TSTART[32] = ts; }
                __syncthreads();
                if (wave == 0) {
                    const int tok = grp * 64 + lane; const int ea = TOKE[tok * 2], eb = TOKE[tok * 2 + 1];
                    int ra = 0, rb = 0; const unsigned long long lt = (1ull << lane) - 1ull;
#pragma unroll 1
                    for (int e = 0; e < 32; ++e) { const unsigned long long ma = __ballot(ea == e), mb = __ballot(eb == e); const int c = __popcll((ma | mb) & lt); if (ea == e) ra = c; if (eb == e) rb = c; }
                    const int sa = TSTART[ea] * 256 + cnt[32 + ea] + ra, sb = TSTART[eb] * 256 + cnt[32 + eb] + rb;
                    const float rsd = pg8::rstd_parts(SSQ, (unsigned)(tok * 16), 4, 1.f / 1024.f);
                    SLOT[tok * 2] = sa; SLOT[tok * 2 + 1] = sb;
                    STOK[sa] = tok; STOK[sb] = tok; SW[sa] = TOKW[tok * 2]; SW[sb] = TOKW[tok * 2 + 1]; SRSTD[sa] = rsd; SRSTD[sb] = rsd;
                    MISC[16 + lane] = (unsigned)sa; MISC[80 + lane] = (unsigned)sb;
                }
                __syncthreads();
                if (grp < 32) { const int beg = TSTART[grp] * 256 + cnt[grp], end = TSTART[grp + 1] * 256;
                    for (int s = beg + tid; s < end; s += NTHREADS) { STOK[s] = 0; SW[s] = 0.f; SRSTD[s] = 0.f; } }
            }
            if (G > 256 || bx >= 256) {
                __syncthreads();
                if (tid < 32) { int tot = 0; for (int g2 = 0; g2 < 256; ++g2) tot += HIST[g2 * 32 + tid]; cnt[tid] = tot; }
                __syncthreads();
                if (tid == 0) { int ts = 0; for (int e = 0; e < 32; ++e) { TSTART[e] = ts; ts += (cnt[e] + 255) >> 8; } TSTART[32] = ts; }
            }
            __syncthreads();
        }
#endif
        xcd_barrier(bar);
        }
                for (int rp_ = 0; rp_ < RP_F1; ++rp_) {
#if PH_F1
        { pg8::Gemm g{XB, WGU, SROWS, 32 * 512, D, D, STOK}; pg8::MoeOrder S{(const LAS int*)TSTART, 2, G, vcu};
          pg8::EpiAct E{ACT, SRSTD, SW};
          pg8::gemm_phase<pg8::EpiAct, pg8::MoeOrder, true, true, true>(lds, g, S, E, wv); }
#endif
        xcd_barrier(bar);
        }
                for (int rp_ = 0; rp_ < RP_F2; ++rp_) {
#if PH_F2
        { pg8::Gemm g{ACT, WD, SROWS, 32 * 1024, opq(256), opq(256), nullptr}; pg8::MoeOrder S{(const LAS int*)TSTART, 4, G, vcu};
          pg8::EpiRS E{YB, 1024, nullptr, 0, 0.f, 1.f, 3, 31, 0};
          pg8::gemm_phase<pg8::EpiRS, pg8::MoeOrder, true, true>(lds, g, S, E, wv); }
#endif
        xcd_barrier(bar);
        }
#if PH_F3
        { PH_BEGIN;
            const GAS float* g_fin = INP(25);
            int s0n = SLOT[gw * 2], s1n = SLOT[gw * 2 + 1];
            for (int m = gw; m < M; m += NGW) {
                GAS f32x4* xr = (GAS f32x4*)(XP + (size_t)m * D) + lane; const int s0 = s0n, s1 = s1n;
                if (m + NGW < M) { s0n = SLOT[(m + NGW) * 2]; s1n = SLOT[(m + NGW) * 2 + 1]; }
                const GAS u32x2* y0 = (const GAS u32x2*)(YB + (size_t)s0 * D) + lane; const GAS u32x2* y1 = (const GAS u32x2*)(YB + (size_t)s1 * D) + lane;
                f32x4 v[4]; float s = 0.f;
#pragma unroll
                for (int j = 0; j < 4; ++j) { const u32x2 a = y0[64 * j], b2 = y1[64 * j]; v[j] = xr[64 * j];
                    v[j][0] += pg8::bflo(a.x) + pg8::bflo(b2.x); v[j][1] += pg8::bfhi(a.x) + pg8::bfhi(b2.x); v[j][2] += pg8::bflo(a.y) + pg8::bflo(b2.y); v[j][3] += pg8::bfhi(a.y) + pg8::bfhi(b2.y);
                    s += (v[j][0] * v[j][0] + v[j][1] * v[j][1]) + (v[j][2] * v[j][2] + v[j][3] * v[j][3]); }
                s = wave_sum(s);
                if (l == DEPTH - 1) { const float rsd = 1.0f / sqrtf(s * (1.f / 1024.f) + 1e-6f);
#pragma unroll
                    for (int j = 0; j < 4; ++j) { const f32x4 gg = ((const GAS f32x4*)g_fin)[lane + 64 * j]; xr[64 * j] = v[j] * rsd * gg; }
                } else {
                    GAS u32x2* o8 = (GAS u32x2*)(XB + (size_t)m * D) + lane;
#pragma unroll
                    for (int j = 0; j < 4; ++j) { xr[64 * j] = v[j]; u32x2 w; w.x = pk2(v[j][0], v[j][1]); w.y = pk2(v[j][2], v[j][3]); o8[64 * j] = w; }
                    if (lane < 16) SSQ[(size_t)m * 16 + lane] = (lane == 0) ? s : 0.f;
                }
            }
        }
#endif
    }
}

extern "C" void kernel_launch(void* const* d_in, const int* in_sizes, int n_in, void* d_out, int out_size, void* d_ws, size_t ws_size, hipStream_t stream) {
    static int grid = 0;
    if (grid == 0) {
        if (n_in != 26 || in_sizes[0] != M * D || out_size != M * D || ws_size < WS_END) { fprintf(stderr, "kernel_launch: unexpected shapes (n_in %d, in0 %d, out %d, ws %zu < %zu)\n", n_in, n_in > 0 ? in_sizes[0] : -1, out_size, ws_size, (size_t)WS_END); grid = -1; return; }
        int dev = 0, cus = 0;
        if (hipGetDevice(&dev) != hipSuccess || hipDeviceGetAttribute(&cus, hipDeviceAttributeMultiprocessorCount, dev) != hipSuccess) { grid = -1; return; }
        if (hipFuncSetAttribute((const void*)fwd, hipFuncAttributeMaxDynamicSharedMemorySize, LDS_BYTES) != hipSuccess) { fprintf(stderr, "kernel_launch: hipFuncSetAttribute failed\n"); grid = -1; return; }
        int per_cu = 0;
        if (hipOccupancyMaxActiveBlocksPerMultiprocessor(&per_cu, (const void*)fwd, NTHREADS, LDS_BYTES) != hipSuccess || per_cu < 1) fprintf(stderr, "kernel_launch: occupancy query says %d\n", per_cu);
        (void)hipGetLastError();
        grid = cus < 256 ? (cus / 8) * 8 : 256;
    }
    if (grid <= 0) return;
    if (hipMemsetAsync((char*)d_ws + WS_CTL, 0, CTL_ZERO_BYTES, stream) != hipSuccess) return;
    Args a{};
    for (int i = 0; i < 26; ++i) a.in[i] = (const float*)d_in[i];
    a.out = (float*)d_out; a.ws = (unsigned char*)d_ws;
    hipLaunchKernelGGL(fwd, dim3(grid), dim3(NTHREADS), LDS_BYTES, stream, a);
}
```

```cpp
#include <hip/hip_runtime.h>
#include <cstdio>
#include <cstdint>
#define LAS __attribute__((address_space(3)))
#define GAS __attribute__((address_space(1)))
#ifndef PH_A
#define PH_A 1
#endif
#ifndef PH_B
#define PH_B 1
#endif
#ifndef PH_C
#define PH_C 1
#endif
#ifndef PH_D1
#define PH_D1 1
#endif
#ifndef PH_D2
#define PH_D2 1
#endif
#ifndef PH_E1
#define PH_E1 1
#endif
#ifndef PH_E2
#define PH_E2 1
#endif
#ifndef PH_E3
#define PH_E3 1
#endif
#ifndef PH_F0A
#define PH_F0A 1
#endif
#ifndef PH_F0B
#define PH_F0B 1
#endif
#ifndef PH_F1
#define PH_F1 1
#endif
#ifndef PH_F2
#define PH_F2 1
#endif
#ifndef PH_P0
#define PH_P0 1
#endif
#ifndef PH_F3
#define PH_F3 1
#endif
#ifndef PH_C_DIFF
#define PH_C_DIFF 1
#endif
#ifndef PH_C_SB
#define PH_C_SB 1
#endif
#ifndef PH_C_MLA
#define PH_C_MLA 1
#endif
#ifndef PH_B1
#define PH_B1 1
#endif
#ifndef PH_B2
#define PH_B2 1
#endif
#ifndef PH_B3
#define PH_B3 1
#endif
#ifndef RP_A
#define RP_A 1
#endif
#ifndef RP_B
#define RP_B 1
#endif
#ifndef RP_C
#define RP_C 1
#endif
#ifndef RP_D1
#define RP_D1 1
#endif
#ifndef RP_E1
#define RP_E1 1
#endif
#ifndef RP_E2
#define RP_E2 1
#endif
#ifndef RP_F0A
#define RP_F0A 1
#endif
#ifndef RP_F0B
#define RP_F0B 1
#endif
#ifndef RP_F1
#define RP_F1 1
#endif
#ifndef RP_F2
#define RP_F2 1
#endif
#ifndef RP_P0
#define RP_P0 1
#endif
#ifndef C_REP_MASK
#define C_REP_MASK 7
#endif
#ifndef C_ABL
#define C_ABL 0
#endif
namespace pg8 {
#define PG8_LAS __attribute__((address_space(3)))
typedef unsigned short bf16_t;
typedef short bf16x8 __attribute__((ext_vector_type(8)));
typedef float f32x4 __attribute__((ext_vector_type(4)));
typedef unsigned u32x4 __attribute__((ext_vector_type(4)));
constexpr int BM = 256, BK = 64, HALF = 128, HTB = HALF * BK * 2  , STAGE_BYTES = 8 * HTB, NXCD = 8, WGM = 8;

__host__ __device__ __forceinline__ int lds_byte(int r, int c) { const int st = (r >> 4) * 2 + (c >> 5), rr = r & 15, cc = c & 31, ob = rr * 64 + cc * 2; return st * 1024 + (ob ^ (((ob >> 9) & 1) << 5)); }
__host__ __device__ __forceinline__ void stage_rc(int b, int& R, int& C) { const int st = b / 1024, sb = b % 1024, swz = sb ^ (((sb >> 9) & 1) << 5); R = (st >> 1) * 16 + swz / 64; C = (st & 1) * 32 + (swz % 64) / 2; }
__host__ __device__ __forceinline__ int perm32(int rho) { const int n = rho >> 4, i = rho & 15; return 8 * (i >> 2) + 4 * n + (i & 3); }

struct Unit { int pm, pn, sel; };
struct Gemm { const GAS bf16_t* A; const GAS bf16_t* Bt; int M, N, K, ld; const GAS int* rowidx; };

struct StaticOrder {
    int nM, nN, nwg, G, c;
    __host__ __device__ void init(int M, int N, int G_, int c_) { nM = M / BM; nN = N / BM; nwg = nM * nN; G = G_; c = c_; }
    __host__ __device__ bool next(int i, Unit& u) const {
        const long L = (long)i * G + c; if (L >= nwg) return false;
        int wgid = (int)L; { const int q = nwg / NXCD, r = nwg % NXCD, xcd = wgid % NXCD, off = wgid / NXCD; wgid = (xcd < r ? xcd * (q + 1) : r * (q + 1) + (xcd - r) * q) + off; }
        const int nig = WGM * nN, gid = wgid / nig, fm = gid * WGM, gsz = (nM - fm) < WGM ? (nM - fm) : WGM;
        u.pm = fm + ((wgid % nig) % gsz); u.pn = (wgid % nig) / gsz; u.sel = 0; return true;
    }
    __device__ __forceinline__ void a_ready(const Unit&) const {}
    __device__ __forceinline__ void done(const Unit&) const {}
    __device__ __forceinline__ size_t a_off(const Unit&) const { return 0; }
    __device__ __forceinline__ size_t b_off(const Unit&) const { return 0; }
    __device__ __forceinline__ bool keep(const Unit&) const { return false; }
};

__device__ __forceinline__ unsigned cvt_pk_bf16(float lo, float hi) { unsigned r; asm volatile("v_cvt_pk_bf16_f32 %0, %1, %2" : "=v"(r) : "v"(lo), "v"(hi)); return r; }
template <class Epi, class Sched, bool ALIGN_EPI = false, bool SP2 = false, bool GATHER = false>
__device__ __forceinline__ void gemm_phase(PG8_LAS unsigned char* lds, const Gemm g, const Sched& S, const Epi& E, const int wave_idx) {
    int tid_; asm volatile("v_mbcnt_lo_u32_b32 %0, -1, 0\n\tv_mbcnt_hi_u32_b32 %0, -1, %0" : "=v"(tid_)); tid_ += wave_idx * 64;
    const int tid = tid_, wid = __builtin_amdgcn_readfirstlane(tid >> 6), lane = tid & 63, wr = wid >> 2, wc = wid & 3, fr = lane & 15, fq = lane >> 4;
    const int K = g.K, nt = K / BK, LD = g.ld;
    unsigned voffA[2], voffB[2];
#pragma unroll
    for (int i = 0; i < 2; ++i) { int R, C; stage_rc(tid * 16 + i * 8192, R, C); const int Rb = Epi::PERM ? ((R & ~31) + perm32(R & 31)) : R;
        voffA[i] = (unsigned)(R * LD + C) * 2u; voffB[i] = (unsigned)(Rb * LD + C) * 2u; }
    const size_t kstep = (size_t)(BK * 2);
    const size_t hstep = (size_t)HALF * LD * 2;
    const size_t tstep = 2 * hstep;
    const unsigned ldsw = (unsigned)wid * 1024u;
    const int aoff = lds_byte(wr * 64 + fr, fq * 8), boff = lds_byte(wc * 32 + fr, fq * 8);
#define PG8_SA(b, h) (((b) * 2 + (h)) * HTB)
#define PG8_SB(b, h) ((4 + (b) * 2 + (h)) * HTB)
#define PG8_STAGE(bufoff, gbase, voff) do { _Pragma("unroll") for (int _i = 0; _i < 2; ++_i) \
        __builtin_amdgcn_global_load_lds((const GAS unsigned*)((const GAS char*)(gbase) + (voff)[_i]), (PG8_LAS unsigned*)(lds + (bufoff) + ldsw + _i * 8192), 16, 0, 0); } while (0)
#define PG8_LDA(dst, b, h) do { _Pragma("unroll") for (int m = 0; m < 4; ++m) _Pragma("unroll") for (int k = 0; k < 2; ++k) dst[m][k] = *(const PG8_LAS bf16x8*)(lds + PG8_SA(b, h) + aoff + m * 2048 + k * 1024); } while (0)
#define PG8_LDB(dst, b, h) do { _Pragma("unroll") for (int n = 0; n < 2; ++n) _Pragma("unroll") for (int k = 0; k < 2; ++k) dst[n][k] = *(const PG8_LAS bf16x8*)(lds + PG8_SB(b, h) + boff + n * 2048 + k * 1024); } while (0)
#define PG8_MMA(ai, bj, At, Bt) do { __builtin_amdgcn_s_setprio(1); _Pragma("unroll") for (int m = 0; m < 4; ++m) _Pragma("unroll") for (int n = 0; n < 2; ++n) _Pragma("unroll") for (int k = 0; k < 2; ++k) \
        acc[ai][bj][m][n] = __builtin_amdgcn_mfma_f32_16x16x32_bf16(Bt[n][k], At[m][k], acc[ai][bj][m][n], 0, 0, 0); __builtin_amdgcn_s_setprio(0); } while (0)
#define PG8_WAIT_V(n) asm volatile("s_waitcnt vmcnt(" #n ")" ::: "memory")
#define PG8_WAIT_L(n) asm volatile("s_waitcnt lgkmcnt(" #n ")" ::: "memory")
#define PG8_BAR __builtin_amdgcn_s_barrier()
#define PG8_SCHED __builtin_amdgcn_sched_barrier(0)
    Unit cur, nxt; int ui = 0;
    if (!S.next(0, cur)) return;
    f32x4 acc[2][2][4][2];
#pragma unroll
    for (int a = 0; a < 2; ++a)
#pragma unroll
        for (int b = 0; b < 2; ++b)
#pragma unroll
            for (int m = 0; m < 4; ++m)
#pragma unroll
                for (int n = 0; n < 2; ++n) acc[a][b][m][n] = (f32x4){0.f, 0.f, 0.f, 0.f};
    bf16x8 At[4][2], B0[2][2], B1[2][2];
    const GAS char* cA = (const GAS char*)g.A + (GATHER ? (size_t)0 : (size_t)cur.pm * tstep + S.a_off(cur)); const GAS char* cB = (const GAS char*)g.Bt + (size_t)cur.pn * tstep + S.b_off(cur);
    unsigned vC[2][2], vN[2][2];
    if constexpr (GATHER) {
#pragma unroll
        for (int h = 0; h < 2; ++h)
#pragma unroll
            for (int i = 0; i < 2; ++i) { int R, C; stage_rc(tid * 16 + i * 8192, R, C); vC[h][i] = (unsigned)(g.rowidx[cur.pm * BM + h * HALF + R] * LD + C) * 2u; vN[h][i] = vC[h][i]; }
    }
#define PG8_STAGE_A(bufoff, gb, h, nx) do { if constexpr (GATHER) { unsigned vs_[2] = {(nx) ? vN[h][0] : vC[h][0], (nx) ? vN[h][1] : vC[h][1]}; PG8_STAGE(bufoff, gb, vs_); } \
        else { PG8_STAGE(bufoff, (gb) + (h) * hstep, voffA); } } while (0)
    S.a_ready(cur);
    if constexpr (SP2) {
        PG8_STAGE(PG8_SB(0, 0), cB, voffB); PG8_STAGE(PG8_SB(0, 1), cB + hstep, voffB); PG8_STAGE_A(PG8_SA(0, 0), cA, 0, false); PG8_STAGE_A(PG8_SA(0, 1), cA, 1, false);
        if (wr == 1) PG8_BAR;
        PG8_WAIT_V(2); PG8_BAR;
        PG8_STAGE(PG8_SB(1, 0), cB + kstep, voffB); PG8_STAGE_A(PG8_SA(1, 0), cA + kstep, 0, false); PG8_STAGE(PG8_SB(1, 1), cB + hstep + kstep, voffB);
        PG8_WAIT_V(6); PG8_BAR;
    } else {
        PG8_STAGE(PG8_SB(0, 0), cB, voffB); PG8_STAGE(PG8_SA(0, 0), cA, voffA); PG8_STAGE(PG8_SB(0, 1), cB + hstep, voffB); PG8_STAGE(PG8_SA(0, 1), cA + hstep, voffA);
        if (wr == 1) PG8_BAR;
        PG8_WAIT_V(4); PG8_BAR;
        PG8_STAGE(PG8_SB(1, 0), cB + kstep, voffB); PG8_STAGE(PG8_SA(1, 0), cA + kstep, voffA); PG8_STAGE(PG8_SB(1, 1), cB + hstep + kstep, voffB);
        PG8_WAIT_V(6); PG8_BAR;
    }
    for (;;) {
        const bool has_next = S.next(ui + 1, nxt);
        if constexpr (GATHER) { if (has_next) {
#pragma unroll
            for (int h = 0; h < 2; ++h)
#pragma unroll
                for (int i = 0; i < 2; ++i) { int R, C; stage_rc(tid * 16 + i * 8192, R, C); vN[h][i] = (unsigned)(g.rowidx[nxt.pm * BM + h * HALF + R] * LD + C) * 2u; } } }
        const GAS char* nA = GATHER ? cA : has_next ? (const GAS char*)g.A + (size_t)nxt.pm * tstep + S.a_off(nxt) : cA; const GAS char* nB = has_next ? (const GAS char*)g.Bt + (size_t)nxt.pn * tstep + S.b_off(nxt) : cB;
        for (int t = 0; t < nt; t += 2) {
            const bool last = (t == nt - 2);
            const GAS char* a1 = cA + (size_t)(t + 1) * kstep;
            const GAS char* a2 = last ? nA : cA + (size_t)(t + 2) * kstep; const GAS char* b2 = last ? nB : cB + (size_t)(t + 2) * kstep;
            const GAS char* a3 = a2 + kstep; const GAS char* b3 = b2 + kstep;
            if (last && has_next) S.a_ready(nxt);
            if constexpr (SP2) {
            PG8_LDB(B0, 0, 0); PG8_LDB(B1, 0, 1); PG8_SCHED; PG8_LDA(At, 0, 0); PG8_STAGE_A(PG8_SA(1, 1), a1, 1, false);
            PG8_WAIT_V(8); PG8_WAIT_L(0); PG8_BAR; PG8_MMA(0, 0, At, B0); PG8_MMA(0, 1, At, B1); PG8_BAR; PG8_SCHED;
            PG8_LDA(At, 0, 1); PG8_STAGE(PG8_SB(0, 0), b2, voffB); PG8_STAGE(PG8_SB(0, 1), b2 + hstep, voffB); PG8_STAGE_A(PG8_SA(0, 0), a2, 0, last);
            PG8_WAIT_V(8); PG8_WAIT_L(0); PG8_BAR; PG8_MMA(1, 0, At, B0); PG8_MMA(1, 1, At, B1); PG8_BAR; PG8_SCHED;
            PG8_LDB(B0, 1, 0); PG8_LDB(B1, 1, 1); PG8_SCHED; PG8_LDA(At, 1, 0); PG8_STAGE_A(PG8_SA(0, 1), a2, 1, last);
            PG8_WAIT_V(8); PG8_WAIT_L(0); PG8_BAR; PG8_MMA(0, 0, At, B0); PG8_MMA(0, 1, At, B1); PG8_BAR; PG8_SCHED;
            PG8_LDA(At, 1, 1); PG8_STAGE(PG8_SB(1, 0), b3, voffB); PG8_STAGE(PG8_SB(1, 1), b3 + hstep, voffB); PG8_STAGE_A(PG8_SA(1, 0), a3, 0, last);
            PG8_WAIT_V(8); PG8_WAIT_L(0); PG8_BAR; PG8_MMA(1, 0, At, B0); PG8_MMA(1, 1, At, B1); PG8_BAR; PG8_SCHED;
            } else {
            PG8_LDB(B0, 0, 0); PG8_SCHED; PG8_LDA(At, 0, 0); PG8_STAGE(PG8_SA(1, 1), a1 + hstep, voffA);
            PG8_WAIT_L(8); PG8_BAR; PG8_WAIT_L(0); PG8_MMA(0, 0, At, B0); PG8_BAR; PG8_SCHED;
            PG8_LDB(B1, 0, 1); PG8_STAGE(PG8_SB(0, 0), b2, voffB);
            PG8_BAR; PG8_WAIT_L(0); PG8_MMA(0, 1, At, B1); PG8_BAR;
            PG8_LDA(At, 0, 1); PG8_STAGE(PG8_SA(0, 0), a2, voffA);
            PG8_BAR; PG8_WAIT_L(0); PG8_MMA(1, 0, At, B0); PG8_BAR; PG8_SCHED;
            PG8_STAGE(PG8_SB(0, 1), b2 + hstep, voffB);
            PG8_WAIT_V(6); PG8_BAR; PG8_MMA(1, 1, At, B1); PG8_BAR;
            PG8_LDB(B0, 1, 0); PG8_SCHED; PG8_LDA(At, 1, 0); PG8_STAGE(PG8_SA(0, 1), a2 + hstep, voffA);
            PG8_WAIT_L(8); PG8_BAR; PG8_WAIT_L(0); PG8_MMA(0, 0, At, B0); PG8_BAR; PG8_SCHED;
            PG8_LDB(B1, 1, 1); PG8_STAGE(PG8_SB(1, 0), b3, voffB);
            PG8_BAR; PG8_WAIT_L(0); PG8_MMA(0, 1, At, B1); PG8_BAR;
            PG8_LDA(At, 1, 1); PG8_STAGE(PG8_SA(1, 0), a3, voffA);
            PG8_BAR; PG8_WAIT_L(0); PG8_MMA(1, 0, At, B0); PG8_BAR; PG8_SCHED;
            PG8_STAGE(PG8_SB(1, 1), b3 + hstep, voffB);
            PG8_WAIT_V(6); PG8_BAR; PG8_MMA(1, 1, At, B1); PG8_BAR;
            }
        }
        if constexpr (ALIGN_EPI) { if (wr == 0) PG8_BAR; }
        const bool keep_ = S.keep(cur);
        if constexpr (!Epi::AFTER_DRAIN) { if (!keep_) { E(acc, cur, wr, wc, fr, fq); S.done(cur); } }
        if (!has_next) break;
        if (!keep_) {
#pragma unroll
        for (int a = 0; a < 2; ++a)
#pragma unroll
            for (int b = 0; b < 2; ++b)
#pragma unroll
                for (int m = 0; m < 4; ++m)
#pragma unroll
                    for (int n = 0; n < 2; ++n) acc[a][b][m][n] = (f32x4){0.f, 0.f, 0.f, 0.f}; }
        cur = nxt; cA = nA; cB = nB; ++ui;
        if constexpr (GATHER) { vC[0][0] = vN[0][0]; vC[0][1] = vN[0][1]; vC[1][0] = vN[1][0]; vC[1][1] = vN[1][1]; }
        if constexpr (ALIGN_EPI) { if (wr == 1) PG8_BAR; }
    }
    PG8_WAIT_V(0);
    if constexpr (!ALIGN_EPI) { if (wr == 0) PG8_BAR; }
    PG8_BAR;
    if constexpr (Epi::AFTER_DRAIN) { E.fused(acc, cur, wr, wc, fr, fq, lds, wid, lane); S.done(cur); }
#undef PG8_SA
#undef PG8_SB
#undef PG8_STAGE
#undef PG8_STAGE_A
#undef PG8_LDA
#undef PG8_LDB
#undef PG8_MMA
#undef PG8_WAIT_V
#undef PG8_WAIT_L
#undef PG8_BAR
#undef PG8_SCHED
}
typedef unsigned u32x2 __attribute__((ext_vector_type(2)));
typedef float f32x2v __attribute__((ext_vector_type(2)));
typedef __bf16 bf16x2v __attribute__((ext_vector_type(2)));
__device__ __forceinline__ unsigned pk2(float lo, float hi) { f32x2v v = {lo, hi}; bf16x2v b = __builtin_convertvector(v, bf16x2v); return __builtin_bit_cast(unsigned, b); }
__device__ __forceinline__ float bflo(unsigned w) { return __builtin_bit_cast(float, w << 16); }
__device__ __forceinline__ float bfhi(unsigned w) { return __builtin_bit_cast(float, w & 0xffff0000u); }
__device__ __forceinline__ float rstd_parts(const GAS float* base, unsigned eoff, int n4, float inv_n) {
    float s = 0.f; const GAS char* p = (const GAS char*)base + (size_t)(eoff * 4u);
    for (int i = 0; i < n4; ++i) { const f32x4 v = *(const GAS f32x4*)(p + 16 * i); s += (v[0] + v[1]) + (v[2] + v[3]); }
    return __builtin_amdgcn_rsqf(s * inv_n + 1e-6f);
}
__device__ const double kRopeRev[16] = {0.15915494309189535, 0.08949940160889101, 0.050329212104487035, 0.0283021958306234, 0.015915494309189534, 0.008949940160889102, 0.005032921210448704, 0.00283021958306234,
                                        0.0015915494309189536, 0.0008949940160889102, 0.0005032921210448703, 0.00028302195830623395, 0.00015915494309189535, 8.949940160889102e-05, 5.0329212104487035e-05, 2.8302195830623396e-05};
__device__ __forceinline__ void rope_cs(int pos, int i, float& cs, float& sn) {
    double a = (double)pos * kRopeRev[i]; a -= __builtin_floor(a);
    const float r = (float)a; sn = __builtin_amdgcn_sinf(r); cs = __builtin_amdgcn_cosf(r);
}
#define PG8_L2E 1.4426950408889634f

struct EpiA {
    static constexpr bool PERM = false, AFTER_DRAIN = false;
    const GAS float* ssq; GAS bf16_t *cq, *ckv, *krope, *qk; GAS float *ssq_cq, *ssq_ckv; float c2; GAS unsigned* kn;
    __device__ __forceinline__ void operator()(const f32x4 (&acc)[2][2][4][2], const Unit& u, int wr, int wc, int fr, int fq) const {
        const int pn = u.pn, row0 = u.pm * BM + wr * 64 + fr;
        float rs[2][4];
#pragma unroll
        for (int ai = 0; ai < 2; ++ai)
#pragma unroll
            for (int m = 0; m < 4; ++m) rs[ai][m] = rstd_parts(ssq, (unsigned)((row0 + ai * HALF + m * 16) * 16), 4, 1.f / 1024.f);
        if (pn < 2) {
            GAS bf16_t* dst = pn == 0 ? cq : ckv; GAS float* sq = pn == 0 ? ssq_cq : ssq_ckv;
#pragma unroll
            for (int ai = 0; ai < 2; ++ai)
#pragma unroll
                for (int m = 0; m < 4; ++m) { const int row = row0 + ai * HALF + m * 16; const float r = rs[ai][m]; float s2 = 0.f;
#pragma unroll
                    for (int bj = 0; bj < 2; ++bj)
#pragma unroll
                        for (int n = 0; n < 2; ++n) { const f32x4 v = acc[ai][bj][m][n] * r; s2 += (v[0] * v[0] + v[1] * v[1]) + (v[2] * v[2] + v[3] * v[3]);
                            u32x2 w; w.x = pk2(v[0], v[1]); w.y = pk2(v[2], v[3]); *(GAS u32x2*)(dst + (size_t)row * 256 + bj * HALF + wc * 32 + n * 16 + fq * 4) = w; }
                    s2 += __shfl_xor(s2, 16); s2 += __shfl_xor(s2, 32);
                    if (fq == 0) sq[(size_t)row * 4 + wc] = s2; }
        } else if (pn == 2) {
            if (wc == 0) {
#pragma unroll
                for (int ai = 0; ai < 2; ++ai)
#pragma unroll
                    for (int m = 0; m < 4; ++m) { const int row = row0 + ai * HALF + m * 16, pos = row & 8191; const float r = rs[ai][m];
                        const f32x4 v0 = acc[ai][0][m][0] * r, v1 = acc[ai][0][m][1] * r; float o0[4], o1[4];
#pragma unroll
                        for (int e = 0; e < 4; ++e) { float cs, sn; rope_cs(pos, 4 * fq + e, cs, sn); o0[e] = v0[e] * cs - v1[e] * sn; o1[e] = v0[e] * sn + v1[e] * cs; }
                        u32x2 w0, w1; w0.x = pk2(o0[0], o0[1]); w0.y = pk2(o0[2], o0[3]); w1.x = pk2(o1[0], o1[1]); w1.y = pk2(o1[2], o1[3]);
                        *(GAS u32x2*)(krope + (size_t)row * 32 + 4 * fq) = w0; *(GAS u32x2*)(krope + (size_t)row * 32 + 16 + 4 * fq) = w1; }
            }
        } else {
            const int t = pn - 3, buf = t >> 1, half = t & 1; GAS bf16_t* dst = qk + (size_t)buf * 16384 * 512; const float sc = (buf & 1) ? 1.f : c2;
#pragma unroll
            for (int ai = 0; ai < 2; ++ai)
#pragma unroll
                for (int bj = 0; bj < 2; ++bj) { float kmx = 0.f;
#pragma unroll
                    for (int m = 0; m < 4; ++m) { const int row = row0 + ai * HALF + m * 16; const float r = rs[ai][m] * sc; float s2 = 0.f;
#pragma unroll
                        for (int n = 0; n < 2; ++n) { const f32x4 v = acc[ai][bj][m][n] * r; u32x2 w; w.x = pk2(v[0], v[1]); w.y = pk2(v[2], v[3]);
                            s2 += (v[0] * v[0] + v[1] * v[1]) + (v[2] * v[2] + v[3] * v[3]);
                            *(GAS u32x2*)(dst + (size_t)row * 512 + half * 256 + bj * HALF + wc * 32 + n * 16 + fq * 4) = w; }
                        kmx = fmaxf(kmx, s2); }
                    if (pn >= 9) {
                        float s = kmx; const float q1 = __shfl_xor(s, 16), q2 = __shfl_xor(s, 32), q3 = __shfl_xor(q1, 32); s = (s + q1) + (q2 + q3);
                        s = fmaxf(s, __shfl_xor(s, 1)); s = fmaxf(s, __shfl_xor(s, 2)); s = fmaxf(s, __shfl_xor(s, 4)); s = fmaxf(s, __shfl_xor(s, 8));
                        if ((fr | fq) == 0) __hip_atomic_fetch_max(kn + (((size_t)(4 * u.pm + 2 * ai + wr) * 8 + 4 * (pn - 9) + 2 * bj + (wc >> 1)) * 2 + (wc & 1)), __builtin_bit_cast(unsigned, s), __ATOMIC_RELAXED, __HIP_MEMORY_SCOPE_AGENT); } }
        }
    }
};
struct EpiVT {
    static constexpr bool PERM = true, AFTER_DRAIN = false;
    GAS bf16_t* out; int ld; const GAS float* ssq; int n4; float inv_n;
    __device__ __forceinline__ void operator()(const f32x4 (&acc)[2][2][4][2], const Unit& u, int wr, int wc, int fr, int fq) const {
        const int col0 = u.pn * BM + wc * 32 + 8 * fq, row0 = u.pm * BM + wr * 64 + fr;
        float cs[2][8];
#pragma unroll
        for (int bj = 0; bj < 2; ++bj)
#pragma unroll
            for (int j = 0; j < 8; ++j) cs[bj][j] = rstd_parts(ssq, (unsigned)((col0 + bj * HALF + j) * (4 * n4)), n4, inv_n);
#pragma unroll
        for (int ai = 0; ai < 2; ++ai)
#pragma unroll
            for (int m = 0; m < 4; ++m) { GAS bf16_t* rowp = out + (size_t)(row0 + ai * HALF + m * 16) * ld + col0;
#pragma unroll
                for (int bj = 0; bj < 2; ++bj) { const f32x4 v0 = acc[ai][bj][m][0], v1 = acc[ai][bj][m][1]; u32x4 w;
                    w.x = pk2(v0[0] * cs[bj][0], v0[1] * cs[bj][1]); w.y = pk2(v0[2] * cs[bj][2], v0[3] * cs[bj][3]);
                    w.z = pk2(v1[0] * cs[bj][4], v1[1] * cs[bj][5]); w.w = pk2(v1[2] * cs[bj][6], v1[3] * cs[bj][7]);
                    *(GAS u32x4*)(rowp + bj * HALF) = w; } }
    }
};
struct EpiRS {
    static constexpr bool PERM = true, AFTER_DRAIN = false;
    GAS bf16_t* out; int ld; const GAS float* ssq; int n4; float inv_n; float scale; int pnmask; int pnshift; size_t zstride;
    __device__ __forceinline__ void operator()(const f32x4 (&acc)[2][2][4][2], const Unit& u, int wr, int wc, int fr, int fq) const {
        const int col0 = (u.pn & pnmask) * BM + wc * 32 + 8 * fq, row0 = u.pm * BM + wr * 64 + fr;
        float rr[2][4];
#pragma unroll
        for (int ai = 0; ai < 2; ++ai)
#pragma unroll
            for (int m = 0; m < 4; ++m) rr[ai][m] = (n4 ? rstd_parts(ssq, (unsigned)((row0 + ai * HALF + m * 16) * (4 * n4)), n4, inv_n) : 1.f) * scale;
#pragma unroll
        for (int ai = 0; ai < 2; ++ai)
#pragma unroll
            for (int m = 0; m < 4; ++m) { const int row = row0 + ai * HALF + m * 16; const float r = rr[ai][m];
                GAS bf16_t* rowp = out + (size_t)(u.pn >> pnshift) * zstride + (size_t)row * ld + col0;
#pragma unroll
                for (int bj = 0; bj < 2; ++bj) { const f32x4 v0 = acc[ai][bj][m][0] * r, v1 = acc[ai][bj][m][1] * r; u32x4 w;
                    w.x = pk2(v0[0], v0[1]); w.y = pk2(v0[2], v0[3]); w.z = pk2(v1[0], v1[1]); w.w = pk2(v1[2], v1[3]); *(GAS u32x4*)(rowp + bj * HALF) = w; } }
    }
};
struct EpiQ {
    static constexpr bool PERM = false, AFTER_DRAIN = false;
    GAS bf16_t* q; const GAS float* ssq_cq; float c2;
    __device__ __forceinline__ void operator()(const f32x4 (&acc)[2][2][4][2], const Unit& u, int wr, int wc, int fr, int fq) const {
        const int pn = u.pn, row0 = u.pm * BM + wr * 64 + fr;
        float rr[2][4];
#pragma unroll
        for (int ai = 0; ai < 2; ++ai)
#pragma unroll
            for (int m = 0; m < 4; ++m) rr[ai][m] = rstd_parts(ssq_cq, (unsigned)((row0 + ai * HALF + m * 16) * 4), 1, 1.f / 256.f) * c2;
#pragma unroll
        for (int ai = 0; ai < 2; ++ai)
#pragma unroll
            for (int m = 0; m < 4; ++m) { const int row = row0 + ai * HALF + m * 16; const float r = rr[ai][m];
                if (pn < 2) {
#pragma unroll
                    for (int bj = 0; bj < 2; ++bj)
#pragma unroll
                        for (int n = 0; n < 2; ++n) { const f32x4 v = acc[ai][bj][m][n] * r; u32x2 w; w.x = pk2(v[0], v[1]); w.y = pk2(v[2], v[3]);
                            *(GAS u32x2*)(q + (size_t)row * 768 + pn * 256 + bj * HALF + wc * 32 + n * 16 + fq * 4) = w; }
                } else { const int pos = row & 8191; float cs[4], sn[4];
#pragma unroll
                    for (int e = 0; e < 4; ++e) rope_cs(pos, 4 * fq + e, cs[e], sn[e]);
#pragma unroll
                    for (int bj = 0; bj < 2; ++bj) { const f32x4 v0 = acc[ai][bj][m][0] * r, v1 = acc[ai][bj][m][1] * r; float o0[4], o1[4];
#pragma unroll
                        for (int e = 0; e < 4; ++e) { o0[e] = v0[e] * cs[e] - v1[e] * sn[e]; o1[e] = v0[e] * sn[e] + v1[e] * cs[e]; }
                        u32x2 w0, w1; w0.x = pk2(o0[0], o0[1]); w0.y = pk2(o0[2], o0[3]); w1.x = pk2(o1[0], o1[1]); w1.y = pk2(o1[2], o1[3]);
                        GAS bf16_t* p = q + (size_t)row * 768 + 512 + (4 * bj + wc) * 32 + 4 * fq; *(GAS u32x2*)p = w0; *(GAS u32x2*)(p + 16) = w1; }
                } }
    }
};
struct D1Order {
    StaticOrder so; size_t dA, dB;
    __device__ __forceinline__ bool next(int i, Unit& u) const { if (i >= 9) return false; if (!so.next(0, u)) return false; u.sel = i; return true; }
    __device__ __forceinline__ void a_ready(const Unit&) const {}
    __device__ __forceinline__ void done(const Unit&) const {}
    __device__ __forceinline__ size_t a_off(const Unit& u) const { const int z = u.sel / 3, p = u.sel - 3 * z; return p == 2 ? dA + (size_t)(z >> 1) * 16384 * 2048 + (size_t)(z & 1) * 1024 : (size_t)p * 1024; }
    __device__ __forceinline__ size_t b_off(const Unit& u) const { const int z = u.sel / 3, p = u.sel - 3 * z; return p == 2 ? dB + (size_t)(z >> 1) * 1024 * 2048 + (size_t)(z & 1) * 1024 : (size_t)z * 1024 * 2048 + (size_t)p * 1024; }
    __device__ __forceinline__ bool keep(const Unit& u) const { return (u.sel % 3) == 0; }
};
struct EpiD1 {
    static constexpr bool PERM = true, AFTER_DRAIN = false;
    GAS bf16_t* g; GAS bf16_t* mb; const GAS float* ssq;
    __device__ __forceinline__ void operator()(const f32x4 (&acc)[2][2][4][2], const Unit& u, int wr, int wc, int fr, int fq) const {
        const int col0 = u.pn * BM + wc * 32 + 8 * fq, row0 = u.pm * BM + wr * 64 + fr, z = u.sel / 3;
        if (u.sel % 3 == 1) {
            float rr[2][4];
#pragma unroll
            for (int ai = 0; ai < 2; ++ai)
#pragma unroll
                for (int m = 0; m < 4; ++m) rr[ai][m] = -PG8_L2E * rstd_parts(ssq, (unsigned)((row0 + ai * HALF + m * 16) * 16), 4, 1.f / 1024.f);
#pragma unroll
            for (int ai = 0; ai < 2; ++ai)
#pragma unroll
                for (int m = 0; m < 4; ++m) { const int row = row0 + ai * HALF + m * 16; const float r = rr[ai][m];
#pragma unroll
                    for (int bj = 0; bj < 2; ++bj) { float s[8];
#pragma unroll
                        for (int j = 0; j < 8; ++j) s[j] = __builtin_amdgcn_rcpf(1.f + __builtin_amdgcn_exp2f(acc[ai][bj][m][j >> 2][j & 3] * r));
                        u32x4 w; w.x = pk2(s[0], s[1]); w.y = pk2(s[2], s[3]); w.z = pk2(s[4], s[5]); w.w = pk2(s[6], s[7]);
                        *(GAS u32x4*)(g + (size_t)row * 1024 + col0 + bj * HALF) = w; } }
        } else {
#pragma unroll
            for (int ai = 0; ai < 2; ++ai) {
                u32x4 gw[4][2], pw[4][2];
#pragma unroll
                for (int m = 0; m < 4; ++m)
#pragma unroll
                    for (int bj = 0; bj < 2; ++bj) { const size_t o = (size_t)(row0 + ai * HALF + m * 16) * 1024 + col0 + bj * HALF; gw[m][bj] = *(const GAS u32x4*)(g + o);
                        if (z > 0) pw[m][bj] = *(const GAS u32x4*)(mb + o); else pw[m][bj] = (u32x4){0u, 0u, 0u, 0u}; }
#pragma unroll
                for (int m = 0; m < 4; ++m)
#pragma unroll
                    for (int bj = 0; bj < 2; ++bj) { const size_t o = (size_t)(row0 + ai * HALF + m * 16) * 1024 + col0 + bj * HALF; const u32x4 gq = gw[m][bj], pm_ = pw[m][bj];
                        f32x4 a0 = acc[ai][bj][m][0], a1 = acc[ai][bj][m][1];
                        a0[0] = a0[0] * bflo(gq.x) + bflo(pm_.x); a0[1] = a0[1] * bfhi(gq.x) + bfhi(pm_.x); a0[2] = a0[2] * bflo(gq.y) + bflo(pm_.y); a0[3] = a0[3] * bfhi(gq.y) + bfhi(pm_.y);
                        a1[0] = a1[0] * bflo(gq.z) + bflo(pm_.z); a1[1] = a1[1] * bfhi(gq.z) + bfhi(pm_.z); a1[2] = a1[2] * bflo(gq.w) + bflo(pm_.w); a1[3] = a1[3] * bfhi(gq.w) + bfhi(pm_.w);
                        u32x4 w; w.x = pk2(a0[0], a0[1]); w.y = pk2(a0[2], a0[3]); w.z = pk2(a1[0], a1[1]); w.w = pk2(a1[2], a1[3]); *(GAS u32x4*)(mb + o) = w; } }
        }
    }
};
struct EpiRes {
    static constexpr bool PERM = true, AFTER_DRAIN = false;
    GAS bf16_t* xb; GAS float* ssq;
    __device__ __forceinline__ void operator()(const f32x4 (&acc)[2][2][4][2], const Unit& u, int wr, int wc, int fr, int fq) const {
        const int col0 = u.pn * BM + wc * 32 + 8 * fq, row0 = u.pm * BM + wr * 64 + fr;
#pragma unroll
        for (int ai = 0; ai < 2; ++ai) {
            u32x4 xv[4][2];
#pragma unroll
            for (int m = 0; m < 4; ++m)
#pragma unroll
                for (int bj = 0; bj < 2; ++bj) xv[m][bj] = *(const GAS u32x4*)(xb + (size_t)(row0 + ai * HALF + m * 16) * 1024 + col0 + bj * HALF);
#pragma unroll
            for (int m = 0; m < 4; ++m) { const int row = row0 + ai * HALF + m * 16; const size_t rb = (size_t)row * 1024 + col0; float s2 = 0.f;
#pragma unroll
                for (int bj = 0; bj < 2; ++bj) { const u32x4 xw = xv[m][bj]; const f32x4 a0 = acc[ai][bj][m][0], a1 = acc[ai][bj][m][1];
                    const float v0 = bflo(xw.x) + a0[0], v1 = bfhi(xw.x) + a0[1], v2 = bflo(xw.y) + a0[2], v3 = bfhi(xw.y) + a0[3];
                    const float v4 = bflo(xw.z) + a1[0], v5 = bfhi(xw.z) + a1[1], v6 = bflo(xw.w) + a1[2], v7 = bfhi(xw.w) + a1[3];
                    u32x4 w; w.x = pk2(v0, v1); w.y = pk2(v2, v3); w.z = pk2(v4, v5); w.w = pk2(v6, v7);
                    *(GAS u32x4*)(xb + rb + bj * HALF) = w;
                    s2 += ((v0 * v0 + v1 * v1) + (v2 * v2 + v3 * v3)) + ((v4 * v4 + v5 * v5) + (v6 * v6 + v7 * v7)); }
                s2 += __shfl_xor(s2, 16); s2 += __shfl_xor(s2, 32);
                if (fq == 0) ssq[(size_t)row * 16 + u.pn * 4 + wc] = s2; } }
    }
};
struct EpiAct {
    static constexpr bool PERM = true, AFTER_DRAIN = false;
    GAS bf16_t* act; const GAS float* s_rstd; const GAS float* s_w;
    __device__ __forceinline__ void operator()(const f32x4 (&acc)[2][2][4][2], const Unit& u, int wr, int wc, int fr, int fq) const {
        const int t = u.pn & 1, row0 = u.pm * BM + wr * 64 + fr;
        float rr[2][4], ww[2][4];
#pragma unroll
        for (int ai = 0; ai < 2; ++ai)
#pragma unroll
            for (int m = 0; m < 4; ++m) { rr[ai][m] = s_rstd[row0 + ai * HALF + m * 16]; ww[ai][m] = s_w[row0 + ai * HALF + m * 16]; }
#pragma unroll
        for (int ai = 0; ai < 2; ++ai)
#pragma unroll
            for (int m = 0; m < 4; ++m) { const int row = row0 + ai * HALF + m * 16; const float rs = rr[ai][m], w = ww[ai][m]; float o[8];
#pragma unroll
                for (int j = 0; j < 8; ++j) { const float a = acc[ai][0][m][j >> 2][j & 3] * rs, b = acc[ai][1][m][j >> 2][j & 3] * rs;
                    const float v = a * __builtin_amdgcn_rcpf(1.f + __builtin_amdgcn_exp2f(-PG8_L2E * a)) * b * w; o[j] = (w != 0.f) ? v : 0.f; }
                u32x4 pw; pw.x = pk2(o[0], o[1]); pw.y = pk2(o[2], o[3]); pw.z = pk2(o[4], o[5]); pw.w = pk2(o[6], o[7]);
                *(GAS u32x4*)(act + (size_t)row * 256 + t * 128 + wc * 32 + 8 * fq) = pw; }
    }
};
struct SplitK2Order {
    StaticOrder so; size_t tstep;
    __device__ __forceinline__ bool next(int i, Unit& u) const { return so.next(i, u); }
    __device__ __forceinline__ void a_ready(const Unit&) const {}
    __device__ __forceinline__ void done(const Unit&) const {}
    __device__ __forceinline__ size_t a_off(const Unit& u) const { return (size_t)(u.pn >> 1) * 1024; }
    __device__ __forceinline__ size_t b_off(const Unit& u) const { return (size_t)(u.pn >> 1) * 1024 - (size_t)(u.pn >> 1) * 2 * tstep; }
    __device__ __forceinline__ bool keep(const Unit&) const { return false; }
};
struct MoeOrder {
    const PG8_LAS int* tstart; int per, G, v;
    __device__ __forceinline__ bool next(int i, Unit& u) const {
        const int idx = i * G + v, tot = tstart[32] * per; if (idx >= tot) return false;
        const int ti = idx / per, ct = idx - ti * per; int e = 0;
#pragma unroll 1
        for (int k = 1; k < 32; ++k) e += (tstart[k] <= ti) ? 1 : 0;
        u.pm = ti; u.pn = e * per + ct; u.sel = 0; return true;
    }
    __device__ __forceinline__ void a_ready(const Unit&) const {}
    __device__ __forceinline__ void done(const Unit&) const {}
    __device__ __forceinline__ size_t a_off(const Unit&) const { return 0; }
    __device__ __forceinline__ size_t b_off(const Unit&) const { return 0; }
    __device__ __forceinline__ bool keep(const Unit&) const { return false; }
};
}
namespace att {
typedef unsigned short bf16;
typedef short bf16x8 __attribute__((ext_vector_type(8)));
typedef short s16x4 __attribute__((ext_vector_type(4)));
typedef float f32x16 __attribute__((ext_vector_type(16)));
typedef float f32x4 __attribute__((ext_vector_type(4)));
typedef unsigned u32x4 __attribute__((ext_vector_type(4)));
typedef unsigned u32x2 __attribute__((ext_vector_type(2)));
typedef float f32x2v __attribute__((ext_vector_type(2)));
typedef __bf16 bf16x2v __attribute__((ext_vector_type(2)));
__device__ __forceinline__ unsigned pk2(float lo, float hi) { f32x2v v = {lo, hi}; bf16x2v b = __builtin_convertvector(v, bf16x2v); return __builtin_bit_cast(unsigned, b); }
__device__ __forceinline__ float bflo(unsigned w) { return __builtin_bit_cast(float, w << 16); }
__device__ __forceinline__ float bfhi(unsigned w) { return __builtin_bit_cast(float, w & 0xffff0000u); }
__device__ __forceinline__ int crow(int r, int hi) { return (r & 3) + 8 * (r >> 2) + 4 * hi; }
__device__ __forceinline__ float xhalf(float v) {
    const unsigned u = __builtin_bit_cast(unsigned, v);
    auto rr = __builtin_amdgcn_permlane32_swap(u, u, false, false);
    const unsigned o = (rr[0] != u) ? rr[0] : rr[1];
    return __builtin_bit_cast(float, o);
}
__device__ __forceinline__ bf16x8 mk8(unsigned a, unsigned b, unsigned c, unsigned d) { u32x4 w = {a, b, c, d}; return __builtin_bit_cast(bf16x8, w); }

constexpr int VPB = 144;
template <int DK> struct KLay { static constexpr int KPB = (DK + 8) * 2, KBUF = 64 * KPB; };

template <int DK, int DV, bool KROPE> struct Stage {
    static constexpr int NK = KROPE ? 1 : DK / 64, NV = DV / 64;
    u32x4 kr[NK]; u32x4 kr2; u32x4 vr[NV];
    __device__ __forceinline__ void loadK(int tid, const GAS bf16* Kg, int ldk, const GAS bf16* K2g, int kv0) {
        const GAS char* kbase = (const GAS char*)(Kg + (size_t)kv0 * ldk);
        if constexpr (KROPE) {
            kr[0] = *(const GAS u32x4*)(kbase + (unsigned)(((tid >> 3) * ldk + 8 * (tid & 7)) * 2));
            if (tid < 256) kr2 = *(const GAS u32x4*)((const GAS char*)(K2g + (size_t)kv0 * 32) + (unsigned)(tid * 16));
        } else {
#pragma unroll
            for (int i = 0; i < NK; ++i) { const int p = tid + 512 * i, row = p / (DK / 8), ch = p % (DK / 8); kr[i] = *(const GAS u32x4*)(kbase + (unsigned)((row * ldk + 8 * ch) * 2)); }
        }
    }
    __device__ __forceinline__ void loadV(int tid, const GAS bf16* Vg, int ldv, int kv0) {
        const GAS char* vbase = (const GAS char*)(Vg + kv0);
#pragma unroll
        for (int i = 0; i < NV; ++i) { const int p = tid + 512 * i, dd = p >> 3, ch = p & 7; vr[i] = *(const GAS u32x4*)(vbase + (unsigned)((dd * ldv + 8 * ch) * 2)); }
    }
    __device__ __forceinline__ void storeK(int tid, LAS unsigned char* kb) const {
        constexpr int KPB = KLay<DK>::KPB;
        if constexpr (KROPE) {
            *(LAS u32x4*)(kb + (tid >> 3) * KPB + 16 * (tid & 7)) = kr[0];
            if (tid < 256) *(LAS u32x4*)(kb + (tid >> 2) * KPB + 128 + 16 * (tid & 3)) = kr2;
        } else {
#pragma unroll
            for (int i = 0; i < NK; ++i) { const int p = tid + 512 * i, row = p / (DK / 8), ch = p % (DK / 8); *(LAS u32x4*)(kb + row * KPB + 16 * ch) = kr[i]; }
        }
    }
    __device__ __forceinline__ void storeV(int tid, LAS unsigned char* vb) const {
#pragma unroll
        for (int i = 0; i < NV; ++i) { const int p = tid + 512 * i, dd = p >> 3, ch = p & 7; LAS unsigned char* q = vb + dd * VPB + 32 * (ch >> 1) + 8 * (ch & 1);
            *(LAS u32x2*)q = (u32x2){vr[i].x, vr[i].y}; *(LAS u32x2*)(q + 16) = (u32x2){vr[i].z, vr[i].w}; }
    }
    __device__ __forceinline__ void load(int tid, const GAS bf16* Kg, int ldk, const GAS bf16* K2g, const GAS bf16* Vg, int ldv, int kv0) { loadK(tid, Kg, ldk, K2g, kv0); loadV(tid, Vg, ldv, kv0); }
    __device__ __forceinline__ void store(int tid, LAS unsigned char* kb, LAS unsigned char* vb) const { storeK(tid, kb); storeV(tid, vb); }
};

template <int DK> __device__ __forceinline__ void qkt(f32x16& p0, f32x16& p1, const LAS unsigned char* kb, const bf16x8 (&qf)[DK / 16], int r32, int hi) {
    constexpr int KPB = KLay<DK>::KPB;
    const LAS unsigned char* k0 = kb + r32 * KPB + hi * 16;
#pragma unroll
    for (int d0 = 0; d0 < DK / 16; ++d0) {
        const bf16x8 a0 = *(const LAS bf16x8*)(k0 + d0 * 32), a1 = *(const LAS bf16x8*)(k0 + 32 * KPB + d0 * 32);
        p0 = __builtin_amdgcn_mfma_f32_32x32x16_bf16(a0, qf[d0], p0, 0, 0, 0);
        p1 = __builtin_amdgcn_mfma_f32_32x32x16_bf16(a1, qf[d0], p1, 0, 0, 0);
    }
}
template <int DK> __device__ __forceinline__ void qkt_qmem(f32x16& p0, f32x16& p1, const LAS unsigned char* kb, const bf16x8* qf, const LAS unsigned char* qlds, int r32, int hi) {
    constexpr int KPB = KLay<DK>::KPB, QR = DK / 32;
    const LAS unsigned char* k0 = kb + r32 * KPB + hi * 16;
#pragma unroll
    for (int d0 = 0; d0 < DK / 16; ++d0) {
        bf16x8 q; if (d0 < QR) q = qf[d0]; else q = *(const LAS bf16x8*)(qlds + (d0 - QR) * 1024);
        const bf16x8 a0 = *(const LAS bf16x8*)(k0 + d0 * 32), a1 = *(const LAS bf16x8*)(k0 + 32 * KPB + d0 * 32);
        p0 = __builtin_amdgcn_mfma_f32_32x32x16_bf16(a0, q, p0, 0, 0, 0);
        p1 = __builtin_amdgcn_mfma_f32_32x32x16_bf16(a1, q, p1, 0, 0, 0);
        if ((d0 & 3) == 3) __builtin_amdgcn_sched_barrier(0);
    }
}
template <int DV> __device__ __forceinline__ void pv(f32x16 (&o)[DV / 32], const LAS unsigned char* vb, const bf16x8 (&pf)[4], int r32, int hi) {
#pragma unroll
    for (int db = 0; db < DV / 32; ++db) {
        const LAS unsigned char* v0 = vb + (32 * db + r32) * VPB + 16 * hi;
#pragma unroll
        for (int s = 0; s < 4; ++s) {
            const bf16x8 vf = *(const LAS bf16x8*)(v0 + 32 * s);
            o[db] = __builtin_amdgcn_mfma_f32_32x32x16_bf16(vf, pf[s], o[db], 0, 0, 0);
        }
        if (DV > 64) __builtin_amdgcn_sched_barrier(0);
    }
}
__device__ __forceinline__ void pack_p(bf16x8 (&pf)[4], const f32x16& p0, const f32x16& p1) {
    pf[0] = mk8(pk2(p0[0], p0[1]), pk2(p0[2], p0[3]), pk2(p0[4], p0[5]), pk2(p0[6], p0[7]));
    pf[1] = mk8(pk2(p0[8], p0[9]), pk2(p0[10], p0[11]), pk2(p0[12], p0[13]), pk2(p0[14], p0[15]));
    pf[2] = mk8(pk2(p1[0], p1[1]), pk2(p1[2], p1[3]), pk2(p1[4], p1[5]), pk2(p1[6], p1[7]));
    pf[3] = mk8(pk2(p1[8], p1[9]), pk2(p1[10], p1[11]), pk2(p1[12], p1[13]), pk2(p1[14], p1[15]));
}

template <bool ALIBI> __device__ __forceinline__ void fl_init(f32x16& p0, f32x16& p1, float slope2, int kv0, int hi, int qrow) {
    if (ALIBI) {
        const float s2 = slope2 + slope2, s4 = s2 + s2, s8 = s4 + s4, s32 = (s8 + s8) + (s8 + s8);
        float g = slope2 * (float)(kv0 + 4 * hi - qrow);
#pragma unroll
        for (int c = 0; c < 4; ++c) { float v = g;
#pragma unroll
            for (int e = 0; e < 4; ++e) { p0[4 * c + e] = v; p1[4 * c + e] = v + s32; v += slope2; }
            g += s8; } }
    else {
#pragma unroll
        for (int r = 0; r < 16; ++r) { p0[r] = 0.f; p1[r] = 0.f; } }
}
__device__ __forceinline__ void fl_mask(f32x16& p0, f32x16& p1, int kv0, int hi, int qrow) {
    const int thr = qrow - kv0 - 4 * hi;
#pragma unroll
    for (int r = 0; r < 16; ++r) { const int c = (r & 3) + 8 * (r >> 2); if (c > thr) p0[r] = -INFINITY; if (c + 32 > thr) p1[r] = -INFINITY; }
}
__device__ __forceinline__ void fl_start(const f32x16& p0, const f32x16& p1, float& m, float& alpha) {
    float mx = fmaxf(p0[0], p1[0]);
#pragma unroll
    for (int r = 1; r < 16; ++r) mx = fmaxf(fmaxf(mx, p0[r]), p1[r]);
    mx = fmaxf(mx, xhalf(mx));
    const float mn = fmaxf(m, mx); alpha = __builtin_amdgcn_exp2f(m - mn); m = mn;
}
__device__ __forceinline__ void fl_finish(f32x16& p0, f32x16& p1, float m, float& l, bf16x8 (&pf)[4]) {
    float s0 = 0.f, s1 = 0.f;
#pragma unroll
    for (int r = 0; r < 16; ++r) { p0[r] = __builtin_amdgcn_exp2f(p0[r] - m); p1[r] = __builtin_amdgcn_exp2f(p1[r] - m); s0 += p0[r]; s1 += p1[r]; }
    l += s0 + s1;
    pack_p(pf, p0, p1);
}

#define FL_EL(P0, P1, e) ((e) < 16 ? P0[(e) & 15] : P1[(e) & 15])
template <int DK, bool QMEM> __device__ __forceinline__ void fl_blockX(f32x16& n0, f32x16& n1, const LAS unsigned char* kb, const bf16x8* qf, const LAS unsigned char* qlds, int r32, int hi,
                                                                         f32x16& c0, f32x16& c1, float m, float& l, bf16x8 (&pf)[4]) {
    constexpr int KPB = KLay<DK>::KPB, NS = DK / 16, CH = ((32 + NS - 1) / NS + 1) & ~1;
    const LAS unsigned char* k0 = kb + r32 * KPB + hi * 16;
    float s0 = 0.f, s1 = 0.f; unsigned pw[16];
#define FLX_K0(s) (*(const LAS bf16x8*)(k0 + ((s) < NS ? (s) : NS - 1) * 32))
#define FLX_K1(s) (*(const LAS bf16x8*)(k0 + 32 * KPB + ((s) < NS ? (s) : NS - 1) * 32))
    bf16x8 a0 = FLX_K0(0), a1 = FLX_K1(0), b0 = FLX_K0(1), b1 = FLX_K1(1), e0 = FLX_K0(2), e1 = FLX_K1(2);
    bf16x8 q, qb, qe; if constexpr (QMEM) { q = *(const LAS bf16x8*)(qlds); qb = *(const LAS bf16x8*)(qlds + (NS > 1 ? 1024 : 0)); qe = *(const LAS bf16x8*)(qlds + (NS > 2 ? 2048 : 0)); } else { q = qf[0]; qb = qf[NS > 1 ? 1 : 0]; qe = qf[NS > 2 ? 2 : 0]; }
#pragma unroll
    for (int d0 = 0; d0 < NS; ++d0) {
        bf16x8 c0n = e0, c1n = e1, qc = qe;
        if (d0 + 3 < NS) { c0n = FLX_K0(d0 + 3); c1n = FLX_K1(d0 + 3);
            if constexpr (QMEM) qc = *(const LAS bf16x8*)(qlds + (d0 + 3) * 1024); else qc = qf[d0 + 3]; }
        n0 = __builtin_amdgcn_mfma_f32_32x32x16_bf16(a0, q, n0, 0, 0, 0);
        n1 = __builtin_amdgcn_mfma_f32_32x32x16_bf16(a1, q, n1, 0, 0, 0);
#pragma unroll
        for (int e = d0 * CH; e < (d0 + 1) * CH && e < 32; e += 2) {
            float x, y;
            if (e < 16) { x = __builtin_amdgcn_exp2f(c0[e] - m); y = __builtin_amdgcn_exp2f(c0[e + 1] - m); s0 += x; s1 += y; }
            else { x = __builtin_amdgcn_exp2f(c1[e - 16] - m); y = __builtin_amdgcn_exp2f(c1[e - 15] - m); s0 += x; s1 += y; }
            pw[e >> 1] = pk2(x, y); asm volatile("" : "+v"(pw[e >> 1])); }
        asm volatile("" : "+v"(s0), "+v"(s1));
        __builtin_amdgcn_sched_barrier(0);
        a0 = b0; a1 = b1; q = qb; b0 = e0; b1 = e1; qb = qe; e0 = c0n; e1 = c1n; qe = qc;
    }
#undef FLX_K0
#undef FLX_K1
    l += s0 + s1;
    pf[0] = mk8(pw[0], pw[1], pw[2], pw[3]); pf[1] = mk8(pw[4], pw[5], pw[6], pw[7]); pf[2] = mk8(pw[8], pw[9], pw[10], pw[11]); pf[3] = mk8(pw[12], pw[13], pw[14], pw[15]);
}
template <int DV> __device__ __forceinline__ void fl_blockY(f32x16 (&o)[DV / 32], const LAS unsigned char* vb, const bf16x8 (&pf)[4], int r32, int hi, const f32x16& n0, const f32x16& n1, float& m, float& alpha) {
    constexpr int NS = DV / 8, CH = 32 / NS;
    float mx0 = -INFINITY, mx1 = -INFINITY;
    const LAS unsigned char* v0 = vb + r32 * VPB + 16 * hi;
    bf16x8 vf = *(const LAS bf16x8*)(v0), vg = *(const LAS bf16x8*)(v0 + 32);
#pragma unroll
    for (int st = 0; st < NS; ++st) {
        const int db = st >> 2, s = st & 3;
        bf16x8 vn = vg;
        if (st + 2 < NS) vn = *(const LAS bf16x8*)(v0 + ((st + 2) >> 2) * 32 * VPB + 32 * ((st + 2) & 3));
        o[db] = __builtin_amdgcn_mfma_f32_32x32x16_bf16(vf, pf[s], o[db], 0, 0, 0);
#pragma unroll
        for (int e = st * CH; e < (st + 1) * CH; ++e) { if (e < 16) mx0 = fmaxf(mx0, n0[e]); else mx1 = fmaxf(mx1, n1[e - 16]); }
        asm volatile("" : "+v"(mx0), "+v"(mx1));
        __builtin_amdgcn_sched_barrier(0);
        vf = vg; vg = vn;
    }
    float mx = fmaxf(mx0, mx1); mx = fmaxf(mx, xhalf(mx));
    const float mn = fmaxf(m, mx); alpha = __builtin_amdgcn_exp2f(m - mn); m = mn;
}

template <int DK, int DV, bool CAUSAL, bool ALIBI, bool KROPE, bool QMEM = false, bool DESC = false>
__device__ __forceinline__ void flash_pass(LAS unsigned char* lds, int tid, const GAS bf16* Qrow, const GAS bf16* Qrow2, const GAS bf16* Kg, int ldk, const GAS bf16* K2g, const GAS bf16* Vg, int ldv,
                                           int NT, int ntw, int qrow, float slope2, f32x16 (&o)[DV / 32], float& lsum, const GAS unsigned* kn = nullptr, int abl = 0) {
    constexpr int KBUF = KLay<DK>::KBUF, VBUF = DV * VPB, QOFF = 2 * KBUF + 2 * VBUF, XOFF = QOFF + 8 * (DK / 16) * 1024;
    constexpr bool CUT = DESC && ALIBI;
    const int lane = tid & 63, r32 = lane & 31, hi = lane >> 5, wid = tid >> 6;
#define FL_TI(i) (DESC ? NT - 1 - (i) : (i))
    bf16x8 qf[QMEM ? 1 : DK / 16];
    LAS unsigned char* qlds = lds + QOFF + wid * (DK / 16) * 1024 + lane * 16;
    float qn2 = 0.f;
#pragma unroll
    for (int d0 = 0; d0 < DK / 16; ++d0) {
        bf16x8 v;
        if (KROPE && d0 >= 4) v = *(const GAS bf16x8*)(Qrow2 + 16 * (d0 - 4) + 8 * hi);
        else v = *(const GAS bf16x8*)(Qrow + 16 * d0 + 8 * hi);
        if constexpr (CUT) {
#pragma unroll
            for (int j = 0; j < 8; ++j) { const float f = __builtin_bit_cast(float, (unsigned)(unsigned short)v[j] << 16); qn2 += f * f; } }
        if constexpr (QMEM) *(LAS bf16x8*)(qlds + d0 * 1024) = v; else qf[d0] = v;
    }
    volatile LAS float* kpre = (volatile LAS float*)(lds + XOFF);
    volatile LAS unsigned* dflag = (volatile LAS unsigned*)(lds + XOFF + 512);
    float qn = 0.f;
    if constexpr (CUT) {
        qn2 += xhalf(qn2); qn = sqrtf(qn2);
        if (wid == 0) {
            float v0 = 0.f, v1 = 0.f;
            if (lane < NT) v0 = sqrtf(__builtin_bit_cast(float, kn[(size_t)lane * 16]) + __builtin_bit_cast(float, kn[(size_t)lane * 16 + 1])) * 1.01f;
            if (lane + 64 < NT) v1 = sqrtf(__builtin_bit_cast(float, kn[(size_t)(lane + 64) * 16]) + __builtin_bit_cast(float, kn[(size_t)(lane + 64) * 16 + 1])) * 1.01f;
#pragma unroll
            for (int dd = 1; dd < 64; dd <<= 1) { const float u0 = __shfl_up(v0, dd), u1 = __shfl_up(v1, dd); if (lane >= dd) { v0 = fmaxf(v0, u0); v1 = fmaxf(v1, u1); } }
            v1 = fmaxf(v1, __shfl(v0, 63));
            kpre[lane] = v0; kpre[lane + 64] = v1;
        }
    }
#pragma unroll
    for (int db = 0; db < DV / 32; ++db)
#pragma unroll
        for (int r = 0; r < 16; ++r) o[db][r] = 0.f;
    float m = -INFINITY, l = 0.f, alpha = 1.0f;
    int cut = NT;
    Stage<DK, DV, KROPE> st;
    st.loadK(tid, Kg, ldk, K2g, 64 * FL_TI(0)); st.loadV(tid, Vg, ldv, 64 * FL_TI(0));
    st.storeK(tid, lds); st.storeV(tid, lds + 2 * KBUF);
    if (NT > 1) { st.loadK(tid, Kg, ldk, K2g, 64 * FL_TI(1)); st.storeK(tid, lds + KBUF); }
    __syncthreads();
    if (NT > 2) st.loadK(tid, Kg, ldk, K2g, 64 * FL_TI(2));
    if (NT > 1) st.loadV(tid, Vg, ldv, 64 * FL_TI(1));
    f32x16 pa0, pa1, pb0, pb1;
#define FL_QKT(P0, P1, KB) do { if constexpr (QMEM) { bf16x8 qt_[DK / 16]; _Pragma("unroll") for (int d0 = 0; d0 < DK / 16; ++d0) qt_[d0] = *(const LAS bf16x8*)(qlds + d0 * 1024); qkt<DK>(P0, P1, KB, qt_, r32, hi); } else qkt<DK>(P0, P1, KB, qf, r32, hi); } while (0)
#define FL_FIRST(P0, P1, KB, TILE) do { const int kv_ = 64 * (TILE); fl_init<ALIBI>(P0, P1, slope2, kv_, hi, qrow); FL_QKT(P0, P1, KB); \
        if (CAUSAL && kv_ + 63 > qrow - r32) fl_mask(P0, P1, kv_, hi, qrow); fl_start(P0, P1, m, alpha); } while (0)
    if (FL_TI(0) < ntw) FL_FIRST(pa0, pa1, lds, FL_TI(0));
    __syncthreads();
    for (int i = 0; i < NT; ++i) {
        int tq_ = tid; asm volatile("" : "+v"(tq_));
        if (!(abl & 1)) {
            if (i + 2 < NT) st.storeK(tq_, lds + (i & 1) * KBUF);
            if (i + 1 < NT) st.storeV(tq_, lds + 2 * KBUF + ((i + 1) & 1) * VBUF);
            if (i + 3 < NT) st.loadK(tq_, Kg, ldk, K2g, 64 * FL_TI(i + 3));
            if (i + 2 < NT) st.loadV(tq_, Vg, ldv, 64 * FL_TI(i + 2)); }
        const int tc = FL_TI(i), tn = FL_TI(i + 1);
        const bool ac = tc < ntw && i < cut && !(abl & 2);
        bool an = i + 1 < NT && tn < ntw && i + 1 < cut && !(abl & 2);
        if constexpr (CUT) {
            if (ac && an) {
                const bool dead = qn * kpre[tn] + slope2 * (float)(64 * tn + 63 - qrow) < m - 64.f;
                if (__all(dead)) { cut = i + 1; an = false; } } }
        const LAS unsigned char* kn_ = lds + ((i + 1) & 1) * KBUF; const LAS unsigned char* vc_ = lds + 2 * KBUF + (i & 1) * VBUF;
        if (ac) {
            l *= alpha;
            if (__any(alpha != 1.0f)) {
#pragma unroll
                for (int db = 0; db < DV / 32; ++db) asm volatile("" : "+v"(o[db]));
#pragma unroll
                for (int db = 0; db < DV / 32; ++db)
#pragma unroll
                    for (int r = 0; r < 16; ++r) o[db][r] *= alpha;
#pragma unroll
                for (int db = 0; db < DV / 32; ++db) asm volatile("" : "+v"(o[db])); }
            bf16x8 pf[4];
            if (an) {
                const int kv1_ = 64 * tn;
                const bool diag_ = CAUSAL && (kv1_ + 63 > qrow - r32);
                fl_init<ALIBI>(pb0, pb1, slope2, kv1_, hi, qrow);
                fl_blockX<DK, QMEM>(pb0, pb1, kn_, qf, qlds, r32, hi, pa0, pa1, m, l, pf);
                if (!diag_) { fl_blockY<DV>(o, vc_, pf, r32, hi, pb0, pb1, m, alpha); }
                else { pv<DV>(o, vc_, pf, r32, hi); fl_mask(pb0, pb1, kv1_, hi, qrow); fl_start(pb0, pb1, m, alpha); }
            } else {
                fl_finish(pa0, pa1, m, l, pf); pv<DV>(o, vc_, pf, r32, hi);
            }
        } else if (an) { FL_FIRST(pb0, pb1, kn_, tn); }
        if constexpr (CUT) { if (lane == 0) dflag[(i & 1) * 8 + wid] = (i + 1 >= cut) ? 1u : 0u; }
        if (!(abl & 4)) __syncthreads();
        if constexpr (CUT) { unsigned alld = 1u;
#pragma unroll
            for (int w = 0; w < 8; ++w) alld &= dflag[(i & 1) * 8 + w];
            if (alld) break; }
        if (!(abl & 8)) { pa0 = pb0; pa1 = pb1; }
    }
#undef FL_FIRST
#undef FL_QKT
#undef FL_TI
    lsum = l + xhalf(l);
}

template <int DK, int DV, bool CAUSAL, bool ALIBI, bool KROPE, bool QMEM = false>
__device__ __forceinline__ void flash_pass_simple(LAS unsigned char* lds, int tid, const GAS bf16* Qrow, const GAS bf16* Qrow2, const GAS bf16* Kg, int ldk, const GAS bf16* K2g, const GAS bf16* Vg, int ldv,
                                           int NT, int ntw, int qrow, float slope2, f32x16 (&o)[DV / 32], float& lsum) {
    constexpr int KBUF = KLay<DK>::KBUF, VBUF = DV * VPB;
    const int lane = tid & 63, r32 = lane & 31, hi = lane >> 5;
    constexpr int QR = QMEM ? DK / 32 : DK / 16;
    bf16x8 qf[QR];
    LAS unsigned char* qlds = lds + 2 * KBUF + 2 * VBUF + (tid >> 6) * (DK / 16 - QR + 1) * 1024 + lane * 16;
#pragma unroll
    for (int d0 = 0; d0 < DK / 16; ++d0) {
        bf16x8 v;
        if (KROPE && d0 >= 4) v = *(const GAS bf16x8*)(Qrow2 + 16 * (d0 - 4) + 8 * hi);
        else v = *(const GAS bf16x8*)(Qrow + 16 * d0 + 8 * hi);
        if constexpr (!KROPE && QMEM) {
            const bf16x8 w2 = *(const GAS bf16x8*)(Qrow2 + 16 * d0 + 8 * hi); const u32x4 a4 = __builtin_bit_cast(u32x4, v), b4 = __builtin_bit_cast(u32x4, w2); u32x4 r4;
            r4.x = pk2(bflo(a4.x) + bflo(b4.x), bfhi(a4.x) + bfhi(b4.x)); r4.y = pk2(bflo(a4.y) + bflo(b4.y), bfhi(a4.y) + bfhi(b4.y));
            r4.z = pk2(bflo(a4.z) + bflo(b4.z), bfhi(a4.z) + bfhi(b4.z)); r4.w = pk2(bflo(a4.w) + bflo(b4.w), bfhi(a4.w) + bfhi(b4.w)); v = __builtin_bit_cast(bf16x8, r4); }
        if (d0 < QR) qf[d0] = v; else *(LAS bf16x8*)(qlds + (d0 - QR) * 1024) = v;
    }
#pragma unroll
    for (int db = 0; db < DV / 32; ++db)
#pragma unroll
        for (int r = 0; r < 16; ++r) o[db][r] = 0.f;
    float m = -INFINITY, l = 0.f;
    Stage<DK, DV, KROPE> st;
    st.load(tid, Kg, ldk, K2g, Vg, ldv, 0);
    st.store(tid, lds, lds + 2 * KBUF);
    __syncthreads();
    for (int t = 0; t < NT; ++t) {
        const int cur = t & 1, kv0 = 64 * t;
        if (t + 1 < NT) st.load(tid, Kg, ldk, K2g, Vg, ldv, kv0 + 64);
        if (t < ntw) {
            const LAS unsigned char* kb = lds + cur * KBUF; const LAS unsigned char* vb = lds + 2 * KBUF + cur * VBUF;
            f32x16 p0, p1;
            if (ALIBI) { const float base = slope2 * (float)(kv0 + 4 * hi - qrow);
#pragma unroll
                for (int r = 0; r < 16; ++r) { p0[r] = __builtin_fmaf(slope2, (float)((r & 3) + 8 * (r >> 2)), base); p1[r] = __builtin_fmaf(slope2, (float)(32 + (r & 3) + 8 * (r >> 2)), base); } }
            else {
#pragma unroll
                for (int r = 0; r < 16; ++r) { p0[r] = 0.f; p1[r] = 0.f; } }
            if constexpr (QMEM) qkt_qmem<DK>(p0, p1, kb, qf, qlds, r32, hi); else qkt<DK>(p0, p1, kb, qf, r32, hi);
            if (CAUSAL && kv0 + 63 > qrow - r32) {
#pragma unroll
                for (int r = 0; r < 16; ++r) { const int kv = kv0 + crow(r, hi); if (kv > qrow) p0[r] = -INFINITY; if (kv + 32 > qrow) p1[r] = -INFINITY; } }
            float mx = p0[0];
#pragma unroll
            for (int r = 1; r < 16; ++r) mx = fmaxf(mx, p0[r]);
#pragma unroll
            for (int r = 0; r < 16; ++r) mx = fmaxf(mx, p1[r]);
            mx = fmaxf(mx, xhalf(mx));
            const float mn = fmaxf(m, mx), alpha = __builtin_amdgcn_exp2f(m - mn); m = mn;
            l *= alpha;
            if (__any(alpha != 1.0f)) {
#pragma unroll
                for (int db = 0; db < DV / 32; ++db)
#pragma unroll
                    for (int r = 0; r < 16; ++r) o[db][r] *= alpha; }
            float s = 0.f;
#pragma unroll
            for (int r = 0; r < 16; ++r) { p0[r] = __builtin_amdgcn_exp2f(p0[r] - mn); p1[r] = __builtin_amdgcn_exp2f(p1[r] - mn); s += p0[r] + p1[r]; }
            l += s;
            bf16x8 pf[4]; pack_p(pf, p0, p1);
            pv<DV>(o, vb, pf, r32, hi);
        }
        if (t + 1 < NT) st.store(tid, lds + (cur ^ 1) * KBUF, lds + 2 * KBUF + (cur ^ 1) * VBUF);
        __syncthreads();
    }
    lsum = l + xhalf(l);
}


template <int DV> __device__ __forceinline__ void store_o(GAS bf16* Orow, const f32x16 (&o)[DV / 32], float sc, int hi) {
#pragma unroll
    for (int db = 0; db < DV / 32; ++db)
#pragma unroll
        for (int c = 0; c < 4; ++c) { u32x2 w; w.x = pk2(o[db][4 * c] * sc, o[db][4 * c + 1] * sc); w.y = pk2(o[db][4 * c + 2] * sc, o[db][4 * c + 3] * sc);
            *(GAS u32x2*)(Orow + 32 * db + 8 * c + 4 * hi) = w; }
}

__device__ __forceinline__ void mla_unit(LAS unsigned char* lds, int tid, int b, int h, int q0, const GAS bf16* qmla, const GAS bf16* knope, const GAS bf16* krope, const GAS bf16* vT, GAS bf16* out, int abl) {
    const int lane = tid & 63, wid = tid >> 6, r32 = lane & 31, hi = lane >> 5;
    const size_t tb = (size_t)b * 8192; const int qrow = q0 + 32 * wid + r32;
    const GAS bf16* Qr = qmla + (tb + qrow) * 768;
    f32x16 o[2]; float l;
    flash_pass<96, 64, true, false, true>(lds, tid, Qr + h * 64, Qr + 512 + h * 32, knope + tb * 512 + h * 64, 512, krope + tb * 32, vT + (size_t)(h * 64) * 16384 + tb, 16384,
                                          q0 / 64 + 4, (q0 + 32 * wid + 31) / 64 + 1, qrow, 0.f, o, l, nullptr, abl);
    if (abl == 0 || l == 12345.678f) store_o<64>(out + (tb + qrow) * 1024 + h * 64, o, 1.0f / l, hi);
}
__device__ __forceinline__ void cross_unit(LAS unsigned char* lds, int tid, int b, int h, int q0, const GAS bf16* qx, const GAS bf16* xk, const GAS bf16* xvT, GAS bf16* out) {
    const int lane = tid & 63, wid = tid >> 6, r32 = lane & 31, hi = lane >> 5;
    const size_t tb = (size_t)b * 8192; const int qrow = q0 + 32 * wid + r32;
    f32x16 o[4]; float l;
    int nt = 4; asm volatile("" : "+s"(nt));
    flash_pass_simple<128, 128, false, false, false, true>(lds, tid, qx + (tb + qrow) * 512 + h * 128, qx + (size_t)16384 * 512 + (tb + qrow) * 512 + h * 128, xk + (size_t)(b * 256) * 512 + h * 128, 512, nullptr, xvT + (size_t)(h * 128) * 512 + b * 256, 512,
                                              nt, nt, qrow, 0.f, o, l);
    store_o<128>(out + (tb + qrow) * 512 + h * 128, o, 1.0f / l, hi);
}
__device__ __forceinline__ void diff_unit(LAS unsigned char* lds, int tid, int b, int h, int hf, int q0, const GAS bf16* dq, const GAS bf16* dk, const GAS bf16* vT, GAS bf16* out, int ldo, const GAS unsigned* knl, int abl) {
    const int lane = tid & 63, wid = tid >> 6, r32 = lane & 31, hi = lane >> 5;
    const size_t tb = (size_t)b * 8192; const int qrow = q0 + 32 * wid + r32;
    const float slope2 = __builtin_amdgcn_exp2f(-2.0f * (float)(h + 1)) * 1.4426950408889634f;
    const int NT = q0 / 64 + 4, ntw = (q0 + 32 * wid + 31) / 64 + 1;
    f32x16 o[4]; float l;
    flash_pass<64, 128, true, true, false, true, true>(lds, tid, dq + (tb + qrow) * 512 + h * 128 + hf * 64, nullptr, dk + tb * 512 + h * 128 + hf * 64, 512, nullptr, vT + (size_t)(512 + h * 128) * 16384 + tb, 16384,
                                                      NT, ntw, qrow, slope2, o, l, knl + ((size_t)(b * 128) * 8 + 2 * h + hf) * 2, abl);
    if (abl == 0 || l == 12345.678f) store_o<128>(out + (tb + qrow) * (size_t)ldo + h * 128, o, 1.0f / l, hi);
}
__device__ __forceinline__ void diff_lambda(const GAS float* lp, int layer, float& lam, float& post) {
    float q1 = 0.f, q2 = 0.f;
    for (int i = 0; i < 64; ++i) { q1 += lp[i] * lp[64 + i]; q2 += lp[128 + i] * lp[192 + i]; }
    const float lam_init = (layer == 0) ? 0.2f : 0.35550906759f;
    lam = expf(q1) - expf(q2) + lam_init; post = 1.f - lam_init;
}
__device__ __forceinline__ void diff_combine4(int item0, int stride, int lane, GAS bf16* o0, const GAS bf16* o1, float lam, float post, const GAS float* subln) {
    unsigned a[4], c[4]; size_t off[4];
#pragma unroll
    for (int k = 0; k < 4; ++k) { const int item = item0 + k * stride; off[k] = (size_t)(item >> 2) * 1024 + (item & 3) * 128 + 2 * lane;
        a[k] = *(const GAS unsigned*)(o0 + off[k]); c[k] = *(const GAS unsigned*)(o1 + (size_t)item * 128 + 2 * lane); }
    const f32x2v g = *(const GAS f32x2v*)(subln + 2 * lane);
#pragma unroll
    for (int k = 0; k < 4; ++k) {
        const float x = bflo(a[k]) - lam * bflo(c[k]), y = bfhi(a[k]) - lam * bfhi(c[k]);
        float s2 = x * x + y * y;
#pragma unroll
        for (int dd = 1; dd < 64; dd <<= 1) s2 += __shfl_xor(s2, dd);
        const float rs = __builtin_amdgcn_rsqf(s2 * (1.f / 128.f) + 1e-6f) * post;
        *(GAS unsigned*)(o0 + off[k]) = pk2(x * rs * g[0], y * rs * g[1]); }
}
__device__ __forceinline__ void sb_unit(LAS unsigned char* lds, int tid, int b, int h, int q0, const GAS bf16* sq, const GAS bf16* sk, const GAS bf16* vT, GAS bf16* out) {
    constexpr int KBUF = KLay<64>::KBUF, VBUF = 64 * VPB;
    const int lane = tid & 63, wid = tid >> 6, r32 = lane & 31, hi = lane >> 5;
    const size_t tb = (size_t)b * 8192; const int qrow = q0 + 32 * wid + r32;
    const GAS bf16* Kg = sk + tb * 512 + h * 64; const GAS bf16* Vg = vT + (size_t)(h * 64) * 16384 + tb;
    const int NT = q0 / 64 + 4, ntw = (q0 + 32 * wid + 30) / 64 + 1;
    bf16x8 qf[4];
#pragma unroll
    for (int d0 = 0; d0 < 4; ++d0) qf[d0] = *(const GAS bf16x8*)(sq + (tb + qrow) * 512 + h * 64 + 16 * d0 + 8 * hi);
    f32x16 o[2];
#pragma unroll
    for (int r = 0; r < 16; ++r) { o[0][r] = 0.f; o[1][r] = 0.f; }
    float R = 1.0f;
    volatile LAS unsigned* dflag = (volatile LAS unsigned*)(lds + 4 * KBUF + 1024);
    Stage<64, 64, false> st;
    st.load(tid, Kg, 512, nullptr, Vg, 16384, 64 * (NT - 1));
    st.store(tid, lds, lds + 2 * KBUF);
    __syncthreads();
    for (int i = 0; i < NT; ++i) {
        const int t = NT - 1 - i, cur = i & 1, kv0 = 64 * t;
        if (t > 0) st.load(tid, Kg, 512, nullptr, Vg, 16384, kv0 - 64);
        if (t < ntw && __any(R != 0.f)) {
            const LAS unsigned char* kb = lds + cur * KBUF; const LAS unsigned char* vb = lds + 2 * KBUF + cur * VBUF;
            f32x16 k0, k1;
#pragma unroll
            for (int r = 0; r < 16; ++r) { k0[r] = 0.f; k1[r] = 0.f; }
            qkt<64>(k0, k1, kb, qf, r32, hi);
            f32x16 b0, b1;
#pragma unroll
            for (int r = 0; r < 16; ++r) {
                const float e0 = __builtin_amdgcn_exp2f(fminf(k0[r], 115.f)), e1 = __builtin_amdgcn_exp2f(fminf(k1[r], 115.f));
                const float r0 = __builtin_amdgcn_rcpf(1.f + e0), r1 = __builtin_amdgcn_rcpf(1.f + e1);
                k0[r] = r0; b0[r] = e0 * r0; k1[r] = r1; b1[r] = e1 * r1; }
            if (kv0 + 63 >= qrow - r32) {
                const int thr = qrow - kv0 - 4 * hi;
#pragma unroll
                for (int r = 0; r < 16; ++r) { const int c = (r & 3) + 8 * (r >> 2); if (c >= thr) { k0[r] = 1.f; b0[r] = 0.f; } if (c + 32 >= thr) { k1[r] = 1.f; b1[r] = 0.f; } } }
            float gp[8], go[8];
#pragma unroll
            for (int c = 0; c < 4; ++c) { gp[c] = (k0[4 * c] * k0[4 * c + 1]) * (k0[4 * c + 2] * k0[4 * c + 3]); gp[4 + c] = (k1[4 * c] * k1[4 * c + 1]) * (k1[4 * c + 2] * k1[4 * c + 3]); }
#pragma unroll
            for (int g = 0; g < 8; ++g) go[g] = xhalf(gp[g]);
            float sp = R;
#pragma unroll
            for (int g = 7; g >= 0; --g) {
                float s = sp * (hi ? 1.0f : go[g]);
                if (g >= 4) { const int c = g - 4;
                    b1[4 * c + 3] *= s; s *= k1[4 * c + 3]; b1[4 * c + 2] *= s; s *= k1[4 * c + 2]; b1[4 * c + 1] *= s; s *= k1[4 * c + 1]; b1[4 * c] *= s; }
                else { const int c = g;
                    b0[4 * c + 3] *= s; s *= k0[4 * c + 3]; b0[4 * c + 2] *= s; s *= k0[4 * c + 2]; b0[4 * c + 1] *= s; s *= k0[4 * c + 1]; b0[4 * c] *= s; }
                sp *= gp[g] * go[g];
            }
            R = sp;
            bf16x8 pf[4]; pack_p(pf, b0, b1);
            pv<64>(o, vb, pf, r32, hi);
        }
        if (t > 0) st.store(tid, lds + (cur ^ 1) * KBUF, lds + 2 * KBUF + (cur ^ 1) * VBUF);
        if (lane == 0) dflag[(i & 1) * 8 + wid] = (t < ntw && !__any(R != 0.f)) ? 1u : 0u;
        __syncthreads();
        { unsigned alld = 1u;
#pragma unroll
          for (int w = 0; w < 8; ++w) alld &= dflag[(i & 1) * 8 + w];
          if (alld) break; }
    }
    store_o<64>(out + (tb + qrow) * 1024 + h * 64, o, 1.0f, hi);
}
}
typedef unsigned short bf16;
typedef float f32x4 __attribute__((ext_vector_type(4)));
typedef unsigned u32x4 __attribute__((ext_vector_type(4)));
typedef unsigned u32x2 __attribute__((ext_vector_type(2)));
constexpr int NWAVES = 8, NTHREADS = 512;
constexpr int M = 16384, D = 1024, SEQ = 8192, DEPTH = 2, IN_COLS = 6688;
constexpr int SROWS = 40960;
constexpr size_t MiB = 1u << 20;
constexpr size_t WS_CTL = 0, CTL_ZERO_BYTES = 128 * 1024;
constexpr size_t WS_SSQ = 1 * MiB;
constexpr size_t WS_SSQCQ = 2 * MiB, WS_SSQCKV = WS_SSQCQ + 256 * 1024, WS_SSQMEM = WS_SSQCKV + 256 * 1024;
constexpr size_t WS_TOKE = 3 * MiB, WS_TOKW = WS_TOKE + 128 * 1024, WS_HIST = WS_TOKW + 128 * 1024, WS_SLOT = WS_HIST + 64 * 1024;
constexpr size_t WS_STOK = 4 * MiB, WS_SW = WS_STOK + 256 * 1024, WS_SRSTD = WS_SW + 256 * 1024;
constexpr size_t WS_WR = 5 * MiB;
constexpr size_t WS_WRH = 5 * MiB + 256 * 1024, WS_WRL = WS_WRH + 128 * 1024;
constexpr size_t WS_MEMN = 6 * MiB, WS_XK = 7 * MiB, WS_XVT = WS_XK + 512 * 1024;
constexpr size_t WS_WIN = 8 * MiB;
constexpr size_t WS_WV = WS_WIN + (size_t)2816 * 1024 * 2;
constexpr size_t WS_WG = WS_WV + 2 * MiB;
constexpr size_t WS_WUQ = WS_WG + 6 * MiB;
constexpr size_t WS_WUKN = WS_WUQ + 768 * 256 * 2;
constexpr size_t WS_WUV = WS_WUKN + 512 * 256 * 2;
constexpr size_t WS_WB = WS_WUV + 512 * 256 * 2;
constexpr size_t WS_WOUT = WS_WB + 4 * MiB;
constexpr size_t WS_WXQ = WS_WOUT + 2 * MiB;
constexpr size_t WS_WXK = WS_WXQ + 1 * MiB, WS_WXV = WS_WXK + 1 * MiB;
constexpr size_t WS_WXO = WS_WXV + 1 * MiB;
constexpr size_t WS_WGU = WS_WXO + 1 * MiB;
constexpr size_t WS_WD = WS_WGU + 32 * MiB;
constexpr size_t WS_WEND = WS_WD + 16 * MiB;
static_assert(WS_WEND <= 81 * MiB, "weights");
constexpr size_t WS_XB = 81 * MiB;
constexpr size_t R0 = 113 * MiB;
constexpr size_t WS_CQ = R0, WS_CKV = R0 + 8 * MiB, WS_KROPE = R0 + 16 * MiB, WS_QK = R0 + 18 * MiB  , WS_VT = R0 + 82 * MiB  ;
constexpr size_t WS_QMLA = R0 + 114 * MiB, WS_KNOPE = R0 + 138 * MiB, WS_VMLAT = R0 + 154 * MiB, WS_OABC = R0 + 170 * MiB  ;
constexpr size_t WS_GSCR = R0, WS_MB = R0 + 96 * MiB;
constexpr size_t WS_QX = R0, WS_OX = R0 + 32 * MiB;
constexpr size_t WS_XG = R0, WS_ACT = R0 + 80 * MiB, WS_Y = R0 + 100 * MiB;
constexpr size_t WS_END = R0 + 234 * MiB;
static_assert(WS_MB + 32 * MiB <= WS_OABC && WS_Y + 80 * MiB <= WS_END && WS_OABC + 64 * MiB <= WS_END, "region map");
constexpr int CW_BAR = 1024, CW_Q = 8192, CW_KN = 16384;
constexpr int RING_BYTES = 131072, LDSCTL_OFF = RING_BYTES, MISC_OFF = LDSCTL_OFF + 320, TSTART_OFF = LDSCTL_OFF + 1024, HIST_OFF = LDSCTL_OFF + 2048;
constexpr int LDS_BYTES = 147456;

#define LDS_WAIT() asm volatile("s_waitcnt lgkmcnt(0)" ::: "memory")
__device__ __forceinline__ float wave_sum(float v) {
#pragma unroll
    for (int o = 1; o < 64; o <<= 1) v += __shfl_xor(v, o);
    return v;
}
__device__ __forceinline__ unsigned pk2(float lo, float hi) { return pg8::pk2(lo, hi); }
__device__ __forceinline__ int lane_id() { int r; asm volatile("v_mbcnt_lo_u32_b32 %0, -1, 0\n\tv_mbcnt_hi_u32_b32 %0, -1, %0" : "=v"(r)); return r; }
#define XB_TMO      128
#define XB_XCNT(j)  (256  + 64 * (j))
#define XB_XSUB(j)  (1280 + 64 * (j))
#define XB_XGEN(j)  (2304 + 64 * (j))
#define XB_TOP      3328
#define XB_TOPGEN   3392
#define XCD_BAR_WORDS 3456
#define XB_SPIN_CAP (1u << 18)

__device__ __forceinline__ unsigned xb_ld(unsigned* p)              { return __hip_atomic_load(p, __ATOMIC_RELAXED, __HIP_MEMORY_SCOPE_AGENT); }
__device__ __forceinline__ unsigned xb_add(unsigned* p, unsigned v) { return __hip_atomic_fetch_add(p, v, __ATOMIC_RELAXED, __HIP_MEMORY_SCOPE_AGENT); }
__device__ __forceinline__ unsigned xb_xcc_id() { return (unsigned)__builtin_amdgcn_s_getreg((3 << 11) | 20) & 0xFu; }
#define XB_SPIN(cond, bar) do { unsigned _sp = 0; while (cond) { __builtin_amdgcn_s_sleep(1); \
    if ((++_sp & 255u) == 0u) { if (xb_ld(&(bar)[XB_TMO])) break; if (_sp > XB_SPIN_CAP) { atomicAdd(&(bar)[XB_TMO], 1u); break; } } } } while (0)

struct XcdBarrier {
    unsigned* bar; unsigned x; int wid;
    volatile LAS unsigned* st;
};

__device__ __forceinline__ XcdBarrier xcd_barrier_post(unsigned* bar, volatile LAS unsigned* st, int wid) {
    XcdBarrier b; b.bar = bar; b.x = xb_xcc_id(); b.st = st; b.wid = wid;
    if (wid == 0 && lane_id() == 0) (void)xb_add(&bar[XB_XCNT(b.x)], 1u);
    return b;
}
__device__ __forceinline__ void xcd_barrier_complete(unsigned* bar, unsigned x, unsigned& nloc, unsigned& nx) {
    const unsigned G = gridDim.x * gridDim.y * gridDim.z;
    unsigned sum, cnt, mine, sp = 0u;
    for (;;) {
        sum = 0u; cnt = 0u; mine = 0u;
#pragma unroll 1
        for (unsigned j = 0; j < 16; ++j) { const unsigned c = xb_ld(&bar[XB_XCNT(j)]); sum += c; cnt += (c > 0u) ? 1u : 0u; mine = (j == x) ? c : mine; }
        if (sum == G) break;
        __builtin_amdgcn_s_sleep(1);
        if ((++sp & 255u) == 0u) { if (xb_ld(&bar[XB_TMO])) break; if (sp > XB_SPIN_CAP) { atomicAdd(&bar[XB_TMO], 1u); break; } }
    }
    nloc = mine > 0u ? mine : 1u; nx = cnt > 0u ? cnt : 1u;
}

__device__ __forceinline__ void xcd_barrier(const XcdBarrier& b) {
    asm volatile("s_waitcnt vmcnt(0)" ::: "memory");
    __syncthreads();
    if (b.wid == 0 && lane_id() == 0) {
        unsigned* bar = b.bar; asm volatile("" : "+s"(bar));
        __builtin_amdgcn_s_waitcnt(0);
        unsigned nloc = b.st[0], nx = b.st[1];
        if (nloc == 0u) { xcd_barrier_complete(bar, b.x, nloc, nx); b.st[0] = nloc; b.st[1] = nx; }
        const unsigned old = xb_add(&bar[XB_XSUB(b.x)], 1u);
        const unsigned gen = old / nloc;
        if (old + 1u == (gen + 1u) * nloc) {
            __builtin_amdgcn_fence(__ATOMIC_RELEASE, "agent");
            asm volatile("s_waitcnt vmcnt(0)" ::: "memory");
            const unsigned og = xb_add(&bar[XB_TOP], 1u);
            const unsigned tg = og / nx;
            if (og + 1u == (tg + 1u) * nx) xb_add(&bar[XB_TOPGEN], 1u);
            else XB_SPIN(xb_ld(&bar[XB_TOPGEN]) == tg, bar);
            __builtin_amdgcn_fence(__ATOMIC_ACQUIRE, "agent");
            xb_add(&bar[XB_XGEN(b.x)], 1u);
            asm volatile("s_waitcnt vmcnt(0)" ::: "memory");
        } else {
            XB_SPIN(xb_ld(&bar[XB_XGEN(b.x)]) == gen, bar);
            __builtin_amdgcn_fence(__ATOMIC_ACQUIRE, "agent");
            asm volatile("s_waitcnt vmcnt(0)" ::: "memory");
        }
    }
    __syncthreads();
}
struct TrJob { const GAS float* src; const GAS float* gain; GAS bf16* dst; int ldn, col0, k0, K, row0, dk; };
__device__ __forceinline__ void tr_load(const TrJob& j, f32x4 (&v)[8], int lane) {
    const int kr = lane >> 3, nq = lane & 7;
    if (j.col0 >= 0) {
#pragma unroll
        for (int i = 0; i < 8; ++i) v[i] = *(const GAS f32x4*)(j.src + (size_t)(j.k0 + 8 * i + kr) * j.ldn + j.col0 + 4 * nq);
    } else {
#pragma unroll
        for (int i = 0; i < 8; ++i) v[i] = (f32x4){0.f, 0.f, 0.f, 0.f};
    }
}
__device__ __forceinline__ void tr_finish(const TrJob& j, const f32x4 (&v)[8], LAS float* scr, int lane) {
    const int kr = lane >> 3, nq = lane & 7;
#pragma unroll
    for (int i = 0; i < 8; ++i) { const int kk = 8 * i + kr; const float g = j.gain ? j.gain[j.k0 + kk] : 1.f; LAS float* s = scr + kk * 33 + 4 * nq;
        s[0] = v[i][0] * g; s[1] = v[i][1] * g; s[2] = v[i][2] * g; s[3] = v[i][3] * g; }
    LDS_WAIT(); asm volatile("" ::: "memory");
    const int c = lane & 7;
#pragma unroll
    for (int q = 0; q < 4; ++q) { const int n = (lane >> 3) + 8 * q; const LAS float* s = scr + (8 * c) * 33 + n;
        u32x4 o; o.x = pk2(s[0 * 33], s[1 * 33]); o.y = pk2(s[2 * 33], s[3 * 33]); o.z = pk2(s[4 * 33], s[5 * 33]); o.w = pk2(s[6 * 33], s[7 * 33]);
        *(GAS u32x4*)(j.dst + (size_t)(j.row0 + n) * j.K + j.dk + j.k0 + 8 * c) = o; }
    LDS_WAIT(); asm volatile("" ::: "memory");
}
__device__ __forceinline__ void row_to_bf16(const GAS float* xrow, GAS bf16* orow, GAS float* ssq16, int lane) {
    const GAS f32x4* xr = (const GAS f32x4*)xrow + lane; f32x4 v[4]; float s = 0.f;
#pragma unroll
    for (int j = 0; j < 4; ++j) { v[j] = xr[64 * j]; s += (v[j][0] * v[j][0] + v[j][1] * v[j][1]) + (v[j][2] * v[j][2] + v[j][3] * v[j][3]); }
    s = wave_sum(s);
    GAS u32x2* o8 = (GAS u32x2*)orow + lane;
#pragma unroll
    for (int j = 0; j < 4; ++j) { u32x2 w; w.x = pk2(v[j][0], v[j][1]); w.y = pk2(v[j][2], v[j][3]); o8[64 * j] = w; }
    if (lane < 16) ssq16[lane] = (lane == 0) ? s : 0.f;
}

struct Args { const float* in[26]; float* out; unsigned char* ws; };
__device__ __forceinline__ int opq(int i) { asm volatile("" : "+s"(i)); return i; }
__device__ __forceinline__ GAS unsigned char* opqp(unsigned char* p0) { GAS unsigned char* p = (GAS unsigned char*)p0; asm volatile("" : "+s"(p)); return p; }
#define INP(i) ((const GAS float*)args.in[opq(i)])
#define WSB(off) (opqp(args.ws) + (off))
#define X_IN INP(0)
#define OUTP ((GAS float*)args.out)
#define XB ((GAS bf16*)WSB(WS_XB))
#define SSQ ((GAS float*)WSB(WS_SSQ))
#define SSQCQ ((GAS float*)WSB(WS_SSQCQ))
#define SSQCKV ((GAS float*)WSB(WS_SSQCKV))
#define SSQMEM ((GAS float*)WSB(WS_SSQMEM))
#define MEMN ((GAS bf16*)WSB(WS_MEMN))
#define XK ((GAS bf16*)WSB(WS_XK))
#define XVT ((GAS bf16*)WSB(WS_XVT))
#define WIN ((GAS bf16*)WSB(WS_WIN))
#define WV ((GAS bf16*)WSB(WS_WV))
#define WG ((GAS bf16*)WSB(WS_WG))
#define WUQ ((GAS bf16*)WSB(WS_WUQ))
#define WUKN ((GAS bf16*)WSB(WS_WUKN))
#define WUV ((GAS bf16*)WSB(WS_WUV))
#define WB ((GAS bf16*)WSB(WS_WB))
#define WOUT ((GAS bf16*)WSB(WS_WOUT))
#define WXQ ((GAS bf16*)WSB(WS_WXQ))
#define WXK ((GAS bf16*)WSB(WS_WXK))
#define WXV ((GAS bf16*)WSB(WS_WXV))
#define WXO ((GAS bf16*)WSB(WS_WXO))
#define WGU ((GAS bf16*)WSB(WS_WGU))
#define WD ((GAS bf16*)WSB(WS_WD))
#define WRH ((GAS bf16*)WSB(WS_WRH))
#define WRL ((GAS bf16*)WSB(WS_WRL))
#define CQ ((GAS bf16*)WSB(WS_CQ))
#define CKV ((GAS bf16*)WSB(WS_CKV))
#define KROPE ((GAS bf16*)WSB(WS_KROPE))
#define QK ((GAS bf16*)WSB(WS_QK))
#define VT ((GAS bf16*)WSB(WS_VT))
#define QMLA ((GAS bf16*)WSB(WS_QMLA))
#define KNOPE ((GAS bf16*)WSB(WS_KNOPE))
#define VMLAT ((GAS bf16*)WSB(WS_VMLAT))
#define OABC ((GAS bf16*)WSB(WS_OABC))
#define GSCR ((GAS bf16*)WSB(WS_GSCR))
#define MB ((GAS bf16*)WSB(WS_MB))
#define QX ((GAS bf16*)WSB(WS_QX))
#define OX ((GAS bf16*)WSB(WS_OX))
#define XG ((GAS bf16*)WSB(WS_XG))
#define ACT ((GAS bf16*)WSB(WS_ACT))
#define YB ((GAS bf16*)WSB(WS_Y))
#define TOKE ((GAS int*)WSB(WS_TOKE))
#define TOKW ((GAS float*)WSB(WS_TOKW))
#define HIST ((GAS int*)WSB(WS_HIST))
#define SLOT ((GAS int*)WSB(WS_SLOT))
#define STOK ((GAS int*)WSB(WS_STOK))
#define SW ((GAS float*)WSB(WS_SW))
#define SRSTD ((GAS float*)WSB(WS_SRSTD))


__global__ void __launch_bounds__(NTHREADS, 2) fwd(Args args) {
    extern __shared__ __attribute__((aligned(16))) unsigned char lds_raw[];
    LAS unsigned char* lds = (LAS unsigned char*)lds_raw;
    volatile LAS unsigned* MISC = (volatile LAS unsigned*)(lds + MISC_OFF);
    LAS int* TSTART = (LAS int*)(lds + TSTART_OFF);
    const int tid0 = threadIdx.x; const int wv = __builtin_amdgcn_readfirstlane(tid0 >> 6);
#define PH_BEGIN int tid_ = wv * 64 + lane_id(); asm volatile("" : "+v"(tid_)); const int tid = tid_, lane = tid & 63, wave = wv, gw = vcu * NWAVES + wave; (void)lane; (void)gw
    const int G = gridDim.x, bx = blockIdx.x, vcu = (G % 8 == 0) ? (bx % 8) * (G / 8) + bx / 8 : bx;
    unsigned* ctl = (unsigned*)(void*)(args.ws + WS_CTL);
    for (int u = tid0; u < (LDS_BYTES - LDSCTL_OFF) / 4; u += NTHREADS) ((LAS unsigned*)(lds + LDSCTL_OFF))[u] = 0u;
    __syncthreads();
    XcdBarrier bar = xcd_barrier_post(ctl + CW_BAR, MISC + 8, wv);
    const int NGW = G * NWAVES;

    constexpr float L2E = 1.4426950408889634f;

    constexpr int I_IN = 88 * 16, I_V = 32 * 16, I_G = 96 * 16, I_UQ = 24 * 4, I_UK = 16 * 4, I_B = 3 * 32 * 8, I_O = 32 * 16, I_XQ = 16 * 16, I_XO = 32 * 8, I_GU = 512 * 16, I_D = 1024 * 4;
    constexpr int NITEMS = I_IN + I_V + I_G + I_UQ + 2 * I_UK + I_B + I_O + 3 * I_XQ + I_XO + I_GU + I_D, NITEMS_P0 = NITEMS - I_GU - I_D;
    for (int l = 0; l < DEPTH; ++l) {
        for (int rp_ = 0; rp_ < RP_P0; ++rp_) {
#if PH_P0
        { PH_BEGIN;
            LAS float* scr = (LAS float*)(lds + wave * 16384);
#define w_in (INP(3) + (size_t)l * D * IN_COLS)
#define g_attn (INP(2) + l * D)
#define w_uq (INP(5) + (size_t)l * 256 * 768)
#define g_q (INP(4) + l * 256)
#define w_ukv (INP(7) + (size_t)l * 256 * 1024)
#define g_kv (INP(6) + l * 256)
#define w_br (INP(10) + (size_t)l * 3 * 512 * 1024)
#define w_out (INP(11) + (size_t)l * D * D)
#define g_cross (INP(12) + l * D)
#define g_mem (INP(13))
#define w_xq (INP(14) + (size_t)l * D * 512)
#define w_xkv (INP(15) + (size_t)l * D * 1024)
#define w_xo (INP(16) + (size_t)l * 512 * D)
#define g_ffn (INP(17) + l * D)
#define w_eg (INP(22) + (size_t)l * 32 * D * 256)
#define w_eu (INP(23) + (size_t)l * 32 * D * 256)
#define w_ed (INP(24) + (size_t)l * 32 * 256 * D)
#define TR_DECODE(itx) do { int r = (itx); \
                if (r < I_IN) { const int nb = r >> 4, kb = r & 15, n0 = nb * 32; int col; \
                    if (n0 < 544) col = 3072 + n0; else if (n0 < 768) col = -1; else if (n0 < 1792) col = 3616 + (n0 - 768); else col = 5152 + (n0 - 1792); \
                    jb = TrJob{w_in, g_attn, WIN, IN_COLS, col, kb * 64, 1024, n0, 0}; break; } r -= I_IN; \
                if (r < I_V) { const int nb = r >> 4, kb = r & 15, n0 = nb * 32; const int col = n0 < 512 ? 4640 + n0 : 6176 + (n0 - 512); \
                    jb = TrJob{w_in, g_attn, WV, IN_COLS, col, kb * 64, 1024, n0, 0}; break; } r -= I_V; \
                if (r < I_G) { const int nb = r >> 4, kb = r & 15; jb = TrJob{w_in, g_attn, WG, IN_COLS, nb * 32, kb * 64, 1024, nb * 32, 0}; break; } r -= I_G; \
                if (r < I_UQ) { const int nb = r >> 2, kb = r & 3, n0 = nb * 32; const int col = n0 < 512 ? 96 * (n0 >> 6) + (n0 & 63) : 96 * ((n0 - 512) >> 5) + 64; \
                    jb = TrJob{w_uq, g_q, WUQ, 768, col, kb * 64, 256, n0, 0}; break; } r -= I_UQ; \
                if (r < I_UK) { const int nb = r >> 2, kb = r & 3, n0 = nb * 32; jb = TrJob{w_ukv, g_kv, WUKN, 1024, 128 * (n0 >> 6) + (n0 & 63), kb * 64, 256, n0, 0}; break; } r -= I_UK; \
                if (r < I_UK) { const int nb = r >> 2, kb = r & 3, n0 = nb * 32; jb = TrJob{w_ukv, g_kv, WUV, 1024, 128 * (n0 >> 6) + 64 + (n0 & 63), kb * 64, 256, n0, 0}; break; } r -= I_UK; \
                if (r < I_B) { const int z = r / 256, q = r % 256, nb = q >> 3, kb = q & 7; jb = TrJob{w_br + (size_t)z * 512 * 1024, nullptr, WB + (size_t)(z >> 1) * 1024 * 1024, 1024, nb * 32, kb * 64, 1024, nb * 32, (z & 1) * 512}; break; } r -= I_B; \
                if (r < I_O) { const int nb = r >> 4, kb = r & 15; jb = TrJob{w_out, nullptr, WOUT, 1024, nb * 32, kb * 64, 1024, nb * 32, 0}; break; } r -= I_O; \
                if (r < I_XQ) { const int nb = r >> 4, kb = r & 15; jb = TrJob{w_xq, g_cross, WXQ, 512, nb * 32, kb * 64, 1024, nb * 32, 0}; break; } r -= I_XQ; \
                if (r < I_XQ) { const int nb = r >> 4, kb = r & 15; jb = TrJob{w_xkv, g_mem, WXK, 1024, nb * 32, kb * 64, 1024, nb * 32, 0}; break; } r -= I_XQ; \
                if (r < I_XQ) { const int nb = r >> 4, kb = r & 15; jb = TrJob{w_xkv, g_mem, WXV, 1024, 512 + nb * 32, kb * 64, 1024, nb * 32, 0}; break; } r -= I_XQ; \
                if (r < I_XO) { const int nb = r >> 3, kb = r & 7; jb = TrJob{w_xo, nullptr, WXO, 1024, nb * 32, kb * 64, 512, nb * 32, 0}; break; } r -= I_XO; \
                if (r < I_GU) { const int nb = r >> 4, kb = r & 15, n0 = nb * 32, e = n0 >> 9, rr = n0 & 511, t = rr >> 8, j = rr & 255; \
                    const GAS float* src = (j < 128 ? w_eg : w_eu) + (size_t)e * D * 256; jb = TrJob{src, g_ffn, WGU, 256, 128 * t + (j & 127), kb * 64, 1024, n0, 0}; break; } r -= I_GU; \
                { const int nb = r >> 2, kb = r & 3, n0 = nb * 32, e = n0 >> 10; jb = TrJob{w_ed + (size_t)e * 256 * 1024, nullptr, WD, 1024, n0 & 1023, kb * 64, 256, n0, 0}; } } while (0)
            for (int it = gw; it < NITEMS_P0; it += NGW) {
                TrJob jb{};
                TR_DECODE(it);
                f32x4 va[8];
                tr_load(jb, va, lane);
                tr_finish(jb, va, scr, lane);
            }
            { const GAS float* wrg = INP(18) + (size_t)l * D * 4; const GAS float* wre = INP(20) + (size_t)l * D * 32; GAS bf16* wh = WRH; GAS bf16* wl = WRL;
              for (int i = bx * NTHREADS + tid; i < 48 * 1024; i += G * NTHREADS) { const int c = i >> 10, k = i & 1023;
                  const float w = c < 36 ? (c < 4 ? wrg[k * 4 + c] : wre[k * 32 + (c - 4)]) * g_ffn[k] : 0.f; const unsigned h = pk2(w, 0.f) & 0xffffu;
                  wh[i] = (bf16)h; wl[i] = (bf16)(pk2(w - __builtin_bit_cast(float, h << 16), 0.f) & 0xffffu); } }
            if (l == 0) {
                for (int m = gw; m < M; m += NGW) row_to_bf16(X_IN + (size_t)m * D, XB + (size_t)m * D, SSQ + (size_t)m * 16, lane);
                for (int m = gw; m < 512; m += NGW) row_to_bf16(INP(1) + (size_t)m * D, MEMN + (size_t)m * D, SSQMEM + (size_t)m * 16, lane);
            }
        }
#endif
        xcd_barrier(bar);
        }
                for (int rp_ = 0; rp_ < RP_A; ++rp_) {
#if PH_A
        {
            { pg8::Gemm g{XB, WIN, M, 2816, D, D, nullptr}; pg8::StaticOrder S; S.init(M, 2816, G, bx);
              pg8::EpiA E{SSQ, CQ, CKV, KROPE, QK, SSQCQ, SSQCKV, 0.125f * L2E, (GAS unsigned*)(opqp(args.ws) + WS_CTL) + CW_KN + l * 4096};
              pg8::gemm_phase<pg8::EpiA, pg8::StaticOrder, true, true>(lds, g, S, E, wv); }
            { pg8::Gemm g{WV, XB, 1024, M, D, D, nullptr}; pg8::StaticOrder S; S.init(1024, M, G, (bx + 64) % G);
              pg8::EpiVT E{VT, M, SSQ, 4, 1.f / 1024.f};
              pg8::gemm_phase<pg8::EpiVT, pg8::StaticOrder, true, true>(lds, g, S, E, wv); }
            { pg8::Gemm g{MEMN, WXK, 512, 512, D, D, nullptr}; pg8::StaticOrder S; S.init(512, 512, G, (bx + 8) % G);
              pg8::EpiRS E{XK, 512, SSQMEM, 4, 1.f / 1024.f, 1.f, 0xffff, 31, 0};
              pg8::gemm_phase<pg8::EpiRS, pg8::StaticOrder, true, true>(lds, g, S, E, wv); }
            { pg8::Gemm g{WXV, MEMN, 512, 512, D, D, nullptr}; pg8::StaticOrder S; S.init(512, 512, G, (bx + 16) % G);
              pg8::EpiVT E{XVT, 512, SSQMEM, 4, 1.f / 1024.f};
              pg8::gemm_phase<pg8::EpiVT, pg8::StaticOrder, true, true>(lds, g, S, E, wv); }
        }
#endif
        xcd_barrier(bar);
        }
                for (int rp_ = 0; rp_ < RP_B; ++rp_) {
#if PH_B
        {
#if PH_B1
            { pg8::Gemm g{CQ, WUQ, M, 768, opq(256), opq(256), nullptr}; pg8::StaticOrder S; S.init(M, 768, G, bx);
              pg8::EpiQ E{QMLA, SSQCQ, 0.10206207261596577f * L2E};
              pg8::gemm_phase<pg8::EpiQ, pg8::StaticOrder, true, true>(lds, g, S, E, wv); }
#endif
#if PH_B2
            { pg8::Gemm g{CKV, WUKN, M, 512, opq(256), opq(256), nullptr}; pg8::StaticOrder S; S.init(M, 512, G, (bx + 64) % G);
              pg8::EpiRS E{KNOPE, 512, SSQCKV, 1, 1.f / 256.f, 1.f, 0xffff, 31, 0};
              pg8::gemm_phase<pg8::EpiRS, pg8::StaticOrder, true, true>(lds, g, S, E, wv); }
#endif
#if PH_B3
            { pg8::Gemm g{WUV, CKV, 512, M, opq(256), opq(256), nullptr}; pg8::StaticOrder S; S.init(512, M, G, (bx + 128) % G);
              pg8::EpiVT E{VMLAT, M, SSQCKV, 1, 1.f / 256.f};
              pg8::gemm_phase<pg8::EpiVT, pg8::StaticOrder, true, true>(lds, g, S, E, wv); }
#endif
        }
#endif
        xcd_barrier(bar);
        }
                for (int rp_ = 0; rp_ < RP_C; ++rp_) {
#if PH_C
        {
            unsigned* qhead = ctl + CW_Q + 64 * (l + 2 * rp_);
            for (;;) {
                if (wv == 0 && lane_id() == 0) MISC[0] = __hip_atomic_fetch_add(qhead, 1u, __ATOMIC_RELAXED, __HIP_MEMORY_SCOPE_AGENT);
                __syncthreads();
                const int idx = (int)MISC[0];
                __syncthreads();
                if (idx >= 32 * 48 + 256) break;
                if (idx >= 32 * 48) {
                    if (rp_ == 0) { const int wl = lane_id(); LAS float* scr = (LAS float*)(lds + wv * 16384);
                        for (int j = 0; j < 6; ++j) { const int it = NITEMS_P0 + (idx - 32 * 48) * 48 + j * 8 + wv; TrJob jb{}; TR_DECODE(it); f32x4 va[8]; tr_load(jb, va, wl); tr_finish(jb, va, scr, wl); } }
                    continue; }
                const int qb = 31 - idx / 48, r = idx % 48, q0 = qb * 256;
                int tu = wv * 64 + lane_id(); asm volatile("" : "+v"(tu));
#if PH_C_DIFF
                if (r < 16 && (rp_ == 0 || (C_REP_MASK & 1))) att::diff_unit(lds, tu, r >> 3, (r >> 1) & 3, r & 1, q0, QK + (size_t)2 * M * 512, QK + (size_t)3 * M * 512, VT, (r & 1) ? CQ : OABC + (size_t)M * 1024, (r & 1) ? 512 : 1024,
                                                                             (const GAS unsigned*)(opqp(args.ws) + WS_CTL) + CW_KN + l * 4096, rp_ ? C_ABL : 0);
#endif
#if PH_C_SB
                if (r >= 16 && r < 32 && (rp_ == 0 || (C_REP_MASK & 2))) att::sb_unit(lds, tu, (r - 16) >> 3, (r - 16) & 7, q0, QK, QK + (size_t)M * 512, VT, OABC + 512);
#endif
#if PH_C_MLA
                if (r >= 32 && (rp_ == 0 || (C_REP_MASK & 4))) att::mla_unit(lds, tu, (r - 32) >> 3, (r - 32) & 7, q0, QMLA, KNOPE, KROPE, VMLAT, OABC, rp_ ? C_ABL : 0);
#endif
            }
        }
#endif
        xcd_barrier(bar);
        }
        #undef TR_DECODE
#undef w_in
#undef g_attn
#undef w_uq
#undef g_q
#undef w_ukv
#undef g_kv
#undef w_br
#undef w_out
#undef g_cross
#undef g_mem
#undef w_xq
#undef w_xkv
#undef w_xo
#undef g_ffn
#undef w_eg
#undef w_eu
#undef w_ed
#if PH_C
        { PH_BEGIN;
          float lam, post; att::diff_lambda(INP(8) + l * 256, l, lam, post);
          for (int it = gw; it < M * 4; it += 4 * NGW) att::diff_combine4(it, NGW, lane, OABC + (size_t)M * 1024, CQ, lam, post, INP(9) + l * 128); }
        xcd_barrier(bar);
#endif
        for (int rp_ = 0; rp_ < RP_D1; ++rp_) {
#if PH_D1
        { pg8::Gemm g{XB, WG, M, 1024, 512, 1024, nullptr}; pg8::D1Order S; S.so.init(M, 1024, G, bx);
          const GAS char* xb_ = (const GAS char*)XB; const GAS char* oab_ = (const GAS char*)OABC; const GAS char* wg_ = (const GAS char*)WG; const GAS char* wb_ = (const GAS char*)WB;
          S.dA = (size_t)(oab_ - xb_); S.dB = (size_t)(wb_ - wg_);
          pg8::EpiD1 E{GSCR, MB, SSQ};
          pg8::gemm_phase<pg8::EpiD1, pg8::D1Order, true, true>(lds, g, S, E, wv); }
#endif
        xcd_barrier(bar);
        }
        #if PH_D2
        { pg8::Gemm g{MB, WOUT, M, 1024, D, D, nullptr}; pg8::StaticOrder S; S.init(M, 1024, G, bx);
          pg8::EpiRes E{XB, SSQ};
          pg8::gemm_phase<pg8::EpiRes, pg8::StaticOrder, true, true>(lds, g, S, E, wv); }
#endif
        xcd_barrier(bar);
                for (int rp_ = 0; rp_ < RP_E1; ++rp_) {
#if PH_E1
        { pg8::Gemm g{XB, WXQ, M, 512, 512, 1024, nullptr}; pg8::SplitK2Order S; S.so.init(M, 1024, G, bx); S.tstep = (size_t)256 * 1024 * 2;
          pg8::EpiRS E{QX, 512, SSQ, 4, 1.f / 1024.f, 0.08838834764831845f * L2E, 1, 1, (size_t)M * 512};
          pg8::gemm_phase<pg8::EpiRS, pg8::SplitK2Order, true, true>(lds, g, S, E, wv); }
#endif
        xcd_barrier(bar);
        }
                for (int rp_ = 0; rp_ < RP_E2; ++rp_) {
#if PH_E2
        { PH_BEGIN; for (int u = vcu; u < 256; u += G) att::cross_unit(lds, tid, u >> 7, (u >> 5) & 3, (u & 31) * 256, QX, XK, XVT, OX); }
#endif
        xcd_barrier(bar);
        }
        #if PH_E3
        { pg8::Gemm g{OX, WXO, M, 1024, 512, 512, nullptr}; pg8::StaticOrder S; S.init(M, 1024, G, bx);
          pg8::EpiRes E{XB, SSQ};
          pg8::gemm_phase<pg8::EpiRes, pg8::StaticOrder, true, true>(lds, g, S, E, wv); }
#endif
        xcd_barrier(bar);
                for (int rp_ = 0; rp_ < RP_F0A; ++rp_) {
#if PH_F0A
        { PH_BEGIN;
            typedef short bf16x8 __attribute__((ext_vector_type(8)));
            const GAS float* brg = INP(19) + l * 4; const GAS float* bre = INP(21) + l * 32;
            LAS float* part = (LAS float*)lds;
            const int rb = wave & 3, kh = wave >> 2, r16 = lane & 15, kq = lane >> 4;
            for (int grp = bx; grp < 256; grp += G) {
                const GAS bf16* xrow = XB + (size_t)(grp * 64 + 16 * rb + r16) * D + 512 * kh + 8 * kq;
                const GAS bf16* wh = WRH + (size_t)r16 * 1024 + 512 * kh + 8 * kq; const GAS bf16* wl = WRL + (size_t)r16 * 1024 + 512 * kh + 8 * kq;
                f32x4 acc[3];
#pragma unroll
                for (int cb = 0; cb < 3; ++cb) acc[cb] = (f32x4){0.f, 0.f, 0.f, 0.f};
#pragma unroll 8
                for (int st = 0; st < 16; ++st) {
                    const bf16x8 ah = *(const GAS bf16x8*)(xrow + 32 * st);
#pragma unroll
                    for (int cb = 0; cb < 3; ++cb) {
                        const bf16x8 bh = *(const GAS bf16x8*)(wh + (size_t)cb * 16 * 1024 + 32 * st), bl = *(const GAS bf16x8*)(wl + (size_t)cb * 16 * 1024 + 32 * st);
                        acc[cb] = __builtin_amdgcn_mfma_f32_16x16x32_bf16(ah, bh, acc[cb], 0, 0, 0);
                        acc[cb] = __builtin_amdgcn_mfma_f32_16x16x32_bf16(ah, bl, acc[cb], 0, 0, 0);
                    }
                }
                __syncthreads();
#pragma unroll
                for (int cb = 0; cb < 3; ++cb)
#pragma unroll
                    for (int r = 0; r < 4; ++r) part[(kh * 64 + 16 * rb + 4 * kq + r) * 49 + 16 * cb + r16] = acc[cb][r];
                __syncthreads();
                if (wave == 0) {
                    const int tok = grp * 64 + lane; const float rs = pg8::rstd_parts(SSQ, (unsigned)(tok * 16), 4, 1.f / 1024.f);
                    const LAS float* p0 = part + lane * 49; const LAS float* p1 = part + (64 + lane) * 49;
                    float gl[4];
#pragma unroll
                    for (int c = 0; c < 4; ++c) gl[c] = (p0[c] + p1[c]) * rs + brg[c];
                    int gs = 0; float gm = gl[0];
#pragma unroll
                    for (int c = 1; c < 4; ++c) if (gl[c] > gm) { gm = gl[c]; gs = c; }
                    float den = 0.f;
#pragma unroll
                    for (int c = 0; c < 4; ++c) den += expf(gl[c] - gm);
                    const float pg = 1.0f / den;
                    float el[8];
#pragma unroll
                    for (int j = 0; j < 8; ++j) el[j] = (p0[4 + gs * 8 + j] + p1[4 + gs * 8 + j]) * rs + bre[gs * 8 + j];
                    int i0 = 0; float v0 = el[0];
#pragma unroll
                    for (int j = 1; j < 8; ++j) if (el[j] > v0) { v0 = el[j]; i0 = j; }
                    int i1 = -1; float v1 = -INFINITY;
#pragma unroll
                    for (int j = 0; j < 8; ++j) if (j != i0 && el[j] > v1) { v1 = el[j]; i1 = j; }
                    const float e1 = expf(v1 - v0), w0 = pg / (1.f + e1), w1 = pg * e1 / (1.f + e1);
                    const int ea = gs * 8 + i0, eb = gs * 8 + i1;
                    TOKE[tok * 2] = ea; TOKE[tok * 2 + 1] = eb; TOKW[tok * 2] = w0; TOKW[tok * 2 + 1] = w1;
                    int mycnt = 0;
#pragma unroll 1
                    for (int e = 0; e < 32; ++e) { const int c = __popcll(__ballot(ea == e)) + __popcll(__ballot(eb == e)); if (lane == e) mycnt = c; }
                    if (lane < 32) HIST[grp * 32 + lane] = mycnt;
                }
            }
            __syncthreads();
        }
#endif
        xcd_barrier(bar);
        }
                for (int rp_ = 0; rp_ < RP_F0B; ++rp_) {
#if PH_F0B
        { PH_BEGIN;
            LAS int* cnt = (LAS int*)(lds + HIST_OFF);
            for (int grp = bx; grp < 256; grp += G) {
                __syncthreads();
                { const int e = tid & 31, ch = tid >> 5; int tot = 0, before = 0;
#pragma unroll
                  for (int j = 0; j < 16; ++j) { const int g2 = ch * 16 + j; const int hv = HIST[g2 * 32 + e]; tot += hv; before += (g2 < grp) ? hv : 0; }
                  cnt[128 + ch * 32 + e] = tot; cnt[640 + ch * 32 + e] = before; }
                __syncthreads();
                if (tid < 32) { int tot = 0, before = 0;
                    for (int ch = 0; ch < 16; ++ch) { tot += cnt[128 + ch * 32 + tid]; before += cnt[640 + ch * 32 + tid]; }
                    cnt[tid] = tot; cnt[32 + tid] = before; }
                __syncthreads();
                if (tid == 0) { int ts = 0; for (int e = 0; e < 32; ++e) { TSTART[e] = ts; ts += (cnt[e] + 255) >> 8; } TSTART[32] = ts; }
                __syncthreads();
                if (wave == 0) {
                    const int tok = grp * 64 + lane; const int ea = TOKE[tok * 2], eb = TOKE[tok * 2 + 1];
                    int ra = 0, rb = 0; const unsigned long long lt = (1ull << lane) - 1ull;
#pragma unroll 1
                    for (int e = 0; e < 32; ++e) { const unsigned long long ma = __ballot(ea == e), mb = __ballot(eb == e); const int c = __popcll((ma | mb) & lt); if (ea == e) ra = c; if (eb == e) rb = c; }
                    const int sa = TSTART[ea] * 256 + cnt[32 + ea] + ra, sb = TSTART[eb] * 256 + cnt[32 + eb] + rb;
                    const float rsd = pg8::rstd_parts(SSQ, (unsigned)(tok * 16), 4, 1.f / 1024.f);
                    SLOT[tok * 2] = sa; SLOT[tok * 2 + 1] = sb;
                    STOK[sa] = tok; STOK[sb] = tok; SW[sa] = TOKW[tok * 2]; SW[sb] = TOKW[tok * 2 + 1]; SRSTD[sa] = rsd; SRSTD[sb] = rsd;
                    MISC[16 + lane] = (unsigned)sa; MISC[80 + lane] = (unsigned)sb;
                }
                __syncthreads();
                if (grp < 32) { const int beg = TSTART[grp] * 256 + cnt[grp], end = TSTART[grp + 1] * 256;
                    for (int s = beg + tid; s < end; s += NTHREADS) { STOK[s] = 0; SW[s] = 0.f; SRSTD[s] = 0.f; } }
            }
            if (G > 256 || bx >= 256) {
                __syncthreads();
                if (tid < 32) { int tot = 0; for (int g2 = 0; g2 < 256; ++g2) tot += HIST[g2 * 32 + tid]; cnt[tid] = tot; }
                __syncthreads();
                if (tid == 0) { int ts = 0; for (int e = 0; e < 32; ++e) { TSTART[e] = ts; ts += (cnt[e] + 255) >> 8; } TSTART[32] = ts; }
            }
            __syncthreads();
        }
#endif
        xcd_barrier(bar);
        }
                for (int rp_ = 0; rp_ < RP_F1; ++rp_) {
#if PH_F1
        { pg8::Gemm g{XB, WGU, SROWS, 32 * 512, D, D, STOK}; pg8::MoeOrder S{(const LAS int*)TSTART, 2, G, vcu};
          pg8::EpiAct E{ACT, SRSTD, SW};
          pg8::gemm_phase<pg8::EpiAct, pg8::MoeOrder, true, true, true>(lds, g, S, E, wv); }
#endif
        xcd_barrier(bar);
        }
                for (int rp_ = 0; rp_ < RP_F2; ++rp_) {
#if PH_F2
        { pg8::Gemm g{ACT, WD, SROWS, 32 * 1024, opq(256), opq(256), nullptr}; pg8::MoeOrder S{(const LAS int*)TSTART, 4, G, vcu};
          pg8::EpiRS E{YB, 1024, nullptr, 0, 0.f, 1.f, 3, 31, 0};
          pg8::gemm_phase<pg8::EpiRS, pg8::MoeOrder, true, true>(lds, g, S, E, wv); }
#endif
        xcd_barrier(bar);
        }
#if PH_F3
        { PH_BEGIN;
            const GAS float* g_fin = INP(25);
            int s0n = SLOT[gw * 2], s1n = SLOT[gw * 2 + 1];
            for (int m = gw; m < M; m += NGW) {
                GAS u32x2* xr = (GAS u32x2*)(XB + (size_t)m * D) + lane; const int s0 = s0n, s1 = s1n;
                if (m + NGW < M) { s0n = SLOT[(m + NGW) * 2]; s1n = SLOT[(m + NGW) * 2 + 1]; }
                const GAS u32x2* y0 = (const GAS u32x2*)(YB + (size_t)s0 * D) + lane; const GAS u32x2* y1 = (const GAS u32x2*)(YB + (size_t)s1 * D) + lane;
                f32x4 v[4]; float s = 0.f;
#pragma unroll
                for (int j = 0; j < 4; ++j) { const u32x2 a = y0[64 * j], b2 = y1[64 * j], xw = xr[64 * j];
                    v[j][0] = pg8::bflo(xw.x) + (pg8::bflo(a.x) + pg8::bflo(b2.x)); v[j][1] = pg8::bfhi(xw.x) + (pg8::bfhi(a.x) + pg8::bfhi(b2.x));
                    v[j][2] = pg8::bflo(xw.y) + (pg8::bflo(a.y) + pg8::bflo(b2.y)); v[j][3] = pg8::bfhi(xw.y) + (pg8::bfhi(a.y) + pg8::bfhi(b2.y));
                    s += (v[j][0] * v[j][0] + v[j][1] * v[j][1]) + (v[j][2] * v[j][2] + v[j][3] * v[j][3]); }
                s = wave_sum(s);
                if (l == DEPTH - 1) { const float rsd = 1.0f / sqrtf(s * (1.f / 1024.f) + 1e-6f); GAS f32x4* orow = (GAS f32x4*)(OUTP + (size_t)m * D) + lane;
#pragma unroll
                    for (int j = 0; j < 4; ++j) { const f32x4 gg = ((const GAS f32x4*)g_fin)[lane + 64 * j]; orow[64 * j] = v[j] * rsd * gg; }
                } else {
#pragma unroll
                    for (int j = 0; j < 4; ++j) { u32x2 w; w.x = pk2(v[j][0], v[j][1]); w.y = pk2(v[j][2], v[j][3]); xr[64 * j] = w; }
                    if (lane < 16) SSQ[(size_t)m * 16 + lane] = (lane == 0) ? s : 0.f;
                }
            }
        }
#endif
    }
}

extern "C" void kernel_launch(void* const* d_in, const int* in_sizes, int n_in, void* d_out, int out_size, void* d_ws, size_t ws_size, hipStream_t stream) {
    static int grid = 0;
    if (grid == 0) {
        if (n_in != 26 || in_sizes[0] != M * D || out_size != M * D || ws_size < WS_END) { fprintf(stderr, "kernel_launch: unexpected shapes (n_in %d, in0 %d, out %d, ws %zu < %zu)\n", n_in, n_in > 0 ? in_sizes[0] : -1, out_size, ws_size, (size_t)WS_END); grid = -1; return; }
        int dev = 0, cus = 0;
        if (hipGetDevice(&dev) != hipSuccess || hipDeviceGetAttribute(&cus, hipDeviceAttributeMultiprocessorCount, dev) != hipSuccess) { grid = -1; return; }
        if (hipFuncSetAttribute((const void*)fwd, hipFuncAttributeMaxDynamicSharedMemorySize, LDS_BYTES) != hipSuccess) { fprintf(stderr, "kernel_launch: hipFuncSetAttribute failed\n"); grid = -1; return; }
        int per_cu = 0;
        if (hipOccupancyMaxActiveBlocksPerMultiprocessor(&per_cu, (const void*)fwd, NTHREADS, LDS_BYTES) != hipSuccess || per_cu < 1) fprintf(stderr, "kernel_launch: occupancy query says %d\n", per_cu);
        (void)hipGetLastError();
        grid = cus < 256 ? (cus / 8) * 8 : 256;
    }
    if (grid <= 0) return;
    if (hipMemsetAsync((char*)d_ws + WS_CTL, 0, CTL_ZERO_BYTES, stream) != hipSuccess) return;
    Args a{};
    for (int i = 0; i < 26; ++i) a.in[i] = (const float*)d_in[i];
    a.out = (float*)d_out; a.ws = (unsigned char*)d_ws;
    hipLaunchKernelGGL(fwd, dim3(grid), dim3(NTHREADS), LDS_BYTES, stream, a);
}
```

```cpp
#include <hip/hip_runtime.h>
#include <cstdio>
#include <cstdint>
#define LAS __attribute__((address_space(3)))
#define GAS __attribute__((address_space(1)))
#ifndef PH_A
#define PH_A 1
#endif
#ifndef PH_B
#define PH_B 1
#endif
#ifndef PH_C
#define PH_C 1
#endif
#ifndef PH_D1
#define PH_D1 1
#endif
#ifndef PH_D2
#define PH_D2 1
#endif
#ifndef PH_E1
#define PH_E1 1
#endif
#ifndef PH_E2
#define PH_E2 1
#endif
#ifndef PH_E3
#define PH_E3 1
#endif
#ifndef PH_F0A
#define PH_F0A 1
#endif
#ifndef PH_F0B
#define PH_F0B 1
#endif
#ifndef PH_F1
#define PH_F1 1
#endif
#ifndef PH_F2
#define PH_F2 1
#endif
#ifndef PH_P0
#define PH_P0 1
#endif
#ifndef PH_F3
#define PH_F3 1
#endif
#ifndef PH_C_DIFF
#define PH_C_DIFF 1
#endif
#ifndef PH_C_SB
#define PH_C_SB 1
#endif
#ifndef PH_C_MLA
#define PH_C_MLA 1
#endif
#ifndef PH_B1
#define PH_B1 1
#endif
#ifndef PH_B2
#define PH_B2 1
#endif
#ifndef PH_B3
#define PH_B3 1
#endif
#ifndef RP_A
#define RP_A 1
#endif
#ifndef RP_B
#define RP_B 1
#endif
#ifndef RP_C
#define RP_C 1
#endif
#ifndef RP_D1
#define RP_D1 1
#endif
#ifndef RP_E1
#define RP_E1 1
#endif
#ifndef RP_E2
#define RP_E2 1
#endif
#ifndef RP_F0A
#define RP_F0A 1
#endif
#ifndef RP_F0B
#define RP_F0B 1
#endif
#ifndef RP_F1
#define RP_F1 1
#endif
#ifndef RP_F2
#define RP_F2 1
#endif
#ifndef RP_P0
#define RP_P0 1
#endif
#ifndef C_REP_MASK
#define C_REP_MASK 7
#endif
#ifndef C_ABL
#define C_ABL 0
#endif
namespace pg8 {
#define PG8_LAS __attribute__((address_space(3)))
typedef unsigned short bf16_t;
typedef short bf16x8 __attribute__((ext_vector_type(8)));
typedef float f32x4 __attribute__((ext_vector_type(4)));
typedef unsigned u32x4 __attribute__((ext_vector_type(4)));
constexpr int BM = 256, BK = 64, HALF = 128, HTB = HALF * BK * 2  , STAGE_BYTES = 8 * HTB, NXCD = 8, WGM = 8;

__host__ __device__ __forceinline__ int lds_byte(int r, int c) { const int st = (r >> 4) * 2 + (c >> 5), rr = r & 15, cc = c & 31, ob = rr * 64 + cc * 2; return st * 1024 + (ob ^ (((ob >> 9) & 1) << 5)); }
__host__ __device__ __forceinline__ void stage_rc(int b, int& R, int& C) { const int st = b / 1024, sb = b % 1024, swz = sb ^ (((sb >> 9) & 1) << 5); R = (st >> 1) * 16 + swz / 64; C = (st & 1) * 32 + (swz % 64) / 2; }
__host__ __device__ __forceinline__ int perm32(int rho) { const int n = rho >> 4, i = rho & 15; return 8 * (i >> 2) + 4 * n + (i & 3); }

struct Unit { int pm, pn, sel; };
struct Gemm { const GAS bf16_t* A; const GAS bf16_t* Bt; int M, N, K, ld; const GAS int* rowidx; };

struct StaticOrder {
    int nM, nN, nwg, G, c;
    __host__ __device__ void init(int M, int N, int G_, int c_) { nM = M / BM; nN = N / BM; nwg = nM * nN; G = G_; c = c_; }
    __host__ __device__ bool next(int i, Unit& u) const {
        const long L = (long)i * G + c; if (L >= nwg) return false;
        int wgid = (int)L; { const int q = nwg / NXCD, r = nwg % NXCD, xcd = wgid % NXCD, off = wgid / NXCD; wgid = (xcd < r ? xcd * (q + 1) : r * (q + 1) + (xcd - r) * q) + off; }
        const int nig = WGM * nN, gid = wgid / nig, fm = gid * WGM, gsz = (nM - fm) < WGM ? (nM - fm) : WGM;
        u.pm = fm + ((wgid % nig) % gsz); u.pn = (wgid % nig) / gsz; u.sel = 0; return true;
    }
    __device__ __forceinline__ void a_ready(const Unit&) const {}
    __device__ __forceinline__ void done(const Unit&) const {}
    __device__ __forceinline__ size_t a_off(const Unit&) const { return 0; }
    __device__ __forceinline__ size_t b_off(const Unit&) const { return 0; }
    __device__ __forceinline__ bool keep(const Unit&) const { return false; }
};

__device__ __forceinline__ unsigned cvt_pk_bf16(float lo, float hi) { unsigned r; asm volatile("v_cvt_pk_bf16_f32 %0, %1, %2" : "=v"(r) : "v"(lo), "v"(hi)); return r; }
template <class Epi, class Sched, bool ALIGN_EPI = false, bool SP2 = false, bool GATHER = false>
__device__ __forceinline__ void gemm_phase(PG8_LAS unsigned char* lds, const Gemm g, const Sched& S, const Epi& E, const int wave_idx) {
    int tid_; asm volatile("v_mbcnt_lo_u32_b32 %0, -1, 0\n\tv_mbcnt_hi_u32_b32 %0, -1, %0" : "=v"(tid_)); tid_ += wave_idx * 64;
    const int tid = tid_, wid = __builtin_amdgcn_readfirstlane(tid >> 6), lane = tid & 63, wr = wid >> 2, wc = wid & 3, fr = lane & 15, fq = lane >> 4;
    const int K = g.K, nt = K / BK, LD = g.ld;
    unsigned voffA[2], voffB[2];
#pragma unroll
    for (int i = 0; i < 2; ++i) { int R, C; stage_rc(tid * 16 + i * 8192, R, C); const int Rb = Epi::PERM ? ((R & ~31) + perm32(R & 31)) : R;
        voffA[i] = (unsigned)(R * LD + C) * 2u; voffB[i] = (unsigned)(Rb * LD + C) * 2u; }
    const size_t kstep = (size_t)(BK * 2);
    const size_t hstep = (size_t)HALF * LD * 2;
    const size_t tstep = 2 * hstep;
    const unsigned ldsw = (unsigned)wid * 1024u;
    const int aoff = lds_byte(wr * 64 + fr, fq * 8), boff = lds_byte(wc * 32 + fr, fq * 8);
#define PG8_SA(b, h) (((b) * 2 + (h)) * HTB)
#define PG8_SB(b, h) ((4 + (b) * 2 + (h)) * HTB)
#define PG8_STAGE(bufoff, gbase, voff) do { _Pragma("unroll") for (int _i = 0; _i < 2; ++_i) \
        __builtin_amdgcn_global_load_lds((const GAS unsigned*)((const GAS char*)(gbase) + (voff)[_i]), (PG8_LAS unsigned*)(lds + (bufoff) + ldsw + _i * 8192), 16, 0, 0); } while (0)
#define PG8_LDA(dst, b, h) do { _Pragma("unroll") for (int m = 0; m < 4; ++m) _Pragma("unroll") for (int k = 0; k < 2; ++k) dst[m][k] = *(const PG8_LAS bf16x8*)(lds + PG8_SA(b, h) + aoff + m * 2048 + k * 1024); } while (0)
#define PG8_LDB(dst, b, h) do { _Pragma("unroll") for (int n = 0; n < 2; ++n) _Pragma("unroll") for (int k = 0; k < 2; ++k) dst[n][k] = *(const PG8_LAS bf16x8*)(lds + PG8_SB(b, h) + boff + n * 2048 + k * 1024); } while (0)
#define PG8_MMA(ai, bj, At, Bt) do { __builtin_amdgcn_s_setprio(1); _Pragma("unroll") for (int m = 0; m < 4; ++m) _Pragma("unroll") for (int n = 0; n < 2; ++n) _Pragma("unroll") for (int k = 0; k < 2; ++k) \
        acc[ai][bj][m][n] = __builtin_amdgcn_mfma_f32_16x16x32_bf16(Bt[n][k], At[m][k], acc[ai][bj][m][n], 0, 0, 0); __builtin_amdgcn_s_setprio(0); } while (0)
#define PG8_WAIT_V(n) asm volatile("s_waitcnt vmcnt(" #n ")" ::: "memory")
#define PG8_WAIT_L(n) asm volatile("s_waitcnt lgkmcnt(" #n ")" ::: "memory")
#define PG8_BAR __builtin_amdgcn_s_barrier()
#define PG8_SCHED __builtin_amdgcn_sched_barrier(0)
    Unit cur, nxt; int ui = 0;
    if (!S.next(0, cur)) return;
    f32x4 acc[2][2][4][2];
#pragma unroll
    for (int a = 0; a < 2; ++a)
#pragma unroll
        for (int b = 0; b < 2; ++b)
#pragma unroll
            for (int m = 0; m < 4; ++m)
#pragma unroll
                for (int n = 0; n < 2; ++n) acc[a][b][m][n] = (f32x4){0.f, 0.f, 0.f, 0.f};
    bf16x8 At[4][2], B0[2][2], B1[2][2];
    const GAS char* cA = (const GAS char*)g.A + (GATHER ? (size_t)0 : (size_t)cur.pm * tstep + S.a_off(cur)); const GAS char* cB = (const GAS char*)g.Bt + (size_t)cur.pn * tstep + S.b_off(cur);
    unsigned vC[2][2], vN[2][2];
    if constexpr (GATHER) {
#pragma unroll
        for (int h = 0; h < 2; ++h)
#pragma unroll
            for (int i = 0; i < 2; ++i) { int R, C; stage_rc(tid * 16 + i * 8192, R, C); vC[h][i] = (unsigned)(g.rowidx[cur.pm * BM + h * HALF + R] * LD + C) * 2u; vN[h][i] = vC[h][i]; }
    }
#define PG8_STAGE_A(bufoff, gb, h, nx) do { if constexpr (GATHER) { unsigned vs_[2] = {(nx) ? vN[h][0] : vC[h][0], (nx) ? vN[h][1] : vC[h][1]}; PG8_STAGE(bufoff, gb, vs_); } \
        else { PG8_STAGE(bufoff, (gb) + (h) * hstep, voffA); } } while (0)
    S.a_ready(cur);
    if constexpr (SP2) {
        PG8_STAGE(PG8_SB(0, 0), cB, voffB); PG8_STAGE(PG8_SB(0, 1), cB + hstep, voffB); PG8_STAGE_A(PG8_SA(0, 0), cA, 0, false); PG8_STAGE_A(PG8_SA(0, 1), cA, 1, false);
        if (wr == 1) PG8_BAR;
        PG8_WAIT_V(2); PG8_BAR;
        PG8_STAGE(PG8_SB(1, 0), cB + kstep, voffB); PG8_STAGE_A(PG8_SA(1, 0), cA + kstep, 0, false); PG8_STAGE(PG8_SB(1, 1), cB + hstep + kstep, voffB);
        PG8_WAIT_V(6); PG8_BAR;
    } else {
        PG8_STAGE(PG8_SB(0, 0), cB, voffB); PG8_STAGE(PG8_SA(0, 0), cA, voffA); PG8_STAGE(PG8_SB(0, 1), cB + hstep, voffB); PG8_STAGE(PG8_SA(0, 1), cA + hstep, voffA);
        if (wr == 1) PG8_BAR;
        PG8_WAIT_V(4); PG8_BAR;
        PG8_STAGE(PG8_SB(1, 0), cB + kstep, voffB); PG8_STAGE(PG8_SA(1, 0), cA + kstep, voffA); PG8_STAGE(PG8_SB(1, 1), cB + hstep + kstep, voffB);
        PG8_WAIT_V(6); PG8_BAR;
    }
    for (;;) {
        const bool has_next = S.next(ui + 1, nxt);
        if constexpr (GATHER) { if (has_next) {
#pragma unroll
            for (int h = 0; h < 2; ++h)
#pragma unroll
                for (int i = 0; i < 2; ++i) { int R, C; stage_rc(tid * 16 + i * 8192, R, C); vN[h][i] = (unsigned)(g.rowidx[nxt.pm * BM + h * HALF + R] * LD + C) * 2u; } } }
        const GAS char* nA = GATHER ? cA : has_next ? (const GAS char*)g.A + (size_t)nxt.pm * tstep + S.a_off(nxt) : cA; const GAS char* nB = has_next ? (const GAS char*)g.Bt + (size_t)nxt.pn * tstep + S.b_off(nxt) : cB;
        for (int t = 0; t < nt; t += 2) {
            const bool last = (t == nt - 2);
            const GAS char* a1 = cA + (size_t)(t + 1) * kstep;
            const GAS char* a2 = last ? nA : cA + (size_t)(t + 2) * kstep; const GAS char* b2 = last ? nB : cB + (size_t)(t + 2) * kstep;
            const GAS char* a3 = a2 + kstep; const GAS char* b3 = b2 + kstep;
            if (last && has_next) S.a_ready(nxt);
            if constexpr (SP2) {
            PG8_LDB(B0, 0, 0); PG8_LDB(B1, 0, 1); PG8_SCHED; PG8_LDA(At, 0, 0); PG8_STAGE_A(PG8_SA(1, 1), a1, 1, false);
            PG8_WAIT_V(8); PG8_WAIT_L(0); PG8_BAR; PG8_MMA(0, 0, At, B0); PG8_MMA(0, 1, At, B1); PG8_BAR; PG8_SCHED;
            PG8_LDA(At, 0, 1); PG8_STAGE(PG8_SB(0, 0), b2, voffB); PG8_STAGE(PG8_SB(0, 1), b2 + hstep, voffB); PG8_STAGE_A(PG8_SA(0, 0), a2, 0, last);
            PG8_WAIT_V(8); PG8_WAIT_L(0); PG8_BAR; PG8_MMA(1, 0, At, B0); PG8_MMA(1, 1, At, B1); PG8_BAR; PG8_SCHED;
            PG8_LDB(B0, 1, 0); PG8_LDB(B1, 1, 1); PG8_SCHED; PG8_LDA(At, 1, 0); PG8_STAGE_A(PG8_SA(0, 1), a2, 1, last);
            PG8_WAIT_V(8); PG8_WAIT_L(0); PG8_BAR; PG8_MMA(0, 0, At, B0); PG8_MMA(0, 1, At, B1); PG8_BAR; PG8_SCHED;
            PG8_LDA(At, 1, 1); PG8_STAGE(PG8_SB(1, 0), b3, voffB); PG8_STAGE(PG8_SB(1, 1), b3 + hstep, voffB); PG8_STAGE_A(PG8_SA(1, 0), a3, 0, last);
            PG8_WAIT_V(8); PG8_WAIT_L(0); PG8_BAR; PG8_MMA(1, 0, At, B0); PG8_MMA(1, 1, At, B1); PG8_BAR; PG8_SCHED;
            } else {
            PG8_LDB(B0, 0, 0); PG8_SCHED; PG8_LDA(At, 0, 0); PG8_STAGE(PG8_SA(1, 1), a1 + hstep, voffA);
            PG8_WAIT_L(8); PG8_BAR; PG8_WAIT_L(0); PG8_MMA(0, 0, At, B0); PG8_BAR; PG8_SCHED;
            PG8_LDB(B1, 0, 1); PG8_STAGE(PG8_SB(0, 0), b2, voffB);
            PG8_BAR; PG8_WAIT_L(0); PG8_MMA(0, 1, At, B1); PG8_BAR;
            PG8_LDA(At, 0, 1); PG8_STAGE(PG8_SA(0, 0), a2, voffA);
            PG8_BAR; PG8_WAIT_L(0); PG8_MMA(1, 0, At, B0); PG8_BAR; PG8_SCHED;
            PG8_STAGE(PG8_SB(0, 1), b2 + hstep, voffB);
            PG8_WAIT_V(6); PG8_BAR; PG8_MMA(1, 1, At, B1); PG8_BAR;
            PG8_LDB(B0, 1, 0); PG8_SCHED; PG8_LDA(At, 1, 0); PG8_STAGE(PG8_SA(0, 1), a2 + hstep, voffA);
            PG8_WAIT_L(8); PG8_BAR; PG8_WAIT_L(0); PG8_MMA(0, 0, At, B0); PG8_BAR; PG8_SCHED;
            PG8_LDB(B1, 1, 1); PG8_STAGE(PG8_SB(1, 0), b3, voffB);
            PG8_BAR; PG8_WAIT_L(0); PG8_MMA(0, 1, At, B1); PG8_BAR;
            PG8_LDA(At, 1, 1); PG8_STAGE(PG8_SA(1, 0), a3, voffA);
            PG8_BAR; PG8_WAIT_L(0); PG8_MMA(1, 0, At, B0); PG8_BAR; PG8_SCHED;
            PG8_STAGE(PG8_SB(1, 1), b3 + hstep, voffB);
            PG8_WAIT_V(6); PG8_BAR; PG8_MMA(1, 1, At, B1); PG8_BAR;
            }
        }
        if constexpr (ALIGN_EPI) { if (wr == 0) PG8_BAR; }
        const bool keep_ = S.keep(cur);
        if constexpr (!Epi::AFTER_DRAIN) { if (!keep_) { E(acc, cur, wr, wc, fr, fq); S.done(cur); } }
        if (!has_next) break;
        if (!keep_) {
#pragma unroll
        for (int a = 0; a < 2; ++a)
#pragma unroll
            for (int b = 0; b < 2; ++b)
#pragma unroll
                for (int m = 0; m < 4; ++m)
#pragma unroll
                    for (int n = 0; n < 2; ++n) acc[a][b][m][n] = (f32x4){0.f, 0.f, 0.f, 0.f}; }
        cur = nxt; cA = nA; cB = nB; ++ui;
        if constexpr (GATHER) { vC[0][0] = vN[0][0]; vC[0][1] = vN[0][1]; vC[1][0] = vN[1][0]; vC[1][1] = vN[1][1]; }
        if constexpr (ALIGN_EPI) { if (wr == 1) PG8_BAR; }
    }
    PG8_WAIT_V(0);
    if constexpr (!ALIGN_EPI) { if (wr == 0) PG8_BAR; }
    PG8_BAR;
    if constexpr (Epi::AFTER_DRAIN) { E.fused(acc, cur, wr, wc, fr, fq, lds, wid, lane); S.done(cur); }
#undef PG8_SA
#undef PG8_SB
#undef PG8_STAGE
#undef PG8_STAGE_A
#undef PG8_LDA
#undef PG8_LDB
#undef PG8_MMA
#undef PG8_WAIT_V
#undef PG8_WAIT_L
#undef PG8_BAR
#undef PG8_SCHED
}
typedef unsigned u32x2 __attribute__((ext_vector_type(2)));
typedef float f32x2v __attribute__((ext_vector_type(2)));
typedef __bf16 bf16x2v __attribute__((ext_vector_type(2)));
__device__ __forceinline__ unsigned pk2(float lo, float hi) { f32x2v v = {lo, hi}; bf16x2v b = __builtin_convertvector(v, bf16x2v); return __builtin_bit_cast(unsigned, b); }
__device__ __forceinline__ float bflo(unsigned w) { return __builtin_bit_cast(float, w << 16); }
__device__ __forceinline__ float bfhi(unsigned w) { return __builtin_bit_cast(float, w & 0xffff0000u); }
__device__ __forceinline__ float rstd_parts(const GAS float* base, unsigned eoff, int n4, float inv_n) {
    float s = 0.f; const GAS char* p = (const GAS char*)base + (size_t)(eoff * 4u);
    for (int i = 0; i < n4; ++i) { const f32x4 v = *(const GAS f32x4*)(p + 16 * i); s += (v[0] + v[1]) + (v[2] + v[3]); }
    return __builtin_amdgcn_rsqf(s * inv_n + 1e-6f);
}
__device__ const double kRopeRev[16] = {0.15915494309189535, 0.08949940160889101, 0.050329212104487035, 0.0283021958306234, 0.015915494309189534, 0.008949940160889102, 0.005032921210448704, 0.00283021958306234,
                                        0.0015915494309189536, 0.0008949940160889102, 0.0005032921210448703, 0.00028302195830623395, 0.00015915494309189535, 8.949940160889102e-05, 5.0329212104487035e-05, 2.8302195830623396e-05};
__device__ __forceinline__ void rope_cs(int pos, int i, float& cs, float& sn) {
    double a = (double)pos * kRopeRev[i]; a -= __builtin_floor(a);
    const float r = (float)a; sn = __builtin_amdgcn_sinf(r); cs = __builtin_amdgcn_cosf(r);
}
#define PG8_L2E 1.4426950408889634f

struct EpiA {
    static constexpr bool PERM = false, AFTER_DRAIN = false;
    const GAS float* ssq; GAS bf16_t *cq, *ckv, *krope, *qk; GAS float *ssq_cq, *ssq_ckv; float c2; GAS unsigned* kn;
    __device__ __forceinline__ void operator()(const f32x4 (&acc)[2][2][4][2], const Unit& u, int wr, int wc, int fr, int fq) const {
        const int pn = u.pn, row0 = u.pm * BM + wr * 64 + fr;
        float rs[2][4];
#pragma unroll
        for (int ai = 0; ai < 2; ++ai)
#pragma unroll
            for (int m = 0; m < 4; ++m) rs[ai][m] = rstd_parts(ssq, (unsigned)((row0 + ai * HALF + m * 16) * 16), 4, 1.f / 1024.f);
        if (pn < 2) {
            GAS bf16_t* dst = pn == 0 ? cq : ckv; GAS float* sq = pn == 0 ? ssq_cq : ssq_ckv;
#pragma unroll
            for (int ai = 0; ai < 2; ++ai)
#pragma unroll
                for (int m = 0; m < 4; ++m) { const int row = row0 + ai * HALF + m * 16; const float r = rs[ai][m]; float s2 = 0.f;
#pragma unroll
                    for (int bj = 0; bj < 2; ++bj)
#pragma unroll
                        for (int n = 0; n < 2; ++n) { const f32x4 v = acc[ai][bj][m][n] * r; s2 += (v[0] * v[0] + v[1] * v[1]) + (v[2] * v[2] + v[3] * v[3]);
                            u32x2 w; w.x = pk2(v[0], v[1]); w.y = pk2(v[2], v[3]); *(GAS u32x2*)(dst + (size_t)row * 256 + bj * HALF + wc * 32 + n * 16 + fq * 4) = w; }
                    s2 += __shfl_xor(s2, 16); s2 += __shfl_xor(s2, 32);
                    if (fq == 0) sq[(size_t)row * 4 + wc] = s2; }
        } else if (pn == 2) {
            if (wc == 0) {
#pragma unroll
                for (int ai = 0; ai < 2; ++ai)
#pragma unroll
                    for (int m = 0; m < 4; ++m) { const int row = row0 + ai * HALF + m * 16, pos = row & 8191; const float r = rs[ai][m];
                        const f32x4 v0 = acc[ai][0][m][0] * r, v1 = acc[ai][0][m][1] * r; float o0[4], o1[4];
#pragma unroll
                        for (int e = 0; e < 4; ++e) { float cs, sn; rope_cs(pos, 4 * fq + e, cs, sn); o0[e] = v0[e] * cs - v1[e] * sn; o1[e] = v0[e] * sn + v1[e] * cs; }
                        u32x2 w0, w1; w0.x = pk2(o0[0], o0[1]); w0.y = pk2(o0[2], o0[3]); w1.x = pk2(o1[0], o1[1]); w1.y = pk2(o1[2], o1[3]);
                        *(GAS u32x2*)(krope + (size_t)row * 32 + 4 * fq) = w0; *(GAS u32x2*)(krope + (size_t)row * 32 + 16 + 4 * fq) = w1; }
            }
        } else {
            const int t = pn - 3, buf = t >> 1, half = t & 1; GAS bf16_t* dst = qk + (size_t)buf * 16384 * 512; const float sc = (buf & 1) ? 1.f : c2;
#pragma unroll
            for (int ai = 0; ai < 2; ++ai)
#pragma unroll
                for (int bj = 0; bj < 2; ++bj) { float kmx = 0.f;
#pragma unroll
                    for (int m = 0; m < 4; ++m) { const int row = row0 + ai * HALF + m * 16; const float r = rs[ai][m] * sc; float s2 = 0.f;
#pragma unroll
                        for (int n = 0; n < 2; ++n) { const f32x4 v = acc[ai][bj][m][n] * r; u32x2 w; w.x = pk2(v[0], v[1]); w.y = pk2(v[2], v[3]);
                            s2 += (v[0] * v[0] + v[1] * v[1]) + (v[2] * v[2] + v[3] * v[3]);
                            *(GAS u32x2*)(dst + (size_t)row * 512 + half * 256 + bj * HALF + wc * 32 + n * 16 + fq * 4) = w; }
                        kmx = fmaxf(kmx, s2); }
                    if (pn >= 9) {
                        float s = kmx; const float q1 = __shfl_xor(s, 16), q2 = __shfl_xor(s, 32), q3 = __shfl_xor(q1, 32); s = (s + q1) + (q2 + q3);
                        s = fmaxf(s, __shfl_xor(s, 1)); s = fmaxf(s, __shfl_xor(s, 2)); s = fmaxf(s, __shfl_xor(s, 4)); s = fmaxf(s, __shfl_xor(s, 8));
                        if ((fr | fq) == 0) __hip_atomic_fetch_max(kn + (((size_t)(4 * u.pm + 2 * ai + wr) * 8 + 4 * (pn - 9) + 2 * bj + (wc >> 1)) * 2 + (wc & 1)), __builtin_bit_cast(unsigned, s), __ATOMIC_RELAXED, __HIP_MEMORY_SCOPE_AGENT); } }
        }
    }
};
struct EpiVT {
    static constexpr bool PERM = true, AFTER_DRAIN = false;
    GAS bf16_t* out; int ld; const GAS float* ssq; int n4; float inv_n;
    __device__ __forceinline__ void operator()(const f32x4 (&acc)[2][2][4][2], const Unit& u, int wr, int wc, int fr, int fq) const {
        const int col0 = u.pn * BM + wc * 32 + 8 * fq, row0 = u.pm * BM + wr * 64 + fr;
        float cs[2][8];
#pragma unroll
        for (int bj = 0; bj < 2; ++bj)
#pragma unroll
            for (int j = 0; j < 8; ++j) cs[bj][j] = rstd_parts(ssq, (unsigned)((col0 + bj * HALF + j) * (4 * n4)), n4, inv_n);
#pragma unroll
        for (int ai = 0; ai < 2; ++ai)
#pragma unroll
            for (int m = 0; m < 4; ++m) { GAS bf16_t* rowp = out + (size_t)(row0 + ai * HALF + m * 16) * ld + col0;
#pragma unroll
                for (int bj = 0; bj < 2; ++bj) { const f32x4 v0 = acc[ai][bj][m][0], v1 = acc[ai][bj][m][1]; u32x4 w;
                    w.x = pk2(v0[0] * cs[bj][0], v0[1] * cs[bj][1]); w.y = pk2(v0[2] * cs[bj][2], v0[3] * cs[bj][3]);
                    w.z = pk2(v1[0] * cs[bj][4], v1[1] * cs[bj][5]); w.w = pk2(v1[2] * cs[bj][6], v1[3] * cs[bj][7]);
                    *(GAS u32x4*)(rowp + bj * HALF) = w; } }
    }
};
struct EpiRS {
    static constexpr bool PERM = true, AFTER_DRAIN = false;
    GAS bf16_t* out; int ld; const GAS float* ssq; int n4; float inv_n; float scale; int pnmask; int pnshift; size_t zstride;
    __device__ __forceinline__ void operator()(const f32x4 (&acc)[2][2][4][2], const Unit& u, int wr, int wc, int fr, int fq) const {
        const int col0 = (u.pn & pnmask) * BM + wc * 32 + 8 * fq, row0 = u.pm * BM + wr * 64 + fr;
        float rr[2][4];
#pragma unroll
        for (int ai = 0; ai < 2; ++ai)
#pragma unroll
            for (int m = 0; m < 4; ++m) rr[ai][m] = (n4 ? rstd_parts(ssq, (unsigned)((row0 + ai * HALF + m * 16) * (4 * n4)), n4, inv_n) : 1.f) * scale;
#pragma unroll
        for (int ai = 0; ai < 2; ++ai)
#pragma unroll
            for (int m = 0; m < 4; ++m) { const int row = row0 + ai * HALF + m * 16; const float r = rr[ai][m];
                GAS bf16_t* rowp = out + (size_t)(u.pn >> pnshift) * zstride + (size_t)row * ld + col0;
#pragma unroll
                for (int bj = 0; bj < 2; ++bj) { const f32x4 v0 = acc[ai][bj][m][0] * r, v1 = acc[ai][bj][m][1] * r; u32x4 w;
                    w.x = pk2(v0[0], v0[1]); w.y = pk2(v0[2], v0[3]); w.z = pk2(v1[0], v1[1]); w.w = pk2(v1[2], v1[3]); *(GAS u32x4*)(rowp + bj * HALF) = w; } }
    }
};
struct EpiQ {
    static constexpr bool PERM = false, AFTER_DRAIN = false;
    GAS bf16_t* q; const GAS float* ssq_cq; float c2;
    __device__ __forceinline__ void operator()(const f32x4 (&acc)[2][2][4][2], const Unit& u, int wr, int wc, int fr, int fq) const {
        const int pn = u.pn, row0 = u.pm * BM + wr * 64 + fr;
        float rr[2][4];
#pragma unroll
        for (int ai = 0; ai < 2; ++ai)
#pragma unroll
            for (int m = 0; m < 4; ++m) rr[ai][m] = rstd_parts(ssq_cq, (unsigned)((row0 + ai * HALF + m * 16) * 4), 1, 1.f / 256.f) * c2;
#pragma unroll
        for (int ai = 0; ai < 2; ++ai)
#pragma unroll
            for (int m = 0; m < 4; ++m) { const int row = row0 + ai * HALF + m * 16; const float r = rr[ai][m];
                if (pn < 2) {
#pragma unroll
                    for (int bj = 0; bj < 2; ++bj)
#pragma unroll
                        for (int n = 0; n < 2; ++n) { const f32x4 v = acc[ai][bj][m][n] * r; u32x2 w; w.x = pk2(v[0], v[1]); w.y = pk2(v[2], v[3]);
                            *(GAS u32x2*)(q + (size_t)row * 768 + pn * 256 + bj * HALF + wc * 32 + n * 16 + fq * 4) = w; }
                } else { const int pos = row & 8191; float cs[4], sn[4];
#pragma unroll
                    for (int e = 0; e < 4; ++e) rope_cs(pos, 4 * fq + e, cs[e], sn[e]);
#pragma unroll
                    for (int bj = 0; bj < 2; ++bj) { const f32x4 v0 = acc[ai][bj][m][0] * r, v1 = acc[ai][bj][m][1] * r; float o0[4], o1[4];
#pragma unroll
                        for (int e = 0; e < 4; ++e) { o0[e] = v0[e] * cs[e] - v1[e] * sn[e]; o1[e] = v0[e] * sn[e] + v1[e] * cs[e]; }
                        u32x2 w0, w1; w0.x = pk2(o0[0], o0[1]); w0.y = pk2(o0[2], o0[3]); w1.x = pk2(o1[0], o1[1]); w1.y = pk2(o1[2], o1[3]);
                        GAS bf16_t* p = q + (size_t)row * 768 + 512 + (4 * bj + wc) * 32 + 4 * fq; *(GAS u32x2*)p = w0; *(GAS u32x2*)(p + 16) = w1; }
                } }
    }
};
struct D1Order {
    StaticOrder so; size_t dA, dB;
    __device__ __forceinline__ bool next(int i, Unit& u) const { if (i >= 9) return false; if (!so.next(0, u)) return false; u.sel = i; return true; }
    __device__ __forceinline__ void a_ready(const Unit&) const {}
    __device__ __forceinline__ void done(const Unit&) const {}
    __device__ __forceinline__ size_t a_off(const Unit& u) const { const int z = u.sel / 3, p = u.sel - 3 * z; return p == 2 ? dA + (size_t)(z >> 1) * 16384 * 2048 + (size_t)(z & 1) * 1024 : (size_t)p * 1024; }
    __device__ __forceinline__ size_t b_off(const Unit& u) const { const int z = u.sel / 3, p = u.sel - 3 * z; return p == 2 ? dB + (size_t)(z >> 1) * 1024 * 2048 + (size_t)(z & 1) * 1024 : (size_t)z * 1024 * 2048 + (size_t)p * 1024; }
    __device__ __forceinline__ bool keep(const Unit& u) const { return (u.sel % 3) == 0; }
};
struct EpiD1 {
    static constexpr bool PERM = true, AFTER_DRAIN = false;
    GAS bf16_t* g; GAS bf16_t* mb; const GAS float* ssq;
    __device__ __forceinline__ void operator()(const f32x4 (&acc)[2][2][4][2], const Unit& u, int wr, int wc, int fr, int fq) const {
        const int col0 = u.pn * BM + wc * 32 + 8 * fq, row0 = u.pm * BM + wr * 64 + fr, z = u.sel / 3;
        if (u.sel % 3 == 1) {
            float rr[2][4];
#pragma unroll
            for (int ai = 0; ai < 2; ++ai)
#pragma unroll
                for (int m = 0; m < 4; ++m) rr[ai][m] = -PG8_L2E * rstd_parts(ssq, (unsigned)((row0 + ai * HALF + m * 16) * 16), 4, 1.f / 1024.f);
#pragma unroll
            for (int ai = 0; ai < 2; ++ai)
#pragma unroll
                for (int m = 0; m < 4; ++m) { const int row = row0 + ai * HALF + m * 16; const float r = rr[ai][m];
#pragma unroll
                    for (int bj = 0; bj < 2; ++bj) { float s[8];
#pragma unroll
                        for (int j = 0; j < 8; ++j) s[j] = __builtin_amdgcn_rcpf(1.f + __builtin_amdgcn_exp2f(acc[ai][bj][m][j >> 2][j & 3] * r));
                        u32x4 w; w.x = pk2(s[0], s[1]); w.y = pk2(s[2], s[3]); w.z = pk2(s[4], s[5]); w.w = pk2(s[6], s[7]);
                        *(GAS u32x4*)(g + (size_t)row * 1024 + col0 + bj * HALF) = w; } }
        } else {
#pragma unroll
            for (int ai = 0; ai < 2; ++ai) {
                u32x4 gw[4][2], pw[4][2];
#pragma unroll
                for (int m = 0; m < 4; ++m)
#pragma unroll
                    for (int bj = 0; bj < 2; ++bj) { const size_t o = (size_t)(row0 + ai * HALF + m * 16) * 1024 + col0 + bj * HALF; gw[m][bj] = *(const GAS u32x4*)(g + o);
                        if (z > 0) pw[m][bj] = *(const GAS u32x4*)(mb + o); else pw[m][bj] = (u32x4){0u, 0u, 0u, 0u}; }
#pragma unroll
                for (int m = 0; m < 4; ++m)
#pragma unroll
                    for (int bj = 0; bj < 2; ++bj) { const size_t o = (size_t)(row0 + ai * HALF + m * 16) * 1024 + col0 + bj * HALF; const u32x4 gq = gw[m][bj], pm_ = pw[m][bj];
                        f32x4 a0 = acc[ai][bj][m][0], a1 = acc[ai][bj][m][1];
                        a0[0] = a0[0] * bflo(gq.x) + bflo(pm_.x); a0[1] = a0[1] * bfhi(gq.x) + bfhi(pm_.x); a0[2] = a0[2] * bflo(gq.y) + bflo(pm_.y); a0[3] = a0[3] * bfhi(gq.y) + bfhi(pm_.y);
                        a1[0] = a1[0] * bflo(gq.z) + bflo(pm_.z); a1[1] = a1[1] * bfhi(gq.z) + bfhi(pm_.z); a1[2] = a1[2] * bflo(gq.w) + bflo(pm_.w); a1[3] = a1[3] * bfhi(gq.w) + bfhi(pm_.w);
                        u32x4 w; w.x = pk2(a0[0], a0[1]); w.y = pk2(a0[2], a0[3]); w.z = pk2(a1[0], a1[1]); w.w = pk2(a1[2], a1[3]); *(GAS u32x4*)(mb + o) = w; } }
        }
    }
};
struct EpiRes {
    static constexpr bool PERM = true, AFTER_DRAIN = false;
    GAS bf16_t* xb; GAS float* ssq;
    __device__ __forceinline__ void operator()(const f32x4 (&acc)[2][2][4][2], const Unit& u, int wr, int wc, int fr, int fq) const {
        const int col0 = u.pn * BM + wc * 32 + 8 * fq, row0 = u.pm * BM + wr * 64 + fr;
#pragma unroll
        for (int ai = 0; ai < 2; ++ai) {
            u32x4 xv[4][2];
#pragma unroll
            for (int m = 0; m < 4; ++m)
#pragma unroll
                for (int bj = 0; bj < 2; ++bj) xv[m][bj] = *(const GAS u32x4*)(xb + (size_t)(row0 + ai * HALF + m * 16) * 1024 + col0 + bj * HALF);
#pragma unroll
            for (int m = 0; m < 4; ++m) { const int row = row0 + ai * HALF + m * 16; const size_t rb = (size_t)row * 1024 + col0; float s2 = 0.f;
#pragma unroll
                for (int bj = 0; bj < 2; ++bj) { const u32x4 xw = xv[m][bj]; const f32x4 a0 = acc[ai][bj][m][0], a1 = acc[ai][bj][m][1];
                    const float v0 = bflo(xw.x) + a0[0], v1 = bfhi(xw.x) + a0[1], v2 = bflo(xw.y) + a0[2], v3 = bfhi(xw.y) + a0[3];
                    const float v4 = bflo(xw.z) + a1[0], v5 = bfhi(xw.z) + a1[1], v6 = bflo(xw.w) + a1[2], v7 = bfhi(xw.w) + a1[3];
                    u32x4 w; w.x = pk2(v0, v1); w.y = pk2(v2, v3); w.z = pk2(v4, v5); w.w = pk2(v6, v7);
                    *(GAS u32x4*)(xb + rb + bj * HALF) = w;
                    s2 += ((v0 * v0 + v1 * v1) + (v2 * v2 + v3 * v3)) + ((v4 * v4 + v5 * v5) + (v6 * v6 + v7 * v7)); }
                s2 += __shfl_xor(s2, 16); s2 += __shfl_xor(s2, 32);
                if (fq == 0) ssq[(size_t)row * 16 + u.pn * 4 + wc] = s2; } }
    }
};
struct EpiAct {
    static constexpr bool PERM = true, AFTER_DRAIN = false;
    GAS bf16_t* act; const GAS float* s_rstd; const GAS float* s_w;
    __device__ __forceinline__ void operator()(const f32x4 (&acc)[2][2][4][2], const Unit& u, int wr, int wc, int fr, int fq) const {
        const int t = u.pn & 1, row0 = u.pm * BM + wr * 64 + fr;
        const __amdgpu_buffer_rsrc_t rsrc = __builtin_amdgcn_make_buffer_rsrc((void*)act, 0, 40960 * 256 * 2, 0x00020000);
        float rr[2][4], ww[2][4];
#pragma unroll
        for (int ai = 0; ai < 2; ++ai)
#pragma unroll
            for (int m = 0; m < 4; ++m) { rr[ai][m] = s_rstd[row0 + ai * HALF + m * 16]; ww[ai][m] = s_w[row0 + ai * HALF + m * 16]; }
#pragma unroll
        for (int ai = 0; ai < 2; ++ai)
#pragma unroll
            for (int m = 0; m < 4; ++m) { const int row = row0 + ai * HALF + m * 16; const float rs = rr[ai][m], w = ww[ai][m]; float o[8];
#pragma unroll
                for (int j = 0; j < 8; ++j) { const float a = acc[ai][0][m][j >> 2][j & 3] * rs, b = acc[ai][1][m][j >> 2][j & 3] * rs;
                    const float v = a * __builtin_amdgcn_rcpf(1.f + __builtin_amdgcn_exp2f(-PG8_L2E * a)) * b * w; o[j] = (w != 0.f) ? v : 0.f; }
                u32x4 pw; pw.x = pk2(o[0], o[1]); pw.y = pk2(o[2], o[3]); pw.z = pk2(o[4], o[5]); pw.w = pk2(o[6], o[7]);
                __builtin_amdgcn_raw_buffer_store_b128(pw, rsrc, (unsigned)(row * 256 + t * 128 + wc * 32 + 8 * fq) * 2u, 0,   16); }
    }
};
struct SplitK2Order {
    StaticOrder so; size_t tstep;
    __device__ __forceinline__ bool next(int i, Unit& u) const { return so.next(i, u); }
    __device__ __forceinline__ void a_ready(const Unit&) const {}
    __device__ __forceinline__ void done(const Unit&) const {}
    __device__ __forceinline__ size_t a_off(const Unit& u) const { return (size_t)(u.pn >> 1) * 1024; }
    __device__ __forceinline__ size_t b_off(const Unit& u) const { return (size_t)(u.pn >> 1) * 1024 - (size_t)(u.pn >> 1) * 2 * tstep; }
    __device__ __forceinline__ bool keep(const Unit&) const { return false; }
};
struct MoeOrder {
    const PG8_LAS int* tstart; int per, G, v;
    __device__ __forceinline__ bool next(int i, Unit& u) const {
        const int idx = i * G + v, tot = tstart[32] * per; if (idx >= tot) return false;
        const int ti = idx / per, ct = idx - ti * per; int e = 0;
#pragma unroll 1
        for (int k = 1; k < 32; ++k) e += (tstart[k] <= ti) ? 1 : 0;
        u.pm = ti; u.pn = e * per + ct; u.sel = 0; return true;
    }
    __device__ __forceinline__ void a_ready(const Unit&) const {}
    __device__ __forceinline__ void done(const Unit&) const {}
    __device__ __forceinline__ size_t a_off(const Unit&) const { return 0; }
    __device__ __forceinline__ size_t b_off(const Unit&) const { return 0; }
    __device__ __forceinline__ bool keep(const Unit&) const { return false; }
};
struct MoeOrderP {
    const PG8_LAS int* tstart; GAS unsigned* cnt; int G, v;
    __device__ __forceinline__ bool next(int i, Unit& u) const {
        const int idx = i * G + v, tot = tstart[32] * 2; if (idx >= tot) return false;
        const int ti = idx >> 1, ct = idx & 1; int e = 0;
#pragma unroll 1
        for (int k = 1; k < 32; ++k) e += (tstart[k] <= ti) ? 1 : 0;
        u.pm = ti; u.pn = e * 2 + ct; u.sel = 0; return true;
    }
    __device__ __forceinline__ void a_ready(const Unit&) const {}
    __device__ __forceinline__ void done(const Unit& u) const {
        asm volatile("s_waitcnt vmcnt(0)" ::: "memory");
        int ln; asm volatile("v_mbcnt_lo_u32_b32 %0, -1, 0\n\tv_mbcnt_hi_u32_b32 %0, -1, %0" : "=v"(ln));
        if (ln == 0) __hip_atomic_fetch_add(cnt + u.pm, 1u, __ATOMIC_RELAXED, __HIP_MEMORY_SCOPE_AGENT);
    }
    __device__ __forceinline__ size_t a_off(const Unit&) const { return 0; }
    __device__ __forceinline__ size_t b_off(const Unit&) const { return 0; }
    __device__ __forceinline__ bool keep(const Unit&) const { return false; }
};
struct MoeOrderC {
    const PG8_LAS int* tstart; const GAS unsigned* cnt; int G, v, wid;
    __device__ __forceinline__ bool next(int i, Unit& u) const {
        const int T = tstart[32], L = (2 * T > G) ? 2 * T - G : 0, R = G - L;
        const int idx = (v >= L) ? ((i < 2) ? i * R + (v - L) : 2 * R + (i - 2) * G + v) : 2 * R + i * G + v;
        if (idx >= 4 * T) return false;
        const int ti = idx >> 2, ct = idx & 3; int e = 0;
#pragma unroll 1
        for (int k = 1; k < 32; ++k) e += (tstart[k] <= ti) ? 1 : 0;
        u.pm = ti; u.pn = e * 4 + ct; u.sel = 0; return true;
    }
    __device__ __forceinline__ void a_ready(const Unit& u) const {
        if (wid == 0) {
            const GAS unsigned* c = cnt + u.pm; int spins = 0;
#pragma unroll 1
            while ((unsigned)__builtin_amdgcn_readfirstlane(__hip_atomic_load(c, __ATOMIC_RELAXED, __HIP_MEMORY_SCOPE_AGENT)) < 16u && ++spins < (1 << 22)) __builtin_amdgcn_s_sleep(2);
            __builtin_amdgcn_fence(__ATOMIC_ACQUIRE, "agent");
            asm volatile("s_waitcnt vmcnt(0)" ::: "memory");
        }
        __builtin_amdgcn_s_barrier();
    }
    __device__ __forceinline__ void done(const Unit&) const {}
    __device__ __forceinline__ size_t a_off(const Unit&) const { return 0; }
    __device__ __forceinline__ size_t b_off(const Unit&) const { return 0; }
    __device__ __forceinline__ bool keep(const Unit&) const { return false; }
};
}
namespace att {
typedef unsigned short bf16;
typedef short bf16x8 __attribute__((ext_vector_type(8)));
typedef short s16x4 __attribute__((ext_vector_type(4)));
typedef float f32x16 __attribute__((ext_vector_type(16)));
typedef float f32x4 __attribute__((ext_vector_type(4)));
typedef unsigned u32x4 __attribute__((ext_vector_type(4)));
typedef unsigned u32x2 __attribute__((ext_vector_type(2)));
typedef float f32x2v __attribute__((ext_vector_type(2)));
typedef __bf16 bf16x2v __attribute__((ext_vector_type(2)));
__device__ __forceinline__ unsigned pk2(float lo, float hi) { f32x2v v = {lo, hi}; bf16x2v b = __builtin_convertvector(v, bf16x2v); return __builtin_bit_cast(unsigned, b); }
__device__ __forceinline__ float bflo(unsigned w) { return __builtin_bit_cast(float, w << 16); }
__device__ __forceinline__ float bfhi(unsigned w) { return __builtin_bit_cast(float, w & 0xffff0000u); }
__device__ __forceinline__ int crow(int r, int hi) { return (r & 3) + 8 * (r >> 2) + 4 * hi; }
__device__ __forceinline__ float xhalf(float v) {
    const unsigned u = __builtin_bit_cast(unsigned, v);
    auto rr = __builtin_amdgcn_permlane32_swap(u, u, false, false);
    const unsigned o = (rr[0] != u) ? rr[0] : rr[1];
    return __builtin_bit_cast(float, o);
}
__device__ __forceinline__ bf16x8 mk8(unsigned a, unsigned b, unsigned c, unsigned d) { u32x4 w = {a, b, c, d}; return __builtin_bit_cast(bf16x8, w); }

constexpr int VPB = 144;
template <int DK> struct KLay { static constexpr int KPB = (DK + 8) * 2, KBUF = 64 * KPB; };

template <int DK, int DV, bool KROPE> struct Stage {
    static constexpr int NK = KROPE ? 1 : DK / 64, NV = DV / 64;
    u32x4 kr[NK]; u32x4 kr2; u32x4 vr[NV];
    __device__ __forceinline__ void loadK(int tid, const GAS bf16* Kg, int ldk, const GAS bf16* K2g, int kv0) {
        const GAS char* kbase = (const GAS char*)(Kg + (size_t)kv0 * ldk);
        if constexpr (KROPE) {
            kr[0] = *(const GAS u32x4*)(kbase + (unsigned)(((tid >> 3) * ldk + 8 * (tid & 7)) * 2));
            if (tid < 256) kr2 = *(const GAS u32x4*)((const GAS char*)(K2g + (size_t)kv0 * 32) + (unsigned)(tid * 16));
        } else {
#pragma unroll
            for (int i = 0; i < NK; ++i) { const int p = tid + 512 * i, row = p / (DK / 8), ch = p % (DK / 8); kr[i] = *(const GAS u32x4*)(kbase + (unsigned)((row * ldk + 8 * ch) * 2)); }
        }
    }
    __device__ __forceinline__ void loadV(int tid, const GAS bf16* Vg, int ldv, int kv0) {
        const GAS char* vbase = (const GAS char*)(Vg + kv0);
#pragma unroll
        for (int i = 0; i < NV; ++i) { const int p = tid + 512 * i, dd = p >> 3, ch = p & 7; vr[i] = *(const GAS u32x4*)(vbase + (unsigned)((dd * ldv + 8 * ch) * 2)); }
    }
    __device__ __forceinline__ void storeK(int tid, LAS unsigned char* kb) const {
        constexpr int KPB = KLay<DK>::KPB;
        if constexpr (KROPE) {
            *(LAS u32x4*)(kb + (tid >> 3) * KPB + 16 * (tid & 7)) = kr[0];
            if (tid < 256) *(LAS u32x4*)(kb + (tid >> 2) * KPB + 128 + 16 * (tid & 3)) = kr2;
        } else {
#pragma unroll
            for (int i = 0; i < NK; ++i) { const int p = tid + 512 * i, row = p / (DK / 8), ch = p % (DK / 8); *(LAS u32x4*)(kb + row * KPB + 16 * ch) = kr[i]; }
        }
    }
    __device__ __forceinline__ void storeV(int tid, LAS unsigned char* vb) const {
#pragma unroll
        for (int i = 0; i < NV; ++i) { const int p = tid + 512 * i, dd = p >> 3, ch = p & 7; LAS unsigned char* q = vb + dd * VPB + 32 * (ch >> 1) + 8 * (ch & 1);
            *(LAS u32x2*)q = (u32x2){vr[i].x, vr[i].y}; *(LAS u32x2*)(q + 16) = (u32x2){vr[i].z, vr[i].w}; }
    }
    __device__ __forceinline__ void load(int tid, const GAS bf16* Kg, int ldk, const GAS bf16* K2g, const GAS bf16* Vg, int ldv, int kv0) { loadK(tid, Kg, ldk, K2g, kv0); loadV(tid, Vg, ldv, kv0); }
    __device__ __forceinline__ void store(int tid, LAS unsigned char* kb, LAS unsigned char* vb) const { storeK(tid, kb); storeV(tid, vb); }
};

template <int DK> __device__ __forceinline__ void qkt(f32x16& p0, f32x16& p1, const LAS unsigned char* kb, const bf16x8 (&qf)[DK / 16], int r32, int hi) {
    constexpr int KPB = KLay<DK>::KPB;
    const LAS unsigned char* k0 = kb + r32 * KPB + hi * 16;
#pragma unroll
    for (int d0 = 0; d0 < DK / 16; ++d0) {
        const bf16x8 a0 = *(const LAS bf16x8*)(k0 + d0 * 32), a1 = *(const LAS bf16x8*)(k0 + 32 * KPB + d0 * 32);
        p0 = __builtin_amdgcn_mfma_f32_32x32x16_bf16(a0, qf[d0], p0, 0, 0, 0);
        p1 = __builtin_amdgcn_mfma_f32_32x32x16_bf16(a1, qf[d0], p1, 0, 0, 0);
    }
}
template <int DK> __device__ __forceinline__ void qkt_qmem(f32x16& p0, f32x16& p1, const LAS unsigned char* kb, const bf16x8* qf, const LAS unsigned char* qlds, int r32, int hi) {
    constexpr int KPB = KLay<DK>::KPB, QR = DK / 32;
    const LAS unsigned char* k0 = kb + r32 * KPB + hi * 16;
#pragma unroll
    for (int d0 = 0; d0 < DK / 16; ++d0) {
        bf16x8 q; if (d0 < QR) q = qf[d0]; else q = *(const LAS bf16x8*)(qlds + (d0 - QR) * 1024);
        const bf16x8 a0 = *(const LAS bf16x8*)(k0 + d0 * 32), a1 = *(const LAS bf16x8*)(k0 + 32 * KPB + d0 * 32);
        p0 = __builtin_amdgcn_mfma_f32_32x32x16_bf16(a0, q, p0, 0, 0, 0);
        p1 = __builtin_amdgcn_mfma_f32_32x32x16_bf16(a1, q, p1, 0, 0, 0);
        if ((d0 & 3) == 3) __builtin_amdgcn_sched_barrier(0);
    }
}
template <int DV> __device__ __forceinline__ void pv(f32x16 (&o)[DV / 32], const LAS unsigned char* vb, const bf16x8 (&pf)[4], int r32, int hi) {
#pragma unroll
    for (int db = 0; db < DV / 32; ++db) {
        const LAS unsigned char* v0 = vb + (32 * db + r32) * VPB + 16 * hi;
#pragma unroll
        for (int s = 0; s < 4; ++s) {
            const bf16x8 vf = *(const LAS bf16x8*)(v0 + 32 * s);
            o[db] = __builtin_amdgcn_mfma_f32_32x32x16_bf16(vf, pf[s], o[db], 0, 0, 0);
        }
        if (DV > 64) __builtin_amdgcn_sched_barrier(0);
    }
}
__device__ __forceinline__ void pack_p(bf16x8 (&pf)[4], const f32x16& p0, const f32x16& p1) {
    pf[0] = mk8(pk2(p0[0], p0[1]), pk2(p0[2], p0[3]), pk2(p0[4], p0[5]), pk2(p0[6], p0[7]));
    pf[1] = mk8(pk2(p0[8], p0[9]), pk2(p0[10], p0[11]), pk2(p0[12], p0[13]), pk2(p0[14], p0[15]));
    pf[2] = mk8(pk2(p1[0], p1[1]), pk2(p1[2], p1[3]), pk2(p1[4], p1[5]), pk2(p1[6], p1[7]));
    pf[3] = mk8(pk2(p1[8], p1[9]), pk2(p1[10], p1[11]), pk2(p1[12], p1[13]), pk2(p1[14], p1[15]));
}

template <bool ALIBI> __device__ __forceinline__ void fl_init(f32x16& p0, f32x16& p1, float slope2, int kv0, int hi, int qrow) {
    if (ALIBI) {
        const float s2 = slope2 + slope2, s4 = s2 + s2, s8 = s4 + s4, s32 = (s8 + s8) + (s8 + s8);
        float g = slope2 * (float)(kv0 + 4 * hi - qrow);
#pragma unroll
        for (int c = 0; c < 4; ++c) { float v = g;
#pragma unroll
            for (int e = 0; e < 4; ++e) { p0[4 * c + e] = v; p1[4 * c + e] = v + s32; v += slope2; }
            g += s8; } }
    else {
#pragma unroll
        for (int r = 0; r < 16; ++r) { p0[r] = 0.f; p1[r] = 0.f; } }
}
__device__ __forceinline__ void fl_mask(f32x16& p0, f32x16& p1, int kv0, int hi, int qrow) {
    const int thr = qrow - kv0 - 4 * hi;
#pragma unroll
    for (int r = 0; r < 16; ++r) { const int c = (r & 3) + 8 * (r >> 2); if (c > thr) p0[r] = -INFINITY; if (c + 32 > thr) p1[r] = -INFINITY; }
}
__device__ __forceinline__ void fl_start(const f32x16& p0, const f32x16& p1, float& m, float& alpha) {
    float mx = fmaxf(p0[0], p1[0]);
#pragma unroll
    for (int r = 1; r < 16; ++r) mx = fmaxf(fmaxf(mx, p0[r]), p1[r]);
    mx = fmaxf(mx, xhalf(mx));
    const float mn = fmaxf(m, mx); alpha = __builtin_amdgcn_exp2f(m - mn); m = mn;
}
__device__ __forceinline__ void fl_finish(f32x16& p0, f32x16& p1, float m, float& l, bf16x8 (&pf)[4]) {
    float s0 = 0.f, s1 = 0.f;
#pragma unroll
    for (int r = 0; r < 16; ++r) { p0[r] = __builtin_amdgcn_exp2f(p0[r] - m); p1[r] = __builtin_amdgcn_exp2f(p1[r] - m); s0 += p0[r]; s1 += p1[r]; }
    l += s0 + s1;
    pack_p(pf, p0, p1);
}

#define FL_EL(P0, P1, e) ((e) < 16 ? P0[(e) & 15] : P1[(e) & 15])
template <int DK, bool QMEM> __device__ __forceinline__ void fl_blockX(f32x16& n0, f32x16& n1, const LAS unsigned char* kb, const bf16x8* qf, const LAS unsigned char* qlds, int r32, int hi,
                                                                         f32x16& c0, f32x16& c1, float m, float& l, bf16x8 (&pf)[4]) {
    constexpr int KPB = KLay<DK>::KPB, NS = DK / 16, CH = ((32 + NS - 1) / NS + 1) & ~1;
    const LAS unsigned char* k0 = kb + r32 * KPB + hi * 16;
    float s0 = 0.f, s1 = 0.f; unsigned pw[16];
#define FLX_K0(s) (*(const LAS bf16x8*)(k0 + ((s) < NS ? (s) : NS - 1) * 32))
#define FLX_K1(s) (*(const LAS bf16x8*)(k0 + 32 * KPB + ((s) < NS ? (s) : NS - 1) * 32))
    bf16x8 a0 = FLX_K0(0), a1 = FLX_K1(0), b0 = FLX_K0(1), b1 = FLX_K1(1), e0 = FLX_K0(2), e1 = FLX_K1(2);
    bf16x8 q, qb, qe; if constexpr (QMEM) { q = *(const LAS bf16x8*)(qlds); qb = *(const LAS bf16x8*)(qlds + (NS > 1 ? 1024 : 0)); qe = *(const LAS bf16x8*)(qlds + (NS > 2 ? 2048 : 0)); } else { q = qf[0]; qb = qf[NS > 1 ? 1 : 0]; qe = qf[NS > 2 ? 2 : 0]; }
#pragma unroll
    for (int d0 = 0; d0 < NS; ++d0) {
        bf16x8 c0n = e0, c1n = e1, qc = qe;
        if (d0 + 3 < NS) { c0n = FLX_K0(d0 + 3); c1n = FLX_K1(d0 + 3);
            if constexpr (QMEM) qc = *(const LAS bf16x8*)(qlds + (d0 + 3) * 1024); else qc = qf[d0 + 3]; }
        n0 = __builtin_amdgcn_mfma_f32_32x32x16_bf16(a0, q, n0, 0, 0, 0);
        n1 = __builtin_amdgcn_mfma_f32_32x32x16_bf16(a1, q, n1, 0, 0, 0);
#pragma unroll
        for (int e = d0 * CH; e < (d0 + 1) * CH && e < 32; e += 2) {
            float x, y;
            if (e < 16) { x = __builtin_amdgcn_exp2f(c0[e] - m); y = __builtin_amdgcn_exp2f(c0[e + 1] - m); s0 += x; s1 += y; }
            else { x = __builtin_amdgcn_exp2f(c1[e - 16] - m); y = __builtin_amdgcn_exp2f(c1[e - 15] - m); s0 += x; s1 += y; }
            pw[e >> 1] = pk2(x, y); asm volatile("" : "+v"(pw[e >> 1])); }
        asm volatile("" : "+v"(s0), "+v"(s1));
        __builtin_amdgcn_sched_barrier(0);
        a0 = b0; a1 = b1; q = qb; b0 = e0; b1 = e1; qb = qe; e0 = c0n; e1 = c1n; qe = qc;
    }
#undef FLX_K0
#undef FLX_K1
    l += s0 + s1;
    pf[0] = mk8(pw[0], pw[1], pw[2], pw[3]); pf[1] = mk8(pw[4], pw[5], pw[6], pw[7]); pf[2] = mk8(pw[8], pw[9], pw[10], pw[11]); pf[3] = mk8(pw[12], pw[13], pw[14], pw[15]);
}
template <int DV> __device__ __forceinline__ void fl_blockY(f32x16 (&o)[DV / 32], const LAS unsigned char* vb, const bf16x8 (&pf)[4], int r32, int hi, const f32x16& n0, const f32x16& n1, float& m, float& alpha) {
    constexpr int NS = DV / 8, CH = 32 / NS;
    float mx0 = -INFINITY, mx1 = -INFINITY;
    const LAS unsigned char* v0 = vb + r32 * VPB + 16 * hi;
    bf16x8 vf = *(const LAS bf16x8*)(v0), vg = *(const LAS bf16x8*)(v0 + 32);
#pragma unroll
    for (int st = 0; st < NS; ++st) {
        const int db = st >> 2, s = st & 3;
        bf16x8 vn = vg;
        if (st + 2 < NS) vn = *(const LAS bf16x8*)(v0 + ((st + 2) >> 2) * 32 * VPB + 32 * ((st + 2) & 3));
        o[db] = __builtin_amdgcn_mfma_f32_32x32x16_bf16(vf, pf[s], o[db], 0, 0, 0);
#pragma unroll
        for (int e = st * CH; e < (st + 1) * CH; ++e) { if (e < 16) mx0 = fmaxf(mx0, n0[e]); else mx1 = fmaxf(mx1, n1[e - 16]); }
        asm volatile("" : "+v"(mx0), "+v"(mx1));
        __builtin_amdgcn_sched_barrier(0);
        vf = vg; vg = vn;
    }
    float mx = fmaxf(mx0, mx1); mx = fmaxf(mx, xhalf(mx));
    const float mn = fmaxf(m, mx); alpha = __builtin_amdgcn_exp2f(m - mn); m = mn;
}

template <int DK, int DV, bool CAUSAL, bool ALIBI, bool KROPE, bool QMEM = false, bool DESC = false>
__device__ __forceinline__ void flash_pass(LAS unsigned char* lds, int tid, const GAS bf16* Qrow, const GAS bf16* Qrow2, const GAS bf16* Kg, int ldk, const GAS bf16* K2g, const GAS bf16* Vg, int ldv,
                                           int NT, int ntw, int qrow, float slope2, f32x16 (&o)[DV / 32], float& lsum, const GAS unsigned* kn = nullptr, int abl = 0) {
    constexpr int KBUF = KLay<DK>::KBUF, VBUF = DV * VPB, QOFF = 2 * KBUF + 2 * VBUF, XOFF = QOFF + 8 * (DK / 16) * 1024;
    constexpr bool CUT = DESC && ALIBI;
    const int lane = tid & 63, r32 = lane & 31, hi = lane >> 5, wid = tid >> 6;
#define FL_TI(i) (DESC ? NT - 1 - (i) : (i))
    bf16x8 qf[QMEM ? 1 : DK / 16];
    LAS unsigned char* qlds = lds + QOFF + wid * (DK / 16) * 1024 + lane * 16;
    float qn2 = 0.f;
#pragma unroll
    for (int d0 = 0; d0 < DK / 16; ++d0) {
        bf16x8 v;
        if (KROPE && d0 >= 4) v = *(const GAS bf16x8*)(Qrow2 + 16 * (d0 - 4) + 8 * hi);
        else v = *(const GAS bf16x8*)(Qrow + 16 * d0 + 8 * hi);
        if constexpr (CUT) {
#pragma unroll
            for (int j = 0; j < 8; ++j) { const float f = __builtin_bit_cast(float, (unsigned)(unsigned short)v[j] << 16); qn2 += f * f; } }
        if constexpr (QMEM) *(LAS bf16x8*)(qlds + d0 * 1024) = v; else qf[d0] = v;
    }
    volatile LAS float* kpre = (volatile LAS float*)(lds + XOFF);
    volatile LAS unsigned* dflag = (volatile LAS unsigned*)(lds + XOFF + 512);
    float qn = 0.f;
    if constexpr (CUT) {
        qn2 += xhalf(qn2); qn = sqrtf(qn2);
        if (wid == 0) {
            float v0 = 0.f, v1 = 0.f;
            if (lane < NT) v0 = sqrtf(__builtin_bit_cast(float, kn[(size_t)lane * 16]) + __builtin_bit_cast(float, kn[(size_t)lane * 16 + 1])) * 1.01f;
            if (lane + 64 < NT) v1 = sqrtf(__builtin_bit_cast(float, kn[(size_t)(lane + 64) * 16]) + __builtin_bit_cast(float, kn[(size_t)(lane + 64) * 16 + 1])) * 1.01f;
#pragma unroll
            for (int dd = 1; dd < 64; dd <<= 1) { const float u0 = __shfl_up(v0, dd), u1 = __shfl_up(v1, dd); if (lane >= dd) { v0 = fmaxf(v0, u0); v1 = fmaxf(v1, u1); } }
            v1 = fmaxf(v1, __shfl(v0, 63));
            kpre[lane] = v0; kpre[lane + 64] = v1;
        }
    }
#pragma unroll
    for (int db = 0; db < DV / 32; ++db)
#pragma unroll
        for (int r = 0; r < 16; ++r) o[db][r] = 0.f;
    float m = -INFINITY, l = 0.f, alpha = 1.0f;
    int cut = NT;
    Stage<DK, DV, KROPE> st;
    st.loadK(tid, Kg, ldk, K2g, 64 * FL_TI(0)); st.loadV(tid, Vg, ldv, 64 * FL_TI(0));
    st.storeK(tid, lds); st.storeV(tid, lds + 2 * KBUF);
    if (NT > 1) { st.loadK(tid, Kg, ldk, K2g, 64 * FL_TI(1)); st.storeK(tid, lds + KBUF); }
    __syncthreads();
    if (NT > 2) st.loadK(tid, Kg, ldk, K2g, 64 * FL_TI(2));
    if (NT > 1) st.loadV(tid, Vg, ldv, 64 * FL_TI(1));
    f32x16 pa0, pa1, pb0, pb1;
#define FL_QKT(P0, P1, KB) do { if constexpr (QMEM) { bf16x8 qt_[DK / 16]; _Pragma("unroll") for (int d0 = 0; d0 < DK / 16; ++d0) qt_[d0] = *(const LAS bf16x8*)(qlds + d0 * 1024); qkt<DK>(P0, P1, KB, qt_, r32, hi); } else qkt<DK>(P0, P1, KB, qf, r32, hi); } while (0)
#define FL_FIRST(P0, P1, KB, TILE) do { const int kv_ = 64 * (TILE); fl_init<ALIBI>(P0, P1, slope2, kv_, hi, qrow); FL_QKT(P0, P1, KB); \
        if (CAUSAL && kv_ + 63 > qrow - r32) fl_mask(P0, P1, kv_, hi, qrow); fl_start(P0, P1, m, alpha); } while (0)
    if (FL_TI(0) < ntw) FL_FIRST(pa0, pa1, lds, FL_TI(0));
    __syncthreads();
    for (int i = 0; i < NT; ++i) {
        int tq_ = tid; asm volatile("" : "+v"(tq_));
        if (!(abl & 1)) {
            if (i + 2 < NT) st.storeK(tq_, lds + (i & 1) * KBUF);
            if (i + 1 < NT) st.storeV(tq_, lds + 2 * KBUF + ((i + 1) & 1) * VBUF);
            if (i + 3 < NT) st.loadK(tq_, Kg, ldk, K2g, 64 * FL_TI(i + 3));
            if (i + 2 < NT) st.loadV(tq_, Vg, ldv, 64 * FL_TI(i + 2)); }
        const int tc = FL_TI(i), tn = FL_TI(i + 1);
        const bool ac = tc < ntw && i < cut && !(abl & 2);
        bool an = i + 1 < NT && tn < ntw && i + 1 < cut && !(abl & 2);
        if constexpr (CUT) {
            if (ac && an) {
                const bool dead = qn * kpre[tn] + slope2 * (float)(64 * tn + 63 - qrow) < m - 64.f;
                if (__all(dead)) { cut = i + 1; an = false; } } }
        const LAS unsigned char* kn_ = lds + ((i + 1) & 1) * KBUF; const LAS unsigned char* vc_ = lds + 2 * KBUF + (i & 1) * VBUF;
        if (ac) {
            l *= alpha;
            if (__any(alpha != 1.0f)) {
#pragma unroll
                for (int db = 0; db < DV / 32; ++db) asm volatile("" : "+v"(o[db]));
#pragma unroll
                for (int db = 0; db < DV / 32; ++db)
#pragma unroll
                    for (int r = 0; r < 16; ++r) o[db][r] *= alpha;
#pragma unroll
                for (int db = 0; db < DV / 32; ++db) asm volatile("" : "+v"(o[db])); }
            bf16x8 pf[4];
            if (an) {
                const int kv1_ = 64 * tn;
                const bool diag_ = CAUSAL && (kv1_ + 63 > qrow - r32);
                fl_init<ALIBI>(pb0, pb1, slope2, kv1_, hi, qrow);
                fl_blockX<DK, QMEM>(pb0, pb1, kn_, qf, qlds, r32, hi, pa0, pa1, m, l, pf);
                if (!diag_) { fl_blockY<DV>(o, vc_, pf, r32, hi, pb0, pb1, m, alpha); }
                else { pv<DV>(o, vc_, pf, r32, hi); fl_mask(pb0, pb1, kv1_, hi, qrow); fl_start(pb0, pb1, m, alpha); }
            } else {
                fl_finish(pa0, pa1, m, l, pf); pv<DV>(o, vc_, pf, r32, hi);
            }
        } else if (an) { FL_FIRST(pb0, pb1, kn_, tn); }
        if constexpr (CUT) { if (lane == 0) dflag[(i & 1) * 8 + wid] = (i + 1 >= cut) ? 1u : 0u; }
        if (!(abl & 4)) __syncthreads();
        if constexpr (CUT) { unsigned alld = 1u;
#pragma unroll
            for (int w = 0; w < 8; ++w) alld &= dflag[(i & 1) * 8 + w];
            if (alld) break; }
        if (!(abl & 8)) { pa0 = pb0; pa1 = pb1; }
    }
#undef FL_FIRST
#undef FL_QKT
#undef FL_TI
    lsum = l + xhalf(l);
}

template <int DK, int DV, bool CAUSAL, bool ALIBI, bool KROPE, bool QMEM = false>
__device__ __forceinline__ void flash_pass_simple(LAS unsigned char* lds, int tid, const GAS bf16* Qrow, const GAS bf16* Qrow2, const GAS bf16* Kg, int ldk, const GAS bf16* K2g, const GAS bf16* Vg, int ldv,
                                           int NT, int ntw, int qrow, float slope2, f32x16 (&o)[DV / 32], float& lsum) {
    constexpr int KBUF = KLay<DK>::KBUF, VBUF = DV * VPB;
    const int lane = tid & 63, r32 = lane & 31, hi = lane >> 5;
    constexpr int QR = QMEM ? DK / 32 : DK / 16;
    bf16x8 qf[QR];
    LAS unsigned char* qlds = lds + 2 * KBUF + 2 * VBUF + (tid >> 6) * (DK / 16 - QR + 1) * 1024 + lane * 16;
#pragma unroll
    for (int d0 = 0; d0 < DK / 16; ++d0) {
        bf16x8 v;
        if (KROPE && d0 >= 4) v = *(const GAS bf16x8*)(Qrow2 + 16 * (d0 - 4) + 8 * hi);
        else v = *(const GAS bf16x8*)(Qrow + 16 * d0 + 8 * hi);
        if constexpr (!KROPE && QMEM) {
            const bf16x8 w2 = *(const GAS bf16x8*)(Qrow2 + 16 * d0 + 8 * hi); const u32x4 a4 = __builtin_bit_cast(u32x4, v), b4 = __builtin_bit_cast(u32x4, w2); u32x4 r4;
            r4.x = pk2(bflo(a4.x) + bflo(b4.x), bfhi(a4.x) + bfhi(b4.x)); r4.y = pk2(bflo(a4.y) + bflo(b4.y), bfhi(a4.y) + bfhi(b4.y));
            r4.z = pk2(bflo(a4.z) + bflo(b4.z), bfhi(a4.z) + bfhi(b4.z)); r4.w = pk2(bflo(a4.w) + bflo(b4.w), bfhi(a4.w) + bfhi(b4.w)); v = __builtin_bit_cast(bf16x8, r4); }
        if (d0 < QR) qf[d0] = v; else *(LAS bf16x8*)(qlds + (d0 - QR) * 1024) = v;
    }
#pragma unroll
    for (int db = 0; db < DV / 32; ++db)
#pragma unroll
        for (int r = 0; r < 16; ++r) o[db][r] = 0.f;
    float m = -INFINITY, l = 0.f;
    Stage<DK, DV, KROPE> st;
    st.load(tid, Kg, ldk, K2g, Vg, ldv, 0);
    st.store(tid, lds, lds + 2 * KBUF);
    __syncthreads();
    for (int t = 0; t < NT; ++t) {
        const int cur = t & 1, kv0 = 64 * t;
        if (t + 1 < NT) st.load(tid, Kg, ldk, K2g, Vg, ldv, kv0 + 64);
        if (t < ntw) {
            const LAS unsigned char* kb = lds + cur * KBUF; const LAS unsigned char* vb = lds + 2 * KBUF + cur * VBUF;
            f32x16 p0, p1;
            if (ALIBI) { const float base = slope2 * (float)(kv0 + 4 * hi - qrow);
#pragma unroll
                for (int r = 0; r < 16; ++r) { p0[r] = __builtin_fmaf(slope2, (float)((r & 3) + 8 * (r >> 2)), base); p1[r] = __builtin_fmaf(slope2, (float)(32 + (r & 3) + 8 * (r >> 2)), base); } }
            else {
#pragma unroll
                for (int r = 0; r < 16; ++r) { p0[r] = 0.f; p1[r] = 0.f; } }
            if constexpr (QMEM) qkt_qmem<DK>(p0, p1, kb, qf, qlds, r32, hi); else qkt<DK>(p0, p1, kb, qf, r32, hi);
            if (CAUSAL && kv0 + 63 > qrow - r32) {
#pragma unroll
                for (int r = 0; r < 16; ++r) { const int kv = kv0 + crow(r, hi); if (kv > qrow) p0[r] = -INFINITY; if (kv + 32 > qrow) p1[r] = -INFINITY; } }
            float mx = p0[0];
#pragma unroll
            for (int r = 1; r < 16; ++r) mx = fmaxf(mx, p0[r]);
#pragma unroll
            for (int r = 0; r < 16; ++r) mx = fmaxf(mx, p1[r]);
            mx = fmaxf(mx, xhalf(mx));
            const float mn = fmaxf(m, mx), alpha = __builtin_amdgcn_exp2f(m - mn); m = mn;
            l *= alpha;
            if (__any(alpha != 1.0f)) {
#pragma unroll
                for (int db = 0; db < DV / 32; ++db)
#pragma unroll
                    for (int r = 0; r < 16; ++r) o[db][r] *= alpha; }
            float s = 0.f;
#pragma unroll
            for (int r = 0; r < 16; ++r) { p0[r] = __builtin_amdgcn_exp2f(p0[r] - mn); p1[r] = __builtin_amdgcn_exp2f(p1[r] - mn); s += p0[r] + p1[r]; }
            l += s;
            bf16x8 pf[4]; pack_p(pf, p0, p1);
            pv<DV>(o, vb, pf, r32, hi);
        }
        if (t + 1 < NT) st.store(tid, lds + (cur ^ 1) * KBUF, lds + 2 * KBUF + (cur ^ 1) * VBUF);
        __syncthreads();
    }
    lsum = l + xhalf(l);
}


template <int DV> __device__ __forceinline__ void store_o(GAS bf16* Orow, const f32x16 (&o)[DV / 32], float sc, int hi) {
#pragma unroll
    for (int db = 0; db < DV / 32; ++db)
#pragma unroll
        for (int c = 0; c < 4; ++c) { u32x2 w; w.x = pk2(o[db][4 * c] * sc, o[db][4 * c + 1] * sc); w.y = pk2(o[db][4 * c + 2] * sc, o[db][4 * c + 3] * sc);
            *(GAS u32x2*)(Orow + 32 * db + 8 * c + 4 * hi) = w; }
}

__device__ __forceinline__ void mla_unit(LAS unsigned char* lds, int tid, int b, int h, int q0, const GAS bf16* qmla, const GAS bf16* knope, const GAS bf16* krope, const GAS bf16* vT, GAS bf16* out, int abl) {
    const int lane = tid & 63, wid = tid >> 6, r32 = lane & 31, hi = lane >> 5;
    const size_t tb = (size_t)b * 8192; const int qrow = q0 + 32 * wid + r32;
    const GAS bf16* Qr = qmla + (tb + qrow) * 768;
    f32x16 o[2]; float l;
    flash_pass<96, 64, true, false, true>(lds, tid, Qr + h * 64, Qr + 512 + h * 32, knope + tb * 512 + h * 64, 512, krope + tb * 32, vT + (size_t)(h * 64) * 16384 + tb, 16384,
                                          q0 / 64 + 4, (q0 + 32 * wid + 31) / 64 + 1, qrow, 0.f, o, l, nullptr, abl);
    if (abl == 0 || l == 12345.678f) store_o<64>(out + (tb + qrow) * 1024 + h * 64, o, 1.0f / l, hi);
}
__device__ __forceinline__ void cross_unit(LAS unsigned char* lds, int tid, int b, int h, int q0, const GAS bf16* qx, const GAS bf16* xk, const GAS bf16* xvT, GAS bf16* out) {
    const int lane = tid & 63, wid = tid >> 6, r32 = lane & 31, hi = lane >> 5;
    const size_t tb = (size_t)b * 8192; const int qrow = q0 + 32 * wid + r32;
    f32x16 o[4]; float l;
    int nt = 4; asm volatile("" : "+s"(nt));
    flash_pass_simple<128, 128, false, false, false, true>(lds, tid, qx + (tb + qrow) * 512 + h * 128, qx + (size_t)16384 * 512 + (tb + qrow) * 512 + h * 128, xk + (size_t)(b * 256) * 512 + h * 128, 512, nullptr, xvT + (size_t)(h * 128) * 512 + b * 256, 512,
                                              nt, nt, qrow, 0.f, o, l);
    store_o<128>(out + (tb + qrow) * 512 + h * 128, o, 1.0f / l, hi);
}
__device__ __forceinline__ void diff_unit(LAS unsigned char* lds, int tid, int b, int h, int hf, int q0, const GAS bf16* dq, const GAS bf16* dk, const GAS bf16* vT, GAS bf16* out, int ldo, const GAS unsigned* knl, int abl) {
    const int lane = tid & 63, wid = tid >> 6, r32 = lane & 31, hi = lane >> 5;
    const size_t tb = (size_t)b * 8192; const int qrow = q0 + 32 * wid + r32;
    const float slope2 = __builtin_amdgcn_exp2f(-2.0f * (float)(h + 1)) * 1.4426950408889634f;
    const int NT = q0 / 64 + 4, ntw = (q0 + 32 * wid + 31) / 64 + 1;
    f32x16 o[4]; float l;
    flash_pass<64, 128, true, true, false, true, true>(lds, tid, dq + (tb + qrow) * 512 + h * 128 + hf * 64, nullptr, dk + tb * 512 + h * 128 + hf * 64, 512, nullptr, vT + (size_t)(512 + h * 128) * 16384 + tb, 16384,
                                                      NT, ntw, qrow, slope2, o, l, knl + ((size_t)(b * 128) * 8 + 2 * h + hf) * 2, abl);
    if (abl == 0 || l == 12345.678f) store_o<128>(out + (tb + qrow) * (size_t)ldo + h * 128, o, 1.0f / l, hi);
}
__device__ __forceinline__ void diff_lambda(const GAS float* lp, int layer, float& lam, float& post) {
    float q1 = 0.f, q2 = 0.f;
    for (int i = 0; i < 64; ++i) { q1 += lp[i] * lp[64 + i]; q2 += lp[128 + i] * lp[192 + i]; }
    const float lam_init = (layer == 0) ? 0.2f : 0.35550906759f;
    lam = expf(q1) - expf(q2) + lam_init; post = 1.f - lam_init;
}
__device__ __forceinline__ void diff_combine4(int item0, int stride, int lane, GAS bf16* o0, const GAS bf16* o1, float lam, float post, const GAS float* subln) {
    unsigned a[4], c[4]; size_t off[4];
#pragma unroll
    for (int k = 0; k < 4; ++k) { const int item = item0 + k * stride; off[k] = (size_t)(item >> 2) * 1024 + (item & 3) * 128 + 2 * lane;
        a[k] = *(const GAS unsigned*)(o0 + off[k]); c[k] = *(const GAS unsigned*)(o1 + (size_t)item * 128 + 2 * lane); }
    const f32x2v g = *(const GAS f32x2v*)(subln + 2 * lane);
#pragma unroll
    for (int k = 0; k < 4; ++k) {
        const float x = bflo(a[k]) - lam * bflo(c[k]), y = bfhi(a[k]) - lam * bfhi(c[k]);
        float s2 = x * x + y * y;
#pragma unroll
        for (int dd = 1; dd < 64; dd <<= 1) s2 += __shfl_xor(s2, dd);
        const float rs = __builtin_amdgcn_rsqf(s2 * (1.f / 128.f) + 1e-6f) * post;
        *(GAS unsigned*)(o0 + off[k]) = pk2(x * rs * g[0], y * rs * g[1]); }
}
__device__ __forceinline__ void sb_unit(LAS unsigned char* lds, int tid, int b, int h, int q0, const GAS bf16* sq, const GAS bf16* sk, const GAS bf16* vT, GAS bf16* out) {
    constexpr int KBUF = KLay<64>::KBUF, VBUF = 64 * VPB;
    const int lane = tid & 63, wid = tid >> 6, r32 = lane & 31, hi = lane >> 5;
    const size_t tb = (size_t)b * 8192; const int qrow = q0 + 32 * wid + r32;
    const GAS bf16* Kg = sk + tb * 512 + h * 64; const GAS bf16* Vg = vT + (size_t)(h * 64) * 16384 + tb;
    const int NT = q0 / 64 + 4, ntw = (q0 + 32 * wid + 30) / 64 + 1;
    bf16x8 qf[4];
#pragma unroll
    for (int d0 = 0; d0 < 4; ++d0) qf[d0] = *(const GAS bf16x8*)(sq + (tb + qrow) * 512 + h * 64 + 16 * d0 + 8 * hi);
    f32x16 o[2];
#pragma unroll
    for (int r = 0; r < 16; ++r) { o[0][r] = 0.f; o[1][r] = 0.f; }
    float R = 1.0f;
    volatile LAS unsigned* dflag = (volatile LAS unsigned*)(lds + 4 * KBUF + 1024);
    Stage<64, 64, false> st;
    st.load(tid, Kg, 512, nullptr, Vg, 16384, 64 * (NT - 1));
    st.store(tid, lds, lds + 2 * KBUF);
    __syncthreads();
    for (int i = 0; i < NT; ++i) {
        const int t = NT - 1 - i, cur = i & 1, kv0 = 64 * t;
        if (t > 0) st.load(tid, Kg, 512, nullptr, Vg, 16384, kv0 - 64);
        if (t < ntw && __any(R != 0.f)) {
            const LAS unsigned char* kb = lds + cur * KBUF; const LAS unsigned char* vb = lds + 2 * KBUF + cur * VBUF;
            f32x16 k0, k1;
#pragma unroll
            for (int r = 0; r < 16; ++r) { k0[r] = 0.f; k1[r] = 0.f; }
            qkt<64>(k0, k1, kb, qf, r32, hi);
            f32x16 b0, b1;
#pragma unroll
            for (int r = 0; r < 16; ++r) {
                const float e0 = __builtin_amdgcn_exp2f(fminf(k0[r], 115.f)), e1 = __builtin_amdgcn_exp2f(fminf(k1[r], 115.f));
                const float r0 = __builtin_amdgcn_rcpf(1.f + e0), r1 = __builtin_amdgcn_rcpf(1.f + e1);
                k0[r] = r0; b0[r] = e0 * r0; k1[r] = r1; b1[r] = e1 * r1; }
            if (kv0 + 63 >= qrow - r32) {
                const int thr = qrow - kv0 - 4 * hi;
#pragma unroll
                for (int r = 0; r < 16; ++r) { const int c = (r & 3) + 8 * (r >> 2); if (c >= thr) { k0[r] = 1.f; b0[r] = 0.f; } if (c + 32 >= thr) { k1[r] = 1.f; b1[r] = 0.f; } } }
            float gp[8], go[8];
#pragma unroll
            for (int c = 0; c < 4; ++c) { gp[c] = (k0[4 * c] * k0[4 * c + 1]) * (k0[4 * c + 2] * k0[4 * c + 3]); gp[4 + c] = (k1[4 * c] * k1[4 * c + 1]) * (k1[4 * c + 2] * k1[4 * c + 3]); }
#pragma unroll
            for (int g = 0; g < 8; ++g) go[g] = xhalf(gp[g]);
            float sp = R;
#pragma unroll
            for (int g = 7; g >= 0; --g) {
                float s = sp * (hi ? 1.0f : go[g]);
                if (g >= 4) { const int c = g - 4;
                    b1[4 * c + 3] *= s; s *= k1[4 * c + 3]; b1[4 * c + 2] *= s; s *= k1[4 * c + 2]; b1[4 * c + 1] *= s; s *= k1[4 * c + 1]; b1[4 * c] *= s; }
                else { const int c = g;
                    b0[4 * c + 3] *= s; s *= k0[4 * c + 3]; b0[4 * c + 2] *= s; s *= k0[4 * c + 2]; b0[4 * c + 1] *= s; s *= k0[4 * c + 1]; b0[4 * c] *= s; }
                sp *= gp[g] * go[g];
            }
            R = sp;
            bf16x8 pf[4]; pack_p(pf, b0, b1);
            pv<64>(o, vb, pf, r32, hi);
        }
        if (t > 0) st.store(tid, lds + (cur ^ 1) * KBUF, lds + 2 * KBUF + (cur ^ 1) * VBUF);
        if (lane == 0) dflag[(i & 1) * 8 + wid] = (t < ntw && !__any(R != 0.f)) ? 1u : 0u;
        __syncthreads();
        { unsigned alld = 1u;
#pragma unroll
          for (int w = 0; w < 8; ++w) alld &= dflag[(i & 1) * 8 + w];
          if (alld) break; }
    }
    store_o<64>(out + (tb + qrow) * 1024 + h * 64, o, 1.0f, hi);
}
}
typedef unsigned short bf16;
typedef float f32x4 __attribute__((ext_vector_type(4)));
typedef unsigned u32x4 __attribute__((ext_vector_type(4)));
typedef unsigned u32x2 __attribute__((ext_vector_type(2)));
constexpr int NWAVES = 8, NTHREADS = 512;
constexpr int M = 16384, D = 1024, SEQ = 8192, DEPTH = 2, IN_COLS = 6688;
constexpr int SROWS = 40960;
constexpr size_t MiB = 1u << 20;
constexpr size_t WS_CTL = 0, CTL_ZERO_BYTES = 128 * 1024;
constexpr size_t WS_SSQ = 1 * MiB;
constexpr size_t WS_SSQCQ = 2 * MiB, WS_SSQCKV = WS_SSQCQ + 256 * 1024, WS_SSQMEM = WS_SSQCKV + 256 * 1024;
constexpr size_t WS_TOKE = 3 * MiB, WS_TOKW = WS_TOKE + 128 * 1024, WS_HIST = WS_TOKW + 128 * 1024, WS_SLOT = WS_HIST + 64 * 1024;
constexpr size_t WS_STOK = 4 * MiB, WS_SW = WS_STOK + 256 * 1024, WS_SRSTD = WS_SW + 256 * 1024;
constexpr size_t WS_WR = 5 * MiB;
constexpr size_t WS_WRH = 5 * MiB + 256 * 1024, WS_WRL = WS_WRH + 128 * 1024;
constexpr size_t WS_MEMN = 6 * MiB, WS_XK = 7 * MiB, WS_XVT = WS_XK + 512 * 1024;
constexpr size_t WS_WIN = 8 * MiB;
constexpr size_t WS_WV = WS_WIN + (size_t)2816 * 1024 * 2;
constexpr size_t WS_WG = WS_WV + 2 * MiB;
constexpr size_t WS_WUQ = WS_WG + 6 * MiB;
constexpr size_t WS_WUKN = WS_WUQ + 768 * 256 * 2;
constexpr size_t WS_WUV = WS_WUKN + 512 * 256 * 2;
constexpr size_t WS_WB = WS_WUV + 512 * 256 * 2;
constexpr size_t WS_WOUT = WS_WB + 4 * MiB;
constexpr size_t WS_WXQ = WS_WOUT + 2 * MiB;
constexpr size_t WS_WXK = WS_WXQ + 1 * MiB, WS_WXV = WS_WXK + 1 * MiB;
constexpr size_t WS_WXO = WS_WXV + 1 * MiB;
constexpr size_t WS_WGU = WS_WXO + 1 * MiB;
constexpr size_t WS_WD = WS_WGU + 32 * MiB;
constexpr size_t WS_WEND = WS_WD + 16 * MiB;
static_assert(WS_WEND <= 81 * MiB, "weights");
constexpr size_t WS_XB = 81 * MiB;
constexpr size_t R0 = 113 * MiB;
constexpr size_t WS_CQ = R0, WS_CKV = R0 + 8 * MiB, WS_KROPE = R0 + 16 * MiB, WS_QK = R0 + 18 * MiB  , WS_VT = R0 + 82 * MiB  ;
constexpr size_t WS_QMLA = R0 + 114 * MiB, WS_KNOPE = R0 + 138 * MiB, WS_VMLAT = R0 + 154 * MiB, WS_OABC = R0 + 170 * MiB  ;
constexpr size_t WS_GSCR = R0, WS_MB = R0 + 96 * MiB;
constexpr size_t WS_QX = R0, WS_OX = R0 + 32 * MiB;
constexpr size_t WS_XG = R0, WS_ACT = R0 + 80 * MiB, WS_Y = R0 + 100 * MiB;
constexpr size_t WS_END = R0 + 234 * MiB;
static_assert(WS_MB + 32 * MiB <= WS_OABC && WS_Y + 80 * MiB <= WS_END && WS_OABC + 64 * MiB <= WS_END, "region map");
constexpr int CW_BAR = 1024, CW_Q = 8192, CW_KN = 16384, CW_F1 = 24576;
constexpr int RING_BYTES = 131072, LDSCTL_OFF = RING_BYTES, MISC_OFF = LDSCTL_OFF + 320, TSTART_OFF = LDSCTL_OFF + 1024, HIST_OFF = LDSCTL_OFF + 2048;
constexpr int LDS_BYTES = 147456;

#define LDS_WAIT() asm volatile("s_waitcnt lgkmcnt(0)" ::: "memory")
__device__ __forceinline__ float wave_sum(float v) {
#pragma unroll
    for (int o = 1; o < 64; o <<= 1) v += __shfl_xor(v, o);
    return v;
}
__device__ __forceinline__ unsigned pk2(float lo, float hi) { return pg8::pk2(lo, hi); }
__device__ __forceinline__ int lane_id() { int r; asm volatile("v_mbcnt_lo_u32_b32 %0, -1, 0\n\tv_mbcnt_hi_u32_b32 %0, -1, %0" : "=v"(r)); return r; }
#define XB_TMO      128
#define XB_XCNT(j)  (256  + 64 * (j))
#define XB_XSUB(j)  (1280 + 64 * (j))
#define XB_XGEN(j)  (2304 + 64 * (j))
#define XB_TOP      3328
#define XB_TOPGEN   3392
#define XCD_BAR_WORDS 3456
#define XB_SPIN_CAP (1u << 18)

__device__ __forceinline__ unsigned xb_ld(unsigned* p)              { return __hip_atomic_load(p, __ATOMIC_RELAXED, __HIP_MEMORY_SCOPE_AGENT); }
__device__ __forceinline__ unsigned xb_add(unsigned* p, unsigned v) { return __hip_atomic_fetch_add(p, v, __ATOMIC_RELAXED, __HIP_MEMORY_SCOPE_AGENT); }
__device__ __forceinline__ unsigned xb_xcc_id() { return (unsigned)__builtin_amdgcn_s_getreg((3 << 11) | 20) & 0xFu; }
#define XB_SPIN(cond, bar) do { unsigned _sp = 0; while (cond) { __builtin_amdgcn_s_sleep(1); \
    if ((++_sp & 255u) == 0u) { if (xb_ld(&(bar)[XB_TMO])) break; if (_sp > XB_SPIN_CAP) { atomicAdd(&(bar)[XB_TMO], 1u); break; } } } } while (0)

struct XcdBarrier {
    unsigned* bar; unsigned x; int wid;
    volatile LAS unsigned* st;
};

__device__ __forceinline__ XcdBarrier xcd_barrier_post(unsigned* bar, volatile LAS unsigned* st, int wid) {
    XcdBarrier b; b.bar = bar; b.x = xb_xcc_id(); b.st = st; b.wid = wid;
    if (wid == 0 && lane_id() == 0) (void)xb_add(&bar[XB_XCNT(b.x)], 1u);
    return b;
}
__device__ __forceinline__ void xcd_barrier_complete(unsigned* bar, unsigned x, unsigned& nloc, unsigned& nx) {
    const unsigned G = gridDim.x * gridDim.y * gridDim.z;
    unsigned sum, cnt, mine, sp = 0u;
    for (;;) {
        sum = 0u; cnt = 0u; mine = 0u;
#pragma unroll 1
        for (unsigned j = 0; j < 16; ++j) { const unsigned c = xb_ld(&bar[XB_XCNT(j)]); sum += c; cnt += (c > 0u) ? 1u : 0u; mine = (j == x) ? c : mine; }
        if (sum == G) break;
        __builtin_amdgcn_s_sleep(1);
        if ((++sp & 255u) == 0u) { if (xb_ld(&bar[XB_TMO])) break; if (sp > XB_SPIN_CAP) { atomicAdd(&bar[XB_TMO], 1u); break; } }
    }
    nloc = mine > 0u ? mine : 1u; nx = cnt > 0u ? cnt : 1u;
}

__device__ __forceinline__ void xcd_barrier(const XcdBarrier& b) {
    asm volatile("s_waitcnt vmcnt(0)" ::: "memory");
    __syncthreads();
    if (b.wid == 0 && lane_id() == 0) {
        unsigned* bar = b.bar; asm volatile("" : "+s"(bar));
        __builtin_amdgcn_s_waitcnt(0);
        unsigned nloc = b.st[0], nx = b.st[1];
        if (nloc == 0u) { xcd_barrier_complete(bar, b.x, nloc, nx); b.st[0] = nloc; b.st[1] = nx; }
        const unsigned old = xb_add(&bar[XB_XSUB(b.x)], 1u);
        const unsigned gen = old / nloc;
        if (old + 1u == (gen + 1u) * nloc) {
            __builtin_amdgcn_fence(__ATOMIC_RELEASE, "agent");
            asm volatile("s_waitcnt vmcnt(0)" ::: "memory");
            const unsigned og = xb_add(&bar[XB_TOP], 1u);
            const unsigned tg = og / nx;
            if (og + 1u == (tg + 1u) * nx) xb_add(&bar[XB_TOPGEN], 1u);
            else XB_SPIN(xb_ld(&bar[XB_TOPGEN]) == tg, bar);
            __builtin_amdgcn_fence(__ATOMIC_ACQUIRE, "agent");
            xb_add(&bar[XB_XGEN(b.x)], 1u);
            asm volatile("s_waitcnt vmcnt(0)" ::: "memory");
        } else {
            XB_SPIN(xb_ld(&bar[XB_XGEN(b.x)]) == gen, bar);
            __builtin_amdgcn_fence(__ATOMIC_ACQUIRE, "agent");
            asm volatile("s_waitcnt vmcnt(0)" ::: "memory");
        }
    }
    __syncthreads();
}
struct TrJob { const GAS float* src; const GAS float* gain; GAS bf16* dst; int ldn, col0, k0, K, row0, dk; };
__device__ __forceinline__ void tr_load(const TrJob& j, f32x4 (&v)[8], int lane) {
    const int kr = lane >> 3, nq = lane & 7;
    if (j.col0 >= 0) {
#pragma unroll
        for (int i = 0; i < 8; ++i) v[i] = *(const GAS f32x4*)(j.src + (size_t)(j.k0 + 8 * i + kr) * j.ldn + j.col0 + 4 * nq);
    } else {
#pragma unroll
        for (int i = 0; i < 8; ++i) v[i] = (f32x4){0.f, 0.f, 0.f, 0.f};
    }
}
__device__ __forceinline__ void tr_finish(const TrJob& j, const f32x4 (&v)[8], LAS float* scr, int lane) {
    const int kr = lane >> 3, nq = lane & 7;
#pragma unroll
    for (int i = 0; i < 8; ++i) { const int kk = 8 * i + kr; const float g = j.gain ? j.gain[j.k0 + kk] : 1.f; LAS float* s = scr + kk * 33 + 4 * nq;
        s[0] = v[i][0] * g; s[1] = v[i][1] * g; s[2] = v[i][2] * g; s[3] = v[i][3] * g; }
    LDS_WAIT(); asm volatile("" ::: "memory");
    const int c = lane & 7;
#pragma unroll
    for (int q = 0; q < 4; ++q) { const int n = (lane >> 3) + 8 * q; const LAS float* s = scr + (8 * c) * 33 + n;
        u32x4 o; o.x = pk2(s[0 * 33], s[1 * 33]); o.y = pk2(s[2 * 33], s[3 * 33]); o.z = pk2(s[4 * 33], s[5 * 33]); o.w = pk2(s[6 * 33], s[7 * 33]);
        *(GAS u32x4*)(j.dst + (size_t)(j.row0 + n) * j.K + j.dk + j.k0 + 8 * c) = o; }
    LDS_WAIT(); asm volatile("" ::: "memory");
}
__device__ __forceinline__ void row_to_bf16(const GAS float* xrow, GAS bf16* orow, GAS float* ssq16, int lane) {
    const GAS f32x4* xr = (const GAS f32x4*)xrow + lane; f32x4 v[4]; float s = 0.f;
#pragma unroll
    for (int j = 0; j < 4; ++j) { v[j] = xr[64 * j]; s += (v[j][0] * v[j][0] + v[j][1] * v[j][1]) + (v[j][2] * v[j][2] + v[j][3] * v[j][3]); }
    s = wave_sum(s);
    GAS u32x2* o8 = (GAS u32x2*)orow + lane;
#pragma unroll
    for (int j = 0; j < 4; ++j) { u32x2 w; w.x = pk2(v[j][0], v[j][1]); w.y = pk2(v[j][2], v[j][3]); o8[64 * j] = w; }
    if (lane < 16) ssq16[lane] = (lane == 0) ? s : 0.f;
}

struct Args { const float* in[26]; float* out; unsigned char* ws; };
__device__ __forceinline__ int opq(int i) { asm volatile("" : "+s"(i)); return i; }
__device__ __forceinline__ GAS unsigned char* opqp(unsigned char* p0) { GAS unsigned char* p = (GAS unsigned char*)p0; asm volatile("" : "+s"(p)); return p; }
#define INP(i) ((const GAS float*)args.in[opq(i)])
#define WSB(off) (opqp(args.ws) + (off))
#define X_IN INP(0)
#define OUTP ((GAS float*)args.out)
#define XB ((GAS bf16*)WSB(WS_XB))
#define SSQ ((GAS float*)WSB(WS_SSQ))
#define SSQCQ ((GAS float*)WSB(WS_SSQCQ))
#define SSQCKV ((GAS float*)WSB(WS_SSQCKV))
#define SSQMEM ((GAS float*)WSB(WS_SSQMEM))
#define MEMN ((GAS bf16*)WSB(WS_MEMN))
#define XK ((GAS bf16*)WSB(WS_XK))
#define XVT ((GAS bf16*)WSB(WS_XVT))
#define WIN ((GAS bf16*)WSB(WS_WIN))
#define WV ((GAS bf16*)WSB(WS_WV))
#define WG ((GAS bf16*)WSB(WS_WG))
#define WUQ ((GAS bf16*)WSB(WS_WUQ))
#define WUKN ((GAS bf16*)WSB(WS_WUKN))
#define WUV ((GAS bf16*)WSB(WS_WUV))
#define WB ((GAS bf16*)WSB(WS_WB))
#define WOUT ((GAS bf16*)WSB(WS_WOUT))
#define WXQ ((GAS bf16*)WSB(WS_WXQ))
#define WXK ((GAS bf16*)WSB(WS_WXK))
#define WXV ((GAS bf16*)WSB(WS_WXV))
#define WXO ((GAS bf16*)WSB(WS_WXO))
#define WGU ((GAS bf16*)WSB(WS_WGU))
#define WD ((GAS bf16*)WSB(WS_WD))
#define WRH ((GAS bf16*)WSB(WS_WRH))
#define WRL ((GAS bf16*)WSB(WS_WRL))
#define CQ ((GAS bf16*)WSB(WS_CQ))
#define CKV ((GAS bf16*)WSB(WS_CKV))
#define KROPE ((GAS bf16*)WSB(WS_KROPE))
#define QK ((GAS bf16*)WSB(WS_QK))
#define VT ((GAS bf16*)WSB(WS_VT))
#define QMLA ((GAS bf16*)WSB(WS_QMLA))
#define KNOPE ((GAS bf16*)WSB(WS_KNOPE))
#define VMLAT ((GAS bf16*)WSB(WS_VMLAT))
#define OABC ((GAS bf16*)WSB(WS_OABC))
#define GSCR ((GAS bf16*)WSB(WS_GSCR))
#define MB ((GAS bf16*)WSB(WS_MB))
#define QX ((GAS bf16*)WSB(WS_QX))
#define OX ((GAS bf16*)WSB(WS_OX))
#define XG ((GAS bf16*)WSB(WS_XG))
#define ACT ((GAS bf16*)WSB(WS_ACT))
#define YB ((GAS bf16*)WSB(WS_Y))
#define TOKE ((GAS int*)WSB(WS_TOKE))
#define TOKW ((GAS float*)WSB(WS_TOKW))
#define HIST ((GAS int*)WSB(WS_HIST))
#define SLOT ((GAS int*)WSB(WS_SLOT))
#define STOK ((GAS int*)WSB(WS_STOK))
#define SW ((GAS float*)WSB(WS_SW))
#define SRSTD ((GAS float*)WSB(WS_SRSTD))


__global__ void __launch_bounds__(NTHREADS, 2) fwd(Args args) {
    extern __shared__ __attribute__((aligned(16))) unsigned char lds_raw[];
    LAS unsigned char* lds = (LAS unsigned char*)lds_raw;
    volatile LAS unsigned* MISC = (volatile LAS unsigned*)(lds + MISC_OFF);
    LAS int* TSTART = (LAS int*)(lds + TSTART_OFF);
    const int tid0 = threadIdx.x; const int wv = __builtin_amdgcn_readfirstlane(tid0 >> 6);
#define PH_BEGIN int tid_ = wv * 64 + lane_id(); asm volatile("" : "+v"(tid_)); const int tid = tid_, lane = tid & 63, wave = wv, gw = vcu * NWAVES + wave; (void)lane; (void)gw
    const int G = gridDim.x, bx = blockIdx.x, vcu = (G % 8 == 0) ? (bx % 8) * (G / 8) + bx / 8 : bx;
    unsigned* ctl = (unsigned*)(void*)(args.ws + WS_CTL);
    for (int u = tid0; u < (LDS_BYTES - LDSCTL_OFF) / 4; u += NTHREADS) ((LAS unsigned*)(lds + LDSCTL_OFF))[u] = 0u;
    __syncthreads();
    XcdBarrier bar = xcd_barrier_post(ctl + CW_BAR, MISC + 8, wv);
    const int NGW = G * NWAVES;

    constexpr float L2E = 1.4426950408889634f;

    constexpr int I_IN = 88 * 16, I_V = 32 * 16, I_G = 96 * 16, I_UQ = 24 * 4, I_UK = 16 * 4, I_B = 3 * 32 * 8, I_O = 32 * 16, I_XQ = 16 * 16, I_XO = 32 * 8, I_GU = 512 * 16, I_D = 1024 * 4;
    constexpr int NITEMS = I_IN + I_V + I_G + I_UQ + 2 * I_UK + I_B + I_O + 3 * I_XQ + I_XO + I_GU + I_D, NITEMS_P0 = NITEMS - I_GU - I_D;
    for (int l = 0; l < DEPTH; ++l) {
        for (int rp_ = 0; rp_ < RP_P0; ++rp_) {
#if PH_P0
        { PH_BEGIN;
            LAS float* scr = (LAS float*)(lds + wave * 16384);
#define w_in (INP(3) + (size_t)l * D * IN_COLS)
#define g_attn (INP(2) + l * D)
#define w_uq (INP(5) + (size_t)l * 256 * 768)
#define g_q (INP(4) + l * 256)
#define w_ukv (INP(7) + (size_t)l * 256 * 1024)
#define g_kv (INP(6) + l * 256)
#define w_br (INP(10) + (size_t)l * 3 * 512 * 1024)
#define w_out (INP(11) + (size_t)l * D * D)
#define g_cross (INP(12) + l * D)
#define g_mem (INP(13))
#define w_xq (INP(14) + (size_t)l * D * 512)
#define w_xkv (INP(15) + (size_t)l * D * 1024)
#define w_xo (INP(16) + (size_t)l * 512 * D)
#define g_ffn (INP(17) + l * D)
#define w_eg (INP(22) + (size_t)l * 32 * D * 256)
#define w_eu (INP(23) + (size_t)l * 32 * D * 256)
#define w_ed (INP(24) + (size_t)l * 32 * 256 * D)
#define TR_DECODE(itx) do { int r = (itx); \
                if (r < I_IN) { const int nb = r >> 4, kb = r & 15, n0 = nb * 32; int col; \
                    if (n0 < 544) col = 3072 + n0; else if (n0 < 768) col = -1; else if (n0 < 1792) col = 3616 + (n0 - 768); else col = 5152 + (n0 - 1792); \
                    jb = TrJob{w_in, g_attn, WIN, IN_COLS, col, kb * 64, 1024, n0, 0}; break; } r -= I_IN; \
                if (r < I_V) { const int nb = r >> 4, kb = r & 15, n0 = nb * 32; const int col = n0 < 512 ? 4640 + n0 : 6176 + (n0 - 512); \
                    jb = TrJob{w_in, g_attn, WV, IN_COLS, col, kb * 64, 1024, n0, 0}; break; } r -= I_V; \
                if (r < I_G) { const int nb = r >> 4, kb = r & 15; jb = TrJob{w_in, g_attn, WG, IN_COLS, nb * 32, kb * 64, 1024, nb * 32, 0}; break; } r -= I_G; \
                if (r < I_UQ) { const int nb = r >> 2, kb = r & 3, n0 = nb * 32; const int col = n0 < 512 ? 96 * (n0 >> 6) + (n0 & 63) : 96 * ((n0 - 512) >> 5) + 64; \
                    jb = TrJob{w_uq, g_q, WUQ, 768, col, kb * 64, 256, n0, 0}; break; } r -= I_UQ; \
                if (r < I_UK) { const int nb = r >> 2, kb = r & 3, n0 = nb * 32; jb = TrJob{w_ukv, g_kv, WUKN, 1024, 128 * (n0 >> 6) + (n0 & 63), kb * 64, 256, n0, 0}; break; } r -= I_UK; \
                if (r < I_UK) { const int nb = r >> 2, kb = r & 3, n0 = nb * 32; jb = TrJob{w_ukv, g_kv, WUV, 1024, 128 * (n0 >> 6) + 64 + (n0 & 63), kb * 64, 256, n0, 0}; break; } r -= I_UK; \
                if (r < I_B) { const int z = r / 256, q = r % 256, nb = q >> 3, kb = q & 7; jb = TrJob{w_br + (size_t)z * 512 * 1024, nullptr, WB + (size_t)(z >> 1) * 1024 * 1024, 1024, nb * 32, kb * 64, 1024, nb * 32, (z & 1) * 512}; break; } r -= I_B; \
                if (r < I_O) { const int nb = r >> 4, kb = r & 15; jb = TrJob{w_out, nullptr, WOUT, 1024, nb * 32, kb * 64, 1024, nb * 32, 0}; break; } r -= I_O; \
                if (r < I_XQ) { const int nb = r >> 4, kb = r & 15; jb = TrJob{w_xq, g_cross, WXQ, 512, nb * 32, kb * 64, 1024, nb * 32, 0}; break; } r -= I_XQ; \
                if (r < I_XQ) { const int nb = r >> 4, kb = r & 15; jb = TrJob{w_xkv, g_mem, WXK, 1024, nb * 32, kb * 64, 1024, nb * 32, 0}; break; } r -= I_XQ; \
                if (r < I_XQ) { const int nb = r >> 4, kb = r & 15; jb = TrJob{w_xkv, g_mem, WXV, 1024, 512 + nb * 32, kb * 64, 1024, nb * 32, 0}; break; } r -= I_XQ; \
                if (r < I_XO) { const int nb = r >> 3, kb = r & 7; jb = TrJob{w_xo, nullptr, WXO, 1024, nb * 32, kb * 64, 512, nb * 32, 0}; break; } r -= I_XO; \
                if (r < I_GU) { const int nb = r >> 4, kb = r & 15, n0 = nb * 32, e = n0 >> 9, rr = n0 & 511, t = rr >> 8, j = rr & 255; \
                    const GAS float* src = (j < 128 ? w_eg : w_eu) + (size_t)e * D * 256; jb = TrJob{src, g_ffn, WGU, 256, 128 * t + (j & 127), kb * 64, 1024, n0, 0}; break; } r -= I_GU; \
                { const int nb = r >> 2, kb = r & 3, n0 = nb * 32, e = n0 >> 10; jb = TrJob{w_ed + (size_t)e * 256 * 1024, nullptr, WD, 1024, n0 & 1023, kb * 64, 256, n0, 0}; } } while (0)
            for (int it = gw; it < NITEMS_P0; it += NGW) {
                TrJob jb{};
                TR_DECODE(it);
                f32x4 va[8];
                tr_load(jb, va, lane);
                tr_finish(jb, va, scr, lane);
            }
            { const GAS float* wrg = INP(18) + (size_t)l * D * 4; const GAS float* wre = INP(20) + (size_t)l * D * 32; GAS bf16* wh = WRH; GAS bf16* wl = WRL;
              for (int i = bx * NTHREADS + tid; i < 48 * 1024; i += G * NTHREADS) { const int c = i >> 10, k = i & 1023;
                  const float w = c < 36 ? (c < 4 ? wrg[k * 4 + c] : wre[k * 32 + (c - 4)]) * g_ffn[k] : 0.f; const unsigned h = pk2(w, 0.f) & 0xffffu;
                  wh[i] = (bf16)h; wl[i] = (bf16)(pk2(w - __builtin_bit_cast(float, h << 16), 0.f) & 0xffffu); } }
            if (l == 0) {
                for (int m = gw; m < M; m += NGW) row_to_bf16(X_IN + (size_t)m * D, XB + (size_t)m * D, SSQ + (size_t)m * 16, lane);
                for (int m = gw; m < 512; m += NGW) row_to_bf16(INP(1) + (size_t)m * D, MEMN + (size_t)m * D, SSQMEM + (size_t)m * 16, lane);
            }
        }
#endif
        xcd_barrier(bar);
        }
                for (int rp_ = 0; rp_ < RP_A; ++rp_) {
#if PH_A
        {
            { pg8::Gemm g{XB, WIN, M, 2816, D, D, nullptr}; pg8::StaticOrder S; S.init(M, 2816, G, bx);
              pg8::EpiA E{SSQ, CQ, CKV, KROPE, QK, SSQCQ, SSQCKV, 0.125f * L2E, (GAS unsigned*)(opqp(args.ws) + WS_CTL) + CW_KN + l * 4096};
              pg8::gemm_phase<pg8::EpiA, pg8::StaticOrder, true, true>(lds, g, S, E, wv); }
            { pg8::Gemm g{WV, XB, 1024, M, D, D, nullptr}; pg8::StaticOrder S; S.init(1024, M, G, (bx + 64) % G);
              pg8::EpiVT E{VT, M, SSQ, 4, 1.f / 1024.f};
              pg8::gemm_phase<pg8::EpiVT, pg8::StaticOrder, true, true>(lds, g, S, E, wv); }
            { pg8::Gemm g{MEMN, WXK, 512, 512, D, D, nullptr}; pg8::StaticOrder S; S.init(512, 512, G, (bx + 8) % G);
              pg8::EpiRS E{XK, 512, SSQMEM, 4, 1.f / 1024.f, 1.f, 0xffff, 31, 0};
              pg8::gemm_phase<pg8::EpiRS, pg8::StaticOrder, true, true>(lds, g, S, E, wv); }
            { pg8::Gemm g{WXV, MEMN, 512, 512, D, D, nullptr}; pg8::StaticOrder S; S.init(512, 512, G, (bx + 16) % G);
              pg8::EpiVT E{XVT, 512, SSQMEM, 4, 1.f / 1024.f};
              pg8::gemm_phase<pg8::EpiVT, pg8::StaticOrder, true, true>(lds, g, S, E, wv); }
        }
#endif
        xcd_barrier(bar);
        }
                for (int rp_ = 0; rp_ < RP_B; ++rp_) {
#if PH_B
        {
#if PH_B1
            { pg8::Gemm g{CQ, WUQ, M, 768, opq(256), opq(256), nullptr}; pg8::StaticOrder S; S.init(M, 768, G, bx);
              pg8::EpiQ E{QMLA, SSQCQ, 0.10206207261596577f * L2E};
              pg8::gemm_phase<pg8::EpiQ, pg8::StaticOrder, true, true>(lds, g, S, E, wv); }
#endif
#if PH_B2
            { pg8::Gemm g{CKV, WUKN, M, 512, opq(256), opq(256), nullptr}; pg8::StaticOrder S; S.init(M, 512, G, (bx + 64) % G);
              pg8::EpiRS E{KNOPE, 512, SSQCKV, 1, 1.f / 256.f, 1.f, 0xffff, 31, 0};
              pg8::gemm_phase<pg8::EpiRS, pg8::StaticOrder, true, true>(lds, g, S, E, wv); }
#endif
#if PH_B3
            { pg8::Gemm g{WUV, CKV, 512, M, opq(256), opq(256), nullptr}; pg8::StaticOrder S; S.init(512, M, G, (bx + 128) % G);
              pg8::EpiVT E{VMLAT, M, SSQCKV, 1, 1.f / 256.f};
              pg8::gemm_phase<pg8::EpiVT, pg8::StaticOrder, true, true>(lds, g, S, E, wv); }
#endif
        }
#endif
        xcd_barrier(bar);
        }
                for (int rp_ = 0; rp_ < RP_C; ++rp_) {
#if PH_C
        {
            unsigned* qhead = ctl + CW_Q + 64 * (l + 2 * rp_);
            for (;;) {
                if (wv == 0 && lane_id() == 0) MISC[0] = __hip_atomic_fetch_add(qhead, 1u, __ATOMIC_RELAXED, __HIP_MEMORY_SCOPE_AGENT);
                __syncthreads();
                const int idx = (int)MISC[0];
                __syncthreads();
                if (idx >= 32 * 48 + 256) break;
                if (idx >= 32 * 48) {
                    if (rp_ == 0) { const int wl = lane_id(); LAS float* scr = (LAS float*)(lds + wv * 16384);
                        for (int j = 0; j < 6; ++j) { const int it = NITEMS_P0 + (idx - 32 * 48) * 48 + j * 8 + wv; TrJob jb{}; TR_DECODE(it); f32x4 va[8]; tr_load(jb, va, wl); tr_finish(jb, va, scr, wl); } }
                    continue; }
                const int qb = 31 - idx / 48, r = idx % 48, q0 = qb * 256;
                int tu = wv * 64 + lane_id(); asm volatile("" : "+v"(tu));
#if PH_C_DIFF
                if (r < 16 && (rp_ == 0 || (C_REP_MASK & 1))) att::diff_unit(lds, tu, r >> 3, (r >> 1) & 3, r & 1, q0, QK + (size_t)2 * M * 512, QK + (size_t)3 * M * 512, VT, (r & 1) ? CQ : OABC + (size_t)M * 1024, (r & 1) ? 512 : 1024,
                                                                             (const GAS unsigned*)(opqp(args.ws) + WS_CTL) + CW_KN + l * 4096, rp_ ? C_ABL : 0);
#endif
#if PH_C_SB
                if (r >= 16 && r < 32 && (rp_ == 0 || (C_REP_MASK & 2))) att::sb_unit(lds, tu, (r - 16) >> 3, (r - 16) & 7, q0, QK, QK + (size_t)M * 512, VT, OABC + 512);
#endif
#if PH_C_MLA
                if (r >= 32 && (rp_ == 0 || (C_REP_MASK & 4))) att::mla_unit(lds, tu, (r - 32) >> 3, (r - 32) & 7, q0, QMLA, KNOPE, KROPE, VMLAT, OABC, rp_ ? C_ABL : 0);
#endif
            }
        }
#endif
        xcd_barrier(bar);
        }
        #undef TR_DECODE
#undef w_in
#undef g_attn
#undef w_uq
#undef g_q
#undef w_ukv
#undef g_kv
#undef w_br
#undef w_out
#undef g_cross
#undef g_mem
#undef w_xq
#undef w_xkv
#undef w_xo
#undef g_ffn
#undef w_eg
#undef w_eu
#undef w_ed
#if PH_C
        { PH_BEGIN;
          float lam, post; att::diff_lambda(INP(8) + l * 256, l, lam, post);
          for (int it = gw; it < M * 4; it += 4 * NGW) att::diff_combine4(it, NGW, lane, OABC + (size_t)M * 1024, CQ, lam, post, INP(9) + l * 128); }
        xcd_barrier(bar);
#endif
        for (int rp_ = 0; rp_ < RP_D1; ++rp_) {
#if PH_D1
        { pg8::Gemm g{XB, WG, M, 1024, 512, 1024, nullptr}; pg8::D1Order S; S.so.init(M, 1024, G, bx);
          const GAS char* xb_ = (const GAS char*)XB; const GAS char* oab_ = (const GAS char*)OABC; const GAS char* wg_ = (const GAS char*)WG; const GAS char* wb_ = (const GAS char*)WB;
          S.dA = (size_t)(oab_ - xb_); S.dB = (size_t)(wb_ - wg_);
          pg8::EpiD1 E{GSCR, MB, SSQ};
          pg8::gemm_phase<pg8::EpiD1, pg8::D1Order, true, true>(lds, g, S, E, wv); }
#endif
        xcd_barrier(bar);
        }
        #if PH_D2
        { pg8::Gemm g{MB, WOUT, M, 1024, D, D, nullptr}; pg8::StaticOrder S; S.init(M, 1024, G, bx);
          pg8::EpiRes E{XB, SSQ};
          pg8::gemm_phase<pg8::EpiRes, pg8::StaticOrder, true, true>(lds, g, S, E, wv); }
#endif
        xcd_barrier(bar);
                for (int rp_ = 0; rp_ < RP_E1; ++rp_) {
#if PH_E1
        { pg8::Gemm g{XB, WXQ, M, 512, 512, 1024, nullptr}; pg8::SplitK2Order S; S.so.init(M, 1024, G, bx); S.tstep = (size_t)256 * 1024 * 2;
          pg8::EpiRS E{QX, 512, SSQ, 4, 1.f / 1024.f, 0.08838834764831845f * L2E, 1, 1, (size_t)M * 512};
          pg8::gemm_phase<pg8::EpiRS, pg8::SplitK2Order, true, true>(lds, g, S, E, wv); }
#endif
        xcd_barrier(bar);
        }
                for (int rp_ = 0; rp_ < RP_E2; ++rp_) {
#if PH_E2
        { PH_BEGIN; for (int u = vcu; u < 256; u += G) att::cross_unit(lds, tid, u >> 7, (u >> 5) & 3, (u & 31) * 256, QX, XK, XVT, OX); }
#endif
        xcd_barrier(bar);
        }
        #if PH_E3
        { pg8::Gemm g{OX, WXO, M, 1024, 512, 512, nullptr}; pg8::StaticOrder S; S.init(M, 1024, G, bx);
          pg8::EpiRes E{XB, SSQ};
          pg8::gemm_phase<pg8::EpiRes, pg8::StaticOrder, true, true>(lds, g, S, E, wv); }
#endif
        xcd_barrier(bar);
                for (int rp_ = 0; rp_ < RP_F0A; ++rp_) {
#if PH_F0A
        { PH_BEGIN;
            typedef short bf16x8 __attribute__((ext_vector_type(8)));
            const GAS float* brg = INP(19) + l * 4; const GAS float* bre = INP(21) + l * 32;
            LAS float* part = (LAS float*)lds;
            const int rb = wave & 3, kh = wave >> 2, r16 = lane & 15, kq = lane >> 4;
            for (int grp = bx; grp < 256; grp += G) {
                const GAS bf16* xrow = XB + (size_t)(grp * 64 + 16 * rb + r16) * D + 512 * kh + 8 * kq;
                const GAS bf16* wh = WRH + (size_t)r16 * 1024 + 512 * kh + 8 * kq; const GAS bf16* wl = WRL + (size_t)r16 * 1024 + 512 * kh + 8 * kq;
                f32x4 acc[3];
#pragma unroll
                for (int cb = 0; cb < 3; ++cb) acc[cb] = (f32x4){0.f, 0.f, 0.f, 0.f};
#pragma unroll 8
                for (int st = 0; st < 16; ++st) {
                    const bf16x8 ah = *(const GAS bf16x8*)(xrow + 32 * st);
#pragma unroll
                    for (int cb = 0; cb < 3; ++cb) {
                        const bf16x8 bh = *(const GAS bf16x8*)(wh + (size_t)cb * 16 * 1024 + 32 * st), bl = *(const GAS bf16x8*)(wl + (size_t)cb * 16 * 1024 + 32 * st);
                        acc[cb] = __builtin_amdgcn_mfma_f32_16x16x32_bf16(ah, bh, acc[cb], 0, 0, 0);
                        acc[cb] = __builtin_amdgcn_mfma_f32_16x16x32_bf16(ah, bl, acc[cb], 0, 0, 0);
                    }
                }
                __syncthreads();
#pragma unroll
                for (int cb = 0; cb < 3; ++cb)
#pragma unroll
                    for (int r = 0; r < 4; ++r) part[(kh * 64 + 16 * rb + 4 * kq + r) * 49 + 16 * cb + r16] = acc[cb][r];
                __syncthreads();
                if (wave == 0) {
                    const int tok = grp * 64 + lane; const float rs = pg8::rstd_parts(SSQ, (unsigned)(tok * 16), 4, 1.f / 1024.f);
                    const LAS float* p0 = part + lane * 49; const LAS float* p1 = part + (64 + lane) * 49;
                    float gl[4];
#pragma unroll
                    for (int c = 0; c < 4; ++c) gl[c] = (p0[c] + p1[c]) * rs + brg[c];
                    int gs = 0; float gm = gl[0];
#pragma unroll
                    for (int c = 1; c < 4; ++c) if (gl[c] > gm) { gm = gl[c]; gs = c; }
                    float den = 0.f;
#pragma unroll
                    for (int c = 0; c < 4; ++c) den += expf(gl[c] - gm);
                    const float pg = 1.0f / den;
                    float el[8];
#pragma unroll
                    for (int j = 0; j < 8; ++j) el[j] = (p0[4 + gs * 8 + j] + p1[4 + gs * 8 + j]) * rs + bre[gs * 8 + j];
                    int i0 = 0; float v0 = el[0];
#pragma unroll
                    for (int j = 1; j < 8; ++j) if (el[j] > v0) { v0 = el[j]; i0 = j; }
                    int i1 = -1; float v1 = -INFINITY;
#pragma unroll
                    for (int j = 0; j < 8; ++j) if (j != i0 && el[j] > v1) { v1 = el[j]; i1 = j; }
                    const float e1 = expf(v1 - v0), w0 = pg / (1.f + e1), w1 = pg * e1 / (1.f + e1);
                    const int ea = gs * 8 + i0, eb = gs * 8 + i1;
                    TOKE[tok * 2] = ea; TOKE[tok * 2 + 1] = eb; TOKW[tok * 2] = w0; TOKW[tok * 2 + 1] = w1;
                    int mycnt = 0;
#pragma unroll 1
                    for (int e = 0; e < 32; ++e) { const int c = __popcll(__ballot(ea == e)) + __popcll(__ballot(eb == e)); if (lane == e) mycnt = c; }
                    if (lane < 32) HIST[grp * 32 + lane] = mycnt;
                }
            }
            __syncthreads();
        }
#endif
        xcd_barrier(bar);
        }
                for (int rp_ = 0; rp_ < RP_F0B; ++rp_) {
#if PH_F0B
        { PH_BEGIN;
            LAS int* cnt = (LAS int*)(lds + HIST_OFF);
            for (int grp = bx; grp < 256; grp += G) {
                __syncthreads();
                { const int e = tid & 31, ch = tid >> 5; int tot = 0, before = 0;
#pragma unroll
                  for (int j = 0; j < 16; ++j) { const int g2 = ch * 16 + j; const int hv = HIST[g2 * 32 + e]; tot += hv; before += (g2 < grp) ? hv : 0; }
                  cnt[128 + ch * 32 + e] = tot; cnt[640 + ch * 32 + e] = before; }
                __syncthreads();
                if (tid < 32) { int tot = 0, before = 0;
                    for (int ch = 0; ch < 16; ++ch) { tot += cnt[128 + ch * 32 + tid]; before += cnt[640 + ch * 32 + tid]; }
                    cnt[tid] = tot; cnt[32 + tid] = before; }
                __syncthreads();
                if (tid == 0) { int ts = 0; for (int e = 0; e < 32; ++e) { TSTART[e] = ts; ts += (cnt[e] + 255) >> 8; } TSTART[32] = ts; }
                __syncthreads();
                if (wave == 0) {
                    const int tok = grp * 64 + lane; const int ea = TOKE[tok * 2], eb = TOKE[tok * 2 + 1];
                    int ra = 0, rb = 0; const unsigned long long lt = (1ull << lane) - 1ull;
#pragma unroll 1
                    for (int e = 0; e < 32; ++e) { const unsigned long long ma = __ballot(ea == e), mb = __ballot(eb == e); const int c = __popcll((ma | mb) & lt); if (ea == e) ra = c; if (eb == e) rb = c; }
                    const int sa = TSTART[ea] * 256 + cnt[32 + ea] + ra, sb = TSTART[eb] * 256 + cnt[32 + eb] + rb;
                    const float rsd = pg8::rstd_parts(SSQ, (unsigned)(tok * 16), 4, 1.f / 1024.f);
                    SLOT[tok * 2] = sa; SLOT[tok * 2 + 1] = sb;
                    STOK[sa] = tok; STOK[sb] = tok; SW[sa] = TOKW[tok * 2]; SW[sb] = TOKW[tok * 2 + 1]; SRSTD[sa] = rsd; SRSTD[sb] = rsd;
                    MISC[16 + lane] = (unsigned)sa; MISC[80 + lane] = (unsigned)sb;
                }
                __syncthreads();
                if (grp < 32) { const int beg = TSTART[grp] * 256 + cnt[grp], end = TSTART[grp + 1] * 256;
                    for (int s = beg + tid; s < end; s += NTHREADS) { STOK[s] = 0; SW[s] = 0.f; SRSTD[s] = 0.f; } }
            }
            if (G > 256 || bx >= 256) {
                __syncthreads();
                if (tid < 32) { int tot = 0; for (int g2 = 0; g2 < 256; ++g2) tot += HIST[g2 * 32 + tid]; cnt[tid] = tot; }
                __syncthreads();
                if (tid == 0) { int ts = 0; for (int e = 0; e < 32; ++e) { TSTART[e] = ts; ts += (cnt[e] + 255) >> 8; } TSTART[32] = ts; }
            }
            __syncthreads();
        }
#endif
        xcd_barrier(bar);
        }
                for (int rp_ = 0; rp_ < RP_F1; ++rp_) {
#if PH_F1
        { pg8::Gemm g{XB, WGU, SROWS, 32 * 512, D, D, STOK}; pg8::MoeOrderP S{(const LAS int*)TSTART, (GAS unsigned*)(opqp(args.ws) + WS_CTL) + CW_F1 + l * 256, G, vcu};
          pg8::EpiAct E{ACT, SRSTD, SW};
          pg8::gemm_phase<pg8::EpiAct, pg8::MoeOrderP, true, true, true>(lds, g, S, E, wv); }
#endif
        }
                for (int rp_ = 0; rp_ < RP_F2; ++rp_) {
#if PH_F2
        { pg8::Gemm g{ACT, WD, SROWS, 32 * 1024, opq(256), opq(256), nullptr}; pg8::MoeOrderC S{(const LAS int*)TSTART, (const GAS unsigned*)(opqp(args.ws) + WS_CTL) + CW_F1 + l * 256, G, vcu, wv};
          pg8::EpiRS E{YB, 1024, nullptr, 0, 0.f, 1.f, 3, 31, 0};
          pg8::gemm_phase<pg8::EpiRS, pg8::MoeOrderC, true, true>(lds, g, S, E, wv); }
#endif
        xcd_barrier(bar);
        }
#if PH_F3
        { PH_BEGIN;
            const GAS float* g_fin = INP(25);
            int s0n = SLOT[gw * 2], s1n = SLOT[gw * 2 + 1];
            for (int m = gw; m < M; m += NGW) {
                GAS u32x2* xr = (GAS u32x2*)(XB + (size_t)m * D) + lane; const int s0 = s0n, s1 = s1n;
                if (m + NGW < M) { s0n = SLOT[(m + NGW) * 2]; s1n = SLOT[(m + NGW) * 2 + 1]; }
                const GAS u32x2* y0 = (const GAS u32x2*)(YB + (size_t)s0 * D) + lane; const GAS u32x2* y1 = (const GAS u32x2*)(YB + (size_t)s1 * D) + lane;
                f32x4 v[4]; float s = 0.f;
#pragma unroll
                for (int j = 0; j < 4; ++j) { const u32x2 a = y0[64 * j], b2 = y1[64 * j], xw = xr[64 * j];
                    v[j][0] = pg8::bflo(xw.x) + (pg8::bflo(a.x) + pg8::bflo(b2.x)); v[j][1] = pg8::bfhi(xw.x) + (pg8::bfhi(a.x) + pg8::bfhi(b2.x));
                    v[j][2] = pg8::bflo(xw.y) + (pg8::bflo(a.y) + pg8::bflo(b2.y)); v[j][3] = pg8::bfhi(xw.y) + (pg8::bfhi(a.y) + pg8::bfhi(b2.y));
                    s += (v[j][0] * v[j][0] + v[j][1] * v[j][1]) + (v[j][2] * v[j][2] + v[j][3] * v[j][3]); }
                s = wave_sum(s);
                if (l == DEPTH - 1) { const float rsd = 1.0f / sqrtf(s * (1.f / 1024.f) + 1e-6f); GAS f32x4* orow = (GAS f32x4*)(OUTP + (size_t)m * D) + lane;
#pragma unroll
                    for (int j = 0; j < 4; ++j) { const f32x4 gg = ((const GAS f32x4*)g_fin)[lane + 64 * j]; orow[64 * j] = v[j] * rsd * gg; }
                } else {
#pragma unroll
                    for (int j = 0; j < 4; ++j) { u32x2 w; w.x = pk2(v[j][0], v[j][1]); w.y = pk2(v[j][2], v[j][3]); xr[64 * j] = w; }
                    if (lane < 16) SSQ[(size_t)m * 16 + lane] = (lane == 0) ? s : 0.f;
                }
            }
        }
#endif
    }
}

extern "C" void kernel_launch(void* const* d_in, const int* in_sizes, int n_in, void* d_out, int out_size, void* d_ws, size_t ws_size, hipStream_t stream) {
    static int grid = 0;
    if (grid == 0) {
        if (n_in != 26 || in_sizes[0] != M * D || out_size != M * D || ws_size < WS_END) { fprintf(stderr, "kernel_launch: unexpected shapes (n_in %d, in0 %d, out %d, ws %zu < %zu)\n", n_in, n_in > 0 ? in_sizes[0] : -1, out_size, ws_size, (size_t)WS_END); grid = -1; return; }
        int dev = 0, cus = 0;
        if (hipGetDevice(&dev) != hipSuccess || hipDeviceGetAttribute(&cus, hipDeviceAttributeMultiprocessorCount, dev) != hipSuccess) { grid = -1; return; }
        if (hipFuncSetAttribute((const void*)fwd, hipFuncAttributeMaxDynamicSharedMemorySize, LDS_BYTES) != hipSuccess) { fprintf(stderr, "kernel_launch: hipFuncSetAttribute failed\n"); grid = -1; return; }
        int per_cu = 0;
        if (hipOccupancyMaxActiveBlocksPerMultiprocessor(&per_cu, (const void*)fwd, NTHREADS, LDS_BYTES) != hipSuccess || per_cu < 1) fprintf(stderr, "kernel_launch: occupancy query says %d\n", per_cu);
        (void)hipGetLastError();
        grid = cus < 256 ? (cus / 8) * 8 : 256;
    }
    if (grid <= 0) return;
    if (hipMemsetAsync((char*)d_ws + WS_CTL, 0, CTL_ZERO_BYTES, stream) != hipSuccess) return;
    Args a{};
    for (int i = 0; i < 26; ++i) a.in[i] = (const float*)d_in[i];
    a.out = (float*)d_out; a.ws = (unsigned char*)d_ws;
    hipLaunchKernelGGL(fwd, dim3(grid), dim3(NTHREADS), LDS_BYTES, stream, a);
}
```

```cpp
#include <hip/hip_runtime.h>
#include <cstdio>
#include <cstdint>
#define LAS __attribute__((address_space(3)))
#define GAS __attribute__((address_space(1)))
#ifndef PH_A
#define PH_A 1
#endif
#ifndef PH_B
#define PH_B 1
#endif
#ifndef PH_C
#define PH_C 1
#endif
#ifndef PH_D1
#define PH_D1 1
#endif
#ifndef PH_D2
#define PH_D2 1
#endif
#ifndef PH_E1
#define PH_E1 1
#endif
#ifndef PH_E2
#define PH_E2 1
#endif
#ifndef PH_E3
#define PH_E3 1
#endif
#ifndef PH_F0A
#define PH_F0A 1
#endif
#ifndef PH_F0B
#define PH_F0B 1
#endif
#ifndef PH_F1
#define PH_F1 1
#endif
#ifndef PH_F2
#define PH_F2 1
#endif
#ifndef PH_P0
#define PH_P0 1
#endif
#ifndef PH_F3
#define PH_F3 1
#endif
#ifndef PH_C_DIFF
#define PH_C_DIFF 1
#endif
#ifndef PH_C_SB
#define PH_C_SB 1
#endif
#ifndef PH_C_MLA
#define PH_C_MLA 1
#endif
#ifndef PH_B1
#define PH_B1 1
#endif
#ifndef PH_B2
#define PH_B2 1
#endif
#ifndef PH_B3
#define PH_B3 1
#endif
#ifndef RP_A
#define RP_A 1
#endif
#ifndef RP_B
#define RP_B 1
#endif
#ifndef RP_C
#define RP_C 1
#endif
#ifndef RP_D1
#define RP_D1 1
#endif
#ifndef RP_E1
#define RP_E1 1
#endif
#ifndef RP_E2
#define RP_E2 1
#endif
#ifndef RP_F0A
#define RP_F0A 1
#endif
#ifndef RP_F0B
#define RP_F0B 1
#endif
#ifndef RP_F1
#define RP_F1 1
#endif
#ifndef RP_F2
#define RP_F2 1
#endif
#ifndef RP_P0
#define RP_P0 1
#endif
#ifndef C_REP_MASK
#define C_REP_MASK 7
#endif
#ifndef C_ABL
#define C_ABL 0
#endif
namespace pg8 {
#define PG8_LAS __attribute__((address_space(3)))
typedef unsigned short bf16_t;
typedef short bf16x8 __attribute__((ext_vector_type(8)));
typedef float f32x4 __attribute__((ext_vector_type(4)));
typedef unsigned u32x4 __attribute__((ext_vector_type(4)));
constexpr int BM = 256, BK = 64, HALF = 128, HTB = HALF * BK * 2  , STAGE_BYTES = 8 * HTB, NXCD = 8, WGM = 8;

__host__ __device__ __forceinline__ int lds_byte(int r, int c) { const int st = (r >> 4) * 2 + (c >> 5), rr = r & 15, cc = c & 31, ob = rr * 64 + cc * 2; return st * 1024 + (ob ^ (((ob >> 9) & 1) << 5)); }
__host__ __device__ __forceinline__ void stage_rc(int b, int& R, int& C) { const int st = b / 1024, sb = b % 1024, swz = sb ^ (((sb >> 9) & 1) << 5); R = (st >> 1) * 16 + swz / 64; C = (st & 1) * 32 + (swz % 64) / 2; }
__host__ __device__ __forceinline__ int perm32(int rho) { const int n = rho >> 4, i = rho & 15; return 8 * (i >> 2) + 4 * n + (i & 3); }

struct Unit { int pm, pn, sel; };
struct Gemm { const GAS bf16_t* A; const GAS bf16_t* Bt; int M, N, K, ld; const GAS int* rowidx; };

struct StaticOrder {
    int nM, nN, nwg, G, c;
    __host__ __device__ void init(int M, int N, int G_, int c_) { nM = M / BM; nN = N / BM; nwg = nM * nN; G = G_; c = c_; }
    __host__ __device__ bool next(int i, Unit& u) const {
        const long L = (long)i * G + c; if (L >= nwg) return false;
        int wgid = (int)L; { const int q = nwg / NXCD, r = nwg % NXCD, xcd = wgid % NXCD, off = wgid / NXCD; wgid = (xcd < r ? xcd * (q + 1) : r * (q + 1) + (xcd - r) * q) + off; }
        const int nig = WGM * nN, gid = wgid / nig, fm = gid * WGM, gsz = (nM - fm) < WGM ? (nM - fm) : WGM;
        u.pm = fm + ((wgid % nig) % gsz); u.pn = (wgid % nig) / gsz; u.sel = 0; return true;
    }
    __device__ __forceinline__ void a_ready(const Unit&) const {}
    __device__ __forceinline__ void done(const Unit&) const {}
    __device__ __forceinline__ size_t a_off(const Unit&) const { return 0; }
    __device__ __forceinline__ size_t b_off(const Unit&) const { return 0; }
    __device__ __forceinline__ bool keep(const Unit&) const { return false; }
};

__device__ __forceinline__ unsigned cvt_pk_bf16(float lo, float hi) { unsigned r; asm volatile("v_cvt_pk_bf16_f32 %0, %1, %2" : "=v"(r) : "v"(lo), "v"(hi)); return r; }
template <class T, class = void> struct HasScale { static constexpr bool v = false; };
template <class T> struct HasScale<T, decltype((void)T::SCALE)> { static constexpr bool v = true; };
template <class Epi, class Sched, bool ALIGN_EPI = false, bool SP2 = false, bool GATHER = false>
__device__ __forceinline__ void gemm_phase(PG8_LAS unsigned char* lds, const Gemm g, const Sched& S, const Epi& E, const int wave_idx) {
    int tid_; asm volatile("v_mbcnt_lo_u32_b32 %0, -1, 0\n\tv_mbcnt_hi_u32_b32 %0, -1, %0" : "=v"(tid_)); tid_ += wave_idx * 64;
    const int tid = tid_, wid = __builtin_amdgcn_readfirstlane(tid >> 6), lane = tid & 63, wr = wid >> 2, wc = wid & 3, fr = lane & 15, fq = lane >> 4;
    const int K = g.K, nt = K / BK, LD = g.ld;
    unsigned voffA[2], voffB[2];
#pragma unroll
    for (int i = 0; i < 2; ++i) { int R, C; stage_rc(tid * 16 + i * 8192, R, C); const int Rb = Epi::PERM ? ((R & ~31) + perm32(R & 31)) : R;
        voffA[i] = (unsigned)(R * LD + C) * 2u; voffB[i] = (unsigned)(Rb * LD + C) * 2u; }
    const size_t kstep = (size_t)(BK * 2);
    const size_t hstep = (size_t)HALF * LD * 2;
    const size_t tstep = 2 * hstep;
    const unsigned ldsw = (unsigned)wid * 1024u;
    const int aoff = lds_byte(wr * 64 + fr, fq * 8), boff = lds_byte(wc * 32 + fr, fq * 8);
#define PG8_SA(b, h) (((b) * 2 + (h)) * HTB)
#define PG8_SB(b, h) ((4 + (b) * 2 + (h)) * HTB)
#define PG8_STAGE(bufoff, gbase, voff) do { _Pragma("unroll") for (int _i = 0; _i < 2; ++_i) \
        __builtin_amdgcn_global_load_lds((const GAS unsigned*)((const GAS char*)(gbase) + (voff)[_i]), (PG8_LAS unsigned*)(lds + (bufoff) + ldsw + _i * 8192), 16, 0, 0); } while (0)
#define PG8_LDA(dst, b, h) do { _Pragma("unroll") for (int m = 0; m < 4; ++m) _Pragma("unroll") for (int k = 0; k < 2; ++k) dst[m][k] = *(const PG8_LAS bf16x8*)(lds + PG8_SA(b, h) + aoff + m * 2048 + k * 1024); } while (0)
#define PG8_LDB(dst, b, h) do { _Pragma("unroll") for (int n = 0; n < 2; ++n) _Pragma("unroll") for (int k = 0; k < 2; ++k) dst[n][k] = *(const PG8_LAS bf16x8*)(lds + PG8_SB(b, h) + boff + n * 2048 + k * 1024); } while (0)
#define PG8_MMA(ai, bj, At, Bt) do { __builtin_amdgcn_s_setprio(1); _Pragma("unroll") for (int m = 0; m < 4; ++m) _Pragma("unroll") for (int n = 0; n < 2; ++n) _Pragma("unroll") for (int k = 0; k < 2; ++k) \
        acc[ai][bj][m][n] = __builtin_amdgcn_mfma_f32_16x16x32_bf16(Bt[n][k], At[m][k], acc[ai][bj][m][n], 0, 0, 0); __builtin_amdgcn_s_setprio(0); } while (0)
#define PG8_WAIT_V(n) asm volatile("s_waitcnt vmcnt(" #n ")" ::: "memory")
#define PG8_WAIT_L(n) asm volatile("s_waitcnt lgkmcnt(" #n ")" ::: "memory")
#define PG8_BAR __builtin_amdgcn_s_barrier()
#define PG8_SCHED __builtin_amdgcn_sched_barrier(0)
    Unit cur, nxt; int ui = 0;
    if (!S.next(0, cur)) return;
    f32x4 acc[2][2][4][2];
#pragma unroll
    for (int a = 0; a < 2; ++a)
#pragma unroll
        for (int b = 0; b < 2; ++b)
#pragma unroll
            for (int m = 0; m < 4; ++m)
#pragma unroll
                for (int n = 0; n < 2; ++n) acc[a][b][m][n] = (f32x4){0.f, 0.f, 0.f, 0.f};
    bf16x8 At[4][2], B0[2][2], B1[2][2];
    const GAS char* cA = (const GAS char*)g.A + (GATHER ? (size_t)0 : (size_t)cur.pm * tstep + S.a_off(cur)); const GAS char* cB = (const GAS char*)g.Bt + (size_t)cur.pn * tstep + S.b_off(cur);
    unsigned vC[2][2], vN[2][2];
    if constexpr (GATHER) {
#pragma unroll
        for (int h = 0; h < 2; ++h)
#pragma unroll
            for (int i = 0; i < 2; ++i) { int R, C; stage_rc(tid * 16 + i * 8192, R, C); vC[h][i] = (unsigned)(g.rowidx[cur.pm * BM + h * HALF + R] * LD + C) * 2u; vN[h][i] = vC[h][i]; }
    }
#define PG8_STAGE_A(bufoff, gb, h, nx) do { if constexpr (GATHER) { unsigned vs_[2] = {(nx) ? vN[h][0] : vC[h][0], (nx) ? vN[h][1] : vC[h][1]}; PG8_STAGE(bufoff, gb, vs_); } \
        else { PG8_STAGE(bufoff, (gb) + (h) * hstep, voffA); } } while (0)
    S.a_ready(cur);
    if constexpr (SP2) {
        PG8_STAGE(PG8_SB(0, 0), cB, voffB); PG8_STAGE(PG8_SB(0, 1), cB + hstep, voffB); PG8_STAGE_A(PG8_SA(0, 0), cA, 0, false); PG8_STAGE_A(PG8_SA(0, 1), cA, 1, false);
        if (wr == 1) PG8_BAR;
        PG8_WAIT_V(2); PG8_BAR;
        PG8_STAGE(PG8_SB(1, 0), cB + kstep, voffB); PG8_STAGE_A(PG8_SA(1, 0), cA + kstep, 0, false); PG8_STAGE(PG8_SB(1, 1), cB + hstep + kstep, voffB);
        PG8_WAIT_V(6); PG8_BAR;
    } else {
        PG8_STAGE(PG8_SB(0, 0), cB, voffB); PG8_STAGE(PG8_SA(0, 0), cA, voffA); PG8_STAGE(PG8_SB(0, 1), cB + hstep, voffB); PG8_STAGE(PG8_SA(0, 1), cA + hstep, voffA);
        if (wr == 1) PG8_BAR;
        PG8_WAIT_V(4); PG8_BAR;
        PG8_STAGE(PG8_SB(1, 0), cB + kstep, voffB); PG8_STAGE(PG8_SA(1, 0), cA + kstep, voffA); PG8_STAGE(PG8_SB(1, 1), cB + hstep + kstep, voffB);
        PG8_WAIT_V(6); PG8_BAR;
    }
    for (;;) {
        const bool has_next = S.next(ui + 1, nxt);
        if constexpr (GATHER) { if (has_next) {
#pragma unroll
            for (int h = 0; h < 2; ++h)
#pragma unroll
                for (int i = 0; i < 2; ++i) { int R, C; stage_rc(tid * 16 + i * 8192, R, C); vN[h][i] = (unsigned)(g.rowidx[nxt.pm * BM + h * HALF + R] * LD + C) * 2u; } } }
        const GAS char* nA = GATHER ? cA : has_next ? (const GAS char*)g.A + (size_t)nxt.pm * tstep + S.a_off(nxt) : cA; const GAS char* nB = has_next ? (const GAS char*)g.Bt + (size_t)nxt.pn * tstep + S.b_off(nxt) : cB;
        for (int t = 0; t < nt; t += 2) {
            const bool last = (t == nt - 2);
            const GAS char* a1 = cA + (size_t)(t + 1) * kstep;
            const GAS char* a2 = last ? nA : cA + (size_t)(t + 2) * kstep; const GAS char* b2 = last ? nB : cB + (size_t)(t + 2) * kstep;
            const GAS char* a3 = a2 + kstep; const GAS char* b3 = b2 + kstep;
            if (last && has_next) S.a_ready(nxt);
            if constexpr (SP2) {
            PG8_LDB(B0, 0, 0); PG8_LDB(B1, 0, 1); PG8_SCHED; PG8_LDA(At, 0, 0); PG8_STAGE_A(PG8_SA(1, 1), a1, 1, false);
            PG8_WAIT_V(8); PG8_WAIT_L(0); PG8_BAR; PG8_MMA(0, 0, At, B0); PG8_MMA(0, 1, At, B1); PG8_BAR; PG8_SCHED;
            PG8_LDA(At, 0, 1); PG8_STAGE(PG8_SB(0, 0), b2, voffB); PG8_STAGE(PG8_SB(0, 1), b2 + hstep, voffB); PG8_STAGE_A(PG8_SA(0, 0), a2, 0, last);
            PG8_WAIT_V(8); PG8_WAIT_L(0); PG8_BAR; PG8_MMA(1, 0, At, B0); PG8_MMA(1, 1, At, B1); PG8_BAR; PG8_SCHED;
            PG8_LDB(B0, 1, 0); PG8_LDB(B1, 1, 1); PG8_SCHED; PG8_LDA(At, 1, 0); PG8_STAGE_A(PG8_SA(0, 1), a2, 1, last);
            PG8_WAIT_V(8); PG8_WAIT_L(0); PG8_BAR; PG8_MMA(0, 0, At, B0); PG8_MMA(0, 1, At, B1); PG8_BAR; PG8_SCHED;
            PG8_LDA(At, 1, 1); PG8_STAGE(PG8_SB(1, 0), b3, voffB); PG8_STAGE(PG8_SB(1, 1), b3 + hstep, voffB); PG8_STAGE_A(PG8_SA(1, 0), a3, 0, last);
            PG8_WAIT_V(8); PG8_WAIT_L(0); PG8_BAR; PG8_MMA(1, 0, At, B0); PG8_MMA(1, 1, At, B1); PG8_BAR; PG8_SCHED;
            } else {
            PG8_LDB(B0, 0, 0); PG8_SCHED; PG8_LDA(At, 0, 0); PG8_STAGE(PG8_SA(1, 1), a1 + hstep, voffA);
            PG8_WAIT_L(8); PG8_BAR; PG8_WAIT_L(0); PG8_MMA(0, 0, At, B0); PG8_BAR; PG8_SCHED;
            PG8_LDB(B1, 0, 1); PG8_STAGE(PG8_SB(0, 0), b2, voffB);
            PG8_BAR; PG8_WAIT_L(0); PG8_MMA(0, 1, At, B1); PG8_BAR;
            PG8_LDA(At, 0, 1); PG8_STAGE(PG8_SA(0, 0), a2, voffA);
            PG8_BAR; PG8_WAIT_L(0); PG8_MMA(1, 0, At, B0); PG8_BAR; PG8_SCHED;
            PG8_STAGE(PG8_SB(0, 1), b2 + hstep, voffB);
            PG8_WAIT_V(6); PG8_BAR; PG8_MMA(1, 1, At, B1); PG8_BAR;
            PG8_LDB(B0, 1, 0); PG8_SCHED; PG8_LDA(At, 1, 0); PG8_STAGE(PG8_SA(0, 1), a2 + hstep, voffA);
            PG8_WAIT_L(8); PG8_BAR; PG8_WAIT_L(0); PG8_MMA(0, 0, At, B0); PG8_BAR; PG8_SCHED;
            PG8_LDB(B1, 1, 1); PG8_STAGE(PG8_SB(1, 0), b3, voffB);
            PG8_BAR; PG8_WAIT_L(0); PG8_MMA(0, 1, At, B1); PG8_BAR;
            PG8_LDA(At, 1, 1); PG8_STAGE(PG8_SA(1, 0), a3, voffA);
            PG8_BAR; PG8_WAIT_L(0); PG8_MMA(1, 0, At, B0); PG8_BAR; PG8_SCHED;
            PG8_STAGE(PG8_SB(1, 1), b3 + hstep, voffB);
            PG8_WAIT_V(6); PG8_BAR; PG8_MMA(1, 1, At, B1); PG8_BAR;
            }
        }
        if constexpr (ALIGN_EPI) { if (wr == 0) PG8_BAR; }
        const int keep_ = (int)S.keep(cur);
        if constexpr (HasScale<Epi>::v) { if (keep_ == 2) E.scale(acc, cur, wr, wc, fr, fq); }
        if constexpr (!Epi::AFTER_DRAIN) { if (keep_ == 0) { E(acc, cur, wr, wc, fr, fq); S.done(cur); } }
        if (!has_next) break;
        if (keep_ == 0) {
#pragma unroll
        for (int a = 0; a < 2; ++a)
#pragma unroll
            for (int b = 0; b < 2; ++b)
#pragma unroll
                for (int m = 0; m < 4; ++m)
#pragma unroll
                    for (int n = 0; n < 2; ++n) acc[a][b][m][n] = (f32x4){0.f, 0.f, 0.f, 0.f}; }
        cur = nxt; cA = nA; cB = nB; ++ui;
        if constexpr (GATHER) { vC[0][0] = vN[0][0]; vC[0][1] = vN[0][1]; vC[1][0] = vN[1][0]; vC[1][1] = vN[1][1]; }
        if constexpr (ALIGN_EPI) { if (wr == 1) PG8_BAR; }
    }
    PG8_WAIT_V(0);
    if constexpr (!ALIGN_EPI) { if (wr == 0) PG8_BAR; }
    PG8_BAR;
    if constexpr (Epi::AFTER_DRAIN) { E.fused(acc, cur, wr, wc, fr, fq, lds, wid, lane); S.done(cur); }
#undef PG8_SA
#undef PG8_SB
#undef PG8_STAGE
#undef PG8_STAGE_A
#undef PG8_LDA
#undef PG8_LDB
#undef PG8_MMA
#undef PG8_WAIT_V
#undef PG8_WAIT_L
#undef PG8_BAR
#undef PG8_SCHED
}
typedef unsigned u32x2 __attribute__((ext_vector_type(2)));
typedef float f32x2v __attribute__((ext_vector_type(2)));
typedef __bf16 bf16x2v __attribute__((ext_vector_type(2)));
__device__ __forceinline__ unsigned pk2(float lo, float hi) { f32x2v v = {lo, hi}; bf16x2v b = __builtin_convertvector(v, bf16x2v); return __builtin_bit_cast(unsigned, b); }
__device__ __forceinline__ float bflo(unsigned w) { return __builtin_bit_cast(float, w << 16); }
__device__ __forceinline__ float bfhi(unsigned w) { return __builtin_bit_cast(float, w & 0xffff0000u); }
__device__ __forceinline__ float rstd_parts(const GAS float* base, unsigned eoff, int n4, float inv_n) {
    float s = 0.f; const GAS char* p = (const GAS char*)base + (size_t)(eoff * 4u);
    for (int i = 0; i < n4; ++i) { const f32x4 v = *(const GAS f32x4*)(p + 16 * i); s += (v[0] + v[1]) + (v[2] + v[3]); }
    return __builtin_amdgcn_rsqf(s * inv_n + 1e-6f);
}
__device__ const double kRopeRev[16] = {0.15915494309189535, 0.08949940160889101, 0.050329212104487035, 0.0283021958306234, 0.015915494309189534, 0.008949940160889102, 0.005032921210448704, 0.00283021958306234,
                                        0.0015915494309189536, 0.0008949940160889102, 0.0005032921210448703, 0.00028302195830623395, 0.00015915494309189535, 8.949940160889102e-05, 5.0329212104487035e-05, 2.8302195830623396e-05};
__device__ __forceinline__ void rope_cs(int pos, int i, float& cs, float& sn) {
    double a = (double)pos * kRopeRev[i]; a -= __builtin_floor(a);
    const float r = (float)a; sn = __builtin_amdgcn_sinf(r); cs = __builtin_amdgcn_cosf(r);
}
#define PG8_L2E 1.4426950408889634f

struct EpiA {
    static constexpr bool PERM = false, AFTER_DRAIN = false;
    const GAS float* ssq; GAS bf16_t *cq, *ckv, *krope, *qk; GAS float *ssq_cq, *ssq_ckv; float c2; GAS unsigned* kn;
    __device__ __forceinline__ void operator()(const f32x4 (&acc)[2][2][4][2], const Unit& u, int wr, int wc, int fr, int fq) const {
        const int pn = u.pn, row0 = u.pm * BM + wr * 64 + fr;
        float rs[2][4];
#pragma unroll
        for (int ai = 0; ai < 2; ++ai)
#pragma unroll
            for (int m = 0; m < 4; ++m) rs[ai][m] = rstd_parts(ssq, (unsigned)((row0 + ai * HALF + m * 16) * 16), 4, 1.f / 1024.f);
        if (pn < 2) {
            GAS bf16_t* dst = pn == 0 ? cq : ckv; GAS float* sq = pn == 0 ? ssq_cq : ssq_ckv;
#pragma unroll
            for (int ai = 0; ai < 2; ++ai)
#pragma unroll
                for (int m = 0; m < 4; ++m) { const int row = row0 + ai * HALF + m * 16; const float r = rs[ai][m]; float s2 = 0.f;
#pragma unroll
                    for (int bj = 0; bj < 2; ++bj)
#pragma unroll
                        for (int n = 0; n < 2; ++n) { const f32x4 v = acc[ai][bj][m][n] * r; s2 += (v[0] * v[0] + v[1] * v[1]) + (v[2] * v[2] + v[3] * v[3]);
                            u32x2 w; w.x = pk2(v[0], v[1]); w.y = pk2(v[2], v[3]); *(GAS u32x2*)(dst + (size_t)row * 256 + bj * HALF + wc * 32 + n * 16 + fq * 4) = w; }
                    s2 += __shfl_xor(s2, 16); s2 += __shfl_xor(s2, 32);
                    if (fq == 0) sq[(size_t)row * 4 + wc] = s2; }
        } else if (pn == 2) {
            if (wc == 0) {
#pragma unroll
                for (int ai = 0; ai < 2; ++ai)
#pragma unroll
                    for (int m = 0; m < 4; ++m) { const int row = row0 + ai * HALF + m * 16, pos = row & 8191; const float r = rs[ai][m];
                        const f32x4 v0 = acc[ai][0][m][0] * r, v1 = acc[ai][0][m][1] * r; float o0[4], o1[4];
#pragma unroll
                        for (int e = 0; e < 4; ++e) { float cs, sn; rope_cs(pos, 4 * fq + e, cs, sn); o0[e] = v0[e] * cs - v1[e] * sn; o1[e] = v0[e] * sn + v1[e] * cs; }
                        u32x2 w0, w1; w0.x = pk2(o0[0], o0[1]); w0.y = pk2(o0[2], o0[3]); w1.x = pk2(o1[0], o1[1]); w1.y = pk2(o1[2], o1[3]);
                        *(GAS u32x2*)(krope + (size_t)row * 32 + 4 * fq) = w0; *(GAS u32x2*)(krope + (size_t)row * 32 + 16 + 4 * fq) = w1; }
            }
        } else {
            const int t = pn - 3, buf = t >> 1, half = t & 1; GAS bf16_t* dst = qk + (size_t)buf * 16384 * 512; const float sc = (buf & 1) ? 1.f : c2;
#pragma unroll
            for (int ai = 0; ai < 2; ++ai)
#pragma unroll
                for (int bj = 0; bj < 2; ++bj) { float kmx = 0.f;
#pragma unroll
                    for (int m = 0; m < 4; ++m) { const int row = row0 + ai * HALF + m * 16; const float r = rs[ai][m] * sc; float s2 = 0.f;
#pragma unroll
                        for (int n = 0; n < 2; ++n) { const f32x4 v = acc[ai][bj][m][n] * r; u32x2 w; w.x = pk2(v[0], v[1]); w.y = pk2(v[2], v[3]);
                            s2 += (v[0] * v[0] + v[1] * v[1]) + (v[2] * v[2] + v[3] * v[3]);
                            *(GAS u32x2*)(dst + (size_t)row * 512 + half * 256 + bj * HALF + wc * 32 + n * 16 + fq * 4) = w; }
                        kmx = fmaxf(kmx, s2); }
                    if (pn >= 9) {
                        float s = kmx; const float q1 = __shfl_xor(s, 16), q2 = __shfl_xor(s, 32), q3 = __shfl_xor(q1, 32); s = (s + q1) + (q2 + q3);
                        s = fmaxf(s, __shfl_xor(s, 1)); s = fmaxf(s, __shfl_xor(s, 2)); s = fmaxf(s, __shfl_xor(s, 4)); s = fmaxf(s, __shfl_xor(s, 8));
                        if ((fr | fq) == 0) __hip_atomic_fetch_max(kn + (((size_t)(4 * u.pm + 2 * ai + wr) * 8 + 4 * (pn - 9) + 2 * bj + (wc >> 1)) * 2 + (wc & 1)), __builtin_bit_cast(unsigned, s), __ATOMIC_RELAXED, __HIP_MEMORY_SCOPE_AGENT); } }
        }
    }
};
struct EpiVT {
    static constexpr bool PERM = true, AFTER_DRAIN = false;
    GAS bf16_t* out; int ld; const GAS float* ssq; int n4; float inv_n;
    __device__ __forceinline__ void operator()(const f32x4 (&acc)[2][2][4][2], const Unit& u, int wr, int wc, int fr, int fq) const {
        const int col0 = u.pn * BM + wc * 32 + 8 * fq, row0 = u.pm * BM + wr * 64 + fr;
        float cs[2][8];
#pragma unroll
        for (int bj = 0; bj < 2; ++bj)
#pragma unroll
            for (int j = 0; j < 8; ++j) cs[bj][j] = rstd_parts(ssq, (unsigned)((col0 + bj * HALF + j) * (4 * n4)), n4, inv_n);
#pragma unroll
        for (int ai = 0; ai < 2; ++ai)
#pragma unroll
            for (int m = 0; m < 4; ++m) { GAS bf16_t* rowp = out + (size_t)(row0 + ai * HALF + m * 16) * ld + col0;
#pragma unroll
                for (int bj = 0; bj < 2; ++bj) { const f32x4 v0 = acc[ai][bj][m][0], v1 = acc[ai][bj][m][1]; u32x4 w;
                    w.x = pk2(v0[0] * cs[bj][0], v0[1] * cs[bj][1]); w.y = pk2(v0[2] * cs[bj][2], v0[3] * cs[bj][3]);
                    w.z = pk2(v1[0] * cs[bj][4], v1[1] * cs[bj][5]); w.w = pk2(v1[2] * cs[bj][6], v1[3] * cs[bj][7]);
                    *(GAS u32x4*)(rowp + bj * HALF) = w; } }
    }
};
struct EpiRS {
    static constexpr bool PERM = true, AFTER_DRAIN = false;
    GAS bf16_t* out; int ld; const GAS float* ssq; int n4; float inv_n; float scale; int pnmask; int pnshift; size_t zstride;
    __device__ __forceinline__ void operator()(const f32x4 (&acc)[2][2][4][2], const Unit& u, int wr, int wc, int fr, int fq) const {
        const int col0 = (u.pn & pnmask) * BM + wc * 32 + 8 * fq, row0 = u.pm * BM + wr * 64 + fr;
        float rr[2][4];
#pragma unroll
        for (int ai = 0; ai < 2; ++ai)
#pragma unroll
            for (int m = 0; m < 4; ++m) rr[ai][m] = (n4 ? rstd_parts(ssq, (unsigned)((row0 + ai * HALF + m * 16) * (4 * n4)), n4, inv_n) : 1.f) * scale;
#pragma unroll
        for (int ai = 0; ai < 2; ++ai)
#pragma unroll
            for (int m = 0; m < 4; ++m) { const int row = row0 + ai * HALF + m * 16; const float r = rr[ai][m];
                GAS bf16_t* rowp = out + (size_t)(u.pn >> pnshift) * zstride + (size_t)row * ld + col0;
#pragma unroll
                for (int bj = 0; bj < 2; ++bj) { const f32x4 v0 = acc[ai][bj][m][0] * r, v1 = acc[ai][bj][m][1] * r; u32x4 w;
                    w.x = pk2(v0[0], v0[1]); w.y = pk2(v0[2], v0[3]); w.z = pk2(v1[0], v1[1]); w.w = pk2(v1[2], v1[3]); *(GAS u32x4*)(rowp + bj * HALF) = w; } }
    }
};
struct EpiQ {
    static constexpr bool PERM = false, AFTER_DRAIN = false;
    GAS bf16_t* q; const GAS float* ssq_cq; float c2;
    __device__ __forceinline__ void operator()(const f32x4 (&acc)[2][2][4][2], const Unit& u, int wr, int wc, int fr, int fq) const {
        const int pn = u.pn, row0 = u.pm * BM + wr * 64 + fr;
        float rr[2][4];
#pragma unroll
        for (int ai = 0; ai < 2; ++ai)
#pragma unroll
            for (int m = 0; m < 4; ++m) rr[ai][m] = rstd_parts(ssq_cq, (unsigned)((row0 + ai * HALF + m * 16) * 4), 1, 1.f / 256.f) * c2;
#pragma unroll
        for (int ai = 0; ai < 2; ++ai)
#pragma unroll
            for (int m = 0; m < 4; ++m) { const int row = row0 + ai * HALF + m * 16; const float r = rr[ai][m];
                if (pn < 2) {
#pragma unroll
                    for (int bj = 0; bj < 2; ++bj)
#pragma unroll
                        for (int n = 0; n < 2; ++n) { const f32x4 v = acc[ai][bj][m][n] * r; u32x2 w; w.x = pk2(v[0], v[1]); w.y = pk2(v[2], v[3]);
                            *(GAS u32x2*)(q + (size_t)row * 768 + pn * 256 + bj * HALF + wc * 32 + n * 16 + fq * 4) = w; }
                } else { const int pos = row & 8191; float cs[4], sn[4];
#pragma unroll
                    for (int e = 0; e < 4; ++e) rope_cs(pos, 4 * fq + e, cs[e], sn[e]);
#pragma unroll
                    for (int bj = 0; bj < 2; ++bj) { const f32x4 v0 = acc[ai][bj][m][0] * r, v1 = acc[ai][bj][m][1] * r; float o0[4], o1[4];
#pragma unroll
                        for (int e = 0; e < 4; ++e) { o0[e] = v0[e] * cs[e] - v1[e] * sn[e]; o1[e] = v0[e] * sn[e] + v1[e] * cs[e]; }
                        u32x2 w0, w1; w0.x = pk2(o0[0], o0[1]); w0.y = pk2(o0[2], o0[3]); w1.x = pk2(o1[0], o1[1]); w1.y = pk2(o1[2], o1[3]);
                        GAS bf16_t* p = q + (size_t)row * 768 + 512 + (4 * bj + wc) * 32 + 4 * fq; *(GAS u32x2*)p = w0; *(GAS u32x2*)(p + 16) = w1; }
                } }
    }
};
struct D1Order {
    StaticOrder so; size_t dA, dB;
    __device__ __forceinline__ bool next(int i, Unit& u) const { if (i >= 9) return false; if (!so.next(0, u)) return false; u.sel = i; return true; }
    __device__ __forceinline__ void a_ready(const Unit&) const {}
    __device__ __forceinline__ void done(const Unit&) const {}
    __device__ __forceinline__ size_t a_off(const Unit& u) const { const int z = u.sel - 6; return u.sel >= 6 ? dA + (size_t)(z >> 1) * 16384 * 2048 + (size_t)(z & 1) * 1024 : (size_t)(u.sel & 1) * 1024; }
    __device__ __forceinline__ size_t b_off(const Unit& u) const { const int z = u.sel - 6; return u.sel >= 6 ? dB + (size_t)(z >> 1) * 1024 * 2048 + (size_t)(z & 1) * 1024 : (size_t)(u.sel >> 1) * 1024 * 2048 + (size_t)(u.sel & 1) * 1024; }
    __device__ __forceinline__ int keep(const Unit& u) const { return u.sel < 6 ? ((u.sel & 1) ? 0 : 1) : (u.sel < 8 ? 2 : 0); }
};
struct EpiD1 {
    static constexpr bool PERM = true, AFTER_DRAIN = false, SCALE = true;
    GAS unsigned char* g; GAS bf16_t* mb; const GAS float* ssq;
    __device__ __forceinline__ void scale(f32x4 (&acc)[2][2][4][2], const Unit& u, int wr, int wc, int fr, int fq) const {
        const unsigned toff = (unsigned)(((wr * 4 + wc) * 64 + fq * 16 + fr) * 16), tile8 = (unsigned)(u.pm * 4 + u.pn) * 8u;
        const GAS unsigned char* ga = g + (size_t)((unsigned)(u.sel - 6) * 2048u + tile8) * 8192u + toff;
        const GAS unsigned char* gb = ga + (size_t)2048 * 8192;
#pragma unroll
        for (int ai = 0; ai < 2; ++ai) {
            u32x4 wa[2][2], wb[2][2];
#pragma unroll
            for (int bj = 0; bj < 2; ++bj)
#pragma unroll
                for (int mp = 0; mp < 2; ++mp) { wa[bj][mp] = *(const GAS u32x4*)(ga + ((ai * 2 + bj) * 2 + mp) * 8192); wb[bj][mp] = *(const GAS u32x4*)(gb + ((ai * 2 + bj) * 2 + mp) * 8192); }
#pragma unroll
            for (int bj = 0; bj < 2; ++bj)
#pragma unroll
                for (int mp = 0; mp < 2; ++mp)
#pragma unroll
                    for (int k = 0; k < 4; ++k) { const int m = 2 * mp + (k >> 1), n = k & 1; const unsigned qa = wa[bj][mp][k], qb = wb[bj][mp][k];
#pragma unroll
                        for (int e2 = 0; e2 < 4; ++e2) acc[ai][bj][m][n][e2] *= ((float)((qa >> (8 * e2)) & 0xffu) + 0.5f) * __builtin_amdgcn_rcpf((float)((qb >> (8 * e2)) & 0xffu) + 0.5f); }
        }
    }
    __device__ __forceinline__ void operator()(const f32x4 (&acc)[2][2][4][2], const Unit& u, int wr, int wc, int fr, int fq) const {
        const int col0 = u.pn * BM + wc * 32 + 8 * fq, row0 = u.pm * BM + wr * 64 + fr;
        const unsigned toff = (unsigned)(((wr * 4 + wc) * 64 + fq * 16 + fr) * 16), tile8 = (unsigned)(u.pm * 4 + u.pn) * 8u;
        if (u.sel < 6) {
            GAS unsigned char* gz = g + (size_t)((unsigned)(u.sel >> 1) * 2048u + tile8) * 8192u + toff;
            float rr[2][4];
#pragma unroll
            for (int ai = 0; ai < 2; ++ai)
#pragma unroll
                for (int m = 0; m < 4; ++m) rr[ai][m] = -PG8_L2E * rstd_parts(ssq, (unsigned)((row0 + ai * HALF + m * 16) * 16), 4, 1.f / 1024.f);
#pragma unroll
            for (int ai = 0; ai < 2; ++ai)
#pragma unroll
                for (int bj = 0; bj < 2; ++bj)
#pragma unroll
                    for (int mp = 0; mp < 2; ++mp) { u32x4 w;
#pragma unroll
                        for (int k = 0; k < 4; ++k) { const int m = 2 * mp + (k >> 1), n = k & 1; const float r = rr[ai][m]; unsigned pk = 0u;
#pragma unroll
                            for (int e2 = 0; e2 < 4; ++e2) { const float sg = __builtin_amdgcn_rcpf(1.f + __builtin_amdgcn_exp2f(acc[ai][bj][m][n][e2] * r));
                                pk = __builtin_amdgcn_cvt_pk_u8_f32(sg * 256.f - 0.5f, e2, pk); }
                            w[k] = pk; }
                        *(GAS u32x4*)(gz + ((ai * 2 + bj) * 2 + mp) * 8192) = w; }
        } else {
            const GAS unsigned char* ga = g + (size_t)(2u * 2048u + tile8) * 8192u + toff;
#pragma unroll
            for (int ai = 0; ai < 2; ++ai) {
                u32x4 wa[2][2];
#pragma unroll
                for (int bj = 0; bj < 2; ++bj)
#pragma unroll
                    for (int mp = 0; mp < 2; ++mp) wa[bj][mp] = *(const GAS u32x4*)(ga + ((ai * 2 + bj) * 2 + mp) * 8192);
#pragma unroll
                for (int m = 0; m < 4; ++m)
#pragma unroll
                    for (int bj = 0; bj < 2; ++bj) { const size_t o = (size_t)(row0 + ai * HALF + m * 16) * 1024 + col0 + bj * HALF; float v[8];
#pragma unroll
                        for (int j = 0; j < 8; ++j) { const unsigned qa = wa[bj][m >> 1][(m & 1) * 2 + (j >> 2)];
                            v[j] = acc[ai][bj][m][j >> 2][j & 3] * (((float)((qa >> (8 * (j & 3))) & 0xffu) + 0.5f) * (1.f / 256.f)); }
                        u32x4 w; w.x = pk2(v[0], v[1]); w.y = pk2(v[2], v[3]); w.z = pk2(v[4], v[5]); w.w = pk2(v[6], v[7]); *(GAS u32x4*)(mb + o) = w; } }
        }
    }
};
struct EpiRes {
    static constexpr bool PERM = true, AFTER_DRAIN = false;
    GAS bf16_t* xb; GAS float* ssq;
    __device__ __forceinline__ void operator()(const f32x4 (&acc)[2][2][4][2], const Unit& u, int wr, int wc, int fr, int fq) const {
        const int col0 = u.pn * BM + wc * 32 + 8 * fq, row0 = u.pm * BM + wr * 64 + fr;
#pragma unroll
        for (int ai = 0; ai < 2; ++ai) {
            u32x4 xv[4][2];
#pragma unroll
            for (int m = 0; m < 4; ++m)
#pragma unroll
                for (int bj = 0; bj < 2; ++bj) xv[m][bj] = *(const GAS u32x4*)(xb + (size_t)(row0 + ai * HALF + m * 16) * 1024 + col0 + bj * HALF);
#pragma unroll
            for (int m = 0; m < 4; ++m) { const int row = row0 + ai * HALF + m * 16; const size_t rb = (size_t)row * 1024 + col0; float s2 = 0.f;
#pragma unroll
                for (int bj = 0; bj < 2; ++bj) { const u32x4 xw = xv[m][bj]; const f32x4 a0 = acc[ai][bj][m][0], a1 = acc[ai][bj][m][1];
                    const float v0 = bflo(xw.x) + a0[0], v1 = bfhi(xw.x) + a0[1], v2 = bflo(xw.y) + a0[2], v3 = bfhi(xw.y) + a0[3];
                    const float v4 = bflo(xw.z) + a1[0], v5 = bfhi(xw.z) + a1[1], v6 = bflo(xw.w) + a1[2], v7 = bfhi(xw.w) + a1[3];
                    u32x4 w; w.x = pk2(v0, v1); w.y = pk2(v2, v3); w.z = pk2(v4, v5); w.w = pk2(v6, v7);
                    *(GAS u32x4*)(xb + rb + bj * HALF) = w;
                    s2 += ((v0 * v0 + v1 * v1) + (v2 * v2 + v3 * v3)) + ((v4 * v4 + v5 * v5) + (v6 * v6 + v7 * v7)); }
                s2 += __shfl_xor(s2, 16); s2 += __shfl_xor(s2, 32);
                if (fq == 0) ssq[(size_t)row * 16 + u.pn * 4 + wc] = s2; } }
    }
};
struct EpiAct {
    static constexpr bool PERM = true, AFTER_DRAIN = false;
    GAS bf16_t* act; const GAS float* s_rstd; const GAS float* s_w;
    __device__ __forceinline__ void operator()(const f32x4 (&acc)[2][2][4][2], const Unit& u, int wr, int wc, int fr, int fq) const {
        const int t = u.pn & 1, row0 = u.pm * BM + wr * 64 + fr;
        const __amdgpu_buffer_rsrc_t rsrc = __builtin_amdgcn_make_buffer_rsrc((void*)act, 0, 40960 * 256 * 2, 0x00020000);
        float rr[2][4], ww[2][4];
#pragma unroll
        for (int ai = 0; ai < 2; ++ai)
#pragma unroll
            for (int m = 0; m < 4; ++m) { rr[ai][m] = s_rstd[row0 + ai * HALF + m * 16]; ww[ai][m] = s_w[row0 + ai * HALF + m * 16]; }
#pragma unroll
        for (int ai = 0; ai < 2; ++ai)
#pragma unroll
            for (int m = 0; m < 4; ++m) { const int row = row0 + ai * HALF + m * 16; const float rs = rr[ai][m], w = ww[ai][m]; float o[8];
#pragma unroll
                for (int j = 0; j < 8; ++j) { const float a = acc[ai][0][m][j >> 2][j & 3] * rs, b = acc[ai][1][m][j >> 2][j & 3] * rs;
                    const float v = a * __builtin_amdgcn_rcpf(1.f + __builtin_amdgcn_exp2f(-PG8_L2E * a)) * b * w; o[j] = (w != 0.f) ? v : 0.f; }
                u32x4 pw; pw.x = pk2(o[0], o[1]); pw.y = pk2(o[2], o[3]); pw.z = pk2(o[4], o[5]); pw.w = pk2(o[6], o[7]);
                __builtin_amdgcn_raw_buffer_store_b128(pw, rsrc, (unsigned)(row * 256 + t * 128 + wc * 32 + 8 * fq) * 2u, 0,   16); }
    }
};
struct SplitK2Order {
    StaticOrder so; size_t tstep;
    __device__ __forceinline__ bool next(int i, Unit& u) const { return so.next(i, u); }
    __device__ __forceinline__ void a_ready(const Unit&) const {}
    __device__ __forceinline__ void done(const Unit&) const {}
    __device__ __forceinline__ size_t a_off(const Unit& u) const { return (size_t)(u.pn >> 1) * 1024; }
    __device__ __forceinline__ size_t b_off(const Unit& u) const { return (size_t)(u.pn >> 1) * 1024 - (size_t)(u.pn >> 1) * 2 * tstep; }
    __device__ __forceinline__ bool keep(const Unit&) const { return false; }
};
struct MoeOrder {
    const PG8_LAS int* tstart; int per, G, v;
    __device__ __forceinline__ bool next(int i, Unit& u) const {
        const int idx = i * G + v, tot = tstart[32] * per; if (idx >= tot) return false;
        const int ti = idx / per, ct = idx - ti * per; int e = 0;
#pragma unroll 1
        for (int k = 1; k < 32; ++k) e += (tstart[k] <= ti) ? 1 : 0;
        u.pm = ti; u.pn = e * per + ct; u.sel = 0; return true;
    }
    __device__ __forceinline__ void a_ready(const Unit&) const {}
    __device__ __forceinline__ void done(const Unit&) const {}
    __device__ __forceinline__ size_t a_off(const Unit&) const { return 0; }
    __device__ __forceinline__ size_t b_off(const Unit&) const { return 0; }
    __device__ __forceinline__ bool keep(const Unit&) const { return false; }
};
struct MoeOrderP {
    const PG8_LAS int* tstart; GAS unsigned* cnt; int G, v;
    __device__ __forceinline__ bool next(int i, Unit& u) const {
        const int idx = i * G + v, tot = tstart[32] * 2; if (idx >= tot) return false;
        const int ti = idx >> 1, ct = idx & 1; int e = 0;
#pragma unroll 1
        for (int k = 1; k < 32; ++k) e += (tstart[k] <= ti) ? 1 : 0;
        u.pm = ti; u.pn = e * 2 + ct; u.sel = 0; return true;
    }
    __device__ __forceinline__ void a_ready(const Unit&) const {}
    __device__ __forceinline__ void done(const Unit& u) const {
        asm volatile("s_waitcnt vmcnt(0)" ::: "memory");
        int ln; asm volatile("v_mbcnt_lo_u32_b32 %0, -1, 0\n\tv_mbcnt_hi_u32_b32 %0, -1, %0" : "=v"(ln));
        if (ln == 0) __hip_atomic_fetch_add(cnt + u.pm, 1u, __ATOMIC_RELAXED, __HIP_MEMORY_SCOPE_AGENT);
    }
    __device__ __forceinline__ size_t a_off(const Unit&) const { return 0; }
    __device__ __forceinline__ size_t b_off(const Unit&) const { return 0; }
    __device__ __forceinline__ bool keep(const Unit&) const { return false; }
};
struct MoeOrderC {
    const PG8_LAS int* tstart; const GAS unsigned* cnt; int G, v, wid;
    __device__ __forceinline__ bool next(int i, Unit& u) const {
        const int T = tstart[32], L = (2 * T > G) ? 2 * T - G : 0, R = G - L;
        const int idx = (v >= L) ? ((i < 2) ? i * R + (v - L) : 2 * R + (i - 2) * G + v) : 2 * R + i * G + v;
        if (idx >= 4 * T) return false;
        const int ti = idx >> 2, ct = idx & 3; int e = 0;
#pragma unroll 1
        for (int k = 1; k < 32; ++k) e += (tstart[k] <= ti) ? 1 : 0;
        u.pm = ti; u.pn = e * 4 + ct; u.sel = 0; return true;
    }
    __device__ __forceinline__ void a_ready(const Unit& u) const {
        if (wid == 0) {
            const GAS unsigned* c = cnt + u.pm; int spins = 0;
#pragma unroll 1
            while ((unsigned)__builtin_amdgcn_readfirstlane(__hip_atomic_load(c, __ATOMIC_RELAXED, __HIP_MEMORY_SCOPE_AGENT)) < 16u && ++spins < (1 << 22)) __builtin_amdgcn_s_sleep(2);
            __builtin_amdgcn_fence(__ATOMIC_ACQUIRE, "agent");
            asm volatile("s_waitcnt vmcnt(0)" ::: "memory");
        }
        __builtin_amdgcn_s_barrier();
    }
    __device__ __forceinline__ void done(const Unit&) const {}
    __device__ __forceinline__ size_t a_off(const Unit&) const { return 0; }
    __device__ __forceinline__ size_t b_off(const Unit&) const { return 0; }
    __device__ __forceinline__ bool keep(const Unit&) const { return false; }
};
}
namespace att {
typedef unsigned short bf16;
typedef short bf16x8 __attribute__((ext_vector_type(8)));
typedef short s16x4 __attribute__((ext_vector_type(4)));
typedef float f32x16 __attribute__((ext_vector_type(16)));
typedef float f32x4 __attribute__((ext_vector_type(4)));
typedef unsigned u32x4 __attribute__((ext_vector_type(4)));
typedef unsigned u32x2 __attribute__((ext_vector_type(2)));
typedef float f32x2v __attribute__((ext_vector_type(2)));
typedef __bf16 bf16x2v __attribute__((ext_vector_type(2)));
__device__ __forceinline__ unsigned pk2(float lo, float hi) { f32x2v v = {lo, hi}; bf16x2v b = __builtin_convertvector(v, bf16x2v); return __builtin_bit_cast(unsigned, b); }
__device__ __forceinline__ float bflo(unsigned w) { return __builtin_bit_cast(float, w << 16); }
__device__ __forceinline__ float bfhi(unsigned w) { return __builtin_bit_cast(float, w & 0xffff0000u); }
__device__ __forceinline__ int crow(int r, int hi) { return (r & 3) + 8 * (r >> 2) + 4 * hi; }
__device__ __forceinline__ float xhalf(float v) {
    const unsigned u = __builtin_bit_cast(unsigned, v);
    auto rr = __builtin_amdgcn_permlane32_swap(u, u, false, false);
    const unsigned o = (rr[0] != u) ? rr[0] : rr[1];
    return __builtin_bit_cast(float, o);
}
__device__ __forceinline__ bf16x8 mk8(unsigned a, unsigned b, unsigned c, unsigned d) { u32x4 w = {a, b, c, d}; return __builtin_bit_cast(bf16x8, w); }

constexpr int VPB = 144;
template <int DK> struct KLay { static constexpr int KPB = (DK + 8) * 2, KBUF = 64 * KPB; };

template <int DK, int DV, bool KROPE> struct Stage {
    static constexpr int NK = KROPE ? 1 : DK / 64, NV = DV / 64;
    u32x4 kr[NK]; u32x4 kr2; u32x4 vr[NV];
    __device__ __forceinline__ void loadK(int tid, const GAS bf16* Kg, int ldk, const GAS bf16* K2g, int kv0) {
        const GAS char* kbase = (const GAS char*)(Kg + (size_t)kv0 * ldk);
        if constexpr (KROPE) {
            kr[0] = *(const GAS u32x4*)(kbase + (unsigned)(((tid >> 3) * ldk + 8 * (tid & 7)) * 2));
            if (tid < 256) kr2 = *(const GAS u32x4*)((const GAS char*)(K2g + (size_t)kv0 * 32) + (unsigned)(tid * 16));
        } else {
#pragma unroll
            for (int i = 0; i < NK; ++i) { const int p = tid + 512 * i, row = p / (DK / 8), ch = p % (DK / 8); kr[i] = *(const GAS u32x4*)(kbase + (unsigned)((row * ldk + 8 * ch) * 2)); }
        }
    }
    __device__ __forceinline__ void loadV(int tid, const GAS bf16* Vg, int ldv, int kv0) {
        const GAS char* vbase = (const GAS char*)(Vg + kv0);
#pragma unroll
        for (int i = 0; i < NV; ++i) { const int p = tid + 512 * i, dd = p >> 3, ch = p & 7; vr[i] = *(const GAS u32x4*)(vbase + (unsigned)((dd * ldv + 8 * ch) * 2)); }
    }
    __device__ __forceinline__ void storeK(int tid, LAS unsigned char* kb) const {
        constexpr int KPB = KLay<DK>::KPB;
        if constexpr (KROPE) {
            *(LAS u32x4*)(kb + (tid >> 3) * KPB + 16 * (tid & 7)) = kr[0];
            if (tid < 256) *(LAS u32x4*)(kb + (tid >> 2) * KPB + 128 + 16 * (tid & 3)) = kr2;
        } else {
#pragma unroll
            for (int i = 0; i < NK; ++i) { const int p = tid + 512 * i, row = p / (DK / 8), ch = p % (DK / 8); *(LAS u32x4*)(kb + row * KPB + 16 * ch) = kr[i]; }
        }
    }
    __device__ __forceinline__ void storeV(int tid, LAS unsigned char* vb) const {
#pragma unroll
        for (int i = 0; i < NV; ++i) { const int p = tid + 512 * i, dd = p >> 3, ch = p & 7; LAS unsigned char* q = vb + dd * VPB + 32 * (ch >> 1) + 8 * (ch & 1);
            *(LAS u32x2*)q = (u32x2){vr[i].x, vr[i].y}; *(LAS u32x2*)(q + 16) = (u32x2){vr[i].z, vr[i].w}; }
    }
    __device__ __forceinline__ void load(int tid, const GAS bf16* Kg, int ldk, const GAS bf16* K2g, const GAS bf16* Vg, int ldv, int kv0) { loadK(tid, Kg, ldk, K2g, kv0); loadV(tid, Vg, ldv, kv0); }
    __device__ __forceinline__ void store(int tid, LAS unsigned char* kb, LAS unsigned char* vb) const { storeK(tid, kb); storeV(tid, vb); }
};

template <int DK> __device__ __forceinline__ void qkt(f32x16& p0, f32x16& p1, const LAS unsigned char* kb, const bf16x8 (&qf)[DK / 16], int r32, int hi) {
    constexpr int KPB = KLay<DK>::KPB;
    const LAS unsigned char* k0 = kb + r32 * KPB + hi * 16;
#pragma unroll
    for (int d0 = 0; d0 < DK / 16; ++d0) {
        const bf16x8 a0 = *(const LAS bf16x8*)(k0 + d0 * 32), a1 = *(const LAS bf16x8*)(k0 + 32 * KPB + d0 * 32);
        p0 = __builtin_amdgcn_mfma_f32_32x32x16_bf16(a0, qf[d0], p0, 0, 0, 0);
        p1 = __builtin_amdgcn_mfma_f32_32x32x16_bf16(a1, qf[d0], p1, 0, 0, 0);
    }
}
template <int DK> __device__ __forceinline__ void qkt_qmem(f32x16& p0, f32x16& p1, const LAS unsigned char* kb, const bf16x8* qf, const LAS unsigned char* qlds, int r32, int hi) {
    constexpr int KPB = KLay<DK>::KPB, QR = DK / 32;
    const LAS unsigned char* k0 = kb + r32 * KPB + hi * 16;
#pragma unroll
    for (int d0 = 0; d0 < DK / 16; ++d0) {
        bf16x8 q; if (d0 < QR) q = qf[d0]; else q = *(const LAS bf16x8*)(qlds + (d0 - QR) * 1024);
        const bf16x8 a0 = *(const LAS bf16x8*)(k0 + d0 * 32), a1 = *(const LAS bf16x8*)(k0 + 32 * KPB + d0 * 32);
        p0 = __builtin_amdgcn_mfma_f32_32x32x16_bf16(a0, q, p0, 0, 0, 0);
        p1 = __builtin_amdgcn_mfma_f32_32x32x16_bf16(a1, q, p1, 0, 0, 0);
        if ((d0 & 3) == 3) __builtin_amdgcn_sched_barrier(0);
    }
}
template <int DV> __device__ __forceinline__ void pv(f32x16 (&o)[DV / 32], const LAS unsigned char* vb, const bf16x8 (&pf)[4], int r32, int hi) {
#pragma unroll
    for (int db = 0; db < DV / 32; ++db) {
        const LAS unsigned char* v0 = vb + (32 * db + r32) * VPB + 16 * hi;
#pragma unroll
        for (int s = 0; s < 4; ++s) {
            const bf16x8 vf = *(const LAS bf16x8*)(v0 + 32 * s);
            o[db] = __builtin_amdgcn_mfma_f32_32x32x16_bf16(vf, pf[s], o[db], 0, 0, 0);
        }
        if (DV > 64) __builtin_amdgcn_sched_barrier(0);
    }
}
__device__ __forceinline__ void pack_p(bf16x8 (&pf)[4], const f32x16& p0, const f32x16& p1) {
    pf[0] = mk8(pk2(p0[0], p0[1]), pk2(p0[2], p0[3]), pk2(p0[4], p0[5]), pk2(p0[6], p0[7]));
    pf[1] = mk8(pk2(p0[8], p0[9]), pk2(p0[10], p0[11]), pk2(p0[12], p0[13]), pk2(p0[14], p0[15]));
    pf[2] = mk8(pk2(p1[0], p1[1]), pk2(p1[2], p1[3]), pk2(p1[4], p1[5]), pk2(p1[6], p1[7]));
    pf[3] = mk8(pk2(p1[8], p1[9]), pk2(p1[10], p1[11]), pk2(p1[12], p1[13]), pk2(p1[14], p1[15]));
}

template <bool ALIBI> __device__ __forceinline__ void fl_init(f32x16& p0, f32x16& p1, float slope2, int kv0, int hi, int qrow) {
    if (ALIBI) {
        const float s2 = slope2 + slope2, s4 = s2 + s2, s8 = s4 + s4, s32 = (s8 + s8) + (s8 + s8);
        float g = slope2 * (float)(kv0 + 4 * hi - qrow);
#pragma unroll
        for (int c = 0; c < 4; ++c) { float v = g;
#pragma unroll
            for (int e = 0; e < 4; ++e) { p0[4 * c + e] = v; p1[4 * c + e] = v + s32; v += slope2; }
            g += s8; } }
    else {
#pragma unroll
        for (int r = 0; r < 16; ++r) { p0[r] = 0.f; p1[r] = 0.f; } }
}
__device__ __forceinline__ void fl_mask(f32x16& p0, f32x16& p1, int kv0, int hi, int qrow) {
    const int thr = qrow - kv0 - 4 * hi;
#pragma unroll
    for (int r = 0; r < 16; ++r) { const int c = (r & 3) + 8 * (r >> 2); if (c > thr) p0[r] = -INFINITY; if (c + 32 > thr) p1[r] = -INFINITY; }
}
__device__ __forceinline__ void fl_start(const f32x16& p0, const f32x16& p1, float& m, float& alpha) {
    float mx = fmaxf(p0[0], p1[0]);
#pragma unroll
    for (int r = 1; r < 16; ++r) mx = fmaxf(fmaxf(mx, p0[r]), p1[r]);
    mx = fmaxf(mx, xhalf(mx));
    const float mn = fmaxf(m, mx); alpha = __builtin_amdgcn_exp2f(m - mn); m = mn;
}
__device__ __forceinline__ void fl_finish(f32x16& p0, f32x16& p1, float m, float& l, bf16x8 (&pf)[4]) {
    float s0 = 0.f, s1 = 0.f;
#pragma unroll
    for (int r = 0; r < 16; ++r) { p0[r] = __builtin_amdgcn_exp2f(p0[r] - m); p1[r] = __builtin_amdgcn_exp2f(p1[r] - m); s0 += p0[r]; s1 += p1[r]; }
    l += s0 + s1;
    pack_p(pf, p0, p1);
}

#define FL_EL(P0, P1, e) ((e) < 16 ? P0[(e) & 15] : P1[(e) & 15])
template <int DK, bool QMEM> __device__ __forceinline__ void fl_blockX(f32x16& n0, f32x16& n1, const LAS unsigned char* kb, const bf16x8* qf, const LAS unsigned char* qlds, int r32, int hi,
                                                                         f32x16& c0, f32x16& c1, float m, float& l, bf16x8 (&pf)[4]) {
    constexpr int KPB = KLay<DK>::KPB, NS = DK / 16, CH = ((32 + NS - 1) / NS + 1) & ~1;
    const LAS unsigned char* k0 = kb + r32 * KPB + hi * 16;
    float s0 = 0.f, s1 = 0.f; unsigned pw[16];
#define FLX_K0(s) (*(const LAS bf16x8*)(k0 + ((s) < NS ? (s) : NS - 1) * 32))
#define FLX_K1(s) (*(const LAS bf16x8*)(k0 + 32 * KPB + ((s) < NS ? (s) : NS - 1) * 32))
    bf16x8 a0 = FLX_K0(0), a1 = FLX_K1(0), b0 = FLX_K0(1), b1 = FLX_K1(1), e0 = FLX_K0(2), e1 = FLX_K1(2);
    bf16x8 q, qb, qe; if constexpr (QMEM) { q = *(const LAS bf16x8*)(qlds); qb = *(const LAS bf16x8*)(qlds + (NS > 1 ? 1024 : 0)); qe = *(const LAS bf16x8*)(qlds + (NS > 2 ? 2048 : 0)); } else { q = qf[0]; qb = qf[NS > 1 ? 1 : 0]; qe = qf[NS > 2 ? 2 : 0]; }
#pragma unroll
    for (int d0 = 0; d0 < NS; ++d0) {
        bf16x8 c0n = e0, c1n = e1, qc = qe;
        if (d0 + 3 < NS) { c0n = FLX_K0(d0 + 3); c1n = FLX_K1(d0 + 3);
            if constexpr (QMEM) qc = *(const LAS bf16x8*)(qlds + (d0 + 3) * 1024); else qc = qf[d0 + 3]; }
        n0 = __builtin_amdgcn_mfma_f32_32x32x16_bf16(a0, q, n0, 0, 0, 0);
        n1 = __builtin_amdgcn_mfma_f32_32x32x16_bf16(a1, q, n1, 0, 0, 0);
#pragma unroll
        for (int e = d0 * CH; e < (d0 + 1) * CH && e < 32; e += 2) {
            float x, y;
            if (e < 16) { x = __builtin_amdgcn_exp2f(c0[e] - m); y = __builtin_amdgcn_exp2f(c0[e + 1] - m); s0 += x; s1 += y; }
            else { x = __builtin_amdgcn_exp2f(c1[e - 16] - m); y = __builtin_amdgcn_exp2f(c1[e - 15] - m); s0 += x; s1 += y; }
            pw[e >> 1] = pk2(x, y); asm volatile("" : "+v"(pw[e >> 1])); }
        asm volatile("" : "+v"(s0), "+v"(s1));
        __builtin_amdgcn_sched_barrier(0);
        a0 = b0; a1 = b1; q = qb; b0 = e0; b1 = e1; qb = qe; e0 = c0n; e1 = c1n; qe = qc;
    }
#undef FLX_K0
#undef FLX_K1
    l += s0 + s1;
    pf[0] = mk8(pw[0], pw[1], pw[2], pw[3]); pf[1] = mk8(pw[4], pw[5], pw[6], pw[7]); pf[2] = mk8(pw[8], pw[9], pw[10], pw[11]); pf[3] = mk8(pw[12], pw[13], pw[14], pw[15]);
}
template <int DV> __device__ __forceinline__ void fl_blockY(f32x16 (&o)[DV / 32], const LAS unsigned char* vb, const bf16x8 (&pf)[4], int r32, int hi, const f32x16& n0, const f32x16& n1, float& m, float& alpha) {
    constexpr int NS = DV / 8, CH = 32 / NS;
    float mx0 = -INFINITY, mx1 = -INFINITY;
    const LAS unsigned char* v0 = vb + r32 * VPB + 16 * hi;
    bf16x8 vf = *(const LAS bf16x8*)(v0), vg = *(const LAS bf16x8*)(v0 + 32);
#pragma unroll
    for (int st = 0; st < NS; ++st) {
        const int db = st >> 2, s = st & 3;
        bf16x8 vn = vg;
        if (st + 2 < NS) vn = *(const LAS bf16x8*)(v0 + ((st + 2) >> 2) * 32 * VPB + 32 * ((st + 2) & 3));
        o[db] = __builtin_amdgcn_mfma_f32_32x32x16_bf16(vf, pf[s], o[db], 0, 0, 0);
#pragma unroll
        for (int e = st * CH; e < (st + 1) * CH; ++e) { if (e < 16) mx0 = fmaxf(mx0, n0[e]); else mx1 = fmaxf(mx1, n1[e - 16]); }
        asm volatile("" : "+v"(mx0), "+v"(mx1));
        __builtin_amdgcn_sched_barrier(0);
        vf = vg; vg = vn;
    }
    float mx = fmaxf(mx0, mx1); mx = fmaxf(mx, xhalf(mx));
    const float mn = fmaxf(m, mx); alpha = __builtin_amdgcn_exp2f(m - mn); m = mn;
}

template <int DK, int DV, bool CAUSAL, bool ALIBI, bool KROPE, bool QMEM = false, bool DESC = false>
__device__ __forceinline__ void flash_pass(LAS unsigned char* lds, int tid, const GAS bf16* Qrow, const GAS bf16* Qrow2, const GAS bf16* Kg, int ldk, const GAS bf16* K2g, const GAS bf16* Vg, int ldv,
                                           int NT, int ntw, int qrow, float slope2, f32x16 (&o)[DV / 32], float& lsum, const GAS unsigned* kn = nullptr, int abl = 0) {
    constexpr int KBUF = KLay<DK>::KBUF, VBUF = DV * VPB, QOFF = 2 * KBUF + 2 * VBUF, XOFF = QOFF + 8 * (DK / 16) * 1024;
    constexpr bool CUT = DESC && ALIBI;
    const int lane = tid & 63, r32 = lane & 31, hi = lane >> 5, wid = tid >> 6;
#define FL_TI(i) (DESC ? NT - 1 - (i) : (i))
    bf16x8 qf[QMEM ? 1 : DK / 16];
    LAS unsigned char* qlds = lds + QOFF + wid * (DK / 16) * 1024 + lane * 16;
    float qn2 = 0.f;
#pragma unroll
    for (int d0 = 0; d0 < DK / 16; ++d0) {
        bf16x8 v;
        if (KROPE && d0 >= 4) v = *(const GAS bf16x8*)(Qrow2 + 16 * (d0 - 4) + 8 * hi);
        else v = *(const GAS bf16x8*)(Qrow + 16 * d0 + 8 * hi);
        if constexpr (CUT) {
#pragma unroll
            for (int j = 0; j < 8; ++j) { const float f = __builtin_bit_cast(float, (unsigned)(unsigned short)v[j] << 16); qn2 += f * f; } }
        if constexpr (QMEM) *(LAS bf16x8*)(qlds + d0 * 1024) = v; else qf[d0] = v;
    }
    volatile LAS float* kpre = (volatile LAS float*)(lds + XOFF);
    volatile LAS unsigned* dflag = (volatile LAS unsigned*)(lds + XOFF + 512);
    float qn = 0.f;
    if constexpr (CUT) {
        qn2 += xhalf(qn2); qn = sqrtf(qn2);
        if (wid == 0) {
            float v0 = 0.f, v1 = 0.f;
            if (lane < NT) v0 = sqrtf(__builtin_bit_cast(float, kn[(size_t)lane * 16]) + __builtin_bit_cast(float, kn[(size_t)lane * 16 + 1])) * 1.01f;
            if (lane + 64 < NT) v1 = sqrtf(__builtin_bit_cast(float, kn[(size_t)(lane + 64) * 16]) + __builtin_bit_cast(float, kn[(size_t)(lane + 64) * 16 + 1])) * 1.01f;
#pragma unroll
            for (int dd = 1; dd < 64; dd <<= 1) { const float u0 = __shfl_up(v0, dd), u1 = __shfl_up(v1, dd); if (lane >= dd) { v0 = fmaxf(v0, u0); v1 = fmaxf(v1, u1); } }
            v1 = fmaxf(v1, __shfl(v0, 63));
            kpre[lane] = v0; kpre[lane + 64] = v1;
        }
    }
#pragma unroll
    for (int db = 0; db < DV / 32; ++db)
#pragma unroll
        for (int r = 0; r < 16; ++r) o[db][r] = 0.f;
    float m = -INFINITY, l = 0.f, alpha = 1.0f;
    int cut = NT;
    Stage<DK, DV, KROPE> st;
    st.loadK(tid, Kg, ldk, K2g, 64 * FL_TI(0)); st.loadV(tid, Vg, ldv, 64 * FL_TI(0));
    st.storeK(tid, lds); st.storeV(tid, lds + 2 * KBUF);
    if (NT > 1) { st.loadK(tid, Kg, ldk, K2g, 64 * FL_TI(1)); st.storeK(tid, lds + KBUF); }
    __syncthreads();
    if (NT > 2) st.loadK(tid, Kg, ldk, K2g, 64 * FL_TI(2));
    if (NT > 1) st.loadV(tid, Vg, ldv, 64 * FL_TI(1));
    f32x16 pa0, pa1, pb0, pb1;
#define FL_QKT(P0, P1, KB) do { if constexpr (QMEM) { bf16x8 qt_[DK / 16]; _Pragma("unroll") for (int d0 = 0; d0 < DK / 16; ++d0) qt_[d0] = *(const LAS bf16x8*)(qlds + d0 * 1024); qkt<DK>(P0, P1, KB, qt_, r32, hi); } else qkt<DK>(P0, P1, KB, qf, r32, hi); } while (0)
#define FL_FIRST(P0, P1, KB, TILE) do { const int kv_ = 64 * (TILE); fl_init<ALIBI>(P0, P1, slope2, kv_, hi, qrow); FL_QKT(P0, P1, KB); \
        if (CAUSAL && kv_ + 63 > qrow - r32) fl_mask(P0, P1, kv_, hi, qrow); fl_start(P0, P1, m, alpha); } while (0)
    if (FL_TI(0) < ntw) FL_FIRST(pa0, pa1, lds, FL_TI(0));
    __syncthreads();
    for (int i = 0; i < NT; ++i) {
        int tq_ = tid; asm volatile("" : "+v"(tq_));
        if (!(abl & 1)) {
            if (i + 2 < NT) st.storeK(tq_, lds + (i & 1) * KBUF);
            if (i + 1 < NT) st.storeV(tq_, lds + 2 * KBUF + ((i + 1) & 1) * VBUF);
            if (i + 3 < NT) st.loadK(tq_, Kg, ldk, K2g, 64 * FL_TI(i + 3));
            if (i + 2 < NT) st.loadV(tq_, Vg, ldv, 64 * FL_TI(i + 2)); }
        const int tc = FL_TI(i), tn = FL_TI(i + 1);
        const bool ac = tc < ntw && i < cut && !(abl & 2);
        bool an = i + 1 < NT && tn < ntw && i + 1 < cut && !(abl & 2);
        if constexpr (CUT) {
            if (ac && an) {
                const bool dead = qn * kpre[tn] + slope2 * (float)(64 * tn + 63 - qrow) < m - 64.f;
                if (__all(dead)) { cut = i + 1; an = false; } } }
        const LAS unsigned char* kn_ = lds + ((i + 1) & 1) * KBUF; const LAS unsigned char* vc_ = lds + 2 * KBUF + (i & 1) * VBUF;
        if (ac) {
            l *= alpha;
            if (__any(alpha != 1.0f)) {
#pragma unroll
                for (int db = 0; db < DV / 32; ++db) asm volatile("" : "+v"(o[db]));
#pragma unroll
                for (int db = 0; db < DV / 32; ++db)
#pragma unroll
                    for (int r = 0; r < 16; ++r) o[db][r] *= alpha;
#pragma unroll
                for (int db = 0; db < DV / 32; ++db) asm volatile("" : "+v"(o[db])); }
            bf16x8 pf[4];
            if (an) {
                const int kv1_ = 64 * tn;
                const bool diag_ = CAUSAL && (kv1_ + 63 > qrow - r32);
                fl_init<ALIBI>(pb0, pb1, slope2, kv1_, hi, qrow);
                fl_blockX<DK, QMEM>(pb0, pb1, kn_, qf, qlds, r32, hi, pa0, pa1, m, l, pf);
                if (!diag_) { fl_blockY<DV>(o, vc_, pf, r32, hi, pb0, pb1, m, alpha); }
                else { pv<DV>(o, vc_, pf, r32, hi); fl_mask(pb0, pb1, kv1_, hi, qrow); fl_start(pb0, pb1, m, alpha); }
            } else {
                fl_finish(pa0, pa1, m, l, pf); pv<DV>(o, vc_, pf, r32, hi);
            }
        } else if (an) { FL_FIRST(pb0, pb1, kn_, tn); }
        if constexpr (CUT) { if (lane == 0) dflag[(i & 1) * 8 + wid] = (i + 1 >= cut) ? 1u : 0u; }
        if (!(abl & 4)) __syncthreads();
        if constexpr (CUT) { unsigned alld = 1u;
#pragma unroll
            for (int w = 0; w < 8; ++w) alld &= dflag[(i & 1) * 8 + w];
            if (alld) break; }
        if (!(abl & 8)) { pa0 = pb0; pa1 = pb1; }
    }
#undef FL_FIRST
#undef FL_QKT
#undef FL_TI
    lsum = l + xhalf(l);
}

template <int DK, int DV, bool CAUSAL, bool ALIBI, bool KROPE, bool QMEM = false>
__device__ __forceinline__ void flash_pass_simple(LAS unsigned char* lds, int tid, const GAS bf16* Qrow, const GAS bf16* Qrow2, const GAS bf16* Kg, int ldk, const GAS bf16* K2g, const GAS bf16* Vg, int ldv,
                                           int NT, int ntw, int qrow, float slope2, f32x16 (&o)[DV / 32], float& lsum) {
    constexpr int KBUF = KLay<DK>::KBUF, VBUF = DV * VPB;
    const int lane = tid & 63, r32 = lane & 31, hi = lane >> 5;
    constexpr int QR = QMEM ? DK / 32 : DK / 16;
    bf16x8 qf[QR];
    LAS unsigned char* qlds = lds + 2 * KBUF + 2 * VBUF + (tid >> 6) * (DK / 16 - QR + 1) * 1024 + lane * 16;
#pragma unroll
    for (int d0 = 0; d0 < DK / 16; ++d0) {
        bf16x8 v;
        if (KROPE && d0 >= 4) v = *(const GAS bf16x8*)(Qrow2 + 16 * (d0 - 4) + 8 * hi);
        else v = *(const GAS bf16x8*)(Qrow + 16 * d0 + 8 * hi);
        if constexpr (!KROPE && QMEM) {
            const bf16x8 w2 = *(const GAS bf16x8*)(Qrow2 + 16 * d0 + 8 * hi); const u32x4 a4 = __builtin_bit_cast(u32x4, v), b4 = __builtin_bit_cast(u32x4, w2); u32x4 r4;
            r4.x = pk2(bflo(a4.x) + bflo(b4.x), bfhi(a4.x) + bfhi(b4.x)); r4.y = pk2(bflo(a4.y) + bflo(b4.y), bfhi(a4.y) + bfhi(b4.y));
            r4.z = pk2(bflo(a4.z) + bflo(b4.z), bfhi(a4.z) + bfhi(b4.z)); r4.w = pk2(bflo(a4.w) + bflo(b4.w), bfhi(a4.w) + bfhi(b4.w)); v = __builtin_bit_cast(bf16x8, r4); }
        if (d0 < QR) qf[d0] = v; else *(LAS bf16x8*)(qlds + (d0 - QR) * 1024) = v;
    }
#pragma unroll
    for (int db = 0; db < DV / 32; ++db)
#pragma unroll
        for (int r = 0; r < 16; ++r) o[db][r] = 0.f;
    float m = -INFINITY, l = 0.f;
    Stage<DK, DV, KROPE> st;
    st.load(tid, Kg, ldk, K2g, Vg, ldv, 0);
    st.store(tid, lds, lds + 2 * KBUF);
    __syncthreads();
    for (int t = 0; t < NT; ++t) {
        const int cur = t & 1, kv0 = 64 * t;
        if (t + 1 < NT) st.load(tid, Kg, ldk, K2g, Vg, ldv, kv0 + 64);
        if (t < ntw) {
            const LAS unsigned char* kb = lds + cur * KBUF; const LAS unsigned char* vb = lds + 2 * KBUF + cur * VBUF;
            f32x16 p0, p1;
            if (ALIBI) { const float base = slope2 * (float)(kv0 + 4 * hi - qrow);
#pragma unroll
                for (int r = 0; r < 16; ++r) { p0[r] = __builtin_fmaf(slope2, (float)((r & 3) + 8 * (r >> 2)), base); p1[r] = __builtin_fmaf(slope2, (float)(32 + (r & 3) + 8 * (r >> 2)), base); } }
            else {
#pragma unroll
                for (int r = 0; r < 16; ++r) { p0[r] = 0.f; p1[r] = 0.f; } }
            if constexpr (QMEM) qkt_qmem<DK>(p0, p1, kb, qf, qlds, r32, hi); else qkt<DK>(p0, p1, kb, qf, r32, hi);
            if (CAUSAL && kv0 + 63 > qrow - r32) {
#pragma unroll
                for (int r = 0; r < 16; ++r) { const int kv = kv0 + crow(r, hi); if (kv > qrow) p0[r] = -INFINITY; if (kv + 32 > qrow) p1[r] = -INFINITY; } }
            float mx = p0[0];
#pragma unroll
            for (int r = 1; r < 16; ++r) mx = fmaxf(mx, p0[r]);
#pragma unroll
            for (int r = 0; r < 16; ++r) mx = fmaxf(mx, p1[r]);
            mx = fmaxf(mx, xhalf(mx));
            const float mn = fmaxf(m, mx), alpha = __builtin_amdgcn_exp2f(m - mn); m = mn;
            l *= alpha;
            if (__any(alpha != 1.0f)) {
#pragma unroll
                for (int db = 0; db < DV / 32; ++db)
#pragma unroll
                    for (int r = 0; r < 16; ++r) o[db][r] *= alpha; }
            float s = 0.f;
#pragma unroll
            for (int r = 0; r < 16; ++r) { p0[r] = __builtin_amdgcn_exp2f(p0[r] - mn); p1[r] = __builtin_amdgcn_exp2f(p1[r] - mn); s += p0[r] + p1[r]; }
            l += s;
            bf16x8 pf[4]; pack_p(pf, p0, p1);
            pv<DV>(o, vb, pf, r32, hi);
        }
        if (t + 1 < NT) st.store(tid, lds + (cur ^ 1) * KBUF, lds + 2 * KBUF + (cur ^ 1) * VBUF);
        __syncthreads();
    }
    lsum = l + xhalf(l);
}


template <int DV> __device__ __forceinline__ void store_o(GAS bf16* Orow, const f32x16 (&o)[DV / 32], float sc, int hi) {
#pragma unroll
    for (int db = 0; db < DV / 32; ++db)
#pragma unroll
        for (int c = 0; c < 4; ++c) { u32x2 w; w.x = pk2(o[db][4 * c] * sc, o[db][4 * c + 1] * sc); w.y = pk2(o[db][4 * c + 2] * sc, o[db][4 * c + 3] * sc);
            *(GAS u32x2*)(Orow + 32 * db + 8 * c + 4 * hi) = w; }
}

__device__ __forceinline__ void mla_unit(LAS unsigned char* lds, int tid, int b, int h, int q0, const GAS bf16* qmla, const GAS bf16* knope, const GAS bf16* krope, const GAS bf16* vT, GAS bf16* out, int abl) {
    const int lane = tid & 63, wid = tid >> 6, r32 = lane & 31, hi = lane >> 5;
    const size_t tb = (size_t)b * 8192; const int qrow = q0 + 32 * wid + r32;
    const GAS bf16* Qr = qmla + (tb + qrow) * 768;
    f32x16 o[2]; float l;
    flash_pass<96, 64, true, false, true>(lds, tid, Qr + h * 64, Qr + 512 + h * 32, knope + tb * 512 + h * 64, 512, krope + tb * 32, vT + (size_t)(h * 64) * 16384 + tb, 16384,
                                          q0 / 64 + 4, (q0 + 32 * wid + 31) / 64 + 1, qrow, 0.f, o, l, nullptr, abl);
    if (abl == 0 || l == 12345.678f) store_o<64>(out + (tb + qrow) * 1024 + h * 64, o, 1.0f / l, hi);
}
__device__ __forceinline__ void cross_unit(LAS unsigned char* lds, int tid, int b, int h, int q0, const GAS bf16* qx, const GAS bf16* xk, const GAS bf16* xvT, GAS bf16* out) {
    const int lane = tid & 63, wid = tid >> 6, r32 = lane & 31, hi = lane >> 5;
    const size_t tb = (size_t)b * 8192; const int qrow = q0 + 32 * wid + r32;
    f32x16 o[4]; float l;
    int nt = 4; asm volatile("" : "+s"(nt));
    flash_pass_simple<128, 128, false, false, false, true>(lds, tid, qx + (tb + qrow) * 512 + h * 128, qx + (size_t)16384 * 512 + (tb + qrow) * 512 + h * 128, xk + (size_t)(b * 256) * 512 + h * 128, 512, nullptr, xvT + (size_t)(h * 128) * 512 + b * 256, 512,
                                              nt, nt, qrow, 0.f, o, l);
    store_o<128>(out + (tb + qrow) * 512 + h * 128, o, 1.0f / l, hi);
}
__device__ __forceinline__ void diff_unit(LAS unsigned char* lds, int tid, int b, int h, int hf, int q0, const GAS bf16* dq, const GAS bf16* dk, const GAS bf16* vT, GAS bf16* out, int ldo, const GAS unsigned* knl, int abl) {
    const int lane = tid & 63, wid = tid >> 6, r32 = lane & 31, hi = lane >> 5;
    const size_t tb = (size_t)b * 8192; const int qrow = q0 + 32 * wid + r32;
    const float slope2 = __builtin_amdgcn_exp2f(-2.0f * (float)(h + 1)) * 1.4426950408889634f;
    const int NT = q0 / 64 + 4, ntw = (q0 + 32 * wid + 31) / 64 + 1;
    f32x16 o[4]; float l;
    flash_pass<64, 128, true, true, false, true, true>(lds, tid, dq + (tb + qrow) * 512 + h * 128 + hf * 64, nullptr, dk + tb * 512 + h * 128 + hf * 64, 512, nullptr, vT + (size_t)(512 + h * 128) * 16384 + tb, 16384,
                                                      NT, ntw, qrow, slope2, o, l, knl + ((size_t)(b * 128) * 8 + 2 * h + hf) * 2, abl);
    if (abl == 0 || l == 12345.678f) store_o<128>(out + (tb + qrow) * (size_t)ldo + h * 128, o, 1.0f / l, hi);
}
__device__ __forceinline__ void diff_lambda(const GAS float* lp, int layer, float& lam, float& post) {
    float q1 = 0.f, q2 = 0.f;
    for (int i = 0; i < 64; ++i) { q1 += lp[i] * lp[64 + i]; q2 += lp[128 + i] * lp[192 + i]; }
    const float lam_init = (layer == 0) ? 0.2f : 0.35550906759f;
    lam = expf(q1) - expf(q2) + lam_init; post = 1.f - lam_init;
}
__device__ __forceinline__ void diff_combine4(int item0, int stride, int lane, GAS bf16* o0, const GAS bf16* o1, float lam, float post, const GAS float* subln) {
    unsigned a[4], c[4]; size_t off[4];
#pragma unroll
    for (int k = 0; k < 4; ++k) { const int item = item0 + k * stride; off[k] = (size_t)(item >> 2) * 1024 + (item & 3) * 128 + 2 * lane;
        a[k] = *(const GAS unsigned*)(o0 + off[k]); c[k] = *(const GAS unsigned*)(o1 + (size_t)item * 128 + 2 * lane); }
    const f32x2v g = *(const GAS f32x2v*)(subln + 2 * lane);
#pragma unroll
    for (int k = 0; k < 4; ++k) {
        const float x = bflo(a[k]) - lam * bflo(c[k]), y = bfhi(a[k]) - lam * bfhi(c[k]);
        float s2 = x * x + y * y;
#pragma unroll
        for (int dd = 1; dd < 64; dd <<= 1) s2 += __shfl_xor(s2, dd);
        const float rs = __builtin_amdgcn_rsqf(s2 * (1.f / 128.f) + 1e-6f) * post;
        *(GAS unsigned*)(o0 + off[k]) = pk2(x * rs * g[0], y * rs * g[1]); }
}
__device__ __forceinline__ void sb_unit(LAS unsigned char* lds, int tid, int b, int h, int q0, const GAS bf16* sq, const GAS bf16* sk, const GAS bf16* vT, GAS bf16* out) {
    constexpr int KBUF = KLay<64>::KBUF, VBUF = 64 * VPB;
    const int lane = tid & 63, wid = tid >> 6, r32 = lane & 31, hi = lane >> 5;
    const size_t tb = (size_t)b * 8192; const int qrow = q0 + 32 * wid + r32;
    const GAS bf16* Kg = sk + tb * 512 + h * 64; const GAS bf16* Vg = vT + (size_t)(h * 64) * 16384 + tb;
    const int NT = q0 / 64 + 4, ntw = (q0 + 32 * wid + 30) / 64 + 1;
    bf16x8 qf[4];
#pragma unroll
    for (int d0 = 0; d0 < 4; ++d0) qf[d0] = *(const GAS bf16x8*)(sq + (tb + qrow) * 512 + h * 64 + 16 * d0 + 8 * hi);
    f32x16 o[2];
#pragma unroll
    for (int r = 0; r < 16; ++r) { o[0][r] = 0.f; o[1][r] = 0.f; }
    float R = 1.0f;
    volatile LAS unsigned* dflag = (volatile LAS unsigned*)(lds + 4 * KBUF + 1024);
    Stage<64, 64, false> st;
    st.load(tid, Kg, 512, nullptr, Vg, 16384, 64 * (NT - 1));
    st.store(tid, lds, lds + 2 * KBUF);
    __syncthreads();
    for (int i = 0; i < NT; ++i) {
        const int t = NT - 1 - i, cur = i & 1, kv0 = 64 * t;
        if (t > 0) st.load(tid, Kg, 512, nullptr, Vg, 16384, kv0 - 64);
        if (t < ntw && __any(R != 0.f)) {
            const LAS unsigned char* kb = lds + cur * KBUF; const LAS unsigned char* vb = lds + 2 * KBUF + cur * VBUF;
            f32x16 k0, k1;
#pragma unroll
            for (int r = 0; r < 16; ++r) { k0[r] = 0.f; k1[r] = 0.f; }
            qkt<64>(k0, k1, kb, qf, r32, hi);
            f32x16 b0, b1;
#pragma unroll
            for (int r = 0; r < 16; ++r) {
                const float e0 = __builtin_amdgcn_exp2f(fminf(k0[r], 115.f)), e1 = __builtin_amdgcn_exp2f(fminf(k1[r], 115.f));
                const float r0 = __builtin_amdgcn_rcpf(1.f + e0), r1 = __builtin_amdgcn_rcpf(1.f + e1);
                k0[r] = r0; b0[r] = e0 * r0; k1[r] = r1; b1[r] = e1 * r1; }
            if (kv0 + 63 >= qrow - r32) {
                const int thr = qrow - kv0 - 4 * hi;
#pragma unroll
                for (int r = 0; r < 16; ++r) { const int c = (r & 3) + 8 * (r >> 2); if (c >= thr) { k0[r] = 1.f; b0[r] = 0.f; } if (c + 32 >= thr) { k1[r] = 1.f; b1[r] = 0.f; } } }
            float gp[8], go[8];
#pragma unroll
            for (int c = 0; c < 4; ++c) { gp[c] = (k0[4 * c] * k0[4 * c + 1]) * (k0[4 * c + 2] * k0[4 * c + 3]); gp[4 + c] = (k1[4 * c] * k1[4 * c + 1]) * (k1[4 * c + 2] * k1[4 * c + 3]); }
#pragma unroll
            for (int g = 0; g < 8; ++g) go[g] = xhalf(gp[g]);
            float sp = R;
#pragma unroll
            for (int g = 7; g >= 0; --g) {
                float s = sp * (hi ? 1.0f : go[g]);
                if (g >= 4) { const int c = g - 4;
                    b1[4 * c + 3] *= s; s *= k1[4 * c + 3]; b1[4 * c + 2] *= s; s *= k1[4 * c + 2]; b1[4 * c + 1] *= s; s *= k1[4 * c + 1]; b1[4 * c] *= s; }
                else { const int c = g;
                    b0[4 * c + 3] *= s; s *= k0[4 * c + 3]; b0[4 * c + 2] *= s; s *= k0[4 * c + 2]; b0[4 * c + 1] *= s; s *= k0[4 * c + 1]; b0[4 * c] *= s; }
                sp *= gp[g] * go[g];
            }
            R = sp;
            bf16x8 pf[4]; pack_p(pf, b0, b1);
            pv<64>(o, vb, pf, r32, hi);
        }
        if (t > 0) st.store(tid, lds + (cur ^ 1) * KBUF, lds + 2 * KBUF + (cur ^ 1) * VBUF);
        if (lane == 0) dflag[(i & 1) * 8 + wid] = (t < ntw && !__any(R != 0.f)) ? 1u : 0u;
        __syncthreads();
        { unsigned alld = 1u;
#pragma unroll
          for (int w = 0; w < 8; ++w) alld &= dflag[(i & 1) * 8 + w];
          if (alld) break; }
    }
    store_o<64>(out + (tb + qrow) * 1024 + h * 64, o, 1.0f, hi);
}
}
typedef unsigned short bf16;
typedef float f32x4 __attribute__((ext_vector_type(4)));
typedef unsigned u32x4 __attribute__((ext_vector_type(4)));
typedef unsigned u32x2 __attribute__((ext_vector_type(2)));
constexpr int NWAVES = 8, NTHREADS = 512;
constexpr int M = 16384, D = 1024, SEQ = 8192, DEPTH = 2, IN_COLS = 6688;
constexpr int SROWS = 40960;
constexpr size_t MiB = 1u << 20;
constexpr size_t WS_CTL = 0, CTL_ZERO_BYTES = 128 * 1024;
constexpr size_t WS_SSQ = 1 * MiB;
constexpr size_t WS_SSQCQ = 2 * MiB, WS_SSQCKV = WS_SSQCQ + 256 * 1024, WS_SSQMEM = WS_SSQCKV + 256 * 1024;
constexpr size_t WS_TOKE = 3 * MiB, WS_TOKW = WS_TOKE + 128 * 1024, WS_HIST = WS_TOKW + 128 * 1024, WS_SLOT = WS_HIST + 64 * 1024;
constexpr size_t WS_STOK = 4 * MiB, WS_SW = WS_STOK + 256 * 1024, WS_SRSTD = WS_SW + 256 * 1024;
constexpr size_t WS_WR = 5 * MiB;
constexpr size_t WS_WRH = 5 * MiB + 256 * 1024, WS_WRL = WS_WRH + 128 * 1024;
constexpr size_t WS_MEMN = 6 * MiB, WS_XK = 7 * MiB, WS_XVT = WS_XK + 512 * 1024;
constexpr size_t WS_WIN = 8 * MiB;
constexpr size_t WS_WV = WS_WIN + (size_t)2816 * 1024 * 2;
constexpr size_t WS_WG = WS_WV + 2 * MiB;
constexpr size_t WS_WUQ = WS_WG + 6 * MiB;
constexpr size_t WS_WUKN = WS_WUQ + 768 * 256 * 2;
constexpr size_t WS_WUV = WS_WUKN + 512 * 256 * 2;
constexpr size_t WS_WB = WS_WUV + 512 * 256 * 2;
constexpr size_t WS_WOUT = WS_WB + 4 * MiB;
constexpr size_t WS_WXQ = WS_WOUT + 2 * MiB;
constexpr size_t WS_WXK = WS_WXQ + 1 * MiB, WS_WXV = WS_WXK + 1 * MiB;
constexpr size_t WS_WXO = WS_WXV + 1 * MiB;
constexpr size_t WS_WGU = WS_WXO + 1 * MiB;
constexpr size_t WS_WD = WS_WGU + 32 * MiB;
constexpr size_t WS_WEND = WS_WD + 16 * MiB;
static_assert(WS_WEND <= 81 * MiB, "weights");
constexpr size_t WS_XB = 81 * MiB;
constexpr size_t R0 = 113 * MiB;
constexpr size_t WS_CQ = R0, WS_CKV = R0 + 8 * MiB, WS_KROPE = R0 + 16 * MiB, WS_QK = R0 + 18 * MiB  , WS_VT = R0 + 82 * MiB  ;
constexpr size_t WS_QMLA = R0 + 114 * MiB, WS_KNOPE = R0 + 138 * MiB, WS_VMLAT = R0 + 154 * MiB, WS_OABC = R0 + 170 * MiB  ;
constexpr size_t WS_GSCR = R0, WS_MB = R0 + 96 * MiB;
constexpr size_t WS_QX = R0, WS_OX = R0 + 32 * MiB;
constexpr size_t WS_XG = R0, WS_ACT = R0 + 80 * MiB, WS_Y = R0 + 100 * MiB;
constexpr size_t WS_END = R0 + 234 * MiB;
static_assert(WS_MB + 32 * MiB <= WS_OABC && WS_Y + 80 * MiB <= WS_END && WS_OABC + 64 * MiB <= WS_END, "region map");
constexpr int CW_BAR = 1024, CW_Q = 8192, CW_KN = 16384, CW_F1 = 24576;
constexpr int RING_BYTES = 131072, LDSCTL_OFF = RING_BYTES, MISC_OFF = LDSCTL_OFF + 320, TSTART_OFF = LDSCTL_OFF + 1024, HIST_OFF = LDSCTL_OFF + 2048;
constexpr int LDS_BYTES = 147456;

#define LDS_WAIT() asm volatile("s_waitcnt lgkmcnt(0)" ::: "memory")
__device__ __forceinline__ float wave_sum(float v) {
#pragma unroll
    for (int o = 1; o < 64; o <<= 1) v += __shfl_xor(v, o);
    return v;
}
__device__ __forceinline__ unsigned pk2(float lo, float hi) { return pg8::pk2(lo, hi); }
__device__ __forceinline__ int lane_id() { int r; asm volatile("v_mbcnt_lo_u32_b32 %0, -1, 0\n\tv_mbcnt_hi_u32_b32 %0, -1, %0" : "=v"(r)); return r; }
#define XB_TMO      128
#define XB_XCNT(j)  (256  + 64 * (j))
#define XB_XSUB(j)  (1280 + 64 * (j))
#define XB_XGEN(j)  (2304 + 64 * (j))
#define XB_TOP      3328
#define XB_TOPGEN   3392
#define XCD_BAR_WORDS 3456
#define XB_SPIN_CAP (1u << 18)

__device__ __forceinline__ unsigned xb_ld(unsigned* p)              { return __hip_atomic_load(p, __ATOMIC_RELAXED, __HIP_MEMORY_SCOPE_AGENT); }
__device__ __forceinline__ unsigned xb_add(unsigned* p, unsigned v) { return __hip_atomic_fetch_add(p, v, __ATOMIC_RELAXED, __HIP_MEMORY_SCOPE_AGENT); }
__device__ __forceinline__ unsigned xb_xcc_id() { return (unsigned)__builtin_amdgcn_s_getreg((3 << 11) | 20) & 0xFu; }
#define XB_SPIN(cond, bar) do { unsigned _sp = 0; while (cond) { __builtin_amdgcn_s_sleep(1); \
    if ((++_sp & 255u) == 0u) { if (xb_ld(&(bar)[XB_TMO])) break; if (_sp > XB_SPIN_CAP) { atomicAdd(&(bar)[XB_TMO], 1u); break; } } } } while (0)

struct XcdBarrier {
    unsigned* bar; unsigned x; int wid;
    volatile LAS unsigned* st;
};

__device__ __forceinline__ XcdBarrier xcd_barrier_post(unsigned* bar, volatile LAS unsigned* st, int wid) {
    XcdBarrier b; b.bar = bar; b.x = xb_xcc_id(); b.st = st; b.wid = wid;
    if (wid == 0 && lane_id() == 0) (void)xb_add(&bar[XB_XCNT(b.x)], 1u);
    return b;
}
__device__ __forceinline__ void xcd_barrier_complete(unsigned* bar, unsigned x, unsigned& nloc, unsigned& nx) {
    const unsigned G = gridDim.x * gridDim.y * gridDim.z;
    unsigned sum, cnt, mine, sp = 0u;
    for (;;) {
        sum = 0u; cnt = 0u; mine = 0u;
#pragma unroll 1
        for (unsigned j = 0; j < 16; ++j) { const unsigned c = xb_ld(&bar[XB_XCNT(j)]); sum += c; cnt += (c > 0u) ? 1u : 0u; mine = (j == x) ? c : mine; }
        if (sum == G) break;
        __builtin_amdgcn_s_sleep(1);
        if ((++sp & 255u) == 0u) { if (xb_ld(&bar[XB_TMO])) break; if (sp > XB_SPIN_CAP) { atomicAdd(&bar[XB_TMO], 1u); break; } }
    }
    nloc = mine > 0u ? mine : 1u; nx = cnt > 0u ? cnt : 1u;
}

__device__ __forceinline__ void xcd_barrier(const XcdBarrier& b) {
    asm volatile("s_waitcnt vmcnt(0)" ::: "memory");
    __syncthreads();
    if (b.wid == 0 && lane_id() == 0) {
        unsigned* bar = b.bar; asm volatile("" : "+s"(bar));
        __builtin_amdgcn_s_waitcnt(0);
        unsigned nloc = b.st[0], nx = b.st[1];
        if (nloc == 0u) { xcd_barrier_complete(bar, b.x, nloc, nx); b.st[0] = nloc; b.st[1] = nx; }
        const unsigned old = xb_add(&bar[XB_XSUB(b.x)], 1u);
        const unsigned gen = old / nloc;
        if (old + 1u == (gen + 1u) * nloc) {
            __builtin_amdgcn_fence(__ATOMIC_RELEASE, "agent");
            asm volatile("s_waitcnt vmcnt(0)" ::: "memory");
            const unsigned og = xb_add(&bar[XB_TOP], 1u);
            const unsigned tg = og / nx;
            if (og + 1u == (tg + 1u) * nx) xb_add(&bar[XB_TOPGEN], 1u);
            else XB_SPIN(xb_ld(&bar[XB_TOPGEN]) == tg, bar);
            __builtin_amdgcn_fence(__ATOMIC_ACQUIRE, "agent");
            xb_add(&bar[XB_XGEN(b.x)], 1u);
            asm volatile("s_waitcnt vmcnt(0)" ::: "memory");
        } else {
            XB_SPIN(xb_ld(&bar[XB_XGEN(b.x)]) == gen, bar);
            __builtin_amdgcn_fence(__ATOMIC_ACQUIRE, "agent");
            asm volatile("s_waitcnt vmcnt(0)" ::: "memory");
        }
    }
    __syncthreads();
}
struct TrJob { const GAS float* src; const GAS float* gain; GAS bf16* dst; int ldn, col0, k0, K, row0, dk; };
__device__ __forceinline__ void tr_load(const TrJob& j, f32x4 (&v)[8], int lane) {
    const int kr = lane >> 3, nq = lane & 7;
    if (j.col0 >= 0) {
#pragma unroll
        for (int i = 0; i < 8; ++i) v[i] = *(const GAS f32x4*)(j.src + (size_t)(j.k0 + 8 * i + kr) * j.ldn + j.col0 + 4 * nq);
    } else {
#pragma unroll
        for (int i = 0; i < 8; ++i) v[i] = (f32x4){0.f, 0.f, 0.f, 0.f};
    }
}
__device__ __forceinline__ void tr_finish(const TrJob& j, const f32x4 (&v)[8], LAS float* scr, int lane) {
    const int kr = lane >> 3, nq = lane & 7;
#pragma unroll
    for (int i = 0; i < 8; ++i) { const int kk = 8 * i + kr; const float g = j.gain ? j.gain[j.k0 + kk] : 1.f; LAS float* s = scr + kk * 33 + 4 * nq;
        s[0] = v[i][0] * g; s[1] = v[i][1] * g; s[2] = v[i][2] * g; s[3] = v[i][3] * g; }
    LDS_WAIT(); asm volatile("" ::: "memory");
    const int c = lane & 7;
#pragma unroll
    for (int q = 0; q < 4; ++q) { const int n = (lane >> 3) + 8 * q; const LAS float* s = scr + (8 * c) * 33 + n;
        u32x4 o; o.x = pk2(s[0 * 33], s[1 * 33]); o.y = pk2(s[2 * 33], s[3 * 33]); o.z = pk2(s[4 * 33], s[5 * 33]); o.w = pk2(s[6 * 33], s[7 * 33]);
        *(GAS u32x4*)(j.dst + (size_t)(j.row0 + n) * j.K + j.dk + j.k0 + 8 * c) = o; }
    LDS_WAIT(); asm volatile("" ::: "memory");
}
__device__ __forceinline__ void row_to_bf16(const GAS float* xrow, GAS bf16* orow, GAS float* ssq16, int lane) {
    const GAS f32x4* xr = (const GAS f32x4*)xrow + lane; f32x4 v[4]; float s = 0.f;
#pragma unroll
    for (int j = 0; j < 4; ++j) { v[j] = xr[64 * j]; s += (v[j][0] * v[j][0] + v[j][1] * v[j][1]) + (v[j][2] * v[j][2] + v[j][3] * v[j][3]); }
    s = wave_sum(s);
    GAS u32x2* o8 = (GAS u32x2*)orow + lane;
#pragma unroll
    for (int j = 0; j < 4; ++j) { u32x2 w; w.x = pk2(v[j][0], v[j][1]); w.y = pk2(v[j][2], v[j][3]); o8[64 * j] = w; }
    if (lane < 16) ssq16[lane] = (lane == 0) ? s : 0.f;
}

struct Args { const float* in[26]; float* out; unsigned char* ws; };
__device__ __forceinline__ int opq(int i) { asm volatile("" : "+s"(i)); return i; }
__device__ __forceinline__ GAS unsigned char* opqp(unsigned char* p0) { GAS unsigned char* p = (GAS unsigned char*)p0; asm volatile("" : "+s"(p)); return p; }
#define INP(i) ((const GAS float*)args.in[opq(i)])
#define WSB(off) (opqp(args.ws) + (off))
#define X_IN INP(0)
#define OUTP ((GAS float*)args.out)
#define XB ((GAS bf16*)WSB(WS_XB))
#define SSQ ((GAS float*)WSB(WS_SSQ))
#define SSQCQ ((GAS float*)WSB(WS_SSQCQ))
#define SSQCKV ((GAS float*)WSB(WS_SSQCKV))
#define SSQMEM ((GAS float*)WSB(WS_SSQMEM))
#define MEMN ((GAS bf16*)WSB(WS_MEMN))
#define XK ((GAS bf16*)WSB(WS_XK))
#define XVT ((GAS bf16*)WSB(WS_XVT))
#define WIN ((GAS bf16*)WSB(WS_WIN))
#define WV ((GAS bf16*)WSB(WS_WV))
#define WG ((GAS bf16*)WSB(WS_WG))
#define WUQ ((GAS bf16*)WSB(WS_WUQ))
#define WUKN ((GAS bf16*)WSB(WS_WUKN))
#define WUV ((GAS bf16*)WSB(WS_WUV))
#define WB ((GAS bf16*)WSB(WS_WB))
#define WOUT ((GAS bf16*)WSB(WS_WOUT))
#define WXQ ((GAS bf16*)WSB(WS_WXQ))
#define WXK ((GAS bf16*)WSB(WS_WXK))
#define WXV ((GAS bf16*)WSB(WS_WXV))
#define WXO ((GAS bf16*)WSB(WS_WXO))
#define WGU ((GAS bf16*)WSB(WS_WGU))
#define WD ((GAS bf16*)WSB(WS_WD))
#define WRH ((GAS bf16*)WSB(WS_WRH))
#define WRL ((GAS bf16*)WSB(WS_WRL))
#define CQ ((GAS bf16*)WSB(WS_CQ))
#define CKV ((GAS bf16*)WSB(WS_CKV))
#define KROPE ((GAS bf16*)WSB(WS_KROPE))
#define QK ((GAS bf16*)WSB(WS_QK))
#define VT ((GAS bf16*)WSB(WS_VT))
#define QMLA ((GAS bf16*)WSB(WS_QMLA))
#define KNOPE ((GAS bf16*)WSB(WS_KNOPE))
#define VMLAT ((GAS bf16*)WSB(WS_VMLAT))
#define OABC ((GAS bf16*)WSB(WS_OABC))
#define GSCR ((GAS unsigned char*)WSB(WS_GSCR))
#define MB ((GAS bf16*)WSB(WS_MB))
#define QX ((GAS bf16*)WSB(WS_QX))
#define OX ((GAS bf16*)WSB(WS_OX))
#define XG ((GAS bf16*)WSB(WS_XG))
#define ACT ((GAS bf16*)WSB(WS_ACT))
#define YB ((GAS bf16*)WSB(WS_Y))
#define TOKE ((GAS int*)WSB(WS_TOKE))
#define TOKW ((GAS float*)WSB(WS_TOKW))
#define HIST ((GAS int*)WSB(WS_HIST))
#define SLOT ((GAS int*)WSB(WS_SLOT))
#define STOK ((GAS int*)WSB(WS_STOK))
#define SW ((GAS float*)WSB(WS_SW))
#define SRSTD ((GAS float*)WSB(WS_SRSTD))


__global__ void __launch_bounds__(NTHREADS, 2) fwd(Args args) {
    extern __shared__ __attribute__((aligned(16))) unsigned char lds_raw[];
    LAS unsigned char* lds = (LAS unsigned char*)lds_raw;
    volatile LAS unsigned* MISC = (volatile LAS unsigned*)(lds + MISC_OFF);
    LAS int* TSTART = (LAS int*)(lds + TSTART_OFF);
    const int tid0 = threadIdx.x; const int wv = __builtin_amdgcn_readfirstlane(tid0 >> 6);
#define PH_BEGIN int tid_ = wv * 64 + lane_id(); asm volatile("" : "+v"(tid_)); const int tid = tid_, lane = tid & 63, wave = wv, gw = vcu * NWAVES + wave; (void)lane; (void)gw
    const int G = gridDim.x, bx = blockIdx.x, vcu = (G % 8 == 0) ? (bx % 8) * (G / 8) + bx / 8 : bx;
    unsigned* ctl = (unsigned*)(void*)(args.ws + WS_CTL);
    for (int u = tid0; u < (LDS_BYTES - LDSCTL_OFF) / 4; u += NTHREADS) ((LAS unsigned*)(lds + LDSCTL_OFF))[u] = 0u;
    __syncthreads();
    XcdBarrier bar = xcd_barrier_post(ctl + CW_BAR, MISC + 8, wv);
    const int NGW = G * NWAVES;

    constexpr float L2E = 1.4426950408889634f;

    constexpr int I_IN = 88 * 16, I_V = 32 * 16, I_G = 96 * 16, I_UQ = 24 * 4, I_UK = 16 * 4, I_B = 3 * 32 * 8, I_O = 32 * 16, I_XQ = 16 * 16, I_XO = 32 * 8, I_GU = 512 * 16, I_D = 1024 * 4;
    constexpr int NITEMS = I_IN + I_V + I_G + I_UQ + 2 * I_UK + I_B + I_O + 3 * I_XQ + I_XO + I_GU + I_D, NITEMS_P0 = NITEMS - I_GU - I_D;
    for (int l = 0; l < DEPTH; ++l) {
        for (int rp_ = 0; rp_ < RP_P0; ++rp_) {
#if PH_P0
        { PH_BEGIN;
            LAS float* scr = (LAS float*)(lds + wave * 16384);
#define w_in (INP(3) + (size_t)l * D * IN_COLS)
#define g_attn (INP(2) + l * D)
#define w_uq (INP(5) + (size_t)l * 256 * 768)
#define g_q (INP(4) + l * 256)
#define w_ukv (INP(7) + (size_t)l * 256 * 1024)
#define g_kv (INP(6) + l * 256)
#define w_br (INP(10) + (size_t)l * 3 * 512 * 1024)
#define w_out (INP(11) + (size_t)l * D * D)
#define g_cross (INP(12) + l * D)
#define g_mem (INP(13))
#define w_xq (INP(14) + (size_t)l * D * 512)
#define w_xkv (INP(15) + (size_t)l * D * 1024)
#define w_xo (INP(16) + (size_t)l * 512 * D)
#define g_ffn (INP(17) + l * D)
#define w_eg (INP(22) + (size_t)l * 32 * D * 256)
#define w_eu (INP(23) + (size_t)l * 32 * D * 256)
#define w_ed (INP(24) + (size_t)l * 32 * 256 * D)
#define TR_DECODE(itx) do { int r = (itx); \
                if (r < I_IN) { const int nb = r >> 4, kb = r & 15, n0 = nb * 32; int col; \
                    if (n0 < 544) col = 3072 + n0; else if (n0 < 768) col = -1; else if (n0 < 1792) col = 3616 + (n0 - 768); else col = 5152 + (n0 - 1792); \
                    jb = TrJob{w_in, g_attn, WIN, IN_COLS, col, kb * 64, 1024, n0, 0}; break; } r -= I_IN; \
                if (r < I_V) { const int nb = r >> 4, kb = r & 15, n0 = nb * 32; const int col = n0 < 512 ? 4640 + n0 : 6176 + (n0 - 512); \
                    jb = TrJob{w_in, g_attn, WV, IN_COLS, col, kb * 64, 1024, n0, 0}; break; } r -= I_V; \
                if (r < I_G) { const int nb = r >> 4, kb = r & 15; jb = TrJob{w_in, g_attn, WG, IN_COLS, nb * 32, kb * 64, 1024, nb * 32, 0}; break; } r -= I_G; \
                if (r < I_UQ) { const int nb = r >> 2, kb = r & 3, n0 = nb * 32; const int col = n0 < 512 ? 96 * (n0 >> 6) + (n0 & 63) : 96 * ((n0 - 512) >> 5) + 64; \
                    jb = TrJob{w_uq, g_q, WUQ, 768, col, kb * 64, 256, n0, 0}; break; } r -= I_UQ; \
                if (r < I_UK) { const int nb = r >> 2, kb = r & 3, n0 = nb * 32; jb = TrJob{w_ukv, g_kv, WUKN, 1024, 128 * (n0 >> 6) + (n0 & 63), kb * 64, 256, n0, 0}; break; } r -= I_UK; \
                if (r < I_UK) { const int nb = r >> 2, kb = r & 3, n0 = nb * 32; jb = TrJob{w_ukv, g_kv, WUV, 1024, 128 * (n0 >> 6) + 64 + (n0 & 63), kb * 64, 256, n0, 0}; break; } r -= I_UK; \
                if (r < I_B) { const int z = r / 256, q = r % 256, nb = q >> 3, kb = q & 7; jb = TrJob{w_br + (size_t)z * 512 * 1024, nullptr, WB + (size_t)(z >> 1) * 1024 * 1024, 1024, nb * 32, kb * 64, 1024, nb * 32, (z & 1) * 512}; break; } r -= I_B; \
                if (r < I_O) { const int nb = r >> 4, kb = r & 15; jb = TrJob{w_out, nullptr, WOUT, 1024, nb * 32, kb * 64, 1024, nb * 32, 0}; break; } r -= I_O; \
                if (r < I_XQ) { const int nb = r >> 4, kb = r & 15; jb = TrJob{w_xq, g_cross, WXQ, 512, nb * 32, kb * 64, 1024, nb * 32, 0}; break; } r -= I_XQ; \
                if (r < I_XQ) { const int nb = r >> 4, kb = r & 15; jb = TrJob{w_xkv, g_mem, WXK, 1024, nb * 32, kb * 64, 1024, nb * 32, 0}; break; } r -= I_XQ; \
                if (r < I_XQ) { const int nb = r >> 4, kb = r & 15; jb = TrJob{w_xkv, g_mem, WXV, 1024, 512 + nb * 32, kb * 64, 1024, nb * 32, 0}; break; } r -= I_XQ; \
                if (r < I_XO) { const int nb = r >> 3, kb = r & 7; jb = TrJob{w_xo, nullptr, WXO, 1024, nb * 32, kb * 64, 512, nb * 32, 0}; break; } r -= I_XO; \
                if (r < I_GU) { const int nb = r >> 4, kb = r & 15, n0 = nb * 32, e = n0 >> 9, rr = n0 & 511, t = rr >> 8, j = rr & 255; \
                    const GAS float* src = (j < 128 ? w_eg : w_eu) + (size_t)e * D * 256; jb = TrJob{src, g_ffn, WGU, 256, 128 * t + (j & 127), kb * 64, 1024, n0, 0}; break; } r -= I_GU; \
                { const int nb = r >> 2, kb = r & 3, n0 = nb * 32, e = n0 >> 10; jb = TrJob{w_ed + (size_t)e * 256 * 1024, nullptr, WD, 1024, n0 & 1023, kb * 64, 256, n0, 0}; } } while (0)
            for (int it = gw; it < NITEMS_P0; it += NGW) {
                TrJob jb{};
                TR_DECODE(it);
                f32x4 va[8];
                tr_load(jb, va, lane);
                tr_finish(jb, va, scr, lane);
            }
            { const GAS float* wrg = INP(18) + (size_t)l * D * 4; const GAS float* wre = INP(20) + (size_t)l * D * 32; GAS bf16* wh = WRH; GAS bf16* wl = WRL;
              for (int i = bx * NTHREADS + tid; i < 48 * 1024; i += G * NTHREADS) { const int c = i >> 10, k = i & 1023;
                  const float w = c < 36 ? (c < 4 ? wrg[k * 4 + c] : wre[k * 32 + (c - 4)]) * g_ffn[k] : 0.f; const unsigned h = pk2(w, 0.f) & 0xffffu;
                  wh[i] = (bf16)h; wl[i] = (bf16)(pk2(w - __builtin_bit_cast(float, h << 16), 0.f) & 0xffffu); } }
            if (l == 0) {
                for (int m = gw; m < M; m += NGW) row_to_bf16(X_IN + (size_t)m * D, XB + (size_t)m * D, SSQ + (size_t)m * 16, lane);
                for (int m = gw; m < 512; m += NGW) row_to_bf16(INP(1) + (size_t)m * D, MEMN + (size_t)m * D, SSQMEM + (size_t)m * 16, lane);
            }
        }
#endif
        xcd_barrier(bar);
        }
                for (int rp_ = 0; rp_ < RP_A; ++rp_) {
#if PH_A
        {
            { pg8::Gemm g{XB, WIN, M, 2816, D, D, nullptr}; pg8::StaticOrder S; S.init(M, 2816, G, bx);
              pg8::EpiA E{SSQ, CQ, CKV, KROPE, QK, SSQCQ, SSQCKV, 0.125f * L2E, (GAS unsigned*)(opqp(args.ws) + WS_CTL) + CW_KN + l * 4096};
              pg8::gemm_phase<pg8::EpiA, pg8::StaticOrder, true, true>(lds, g, S, E, wv); }
            { pg8::Gemm g{WV, XB, 1024, M, D, D, nullptr}; pg8::StaticOrder S; S.init(1024, M, G, (bx + 64) % G);
              pg8::EpiVT E{VT, M, SSQ, 4, 1.f / 1024.f};
              pg8::gemm_phase<pg8::EpiVT, pg8::StaticOrder, true, true>(lds, g, S, E, wv); }
            { pg8::Gemm g{MEMN, WXK, 512, 512, D, D, nullptr}; pg8::StaticOrder S; S.init(512, 512, G, (bx + 8) % G);
              pg8::EpiRS E{XK, 512, SSQMEM, 4, 1.f / 1024.f, 1.f, 0xffff, 31, 0};
              pg8::gemm_phase<pg8::EpiRS, pg8::StaticOrder, true, true>(lds, g, S, E, wv); }
            { pg8::Gemm g{WXV, MEMN, 512, 512, D, D, nullptr}; pg8::StaticOrder S; S.init(512, 512, G, (bx + 16) % G);
              pg8::EpiVT E{XVT, 512, SSQMEM, 4, 1.f / 1024.f};
              pg8::gemm_phase<pg8::EpiVT, pg8::StaticOrder, true, true>(lds, g, S, E, wv); }
        }
#endif
        xcd_barrier(bar);
        }
                for (int rp_ = 0; rp_ < RP_B; ++rp_) {
#if PH_B
        {
#if PH_B1
            { pg8::Gemm g{CQ, WUQ, M, 768, opq(256), opq(256), nullptr}; pg8::StaticOrder S; S.init(M, 768, G, bx);
              pg8::EpiQ E{QMLA, SSQCQ, 0.10206207261596577f * L2E};
              pg8::gemm_phase<pg8::EpiQ, pg8::StaticOrder, true, true>(lds, g, S, E, wv); }
#endif
#if PH_B2
            { pg8::Gemm g{CKV, WUKN, M, 512, opq(256), opq(256), nullptr}; pg8::StaticOrder S; S.init(M, 512, G, (bx + 64) % G);
              pg8::EpiRS E{KNOPE, 512, SSQCKV, 1, 1.f / 256.f, 1.f, 0xffff, 31, 0};
              pg8::gemm_phase<pg8::EpiRS, pg8::StaticOrder, true, true>(lds, g, S, E, wv); }
#endif
#if PH_B3
            { pg8::Gemm g{WUV, CKV, 512, M, opq(256), opq(256), nullptr}; pg8::StaticOrder S; S.init(512, M, G, (bx + 128) % G);
              pg8::EpiVT E{VMLAT, M, SSQCKV, 1, 1.f / 256.f};
              pg8::gemm_phase<pg8::EpiVT, pg8::StaticOrder, true, true>(lds, g, S, E, wv); }
#endif
        }
#endif
        xcd_barrier(bar);
        }
                for (int rp_ = 0; rp_ < RP_C; ++rp_) {
#if PH_C
        {
            unsigned* qhead = ctl + CW_Q + 64 * (l + 2 * rp_);
            for (;;) {
                if (wv == 0 && lane_id() == 0) MISC[0] = __hip_atomic_fetch_add(qhead, 1u, __ATOMIC_RELAXED, __HIP_MEMORY_SCOPE_AGENT);
                __syncthreads();
                const int idx = (int)MISC[0];
                __syncthreads();
                if (idx >= 32 * 48 + 256) break;
                if (idx >= 32 * 48) {
                    if (rp_ == 0) { const int wl = lane_id(); LAS float* scr = (LAS float*)(lds + wv * 16384);
                        for (int j = 0; j < 6; ++j) { const int it = NITEMS_P0 + (idx - 32 * 48) * 48 + j * 8 + wv; TrJob jb{}; TR_DECODE(it); f32x4 va[8]; tr_load(jb, va, wl); tr_finish(jb, va, scr, wl); } }
                    continue; }
                const int qb = 31 - idx / 48, r = idx % 48, q0 = qb * 256;
                int tu = wv * 64 + lane_id(); asm volatile("" : "+v"(tu));
#if PH_C_DIFF
                if (r < 16 && (rp_ == 0 || (C_REP_MASK & 1))) att::diff_unit(lds, tu, r >> 3, (r >> 1) & 3, r & 1, q0, QK + (size_t)2 * M * 512, QK + (size_t)3 * M * 512, VT, (r & 1) ? CQ : OABC + (size_t)M * 1024, (r & 1) ? 512 : 1024,
                                                                             (const GAS unsigned*)(opqp(args.ws) + WS_CTL) + CW_KN + l * 4096, rp_ ? C_ABL : 0);
#endif
#if PH_C_SB
                if (r >= 16 && r < 32 && (rp_ == 0 || (C_REP_MASK & 2))) att::sb_unit(lds, tu, (r - 16) >> 3, (r - 16) & 7, q0, QK, QK + (size_t)M * 512, VT, OABC + 512);
#endif
#if PH_C_MLA
                if (r >= 32 && (rp_ == 0 || (C_REP_MASK & 4))) att::mla_unit(lds, tu, (r - 32) >> 3, (r - 32) & 7, q0, QMLA, KNOPE, KROPE, VMLAT, OABC, rp_ ? C_ABL : 0);
#endif
            }
        }
#endif
        xcd_barrier(bar);
        }
        #undef TR_DECODE
#undef w_in
#undef g_attn
#undef w_uq
#undef g_q
#undef w_ukv
#undef g_kv
#undef w_br
#undef w_out
#undef g_cross
#undef g_mem
#undef w_xq
#undef w_xkv
#undef w_xo
#undef g_ffn
#undef w_eg
#undef w_eu
#undef w_ed
#if PH_C
        { PH_BEGIN;
          float lam, post; att::diff_lambda(INP(8) + l * 256, l, lam, post);
          for (int it = gw; it < M * 4; it += 4 * NGW) att::diff_combine4(it, NGW, lane, OABC + (size_t)M * 1024, CQ, lam, post, INP(9) + l * 128); }
        xcd_barrier(bar);
#endif
        for (int rp_ = 0; rp_ < RP_D1; ++rp_) {
#if PH_D1
        { pg8::Gemm g{XB, WG, M, 1024, 512, 1024, nullptr}; pg8::D1Order S; S.so.init(M, 1024, G, bx);
          const GAS char* xb_ = (const GAS char*)XB; const GAS char* oab_ = (const GAS char*)OABC; const GAS char* wg_ = (const GAS char*)WG; const GAS char* wb_ = (const GAS char*)WB;
          S.dA = (size_t)(oab_ - xb_); S.dB = (size_t)(wb_ - wg_);
          pg8::EpiD1 E{GSCR, MB, SSQ};
          pg8::gemm_phase<pg8::EpiD1, pg8::D1Order, true, true>(lds, g, S, E, wv); }
#endif
        xcd_barrier(bar);
        }
        #if PH_D2
        { pg8::Gemm g{MB, WOUT, M, 1024, D, D, nullptr}; pg8::StaticOrder S; S.init(M, 1024, G, bx);
          pg8::EpiRes E{XB, SSQ};
          pg8::gemm_phase<pg8::EpiRes, pg8::StaticOrder, true, true>(lds, g, S, E, wv); }
#endif
        xcd_barrier(bar);
                for (int rp_ = 0; rp_ < RP_E1; ++rp_) {
#if PH_E1
        { pg8::Gemm g{XB, WXQ, M, 512, 512, 1024, nullptr}; pg8::SplitK2Order S; S.so.init(M, 1024, G, bx); S.tstep = (size_t)256 * 1024 * 2;
          pg8::EpiRS E{QX, 512, SSQ, 4, 1.f / 1024.f, 0.08838834764831845f * L2E, 1, 1, (size_t)M * 512};
          pg8::gemm_phase<pg8::EpiRS, pg8::SplitK2Order, true, true>(lds, g, S, E, wv); }
#endif
        xcd_barrier(bar);
        }
                for (int rp_ = 0; rp_ < RP_E2; ++rp_) {
#if PH_E2
        { PH_BEGIN; for (int u = vcu; u < 256; u += G) att::cross_unit(lds, tid, u >> 7, (u >> 5) & 3, (u & 31) * 256, QX, XK, XVT, OX); }
#endif
        xcd_barrier(bar);
        }
        #if PH_E3
        { pg8::Gemm g{OX, WXO, M, 1024, 512, 512, nullptr}; pg8::StaticOrder S; S.init(M, 1024, G, bx);
          pg8::EpiRes E{XB, SSQ};
          pg8::gemm_phase<pg8::EpiRes, pg8::StaticOrder, true, true>(lds, g, S, E, wv); }
#endif
        xcd_barrier(bar);
                for (int rp_ = 0; rp_ < RP_F0A; ++rp_) {
#if PH_F0A
        { PH_BEGIN;
            typedef short bf16x8 __attribute__((ext_vector_type(8)));
            const GAS float* brg = INP(19) + l * 4; const GAS float* bre = INP(21) + l * 32;
            LAS float* part = (LAS float*)lds;
            const int rb = wave & 3, kh = wave >> 2, r16 = lane & 15, kq = lane >> 4;
            for (int grp = bx; grp < 256; grp += G) {
                const GAS bf16* xrow = XB + (size_t)(grp * 64 + 16 * rb + r16) * D + 512 * kh + 8 * kq;
                const GAS bf16* wh = WRH + (size_t)r16 * 1024 + 512 * kh + 8 * kq; const GAS bf16* wl = WRL + (size_t)r16 * 1024 + 512 * kh + 8 * kq;
                f32x4 acc[3];
#pragma unroll
                for (int cb = 0; cb < 3; ++cb) acc[cb] = (f32x4){0.f, 0.f, 0.f, 0.f};
#pragma unroll 8
                for (int st = 0; st < 16; ++st) {
                    const bf16x8 ah = *(const GAS bf16x8*)(xrow + 32 * st);
#pragma unroll
                    for (int cb = 0; cb < 3; ++cb) {
                        const bf16x8 bh = *(const GAS bf16x8*)(wh + (size_t)cb * 16 * 1024 + 32 * st), bl = *(const GAS bf16x8*)(wl + (size_t)cb * 16 * 1024 + 32 * st);
                        acc[cb] = __builtin_amdgcn_mfma_f32_16x16x32_bf16(ah, bh, acc[cb], 0, 0, 0);
                        acc[cb] = __builtin_amdgcn_mfma_f32_16x16x32_bf16(ah, bl, acc[cb], 0, 0, 0);
                    }
                }
                __syncthreads();
#pragma unroll
                for (int cb = 0; cb < 3; ++cb)
#pragma unroll
                    for (int r = 0; r < 4; ++r) part[(kh * 64 + 16 * rb + 4 * kq + r) * 49 + 16 * cb + r16] = acc[cb][r];
                __syncthreads();
                if (wave == 0) {
                    const int tok = grp * 64 + lane; const float rs = pg8::rstd_parts(SSQ, (unsigned)(tok * 16), 4, 1.f / 1024.f);
                    const LAS float* p0 = part + lane * 49; const LAS float* p1 = part + (64 + lane) * 49;
                    float gl[4];
#pragma unroll
                    for (int c = 0; c < 4; ++c) gl[c] = (p0[c] + p1[c]) * rs + brg[c];
                    int gs = 0; float gm = gl[0];
#pragma unroll
                    for (int c = 1; c < 4; ++c) if (gl[c] > gm) { gm = gl[c]; gs = c; }
                    float den = 0.f;
#pragma unroll
                    for (int c = 0; c < 4; ++c) den += expf(gl[c] - gm);
                    const float pg = 1.0f / den;
                    float el[8];
#pragma unroll
                    for (int j = 0; j < 8; ++j) el[j] = (p0[4 + gs * 8 + j] + p1[4 + gs * 8 + j]) * rs + bre[gs * 8 + j];
                    int i0 = 0; float v0 = el[0];
#pragma unroll
                    for (int j = 1; j < 8; ++j) if (el[j] > v0) { v0 = el[j]; i0 = j; }
                    int i1 = -1; float v1 = -INFINITY;
#pragma unroll
                    for (int j = 0; j < 8; ++j) if (j != i0 && el[j] > v1) { v1 = el[j]; i1 = j; }
                    const float e1 = expf(v1 - v0), w0 = pg / (1.f + e1), w1 = pg * e1 / (1.f + e1);
                    const int ea = gs * 8 + i0, eb = gs * 8 + i1;
                    TOKE[tok * 2] = ea; TOKE[tok * 2 + 1] = eb; TOKW[tok * 2] = w0; TOKW[tok * 2 + 1] = w1;
                    int mycnt = 0;
#pragma unroll 1
                    for (int e = 0; e < 32; ++e) { const int c = __popcll(__ballot(ea == e)) + __popcll(__ballot(eb == e)); if (lane == e) mycnt = c; }
                    if (lane < 32) HIST[grp * 32 + lane] = mycnt;
                }
            }
            __syncthreads();
        }
#endif
        xcd_barrier(bar);
        }
                for (int rp_ = 0; rp_ < RP_F0B; ++rp_) {
#if PH_F0B
        { PH_BEGIN;
            LAS int* cnt = (LAS int*)(lds + HIST_OFF);
            for (int grp = bx; grp < 256; grp += G) {
                __syncthreads();
                { const int e = tid & 31, ch = tid >> 5; int tot = 0, before = 0;
#pragma unroll
                  for (int j = 0; j < 16; ++j) { const int g2 = ch * 16 + j; const int hv = HIST[g2 * 32 + e]; tot += hv; before += (g2 < grp) ? hv : 0; }
                  cnt[128 + ch * 32 + e] = tot; cnt[640 + ch * 32 + e] = before; }
                __syncthreads();
                if (tid < 32) { int tot = 0, before = 0;
                    for (int ch = 0; ch < 16; ++ch) { tot += cnt[128 + ch * 32 + tid]; before += cnt[640 + ch * 32 + tid]; }
                    cnt[tid] = tot; cnt[32 + tid] = before; }
                __syncthreads();
                if (tid == 0) { int ts = 0; for (int e = 0; e < 32; ++e) { TSTART[e] = ts; ts += (cnt[e] + 255) >> 8; } TSTART[32] = ts; }
                __syncthreads();
                if (wave == 0) {
                    const int tok = grp * 64 + lane; const int ea = TOKE[tok * 2], eb = TOKE[tok * 2 + 1];
                    int ra = 0, rb = 0; const unsigned long long lt = (1ull << lane) - 1ull;
#pragma unroll 1
                    for (int e = 0; e < 32; ++e) { const unsigned long long ma = __ballot(ea == e), mb = __ballot(eb == e); const int c = __popcll((ma | mb) & lt); if (ea == e) ra = c; if (eb == e) rb = c; }
                    const int sa = TSTART[ea] * 256 + cnt[32 + ea] + ra, sb = TSTART[eb] * 256 + cnt[32 + eb] + rb;
                    const float rsd = pg8::rstd_parts(SSQ, (unsigned)(tok * 16), 4, 1.f / 1024.f);
                    SLOT[tok * 2] = sa; SLOT[tok * 2 + 1] = sb;
                    STOK[sa] = tok; STOK[sb] = tok; SW[sa] = TOKW[tok * 2]; SW[sb] = TOKW[tok * 2 + 1]; SRSTD[sa] = rsd; SRSTD[sb] = rsd;
                    MISC[16 + lane] = (unsigned)sa; MISC[80 + lane] = (unsigned)sb;
                }
                __syncthreads();
                if (grp < 32) { const int beg = TSTART[grp] * 256 + cnt[grp], end = TSTART[grp + 1] * 256;
                    for (int s = beg + tid; s < end; s += NTHREADS) { STOK[s] = 0; SW[s] = 0.f; SRSTD[s] = 0.f; } }
            }
            if (G > 256 || bx >= 256) {
                __syncthreads();
                if (tid < 32) { int tot = 0; for (int g2 = 0; g2 < 256; ++g2) tot += HIST[g2 * 32 + tid]; cnt[tid] = tot; }
                __syncthreads();
                if (tid == 0) { int ts = 0; for (int e = 0; e < 32; ++e) { TSTART[e] = ts; ts += (cnt[e] + 255) >> 8; } TSTART[32] = ts; }
            }
            __syncthreads();
        }
#endif
        xcd_barrier(bar);
        }
                for (int rp_ = 0; rp_ < RP_F1; ++rp_) {
#if PH_F1
        { pg8::Gemm g{XB, WGU, SROWS, 32 * 512, D, D, STOK}; pg8::MoeOrderP S{(const LAS int*)TSTART, (GAS unsigned*)(opqp(args.ws) + WS_CTL) + CW_F1 + l * 256, G, vcu};
          pg8::EpiAct E{ACT, SRSTD, SW};
          pg8::gemm_phase<pg8::EpiAct, pg8::MoeOrderP, true, true, true>(lds, g, S, E, wv); }
#endif
        }
                for (int rp_ = 0; rp_ < RP_F2; ++rp_) {
#if PH_F2
        { pg8::Gemm g{ACT, WD, SROWS, 32 * 1024, opq(256), opq(256), nullptr}; pg8::MoeOrderC S{(const LAS int*)TSTART, (const GAS unsigned*)(opqp(args.ws) + WS_CTL) + CW_F1 + l * 256, G, vcu, wv};
          pg8::EpiRS E{YB, 1024, nullptr, 0, 0.f, 1.f, 3, 31, 0};
          pg8::gemm_phase<pg8::EpiRS, pg8::MoeOrderC, true, true>(lds, g, S, E, wv); }
#endif
        xcd_barrier(bar);
        }
#if PH_F3
        { PH_BEGIN;
            const GAS float* g_fin = INP(25);
            int s0n = SLOT[gw * 2], s1n = SLOT[gw * 2 + 1];
            for (int m = gw; m < M; m += NGW) {
                GAS u32x2* xr = (GAS u32x2*)(XB + (size_t)m * D) + lane; const int s0 = s0n, s1 = s1n;
                if (m + NGW < M) { s0n = SLOT[(m + NGW) * 2]; s1n = SLOT[(m + NGW) * 2 + 1]; }
                const GAS u32x2* y0 = (const GAS u32x2*)(YB + (size_t)s0 * D) + lane; const GAS u32x2* y1 = (const GAS u32x2*)(YB + (size_t)s1 * D) + lane;
                f32x4 v[4]; float s = 0.f;
#pragma unroll
                for (int j = 0; j < 4; ++j) { const u32x2 a = y0[64 * j], b2 = y1[64 * j], xw = xr[64 * j];
                    v[j][0] = pg8::bflo(xw.x) + (pg8::bflo(a.x) + pg8::bflo(b2.x)); v[j][1] = pg8::bfhi(xw.x) + (pg8::bfhi(a.x) + pg8::bfhi(b2.x));
                    v[j][2] = pg8::bflo(xw.y) + (pg8::bflo(a.y) + pg8::bflo(b2.y)); v[j][3] = pg8::bfhi(xw.y) + (pg8::bfhi(a.y) + pg8::bfhi(b2.y));
                    s += (v[j][0] * v[j][0] + v[j][1] * v[j][1]) + (v[j][2] * v[j][2] + v[j][3] * v[j][3]); }
                s = wave_sum(s);
                if (l == DEPTH - 1) { const float rsd = 1.0f / sqrtf(s * (1.f / 1024.f) + 1e-6f); GAS f32x4* orow = (GAS f32x4*)(OUTP + (size_t)m * D) + lane;
#pragma unroll
                    for (int j = 0; j < 4; ++j) { const f32x4 gg = ((const GAS f32x4*)g_fin)[lane + 64 * j]; orow[64 * j] = v[j] * rsd * gg; }
                } else {
#pragma unroll
                    for (int j = 0; j < 4; ++j) { u32x2 w; w.x = pk2(v[j][0], v[j][1]); w.y = pk2(v[j][2], v[j][3]); xr[64 * j] = w; }
                    if (lane < 16) SSQ[(size_t)m * 16 + lane] = (lane == 0) ? s : 0.f;
                }
            }
        }
#endif
    }
}

extern "C" void kernel_launch(void* const* d_in, const int* in_sizes, int n_in, void* d_out, int out_size, void* d_ws, size_t ws_size, hipStream_t stream) {
    static int grid = 0;
    if (grid == 0) {
        if (n_in != 26 || in_sizes[0] != M * D || out_size != M * D || ws_size < WS_END) { fprintf(stderr, "kernel_launch: unexpected shapes (n_in %d, in0 %d, out %d, ws %zu < %zu)\n", n_in, n_in > 0 ? in_sizes[0] : -1, out_size, ws_size, (size_t)WS_END); grid = -1; return; }
        int dev = 0, cus = 0;
        if (hipGetDevice(&dev) != hipSuccess || hipDeviceGetAttribute(&cus, hipDeviceAttributeMultiprocessorCount, dev) != hipSuccess) { grid = -1; return; }
        if (hipFuncSetAttribute((const void*)fwd, hipFuncAttributeMaxDynamicSharedMemorySize, LDS_BYTES) != hipSuccess) { fprintf(stderr, "kernel_launch: hipFuncSetAttribute failed\n"); grid = -1; return; }
        int per_cu = 0;
        if (hipOccupancyMaxActiveBlocksPerMultiprocessor(&per_cu, (const void*)fwd, NTHREADS, LDS_BYTES) != hipSuccess || per_cu < 1) fprintf(stderr, "kernel_launch: occupancy query says %d\n", per_cu);
        (void)hipGetLastError();
        grid = cus < 256 ? (cus / 8) * 8 : 256;
    }
    if (grid <= 0) return;
    if (hipMemsetAsync((char*)d_ws + WS_CTL, 0, CTL_ZERO_BYTES, stream) != hipSuccess) return;
    Args a{};
    for (int i = 0; i < 26; ++i) a.in[i] = (const float*)d_in[i];
    a.out = (float*)d_out; a.ws = (unsigned char*)d_ws;
    hipLaunchKernelGGL(fwd, dim3(grid), dim3(NTHREADS), LDS_BYTES, stream, a);
}
```

```cpp
#include <hip/hip_runtime.h>
#include <cstdio>
#include <cstdint>
#define LAS __attribute__((address_space(3)))
#define GAS __attribute__((address_space(1)))
#ifndef PH_A
#define PH_A 1
#endif
#ifndef PH_B
#define PH_B 1
#endif
#ifndef PH_C
#define PH_C 1
#endif
#ifndef PH_D1
#define PH_D1 1
#endif
#ifndef PH_D2
#define PH_D2 1
#endif
#ifndef PH_E1
#define PH_E1 1
#endif
#ifndef PH_E2
#define PH_E2 1
#endif
#ifndef PH_E3
#define PH_E3 1
#endif
#ifndef PH_F0A
#define PH_F0A 1
#endif
#ifndef PH_F0B
#define PH_F0B 1
#endif
#ifndef PH_F1
#define PH_F1 1
#endif
#ifndef PH_F2
#define PH_F2 1
#endif
#ifndef PH_P0
#define PH_P0 1
#endif
#ifndef PH_F3
#define PH_F3 1
#endif
#ifndef PH_C_DIFF
#define PH_C_DIFF 1
#endif
#ifndef PH_C_SB
#define PH_C_SB 1
#endif
#ifndef PH_C_MLA
#define PH_C_MLA 1
#endif
#ifndef PH_B1
#define PH_B1 1
#endif
#ifndef PH_B2
#define PH_B2 1
#endif
#ifndef PH_B3
#define PH_B3 1
#endif
#ifndef RP_A
#define RP_A 1
#endif
#ifndef RP_B
#define RP_B 1
#endif
#ifndef RP_C
#define RP_C 1
#endif
#ifndef RP_D1
#define RP_D1 1
#endif
#ifndef RP_E1
#define RP_E1 1
#endif
#ifndef RP_E2
#define RP_E2 1
#endif
#ifndef RP_F0A
#define RP_F0A 1
#endif
#ifndef RP_F0B
#define RP_F0B 1
#endif
#ifndef RP_F1
#define RP_F1 1
#endif
#ifndef RP_F2
#define RP_F2 1
#endif
#ifndef RP_P0
#define RP_P0 1
#endif
#ifndef C_REP_MASK
#define C_REP_MASK 7
#endif
#ifndef A_ABL
#define A_ABL 0
#endif
#ifndef C_ABL
#define C_ABL 0
#endif
namespace pg8 {
#define PG8_LAS __attribute__((address_space(3)))
typedef unsigned short bf16_t;
typedef short bf16x8 __attribute__((ext_vector_type(8)));
typedef float f32x4 __attribute__((ext_vector_type(4)));
typedef unsigned u32x4 __attribute__((ext_vector_type(4)));
constexpr int BM = 256, BK = 64, HALF = 128, HTB = HALF * BK * 2  , STAGE_BYTES = 8 * HTB, NXCD = 8, WGM = 8;

__host__ __device__ __forceinline__ int lds_byte(int r, int c) { const int st = (r >> 4) * 2 + (c >> 5), rr = r & 15, cc = c & 31, ob = rr * 64 + cc * 2; return st * 1024 + (ob ^ (((ob >> 9) & 1) << 5)); }
__host__ __device__ __forceinline__ void stage_rc(int b, int& R, int& C) { const int st = b / 1024, sb = b % 1024, swz = sb ^ (((sb >> 9) & 1) << 5); R = (st >> 1) * 16 + swz / 64; C = (st & 1) * 32 + (swz % 64) / 2; }
__host__ __device__ __forceinline__ int perm32(int rho) { const int n = rho >> 4, i = rho & 15; return 8 * (i >> 2) + 4 * n + (i & 3); }

struct Unit { int pm, pn, sel; };
struct Gemm { const GAS bf16_t* A; const GAS bf16_t* Bt; int M, N, K, ld; const GAS int* rowidx; };

struct StaticOrder {
    int nM, nN, nwg, G, c;
    __host__ __device__ void init(int M, int N, int G_, int c_) { nM = M / BM; nN = N / BM; nwg = nM * nN; G = G_; c = c_; }
    __host__ __device__ bool next(int i, Unit& u) const {
        const long L = (long)i * G + c; if (L >= nwg) return false;
        int wgid = (int)L; { const int q = nwg / NXCD, r = nwg % NXCD, xcd = wgid % NXCD, off = wgid / NXCD; wgid = (xcd < r ? xcd * (q + 1) : r * (q + 1) + (xcd - r) * q) + off; }
        const int nig = WGM * nN, gid = wgid / nig, fm = gid * WGM, gsz = (nM - fm) < WGM ? (nM - fm) : WGM;
        u.pm = fm + ((wgid % nig) % gsz); u.pn = (wgid % nig) / gsz; u.sel = 0; return true;
    }
    __device__ __forceinline__ void a_ready(const Unit&) const {}
    __device__ __forceinline__ void done(const Unit&) const {}
    __device__ __forceinline__ size_t a_off(const Unit&) const { return 0; }
    __device__ __forceinline__ size_t b_off(const Unit&) const { return 0; }
    __device__ __forceinline__ bool keep(const Unit&) const { return false; }
};

__device__ __forceinline__ unsigned cvt_pk_bf16(float lo, float hi) { unsigned r; asm volatile("v_cvt_pk_bf16_f32 %0, %1, %2" : "=v"(r) : "v"(lo), "v"(hi)); return r; }
template <class T, class = void> struct HasScale { static constexpr bool v = false; };
template <class T> struct HasScale<T, decltype((void)T::SCALE)> { static constexpr bool v = true; };
template <class Epi, class Sched, bool ALIGN_EPI = false, bool SP2 = false, bool GATHER = false>
__device__ __forceinline__ void gemm_phase(PG8_LAS unsigned char* lds, const Gemm g, const Sched& S, const Epi& E, const int wave_idx) {
    int tid_; asm volatile("v_mbcnt_lo_u32_b32 %0, -1, 0\n\tv_mbcnt_hi_u32_b32 %0, -1, %0" : "=v"(tid_)); tid_ += wave_idx * 64;
    const int tid = tid_, wid = __builtin_amdgcn_readfirstlane(tid >> 6), lane = tid & 63, wr = wid >> 2, wc = wid & 3, fr = lane & 15, fq = lane >> 4;
    const int K = g.K, nt = K / BK, LD = g.ld;
    unsigned voffA[2], voffB[2];
#pragma unroll
    for (int i = 0; i < 2; ++i) { int R, C; stage_rc(tid * 16 + i * 8192, R, C); const int Rb = Epi::PERM ? ((R & ~31) + perm32(R & 31)) : R;
        voffA[i] = (unsigned)(R * LD + C) * 2u; voffB[i] = (unsigned)(Rb * LD + C) * 2u; }
    const size_t kstep = (size_t)(BK * 2);
    const size_t hstep = (size_t)HALF * LD * 2;
    const size_t tstep = 2 * hstep;
    const unsigned ldsw = (unsigned)wid * 1024u;
    const int aoff = lds_byte(wr * 64 + fr, fq * 8), boff = lds_byte(wc * 32 + fr, fq * 8);
#define PG8_SA(b, h) (((b) * 2 + (h)) * HTB)
#define PG8_SB(b, h) ((4 + (b) * 2 + (h)) * HTB)
#define PG8_STAGE(bufoff, gbase, voff) do { _Pragma("unroll") for (int _i = 0; _i < 2; ++_i) \
        __builtin_amdgcn_global_load_lds((const GAS unsigned*)((const GAS char*)(gbase) + (voff)[_i]), (PG8_LAS unsigned*)(lds + (bufoff) + ldsw + _i * 8192), 16, 0, 0); } while (0)
#define PG8_LDA(dst, b, h) do { _Pragma("unroll") for (int m = 0; m < 4; ++m) _Pragma("unroll") for (int k = 0; k < 2; ++k) dst[m][k] = *(const PG8_LAS bf16x8*)(lds + PG8_SA(b, h) + aoff + m * 2048 + k * 1024); } while (0)
#define PG8_LDB(dst, b, h) do { _Pragma("unroll") for (int n = 0; n < 2; ++n) _Pragma("unroll") for (int k = 0; k < 2; ++k) dst[n][k] = *(const PG8_LAS bf16x8*)(lds + PG8_SB(b, h) + boff + n * 2048 + k * 1024); } while (0)
#define PG8_MMA(ai, bj, At, Bt) do { __builtin_amdgcn_s_setprio(1); _Pragma("unroll") for (int m = 0; m < 4; ++m) _Pragma("unroll") for (int n = 0; n < 2; ++n) _Pragma("unroll") for (int k = 0; k < 2; ++k) \
        acc[ai][bj][m][n] = __builtin_amdgcn_mfma_f32_16x16x32_bf16(Bt[n][k], At[m][k], acc[ai][bj][m][n], 0, 0, 0); __builtin_amdgcn_s_setprio(0); } while (0)
#define PG8_WAIT_V(n) asm volatile("s_waitcnt vmcnt(" #n ")" ::: "memory")
#define PG8_WAIT_L(n) asm volatile("s_waitcnt lgkmcnt(" #n ")" ::: "memory")
#define PG8_BAR __builtin_amdgcn_s_barrier()
#define PG8_SCHED __builtin_amdgcn_sched_barrier(0)
    Unit cur, nxt; int ui = 0;
    if (!S.next(0, cur)) return;
    f32x4 acc[2][2][4][2];
#pragma unroll
    for (int a = 0; a < 2; ++a)
#pragma unroll
        for (int b = 0; b < 2; ++b)
#pragma unroll
            for (int m = 0; m < 4; ++m)
#pragma unroll
                for (int n = 0; n < 2; ++n) acc[a][b][m][n] = (f32x4){0.f, 0.f, 0.f, 0.f};
    bf16x8 At[4][2], B0[2][2], B1[2][2];
    const GAS char* cA = (const GAS char*)g.A + (GATHER ? (size_t)0 : (size_t)cur.pm * tstep + S.a_off(cur)); const GAS char* cB = (const GAS char*)g.Bt + (size_t)cur.pn * tstep + S.b_off(cur);
    unsigned vC[2][2], vN[2][2];
    if constexpr (GATHER) {
#pragma unroll
        for (int h = 0; h < 2; ++h)
#pragma unroll
            for (int i = 0; i < 2; ++i) { int R, C; stage_rc(tid * 16 + i * 8192, R, C); vC[h][i] = (unsigned)(g.rowidx[cur.pm * BM + h * HALF + R] * LD + C) * 2u; vN[h][i] = vC[h][i]; }
    }
#define PG8_STAGE_A(bufoff, gb, h, nx) do { if constexpr (GATHER) { unsigned vs_[2] = {(nx) ? vN[h][0] : vC[h][0], (nx) ? vN[h][1] : vC[h][1]}; PG8_STAGE(bufoff, gb, vs_); } \
        else { PG8_STAGE(bufoff, (gb) + (h) * hstep, voffA); } } while (0)
    S.a_ready(cur);
    if constexpr (SP2) {
        PG8_STAGE(PG8_SB(0, 0), cB, voffB); PG8_STAGE(PG8_SB(0, 1), cB + hstep, voffB); PG8_STAGE_A(PG8_SA(0, 0), cA, 0, false); PG8_STAGE_A(PG8_SA(0, 1), cA, 1, false);
        if (wr == 1) PG8_BAR;
        PG8_WAIT_V(2); PG8_BAR;
        PG8_STAGE(PG8_SB(1, 0), cB + kstep, voffB); PG8_STAGE_A(PG8_SA(1, 0), cA + kstep, 0, false); PG8_STAGE(PG8_SB(1, 1), cB + hstep + kstep, voffB);
        PG8_WAIT_V(6); PG8_BAR;
    } else {
        PG8_STAGE(PG8_SB(0, 0), cB, voffB); PG8_STAGE(PG8_SA(0, 0), cA, voffA); PG8_STAGE(PG8_SB(0, 1), cB + hstep, voffB); PG8_STAGE(PG8_SA(0, 1), cA + hstep, voffA);
        if (wr == 1) PG8_BAR;
        PG8_WAIT_V(4); PG8_BAR;
        PG8_STAGE(PG8_SB(1, 0), cB + kstep, voffB); PG8_STAGE(PG8_SA(1, 0), cA + kstep, voffA); PG8_STAGE(PG8_SB(1, 1), cB + hstep + kstep, voffB);
        PG8_WAIT_V(6); PG8_BAR;
    }
    for (;;) {
        const bool has_next = S.next(ui + 1, nxt);
        if constexpr (GATHER) { if (has_next) {
#pragma unroll
            for (int h = 0; h < 2; ++h)
#pragma unroll
                for (int i = 0; i < 2; ++i) { int R, C; stage_rc(tid * 16 + i * 8192, R, C); vN[h][i] = (unsigned)(g.rowidx[nxt.pm * BM + h * HALF + R] * LD + C) * 2u; } } }
        const GAS char* nA = GATHER ? cA : has_next ? (const GAS char*)g.A + (size_t)nxt.pm * tstep + S.a_off(nxt) : cA; const GAS char* nB = has_next ? (const GAS char*)g.Bt + (size_t)nxt.pn * tstep + S.b_off(nxt) : cB;
        for (int t = 0; t < nt; t += 2) {
            const bool last = (t == nt - 2);
            const GAS char* a1 = cA + (size_t)(t + 1) * kstep;
            const GAS char* a2 = last ? nA : cA + (size_t)(t + 2) * kstep; const GAS char* b2 = last ? nB : cB + (size_t)(t + 2) * kstep;
            const GAS char* a3 = a2 + kstep; const GAS char* b3 = b2 + kstep;
            if (last && has_next) S.a_ready(nxt);
            if constexpr (SP2) {
            PG8_LDB(B0, 0, 0); PG8_LDB(B1, 0, 1); PG8_SCHED; PG8_LDA(At, 0, 0); PG8_STAGE_A(PG8_SA(1, 1), a1, 1, false);
            PG8_WAIT_V(8); PG8_WAIT_L(0); PG8_BAR; PG8_MMA(0, 0, At, B0); PG8_MMA(0, 1, At, B1); PG8_BAR; PG8_SCHED;
            PG8_LDA(At, 0, 1); PG8_STAGE(PG8_SB(0, 0), b2, voffB); PG8_STAGE(PG8_SB(0, 1), b2 + hstep, voffB); PG8_STAGE_A(PG8_SA(0, 0), a2, 0, last);
            PG8_WAIT_V(8); PG8_WAIT_L(0); PG8_BAR; PG8_MMA(1, 0, At, B0); PG8_MMA(1, 1, At, B1); PG8_BAR; PG8_SCHED;
            PG8_LDB(B0, 1, 0); PG8_LDB(B1, 1, 1); PG8_SCHED; PG8_LDA(At, 1, 0); PG8_STAGE_A(PG8_SA(0, 1), a2, 1, last);
            PG8_WAIT_V(8); PG8_WAIT_L(0); PG8_BAR; PG8_MMA(0, 0, At, B0); PG8_MMA(0, 1, At, B1); PG8_BAR; PG8_SCHED;
            PG8_LDA(At, 1, 1); PG8_STAGE(PG8_SB(1, 0), b3, voffB); PG8_STAGE(PG8_SB(1, 1), b3 + hstep, voffB); PG8_STAGE_A(PG8_SA(1, 0), a3, 0, last);
            PG8_WAIT_V(8); PG8_WAIT_L(0); PG8_BAR; PG8_MMA(1, 0, At, B0); PG8_MMA(1, 1, At, B1); PG8_BAR; PG8_SCHED;
            } else {
            PG8_LDB(B0, 0, 0); PG8_SCHED; PG8_LDA(At, 0, 0); PG8_STAGE(PG8_SA(1, 1), a1 + hstep, voffA);
            PG8_WAIT_L(8); PG8_BAR; PG8_WAIT_L(0); PG8_MMA(0, 0, At, B0); PG8_BAR; PG8_SCHED;
            PG8_LDB(B1, 0, 1); PG8_STAGE(PG8_SB(0, 0), b2, voffB);
            PG8_BAR; PG8_WAIT_L(0); PG8_MMA(0, 1, At, B1); PG8_BAR;
            PG8_LDA(At, 0, 1); PG8_STAGE(PG8_SA(0, 0), a2, voffA);
            PG8_BAR; PG8_WAIT_L(0); PG8_MMA(1, 0, At, B0); PG8_BAR; PG8_SCHED;
            PG8_STAGE(PG8_SB(0, 1), b2 + hstep, voffB);
            PG8_WAIT_V(6); PG8_BAR; PG8_MMA(1, 1, At, B1); PG8_BAR;
            PG8_LDB(B0, 1, 0); PG8_SCHED; PG8_LDA(At, 1, 0); PG8_STAGE(PG8_SA(0, 1), a2 + hstep, voffA);
            PG8_WAIT_L(8); PG8_BAR; PG8_WAIT_L(0); PG8_MMA(0, 0, At, B0); PG8_BAR; PG8_SCHED;
            PG8_LDB(B1, 1, 1); PG8_STAGE(PG8_SB(1, 0), b3, voffB);
            PG8_BAR; PG8_WAIT_L(0); PG8_MMA(0, 1, At, B1); PG8_BAR;
            PG8_LDA(At, 1, 1); PG8_STAGE(PG8_SA(1, 0), a3, voffA);
            PG8_BAR; PG8_WAIT_L(0); PG8_MMA(1, 0, At, B0); PG8_BAR; PG8_SCHED;
            PG8_STAGE(PG8_SB(1, 1), b3 + hstep, voffB);
            PG8_WAIT_V(6); PG8_BAR; PG8_MMA(1, 1, At, B1); PG8_BAR;
            }
        }
        if constexpr (ALIGN_EPI) { if (wr == 0) PG8_BAR; }
        const int keep_ = (int)S.keep(cur);
        if constexpr (HasScale<Epi>::v) { if (keep_ == 2) E.scale(acc, cur, wr, wc, fr, fq); }
        if constexpr (!Epi::AFTER_DRAIN) { if (keep_ == 0) { E(acc, cur, wr, wc, fr, fq); S.done(cur); } }
        if (!has_next) break;
        if (keep_ == 0) {
#pragma unroll
        for (int a = 0; a < 2; ++a)
#pragma unroll
            for (int b = 0; b < 2; ++b)
#pragma unroll
                for (int m = 0; m < 4; ++m)
#pragma unroll
                    for (int n = 0; n < 2; ++n) acc[a][b][m][n] = (f32x4){0.f, 0.f, 0.f, 0.f}; }
        cur = nxt; cA = nA; cB = nB; ++ui;
        if constexpr (GATHER) { vC[0][0] = vN[0][0]; vC[0][1] = vN[0][1]; vC[1][0] = vN[1][0]; vC[1][1] = vN[1][1]; }
        if constexpr (ALIGN_EPI) { if (wr == 1) PG8_BAR; }
    }
    PG8_WAIT_V(0);
    if constexpr (!ALIGN_EPI) { if (wr == 0) PG8_BAR; }
    PG8_BAR;
    if constexpr (Epi::AFTER_DRAIN) { E.fused(acc, cur, wr, wc, fr, fq, lds, wid, lane); S.done(cur); }
#undef PG8_SA
#undef PG8_SB
#undef PG8_STAGE
#undef PG8_STAGE_A
#undef PG8_LDA
#undef PG8_LDB
#undef PG8_MMA
#undef PG8_WAIT_V
#undef PG8_WAIT_L
#undef PG8_BAR
#undef PG8_SCHED
}
typedef unsigned u32x2 __attribute__((ext_vector_type(2)));
typedef float f32x2v __attribute__((ext_vector_type(2)));
typedef __bf16 bf16x2v __attribute__((ext_vector_type(2)));
__device__ __forceinline__ unsigned pk2(float lo, float hi) { f32x2v v = {lo, hi}; bf16x2v b = __builtin_convertvector(v, bf16x2v); return __builtin_bit_cast(unsigned, b); }
__device__ __forceinline__ float bflo(unsigned w) { return __builtin_bit_cast(float, w << 16); }
__device__ __forceinline__ float bfhi(unsigned w) { return __builtin_bit_cast(float, w & 0xffff0000u); }
__device__ __forceinline__ float rstd_parts(const GAS float* base, unsigned eoff, int n4, float inv_n) {
    float s = 0.f; const GAS char* p = (const GAS char*)base + (size_t)(eoff * 4u);
    for (int i = 0; i < n4; ++i) { const f32x4 v = *(const GAS f32x4*)(p + 16 * i); s += (v[0] + v[1]) + (v[2] + v[3]); }
    return __builtin_amdgcn_rsqf(s * inv_n + 1e-6f);
}
__device__ __forceinline__ float rows4_sum(float s) {
    const unsigned u = __builtin_bit_cast(unsigned, s);
    auto r = __builtin_amdgcn_permlane16_swap(u, u, false, false);
    const float t = __builtin_bit_cast(float, (unsigned)r[0]) + __builtin_bit_cast(float, (unsigned)r[1]);
    const unsigned v = __builtin_bit_cast(unsigned, t);
    auto q = __builtin_amdgcn_permlane32_swap(v, v, false, false);
    return __builtin_bit_cast(float, (unsigned)q[0]) + __builtin_bit_cast(float, (unsigned)q[1]);
}
__device__ __forceinline__ float rstd16_coop(const GAS float* base, unsigned row, int fq, float inv_n) {
    const f32x4 v = *(const GAS f32x4*)((const GAS char*)base + (size_t)((row * 16u + (unsigned)fq * 4u) * 4u));
    return __builtin_amdgcn_rsqf(rows4_sum((v[0] + v[1]) + (v[2] + v[3])) * inv_n + 1e-6f);
}
__device__ __forceinline__ void swap16(unsigned& a, unsigned& b) { auto r = __builtin_amdgcn_permlane16_swap(a, b, false, false); a = r[0]; b = r[1]; }
__device__ __forceinline__ int swz8(int fq) { return 8 * (((fq & 1) << 1) | (fq >> 1)); }
__device__ const double kRopeRev[16] = {0.15915494309189535, 0.08949940160889101, 0.050329212104487035, 0.0283021958306234, 0.015915494309189534, 0.008949940160889102, 0.005032921210448704, 0.00283021958306234,
                                        0.0015915494309189536, 0.0008949940160889102, 0.0005032921210448703, 0.00028302195830623395, 0.00015915494309189535, 8.949940160889102e-05, 5.0329212104487035e-05, 2.8302195830623396e-05};
__device__ __forceinline__ void rope_cs(int pos, int i, float& cs, float& sn) {
    double a = (double)pos * kRopeRev[i]; a -= __builtin_floor(a);
    const float r = (float)a; sn = __builtin_amdgcn_sinf(r); cs = __builtin_amdgcn_cosf(r);
}
#define PG8_L2E 1.4426950408889634f

struct EpiA {
    static constexpr bool PERM = false, AFTER_DRAIN = false;
    const GAS float* ssq; GAS bf16_t *cq, *ckv, *krope, *qk; GAS float *ssq_cq, *ssq_ckv; float c2; GAS unsigned* kn; int skip;
    __device__ __forceinline__ void operator()(const f32x4 (&acc)[2][2][4][2], const Unit& u, int wr, int wc, int fr, int fq) const {
        if (skip) return;
        const int pn = u.pn, row0 = u.pm * BM + wr * 64 + fr;
        float rs[2][4];
#pragma unroll
        for (int ai = 0; ai < 2; ++ai)
#pragma unroll
            for (int m = 0; m < 4; ++m) rs[ai][m] = rstd16_coop(ssq, (unsigned)(row0 + ai * HALF + m * 16), fq, 1.f / 1024.f);
        if (pn < 2) {
            GAS bf16_t* dst = pn == 0 ? cq : ckv; GAS float* sq = pn == 0 ? ssq_cq : ssq_ckv;
#pragma unroll
            for (int ai = 0; ai < 2; ++ai)
#pragma unroll
                for (int m = 0; m < 4; ++m) { const int row = row0 + ai * HALF + m * 16; const float r = rs[ai][m]; float s2 = 0.f;
#pragma unroll
                    for (int bj = 0; bj < 2; ++bj) { const f32x4 v = acc[ai][bj][m][0] * r, v2 = acc[ai][bj][m][1] * r;
                        s2 += ((v[0] * v[0] + v[1] * v[1]) + (v[2] * v[2] + v[3] * v[3])) + ((v2[0] * v2[0] + v2[1] * v2[1]) + (v2[2] * v2[2] + v2[3] * v2[3]));
                        unsigned wx = pk2(v[0], v[1]), wy = pk2(v[2], v[3]), wz = pk2(v2[0], v2[1]), ww = pk2(v2[2], v2[3]); swap16(wx, wz); swap16(wy, ww); const u32x4 w = {wx, wy, wz, ww};
                        *(GAS u32x4*)(dst + (size_t)row * 256 + bj * HALF + wc * 32 + swz8(fq)) = w; }
                    s2 = rows4_sum(s2);
                    if (fq == 0) sq[(size_t)row * 4 + wc] = s2; }
        } else if (pn == 2) {
            if (wc == 0) {
#pragma unroll
                for (int ai = 0; ai < 2; ++ai)
#pragma unroll
                    for (int m = 0; m < 4; ++m) { const int row = row0 + ai * HALF + m * 16, pos = row & 8191; const float r = rs[ai][m];
                        const f32x4 v0 = acc[ai][0][m][0] * r, v1 = acc[ai][0][m][1] * r; float o0[4], o1[4];
#pragma unroll
                        for (int e = 0; e < 4; ++e) { float cs, sn; rope_cs(pos, 4 * fq + e, cs, sn); o0[e] = v0[e] * cs - v1[e] * sn; o1[e] = v0[e] * sn + v1[e] * cs; }
                        u32x2 w0, w1; w0.x = pk2(o0[0], o0[1]); w0.y = pk2(o0[2], o0[3]); w1.x = pk2(o1[0], o1[1]); w1.y = pk2(o1[2], o1[3]);
                        *(GAS u32x2*)(krope + (size_t)row * 32 + 4 * fq) = w0; *(GAS u32x2*)(krope + (size_t)row * 32 + 16 + 4 * fq) = w1; }
            }
        } else {
            const int t = pn - 3, buf = t >> 1, half = t & 1; GAS bf16_t* dst = qk + (size_t)buf * 16384 * 512; const float sc = (buf & 1) ? 1.f : c2;
#pragma unroll
            for (int ai = 0; ai < 2; ++ai)
#pragma unroll
                for (int bj = 0; bj < 2; ++bj) { float kmx = 0.f;
#pragma unroll
                    for (int m = 0; m < 4; ++m) { const int row = row0 + ai * HALF + m * 16; const float r = rs[ai][m] * sc;
                        const f32x4 v = acc[ai][bj][m][0] * r, v2 = acc[ai][bj][m][1] * r;
                        const float s2 = ((v[0] * v[0] + v[1] * v[1]) + (v[2] * v[2] + v[3] * v[3])) + ((v2[0] * v2[0] + v2[1] * v2[1]) + (v2[2] * v2[2] + v2[3] * v2[3]));
                        unsigned wx = pk2(v[0], v[1]), wy = pk2(v[2], v[3]), wz = pk2(v2[0], v2[1]), ww = pk2(v2[2], v2[3]); swap16(wx, wz); swap16(wy, ww); const u32x4 w = {wx, wy, wz, ww};
                        *(GAS u32x4*)(dst + (size_t)row * 512 + half * 256 + bj * HALF + wc * 32 + swz8(fq)) = w;
                        kmx = fmaxf(kmx, s2); }
                    if (pn >= 9) {
                        float s = kmx; const float q1 = __shfl_xor(s, 16), q2 = __shfl_xor(s, 32), q3 = __shfl_xor(q1, 32); s = (s + q1) + (q2 + q3);
                        s = fmaxf(s, __shfl_xor(s, 1)); s = fmaxf(s, __shfl_xor(s, 2)); s = fmaxf(s, __shfl_xor(s, 4)); s = fmaxf(s, __shfl_xor(s, 8));
                        if ((fr | fq) == 0) __hip_atomic_fetch_max(kn + (((size_t)(4 * u.pm + 2 * ai + wr) * 8 + 4 * (pn - 9) + 2 * bj + (wc >> 1)) * 2 + (wc & 1)), __builtin_bit_cast(unsigned, s), __ATOMIC_RELAXED, __HIP_MEMORY_SCOPE_AGENT); } }
        }
    }
};
struct EpiVT {
    static constexpr bool PERM = true, AFTER_DRAIN = false;
    GAS bf16_t* out; int ld; const GAS float* ssq; int n4; float inv_n;
    __device__ __forceinline__ void operator()(const f32x4 (&acc)[2][2][4][2], const Unit& u, int wr, int wc, int fr, int fq) const {
        const int col0 = u.pn * BM + wc * 32 + 8 * fq, row0 = u.pm * BM + wr * 64 + fr;
        float cs[2][8];
#pragma unroll
        for (int bj = 0; bj < 2; ++bj)
#pragma unroll
            for (int j = 0; j < 8; ++j) cs[bj][j] = rstd_parts(ssq, (unsigned)((col0 + bj * HALF + j) * (4 * n4)), n4, inv_n);
#pragma unroll
        for (int ai = 0; ai < 2; ++ai)
#pragma unroll
            for (int m = 0; m < 4; ++m) { GAS bf16_t* rowp = out + (size_t)(row0 + ai * HALF + m * 16) * ld + col0;
#pragma unroll
                for (int bj = 0; bj < 2; ++bj) { const f32x4 v0 = acc[ai][bj][m][0], v1 = acc[ai][bj][m][1]; u32x4 w;
                    w.x = pk2(v0[0] * cs[bj][0], v0[1] * cs[bj][1]); w.y = pk2(v0[2] * cs[bj][2], v0[3] * cs[bj][3]);
                    w.z = pk2(v1[0] * cs[bj][4], v1[1] * cs[bj][5]); w.w = pk2(v1[2] * cs[bj][6], v1[3] * cs[bj][7]);
                    *(GAS u32x4*)(rowp + bj * HALF) = w; } }
    }
};
struct EpiRS {
    static constexpr bool PERM = true, AFTER_DRAIN = false;
    GAS bf16_t* out; int ld; const GAS float* ssq; int n4; float inv_n; float scale; int pnmask; int pnshift; size_t zstride;
    __device__ __forceinline__ void operator()(const f32x4 (&acc)[2][2][4][2], const Unit& u, int wr, int wc, int fr, int fq) const {
        const int col0 = (u.pn & pnmask) * BM + wc * 32 + 8 * fq, row0 = u.pm * BM + wr * 64 + fr;
        float rr[2][4];
#pragma unroll
        for (int ai = 0; ai < 2; ++ai)
#pragma unroll
            for (int m = 0; m < 4; ++m) rr[ai][m] = (n4 ? rstd_parts(ssq, (unsigned)((row0 + ai * HALF + m * 16) * (4 * n4)), n4, inv_n) : 1.f) * scale;
#pragma unroll
        for (int ai = 0; ai < 2; ++ai)
#pragma unroll
            for (int m = 0; m < 4; ++m) { const int row = row0 + ai * HALF + m * 16; const float r = rr[ai][m];
                GAS bf16_t* rowp = out + (size_t)(u.pn >> pnshift) * zstride + (size_t)row * ld + col0;
#pragma unroll
                for (int bj = 0; bj < 2; ++bj) { const f32x4 v0 = acc[ai][bj][m][0] * r, v1 = acc[ai][bj][m][1] * r; u32x4 w;
                    w.x = pk2(v0[0], v0[1]); w.y = pk2(v0[2], v0[3]); w.z = pk2(v1[0], v1[1]); w.w = pk2(v1[2], v1[3]); *(GAS u32x4*)(rowp + bj * HALF) = w; } }
    }
};
struct EpiQ {
    static constexpr bool PERM = false, AFTER_DRAIN = false;
    GAS bf16_t* q; const GAS float* ssq_cq; float c2;
    __device__ __forceinline__ void operator()(const f32x4 (&acc)[2][2][4][2], const Unit& u, int wr, int wc, int fr, int fq) const {
        const int pn = u.pn, row0 = u.pm * BM + wr * 64 + fr;
        float rr[2][4];
#pragma unroll
        for (int ai = 0; ai < 2; ++ai)
#pragma unroll
            for (int m = 0; m < 4; ++m) rr[ai][m] = rstd_parts(ssq_cq, (unsigned)((row0 + ai * HALF + m * 16) * 4), 1, 1.f / 256.f) * c2;
#pragma unroll
        for (int ai = 0; ai < 2; ++ai)
#pragma unroll
            for (int m = 0; m < 4; ++m) { const int row = row0 + ai * HALF + m * 16; const float r = rr[ai][m];
                if (pn < 2) {
#pragma unroll
                    for (int bj = 0; bj < 2; ++bj)
#pragma unroll
                        for (int n = 0; n < 2; ++n) { const f32x4 v = acc[ai][bj][m][n] * r; u32x2 w; w.x = pk2(v[0], v[1]); w.y = pk2(v[2], v[3]);
                            *(GAS u32x2*)(q + (size_t)row * 768 + pn * 256 + bj * HALF + wc * 32 + n * 16 + fq * 4) = w; }
                } else { const int pos = row & 8191; float cs[4], sn[4];
#pragma unroll
                    for (int e = 0; e < 4; ++e) rope_cs(pos, 4 * fq + e, cs[e], sn[e]);
#pragma unroll
                    for (int bj = 0; bj < 2; ++bj) { const f32x4 v0 = acc[ai][bj][m][0] * r, v1 = acc[ai][bj][m][1] * r; float o0[4], o1[4];
#pragma unroll
                        for (int e = 0; e < 4; ++e) { o0[e] = v0[e] * cs[e] - v1[e] * sn[e]; o1[e] = v0[e] * sn[e] + v1[e] * cs[e]; }
                        u32x2 w0, w1; w0.x = pk2(o0[0], o0[1]); w0.y = pk2(o0[2], o0[3]); w1.x = pk2(o1[0], o1[1]); w1.y = pk2(o1[2], o1[3]);
                        GAS bf16_t* p = q + (size_t)row * 768 + 512 + (4 * bj + wc) * 32 + 4 * fq; *(GAS u32x2*)p = w0; *(GAS u32x2*)(p + 16) = w1; }
                } }
    }
};
struct D1Order {
    StaticOrder so; size_t dA, dB;
    __device__ __forceinline__ bool next(int i, Unit& u) const { if (i >= 9) return false; if (!so.next(0, u)) return false; u.sel = i; return true; }
    __device__ __forceinline__ void a_ready(const Unit&) const {}
    __device__ __forceinline__ void done(const Unit&) const {}
    __device__ __forceinline__ size_t a_off(const Unit& u) const { const int z = u.sel - 6; return u.sel >= 6 ? dA + (size_t)(z >> 1) * 16384 * 2048 + (size_t)(z & 1) * 1024 : (size_t)(u.sel & 1) * 1024; }
    __device__ __forceinline__ size_t b_off(const Unit& u) const { const int z = u.sel - 6; return u.sel >= 6 ? dB + (size_t)(z >> 1) * 1024 * 2048 + (size_t)(z & 1) * 1024 : (size_t)(u.sel >> 1) * 1024 * 2048 + (size_t)(u.sel & 1) * 1024; }
    __device__ __forceinline__ int keep(const Unit& u) const { return u.sel < 6 ? ((u.sel & 1) ? 0 : 1) : (u.sel < 8 ? 2 : 0); }
};
struct EpiD1 {
    static constexpr bool PERM = true, AFTER_DRAIN = false, SCALE = true;
    GAS unsigned char* g; GAS bf16_t* mb; const GAS float* ssq;
    __device__ __forceinline__ void scale(f32x4 (&acc)[2][2][4][2], const Unit& u, int wr, int wc, int fr, int fq) const {
        const unsigned toff = (unsigned)(((wr * 4 + wc) * 64 + fq * 16 + fr) * 16), tile8 = (unsigned)(u.pm * 4 + u.pn) * 8u;
        const GAS unsigned char* ga = g + (size_t)((unsigned)(u.sel - 6) * 2048u + tile8) * 8192u + toff;
        const GAS unsigned char* gb = ga + (size_t)2048 * 8192;
#pragma unroll
        for (int ai = 0; ai < 2; ++ai) {
            u32x4 wa[2][2], wb[2][2];
#pragma unroll
            for (int bj = 0; bj < 2; ++bj)
#pragma unroll
                for (int mp = 0; mp < 2; ++mp) { wa[bj][mp] = *(const GAS u32x4*)(ga + ((ai * 2 + bj) * 2 + mp) * 8192); wb[bj][mp] = *(const GAS u32x4*)(gb + ((ai * 2 + bj) * 2 + mp) * 8192); }
#pragma unroll
            for (int bj = 0; bj < 2; ++bj)
#pragma unroll
                for (int mp = 0; mp < 2; ++mp)
#pragma unroll
                    for (int k = 0; k < 4; ++k) { const int m = 2 * mp + (k >> 1), n = k & 1; const unsigned qa = wa[bj][mp][k], qb = wb[bj][mp][k];
#pragma unroll
                        for (int e2 = 0; e2 < 4; ++e2) acc[ai][bj][m][n][e2] *= ((float)((qa >> (8 * e2)) & 0xffu) + 0.5f) * __builtin_amdgcn_rcpf((float)((qb >> (8 * e2)) & 0xffu) + 0.5f); }
        }
    }
    __device__ __forceinline__ void operator()(const f32x4 (&acc)[2][2][4][2], const Unit& u, int wr, int wc, int fr, int fq) const {
        const int col0 = u.pn * BM + wc * 32 + 8 * fq, row0 = u.pm * BM + wr * 64 + fr;
        const unsigned toff = (unsigned)(((wr * 4 + wc) * 64 + fq * 16 + fr) * 16), tile8 = (unsigned)(u.pm * 4 + u.pn) * 8u;
        if (u.sel < 6) {
            GAS unsigned char* gz = g + (size_t)((unsigned)(u.sel >> 1) * 2048u + tile8) * 8192u + toff;
            float rr[2][4];
#pragma unroll
            for (int ai = 0; ai < 2; ++ai)
#pragma unroll
                for (int m = 0; m < 4; ++m) rr[ai][m] = -PG8_L2E * rstd_parts(ssq, (unsigned)((row0 + ai * HALF + m * 16) * 16), 4, 1.f / 1024.f);
#pragma unroll
            for (int ai = 0; ai < 2; ++ai)
#pragma unroll
                for (int bj = 0; bj < 2; ++bj)
#pragma unroll
                    for (int mp = 0; mp < 2; ++mp) { u32x4 w;
#pragma unroll
                        for (int k = 0; k < 4; ++k) { const int m = 2 * mp + (k >> 1), n = k & 1; const float r = rr[ai][m]; unsigned pk = 0u;
#pragma unroll
                            for (int e2 = 0; e2 < 4; ++e2) { const float sg = __builtin_amdgcn_rcpf(1.f + __builtin_amdgcn_exp2f(acc[ai][bj][m][n][e2] * r));
                                pk = __builtin_amdgcn_cvt_pk_u8_f32(sg * 256.f - 0.5f, e2, pk); }
                            w[k] = pk; }
                        *(GAS u32x4*)(gz + ((ai * 2 + bj) * 2 + mp) * 8192) = w; }
        } else {
            const GAS unsigned char* ga = g + (size_t)(2u * 2048u + tile8) * 8192u + toff;
#pragma unroll
            for (int ai = 0; ai < 2; ++ai) {
                u32x4 wa[2][2];
#pragma unroll
                for (int bj = 0; bj < 2; ++bj)
#pragma unroll
                    for (int mp = 0; mp < 2; ++mp) wa[bj][mp] = *(const GAS u32x4*)(ga + ((ai * 2 + bj) * 2 + mp) * 8192);
#pragma unroll
                for (int m = 0; m < 4; ++m)
#pragma unroll
                    for (int bj = 0; bj < 2; ++bj) { const size_t o = (size_t)(row0 + ai * HALF + m * 16) * 1024 + col0 + bj * HALF; float v[8];
#pragma unroll
                        for (int j = 0; j < 8; ++j) { const unsigned qa = wa[bj][m >> 1][(m & 1) * 2 + (j >> 2)];
                            v[j] = acc[ai][bj][m][j >> 2][j & 3] * (((float)((qa >> (8 * (j & 3))) & 0xffu) + 0.5f) * (1.f / 256.f)); }
                        u32x4 w; w.x = pk2(v[0], v[1]); w.y = pk2(v[2], v[3]); w.z = pk2(v[4], v[5]); w.w = pk2(v[6], v[7]); *(GAS u32x4*)(mb + o) = w; } }
        }
    }
};
struct EpiRes {
    static constexpr bool PERM = true, AFTER_DRAIN = false;
    GAS bf16_t* xb; GAS float* ssq;
    __device__ __forceinline__ void operator()(const f32x4 (&acc)[2][2][4][2], const Unit& u, int wr, int wc, int fr, int fq) const {
        const int col0 = u.pn * BM + wc * 32 + 8 * fq, row0 = u.pm * BM + wr * 64 + fr;
#pragma unroll
        for (int ai = 0; ai < 2; ++ai) {
            u32x4 xv[4][2];
#pragma unroll
            for (int m = 0; m < 4; ++m)
#pragma unroll
                for (int bj = 0; bj < 2; ++bj) xv[m][bj] = *(const GAS u32x4*)(xb + (size_t)(row0 + ai * HALF + m * 16) * 1024 + col0 + bj * HALF);
#pragma unroll
            for (int m = 0; m < 4; ++m) { const int row = row0 + ai * HALF + m * 16; const size_t rb = (size_t)row * 1024 + col0; float s2 = 0.f;
#pragma unroll
                for (int bj = 0; bj < 2; ++bj) { const u32x4 xw = xv[m][bj]; const f32x4 a0 = acc[ai][bj][m][0], a1 = acc[ai][bj][m][1];
                    const float v0 = bflo(xw.x) + a0[0], v1 = bfhi(xw.x) + a0[1], v2 = bflo(xw.y) + a0[2], v3 = bfhi(xw.y) + a0[3];
                    const float v4 = bflo(xw.z) + a1[0], v5 = bfhi(xw.z) + a1[1], v6 = bflo(xw.w) + a1[2], v7 = bfhi(xw.w) + a1[3];
                    u32x4 w; w.x = pk2(v0, v1); w.y = pk2(v2, v3); w.z = pk2(v4, v5); w.w = pk2(v6, v7);
                    *(GAS u32x4*)(xb + rb + bj * HALF) = w;
                    s2 += ((v0 * v0 + v1 * v1) + (v2 * v2 + v3 * v3)) + ((v4 * v4 + v5 * v5) + (v6 * v6 + v7 * v7)); }
                s2 += __shfl_xor(s2, 16); s2 += __shfl_xor(s2, 32);
                if (fq == 0) ssq[(size_t)row * 16 + u.pn * 4 + wc] = s2; } }
    }
};
struct EpiAct {
    static constexpr bool PERM = true, AFTER_DRAIN = false;
    GAS bf16_t* act; const GAS float* s_rstd; const GAS float* s_w;
    __device__ __forceinline__ void operator()(const f32x4 (&acc)[2][2][4][2], const Unit& u, int wr, int wc, int fr, int fq) const {
        const int t = u.pn & 1, row0 = u.pm * BM + wr * 64 + fr;
        const __amdgpu_buffer_rsrc_t rsrc = __builtin_amdgcn_make_buffer_rsrc((void*)act, 0, 40960 * 256 * 2, 0x00020000);
        float rr[2][4], ww[2][4];
#pragma unroll
        for (int ai = 0; ai < 2; ++ai)
#pragma unroll
            for (int m = 0; m < 4; ++m) { rr[ai][m] = s_rstd[row0 + ai * HALF + m * 16]; ww[ai][m] = s_w[row0 + ai * HALF + m * 16]; }
#pragma unroll
        for (int ai = 0; ai < 2; ++ai)
#pragma unroll
            for (int m = 0; m < 4; ++m) { const int row = row0 + ai * HALF + m * 16; const float rs = rr[ai][m], w = ww[ai][m]; float o[8];
#pragma unroll
                for (int j = 0; j < 8; ++j) { const float a = acc[ai][0][m][j >> 2][j & 3] * rs, b = acc[ai][1][m][j >> 2][j & 3] * rs;
                    const float v = a * __builtin_amdgcn_rcpf(1.f + __builtin_amdgcn_exp2f(-PG8_L2E * a)) * b * w; o[j] = (w != 0.f) ? v : 0.f; }
                u32x4 pw; pw.x = pk2(o[0], o[1]); pw.y = pk2(o[2], o[3]); pw.z = pk2(o[4], o[5]); pw.w = pk2(o[6], o[7]);
                __builtin_amdgcn_raw_buffer_store_b128(pw, rsrc, (unsigned)(row * 256 + t * 128 + wc * 32 + 8 * fq) * 2u, 0,   16); }
    }
};
struct SplitK2Order {
    StaticOrder so; size_t tstep;
    __device__ __forceinline__ bool next(int i, Unit& u) const { return so.next(i, u); }
    __device__ __forceinline__ void a_ready(const Unit&) const {}
    __device__ __forceinline__ void done(const Unit&) const {}
    __device__ __forceinline__ size_t a_off(const Unit& u) const { return (size_t)(u.pn >> 1) * 1024; }
    __device__ __forceinline__ size_t b_off(const Unit& u) const { return (size_t)(u.pn >> 1) * 1024 - (size_t)(u.pn >> 1) * 2 * tstep; }
    __device__ __forceinline__ bool keep(const Unit&) const { return false; }
};
struct MoeOrder {
    const PG8_LAS int* tstart; int per, G, v;
    __device__ __forceinline__ bool next(int i, Unit& u) const {
        const int idx = i * G + v, tot = tstart[32] * per; if (idx >= tot) return false;
        const int ti = idx / per, ct = idx - ti * per; int e = 0;
#pragma unroll 1
        for (int k = 1; k < 32; ++k) e += (tstart[k] <= ti) ? 1 : 0;
        u.pm = ti; u.pn = e * per + ct; u.sel = 0; return true;
    }
    __device__ __forceinline__ void a_ready(const Unit&) const {}
    __device__ __forceinline__ void done(const Unit&) const {}
    __device__ __forceinline__ size_t a_off(const Unit&) const { return 0; }
    __device__ __forceinline__ size_t b_off(const Unit&) const { return 0; }
    __device__ __forceinline__ bool keep(const Unit&) const { return false; }
};
struct MoeOrderP {
    const PG8_LAS int* tstart; GAS unsigned* cnt; int G, v;
    __device__ __forceinline__ bool next(int i, Unit& u) const {
        const int idx = i * G + v, tot = tstart[32] * 2; if (idx >= tot) return false;
        const int ti = idx >> 1, ct = idx & 1; int e = 0;
#pragma unroll 1
        for (int k = 1; k < 32; ++k) e += (tstart[k] <= ti) ? 1 : 0;
        u.pm = ti; u.pn = e * 2 + ct; u.sel = 0; return true;
    }
    __device__ __forceinline__ void a_ready(const Unit&) const {}
    __device__ __forceinline__ void done(const Unit& u) const {
        asm volatile("s_waitcnt vmcnt(0)" ::: "memory");
        int ln; asm volatile("v_mbcnt_lo_u32_b32 %0, -1, 0\n\tv_mbcnt_hi_u32_b32 %0, -1, %0" : "=v"(ln));
        if (ln == 0) __hip_atomic_fetch_add(cnt + u.pm, 1u, __ATOMIC_RELAXED, __HIP_MEMORY_SCOPE_AGENT);
    }
    __device__ __forceinline__ size_t a_off(const Unit&) const { return 0; }
    __device__ __forceinline__ size_t b_off(const Unit&) const { return 0; }
    __device__ __forceinline__ bool keep(const Unit&) const { return false; }
};
struct MoeOrderC {
    const PG8_LAS int* tstart; const GAS unsigned* cnt; int G, v, wid;
    __device__ __forceinline__ bool next(int i, Unit& u) const {
        const int T = tstart[32], L = (2 * T > G) ? 2 * T - G : 0, R = G - L;
        const int idx = (v >= L) ? ((i < 2) ? i * R + (v - L) : 2 * R + (i - 2) * G + v) : 2 * R + i * G + v;
        if (idx >= 4 * T) return false;
        const int ti = idx >> 2, ct = idx & 3; int e = 0;
#pragma unroll 1
        for (int k = 1; k < 32; ++k) e += (tstart[k] <= ti) ? 1 : 0;
        u.pm = ti; u.pn = e * 4 + ct; u.sel = 0; return true;
    }
    __device__ __forceinline__ void a_ready(const Unit& u) const {
        if (wid == 0) {
            const GAS unsigned* c = cnt + u.pm; int spins = 0;
#pragma unroll 1
            while ((unsigned)__builtin_amdgcn_readfirstlane(__hip_atomic_load(c, __ATOMIC_RELAXED, __HIP_MEMORY_SCOPE_AGENT)) < 16u && ++spins < (1 << 22)) __builtin_amdgcn_s_sleep(2);
            __builtin_amdgcn_fence(__ATOMIC_ACQUIRE, "agent");
            asm volatile("s_waitcnt vmcnt(0)" ::: "memory");
        }
        __builtin_amdgcn_s_barrier();
    }
    __device__ __forceinline__ void done(const Unit&) const {}
    __device__ __forceinline__ size_t a_off(const Unit&) const { return 0; }
    __device__ __forceinline__ size_t b_off(const Unit&) const { return 0; }
    __device__ __forceinline__ bool keep(const Unit&) const { return false; }
};
}
namespace att {
typedef unsigned short bf16;
typedef short bf16x8 __attribute__((ext_vector_type(8)));
typedef short s16x4 __attribute__((ext_vector_type(4)));
typedef float f32x16 __attribute__((ext_vector_type(16)));
typedef float f32x4 __attribute__((ext_vector_type(4)));
typedef unsigned u32x4 __attribute__((ext_vector_type(4)));
typedef unsigned u32x2 __attribute__((ext_vector_type(2)));
typedef float f32x2v __attribute__((ext_vector_type(2)));
typedef __bf16 bf16x2v __attribute__((ext_vector_type(2)));
__device__ __forceinline__ unsigned pk2(float lo, float hi) { f32x2v v = {lo, hi}; bf16x2v b = __builtin_convertvector(v, bf16x2v); return __builtin_bit_cast(unsigned, b); }
__device__ __forceinline__ float bflo(unsigned w) { return __builtin_bit_cast(float, w << 16); }
__device__ __forceinline__ float bfhi(unsigned w) { return __builtin_bit_cast(float, w & 0xffff0000u); }
__device__ __forceinline__ int crow(int r, int hi) { return (r & 3) + 8 * (r >> 2) + 4 * hi; }
__device__ __forceinline__ float xhalf(float v) {
    const unsigned u = __builtin_bit_cast(unsigned, v);
    auto rr = __builtin_amdgcn_permlane32_swap(u, u, false, false);
    const unsigned o = (rr[0] != u) ? rr[0] : rr[1];
    return __builtin_bit_cast(float, o);
}
__device__ __forceinline__ bf16x8 mk8(unsigned a, unsigned b, unsigned c, unsigned d) { u32x4 w = {a, b, c, d}; return __builtin_bit_cast(bf16x8, w); }

constexpr int VPB = 144;
template <int DK> struct KLay { static constexpr int KPB = (DK + 8) * 2, KBUF = 64 * KPB; };

template <int DK, int DV, bool KROPE> struct Stage {
    static constexpr int NK = KROPE ? 1 : DK / 64, NV = DV / 64;
    u32x4 kr[NK]; u32x4 kr2; u32x4 vr[NV];
    __device__ __forceinline__ void loadK(int tid, const GAS bf16* Kg, int ldk, const GAS bf16* K2g, int kv0) {
        const GAS char* kbase = (const GAS char*)(Kg + (size_t)kv0 * ldk);
        if constexpr (KROPE) {
            kr[0] = *(const GAS u32x4*)(kbase + (unsigned)(((tid >> 3) * ldk + 8 * (tid & 7)) * 2));
            if (tid < 256) kr2 = *(const GAS u32x4*)((const GAS char*)(K2g + (size_t)kv0 * 32) + (unsigned)(tid * 16));
        } else {
#pragma unroll
            for (int i = 0; i < NK; ++i) { const int p = tid + 512 * i, row = p / (DK / 8), ch = p % (DK / 8); kr[i] = *(const GAS u32x4*)(kbase + (unsigned)((row * ldk + 8 * ch) * 2)); }
        }
    }
    __device__ __forceinline__ void loadV(int tid, const GAS bf16* Vg, int ldv, int kv0) {
        const GAS char* vbase = (const GAS char*)(Vg + kv0);
#pragma unroll
        for (int i = 0; i < NV; ++i) { const int p = tid + 512 * i, dd = p >> 3, ch = p & 7; vr[i] = *(const GAS u32x4*)(vbase + (unsigned)((dd * ldv + 8 * ch) * 2)); }
    }
    __device__ __forceinline__ void storeK(int tid, LAS unsigned char* kb) const {
        constexpr int KPB = KLay<DK>::KPB;
        if constexpr (KROPE) {
            *(LAS u32x4*)(kb + (tid >> 3) * KPB + 16 * (tid & 7)) = kr[0];
            if (tid < 256) *(LAS u32x4*)(kb + (tid >> 2) * KPB + 128 + 16 * (tid & 3)) = kr2;
        } else {
#pragma unroll
            for (int i = 0; i < NK; ++i) { const int p = tid + 512 * i, row = p / (DK / 8), ch = p % (DK / 8); *(LAS u32x4*)(kb + row * KPB + 16 * ch) = kr[i]; }
        }
    }
    __device__ __forceinline__ void storeV(int tid, LAS unsigned char* vb) const {
#pragma unroll
        for (int i = 0; i < NV; ++i) { const int p = tid + 512 * i, dd = p >> 3, ch = p & 7; LAS unsigned char* q = vb + dd * VPB + 32 * (ch >> 1) + 8 * (ch & 1);
            *(LAS u32x2*)q = (u32x2){vr[i].x, vr[i].y}; *(LAS u32x2*)(q + 16) = (u32x2){vr[i].z, vr[i].w}; }
    }
    __device__ __forceinline__ void load(int tid, const GAS bf16* Kg, int ldk, const GAS bf16* K2g, const GAS bf16* Vg, int ldv, int kv0) { loadK(tid, Kg, ldk, K2g, kv0); loadV(tid, Vg, ldv, kv0); }
    __device__ __forceinline__ void store(int tid, LAS unsigned char* kb, LAS unsigned char* vb) const { storeK(tid, kb); storeV(tid, vb); }
};

template <int DK> __device__ __forceinline__ void qkt(f32x16& p0, f32x16& p1, const LAS unsigned char* kb, const bf16x8 (&qf)[DK / 16], int r32, int hi) {
    constexpr int KPB = KLay<DK>::KPB;
    const LAS unsigned char* k0 = kb + r32 * KPB + hi * 16;
#pragma unroll
    for (int d0 = 0; d0 < DK / 16; ++d0) {
        const bf16x8 a0 = *(const LAS bf16x8*)(k0 + d0 * 32), a1 = *(const LAS bf16x8*)(k0 + 32 * KPB + d0 * 32);
        p0 = __builtin_amdgcn_mfma_f32_32x32x16_bf16(a0, qf[d0], p0, 0, 0, 0);
        p1 = __builtin_amdgcn_mfma_f32_32x32x16_bf16(a1, qf[d0], p1, 0, 0, 0);
    }
}
template <int DK> __device__ __forceinline__ void qkt_qmem(f32x16& p0, f32x16& p1, const LAS unsigned char* kb, const bf16x8* qf, const LAS unsigned char* qlds, int r32, int hi) {
    constexpr int KPB = KLay<DK>::KPB, QR = DK / 32;
    const LAS unsigned char* k0 = kb + r32 * KPB + hi * 16;
#pragma unroll
    for (int d0 = 0; d0 < DK / 16; ++d0) {
        bf16x8 q; if (d0 < QR) q = qf[d0]; else q = *(const LAS bf16x8*)(qlds + (d0 - QR) * 1024);
        const bf16x8 a0 = *(const LAS bf16x8*)(k0 + d0 * 32), a1 = *(const LAS bf16x8*)(k0 + 32 * KPB + d0 * 32);
        p0 = __builtin_amdgcn_mfma_f32_32x32x16_bf16(a0, q, p0, 0, 0, 0);
        p1 = __builtin_amdgcn_mfma_f32_32x32x16_bf16(a1, q, p1, 0, 0, 0);
        if ((d0 & 3) == 3) __builtin_amdgcn_sched_barrier(0);
    }
}
template <int DV> __device__ __forceinline__ void pv(f32x16 (&o)[DV / 32], const LAS unsigned char* vb, const bf16x8 (&pf)[4], int r32, int hi) {
#pragma unroll
    for (int db = 0; db < DV / 32; ++db) {
        const LAS unsigned char* v0 = vb + (32 * db + r32) * VPB + 16 * hi;
#pragma unroll
        for (int s = 0; s < 4; ++s) {
            const bf16x8 vf = *(const LAS bf16x8*)(v0 + 32 * s);
            o[db] = __builtin_amdgcn_mfma_f32_32x32x16_bf16(vf, pf[s], o[db], 0, 0, 0);
        }
        if (DV > 64) __builtin_amdgcn_sched_barrier(0);
    }
}
__device__ __forceinline__ void pack_p(bf16x8 (&pf)[4], const f32x16& p0, const f32x16& p1) {
    pf[0] = mk8(pk2(p0[0], p0[1]), pk2(p0[2], p0[3]), pk2(p0[4], p0[5]), pk2(p0[6], p0[7]));
    pf[1] = mk8(pk2(p0[8], p0[9]), pk2(p0[10], p0[11]), pk2(p0[12], p0[13]), pk2(p0[14], p0[15]));
    pf[2] = mk8(pk2(p1[0], p1[1]), pk2(p1[2], p1[3]), pk2(p1[4], p1[5]), pk2(p1[6], p1[7]));
    pf[3] = mk8(pk2(p1[8], p1[9]), pk2(p1[10], p1[11]), pk2(p1[12], p1[13]), pk2(p1[14], p1[15]));
}

template <bool ALIBI> __device__ __forceinline__ void fl_init(f32x16& p0, f32x16& p1, float slope2, int kv0, int hi, int qrow) {
    if (ALIBI) {
        const float s2 = slope2 + slope2, s4 = s2 + s2, s8 = s4 + s4, s32 = (s8 + s8) + (s8 + s8);
        float g = slope2 * (float)(kv0 + 4 * hi - qrow);
#pragma unroll
        for (int c = 0; c < 4; ++c) { float v = g;
#pragma unroll
            for (int e = 0; e < 4; ++e) { p0[4 * c + e] = v; p1[4 * c + e] = v + s32; v += slope2; }
            g += s8; } }
    else {
#pragma unroll
        for (int r = 0; r < 16; ++r) { p0[r] = 0.f; p1[r] = 0.f; } }
}
__device__ __forceinline__ void fl_mask(f32x16& p0, f32x16& p1, int kv0, int hi, int qrow) {
    const int thr = qrow - kv0 - 4 * hi;
#pragma unroll
    for (int r = 0; r < 16; ++r) { const int c = (r & 3) + 8 * (r >> 2); if (c > thr) p0[r] = -INFINITY; if (c + 32 > thr) p1[r] = -INFINITY; }
}
__device__ __forceinline__ void fl_start(const f32x16& p0, const f32x16& p1, float& m, float& alpha) {
    float mx = fmaxf(p0[0], p1[0]);
#pragma unroll
    for (int r = 1; r < 16; ++r) mx = fmaxf(fmaxf(mx, p0[r]), p1[r]);
    mx = fmaxf(mx, xhalf(mx));
    const float mn = fmaxf(m, mx); alpha = __builtin_amdgcn_exp2f(m - mn); m = mn;
}
__device__ __forceinline__ void fl_finish(f32x16& p0, f32x16& p1, float m, float& l, bf16x8 (&pf)[4]) {
    float s0 = 0.f, s1 = 0.f;
#pragma unroll
    for (int r = 0; r < 16; ++r) { p0[r] = __builtin_amdgcn_exp2f(p0[r] - m); p1[r] = __builtin_amdgcn_exp2f(p1[r] - m); s0 += p0[r]; s1 += p1[r]; }
    l += s0 + s1;
    pack_p(pf, p0, p1);
}

#define FL_EL(P0, P1, e) ((e) < 16 ? P0[(e) & 15] : P1[(e) & 15])
template <int DK, bool QMEM> __device__ __forceinline__ void fl_blockX(f32x16& n0, f32x16& n1, const LAS unsigned char* kb, const bf16x8* qf, const LAS unsigned char* qlds, int r32, int hi,
                                                                         f32x16& c0, f32x16& c1, float m, float& l, bf16x8 (&pf)[4]) {
    constexpr int KPB = KLay<DK>::KPB, NS = DK / 16, CH = ((32 + NS - 1) / NS + 1) & ~1;
    const LAS unsigned char* k0 = kb + r32 * KPB + hi * 16;
    float s0 = 0.f, s1 = 0.f; unsigned pw[16];
#define FLX_K0(s) (*(const LAS bf16x8*)(k0 + ((s) < NS ? (s) : NS - 1) * 32))
#define FLX_K1(s) (*(const LAS bf16x8*)(k0 + 32 * KPB + ((s) < NS ? (s) : NS - 1) * 32))
    bf16x8 a0 = FLX_K0(0), a1 = FLX_K1(0), b0 = FLX_K0(1), b1 = FLX_K1(1), e0 = FLX_K0(2), e1 = FLX_K1(2);
    bf16x8 q, qb, qe; if constexpr (QMEM) { q = *(const LAS bf16x8*)(qlds); qb = *(const LAS bf16x8*)(qlds + (NS > 1 ? 1024 : 0)); qe = *(const LAS bf16x8*)(qlds + (NS > 2 ? 2048 : 0)); } else { q = qf[0]; qb = qf[NS > 1 ? 1 : 0]; qe = qf[NS > 2 ? 2 : 0]; }
#pragma unroll
    for (int d0 = 0; d0 < NS; ++d0) {
        bf16x8 c0n = e0, c1n = e1, qc = qe;
        if (d0 + 3 < NS) { c0n = FLX_K0(d0 + 3); c1n = FLX_K1(d0 + 3);
            if constexpr (QMEM) qc = *(const LAS bf16x8*)(qlds + (d0 + 3) * 1024); else qc = qf[d0 + 3]; }
        n0 = __builtin_amdgcn_mfma_f32_32x32x16_bf16(a0, q, n0, 0, 0, 0);
        n1 = __builtin_amdgcn_mfma_f32_32x32x16_bf16(a1, q, n1, 0, 0, 0);
#pragma unroll
        for (int e = d0 * CH; e < (d0 + 1) * CH && e < 32; e += 2) {
            float x, y;
            if (e < 16) { x = __builtin_amdgcn_exp2f(c0[e] - m); y = __builtin_amdgcn_exp2f(c0[e + 1] - m); s0 += x; s1 += y; }
            else { x = __builtin_amdgcn_exp2f(c1[e - 16] - m); y = __builtin_amdgcn_exp2f(c1[e - 15] - m); s0 += x; s1 += y; }
            pw[e >> 1] = pk2(x, y); asm volatile("" : "+v"(pw[e >> 1])); }
        asm volatile("" : "+v"(s0), "+v"(s1));
        __builtin_amdgcn_sched_barrier(0);
        a0 = b0; a1 = b1; q = qb; b0 = e0; b1 = e1; qb = qe; e0 = c0n; e1 = c1n; qe = qc;
    }
#undef FLX_K0
#undef FLX_K1
    l += s0 + s1;
    pf[0] = mk8(pw[0], pw[1], pw[2], pw[3]); pf[1] = mk8(pw[4], pw[5], pw[6], pw[7]); pf[2] = mk8(pw[8], pw[9], pw[10], pw[11]); pf[3] = mk8(pw[12], pw[13], pw[14], pw[15]);
}
template <int DV> __device__ __forceinline__ void fl_blockY(f32x16 (&o)[DV / 32], const LAS unsigned char* vb, const bf16x8 (&pf)[4], int r32, int hi, const f32x16& n0, const f32x16& n1, float& m, float& alpha) {
    constexpr int NS = DV / 8, CH = 32 / NS;
    float mx0 = -INFINITY, mx1 = -INFINITY;
    const LAS unsigned char* v0 = vb + r32 * VPB + 16 * hi;
    bf16x8 vf = *(const LAS bf16x8*)(v0), vg = *(const LAS bf16x8*)(v0 + 32);
#pragma unroll
    for (int st = 0; st < NS; ++st) {
        const int db = st >> 2, s = st & 3;
        bf16x8 vn = vg;
        if (st + 2 < NS) vn = *(const LAS bf16x8*)(v0 + ((st + 2) >> 2) * 32 * VPB + 32 * ((st + 2) & 3));
        o[db] = __builtin_amdgcn_mfma_f32_32x32x16_bf16(vf, pf[s], o[db], 0, 0, 0);
#pragma unroll
        for (int e = st * CH; e < (st + 1) * CH; ++e) { if (e < 16) mx0 = fmaxf(mx0, n0[e]); else mx1 = fmaxf(mx1, n1[e - 16]); }
        asm volatile("" : "+v"(mx0), "+v"(mx1));
        __builtin_amdgcn_sched_barrier(0);
        vf = vg; vg = vn;
    }
    float mx = fmaxf(mx0, mx1); mx = fmaxf(mx, xhalf(mx));
    const float mn = fmaxf(m, mx); alpha = __builtin_amdgcn_exp2f(m - mn); m = mn;
}

template <int DK, int DV, bool CAUSAL, bool ALIBI, bool KROPE, bool QMEM = false, bool DESC = false>
__device__ __forceinline__ void flash_pass(LAS unsigned char* lds, int tid, const GAS bf16* Qrow, const GAS bf16* Qrow2, const GAS bf16* Kg, int ldk, const GAS bf16* K2g, const GAS bf16* Vg, int ldv,
                                           int NT, int ntw, int qrow, float slope2, f32x16 (&o)[DV / 32], float& lsum, const GAS unsigned* kn = nullptr, int abl = 0) {
    constexpr int KBUF = KLay<DK>::KBUF, VBUF = DV * VPB, QOFF = 2 * KBUF + 2 * VBUF, XOFF = QOFF + 8 * (DK / 16) * 1024;
    constexpr bool CUT = DESC && ALIBI;
    const int lane = tid & 63, r32 = lane & 31, hi = lane >> 5, wid = tid >> 6;
#define FL_TI(i) (DESC ? NT - 1 - (i) : (i))
    bf16x8 qf[QMEM ? 1 : DK / 16];
    LAS unsigned char* qlds = lds + QOFF + wid * (DK / 16) * 1024 + lane * 16;
    float qn2 = 0.f;
#pragma unroll
    for (int d0 = 0; d0 < DK / 16; ++d0) {
        bf16x8 v;
        if (KROPE && d0 >= 4) v = *(const GAS bf16x8*)(Qrow2 + 16 * (d0 - 4) + 8 * hi);
        else v = *(const GAS bf16x8*)(Qrow + 16 * d0 + 8 * hi);
        if constexpr (CUT) {
#pragma unroll
            for (int j = 0; j < 8; ++j) { const float f = __builtin_bit_cast(float, (unsigned)(unsigned short)v[j] << 16); qn2 += f * f; } }
        if constexpr (QMEM) *(LAS bf16x8*)(qlds + d0 * 1024) = v; else qf[d0] = v;
    }
    volatile LAS float* kpre = (volatile LAS float*)(lds + XOFF);
    volatile LAS unsigned* dflag = (volatile LAS unsigned*)(lds + XOFF + 512);
    float qn = 0.f;
    if constexpr (CUT) {
        qn2 += xhalf(qn2); qn = sqrtf(qn2);
        if (wid == 0) {
            float v0 = 0.f, v1 = 0.f;
            if (lane < NT) v0 = sqrtf(__builtin_bit_cast(float, kn[(size_t)lane * 16]) + __builtin_bit_cast(float, kn[(size_t)lane * 16 + 1])) * 1.01f;
            if (lane + 64 < NT) v1 = sqrtf(__builtin_bit_cast(float, kn[(size_t)(lane + 64) * 16]) + __builtin_bit_cast(float, kn[(size_t)(lane + 64) * 16 + 1])) * 1.01f;
#pragma unroll
            for (int dd = 1; dd < 64; dd <<= 1) { const float u0 = __shfl_up(v0, dd), u1 = __shfl_up(v1, dd); if (lane >= dd) { v0 = fmaxf(v0, u0); v1 = fmaxf(v1, u1); } }
            v1 = fmaxf(v1, __shfl(v0, 63));
            kpre[lane] = v0; kpre[lane + 64] = v1;
        }
    }
#pragma unroll
    for (int db = 0; db < DV / 32; ++db)
#pragma unroll
        for (int r = 0; r < 16; ++r) o[db][r] = 0.f;
    float m = -INFINITY, l = 0.f, alpha = 1.0f;
    int cut = NT;
    Stage<DK, DV, KROPE> st;
    st.loadK(tid, Kg, ldk, K2g, 64 * FL_TI(0)); st.loadV(tid, Vg, ldv, 64 * FL_TI(0));
    st.storeK(tid, lds); st.storeV(tid, lds + 2 * KBUF);
    if (NT > 1) { st.loadK(tid, Kg, ldk, K2g, 64 * FL_TI(1)); st.storeK(tid, lds + KBUF); }
    __syncthreads();
    if (NT > 2) st.loadK(tid, Kg, ldk, K2g, 64 * FL_TI(2));
    if (NT > 1) st.loadV(tid, Vg, ldv, 64 * FL_TI(1));
    f32x16 pa0, pa1, pb0, pb1;
#define FL_QKT(P0, P1, KB) do { if constexpr (QMEM) { bf16x8 qt_[DK / 16]; _Pragma("unroll") for (int d0 = 0; d0 < DK / 16; ++d0) qt_[d0] = *(const LAS bf16x8*)(qlds + d0 * 1024); qkt<DK>(P0, P1, KB, qt_, r32, hi); } else qkt<DK>(P0, P1, KB, qf, r32, hi); } while (0)
#define FL_FIRST(P0, P1, KB, TILE) do { const int kv_ = 64 * (TILE); fl_init<ALIBI>(P0, P1, slope2, kv_, hi, qrow); FL_QKT(P0, P1, KB); \
        if (CAUSAL && kv_ + 63 > qrow - r32) fl_mask(P0, P1, kv_, hi, qrow); fl_start(P0, P1, m, alpha); } while (0)
    if (FL_TI(0) < ntw) FL_FIRST(pa0, pa1, lds, FL_TI(0));
    __syncthreads();
    for (int i = 0; i < NT; ++i) {
        int tq_ = tid; asm volatile("" : "+v"(tq_));
        if (!(abl & 1)) {
            if (i + 2 < NT) st.storeK(tq_, lds + (i & 1) * KBUF);
            if (i + 1 < NT) st.storeV(tq_, lds + 2 * KBUF + ((i + 1) & 1) * VBUF);
            if (i + 3 < NT) st.loadK(tq_, Kg, ldk, K2g, 64 * FL_TI(i + 3));
            if (i + 2 < NT) st.loadV(tq_, Vg, ldv, 64 * FL_TI(i + 2)); }
        const int tc = FL_TI(i), tn = FL_TI(i + 1);
        const bool ac = tc < ntw && i < cut && !(abl & 2);
        bool an = i + 1 < NT && tn < ntw && i + 1 < cut && !(abl & 2);
        if constexpr (CUT) {
            if (ac && an) {
                const bool dead = qn * kpre[tn] + slope2 * (float)(64 * tn + 63 - qrow) < m - 64.f;
                if (__all(dead)) { cut = i + 1; an = false; } } }
        const LAS unsigned char* kn_ = lds + ((i + 1) & 1) * KBUF; const LAS unsigned char* vc_ = lds + 2 * KBUF + (i & 1) * VBUF;
        if (ac) {
            l *= alpha;
            if (__any(alpha != 1.0f)) {
#pragma unroll
                for (int db = 0; db < DV / 32; ++db) asm volatile("" : "+v"(o[db]));
#pragma unroll
                for (int db = 0; db < DV / 32; ++db)
#pragma unroll
                    for (int r = 0; r < 16; ++r) o[db][r] *= alpha;
#pragma unroll
                for (int db = 0; db < DV / 32; ++db) asm volatile("" : "+v"(o[db])); }
            bf16x8 pf[4];
            if (an) {
                const int kv1_ = 64 * tn;
                const bool diag_ = CAUSAL && (kv1_ + 63 > qrow - r32);
                fl_init<ALIBI>(pb0, pb1, slope2, kv1_, hi, qrow);
                fl_blockX<DK, QMEM>(pb0, pb1, kn_, qf, qlds, r32, hi, pa0, pa1, m, l, pf);
                if (!diag_) { fl_blockY<DV>(o, vc_, pf, r32, hi, pb0, pb1, m, alpha); }
                else { pv<DV>(o, vc_, pf, r32, hi); fl_mask(pb0, pb1, kv1_, hi, qrow); fl_start(pb0, pb1, m, alpha); }
            } else {
                fl_finish(pa0, pa1, m, l, pf); pv<DV>(o, vc_, pf, r32, hi);
            }
        } else if (an) { FL_FIRST(pb0, pb1, kn_, tn); }
        if constexpr (CUT) { if (lane == 0) dflag[(i & 1) * 8 + wid] = (i + 1 >= cut) ? 1u : 0u; }
        if (!(abl & 4)) __syncthreads();
        if constexpr (CUT) { unsigned alld = 1u;
#pragma unroll
            for (int w = 0; w < 8; ++w) alld &= dflag[(i & 1) * 8 + w];
            if (alld) break; }
        if (!(abl & 8)) { pa0 = pb0; pa1 = pb1; }
    }
#undef FL_FIRST
#undef FL_QKT
#undef FL_TI
    lsum = l + xhalf(l);
}

template <int DK, int DV, bool CAUSAL, bool ALIBI, bool KROPE, bool QMEM = false>
__device__ __forceinline__ void flash_pass_simple(LAS unsigned char* lds, int tid, const GAS bf16* Qrow, const GAS bf16* Qrow2, const GAS bf16* Kg, int ldk, const GAS bf16* K2g, const GAS bf16* Vg, int ldv,
                                           int NT, int ntw, int qrow, float slope2, f32x16 (&o)[DV / 32], float& lsum) {
    constexpr int KBUF = KLay<DK>::KBUF, VBUF = DV * VPB;
    const int lane = tid & 63, r32 = lane & 31, hi = lane >> 5;
    constexpr int QR = QMEM ? DK / 32 : DK / 16;
    bf16x8 qf[QR];
    LAS unsigned char* qlds = lds + 2 * KBUF + 2 * VBUF + (tid >> 6) * (DK / 16 - QR + 1) * 1024 + lane * 16;
#pragma unroll
    for (int d0 = 0; d0 < DK / 16; ++d0) {
        bf16x8 v;
        if (KROPE && d0 >= 4) v = *(const GAS bf16x8*)(Qrow2 + 16 * (d0 - 4) + 8 * hi);
        else v = *(const GAS bf16x8*)(Qrow + 16 * d0 + 8 * hi);
        if constexpr (!KROPE && QMEM) {
            const bf16x8 w2 = *(const GAS bf16x8*)(Qrow2 + 16 * d0 + 8 * hi); const u32x4 a4 = __builtin_bit_cast(u32x4, v), b4 = __builtin_bit_cast(u32x4, w2); u32x4 r4;
            r4.x = pk2(bflo(a4.x) + bflo(b4.x), bfhi(a4.x) + bfhi(b4.x)); r4.y = pk2(bflo(a4.y) + bflo(b4.y), bfhi(a4.y) + bfhi(b4.y));
            r4.z = pk2(bflo(a4.z) + bflo(b4.z), bfhi(a4.z) + bfhi(b4.z)); r4.w = pk2(bflo(a4.w) + bflo(b4.w), bfhi(a4.w) + bfhi(b4.w)); v = __builtin_bit_cast(bf16x8, r4); }
        if (d0 < QR) qf[d0] = v; else *(LAS bf16x8*)(qlds + (d0 - QR) * 1024) = v;
    }
#pragma unroll
    for (int db = 0; db < DV / 32; ++db)
#pragma unroll
        for (int r = 0; r < 16; ++r) o[db][r] = 0.f;
    float m = -INFINITY, l = 0.f;
    Stage<DK, DV, KROPE> st;
    st.load(tid, Kg, ldk, K2g, Vg, ldv, 0);
    st.store(tid, lds, lds + 2 * KBUF);
    __syncthreads();
    for (int t = 0; t < NT; ++t) {
        const int cur = t & 1, kv0 = 64 * t;
        if (t + 1 < NT) st.load(tid, Kg, ldk, K2g, Vg, ldv, kv0 + 64);
        if (t < ntw) {
            const LAS unsigned char* kb = lds + cur * KBUF; const LAS unsigned char* vb = lds + 2 * KBUF + cur * VBUF;
            f32x16 p0, p1;
            if (ALIBI) { const float base = slope2 * (float)(kv0 + 4 * hi - qrow);
#pragma unroll
                for (int r = 0; r < 16; ++r) { p0[r] = __builtin_fmaf(slope2, (float)((r & 3) + 8 * (r >> 2)), base); p1[r] = __builtin_fmaf(slope2, (float)(32 + (r & 3) + 8 * (r >> 2)), base); } }
            else {
#pragma unroll
                for (int r = 0; r < 16; ++r) { p0[r] = 0.f; p1[r] = 0.f; } }
            if constexpr (QMEM) qkt_qmem<DK>(p0, p1, kb, qf, qlds, r32, hi); else qkt<DK>(p0, p1, kb, qf, r32, hi);
            if (CAUSAL && kv0 + 63 > qrow - r32) {
#pragma unroll
                for (int r = 0; r < 16; ++r) { const int kv = kv0 + crow(r, hi); if (kv > qrow) p0[r] = -INFINITY; if (kv + 32 > qrow) p1[r] = -INFINITY; } }
            float mx = p0[0];
#pragma unroll
            for (int r = 1; r < 16; ++r) mx = fmaxf(mx, p0[r]);
#pragma unroll
            for (int r = 0; r < 16; ++r) mx = fmaxf(mx, p1[r]);
            mx = fmaxf(mx, xhalf(mx));
            const float mn = fmaxf(m, mx), alpha = __builtin_amdgcn_exp2f(m - mn); m = mn;
            l *= alpha;
            if (__any(alpha != 1.0f)) {
#pragma unroll
                for (int db = 0; db < DV / 32; ++db)
#pragma unroll
                    for (int r = 0; r < 16; ++r) o[db][r] *= alpha; }
            float s = 0.f;
#pragma unroll
            for (int r = 0; r < 16; ++r) { p0[r] = __builtin_amdgcn_exp2f(p0[r] - mn); p1[r] = __builtin_amdgcn_exp2f(p1[r] - mn); s += p0[r] + p1[r]; }
            l += s;
            bf16x8 pf[4]; pack_p(pf, p0, p1);
            pv<DV>(o, vb, pf, r32, hi);
        }
        if (t + 1 < NT) st.store(tid, lds + (cur ^ 1) * KBUF, lds + 2 * KBUF + (cur ^ 1) * VBUF);
        __syncthreads();
    }
    lsum = l + xhalf(l);
}


template <int DV> __device__ __forceinline__ void store_o(GAS bf16* Orow, const f32x16 (&o)[DV / 32], float sc, int hi) {
#pragma unroll
    for (int db = 0; db < DV / 32; ++db)
#pragma unroll
        for (int c = 0; c < 4; ++c) { u32x2 w; w.x = pk2(o[db][4 * c] * sc, o[db][4 * c + 1] * sc); w.y = pk2(o[db][4 * c + 2] * sc, o[db][4 * c + 3] * sc);
            *(GAS u32x2*)(Orow + 32 * db + 8 * c + 4 * hi) = w; }
}

__device__ __forceinline__ void mla_unit(LAS unsigned char* lds, int tid, int b, int h, int q0, const GAS bf16* qmla, const GAS bf16* knope, const GAS bf16* krope, const GAS bf16* vT, GAS bf16* out, int abl) {
    const int lane = tid & 63, wid = tid >> 6, r32 = lane & 31, hi = lane >> 5;
    const size_t tb = (size_t)b * 8192; const int qrow = q0 + 32 * wid + r32;
    const GAS bf16* Qr = qmla + (tb + qrow) * 768;
    f32x16 o[2]; float l;
    flash_pass<96, 64, true, false, true>(lds, tid, Qr + h * 64, Qr + 512 + h * 32, knope + tb * 512 + h * 64, 512, krope + tb * 32, vT + (size_t)(h * 64) * 16384 + tb, 16384,
                                          q0 / 64 + 4, (q0 + 32 * wid + 31) / 64 + 1, qrow, 0.f, o, l, nullptr, abl);
    if (abl == 0 || l == 12345.678f) store_o<64>(out + (tb + qrow) * 1024 + h * 64, o, 1.0f / l, hi);
}
__device__ __forceinline__ void cross_unit(LAS unsigned char* lds, int tid, int b, int h, int q0, const GAS bf16* qx, const GAS bf16* xk, const GAS bf16* xvT, GAS bf16* out) {
    const int lane = tid & 63, wid = tid >> 6, r32 = lane & 31, hi = lane >> 5;
    const size_t tb = (size_t)b * 8192; const int qrow = q0 + 32 * wid + r32;
    f32x16 o[4]; float l;
    int nt = 4; asm volatile("" : "+s"(nt));
    flash_pass_simple<128, 128, false, false, false, true>(lds, tid, qx + (tb + qrow) * 512 + h * 128, qx + (size_t)16384 * 512 + (tb + qrow) * 512 + h * 128, xk + (size_t)(b * 256) * 512 + h * 128, 512, nullptr, xvT + (size_t)(h * 128) * 512 + b * 256, 512,
                                              nt, nt, qrow, 0.f, o, l);
    store_o<128>(out + (tb + qrow) * 512 + h * 128, o, 1.0f / l, hi);
}
__device__ __forceinline__ void diff_unit(LAS unsigned char* lds, int tid, int b, int h, int hf, int q0, const GAS bf16* dq, const GAS bf16* dk, const GAS bf16* vT, GAS bf16* out, int ldo, const GAS unsigned* knl, int abl) {
    const int lane = tid & 63, wid = tid >> 6, r32 = lane & 31, hi = lane >> 5;
    const size_t tb = (size_t)b * 8192; const int qrow = q0 + 32 * wid + r32;
    const float slope2 = __builtin_amdgcn_exp2f(-2.0f * (float)(h + 1)) * 1.4426950408889634f;
    const int NT = q0 / 64 + 4, ntw = (q0 + 32 * wid + 31) / 64 + 1;
    f32x16 o[4]; float l;
    flash_pass<64, 128, true, true, false, true, true>(lds, tid, dq + (tb + qrow) * 512 + h * 128 + hf * 64, nullptr, dk + tb * 512 + h * 128 + hf * 64, 512, nullptr, vT + (size_t)(512 + h * 128) * 16384 + tb, 16384,
                                                      NT, ntw, qrow, slope2, o, l, knl + ((size_t)(b * 128) * 8 + 2 * h + hf) * 2, abl);
    if (abl == 0 || l == 12345.678f) store_o<128>(out + (tb + qrow) * (size_t)ldo + h * 128, o, 1.0f / l, hi);
}
__device__ __forceinline__ void diff_lambda(const GAS float* lp, int layer, float& lam, float& post) {
    float q1 = 0.f, q2 = 0.f;
    for (int i = 0; i < 64; ++i) { q1 += lp[i] * lp[64 + i]; q2 += lp[128 + i] * lp[192 + i]; }
    const float lam_init = (layer == 0) ? 0.2f : 0.35550906759f;
    lam = expf(q1) - expf(q2) + lam_init; post = 1.f - lam_init;
}
__device__ __forceinline__ void diff_combine4(int item0, int stride, int lane, GAS bf16* o0, const GAS bf16* o1, float lam, float post, const GAS float* subln) {
    unsigned a[4], c[4]; size_t off[4];
#pragma unroll
    for (int k = 0; k < 4; ++k) { const int item = item0 + k * stride; off[k] = (size_t)(item >> 2) * 1024 + (item & 3) * 128 + 2 * lane;
        a[k] = *(const GAS unsigned*)(o0 + off[k]); c[k] = *(const GAS unsigned*)(o1 + (size_t)item * 128 + 2 * lane); }
    const f32x2v g = *(const GAS f32x2v*)(subln + 2 * lane);
#pragma unroll
    for (int k = 0; k < 4; ++k) {
        const float x = bflo(a[k]) - lam * bflo(c[k]), y = bfhi(a[k]) - lam * bfhi(c[k]);
        float s2 = x * x + y * y;
#pragma unroll
        for (int dd = 1; dd < 64; dd <<= 1) s2 += __shfl_xor(s2, dd);
        const float rs = __builtin_amdgcn_rsqf(s2 * (1.f / 128.f) + 1e-6f) * post;
        *(GAS unsigned*)(o0 + off[k]) = pk2(x * rs * g[0], y * rs * g[1]); }
}
__device__ __forceinline__ void sb_unit(LAS unsigned char* lds, int tid, int b, int h, int q0, const GAS bf16* sq, const GAS bf16* sk, const GAS bf16* vT, GAS bf16* out) {
    constexpr int KBUF = KLay<64>::KBUF, VBUF = 64 * VPB;
    const int lane = tid & 63, wid = tid >> 6, r32 = lane & 31, hi = lane >> 5;
    const size_t tb = (size_t)b * 8192; const int qrow = q0 + 32 * wid + r32;
    const GAS bf16* Kg = sk + tb * 512 + h * 64; const GAS bf16* Vg = vT + (size_t)(h * 64) * 16384 + tb;
    const int NT = q0 / 64 + 4, ntw = (q0 + 32 * wid + 30) / 64 + 1;
    bf16x8 qf[4];
#pragma unroll
    for (int d0 = 0; d0 < 4; ++d0) qf[d0] = *(const GAS bf16x8*)(sq + (tb + qrow) * 512 + h * 64 + 16 * d0 + 8 * hi);
    f32x16 o[2];
#pragma unroll
    for (int r = 0; r < 16; ++r) { o[0][r] = 0.f; o[1][r] = 0.f; }
    float R = 1.0f;
    volatile LAS unsigned* dflag = (volatile LAS unsigned*)(lds + 4 * KBUF + 1024);
    Stage<64, 64, false> st;
    st.load(tid, Kg, 512, nullptr, Vg, 16384, 64 * (NT - 1));
    st.store(tid, lds, lds + 2 * KBUF);
    __syncthreads();
    for (int i = 0; i < NT; ++i) {
        const int t = NT - 1 - i, cur = i & 1, kv0 = 64 * t;
        if (t > 0) st.load(tid, Kg, 512, nullptr, Vg, 16384, kv0 - 64);
        if (t < ntw && __any(R != 0.f)) {
            const LAS unsigned char* kb = lds + cur * KBUF; const LAS unsigned char* vb = lds + 2 * KBUF + cur * VBUF;
            f32x16 k0, k1;
#pragma unroll
            for (int r = 0; r < 16; ++r) { k0[r] = 0.f; k1[r] = 0.f; }
            qkt<64>(k0, k1, kb, qf, r32, hi);
            f32x16 b0, b1;
#pragma unroll
            for (int r = 0; r < 16; ++r) {
                const float e0 = __builtin_amdgcn_exp2f(fminf(k0[r], 115.f)), e1 = __builtin_amdgcn_exp2f(fminf(k1[r], 115.f));
                const float r0 = __builtin_amdgcn_rcpf(1.f + e0), r1 = __builtin_amdgcn_rcpf(1.f + e1);
                k0[r] = r0; b0[r] = e0 * r0; k1[r] = r1; b1[r] = e1 * r1; }
            if (kv0 + 63 >= qrow - r32) {
                const int thr = qrow - kv0 - 4 * hi;
#pragma unroll
                for (int r = 0; r < 16; ++r) { const int c = (r & 3) + 8 * (r >> 2); if (c >= thr) { k0[r] = 1.f; b0[r] = 0.f; } if (c + 32 >= thr) { k1[r] = 1.f; b1[r] = 0.f; } } }
            float gp[8], go[8];
#pragma unroll
            for (int c = 0; c < 4; ++c) { gp[c] = (k0[4 * c] * k0[4 * c + 1]) * (k0[4 * c + 2] * k0[4 * c + 3]); gp[4 + c] = (k1[4 * c] * k1[4 * c + 1]) * (k1[4 * c + 2] * k1[4 * c + 3]); }
#pragma unroll
            for (int g = 0; g < 8; ++g) go[g] = xhalf(gp[g]);
            float sp = R;
#pragma unroll
            for (int g = 7; g >= 0; --g) {
                float s = sp * (hi ? 1.0f : go[g]);
                if (g >= 4) { const int c = g - 4;
                    b1[4 * c + 3] *= s; s *= k1[4 * c + 3]; b1[4 * c + 2] *= s; s *= k1[4 * c + 2]; b1[4 * c + 1] *= s; s *= k1[4 * c + 1]; b1[4 * c] *= s; }
                else { const int c = g;
                    b0[4 * c + 3] *= s; s *= k0[4 * c + 3]; b0[4 * c + 2] *= s; s *= k0[4 * c + 2]; b0[4 * c + 1] *= s; s *= k0[4 * c + 1]; b0[4 * c] *= s; }
                sp *= gp[g] * go[g];
            }
            R = sp;
            bf16x8 pf[4]; pack_p(pf, b0, b1);
            pv<64>(o, vb, pf, r32, hi);
        }
        if (t > 0) st.store(tid, lds + (cur ^ 1) * KBUF, lds + 2 * KBUF + (cur ^ 1) * VBUF);
        if (lane == 0) dflag[(i & 1) * 8 + wid] = (t < ntw && !__any(R != 0.f)) ? 1u : 0u;
        __syncthreads();
        { unsigned alld = 1u;
#pragma unroll
          for (int w = 0; w < 8; ++w) alld &= dflag[(i & 1) * 8 + w];
          if (alld) break; }
    }
    store_o<64>(out + (tb + qrow) * 1024 + h * 64, o, 1.0f, hi);
}
}
typedef unsigned short bf16;
typedef float f32x4 __attribute__((ext_vector_type(4)));
typedef unsigned u32x4 __attribute__((ext_vector_type(4)));
typedef unsigned u32x2 __attribute__((ext_vector_type(2)));
constexpr int NWAVES = 8, NTHREADS = 512;
constexpr int M = 16384, D = 1024, SEQ = 8192, DEPTH = 2, IN_COLS = 6688;
constexpr int SROWS = 40960;
constexpr size_t MiB = 1u << 20;
constexpr size_t WS_CTL = 0, CTL_ZERO_BYTES = 128 * 1024;
constexpr size_t WS_SSQ = 1 * MiB;
constexpr size_t WS_SSQCQ = 2 * MiB, WS_SSQCKV = WS_SSQCQ + 256 * 1024, WS_SSQMEM = WS_SSQCKV + 256 * 1024;
constexpr size_t WS_TOKE = 3 * MiB, WS_TOKW = WS_TOKE + 128 * 1024, WS_HIST = WS_TOKW + 128 * 1024, WS_SLOT = WS_HIST + 64 * 1024;
constexpr size_t WS_STOK = 4 * MiB, WS_SW = WS_STOK + 256 * 1024, WS_SRSTD = WS_SW + 256 * 1024;
constexpr size_t WS_WR = 5 * MiB;
constexpr size_t WS_WRH = 5 * MiB + 256 * 1024, WS_WRL = WS_WRH + 128 * 1024;
constexpr size_t WS_MEMN = 6 * MiB, WS_XK = 7 * MiB, WS_XVT = WS_XK + 512 * 1024;
constexpr size_t WS_WIN = 8 * MiB;
constexpr size_t WS_WV = WS_WIN + (size_t)2816 * 1024 * 2;
constexpr size_t WS_WG = WS_WV + 2 * MiB;
constexpr size_t WS_WUQ = WS_WG + 6 * MiB;
constexpr size_t WS_WUKN = WS_WUQ + 768 * 256 * 2;
constexpr size_t WS_WUV = WS_WUKN + 512 * 256 * 2;
constexpr size_t WS_WB = WS_WUV + 512 * 256 * 2;
constexpr size_t WS_WOUT = WS_WB + 4 * MiB;
constexpr size_t WS_WXQ = WS_WOUT + 2 * MiB;
constexpr size_t WS_WXK = WS_WXQ + 1 * MiB, WS_WXV = WS_WXK + 1 * MiB;
constexpr size_t WS_WXO = WS_WXV + 1 * MiB;
constexpr size_t WS_WGU = WS_WXO + 1 * MiB;
constexpr size_t WS_WD = WS_WGU + 32 * MiB;
constexpr size_t WS_WEND = WS_WD + 16 * MiB;
static_assert(WS_WEND <= 81 * MiB, "weights");
constexpr size_t WS_XB = 81 * MiB;
constexpr size_t R0 = 113 * MiB;
constexpr size_t WS_CQ = R0, WS_CKV = R0 + 8 * MiB, WS_KROPE = R0 + 16 * MiB, WS_QK = R0 + 18 * MiB  , WS_VT = R0 + 82 * MiB  ;
constexpr size_t WS_QMLA = R0 + 114 * MiB, WS_KNOPE = R0 + 138 * MiB, WS_VMLAT = R0 + 154 * MiB, WS_OABC = R0 + 170 * MiB  ;
constexpr size_t WS_GSCR = R0, WS_MB = R0 + 96 * MiB;
constexpr size_t WS_QX = R0, WS_OX = R0 + 32 * MiB;
constexpr size_t WS_XG = R0, WS_ACT = R0 + 80 * MiB, WS_Y = R0 + 100 * MiB;
constexpr size_t WS_END = R0 + 234 * MiB;
static_assert(WS_MB + 32 * MiB <= WS_OABC && WS_Y + 80 * MiB <= WS_END && WS_OABC + 64 * MiB <= WS_END, "region map");
constexpr int CW_BAR = 1024, CW_Q = 8192, CW_KN = 16384, CW_F1 = 24576;
constexpr int RING_BYTES = 131072, LDSCTL_OFF = RING_BYTES, MISC_OFF = LDSCTL_OFF + 320, TSTART_OFF = LDSCTL_OFF + 1024, HIST_OFF = LDSCTL_OFF + 2048;
constexpr int LDS_BYTES = 147456;

#define LDS_WAIT() asm volatile("s_waitcnt lgkmcnt(0)" ::: "memory")
__device__ __forceinline__ float wave_sum(float v) {
#pragma unroll
    for (int o = 1; o < 64; o <<= 1) v += __shfl_xor(v, o);
    return v;
}
__device__ __forceinline__ unsigned pk2(float lo, float hi) { return pg8::pk2(lo, hi); }
__device__ __forceinline__ int lane_id() { int r; asm volatile("v_mbcnt_lo_u32_b32 %0, -1, 0\n\tv_mbcnt_hi_u32_b32 %0, -1, %0" : "=v"(r)); return r; }
#define XB_TMO      128
#define XB_XCNT(j)  (256  + 64 * (j))
#define XB_XSUB(j)  (1280 + 64 * (j))
#define XB_XGEN(j)  (2304 + 64 * (j))
#define XB_TOP      3328
#define XB_TOPGEN   3392
#define XCD_BAR_WORDS 3456
#define XB_SPIN_CAP (1u << 18)

__device__ __forceinline__ unsigned xb_ld(unsigned* p)              { return __hip_atomic_load(p, __ATOMIC_RELAXED, __HIP_MEMORY_SCOPE_AGENT); }
__device__ __forceinline__ unsigned xb_add(unsigned* p, unsigned v) { return __hip_atomic_fetch_add(p, v, __ATOMIC_RELAXED, __HIP_MEMORY_SCOPE_AGENT); }
__device__ __forceinline__ unsigned xb_xcc_id() { return (unsigned)__builtin_amdgcn_s_getreg((3 << 11) | 20) & 0xFu; }
#define XB_SPIN(cond, bar) do { unsigned _sp = 0; while (cond) { __builtin_amdgcn_s_sleep(1); \
    if ((++_sp & 255u) == 0u) { if (xb_ld(&(bar)[XB_TMO])) break; if (_sp > XB_SPIN_CAP) { atomicAdd(&(bar)[XB_TMO], 1u); break; } } } } while (0)

struct XcdBarrier {
    unsigned* bar; unsigned x; int wid;
    volatile LAS unsigned* st;
};

__device__ __forceinline__ XcdBarrier xcd_barrier_post(unsigned* bar, volatile LAS unsigned* st, int wid) {
    XcdBarrier b; b.bar = bar; b.x = xb_xcc_id(); b.st = st; b.wid = wid;
    if (wid == 0 && lane_id() == 0) (void)xb_add(&bar[XB_XCNT(b.x)], 1u);
    return b;
}
__device__ __forceinline__ void xcd_barrier_complete(unsigned* bar, unsigned x, unsigned& nloc, unsigned& nx) {
    const unsigned G = gridDim.x * gridDim.y * gridDim.z;
    unsigned sum, cnt, mine, sp = 0u;
    for (;;) {
        sum = 0u; cnt = 0u; mine = 0u;
#pragma unroll 1
        for (unsigned j = 0; j < 16; ++j) { const unsigned c = xb_ld(&bar[XB_XCNT(j)]); sum += c; cnt += (c > 0u) ? 1u : 0u; mine = (j == x) ? c : mine; }
        if (sum == G) break;
        __builtin_amdgcn_s_sleep(1);
        if ((++sp & 255u) == 0u) { if (xb_ld(&bar[XB_TMO])) break; if (sp > XB_SPIN_CAP) { atomicAdd(&bar[XB_TMO], 1u); break; } }
    }
    nloc = mine > 0u ? mine : 1u; nx = cnt > 0u ? cnt : 1u;
}

__device__ __forceinline__ void xcd_barrier(const XcdBarrier& b) {
    asm volatile("s_waitcnt vmcnt(0)" ::: "memory");
    __syncthreads();
    if (b.wid == 0 && lane_id() == 0) {
        unsigned* bar = b.bar; asm volatile("" : "+s"(bar));
        __builtin_amdgcn_s_waitcnt(0);
        unsigned nloc = b.st[0], nx = b.st[1];
        if (nloc == 0u) { xcd_barrier_complete(bar, b.x, nloc, nx); b.st[0] = nloc; b.st[1] = nx; }
        const unsigned old = xb_add(&bar[XB_XSUB(b.x)], 1u);
        const unsigned gen = old / nloc;
        if (old + 1u == (gen + 1u) * nloc) {
            __builtin_amdgcn_fence(__ATOMIC_RELEASE, "agent");
            asm volatile("s_waitcnt vmcnt(0)" ::: "memory");
            const unsigned og = xb_add(&bar[XB_TOP], 1u);
            const unsigned tg = og / nx;
            if (og + 1u == (tg + 1u) * nx) xb_add(&bar[XB_TOPGEN], 1u);
            else XB_SPIN(xb_ld(&bar[XB_TOPGEN]) == tg, bar);
            __builtin_amdgcn_fence(__ATOMIC_ACQUIRE, "agent");
            xb_add(&bar[XB_XGEN(b.x)], 1u);
            asm volatile("s_waitcnt vmcnt(0)" ::: "memory");
        } else {
            XB_SPIN(xb_ld(&bar[XB_XGEN(b.x)]) == gen, bar);
            __builtin_amdgcn_fence(__ATOMIC_ACQUIRE, "agent");
            asm volatile("s_waitcnt vmcnt(0)" ::: "memory");
        }
    }
    __syncthreads();
}
struct TrJob { const GAS float* src; const GAS float* gain; GAS bf16* dst; int ldn, col0, k0, K, row0, dk; };
__device__ __forceinline__ void tr_load(const TrJob& j, f32x4 (&v)[8], int lane) {
    const int kr = lane >> 3, nq = lane & 7;
    if (j.col0 >= 0) {
#pragma unroll
        for (int i = 0; i < 8; ++i) v[i] = *(const GAS f32x4*)(j.src + (size_t)(j.k0 + 8 * i + kr) * j.ldn + j.col0 + 4 * nq);
    } else {
#pragma unroll
        for (int i = 0; i < 8; ++i) v[i] = (f32x4){0.f, 0.f, 0.f, 0.f};
    }
}
__device__ __forceinline__ void tr_finish(const TrJob& j, const f32x4 (&v)[8], LAS float* scr, int lane) {
    const int kr = lane >> 3, nq = lane & 7;
#pragma unroll
    for (int i = 0; i < 8; ++i) { const int kk = 8 * i + kr; const float g = j.gain ? j.gain[j.k0 + kk] : 1.f; LAS float* s = scr + kk * 33 + 4 * nq;
        s[0] = v[i][0] * g; s[1] = v[i][1] * g; s[2] = v[i][2] * g; s[3] = v[i][3] * g; }
    LDS_WAIT(); asm volatile("" ::: "memory");
    const int c = lane & 7;
#pragma unroll
    for (int q = 0; q < 4; ++q) { const int n = (lane >> 3) + 8 * q; const LAS float* s = scr + (8 * c) * 33 + n;
        u32x4 o; o.x = pk2(s[0 * 33], s[1 * 33]); o.y = pk2(s[2 * 33], s[3 * 33]); o.z = pk2(s[4 * 33], s[5 * 33]); o.w = pk2(s[6 * 33], s[7 * 33]);
        *(GAS u32x4*)(j.dst + (size_t)(j.row0 + n) * j.K + j.dk + j.k0 + 8 * c) = o; }
    LDS_WAIT(); asm volatile("" ::: "memory");
}
__device__ __forceinline__ void row_to_bf16(const GAS float* xrow, GAS bf16* orow, GAS float* ssq16, int lane) {
    const GAS f32x4* xr = (const GAS f32x4*)xrow + lane; f32x4 v[4]; float s = 0.f;
#pragma unroll
    for (int j = 0; j < 4; ++j) { v[j] = xr[64 * j]; s += (v[j][0] * v[j][0] + v[j][1] * v[j][1]) + (v[j][2] * v[j][2] + v[j][3] * v[j][3]); }
    s = wave_sum(s);
    GAS u32x2* o8 = (GAS u32x2*)orow + lane;
#pragma unroll
    for (int j = 0; j < 4; ++j) { u32x2 w; w.x = pk2(v[j][0], v[j][1]); w.y = pk2(v[j][2], v[j][3]); o8[64 * j] = w; }
    if (lane < 16) ssq16[lane] = (lane == 0) ? s : 0.f;
}

struct Args { const float* in[26]; float* out; unsigned char* ws; };
__device__ __forceinline__ int opq(int i) { asm volatile("" : "+s"(i)); return i; }
__device__ __forceinline__ GAS unsigned char* opqp(unsigned char* p0) { GAS unsigned char* p = (GAS unsigned char*)p0; asm volatile("" : "+s"(p)); return p; }
#define INP(i) ((const GAS float*)args.in[opq(i)])
#define WSB(off) (opqp(args.ws) + (off))
#define X_IN INP(0)
#define OUTP ((GAS float*)args.out)
#define XB ((GAS bf16*)WSB(WS_XB))
#define SSQ ((GAS float*)WSB(WS_SSQ))
#define SSQCQ ((GAS float*)WSB(WS_SSQCQ))
#define SSQCKV ((GAS float*)WSB(WS_SSQCKV))
#define SSQMEM ((GAS float*)WSB(WS_SSQMEM))
#define MEMN ((GAS bf16*)WSB(WS_MEMN))
#define XK ((GAS bf16*)WSB(WS_XK))
#define XVT ((GAS bf16*)WSB(WS_XVT))
#define WIN ((GAS bf16*)WSB(WS_WIN))
#define WV ((GAS bf16*)WSB(WS_WV))
#define WG ((GAS bf16*)WSB(WS_WG))
#define WUQ ((GAS bf16*)WSB(WS_WUQ))
#define WUKN ((GAS bf16*)WSB(WS_WUKN))
#define WUV ((GAS bf16*)WSB(WS_WUV))
#define WB ((GAS bf16*)WSB(WS_WB))
#define WOUT ((GAS bf16*)WSB(WS_WOUT))
#define WXQ ((GAS bf16*)WSB(WS_WXQ))
#define WXK ((GAS bf16*)WSB(WS_WXK))
#define WXV ((GAS bf16*)WSB(WS_WXV))
#define WXO ((GAS bf16*)WSB(WS_WXO))
#define WGU ((GAS bf16*)WSB(WS_WGU))
#define WD ((GAS bf16*)WSB(WS_WD))
#define WRH ((GAS bf16*)WSB(WS_WRH))
#define WRL ((GAS bf16*)WSB(WS_WRL))
#define CQ ((GAS bf16*)WSB(WS_CQ))
#define CKV ((GAS bf16*)WSB(WS_CKV))
#define KROPE ((GAS bf16*)WSB(WS_KROPE))
#define QK ((GAS bf16*)WSB(WS_QK))
#define VT ((GAS bf16*)WSB(WS_VT))
#define QMLA ((GAS bf16*)WSB(WS_QMLA))
#define KNOPE ((GAS bf16*)WSB(WS_KNOPE))
#define VMLAT ((GAS bf16*)WSB(WS_VMLAT))
#define OABC ((GAS bf16*)WSB(WS_OABC))
#define GSCR ((GAS unsigned char*)WSB(WS_GSCR))
#define MB ((GAS bf16*)WSB(WS_MB))
#define QX ((GAS bf16*)WSB(WS_QX))
#define OX ((GAS bf16*)WSB(WS_OX))
#define XG ((GAS bf16*)WSB(WS_XG))
#define ACT ((GAS bf16*)WSB(WS_ACT))
#define YB ((GAS bf16*)WSB(WS_Y))
#define TOKE ((GAS int*)WSB(WS_TOKE))
#define TOKW ((GAS float*)WSB(WS_TOKW))
#define HIST ((GAS int*)WSB(WS_HIST))
#define SLOT ((GAS int*)WSB(WS_SLOT))
#define STOK ((GAS int*)WSB(WS_STOK))
#define SW ((GAS float*)WSB(WS_SW))
#define SRSTD ((GAS float*)WSB(WS_SRSTD))


__global__ void __launch_bounds__(NTHREADS, 2) fwd(Args args) {
    extern __shared__ __attribute__((aligned(16))) unsigned char lds_raw[];
    LAS unsigned char* lds = (LAS unsigned char*)lds_raw;
    volatile LAS unsigned* MISC = (volatile LAS unsigned*)(lds + MISC_OFF);
    LAS int* TSTART = (LAS int*)(lds + TSTART_OFF);
    const int tid0 = threadIdx.x; const int wv = __builtin_amdgcn_readfirstlane(tid0 >> 6);
#define PH_BEGIN int tid_ = wv * 64 + lane_id(); asm volatile("" : "+v"(tid_)); const int tid = tid_, lane = tid & 63, wave = wv, gw = vcu * NWAVES + wave; (void)lane; (void)gw
    const int G = gridDim.x, bx = blockIdx.x, vcu = (G % 8 == 0) ? (bx % 8) * (G / 8) + bx / 8 : bx;
    unsigned* ctl = (unsigned*)(void*)(args.ws + WS_CTL);
    for (int u = tid0; u < (LDS_BYTES - LDSCTL_OFF) / 4; u += NTHREADS) ((LAS unsigned*)(lds + LDSCTL_OFF))[u] = 0u;
    __syncthreads();
    XcdBarrier bar = xcd_barrier_post(ctl + CW_BAR, MISC + 8, wv);
    const int NGW = G * NWAVES;

    constexpr float L2E = 1.4426950408889634f;

    constexpr int I_IN = 88 * 16, I_V = 32 * 16, I_G = 96 * 16, I_UQ = 24 * 4, I_UK = 16 * 4, I_B = 3 * 32 * 8, I_O = 32 * 16, I_XQ = 16 * 16, I_XO = 32 * 8, I_GU = 512 * 16, I_D = 1024 * 4;
    constexpr int NITEMS = I_IN + I_V + I_G + I_UQ + 2 * I_UK + I_B + I_O + 3 * I_XQ + I_XO + I_GU + I_D, NITEMS_P0 = NITEMS - I_GU - I_D;
    for (int l = 0; l < DEPTH; ++l) {
        for (int rp_ = 0; rp_ < RP_P0; ++rp_) {
#if PH_P0
        { PH_BEGIN;
            LAS float* scr = (LAS float*)(lds + wave * 16384);
#define w_in (INP(3) + (size_t)l * D * IN_COLS)
#define g_attn (INP(2) + l * D)
#define w_uq (INP(5) + (size_t)l * 256 * 768)
#define g_q (INP(4) + l * 256)
#define w_ukv (INP(7) + (size_t)l * 256 * 1024)
#define g_kv (INP(6) + l * 256)
#define w_br (INP(10) + (size_t)l * 3 * 512 * 1024)
#define w_out (INP(11) + (size_t)l * D * D)
#define g_cross (INP(12) + l * D)
#define g_mem (INP(13))
#define w_xq (INP(14) + (size_t)l * D * 512)
#define w_xkv (INP(15) + (size_t)l * D * 1024)
#define w_xo (INP(16) + (size_t)l * 512 * D)
#define g_ffn (INP(17) + l * D)
#define w_eg (INP(22) + (size_t)l * 32 * D * 256)
#define w_eu (INP(23) + (size_t)l * 32 * D * 256)
#define w_ed (INP(24) + (size_t)l * 32 * 256 * D)
#define TR_DECODE(itx) do { int r = (itx); \
                if (r < I_IN) { const int nb = r >> 4, kb = r & 15, n0 = nb * 32; int col; \
                    if (n0 < 544) col = 3072 + n0; else if (n0 < 768) col = -1; else if (n0 < 1792) col = 3616 + (n0 - 768); else col = 5152 + (n0 - 1792); \
                    jb = TrJob{w_in, g_attn, WIN, IN_COLS, col, kb * 64, 1024, n0, 0}; break; } r -= I_IN; \
                if (r < I_V) { const int nb = r >> 4, kb = r & 15, n0 = nb * 32; const int col = n0 < 512 ? 4640 + n0 : 6176 + (n0 - 512); \
                    jb = TrJob{w_in, g_attn, WV, IN_COLS, col, kb * 64, 1024, n0, 0}; break; } r -= I_V; \
                if (r < I_G) { const int nb = r >> 4, kb = r & 15; jb = TrJob{w_in, g_attn, WG, IN_COLS, nb * 32, kb * 64, 1024, nb * 32, 0}; break; } r -= I_G; \
                if (r < I_UQ) { const int nb = r >> 2, kb = r & 3, n0 = nb * 32; const int col = n0 < 512 ? 96 * (n0 >> 6) + (n0 & 63) : 96 * ((n0 - 512) >> 5) + 64; \
                    jb = TrJob{w_uq, g_q, WUQ, 768, col, kb * 64, 256, n0, 0}; break; } r -= I_UQ; \
                if (r < I_UK) { const int nb = r >> 2, kb = r & 3, n0 = nb * 32; jb = TrJob{w_ukv, g_kv, WUKN, 1024, 128 * (n0 >> 6) + (n0 & 63), kb * 64, 256, n0, 0}; break; } r -= I_UK; \
                if (r < I_UK) { const int nb = r >> 2, kb = r & 3, n0 = nb * 32; jb = TrJob{w_ukv, g_kv, WUV, 1024, 128 * (n0 >> 6) + 64 + (n0 & 63), kb * 64, 256, n0, 0}; break; } r -= I_UK; \
                if (r < I_B) { const int z = r / 256, q = r % 256, nb = q >> 3, kb = q & 7; jb = TrJob{w_br + (size_t)z * 512 * 1024, nullptr, WB + (size_t)(z >> 1) * 1024 * 1024, 1024, nb * 32, kb * 64, 1024, nb * 32, (z & 1) * 512}; break; } r -= I_B; \
                if (r < I_O) { const int nb = r >> 4, kb = r & 15; jb = TrJob{w_out, nullptr, WOUT, 1024, nb * 32, kb * 64, 1024, nb * 32, 0}; break; } r -= I_O; \
                if (r < I_XQ) { const int nb = r >> 4, kb = r & 15; jb = TrJob{w_xq, g_cross, WXQ, 512, nb * 32, kb * 64, 1024, nb * 32, 0}; break; } r -= I_XQ; \
                if (r < I_XQ) { const int nb = r >> 4, kb = r & 15; jb = TrJob{w_xkv, g_mem, WXK, 1024, nb * 32, kb * 64, 1024, nb * 32, 0}; break; } r -= I_XQ; \
                if (r < I_XQ) { const int nb = r >> 4, kb = r & 15; jb = TrJob{w_xkv, g_mem, WXV, 1024, 512 + nb * 32, kb * 64, 1024, nb * 32, 0}; break; } r -= I_XQ; \
                if (r < I_XO) { const int nb = r >> 3, kb = r & 7; jb = TrJob{w_xo, nullptr, WXO, 1024, nb * 32, kb * 64, 512, nb * 32, 0}; break; } r -= I_XO; \
                if (r < I_GU) { const int nb = r >> 4, kb = r & 15, n0 = nb * 32, e = n0 >> 9, rr = n0 & 511, t = rr >> 8, j = rr & 255; \
                    const GAS float* src = (j < 128 ? w_eg : w_eu) + (size_t)e * D * 256; jb = TrJob{src, g_ffn, WGU, 256, 128 * t + (j & 127), kb * 64, 1024, n0, 0}; break; } r -= I_GU; \
                { const int nb = r >> 2, kb = r & 3, n0 = nb * 32, e = n0 >> 10; jb = TrJob{w_ed + (size_t)e * 256 * 1024, nullptr, WD, 1024, n0 & 1023, kb * 64, 256, n0, 0}; } } while (0)
            for (int it = gw; it < NITEMS_P0; it += NGW) {
                TrJob jb{};
                TR_DECODE(it);
                f32x4 va[8];
                tr_load(jb, va, lane);
                tr_finish(jb, va, scr, lane);
            }
            { const GAS float* wrg = INP(18) + (size_t)l * D * 4; const GAS float* wre = INP(20) + (size_t)l * D * 32; GAS bf16* wh = WRH; GAS bf16* wl = WRL;
              for (int i = bx * NTHREADS + tid; i < 48 * 1024; i += G * NTHREADS) { const int c = i >> 10, k = i & 1023;
                  const float w = c < 36 ? (c < 4 ? wrg[k * 4 + c] : wre[k * 32 + (c - 4)]) * g_ffn[k] : 0.f; const unsigned h = pk2(w, 0.f) & 0xffffu;
                  wh[i] = (bf16)h; wl[i] = (bf16)(pk2(w - __builtin_bit_cast(float, h << 16), 0.f) & 0xffffu); } }
            if (l == 0) {
                for (int m = gw; m < M; m += NGW) row_to_bf16(X_IN + (size_t)m * D, XB + (size_t)m * D, SSQ + (size_t)m * 16, lane);
                for (int m = gw; m < 512; m += NGW) row_to_bf16(INP(1) + (size_t)m * D, MEMN + (size_t)m * D, SSQMEM + (size_t)m * 16, lane);
            }
        }
#endif
        xcd_barrier(bar);
        }
                for (int rp_ = 0; rp_ < RP_A; ++rp_) {
#if PH_A
        {
            { pg8::Gemm g{XB, WIN, M, 2816, D, D, nullptr}; pg8::StaticOrder S; S.init(M, 2816, G, bx);
              pg8::EpiA E{SSQ, CQ, CKV, KROPE, QK, SSQCQ, SSQCKV, 0.125f * L2E, (GAS unsigned*)(opqp(args.ws) + WS_CTL) + CW_KN + l * 4096, rp_ ? A_ABL : 0};
              pg8::gemm_phase<pg8::EpiA, pg8::StaticOrder, true, true>(lds, g, S, E, wv); }
            { pg8::Gemm g{WV, XB, 1024, M, D, D, nullptr}; pg8::StaticOrder S; S.init(1024, M, G, (bx + 64) % G);
              pg8::EpiVT E{VT, M, SSQ, 4, 1.f / 1024.f};
              pg8::gemm_phase<pg8::EpiVT, pg8::StaticOrder, true, true>(lds, g, S, E, wv); }
            { pg8::Gemm g{MEMN, WXK, 512, 512, D, D, nullptr}; pg8::StaticOrder S; S.init(512, 512, G, (bx + 8) % G);
              pg8::EpiRS E{XK, 512, SSQMEM, 4, 1.f / 1024.f, 1.f, 0xffff, 31, 0};
              pg8::gemm_phase<pg8::EpiRS, pg8::StaticOrder, true, true>(lds, g, S, E, wv); }
            { pg8::Gemm g{WXV, MEMN, 512, 512, D, D, nullptr}; pg8::StaticOrder S; S.init(512, 512, G, (bx + 16) % G);
              pg8::EpiVT E{XVT, 512, SSQMEM, 4, 1.f / 1024.f};
              pg8::gemm_phase<pg8::EpiVT, pg8::StaticOrder, true, true>(lds, g, S, E, wv); }
        }
#endif
        xcd_barrier(bar);
        }
                for (int rp_ = 0; rp_ < RP_B; ++rp_) {
#if PH_B
        {
#if PH_B1
            { pg8::Gemm g{CQ, WUQ, M, 768, opq(256), opq(256), nullptr}; pg8::StaticOrder S; S.init(M, 768, G, bx);
              pg8::EpiQ E{QMLA, SSQCQ, 0.10206207261596577f * L2E};
              pg8::gemm_phase<pg8::EpiQ, pg8::StaticOrder, true, true>(lds, g, S, E, wv); }
#endif
#if PH_B2
            { pg8::Gemm g{CKV, WUKN, M, 512, opq(256), opq(256), nullptr}; pg8::StaticOrder S; S.init(M, 512, G, (bx + 64) % G);
              pg8::EpiRS E{KNOPE, 512, SSQCKV, 1, 1.f / 256.f, 1.f, 0xffff, 31, 0};
              pg8::gemm_phase<pg8::EpiRS, pg8::StaticOrder, true, true>(lds, g, S, E, wv); }
#endif
#if PH_B3
            { pg8::Gemm g{WUV, CKV, 512, M, opq(256), opq(256), nullptr}; pg8::StaticOrder S; S.init(512, M, G, (bx + 128) % G);
              pg8::EpiVT E{VMLAT, M, SSQCKV, 1, 1.f / 256.f};
              pg8::gemm_phase<pg8::EpiVT, pg8::StaticOrder, true, true>(lds, g, S, E, wv); }
#endif
        }
#endif
        xcd_barrier(bar);
        }
                for (int rp_ = 0; rp_ < RP_C; ++rp_) {
#if PH_C
        {
            unsigned* qhead = ctl + CW_Q + 64 * (l + 2 * rp_);
            for (;;) {
                if (wv == 0 && lane_id() == 0) MISC[0] = __hip_atomic_fetch_add(qhead, 1u, __ATOMIC_RELAXED, __HIP_MEMORY_SCOPE_AGENT);
                __syncthreads();
                const int idx = (int)MISC[0];
                __syncthreads();
                if (idx >= 32 * 48 + 256) break;
                if (idx >= 32 * 48) {
                    if (rp_ == 0) { const int wl = lane_id(); LAS float* scr = (LAS float*)(lds + wv * 16384);
                        for (int j = 0; j < 6; ++j) { const int it = NITEMS_P0 + (idx - 32 * 48) * 48 + j * 8 + wv; TrJob jb{}; TR_DECODE(it); f32x4 va[8]; tr_load(jb, va, wl); tr_finish(jb, va, scr, wl); } }
                    continue; }
                const int qb = 31 - idx / 48, r = idx % 48, q0 = qb * 256;
                int tu = wv * 64 + lane_id(); asm volatile("" : "+v"(tu));
#if PH_C_DIFF
                if (r < 16 && (rp_ == 0 || (C_REP_MASK & 1))) att::diff_unit(lds, tu, r >> 3, (r >> 1) & 3, r & 1, q0, QK + (size_t)2 * M * 512, QK + (size_t)3 * M * 512, VT, (r & 1) ? CQ : OABC + (size_t)M * 1024, (r & 1) ? 512 : 1024,
                                                                             (const GAS unsigned*)(opqp(args.ws) + WS_CTL) + CW_KN + l * 4096, rp_ ? C_ABL : 0);
#endif
#if PH_C_SB
                if (r >= 16 && r < 32 && (rp_ == 0 || (C_REP_MASK & 2))) att::sb_unit(lds, tu, (r - 16) >> 3, (r - 16) & 7, q0, QK, QK + (size_t)M * 512, VT, OABC + 512);
#endif
#if PH_C_MLA
                if (r >= 32 && (rp_ == 0 || (C_REP_MASK & 4))) att::mla_unit(lds, tu, (r - 32) >> 3, (r - 32) & 7, q0, QMLA, KNOPE, KROPE, VMLAT, OABC, rp_ ? C_ABL : 0);
#endif
            }
        }
#endif
        xcd_barrier(bar);
        }
        #undef TR_DECODE
#undef w_in
#undef g_attn
#undef w_uq
#undef g_q
#undef w_ukv
#undef g_kv
#undef w_br
#undef w_out
#undef g_cross
#undef g_mem
#undef w_xq
#undef w_xkv
#undef w_xo
#undef g_ffn
#undef w_eg
#undef w_eu
#undef w_ed
#if PH_C
        { PH_BEGIN;
          float lam, post; att::diff_lambda(INP(8) + l * 256, l, lam, post);
          for (int it = gw; it < M * 4; it += 4 * NGW) att::diff_combine4(it, NGW, lane, OABC + (size_t)M * 1024, CQ, lam, post, INP(9) + l * 128); }
        xcd_barrier(bar);
#endif
        for (int rp_ = 0; rp_ < RP_D1; ++rp_) {
#if PH_D1
        { pg8::Gemm g{XB, WG, M, 1024, 512, 1024, nullptr}; pg8::D1Order S; S.so.init(M, 1024, G, bx);
          const GAS char* xb_ = (const GAS char*)XB; const GAS char* oab_ = (const GAS char*)OABC; const GAS char* wg_ = (const GAS char*)WG; const GAS char* wb_ = (const GAS char*)WB;
          S.dA = (size_t)(oab_ - xb_); S.dB = (size_t)(wb_ - wg_);
          pg8::EpiD1 E{GSCR, MB, SSQ};
          pg8::gemm_phase<pg8::EpiD1, pg8::D1Order, true, true>(lds, g, S, E, wv); }
#endif
        xcd_barrier(bar);
        }
        #if PH_D2
        { pg8::Gemm g{MB, WOUT, M, 1024, D, D, nullptr}; pg8::StaticOrder S; S.init(M, 1024, G, bx);
          pg8::EpiRes E{XB, SSQ};
          pg8::gemm_phase<pg8::EpiRes, pg8::StaticOrder, true, true>(lds, g, S, E, wv); }
#endif
        xcd_barrier(bar);
                for (int rp_ = 0; rp_ < RP_E1; ++rp_) {
#if PH_E1
        { pg8::Gemm g{XB, WXQ, M, 512, 512, 1024, nullptr}; pg8::SplitK2Order S; S.so.init(M, 1024, G, bx); S.tstep = (size_t)256 * 1024 * 2;
          pg8::EpiRS E{QX, 512, SSQ, 4, 1.f / 1024.f, 0.08838834764831845f * L2E, 1, 1, (size_t)M * 512};
          pg8::gemm_phase<pg8::EpiRS, pg8::SplitK2Order, true, true>(lds, g, S, E, wv); }
#endif
        xcd_barrier(bar);
        }
                for (int rp_ = 0; rp_ < RP_E2; ++rp_) {
#if PH_E2
        { PH_BEGIN; for (int u = vcu; u < 256; u += G) att::cross_unit(lds, tid, u >> 7, (u >> 5) & 3, (u & 31) * 256, QX, XK, XVT, OX); }
#endif
        xcd_barrier(bar);
        }
        #if PH_E3
        { pg8::Gemm g{OX, WXO, M, 1024, 512, 512, nullptr}; pg8::StaticOrder S; S.init(M, 1024, G, bx);
          pg8::EpiRes E{XB, SSQ};
          pg8::gemm_phase<pg8::EpiRes, pg8::StaticOrder, true, true>(lds, g, S, E, wv); }
#endif
        xcd_barrier(bar);
                for (int rp_ = 0; rp_ < RP_F0A; ++rp_) {
#if PH_F0A
        { PH_BEGIN;
            typedef short bf16x8 __attribute__((ext_vector_type(8)));
            const GAS float* brg = INP(19) + l * 4; const GAS float* bre = INP(21) + l * 32;
            LAS float* part = (LAS float*)lds;
            const int rb = wave & 3, kh = wave >> 2, r16 = lane & 15, kq = lane >> 4;
            for (int grp = bx; grp < 256; grp += G) {
                const GAS bf16* xrow = XB + (size_t)(grp * 64 + 16 * rb + r16) * D + 512 * kh + 8 * kq;
                const GAS bf16* wh = WRH + (size_t)r16 * 1024 + 512 * kh + 8 * kq; const GAS bf16* wl = WRL + (size_t)r16 * 1024 + 512 * kh + 8 * kq;
                f32x4 acc[3];
#pragma unroll
                for (int cb = 0; cb < 3; ++cb) acc[cb] = (f32x4){0.f, 0.f, 0.f, 0.f};
#pragma unroll 8
                for (int st = 0; st < 16; ++st) {
                    const bf16x8 ah = *(const GAS bf16x8*)(xrow + 32 * st);
#pragma unroll
                    for (int cb = 0; cb < 3; ++cb) {
                        const bf16x8 bh = *(const GAS bf16x8*)(wh + (size_t)cb * 16 * 1024 + 32 * st), bl = *(const GAS bf16x8*)(wl + (size_t)cb * 16 * 1024 + 32 * st);
                        acc[cb] = __builtin_amdgcn_mfma_f32_16x16x32_bf16(ah, bh, acc[cb], 0, 0, 0);
                        acc[cb] = __builtin_amdgcn_mfma_f32_16x16x32_bf16(ah, bl, acc[cb], 0, 0, 0);
                    }
                }
                __syncthreads();
#pragma unroll
                for (int cb = 0; cb < 3; ++cb)
#pragma unroll
                    for (int r = 0; r < 4; ++r) part[(kh * 64 + 16 * rb + 4 * kq + r) * 49 + 16 * cb + r16] = acc[cb][r];
                __syncthreads();
                if (wave == 0) {
                    const int tok = grp * 64 + lane; const float rs = pg8::rstd_parts(SSQ, (unsigned)(tok * 16), 4, 1.f / 1024.f);
                    const LAS float* p0 = part + lane * 49; const LAS float* p1 = part + (64 + lane) * 49;
                    float gl[4];
#pragma unroll
                    for (int c = 0; c < 4; ++c) gl[c] = (p0[c] + p1[c]) * rs + brg[c];
                    int gs = 0; float gm = gl[0];
#pragma unroll
                    for (int c = 1; c < 4; ++c) if (gl[c] > gm) { gm = gl[c]; gs = c; }
                    float den = 0.f;
#pragma unroll
                    for (int c = 0; c < 4; ++c) den += expf(gl[c] - gm);
                    const float pg = 1.0f / den;
                    float el[8];
#pragma unroll
                    for (int j = 0; j < 8; ++j) el[j] = (p0[4 + gs * 8 + j] + p1[4 + gs * 8 + j]) * rs + bre[gs * 8 + j];
                    int i0 = 0; float v0 = el[0];
#pragma unroll
                    for (int j = 1; j < 8; ++j) if (el[j] > v0) { v0 = el[j]; i0 = j; }
                    int i1 = -1; float v1 = -INFINITY;
#pragma unroll
                    for (int j = 0; j < 8; ++j) if (j != i0 && el[j] > v1) { v1 = el[j]; i1 = j; }
                    const float e1 = expf(v1 - v0), w0 = pg / (1.f + e1), w1 = pg * e1 / (1.f + e1);
                    const int ea = gs * 8 + i0, eb = gs * 8 + i1;
                    TOKE[tok * 2] = ea; TOKE[tok * 2 + 1] = eb; TOKW[tok * 2] = w0; TOKW[tok * 2 + 1] = w1;
                    int mycnt = 0;
#pragma unroll 1
                    for (int e = 0; e < 32; ++e) { const int c = __popcll(__ballot(ea == e)) + __popcll(__ballot(eb == e)); if (lane == e) mycnt = c; }
                    if (lane < 32) HIST[grp * 32 + lane] = mycnt;
                }
            }
            __syncthreads();
        }
#endif
        xcd_barrier(bar);
        }
                for (int rp_ = 0; rp_ < RP_F0B; ++rp_) {
#if PH_F0B
        { PH_BEGIN;
            LAS int* cnt = (LAS int*)(lds + HIST_OFF);
            for (int grp = bx; grp < 256; grp += G) {
                __syncthreads();
                { const int e = tid & 31, ch = tid >> 5; int tot = 0, before = 0;
#pragma unroll
                  for (int j = 0; j < 16; ++j) { const int g2 = ch * 16 + j; const int hv = HIST[g2 * 32 + e]; tot += hv; before += (g2 < grp) ? hv : 0; }
                  cnt[128 + ch * 32 + e] = tot; cnt[640 + ch * 32 + e] = before; }
                __syncthreads();
                if (tid < 32) { int tot = 0, before = 0;
                    for (int ch = 0; ch < 16; ++ch) { tot += cnt[128 + ch * 32 + tid]; before += cnt[640 + ch * 32 + tid]; }
                    cnt[tid] = tot; cnt[32 + tid] = before; }
                __syncthreads();
                if (tid == 0) { int ts = 0; for (int e = 0; e < 32; ++e) { TSTART[e] = ts; ts += (cnt[e] + 255) >> 8; } TSTART[32] = ts; }
                __syncthreads();
                if (wave == 0) {
                    const int tok = grp * 64 + lane; const int ea = TOKE[tok * 2], eb = TOKE[tok * 2 + 1];
                    int ra = 0, rb = 0; const unsigned long long lt = (1ull << lane) - 1ull;
#pragma unroll 1
                    for (int e = 0; e < 32; ++e) { const unsigned long long ma = __ballot(ea == e), mb = __ballot(eb == e); const int c = __popcll((ma | mb) & lt); if (ea == e) ra = c; if (eb == e) rb = c; }
                    const int sa = TSTART[ea] * 256 + cnt[32 + ea] + ra, sb = TSTART[eb] * 256 + cnt[32 + eb] + rb;
                    const float rsd = pg8::rstd_parts(SSQ, (unsigned)(tok * 16), 4, 1.f / 1024.f);
                    SLOT[tok * 2] = sa; SLOT[tok * 2 + 1] = sb;
                    STOK[sa] = tok; STOK[sb] = tok; SW[sa] = TOKW[tok * 2]; SW[sb] = TOKW[tok * 2 + 1]; SRSTD[sa] = rsd; SRSTD[sb] = rsd;
                    MISC[16 + lane] = (unsigned)sa; MISC[80 + lane] = (unsigned)sb;
                }
                __syncthreads();
                if (grp < 32) { const int beg = TSTART[grp] * 256 + cnt[grp], end = TSTART[grp + 1] * 256;
                    for (int s = beg + tid; s < end; s += NTHREADS) { STOK[s] = 0; SW[s] = 0.f; SRSTD[s] = 0.f; } }
            }
            if (G > 256 || bx >= 256) {
                __syncthreads();
                if (tid < 32) { int tot = 0; for (int g2 = 0; g2 < 256; ++g2) tot += HIST[g2 * 32 + tid]; cnt[tid] = tot; }
                __syncthreads();
                if (tid == 0) { int ts = 0; for (int e = 0; e < 32; ++e) { TSTART[e] = ts; ts += (cnt[e] + 255) >> 8; } TSTART[32] = ts; }
            }
            __syncthreads();
        }
#endif
        xcd_barrier(bar);
        }
                for (int rp_ = 0; rp_ < RP_F1; ++rp_) {
#if PH_F1
        { pg8::Gemm g{XB, WGU, SROWS, 32 * 512, D, D, STOK}; pg8::MoeOrderP S{(const LAS int*)TSTART, (GAS unsigned*)(opqp(args.ws) + WS_CTL) + CW_F1 + l * 256, G, vcu};
          pg8::EpiAct E{ACT, SRSTD, SW};
          pg8::gemm_phase<pg8::EpiAct, pg8::MoeOrderP, true, true, true>(lds, g, S, E, wv); }
#endif
        }
                for (int rp_ = 0; rp_ < RP_F2; ++rp_) {
#if PH_F2
        { pg8::Gemm g{ACT, WD, SROWS, 32 * 1024, opq(256), opq(256), nullptr}; pg8::MoeOrderC S{(const LAS int*)TSTART, (const GAS unsigned*)(opqp(args.ws) + WS_CTL) + CW_F1 + l * 256, G, vcu, wv};
          pg8::EpiRS E{YB, 1024, nullptr, 0, 0.f, 1.f, 3, 31, 0};
          pg8::gemm_phase<pg8::EpiRS, pg8::MoeOrderC, true, true>(lds, g, S, E, wv); }
#endif
        xcd_barrier(bar);
        }
#if PH_F3
        { PH_BEGIN;
            const GAS float* g_fin = INP(25);
            int s0n = SLOT[gw * 2], s1n = SLOT[gw * 2 + 1];
            for (int m = gw; m < M; m += NGW) {
                GAS u32x2* xr = (GAS u32x2*)(XB + (size_t)m * D) + lane; const int s0 = s0n, s1 = s1n;
                if (m + NGW < M) { s0n = SLOT[(m + NGW) * 2]; s1n = SLOT[(m + NGW) * 2 + 1]; }
                const GAS u32x2* y0 = (const GAS u32x2*)(YB + (size_t)s0 * D) + lane; const GAS u32x2* y1 = (const GAS u32x2*)(YB + (size_t)s1 * D) + lane;
                f32x4 v[4]; float s = 0.f;
#pragma unroll
                for (int j = 0; j < 4; ++j) { const u32x2 a = y0[64 * j], b2 = y1[64 * j], xw = xr[64 * j];
                    v[j][0] = pg8::bflo(xw.x) + (pg8::bflo(a.x) + pg8::bflo(b2.x)); v[j][1] = pg8::bfhi(xw.x) + (pg8::bfhi(a.x) + pg8::bfhi(b2.x));
                    v[j][2] = pg8::bflo(xw.y) + (pg8::bflo(a.y) + pg8::bflo(b2.y)); v[j][3] = pg8::bfhi(xw.y) + (pg8::bfhi(a.y) + pg8::bfhi(b2.y));
                    s += (v[j][0] * v[j][0] + v[j][1] * v[j][1]) + (v[j][2] * v[j][2] + v[j][3] * v[j][3]); }
                s = wave_sum(s);
                if (l == DEPTH - 1) { const float rsd = 1.0f / sqrtf(s * (1.f / 1024.f) + 1e-6f); GAS f32x4* orow = (GAS f32x4*)(OUTP + (size_t)m * D) + lane;
#pragma unroll
                    for (int j = 0; j < 4; ++j) { const f32x4 gg = ((const GAS f32x4*)g_fin)[lane + 64 * j]; orow[64 * j] = v[j] * rsd * gg; }
                } else {
#pragma unroll
                    for (int j = 0; j < 4; ++j) { u32x2 w; w.x = pk2(v[j][0], v[j][1]); w.y = pk2(v[j][2], v[j][3]); xr[64 * j] = w; }
                    if (lane < 16) SSQ[(size_t)m * 16 + lane] = (lane == 0) ? s : 0.f;
                }
            }
        }
#endif
    }
}

extern "C" void kernel_launch(void* const* d_in, const int* in_sizes, int n_in, void* d_out, int out_size, void* d_ws, size_t ws_size, hipStream_t stream) {
    static int grid = 0;
    if (grid == 0) {
        if (n_in != 26 || in_sizes[0] != M * D || out_size != M * D || ws_size < WS_END) { fprintf(stderr, "kernel_launch: unexpected shapes (n_in %d, in0 %d, out %d, ws %zu < %zu)\n", n_in, n_in > 0 ? in_sizes[0] : -1, out_size, ws_size, (size_t)WS_END); grid = -1; return; }
        int dev = 0, cus = 0;
        if (hipGetDevice(&dev) != hipSuccess || hipDeviceGetAttribute(&cus, hipDeviceAttributeMultiprocessorCount, dev) != hipSuccess) { grid = -1; return; }
        if (hipFuncSetAttribute((const void*)fwd, hipFuncAttributeMaxDynamicSharedMemorySize, LDS_BYTES) != hipSuccess) { fprintf(stderr, "kernel_launch: hipFuncSetAttribute failed\n"); grid = -1; return; }
        int per_cu = 0;
        if (hipOccupancyMaxActiveBlocksPerMultiprocessor(&per_cu, (const void*)fwd, NTHREADS, LDS_BYTES) != hipSuccess || per_cu < 1) fprintf(stderr, "kernel_launch: occupancy query says %d\n", per_cu);
        (void)hipGetLastError();
        grid = cus < 256 ? (cus / 8) * 8 : 256;
    }
    if (grid <= 0) return;
    if (hipMemsetAsync((char*)d_ws + WS_CTL, 0, CTL_ZERO_BYTES, stream) != hipSuccess) return;
    Args a{};
    for (int i = 0; i < 26; ++i) a.in[i] = (const float*)d_in[i];
    a.out = (float*)d_out; a.ws = (unsigned char*)d_ws;
    hipLaunchKernelGGL(fwd, dim3(grid), dim3(NTHREADS), LDS_BYTES, stream, a);
}
```

```cpp
#include <hip/hip_runtime.h>
#include <cstdio>
#include <cstdint>
#define LAS __attribute__((address_space(3)))
#define GAS __attribute__((address_space(1)))
#ifndef PH_A
#define PH_A 1
#endif
#ifndef PH_B
#define PH_B 1
#endif
#ifndef PH_C
#define PH_C 1
#endif
#ifndef PH_D1
#define PH_D1 1
#endif
#ifndef PH_D2
#define PH_D2 1
#endif
#ifndef PH_E1
#define PH_E1 1
#endif
#ifndef PH_E2
#define PH_E2 1
#endif
#ifndef PH_E3
#define PH_E3 1
#endif
#ifndef PH_F0A
#define PH_F0A 1
#endif
#ifndef PH_F0B
#define PH_F0B 1
#endif
#ifndef PH_F1
#define PH_F1 1
#endif
#ifndef PH_F2
#define PH_F2 1
#endif
#ifndef PH_P0
#define PH_P0 1
#endif
#ifndef PH_F3
#define PH_F3 1
#endif
#ifndef PH_C_DIFF
#define PH_C_DIFF 1
#endif
#ifndef PH_C_SB
#define PH_C_SB 1
#endif
#ifndef PH_C_MLA
#define PH_C_MLA 1
#endif
#ifndef PH_B1
#define PH_B1 1
#endif
#ifndef PH_B2
#define PH_B2 1
#endif
#ifndef PH_B3
#define PH_B3 1
#endif
#ifndef RP_A
#define RP_A 1
#endif
#ifndef RP_B
#define RP_B 1
#endif
#ifndef RP_C
#define RP_C 1
#endif
#ifndef RP_D1
#define RP_D1 1
#endif
#ifndef RP_E1
#define RP_E1 1
#endif
#ifndef RP_E2
#define RP_E2 1
#endif
#ifndef RP_F0A
#define RP_F0A 1
#endif
#ifndef RP_F0B
#define RP_F0B 1
#endif
#ifndef RP_F1
#define RP_F1 1
#endif
#ifndef RP_F2
#define RP_F2 1
#endif
#ifndef RP_P0
#define RP_P0 1
#endif
#ifndef C_REP_MASK
#define C_REP_MASK 7
#endif
#ifndef A_ABL
#define A_ABL 0
#endif
#ifndef C_ABL
#define C_ABL 0
#endif
namespace pg8 {
#define PG8_LAS __attribute__((address_space(3)))
typedef unsigned short bf16_t;
typedef short bf16x8 __attribute__((ext_vector_type(8)));
typedef float f32x4 __attribute__((ext_vector_type(4)));
typedef unsigned u32x4 __attribute__((ext_vector_type(4)));
constexpr int BM = 256, BK = 64, HALF = 128, HTB = HALF * BK * 2  , STAGE_BYTES = 8 * HTB, NXCD = 8, WGM = 8;

__host__ __device__ __forceinline__ int lds_byte(int r, int c) { const int st = (r >> 4) * 2 + (c >> 5), rr = r & 15, cc = c & 31, ob = rr * 64 + cc * 2; return st * 1024 + (ob ^ (((ob >> 9) & 1) << 5)); }
__host__ __device__ __forceinline__ void stage_rc(int b, int& R, int& C) { const int st = b / 1024, sb = b % 1024, swz = sb ^ (((sb >> 9) & 1) << 5); R = (st >> 1) * 16 + swz / 64; C = (st & 1) * 32 + (swz % 64) / 2; }
__host__ __device__ __forceinline__ int perm32(int rho) { const int n = rho >> 4, i = rho & 15; return 8 * (i >> 2) + 4 * n + (i & 3); }

struct Unit { int pm, pn, sel; };
struct Gemm { const GAS bf16_t* A; const GAS bf16_t* Bt; int M, N, K, ld; const GAS int* rowidx; };

struct StaticOrder {
    int nM, nN, nwg, G, c;
    __host__ __device__ void init(int M, int N, int G_, int c_) { nM = M / BM; nN = N / BM; nwg = nM * nN; G = G_; c = c_; }
    __host__ __device__ bool next(int i, Unit& u) const {
        const long L = (long)i * G + c; if (L >= nwg) return false;
        int wgid = (int)L; { const int q = nwg / NXCD, r = nwg % NXCD, xcd = wgid % NXCD, off = wgid / NXCD; wgid = (xcd < r ? xcd * (q + 1) : r * (q + 1) + (xcd - r) * q) + off; }
        const int nig = WGM * nN, gid = wgid / nig, fm = gid * WGM, gsz = (nM - fm) < WGM ? (nM - fm) : WGM;
        u.pm = fm + ((wgid % nig) % gsz); u.pn = (wgid % nig) / gsz; u.sel = 0; return true;
    }
    __device__ __forceinline__ void a_ready(const Unit&) const {}
    __device__ __forceinline__ void done(const Unit&) const {}
    __device__ __forceinline__ size_t a_off(const Unit&) const { return 0; }
    __device__ __forceinline__ size_t b_off(const Unit&) const { return 0; }
    __device__ __forceinline__ bool keep(const Unit&) const { return false; }
};

__device__ __forceinline__ unsigned cvt_pk_bf16(float lo, float hi) { unsigned r; asm volatile("v_cvt_pk_bf16_f32 %0, %1, %2" : "=v"(r) : "v"(lo), "v"(hi)); return r; }
template <class T, class = void> struct HasScale { static constexpr bool v = false; };
template <class T> struct HasScale<T, decltype((void)T::SCALE)> { static constexpr bool v = true; };
template <class Epi, class Sched, bool ALIGN_EPI = false, bool SP2 = false, bool GATHER = false>
__device__ __forceinline__ void gemm_phase(PG8_LAS unsigned char* lds, const Gemm g, const Sched& S, const Epi& E, const int wave_idx) {
    int tid_; asm volatile("v_mbcnt_lo_u32_b32 %0, -1, 0\n\tv_mbcnt_hi_u32_b32 %0, -1, %0" : "=v"(tid_)); tid_ += wave_idx * 64;
    const int tid = tid_, wid = __builtin_amdgcn_readfirstlane(tid >> 6), lane = tid & 63, wr = wid >> 2, wc = wid & 3, fr = lane & 15, fq = lane >> 4;
    const int K = g.K, nt = K / BK, LD = g.ld;
    unsigned voffA[2], voffB[2];
#pragma unroll
    for (int i = 0; i < 2; ++i) { int R, C; stage_rc(tid * 16 + i * 8192, R, C); const int Rb = Epi::PERM ? ((R & ~31) + perm32(R & 31)) : R;
        voffA[i] = (unsigned)(R * LD + C) * 2u; voffB[i] = (unsigned)(Rb * LD + C) * 2u; }
    const size_t kstep = (size_t)(BK * 2);
    const size_t hstep = (size_t)HALF * LD * 2;
    const size_t tstep = 2 * hstep;
    const unsigned ldsw = (unsigned)wid * 1024u;
    const int aoff = lds_byte(wr * 64 + fr, fq * 8), boff = lds_byte(wc * 32 + fr, fq * 8);
#define PG8_SA(b, h) (((b) * 2 + (h)) * HTB)
#define PG8_SB(b, h) ((4 + (b) * 2 + (h)) * HTB)
#define PG8_STAGE(bufoff, gbase, voff) do { _Pragma("unroll") for (int _i = 0; _i < 2; ++_i) \
        __builtin_amdgcn_global_load_lds((const GAS unsigned*)((const GAS char*)(gbase) + (voff)[_i]), (PG8_LAS unsigned*)(lds + (bufoff) + ldsw + _i * 8192), 16, 0, 0); } while (0)
#define PG8_LDA(dst, b, h) do { _Pragma("unroll") for (int m = 0; m < 4; ++m) _Pragma("unroll") for (int k = 0; k < 2; ++k) dst[m][k] = *(const PG8_LAS bf16x8*)(lds + PG8_SA(b, h) + aoff + m * 2048 + k * 1024); } while (0)
#define PG8_LDB(dst, b, h) do { _Pragma("unroll") for (int n = 0; n < 2; ++n) _Pragma("unroll") for (int k = 0; k < 2; ++k) dst[n][k] = *(const PG8_LAS bf16x8*)(lds + PG8_SB(b, h) + boff + n * 2048 + k * 1024); } while (0)
#define PG8_MMA(ai, bj, At, Bt) do { __builtin_amdgcn_s_setprio(1); _Pragma("unroll") for (int m = 0; m < 4; ++m) _Pragma("unroll") for (int n = 0; n < 2; ++n) _Pragma("unroll") for (int k = 0; k < 2; ++k) \
        acc[ai][bj][m][n] = __builtin_amdgcn_mfma_f32_16x16x32_bf16(Bt[n][k], At[m][k], acc[ai][bj][m][n], 0, 0, 0); __builtin_amdgcn_s_setprio(0); } while (0)
#define PG8_WAIT_V(n) asm volatile("s_waitcnt vmcnt(" #n ")" ::: "memory")
#define PG8_WAIT_L(n) asm volatile("s_waitcnt lgkmcnt(" #n ")" ::: "memory")
#define PG8_BAR __builtin_amdgcn_s_barrier()
#define PG8_SCHED __builtin_amdgcn_sched_barrier(0)
    Unit cur, nxt; int ui = 0;
    if (!S.next(0, cur)) return;
    f32x4 acc[2][2][4][2];
#pragma unroll
    for (int a = 0; a < 2; ++a)
#pragma unroll
        for (int b = 0; b < 2; ++b)
#pragma unroll
            for (int m = 0; m < 4; ++m)
#pragma unroll
                for (int n = 0; n < 2; ++n) acc[a][b][m][n] = (f32x4){0.f, 0.f, 0.f, 0.f};
    bf16x8 At[4][2], B0[2][2], B1[2][2];
    const GAS char* cA = (const GAS char*)g.A + (GATHER ? (size_t)0 : (size_t)cur.pm * tstep + S.a_off(cur)); const GAS char* cB = (const GAS char*)g.Bt + (size_t)cur.pn * tstep + S.b_off(cur);
    unsigned vC[2][2], vN[2][2];
    if constexpr (GATHER) {
#pragma unroll
        for (int h = 0; h < 2; ++h)
#pragma unroll
            for (int i = 0; i < 2; ++i) { int R, C; stage_rc(tid * 16 + i * 8192, R, C); vC[h][i] = (unsigned)(g.rowidx[cur.pm * BM + h * HALF + R] * LD + C) * 2u; vN[h][i] = vC[h][i]; }
    }
#define PG8_STAGE_A(bufoff, gb, h, nx) do { if constexpr (GATHER) { unsigned vs_[2] = {(nx) ? vN[h][0] : vC[h][0], (nx) ? vN[h][1] : vC[h][1]}; PG8_STAGE(bufoff, gb, vs_); } \
        else { PG8_STAGE(bufoff, (gb) + (h) * hstep, voffA); } } while (0)
    S.a_ready(cur);
    if constexpr (SP2) {
        PG8_STAGE(PG8_SB(0, 0), cB, voffB); PG8_STAGE(PG8_SB(0, 1), cB + hstep, voffB); PG8_STAGE_A(PG8_SA(0, 0), cA, 0, false); PG8_STAGE_A(PG8_SA(0, 1), cA, 1, false);
        if (wr == 1) PG8_BAR;
        PG8_WAIT_V(2); PG8_BAR;
        PG8_STAGE(PG8_SB(1, 0), cB + kstep, voffB); PG8_STAGE_A(PG8_SA(1, 0), cA + kstep, 0, false); PG8_STAGE(PG8_SB(1, 1), cB + hstep + kstep, voffB);
        PG8_WAIT_V(6); PG8_BAR;
    } else {
        PG8_STAGE(PG8_SB(0, 0), cB, voffB); PG8_STAGE(PG8_SA(0, 0), cA, voffA); PG8_STAGE(PG8_SB(0, 1), cB + hstep, voffB); PG8_STAGE(PG8_SA(0, 1), cA + hstep, voffA);
        if (wr == 1) PG8_BAR;
        PG8_WAIT_V(4); PG8_BAR;
        PG8_STAGE(PG8_SB(1, 0), cB + kstep, voffB); PG8_STAGE(PG8_SA(1, 0), cA + kstep, voffA); PG8_STAGE(PG8_SB(1, 1), cB + hstep + kstep, voffB);
        PG8_WAIT_V(6); PG8_BAR;
    }
    for (;;) {
        const bool has_next = S.next(ui + 1, nxt);
        if constexpr (GATHER) { if (has_next) {
#pragma unroll
            for (int h = 0; h < 2; ++h)
#pragma unroll
                for (int i = 0; i < 2; ++i) { int R, C; stage_rc(tid * 16 + i * 8192, R, C); vN[h][i] = (unsigned)(g.rowidx[nxt.pm * BM + h * HALF + R] * LD + C) * 2u; } } }
        const GAS char* nA = GATHER ? cA : has_next ? (const GAS char*)g.A + (size_t)nxt.pm * tstep + S.a_off(nxt) : cA; const GAS char* nB = has_next ? (const GAS char*)g.Bt + (size_t)nxt.pn * tstep + S.b_off(nxt) : cB;
        for (int t = 0; t < nt; t += 2) {
            const bool last = (t == nt - 2);
            const GAS char* a1 = cA + (size_t)(t + 1) * kstep;
            const GAS char* a2 = last ? nA : cA + (size_t)(t + 2) * kstep; const GAS char* b2 = last ? nB : cB + (size_t)(t + 2) * kstep;
            const GAS char* a3 = a2 + kstep; const GAS char* b3 = b2 + kstep;
            if (last && has_next) S.a_ready(nxt);
            if constexpr (SP2) {
            PG8_LDB(B0, 0, 0); PG8_LDB(B1, 0, 1); PG8_SCHED; PG8_LDA(At, 0, 0); PG8_STAGE_A(PG8_SA(1, 1), a1, 1, false);
            PG8_WAIT_V(8); PG8_WAIT_L(0); PG8_BAR; PG8_MMA(0, 0, At, B0); PG8_MMA(0, 1, At, B1); PG8_BAR; PG8_SCHED;
            PG8_LDA(At, 0, 1); PG8_STAGE(PG8_SB(0, 0), b2, voffB); PG8_STAGE(PG8_SB(0, 1), b2 + hstep, voffB); PG8_STAGE_A(PG8_SA(0, 0), a2, 0, last);
            PG8_WAIT_V(8); PG8_WAIT_L(0); PG8_BAR; PG8_MMA(1, 0, At, B0); PG8_MMA(1, 1, At, B1); PG8_BAR; PG8_SCHED;
            PG8_LDB(B0, 1, 0); PG8_LDB(B1, 1, 1); PG8_SCHED; PG8_LDA(At, 1, 0); PG8_STAGE_A(PG8_SA(0, 1), a2, 1, last);
            PG8_WAIT_V(8); PG8_WAIT_L(0); PG8_BAR; PG8_MMA(0, 0, At, B0); PG8_MMA(0, 1, At, B1); PG8_BAR; PG8_SCHED;
            PG8_LDA(At, 1, 1); PG8_STAGE(PG8_SB(1, 0), b3, voffB); PG8_STAGE(PG8_SB(1, 1), b3 + hstep, voffB); PG8_STAGE_A(PG8_SA(1, 0), a3, 0, last);
            PG8_WAIT_V(8); PG8_WAIT_L(0); PG8_BAR; PG8_MMA(1, 0, At, B0); PG8_MMA(1, 1, At, B1); PG8_BAR; PG8_SCHED;
            } else {
            PG8_LDB(B0, 0, 0); PG8_SCHED; PG8_LDA(At, 0, 0); PG8_STAGE(PG8_SA(1, 1), a1 + hstep, voffA);
            PG8_WAIT_L(8); PG8_BAR; PG8_WAIT_L(0); PG8_MMA(0, 0, At, B0); PG8_BAR; PG8_SCHED;
            PG8_LDB(B1, 0, 1); PG8_STAGE(PG8_SB(0, 0), b2, voffB);
            PG8_BAR; PG8_WAIT_L(0); PG8_MMA(0, 1, At, B1); PG8_BAR;
            PG8_LDA(At, 0, 1); PG8_STAGE(PG8_SA(0, 0), a2, voffA);
            PG8_BAR; PG8_WAIT_L(0); PG8_MMA(1, 0, At, B0); PG8_BAR; PG8_SCHED;
            PG8_STAGE(PG8_SB(0, 1), b2 + hstep, voffB);
            PG8_WAIT_V(6); PG8_BAR; PG8_MMA(1, 1, At, B1); PG8_BAR;
            PG8_LDB(B0, 1, 0); PG8_SCHED; PG8_LDA(At, 1, 0); PG8_STAGE(PG8_SA(0, 1), a2 + hstep, voffA);
            PG8_WAIT_L(8); PG8_BAR; PG8_WAIT_L(0); PG8_MMA(0, 0, At, B0); PG8_BAR; PG8_SCHED;
            PG8_LDB(B1, 1, 1); PG8_STAGE(PG8_SB(1, 0), b3, voffB);
            PG8_BAR; PG8_WAIT_L(0); PG8_MMA(0, 1, At, B1); PG8_BAR;
            PG8_LDA(At, 1, 1); PG8_STAGE(PG8_SA(1, 0), a3, voffA);
            PG8_BAR; PG8_WAIT_L(0); PG8_MMA(1, 0, At, B0); PG8_BAR; PG8_SCHED;
            PG8_STAGE(PG8_SB(1, 1), b3 + hstep, voffB);
            PG8_WAIT_V(6); PG8_BAR; PG8_MMA(1, 1, At, B1); PG8_BAR;
            }
        }
        if constexpr (ALIGN_EPI) { if (wr == 0) PG8_BAR; }
        const int keep_ = (int)S.keep(cur);
        if constexpr (HasScale<Epi>::v) { if (keep_ == 2) E.scale(acc, cur, wr, wc, fr, fq); }
        if constexpr (!Epi::AFTER_DRAIN) { if (keep_ == 0) { E(acc, cur, wr, wc, fr, fq); S.done(cur); } }
        if (!has_next) break;
        if (keep_ == 0) {
#pragma unroll
        for (int a = 0; a < 2; ++a)
#pragma unroll
            for (int b = 0; b < 2; ++b)
#pragma unroll
                for (int m = 0; m < 4; ++m)
#pragma unroll
                    for (int n = 0; n < 2; ++n) acc[a][b][m][n] = (f32x4){0.f, 0.f, 0.f, 0.f}; }
        cur = nxt; cA = nA; cB = nB; ++ui;
        if constexpr (GATHER) { vC[0][0] = vN[0][0]; vC[0][1] = vN[0][1]; vC[1][0] = vN[1][0]; vC[1][1] = vN[1][1]; }
        if constexpr (ALIGN_EPI) { if (wr == 1) PG8_BAR; }
    }
    PG8_WAIT_V(0);
    if constexpr (!ALIGN_EPI) { if (wr == 0) PG8_BAR; }
    PG8_BAR;
    if constexpr (Epi::AFTER_DRAIN) { E.fused(acc, cur, wr, wc, fr, fq, lds, wid, lane); S.done(cur); }
#undef PG8_SA
#undef PG8_SB
#undef PG8_STAGE
#undef PG8_STAGE_A
#undef PG8_LDA
#undef PG8_LDB
#undef PG8_MMA
#undef PG8_WAIT_V
#undef PG8_WAIT_L
#undef PG8_BAR
#undef PG8_SCHED
}
typedef unsigned u32x2 __attribute__((ext_vector_type(2)));
typedef float f32x2v __attribute__((ext_vector_type(2)));
typedef __bf16 bf16x2v __attribute__((ext_vector_type(2)));
__device__ __forceinline__ unsigned pk2(float lo, float hi) { f32x2v v = {lo, hi}; bf16x2v b = __builtin_convertvector(v, bf16x2v); return __builtin_bit_cast(unsigned, b); }
__device__ __forceinline__ float bflo(unsigned w) { return __builtin_bit_cast(float, w << 16); }
__device__ __forceinline__ float bfhi(unsigned w) { return __builtin_bit_cast(float, w & 0xffff0000u); }
__device__ __forceinline__ float rstd_parts(const GAS float* base, unsigned eoff, int n4, float inv_n) {
    float s = 0.f; const GAS char* p = (const GAS char*)base + (size_t)(eoff * 4u);
    for (int i = 0; i < n4; ++i) { const f32x4 v = *(const GAS f32x4*)(p + 16 * i); s += (v[0] + v[1]) + (v[2] + v[3]); }
    return __builtin_amdgcn_rsqf(s * inv_n + 1e-6f);
}
__device__ __forceinline__ __amdgpu_buffer_rsrc_t wt_rsrc(GAS void* base) { return __builtin_amdgcn_make_buffer_rsrc((void*)base, 0, 0x7fffffff, 0x00020000); }
__device__ __forceinline__ void st16_wt(__amdgpu_buffer_rsrc_t r, unsigned byteoff, u32x4 v) { __builtin_amdgcn_raw_buffer_store_b128(v, r, byteoff, 0, 16); }
__device__ __forceinline__ float rows4_sum(float s) {
    const unsigned u = __builtin_bit_cast(unsigned, s);
    auto r = __builtin_amdgcn_permlane16_swap(u, u, false, false);
    const float t = __builtin_bit_cast(float, (unsigned)r[0]) + __builtin_bit_cast(float, (unsigned)r[1]);
    const unsigned v = __builtin_bit_cast(unsigned, t);
    auto q = __builtin_amdgcn_permlane32_swap(v, v, false, false);
    return __builtin_bit_cast(float, (unsigned)q[0]) + __builtin_bit_cast(float, (unsigned)q[1]);
}
__device__ __forceinline__ float rstd16_coop(const GAS float* base, unsigned row, int fq, float inv_n) {
    const f32x4 v = *(const GAS f32x4*)((const GAS char*)base + (size_t)((row * 16u + (unsigned)fq * 4u) * 4u));
    return __builtin_amdgcn_rsqf(rows4_sum((v[0] + v[1]) + (v[2] + v[3])) * inv_n + 1e-6f);
}
__device__ __forceinline__ void swap16(unsigned& a, unsigned& b) { auto r = __builtin_amdgcn_permlane16_swap(a, b, false, false); a = r[0]; b = r[1]; }
__device__ __forceinline__ int swz8(int fq) { return 8 * (((fq & 1) << 1) | (fq >> 1)); }
__device__ const double kRopeRev[16] = {0.15915494309189535, 0.08949940160889101, 0.050329212104487035, 0.0283021958306234, 0.015915494309189534, 0.008949940160889102, 0.005032921210448704, 0.00283021958306234,
                                        0.0015915494309189536, 0.0008949940160889102, 0.0005032921210448703, 0.00028302195830623395, 0.00015915494309189535, 8.949940160889102e-05, 5.0329212104487035e-05, 2.8302195830623396e-05};
__device__ __forceinline__ void rope_cs(int pos, int i, float& cs, float& sn) {
    double a = (double)pos * kRopeRev[i]; a -= __builtin_floor(a);
    const float r = (float)a; sn = __builtin_amdgcn_sinf(r); cs = __builtin_amdgcn_cosf(r);
}
#define PG8_L2E 1.4426950408889634f

struct EpiA {
    static constexpr bool PERM = false, AFTER_DRAIN = false;
    const GAS float* ssq; GAS bf16_t *cq, *ckv, *krope, *qk; GAS float *ssq_cq, *ssq_ckv; float c2; GAS unsigned* kn; int skip;
    __device__ __forceinline__ void operator()(const f32x4 (&acc)[2][2][4][2], const Unit& u, int wr, int wc, int fr, int fq) const {
        if (skip) return;
        const int pn = u.pn, row0 = u.pm * BM + wr * 64 + fr;
        float rs[2][4];
#pragma unroll
        for (int ai = 0; ai < 2; ++ai)
#pragma unroll
            for (int m = 0; m < 4; ++m) rs[ai][m] = rstd16_coop(ssq, (unsigned)(row0 + ai * HALF + m * 16), fq, 1.f / 1024.f);
        if (pn < 2) {
            GAS bf16_t* dst = pn == 0 ? cq : ckv; GAS float* sq = pn == 0 ? ssq_cq : ssq_ckv;
#pragma unroll
            for (int ai = 0; ai < 2; ++ai)
#pragma unroll
                for (int m = 0; m < 4; ++m) { const int row = row0 + ai * HALF + m * 16; const float r = rs[ai][m]; float s2 = 0.f;
#pragma unroll
                    for (int bj = 0; bj < 2; ++bj) { const f32x4 v = acc[ai][bj][m][0] * r, v2 = acc[ai][bj][m][1] * r;
                        s2 += ((v[0] * v[0] + v[1] * v[1]) + (v[2] * v[2] + v[3] * v[3])) + ((v2[0] * v2[0] + v2[1] * v2[1]) + (v2[2] * v2[2] + v2[3] * v2[3]));
                        unsigned wx = pk2(v[0], v[1]), wy = pk2(v[2], v[3]), wz = pk2(v2[0], v2[1]), ww = pk2(v2[2], v2[3]); swap16(wx, wz); swap16(wy, ww); const u32x4 w = {wx, wy, wz, ww};
                        *(GAS u32x4*)(dst + (size_t)row * 256 + bj * HALF + wc * 32 + swz8(fq)) = w; }
                    s2 = rows4_sum(s2);
                    if (fq == 0) sq[(size_t)row * 4 + wc] = s2; }
        } else if (pn == 2) {
            if (wc == 0) {
#pragma unroll
                for (int ai = 0; ai < 2; ++ai)
#pragma unroll
                    for (int m = 0; m < 4; ++m) { const int row = row0 + ai * HALF + m * 16, pos = row & 8191; const float r = rs[ai][m];
                        const f32x4 v0 = acc[ai][0][m][0] * r, v1 = acc[ai][0][m][1] * r; float o0[4], o1[4];
#pragma unroll
                        for (int e = 0; e < 4; ++e) { float cs, sn; rope_cs(pos, 4 * fq + e, cs, sn); o0[e] = v0[e] * cs - v1[e] * sn; o1[e] = v0[e] * sn + v1[e] * cs; }
                        u32x2 w0, w1; w0.x = pk2(o0[0], o0[1]); w0.y = pk2(o0[2], o0[3]); w1.x = pk2(o1[0], o1[1]); w1.y = pk2(o1[2], o1[3]);
                        *(GAS u32x2*)(krope + (size_t)row * 32 + 4 * fq) = w0; *(GAS u32x2*)(krope + (size_t)row * 32 + 16 + 4 * fq) = w1; }
            }
        } else {
            const int t = pn - 3, buf = t >> 1, half = t & 1; GAS bf16_t* dst = qk + (size_t)buf * 16384 * 512; const float sc = (buf & 1) ? 1.f : c2;
#pragma unroll
            for (int ai = 0; ai < 2; ++ai)
#pragma unroll
                for (int bj = 0; bj < 2; ++bj) { float kmx = 0.f;
#pragma unroll
                    for (int m = 0; m < 4; ++m) { const int row = row0 + ai * HALF + m * 16; const float r = rs[ai][m] * sc;
                        const f32x4 v = acc[ai][bj][m][0] * r, v2 = acc[ai][bj][m][1] * r;
                        const float s2 = ((v[0] * v[0] + v[1] * v[1]) + (v[2] * v[2] + v[3] * v[3])) + ((v2[0] * v2[0] + v2[1] * v2[1]) + (v2[2] * v2[2] + v2[3] * v2[3]));
                        unsigned wx = pk2(v[0], v[1]), wy = pk2(v[2], v[3]), wz = pk2(v2[0], v2[1]), ww = pk2(v2[2], v2[3]); swap16(wx, wz); swap16(wy, ww); const u32x4 w = {wx, wy, wz, ww};
                        *(GAS u32x4*)(dst + (size_t)row * 512 + half * 256 + bj * HALF + wc * 32 + swz8(fq)) = w;
                        kmx = fmaxf(kmx, s2); }
                    if (pn >= 9) {
                        float s = kmx; const float q1 = __shfl_xor(s, 16), q2 = __shfl_xor(s, 32), q3 = __shfl_xor(q1, 32); s = (s + q1) + (q2 + q3);
                        s = fmaxf(s, __shfl_xor(s, 1)); s = fmaxf(s, __shfl_xor(s, 2)); s = fmaxf(s, __shfl_xor(s, 4)); s = fmaxf(s, __shfl_xor(s, 8));
                        if ((fr | fq) == 0) __hip_atomic_fetch_max(kn + (((size_t)(4 * u.pm + 2 * ai + wr) * 8 + 4 * (pn - 9) + 2 * bj + (wc >> 1)) * 2 + (wc & 1)), __builtin_bit_cast(unsigned, s), __ATOMIC_RELAXED, __HIP_MEMORY_SCOPE_AGENT); } }
        }
    }
};
struct EpiVT {
    static constexpr bool PERM = true, AFTER_DRAIN = false;
    GAS bf16_t* out; int ld; const GAS float* ssq; int n4; float inv_n;
    __device__ __forceinline__ void operator()(const f32x4 (&acc)[2][2][4][2], const Unit& u, int wr, int wc, int fr, int fq) const {
        const int col0 = u.pn * BM + wc * 32 + 8 * fq, row0 = u.pm * BM + wr * 64 + fr;
        float cs[2][8];
        { const int ln = fq * 16 + fr;
          const float mine = rstd_parts(ssq, (unsigned)((u.pn * BM + wc * 32 + (ln >> 5) * HALF + ((ln >> 3) & 3) * 8 + (ln & 7)) * (4 * n4)), n4, inv_n);
#pragma unroll
          for (int bj = 0; bj < 2; ++bj)
#pragma unroll
            for (int j = 0; j < 8; ++j) cs[bj][j] = __shfl(mine, bj * 32 + fq * 8 + j); }
#pragma unroll
        for (int ai = 0; ai < 2; ++ai)
#pragma unroll
            for (int m = 0; m < 4; ++m) { GAS bf16_t* rowp = out + (size_t)(row0 + ai * HALF + m * 16) * ld + col0;
#pragma unroll
                for (int bj = 0; bj < 2; ++bj) { const f32x4 v0 = acc[ai][bj][m][0], v1 = acc[ai][bj][m][1]; u32x4 w;
                    w.x = pk2(v0[0] * cs[bj][0], v0[1] * cs[bj][1]); w.y = pk2(v0[2] * cs[bj][2], v0[3] * cs[bj][3]);
                    w.z = pk2(v1[0] * cs[bj][4], v1[1] * cs[bj][5]); w.w = pk2(v1[2] * cs[bj][6], v1[3] * cs[bj][7]);
                    *(GAS u32x4*)(rowp + bj * HALF) = w; } }
    }
};
struct EpiRS {
    static constexpr bool PERM = true, AFTER_DRAIN = false;
    GAS bf16_t* out; int ld; const GAS float* ssq; int n4; float inv_n; float scale; int pnmask; int pnshift; size_t zstride;
    __device__ __forceinline__ void operator()(const f32x4 (&acc)[2][2][4][2], const Unit& u, int wr, int wc, int fr, int fq) const {
        const int col0 = (u.pn & pnmask) * BM + wc * 32 + 8 * fq, row0 = u.pm * BM + wr * 64 + fr;
        float rr[2][4];
#pragma unroll
        for (int ai = 0; ai < 2; ++ai)
#pragma unroll
            for (int m = 0; m < 4; ++m) rr[ai][m] = (n4 ? rstd_parts(ssq, (unsigned)((row0 + ai * HALF + m * 16) * (4 * n4)), n4, inv_n) : 1.f) * scale;
#pragma unroll
        for (int ai = 0; ai < 2; ++ai)
#pragma unroll
            for (int m = 0; m < 4; ++m) { const int row = row0 + ai * HALF + m * 16; const float r = rr[ai][m];
                GAS bf16_t* rowp = out + (size_t)(u.pn >> pnshift) * zstride + (size_t)row * ld + col0;
#pragma unroll
                for (int bj = 0; bj < 2; ++bj) { const f32x4 v0 = acc[ai][bj][m][0] * r, v1 = acc[ai][bj][m][1] * r; u32x4 w;
                    w.x = pk2(v0[0], v0[1]); w.y = pk2(v0[2], v0[3]); w.z = pk2(v1[0], v1[1]); w.w = pk2(v1[2], v1[3]); *(GAS u32x4*)(rowp + bj * HALF) = w; } }
    }
};
struct EpiQ {
    static constexpr bool PERM = false, AFTER_DRAIN = false;
    GAS bf16_t* q; const GAS float* ssq_cq; float c2;
    __device__ __forceinline__ void operator()(const f32x4 (&acc)[2][2][4][2], const Unit& u, int wr, int wc, int fr, int fq) const {
        const int pn = u.pn, row0 = u.pm * BM + wr * 64 + fr;
        float rr[2][4];
#pragma unroll
        for (int ai = 0; ai < 2; ++ai)
#pragma unroll
            for (int m = 0; m < 4; ++m) rr[ai][m] = rstd_parts(ssq_cq, (unsigned)((row0 + ai * HALF + m * 16) * 4), 1, 1.f / 256.f) * c2;
#pragma unroll
        for (int ai = 0; ai < 2; ++ai)
#pragma unroll
            for (int m = 0; m < 4; ++m) { const int row = row0 + ai * HALF + m * 16; const float r = rr[ai][m];
                if (pn < 2) {
#pragma unroll
                    for (int bj = 0; bj < 2; ++bj) { const f32x4 v = acc[ai][bj][m][0] * r, v2 = acc[ai][bj][m][1] * r;
                        unsigned wx = pk2(v[0], v[1]), wy = pk2(v[2], v[3]), wz = pk2(v2[0], v2[1]), ww = pk2(v2[2], v2[3]); swap16(wx, wz); swap16(wy, ww); const u32x4 w = {wx, wy, wz, ww};
                        *(GAS u32x4*)(q + (size_t)row * 768 + pn * 256 + bj * HALF + wc * 32 + swz8(fq)) = w; }
                } else { const int pos = row & 8191; float cs[4], sn[4];
#pragma unroll
                    for (int e = 0; e < 4; ++e) rope_cs(pos, 4 * fq + e, cs[e], sn[e]);
#pragma unroll
                    for (int bj = 0; bj < 2; ++bj) { const f32x4 v0 = acc[ai][bj][m][0] * r, v1 = acc[ai][bj][m][1] * r; float o0[4], o1[4];
#pragma unroll
                        for (int e = 0; e < 4; ++e) { o0[e] = v0[e] * cs[e] - v1[e] * sn[e]; o1[e] = v0[e] * sn[e] + v1[e] * cs[e]; }
                        u32x2 w0, w1; w0.x = pk2(o0[0], o0[1]); w0.y = pk2(o0[2], o0[3]); w1.x = pk2(o1[0], o1[1]); w1.y = pk2(o1[2], o1[3]);
                        GAS bf16_t* p = q + (size_t)row * 768 + 512 + (4 * bj + wc) * 32 + 4 * fq; *(GAS u32x2*)p = w0; *(GAS u32x2*)(p + 16) = w1; }
                } }
    }
};
struct D1Order {
    StaticOrder so; size_t dA, dB;
    __device__ __forceinline__ bool next(int i, Unit& u) const { if (i >= 9) return false; if (!so.next(0, u)) return false; u.sel = i; return true; }
    __device__ __forceinline__ void a_ready(const Unit&) const {}
    __device__ __forceinline__ void done(const Unit&) const {}
    __device__ __forceinline__ size_t a_off(const Unit& u) const { const int z = u.sel - 6; return u.sel >= 6 ? dA + (size_t)(z >> 1) * 16384 * 2048 + (size_t)(z & 1) * 1024 : (size_t)(u.sel & 1) * 1024; }
    __device__ __forceinline__ size_t b_off(const Unit& u) const { const int z = u.sel - 6; return u.sel >= 6 ? dB + (size_t)(z >> 1) * 1024 * 2048 + (size_t)(z & 1) * 1024 : (size_t)(u.sel >> 1) * 1024 * 2048 + (size_t)(u.sel & 1) * 1024; }
    __device__ __forceinline__ int keep(const Unit& u) const { return u.sel < 6 ? ((u.sel & 1) ? 0 : 1) : (u.sel < 8 ? 2 : 0); }
};
struct EpiD1 {
    static constexpr bool PERM = true, AFTER_DRAIN = false, SCALE = true;
    GAS unsigned char* g; GAS bf16_t* mb; const GAS float* ssq;
    __device__ __forceinline__ void scale(f32x4 (&acc)[2][2][4][2], const Unit& u, int wr, int wc, int fr, int fq) const {
        const unsigned toff = (unsigned)(((wr * 4 + wc) * 64 + fq * 16 + fr) * 16), tile8 = (unsigned)(u.pm * 4 + u.pn) * 8u;
        const GAS unsigned char* ga = g + (size_t)((unsigned)(u.sel - 6) * 2048u + tile8) * 8192u + toff;
        const GAS unsigned char* gb = ga + (size_t)2048 * 8192;
#pragma unroll
        for (int ai = 0; ai < 2; ++ai) {
            u32x4 wa[2][2], wb[2][2];
#pragma unroll
            for (int bj = 0; bj < 2; ++bj)
#pragma unroll
                for (int mp = 0; mp < 2; ++mp) { wa[bj][mp] = *(const GAS u32x4*)(ga + ((ai * 2 + bj) * 2 + mp) * 8192); wb[bj][mp] = *(const GAS u32x4*)(gb + ((ai * 2 + bj) * 2 + mp) * 8192); }
#pragma unroll
            for (int bj = 0; bj < 2; ++bj)
#pragma unroll
                for (int mp = 0; mp < 2; ++mp)
#pragma unroll
                    for (int k = 0; k < 4; ++k) { const int m = 2 * mp + (k >> 1), n = k & 1; const unsigned qa = wa[bj][mp][k], qb = wb[bj][mp][k];
#pragma unroll
                        for (int e2 = 0; e2 < 4; ++e2) acc[ai][bj][m][n][e2] *= ((float)((qa >> (8 * e2)) & 0xffu) + 0.5f) * __builtin_amdgcn_rcpf((float)((qb >> (8 * e2)) & 0xffu) + 0.5f); }
        }
    }
    __device__ __forceinline__ void operator()(const f32x4 (&acc)[2][2][4][2], const Unit& u, int wr, int wc, int fr, int fq) const {
        const int col0 = u.pn * BM + wc * 32 + 8 * fq, row0 = u.pm * BM + wr * 64 + fr;
        const unsigned toff = (unsigned)(((wr * 4 + wc) * 64 + fq * 16 + fr) * 16), tile8 = (unsigned)(u.pm * 4 + u.pn) * 8u;
        if (u.sel < 6) {
            GAS unsigned char* gz = g + (size_t)((unsigned)(u.sel >> 1) * 2048u + tile8) * 8192u + toff;
            float rr[2][4];
#pragma unroll
            for (int ai = 0; ai < 2; ++ai)
#pragma unroll
                for (int m = 0; m < 4; ++m) rr[ai][m] = -PG8_L2E * rstd16_coop(ssq, (unsigned)(row0 + ai * HALF + m * 16), fq, 1.f / 1024.f);
#pragma unroll
            for (int ai = 0; ai < 2; ++ai)
#pragma unroll
                for (int bj = 0; bj < 2; ++bj)
#pragma unroll
                    for (int mp = 0; mp < 2; ++mp) { u32x4 w;
#pragma unroll
                        for (int k = 0; k < 4; ++k) { const int m = 2 * mp + (k >> 1), n = k & 1; const float r = rr[ai][m]; unsigned pk = 0u;
#pragma unroll
                            for (int e2 = 0; e2 < 4; ++e2) { const float sg = __builtin_amdgcn_rcpf(1.f + __builtin_amdgcn_exp2f(acc[ai][bj][m][n][e2] * r));
                                pk = __builtin_amdgcn_cvt_pk_u8_f32(sg * 256.f - 0.5f, e2, pk); }
                            w[k] = pk; }
                        *(GAS u32x4*)(gz + ((ai * 2 + bj) * 2 + mp) * 8192) = w; }
        } else {
            const GAS unsigned char* ga = g + (size_t)(2u * 2048u + tile8) * 8192u + toff;
#pragma unroll
            for (int ai = 0; ai < 2; ++ai) {
                u32x4 wa[2][2];
#pragma unroll
                for (int bj = 0; bj < 2; ++bj)
#pragma unroll
                    for (int mp = 0; mp < 2; ++mp) wa[bj][mp] = *(const GAS u32x4*)(ga + ((ai * 2 + bj) * 2 + mp) * 8192);
#pragma unroll
                for (int m = 0; m < 4; ++m)
#pragma unroll
                    for (int bj = 0; bj < 2; ++bj) { const size_t o = (size_t)(row0 + ai * HALF + m * 16) * 1024 + col0 + bj * HALF; float v[8];
#pragma unroll
                        for (int j = 0; j < 8; ++j) { const unsigned qa = wa[bj][m >> 1][(m & 1) * 2 + (j >> 2)];
                            v[j] = acc[ai][bj][m][j >> 2][j & 3] * (((float)((qa >> (8 * (j & 3))) & 0xffu) + 0.5f) * (1.f / 256.f)); }
                        u32x4 w; w.x = pk2(v[0], v[1]); w.y = pk2(v[2], v[3]); w.z = pk2(v[4], v[5]); w.w = pk2(v[6], v[7]); *(GAS u32x4*)(mb + o) = w; } }
        }
    }
};
struct EpiRes {
    static constexpr bool PERM = true, AFTER_DRAIN = false;
    GAS bf16_t* xb; GAS float* ssq;
    __device__ __forceinline__ void operator()(const f32x4 (&acc)[2][2][4][2], const Unit& u, int wr, int wc, int fr, int fq) const {
        const int col0 = u.pn * BM + wc * 32 + 8 * fq, row0 = u.pm * BM + wr * 64 + fr;
#pragma unroll
        for (int ai = 0; ai < 2; ++ai) {
            u32x4 xv[4][2];
#pragma unroll
            for (int m = 0; m < 4; ++m)
#pragma unroll
                for (int bj = 0; bj < 2; ++bj) xv[m][bj] = *(const GAS u32x4*)(xb + (size_t)(row0 + ai * HALF + m * 16) * 1024 + col0 + bj * HALF);
#pragma unroll
            for (int m = 0; m < 4; ++m) { const int row = row0 + ai * HALF + m * 16; const size_t rb = (size_t)row * 1024 + col0; float s2 = 0.f;
#pragma unroll
                for (int bj = 0; bj < 2; ++bj) { const u32x4 xw = xv[m][bj]; const f32x4 a0 = acc[ai][bj][m][0], a1 = acc[ai][bj][m][1];
                    const float v0 = bflo(xw.x) + a0[0], v1 = bfhi(xw.x) + a0[1], v2 = bflo(xw.y) + a0[2], v3 = bfhi(xw.y) + a0[3];
                    const float v4 = bflo(xw.z) + a1[0], v5 = bfhi(xw.z) + a1[1], v6 = bflo(xw.w) + a1[2], v7 = bfhi(xw.w) + a1[3];
                    u32x4 w; w.x = pk2(v0, v1); w.y = pk2(v2, v3); w.z = pk2(v4, v5); w.w = pk2(v6, v7);
                    *(GAS u32x4*)(xb + rb + bj * HALF) = w;
                    s2 += ((v0 * v0 + v1 * v1) + (v2 * v2 + v3 * v3)) + ((v4 * v4 + v5 * v5) + (v6 * v6 + v7 * v7)); }
                s2 += __shfl_xor(s2, 16); s2 += __shfl_xor(s2, 32);
                if (fq == 0) ssq[(size_t)row * 16 + u.pn * 4 + wc] = s2; } }
    }
};
struct EpiAct {
    static constexpr bool PERM = true, AFTER_DRAIN = false;
    GAS bf16_t* act; const GAS float* s_rstd; const GAS float* s_w;
    __device__ __forceinline__ void operator()(const f32x4 (&acc)[2][2][4][2], const Unit& u, int wr, int wc, int fr, int fq) const {
        const int t = u.pn & 1, row0 = u.pm * BM + wr * 64 + fr;
        const __amdgpu_buffer_rsrc_t rsrc = __builtin_amdgcn_make_buffer_rsrc((void*)act, 0, 40960 * 256 * 2, 0x00020000);
        float rr[2][4], ww[2][4];
#pragma unroll
        for (int ai = 0; ai < 2; ++ai)
#pragma unroll
            for (int m = 0; m < 4; ++m) { rr[ai][m] = s_rstd[row0 + ai * HALF + m * 16]; ww[ai][m] = s_w[row0 + ai * HALF + m * 16]; }
#pragma unroll
        for (int ai = 0; ai < 2; ++ai)
#pragma unroll
            for (int m = 0; m < 4; ++m) { const int row = row0 + ai * HALF + m * 16; const float rs = rr[ai][m], w = ww[ai][m]; float o[8];
#pragma unroll
                for (int j = 0; j < 8; ++j) { const float a = acc[ai][0][m][j >> 2][j & 3] * rs, b = acc[ai][1][m][j >> 2][j & 3] * rs;
                    const float v = a * __builtin_amdgcn_rcpf(1.f + __builtin_amdgcn_exp2f(-PG8_L2E * a)) * b * w; o[j] = (w != 0.f) ? v : 0.f; }
                u32x4 pw; pw.x = pk2(o[0], o[1]); pw.y = pk2(o[2], o[3]); pw.z = pk2(o[4], o[5]); pw.w = pk2(o[6], o[7]);
                __builtin_amdgcn_raw_buffer_store_b128(pw, rsrc, (unsigned)(row * 256 + t * 128 + wc * 32 + 8 * fq) * 2u, 0,   16); }
    }
};
struct SplitK2Order {
    StaticOrder so; size_t tstep;
    __device__ __forceinline__ bool next(int i, Unit& u) const { return so.next(i, u); }
    __device__ __forceinline__ void a_ready(const Unit&) const {}
    __device__ __forceinline__ void done(const Unit&) const {}
    __device__ __forceinline__ size_t a_off(const Unit& u) const { return (size_t)(u.pn >> 1) * 1024; }
    __device__ __forceinline__ size_t b_off(const Unit& u) const { return (size_t)(u.pn >> 1) * 1024 - (size_t)(u.pn >> 1) * 2 * tstep; }
    __device__ __forceinline__ bool keep(const Unit&) const { return false; }
};
struct MoeOrder {
    const PG8_LAS int* tstart; int per, G, v;
    __device__ __forceinline__ bool next(int i, Unit& u) const {
        const int idx = i * G + v, tot = tstart[32] * per; if (idx >= tot) return false;
        const int ti = idx / per, ct = idx - ti * per; int e = 0;
#pragma unroll 1
        for (int k = 1; k < 32; ++k) e += (tstart[k] <= ti) ? 1 : 0;
        u.pm = ti; u.pn = e * per + ct; u.sel = 0; return true;
    }
    __device__ __forceinline__ void a_ready(const Unit&) const {}
    __device__ __forceinline__ void done(const Unit&) const {}
    __device__ __forceinline__ size_t a_off(const Unit&) const { return 0; }
    __device__ __forceinline__ size_t b_off(const Unit&) const { return 0; }
    __device__ __forceinline__ bool keep(const Unit&) const { return false; }
};
struct MoeOrderP {
    const PG8_LAS int* tstart; GAS unsigned* cnt; int G, v;
    __device__ __forceinline__ bool next(int i, Unit& u) const {
        const int idx = i * G + v, tot = tstart[32] * 2; if (idx >= tot) return false;
        const int ti = idx >> 1, ct = idx & 1; int e = 0;
#pragma unroll 1
        for (int k = 1; k < 32; ++k) e += (tstart[k] <= ti) ? 1 : 0;
        u.pm = ti; u.pn = e * 2 + ct; u.sel = 0; return true;
    }
    __device__ __forceinline__ void a_ready(const Unit&) const {}
    __device__ __forceinline__ void done(const Unit& u) const {
        asm volatile("s_waitcnt vmcnt(0)" ::: "memory");
        int ln; asm volatile("v_mbcnt_lo_u32_b32 %0, -1, 0\n\tv_mbcnt_hi_u32_b32 %0, -1, %0" : "=v"(ln));
        if (ln == 0) __hip_atomic_fetch_add(cnt + u.pm, 1u, __ATOMIC_RELAXED, __HIP_MEMORY_SCOPE_AGENT);
    }
    __device__ __forceinline__ size_t a_off(const Unit&) const { return 0; }
    __device__ __forceinline__ size_t b_off(const Unit&) const { return 0; }
    __device__ __forceinline__ bool keep(const Unit&) const { return false; }
};
struct MoeOrderC {
    const PG8_LAS int* tstart; const GAS unsigned* cnt; int G, v, wid;
    __device__ __forceinline__ bool next(int i, Unit& u) const {
        const int T = tstart[32], L = (2 * T > G) ? 2 * T - G : 0, R = G - L;
        const int idx = (v >= L) ? ((i < 2) ? i * R + (v - L) : 2 * R + (i - 2) * G + v) : 2 * R + i * G + v;
        if (idx >= 4 * T) return false;
        const int ti = idx >> 2, ct = idx & 3; int e = 0;
#pragma unroll 1
        for (int k = 1; k < 32; ++k) e += (tstart[k] <= ti) ? 1 : 0;
        u.pm = ti; u.pn = e * 4 + ct; u.sel = 0; return true;
    }
    __device__ __forceinline__ void a_ready(const Unit& u) const {
        if (wid == 0) {
            const GAS unsigned* c = cnt + u.pm; int spins = 0;
#pragma unroll 1
            while ((unsigned)__builtin_amdgcn_readfirstlane(__hip_atomic_load(c, __ATOMIC_RELAXED, __HIP_MEMORY_SCOPE_AGENT)) < 16u && ++spins < (1 << 22)) __builtin_amdgcn_s_sleep(2);
            __builtin_amdgcn_fence(__ATOMIC_ACQUIRE, "agent");
            asm volatile("s_waitcnt vmcnt(0)" ::: "memory");
        }
        __builtin_amdgcn_s_barrier();
    }
    __device__ __forceinline__ void done(const Unit&) const {}
    __device__ __forceinline__ size_t a_off(const Unit&) const { return 0; }
    __device__ __forceinline__ size_t b_off(const Unit&) const { return 0; }
    __device__ __forceinline__ bool keep(const Unit&) const { return false; }
};
}
namespace att {
typedef unsigned short bf16;
typedef short bf16x8 __attribute__((ext_vector_type(8)));
typedef short s16x4 __attribute__((ext_vector_type(4)));
typedef float f32x16 __attribute__((ext_vector_type(16)));
typedef float f32x4 __attribute__((ext_vector_type(4)));
typedef unsigned u32x4 __attribute__((ext_vector_type(4)));
typedef unsigned u32x2 __attribute__((ext_vector_type(2)));
typedef float f32x2v __attribute__((ext_vector_type(2)));
typedef __bf16 bf16x2v __attribute__((ext_vector_type(2)));
__device__ __forceinline__ unsigned pk2(float lo, float hi) { f32x2v v = {lo, hi}; bf16x2v b = __builtin_convertvector(v, bf16x2v); return __builtin_bit_cast(unsigned, b); }
__device__ __forceinline__ float bflo(unsigned w) { return __builtin_bit_cast(float, w << 16); }
__device__ __forceinline__ float bfhi(unsigned w) { return __builtin_bit_cast(float, w & 0xffff0000u); }
__device__ __forceinline__ int crow(int r, int hi) { return (r & 3) + 8 * (r >> 2) + 4 * hi; }
__device__ __forceinline__ float xhalf(float v) {
    const unsigned u = __builtin_bit_cast(unsigned, v);
    auto rr = __builtin_amdgcn_permlane32_swap(u, u, false, false);
    const unsigned o = (rr[0] != u) ? rr[0] : rr[1];
    return __builtin_bit_cast(float, o);
}
__device__ __forceinline__ bf16x8 mk8(unsigned a, unsigned b, unsigned c, unsigned d) { u32x4 w = {a, b, c, d}; return __builtin_bit_cast(bf16x8, w); }

constexpr int VPB = 144;
template <int DK> struct KLay { static constexpr int KPB = (DK + 8) * 2, KBUF = 64 * KPB; };

template <int DK, int DV, bool KROPE> struct Stage {
    static constexpr int NK = KROPE ? 1 : DK / 64, NV = DV / 64;
    u32x4 kr[NK]; u32x4 kr2; u32x4 vr[NV];
    __device__ __forceinline__ void loadK(int tid, const GAS bf16* Kg, int ldk, const GAS bf16* K2g, int kv0) {
        const GAS char* kbase = (const GAS char*)(Kg + (size_t)kv0 * ldk);
        if constexpr (KROPE) {
            kr[0] = *(const GAS u32x4*)(kbase + (unsigned)(((tid >> 3) * ldk + 8 * (tid & 7)) * 2));
            if (tid < 256) kr2 = *(const GAS u32x4*)((const GAS char*)(K2g + (size_t)kv0 * 32) + (unsigned)(tid * 16));
        } else {
#pragma unroll
            for (int i = 0; i < NK; ++i) { const int p = tid + 512 * i, row = p / (DK / 8), ch = p % (DK / 8); kr[i] = *(const GAS u32x4*)(kbase + (unsigned)((row * ldk + 8 * ch) * 2)); }
        }
    }
    __device__ __forceinline__ void loadV(int tid, const GAS bf16* Vg, int ldv, int kv0) {
        const GAS char* vbase = (const GAS char*)(Vg + kv0);
#pragma unroll
        for (int i = 0; i < NV; ++i) { const int p = tid + 512 * i, dd = p >> 3, ch = p & 7; vr[i] = *(const GAS u32x4*)(vbase + (unsigned)((dd * ldv + 8 * ch) * 2)); }
    }
    __device__ __forceinline__ void storeK(int tid, LAS unsigned char* kb) const {
        constexpr int KPB = KLay<DK>::KPB;
        if constexpr (KROPE) {
            *(LAS u32x4*)(kb + (tid >> 3) * KPB + 16 * (tid & 7)) = kr[0];
            if (tid < 256) *(LAS u32x4*)(kb + (tid >> 2) * KPB + 128 + 16 * (tid & 3)) = kr2;
        } else {
#pragma unroll
            for (int i = 0; i < NK; ++i) { const int p = tid + 512 * i, row = p / (DK / 8), ch = p % (DK / 8); *(LAS u32x4*)(kb + row * KPB + 16 * ch) = kr[i]; }
        }
    }
    __device__ __forceinline__ void storeV(int tid, LAS unsigned char* vb) const {
#pragma unroll
        for (int i = 0; i < NV; ++i) { const int p = tid + 512 * i, dd = p >> 3, ch = p & 7; LAS unsigned char* q = vb + dd * VPB + 32 * (ch >> 1) + 8 * (ch & 1);
            *(LAS u32x2*)q = (u32x2){vr[i].x, vr[i].y}; *(LAS u32x2*)(q + 16) = (u32x2){vr[i].z, vr[i].w}; }
    }
    __device__ __forceinline__ void load(int tid, const GAS bf16* Kg, int ldk, const GAS bf16* K2g, const GAS bf16* Vg, int ldv, int kv0) { loadK(tid, Kg, ldk, K2g, kv0); loadV(tid, Vg, ldv, kv0); }
    __device__ __forceinline__ void store(int tid, LAS unsigned char* kb, LAS unsigned char* vb) const { storeK(tid, kb); storeV(tid, vb); }
};

template <int DK> __device__ __forceinline__ void qkt(f32x16& p0, f32x16& p1, const LAS unsigned char* kb, const bf16x8 (&qf)[DK / 16], int r32, int hi) {
    constexpr int KPB = KLay<DK>::KPB;
    const LAS unsigned char* k0 = kb + r32 * KPB + hi * 16;
#pragma unroll
    for (int d0 = 0; d0 < DK / 16; ++d0) {
        const bf16x8 a0 = *(const LAS bf16x8*)(k0 + d0 * 32), a1 = *(const LAS bf16x8*)(k0 + 32 * KPB + d0 * 32);
        p0 = __builtin_amdgcn_mfma_f32_32x32x16_bf16(a0, qf[d0], p0, 0, 0, 0);
        p1 = __builtin_amdgcn_mfma_f32_32x32x16_bf16(a1, qf[d0], p1, 0, 0, 0);
    }
}
template <int DK> __device__ __forceinline__ void qkt_qmem(f32x16& p0, f32x16& p1, const LAS unsigned char* kb, const bf16x8* qf, const LAS unsigned char* qlds, int r32, int hi) {
    constexpr int KPB = KLay<DK>::KPB, QR = DK / 32;
    const LAS unsigned char* k0 = kb + r32 * KPB + hi * 16;
#pragma unroll
    for (int d0 = 0; d0 < DK / 16; ++d0) {
        bf16x8 q; if (d0 < QR) q = qf[d0]; else q = *(const LAS bf16x8*)(qlds + (d0 - QR) * 1024);
        const bf16x8 a0 = *(const LAS bf16x8*)(k0 + d0 * 32), a1 = *(const LAS bf16x8*)(k0 + 32 * KPB + d0 * 32);
        p0 = __builtin_amdgcn_mfma_f32_32x32x16_bf16(a0, q, p0, 0, 0, 0);
        p1 = __builtin_amdgcn_mfma_f32_32x32x16_bf16(a1, q, p1, 0, 0, 0);
        if ((d0 & 3) == 3) __builtin_amdgcn_sched_barrier(0);
    }
}
template <int DV> __device__ __forceinline__ void pv(f32x16 (&o)[DV / 32], const LAS unsigned char* vb, const bf16x8 (&pf)[4], int r32, int hi) {
#pragma unroll
    for (int db = 0; db < DV / 32; ++db) {
        const LAS unsigned char* v0 = vb + (32 * db + r32) * VPB + 16 * hi;
#pragma unroll
        for (int s = 0; s < 4; ++s) {
            const bf16x8 vf = *(const LAS bf16x8*)(v0 + 32 * s);
            o[db] = __builtin_amdgcn_mfma_f32_32x32x16_bf16(vf, pf[s], o[db], 0, 0, 0);
        }
        if (DV > 64) __builtin_amdgcn_sched_barrier(0);
    }
}
__device__ __forceinline__ void pack_p(bf16x8 (&pf)[4], const f32x16& p0, const f32x16& p1) {
    pf[0] = mk8(pk2(p0[0], p0[1]), pk2(p0[2], p0[3]), pk2(p0[4], p0[5]), pk2(p0[6], p0[7]));
    pf[1] = mk8(pk2(p0[8], p0[9]), pk2(p0[10], p0[11]), pk2(p0[12], p0[13]), pk2(p0[14], p0[15]));
    pf[2] = mk8(pk2(p1[0], p1[1]), pk2(p1[2], p1[3]), pk2(p1[4], p1[5]), pk2(p1[6], p1[7]));
    pf[3] = mk8(pk2(p1[8], p1[9]), pk2(p1[10], p1[11]), pk2(p1[12], p1[13]), pk2(p1[14], p1[15]));
}

template <bool ALIBI> __device__ __forceinline__ void fl_init(f32x16& p0, f32x16& p1, float slope2, int kv0, int hi, int qrow) {
    if (ALIBI) {
        const float s2 = slope2 + slope2, s4 = s2 + s2, s8 = s4 + s4, s32 = (s8 + s8) + (s8 + s8);
        float g = slope2 * (float)(kv0 + 4 * hi - qrow);
#pragma unroll
        for (int c = 0; c < 4; ++c) { float v = g;
#pragma unroll
            for (int e = 0; e < 4; ++e) { p0[4 * c + e] = v; p1[4 * c + e] = v + s32; v += slope2; }
            g += s8; } }
    else {
#pragma unroll
        for (int r = 0; r < 16; ++r) { p0[r] = 0.f; p1[r] = 0.f; } }
}
__device__ __forceinline__ void fl_mask(f32x16& p0, f32x16& p1, int kv0, int hi, int qrow) {
    const int thr = qrow - kv0 - 4 * hi;
#pragma unroll
    for (int r = 0; r < 16; ++r) { const int c = (r & 3) + 8 * (r >> 2); if (c > thr) p0[r] = -INFINITY; if (c + 32 > thr) p1[r] = -INFINITY; }
}
__device__ __forceinline__ void fl_start(const f32x16& p0, const f32x16& p1, float& m, float& alpha) {
    float mx = fmaxf(p0[0], p1[0]);
#pragma unroll
    for (int r = 1; r < 16; ++r) mx = fmaxf(fmaxf(mx, p0[r]), p1[r]);
    mx = fmaxf(mx, xhalf(mx));
    const float mn = fmaxf(m, mx); alpha = __builtin_amdgcn_exp2f(m - mn); m = mn;
}
__device__ __forceinline__ void fl_finish(f32x16& p0, f32x16& p1, float m, float& l, bf16x8 (&pf)[4]) {
    float s0 = 0.f, s1 = 0.f;
#pragma unroll
    for (int r = 0; r < 16; ++r) { p0[r] = __builtin_amdgcn_exp2f(p0[r] - m); p1[r] = __builtin_amdgcn_exp2f(p1[r] - m); s0 += p0[r]; s1 += p1[r]; }
    l += s0 + s1;
    pack_p(pf, p0, p1);
}

#define FL_EL(P0, P1, e) ((e) < 16 ? P0[(e) & 15] : P1[(e) & 15])
template <int DK, bool QMEM> __device__ __forceinline__ void fl_blockX(f32x16& n0, f32x16& n1, const LAS unsigned char* kb, const bf16x8* qf, const LAS unsigned char* qlds, int r32, int hi,
                                                                         f32x16& c0, f32x16& c1, float m, float& l, bf16x8 (&pf)[4]) {
    constexpr int KPB = KLay<DK>::KPB, NS = DK / 16, CH = ((32 + NS - 1) / NS + 1) & ~1;
    const LAS unsigned char* k0 = kb + r32 * KPB + hi * 16;
    float s0 = 0.f, s1 = 0.f; unsigned pw[16];
#define FLX_K0(s) (*(const LAS bf16x8*)(k0 + ((s) < NS ? (s) : NS - 1) * 32))
#define FLX_K1(s) (*(const LAS bf16x8*)(k0 + 32 * KPB + ((s) < NS ? (s) : NS - 1) * 32))
    bf16x8 a0 = FLX_K0(0), a1 = FLX_K1(0), b0 = FLX_K0(1), b1 = FLX_K1(1), e0 = FLX_K0(2), e1 = FLX_K1(2);
    bf16x8 q, qb, qe; if constexpr (QMEM) { q = *(const LAS bf16x8*)(qlds); qb = *(const LAS bf16x8*)(qlds + (NS > 1 ? 1024 : 0)); qe = *(const LAS bf16x8*)(qlds + (NS > 2 ? 2048 : 0)); } else { q = qf[0]; qb = qf[NS > 1 ? 1 : 0]; qe = qf[NS > 2 ? 2 : 0]; }
#pragma unroll
    for (int d0 = 0; d0 < NS; ++d0) {
        bf16x8 c0n = e0, c1n = e1, qc = qe;
        if (d0 + 3 < NS) { c0n = FLX_K0(d0 + 3); c1n = FLX_K1(d0 + 3);
            if constexpr (QMEM) qc = *(const LAS bf16x8*)(qlds + (d0 + 3) * 1024); else qc = qf[d0 + 3]; }
        n0 = __builtin_amdgcn_mfma_f32_32x32x16_bf16(a0, q, n0, 0, 0, 0);
        n1 = __builtin_amdgcn_mfma_f32_32x32x16_bf16(a1, q, n1, 0, 0, 0);
#pragma unroll
        for (int e = d0 * CH; e < (d0 + 1) * CH && e < 32; e += 2) {
            float x, y;
            if (e < 16) { x = __builtin_amdgcn_exp2f(c0[e] - m); y = __builtin_amdgcn_exp2f(c0[e + 1] - m); s0 += x; s1 += y; }
            else { x = __builtin_amdgcn_exp2f(c1[e - 16] - m); y = __builtin_amdgcn_exp2f(c1[e - 15] - m); s0 += x; s1 += y; }
            pw[e >> 1] = pk2(x, y); asm volatile("" : "+v"(pw[e >> 1])); }
        asm volatile("" : "+v"(s0), "+v"(s1));
        __builtin_amdgcn_sched_barrier(0);
        a0 = b0; a1 = b1; q = qb; b0 = e0; b1 = e1; qb = qe; e0 = c0n; e1 = c1n; qe = qc;
    }
#undef FLX_K0
#undef FLX_K1
    l += s0 + s1;
    pf[0] = mk8(pw[0], pw[1], pw[2], pw[3]); pf[1] = mk8(pw[4], pw[5], pw[6], pw[7]); pf[2] = mk8(pw[8], pw[9], pw[10], pw[11]); pf[3] = mk8(pw[12], pw[13], pw[14], pw[15]);
}
template <int DV> __device__ __forceinline__ void fl_blockY(f32x16 (&o)[DV / 32], const LAS unsigned char* vb, const bf16x8 (&pf)[4], int r32, int hi, const f32x16& n0, const f32x16& n1, float& m, float& alpha) {
    constexpr int NS = DV / 8, CH = 32 / NS;
    float mx0 = -INFINITY, mx1 = -INFINITY;
    const LAS unsigned char* v0 = vb + r32 * VPB + 16 * hi;
    bf16x8 vf = *(const LAS bf16x8*)(v0), vg = *(const LAS bf16x8*)(v0 + 32);
#pragma unroll
    for (int st = 0; st < NS; ++st) {
        const int db = st >> 2, s = st & 3;
        bf16x8 vn = vg;
        if (st + 2 < NS) vn = *(const LAS bf16x8*)(v0 + ((st + 2) >> 2) * 32 * VPB + 32 * ((st + 2) & 3));
        o[db] = __builtin_amdgcn_mfma_f32_32x32x16_bf16(vf, pf[s], o[db], 0, 0, 0);
#pragma unroll
        for (int e = st * CH; e < (st + 1) * CH; ++e) { if (e < 16) mx0 = fmaxf(mx0, n0[e]); else mx1 = fmaxf(mx1, n1[e - 16]); }
        asm volatile("" : "+v"(mx0), "+v"(mx1));
        __builtin_amdgcn_sched_barrier(0);
        vf = vg; vg = vn;
    }
    float mx = fmaxf(mx0, mx1); mx = fmaxf(mx, xhalf(mx));
    const float mn = fmaxf(m, mx); alpha = __builtin_amdgcn_exp2f(m - mn); m = mn;
}

template <int DK, int DV, bool CAUSAL, bool ALIBI, bool KROPE, bool QMEM = false, bool DESC = false>
__device__ __forceinline__ void flash_pass(LAS unsigned char* lds, int tid, const GAS bf16* Qrow, const GAS bf16* Qrow2, const GAS bf16* Kg, int ldk, const GAS bf16* K2g, const GAS bf16* Vg, int ldv,
                                           int NT, int ntw, int qrow, float slope2, f32x16 (&o)[DV / 32], float& lsum, const GAS unsigned* kn = nullptr, int abl = 0) {
    constexpr int KBUF = KLay<DK>::KBUF, VBUF = DV * VPB, QOFF = 2 * KBUF + 2 * VBUF, XOFF = QOFF + 8 * (DK / 16) * 1024;
    constexpr bool CUT = DESC && ALIBI;
    const int lane = tid & 63, r32 = lane & 31, hi = lane >> 5, wid = tid >> 6;
#define FL_TI(i) (DESC ? NT - 1 - (i) : (i))
    bf16x8 qf[QMEM ? 1 : DK / 16];
    LAS unsigned char* qlds = lds + QOFF + wid * (DK / 16) * 1024 + lane * 16;
    float qn2 = 0.f;
#pragma unroll
    for (int d0 = 0; d0 < DK / 16; ++d0) {
        bf16x8 v;
        if (KROPE && d0 >= 4) v = *(const GAS bf16x8*)(Qrow2 + 16 * (d0 - 4) + 8 * hi);
        else v = *(const GAS bf16x8*)(Qrow + 16 * d0 + 8 * hi);
        if constexpr (CUT) {
#pragma unroll
            for (int j = 0; j < 8; ++j) { const float f = __builtin_bit_cast(float, (unsigned)(unsigned short)v[j] << 16); qn2 += f * f; } }
        if constexpr (QMEM) *(LAS bf16x8*)(qlds + d0 * 1024) = v; else qf[d0] = v;
    }
    volatile LAS float* kpre = (volatile LAS float*)(lds + XOFF);
    volatile LAS unsigned* dflag = (volatile LAS unsigned*)(lds + XOFF + 512);
    float qn = 0.f;
    if constexpr (CUT) {
        qn2 += xhalf(qn2); qn = sqrtf(qn2);
        if (wid == 0) {
            float v0 = 0.f, v1 = 0.f;
            if (lane < NT) v0 = sqrtf(__builtin_bit_cast(float, kn[(size_t)lane * 16]) + __builtin_bit_cast(float, kn[(size_t)lane * 16 + 1])) * 1.01f;
            if (lane + 64 < NT) v1 = sqrtf(__builtin_bit_cast(float, kn[(size_t)(lane + 64) * 16]) + __builtin_bit_cast(float, kn[(size_t)(lane + 64) * 16 + 1])) * 1.01f;
#pragma unroll
            for (int dd = 1; dd < 64; dd <<= 1) { const float u0 = __shfl_up(v0, dd), u1 = __shfl_up(v1, dd); if (lane >= dd) { v0 = fmaxf(v0, u0); v1 = fmaxf(v1, u1); } }
            v1 = fmaxf(v1, __shfl(v0, 63));
            kpre[lane] = v0; kpre[lane + 64] = v1;
        }
    }
#pragma unroll
    for (int db = 0; db < DV / 32; ++db)
#pragma unroll
        for (int r = 0; r < 16; ++r) o[db][r] = 0.f;
    float m = -INFINITY, l = 0.f, alpha = 1.0f;
    int cut = NT;
    Stage<DK, DV, KROPE> st;
    st.loadK(tid, Kg, ldk, K2g, 64 * FL_TI(0)); st.loadV(tid, Vg, ldv, 64 * FL_TI(0));
    st.storeK(tid, lds); st.storeV(tid, lds + 2 * KBUF);
    if (NT > 1) { st.loadK(tid, Kg, ldk, K2g, 64 * FL_TI(1)); st.storeK(tid, lds + KBUF); }
    __syncthreads();
    if (NT > 2) st.loadK(tid, Kg, ldk, K2g, 64 * FL_TI(2));
    if (NT > 1) st.loadV(tid, Vg, ldv, 64 * FL_TI(1));
    f32x16 pa0, pa1, pb0, pb1;
#define FL_QKT(P0, P1, KB) do { if constexpr (QMEM) { bf16x8 qt_[DK / 16]; _Pragma("unroll") for (int d0 = 0; d0 < DK / 16; ++d0) qt_[d0] = *(const LAS bf16x8*)(qlds + d0 * 1024); qkt<DK>(P0, P1, KB, qt_, r32, hi); } else qkt<DK>(P0, P1, KB, qf, r32, hi); } while (0)
#define FL_FIRST(P0, P1, KB, TILE) do { const int kv_ = 64 * (TILE); fl_init<ALIBI>(P0, P1, slope2, kv_, hi, qrow); FL_QKT(P0, P1, KB); \
        if (CAUSAL && kv_ + 63 > qrow - r32) fl_mask(P0, P1, kv_, hi, qrow); fl_start(P0, P1, m, alpha); } while (0)
    if (FL_TI(0) < ntw) FL_FIRST(pa0, pa1, lds, FL_TI(0));
    __syncthreads();
    for (int i = 0; i < NT; ++i) {
        int tq_ = tid; asm volatile("" : "+v"(tq_));
        if (!(abl & 1)) {
            if (i + 2 < NT) st.storeK(tq_, lds + (i & 1) * KBUF);
            if (i + 1 < NT) st.storeV(tq_, lds + 2 * KBUF + ((i + 1) & 1) * VBUF);
            if (i + 3 < NT) st.loadK(tq_, Kg, ldk, K2g, 64 * FL_TI(i + 3));
            if (i + 2 < NT) st.loadV(tq_, Vg, ldv, 64 * FL_TI(i + 2)); }
        const int tc = FL_TI(i), tn = FL_TI(i + 1);
        const bool ac = tc < ntw && i < cut && !(abl & 2);
        bool an = i + 1 < NT && tn < ntw && i + 1 < cut && !(abl & 2);
        if constexpr (CUT) {
            if (ac && an) {
                const bool dead = qn * kpre[tn] + slope2 * (float)(64 * tn + 63 - qrow) < m - 64.f;
                if (__all(dead)) { cut = i + 1; an = false; } } }
        const LAS unsigned char* kn_ = lds + ((i + 1) & 1) * KBUF; const LAS unsigned char* vc_ = lds + 2 * KBUF + (i & 1) * VBUF;
        if (ac) {
            l *= alpha;
            if (__any(alpha != 1.0f)) {
#pragma unroll
                for (int db = 0; db < DV / 32; ++db) asm volatile("" : "+v"(o[db]));
#pragma unroll
                for (int db = 0; db < DV / 32; ++db)
#pragma unroll
                    for (int r = 0; r < 16; ++r) o[db][r] *= alpha;
#pragma unroll
                for (int db = 0; db < DV / 32; ++db) asm volatile("" : "+v"(o[db])); }
            bf16x8 pf[4];
            if (an) {
                const int kv1_ = 64 * tn;
                const bool diag_ = CAUSAL && (kv1_ + 63 > qrow - r32);
                fl_init<ALIBI>(pb0, pb1, slope2, kv1_, hi, qrow);
                fl_blockX<DK, QMEM>(pb0, pb1, kn_, qf, qlds, r32, hi, pa0, pa1, m, l, pf);
                if (!diag_) { fl_blockY<DV>(o, vc_, pf, r32, hi, pb0, pb1, m, alpha); }
                else { pv<DV>(o, vc_, pf, r32, hi); fl_mask(pb0, pb1, kv1_, hi, qrow); fl_start(pb0, pb1, m, alpha); }
            } else {
                fl_finish(pa0, pa1, m, l, pf); pv<DV>(o, vc_, pf, r32, hi);
            }
        } else if (an) { FL_FIRST(pb0, pb1, kn_, tn); }
        if constexpr (CUT) { if (lane == 0) dflag[(i & 1) * 8 + wid] = (i + 1 >= cut) ? 1u : 0u; }
        if (!(abl & 4)) __syncthreads();
        if constexpr (CUT) { unsigned alld = 1u;
#pragma unroll
            for (int w = 0; w < 8; ++w) alld &= dflag[(i & 1) * 8 + w];
            if (alld) break; }
        if (!(abl & 8)) { pa0 = pb0; pa1 = pb1; }
    }
#undef FL_FIRST
#undef FL_QKT
#undef FL_TI
    lsum = l + xhalf(l);
}

template <int DK, int DV, bool CAUSAL, bool ALIBI, bool KROPE, bool QMEM = false>
__device__ __forceinline__ void flash_pass_simple(LAS unsigned char* lds, int tid, const GAS bf16* Qrow, const GAS bf16* Qrow2, const GAS bf16* Kg, int ldk, const GAS bf16* K2g, const GAS bf16* Vg, int ldv,
                                           int NT, int ntw, int qrow, float slope2, f32x16 (&o)[DV / 32], float& lsum) {
    constexpr int KBUF = KLay<DK>::KBUF, VBUF = DV * VPB;
    const int lane = tid & 63, r32 = lane & 31, hi = lane >> 5;
    constexpr int QR = QMEM ? DK / 32 : DK / 16;
    bf16x8 qf[QR];
    LAS unsigned char* qlds = lds + 2 * KBUF + 2 * VBUF + (tid >> 6) * (DK / 16 - QR + 1) * 1024 + lane * 16;
#pragma unroll
    for (int d0 = 0; d0 < DK / 16; ++d0) {
        bf16x8 v;
        if (KROPE && d0 >= 4) v = *(const GAS bf16x8*)(Qrow2 + 16 * (d0 - 4) + 8 * hi);
        else v = *(const GAS bf16x8*)(Qrow + 16 * d0 + 8 * hi);
        if constexpr (!KROPE && QMEM) {
            const bf16x8 w2 = *(const GAS bf16x8*)(Qrow2 + 16 * d0 + 8 * hi); const u32x4 a4 = __builtin_bit_cast(u32x4, v), b4 = __builtin_bit_cast(u32x4, w2); u32x4 r4;
            r4.x = pk2(bflo(a4.x) + bflo(b4.x), bfhi(a4.x) + bfhi(b4.x)); r4.y = pk2(bflo(a4.y) + bflo(b4.y), bfhi(a4.y) + bfhi(b4.y));
            r4.z = pk2(bflo(a4.z) + bflo(b4.z), bfhi(a4.z) + bfhi(b4.z)); r4.w = pk2(bflo(a4.w) + bflo(b4.w), bfhi(a4.w) + bfhi(b4.w)); v = __builtin_bit_cast(bf16x8, r4); }
        if (d0 < QR) qf[d0] = v; else *(LAS bf16x8*)(qlds + (d0 - QR) * 1024) = v;
    }
#pragma unroll
    for (int db = 0; db < DV / 32; ++db)
#pragma unroll
        for (int r = 0; r < 16; ++r) o[db][r] = 0.f;
    float m = -INFINITY, l = 0.f;
    Stage<DK, DV, KROPE> st;
    st.load(tid, Kg, ldk, K2g, Vg, ldv, 0);
    st.store(tid, lds, lds + 2 * KBUF);
    __syncthreads();
    for (int t = 0; t < NT; ++t) {
        const int cur = t & 1, kv0 = 64 * t;
        if (t + 1 < NT) st.load(tid, Kg, ldk, K2g, Vg, ldv, kv0 + 64);
        if (t < ntw) {
            const LAS unsigned char* kb = lds + cur * KBUF; const LAS unsigned char* vb = lds + 2 * KBUF + cur * VBUF;
            f32x16 p0, p1;
            if (ALIBI) { const float base = slope2 * (float)(kv0 + 4 * hi - qrow);
#pragma unroll
                for (int r = 0; r < 16; ++r) { p0[r] = __builtin_fmaf(slope2, (float)((r & 3) + 8 * (r >> 2)), base); p1[r] = __builtin_fmaf(slope2, (float)(32 + (r & 3) + 8 * (r >> 2)), base); } }
            else {
#pragma unroll
                for (int r = 0; r < 16; ++r) { p0[r] = 0.f; p1[r] = 0.f; } }
            if constexpr (QMEM) qkt_qmem<DK>(p0, p1, kb, qf, qlds, r32, hi); else qkt<DK>(p0, p1, kb, qf, r32, hi);
            if (CAUSAL && kv0 + 63 > qrow - r32) {
#pragma unroll
                for (int r = 0; r < 16; ++r) { const int kv = kv0 + crow(r, hi); if (kv > qrow) p0[r] = -INFINITY; if (kv + 32 > qrow) p1[r] = -INFINITY; } }
            float mx = p0[0];
#pragma unroll
            for (int r = 1; r < 16; ++r) mx = fmaxf(mx, p0[r]);
#pragma unroll
            for (int r = 0; r < 16; ++r) mx = fmaxf(mx, p1[r]);
            mx = fmaxf(mx, xhalf(mx));
            const float mn = fmaxf(m, mx), alpha = __builtin_amdgcn_exp2f(m - mn); m = mn;
            l *= alpha;
            if (__any(alpha != 1.0f)) {
#pragma unroll
                for (int db = 0; db < DV / 32; ++db)
#pragma unroll
                    for (int r = 0; r < 16; ++r) o[db][r] *= alpha; }
            float s = 0.f;
#pragma unroll
            for (int r = 0; r < 16; ++r) { p0[r] = __builtin_amdgcn_exp2f(p0[r] - mn); p1[r] = __builtin_amdgcn_exp2f(p1[r] - mn); s += p0[r] + p1[r]; }
            l += s;
            bf16x8 pf[4]; pack_p(pf, p0, p1);
            pv<DV>(o, vb, pf, r32, hi);
        }
        if (t + 1 < NT) st.store(tid, lds + (cur ^ 1) * KBUF, lds + 2 * KBUF + (cur ^ 1) * VBUF);
        __syncthreads();
    }
    lsum = l + xhalf(l);
}


template <int DV> __device__ __forceinline__ void store_o(GAS bf16* Orow, const f32x16 (&o)[DV / 32], float sc, int hi) {
#pragma unroll
    for (int db = 0; db < DV / 32; ++db)
#pragma unroll
        for (int c = 0; c < 4; ++c) { u32x2 w; w.x = pk2(o[db][4 * c] * sc, o[db][4 * c + 1] * sc); w.y = pk2(o[db][4 * c + 2] * sc, o[db][4 * c + 3] * sc);
            *(GAS u32x2*)(Orow + 32 * db + 8 * c + 4 * hi) = w; }
}

__device__ __forceinline__ void mla_unit(LAS unsigned char* lds, int tid, int b, int h, int q0, const GAS bf16* qmla, const GAS bf16* knope, const GAS bf16* krope, const GAS bf16* vT, GAS bf16* out, int abl) {
    const int lane = tid & 63, wid = tid >> 6, r32 = lane & 31, hi = lane >> 5;
    const size_t tb = (size_t)b * 8192; const int qrow = q0 + 32 * wid + r32;
    const GAS bf16* Qr = qmla + (tb + qrow) * 768;
    f32x16 o[2]; float l;
    flash_pass<96, 64, true, false, true>(lds, tid, Qr + h * 64, Qr + 512 + h * 32, knope + tb * 512 + h * 64, 512, krope + tb * 32, vT + (size_t)(h * 64) * 16384 + tb, 16384,
                                          q0 / 64 + 4, (q0 + 32 * wid + 31) / 64 + 1, qrow, 0.f, o, l, nullptr, abl);
    if (abl == 0 || l == 12345.678f) store_o<64>(out + (tb + qrow) * 1024 + h * 64, o, 1.0f / l, hi);
}
__device__ __forceinline__ void cross_unit(LAS unsigned char* lds, int tid, int b, int h, int q0, const GAS bf16* qx, const GAS bf16* xk, const GAS bf16* xvT, GAS bf16* out) {
    const int lane = tid & 63, wid = tid >> 6, r32 = lane & 31, hi = lane >> 5;
    const size_t tb = (size_t)b * 8192; const int qrow = q0 + 32 * wid + r32;
    f32x16 o[4]; float l;
    int nt = 4; asm volatile("" : "+s"(nt));
    flash_pass_simple<128, 128, false, false, false, true>(lds, tid, qx + (tb + qrow) * 512 + h * 128, qx + (size_t)16384 * 512 + (tb + qrow) * 512 + h * 128, xk + (size_t)(b * 256) * 512 + h * 128, 512, nullptr, xvT + (size_t)(h * 128) * 512 + b * 256, 512,
                                              nt, nt, qrow, 0.f, o, l);
    store_o<128>(out + (tb + qrow) * 512 + h * 128, o, 1.0f / l, hi);
}
__device__ __forceinline__ void diff_unit(LAS unsigned char* lds, int tid, int b, int h, int hf, int q0, const GAS bf16* dq, const GAS bf16* dk, const GAS bf16* vT, GAS bf16* out, int ldo, const GAS unsigned* knl, int abl) {
    const int lane = tid & 63, wid = tid >> 6, r32 = lane & 31, hi = lane >> 5;
    const size_t tb = (size_t)b * 8192; const int qrow = q0 + 32 * wid + r32;
    const float slope2 = __builtin_amdgcn_exp2f(-2.0f * (float)(h + 1)) * 1.4426950408889634f;
    const int NT = q0 / 64 + 4, ntw = (q0 + 32 * wid + 31) / 64 + 1;
    f32x16 o[4]; float l;
    flash_pass<64, 128, true, true, false, true, true>(lds, tid, dq + (tb + qrow) * 512 + h * 128 + hf * 64, nullptr, dk + tb * 512 + h * 128 + hf * 64, 512, nullptr, vT + (size_t)(512 + h * 128) * 16384 + tb, 16384,
                                                      NT, ntw, qrow, slope2, o, l, knl + ((size_t)(b * 128) * 8 + 2 * h + hf) * 2, abl);
    if (abl == 0 || l == 12345.678f) store_o<128>(out + (tb + qrow) * (size_t)ldo + h * 128, o, 1.0f / l, hi);
}
__device__ __forceinline__ void diff_lambda(const GAS float* lp, int layer, float& lam, float& post) {
    float q1 = 0.f, q2 = 0.f;
    for (int i = 0; i < 64; ++i) { q1 += lp[i] * lp[64 + i]; q2 += lp[128 + i] * lp[192 + i]; }
    const float lam_init = (layer == 0) ? 0.2f : 0.35550906759f;
    lam = expf(q1) - expf(q2) + lam_init; post = 1.f - lam_init;
}
__device__ __forceinline__ void diff_combine4(int item0, int stride, int lane, GAS bf16* o0, const GAS bf16* o1, float lam, float post, const GAS float* subln) {
    unsigned a[4], c[4]; size_t off[4];
#pragma unroll
    for (int k = 0; k < 4; ++k) { const int item = item0 + k * stride; off[k] = (size_t)(item >> 2) * 1024 + (item & 3) * 128 + 2 * lane;
        a[k] = *(const GAS unsigned*)(o0 + off[k]); c[k] = *(const GAS unsigned*)(o1 + (size_t)item * 128 + 2 * lane); }
    const f32x2v g = *(const GAS f32x2v*)(subln + 2 * lane);
#pragma unroll
    for (int k = 0; k < 4; ++k) {
        const float x = bflo(a[k]) - lam * bflo(c[k]), y = bfhi(a[k]) - lam * bfhi(c[k]);
        float s2 = x * x + y * y;
#pragma unroll
        for (int dd = 1; dd < 64; dd <<= 1) s2 += __shfl_xor(s2, dd);
        const float rs = __builtin_amdgcn_rsqf(s2 * (1.f / 128.f) + 1e-6f) * post;
        *(GAS unsigned*)(o0 + off[k]) = pk2(x * rs * g[0], y * rs * g[1]); }
}
__device__ __forceinline__ void sb_unit(LAS unsigned char* lds, int tid, int b, int h, int q0, const GAS bf16* sq, const GAS bf16* sk, const GAS bf16* vT, GAS bf16* out) {
    constexpr int KBUF = KLay<64>::KBUF, VBUF = 64 * VPB;
    const int lane = tid & 63, wid = tid >> 6, r32 = lane & 31, hi = lane >> 5;
    const size_t tb = (size_t)b * 8192; const int qrow = q0 + 32 * wid + r32;
    const GAS bf16* Kg = sk + tb * 512 + h * 64; const GAS bf16* Vg = vT + (size_t)(h * 64) * 16384 + tb;
    const int NT = q0 / 64 + 4, ntw = (q0 + 32 * wid + 30) / 64 + 1;
    bf16x8 qf[4];
#pragma unroll
    for (int d0 = 0; d0 < 4; ++d0) qf[d0] = *(const GAS bf16x8*)(sq + (tb + qrow) * 512 + h * 64 + 16 * d0 + 8 * hi);
    f32x16 o[2];
#pragma unroll
    for (int r = 0; r < 16; ++r) { o[0][r] = 0.f; o[1][r] = 0.f; }
    float R = 1.0f;
    volatile LAS unsigned* dflag = (volatile LAS unsigned*)(lds + 4 * KBUF + 1024);
    Stage<64, 64, false> st;
    st.load(tid, Kg, 512, nullptr, Vg, 16384, 64 * (NT - 1));
    st.store(tid, lds, lds + 2 * KBUF);
    __syncthreads();
    for (int i = 0; i < NT; ++i) {
        const int t = NT - 1 - i, cur = i & 1, kv0 = 64 * t;
        if (t > 0) st.load(tid, Kg, 512, nullptr, Vg, 16384, kv0 - 64);
        if (t < ntw && __any(R != 0.f)) {
            const LAS unsigned char* kb = lds + cur * KBUF; const LAS unsigned char* vb = lds + 2 * KBUF + cur * VBUF;
            f32x16 k0, k1;
#pragma unroll
            for (int r = 0; r < 16; ++r) { k0[r] = 0.f; k1[r] = 0.f; }
            qkt<64>(k0, k1, kb, qf, r32, hi);
            f32x16 b0, b1;
#pragma unroll
            for (int r = 0; r < 16; ++r) {
                const float e0 = __builtin_amdgcn_exp2f(fminf(k0[r], 115.f)), e1 = __builtin_amdgcn_exp2f(fminf(k1[r], 115.f));
                const float r0 = __builtin_amdgcn_rcpf(1.f + e0), r1 = __builtin_amdgcn_rcpf(1.f + e1);
                k0[r] = r0; b0[r] = e0 * r0; k1[r] = r1; b1[r] = e1 * r1; }
            if (kv0 + 63 >= qrow - r32) {
                const int thr = qrow - kv0 - 4 * hi;
#pragma unroll
                for (int r = 0; r < 16; ++r) { const int c = (r & 3) + 8 * (r >> 2); if (c >= thr) { k0[r] = 1.f; b0[r] = 0.f; } if (c + 32 >= thr) { k1[r] = 1.f; b1[r] = 0.f; } } }
            float gp[8], go[8];
#pragma unroll
            for (int c = 0; c < 4; ++c) { gp[c] = (k0[4 * c] * k0[4 * c + 1]) * (k0[4 * c + 2] * k0[4 * c + 3]); gp[4 + c] = (k1[4 * c] * k1[4 * c + 1]) * (k1[4 * c + 2] * k1[4 * c + 3]); }
#pragma unroll
            for (int g = 0; g < 8; ++g) go[g] = xhalf(gp[g]);
            float sp = R;
#pragma unroll
            for (int g = 7; g >= 0; --g) {
                float s = sp * (hi ? 1.0f : go[g]);
                if (g >= 4) { const int c = g - 4;
                    b1[4 * c + 3] *= s; s *= k1[4 * c + 3]; b1[4 * c + 2] *= s; s *= k1[4 * c + 2]; b1[4 * c + 1] *= s; s *= k1[4 * c + 1]; b1[4 * c] *= s; }
                else { const int c = g;
                    b0[4 * c + 3] *= s; s *= k0[4 * c + 3]; b0[4 * c + 2] *= s; s *= k0[4 * c + 2]; b0[4 * c + 1] *= s; s *= k0[4 * c + 1]; b0[4 * c] *= s; }
                sp *= gp[g] * go[g];
            }
            R = sp;
            bf16x8 pf[4]; pack_p(pf, b0, b1);
            pv<64>(o, vb, pf, r32, hi);
        }
        if (t > 0) st.store(tid, lds + (cur ^ 1) * KBUF, lds + 2 * KBUF + (cur ^ 1) * VBUF);
        if (lane == 0) dflag[(i & 1) * 8 + wid] = (t < ntw && !__any(R != 0.f)) ? 1u : 0u;
        __syncthreads();
        { unsigned alld = 1u;
#pragma unroll
          for (int w = 0; w < 8; ++w) alld &= dflag[(i & 1) * 8 + w];
          if (alld) break; }
    }
    store_o<64>(out + (tb + qrow) * 1024 + h * 64, o, 1.0f, hi);
}
}
typedef unsigned short bf16;
typedef float f32x4 __attribute__((ext_vector_type(4)));
typedef unsigned u32x4 __attribute__((ext_vector_type(4)));
typedef unsigned u32x2 __attribute__((ext_vector_type(2)));
constexpr int NWAVES = 8, NTHREADS = 512;
constexpr int M = 16384, D = 1024, SEQ = 8192, DEPTH = 2, IN_COLS = 6688;
constexpr int SROWS = 40960;
constexpr size_t MiB = 1u << 20;
constexpr size_t WS_CTL = 0, CTL_ZERO_BYTES = 128 * 1024;
constexpr size_t WS_SSQ = 1 * MiB;
constexpr size_t WS_SSQCQ = 2 * MiB, WS_SSQCKV = WS_SSQCQ + 256 * 1024, WS_SSQMEM = WS_SSQCKV + 256 * 1024;
constexpr size_t WS_TOKE = 3 * MiB, WS_TOKW = WS_TOKE + 128 * 1024, WS_HIST = WS_TOKW + 128 * 1024, WS_SLOT = WS_HIST + 64 * 1024;
constexpr size_t WS_STOK = 4 * MiB, WS_SW = WS_STOK + 256 * 1024, WS_SRSTD = WS_SW + 256 * 1024;
constexpr size_t WS_WR = 5 * MiB;
constexpr size_t WS_WRH = 5 * MiB + 256 * 1024, WS_WRL = WS_WRH + 128 * 1024;
constexpr size_t WS_MEMN = 6 * MiB, WS_XK = 7 * MiB, WS_XVT = WS_XK + 512 * 1024;
constexpr size_t WS_WIN = 8 * MiB;
constexpr size_t WS_WV = WS_WIN + (size_t)2816 * 1024 * 2;
constexpr size_t WS_WG = WS_WV + 2 * MiB;
constexpr size_t WS_WUQ = WS_WG + 6 * MiB;
constexpr size_t WS_WUKN = WS_WUQ + 768 * 256 * 2;
constexpr size_t WS_WUV = WS_WUKN + 512 * 256 * 2;
constexpr size_t WS_WB = WS_WUV + 512 * 256 * 2;
constexpr size_t WS_WOUT = WS_WB + 4 * MiB;
constexpr size_t WS_WXQ = WS_WOUT + 2 * MiB;
constexpr size_t WS_WXK = WS_WXQ + 1 * MiB, WS_WXV = WS_WXK + 1 * MiB;
constexpr size_t WS_WXO = WS_WXV + 1 * MiB;
constexpr size_t WS_WGU = WS_WXO + 1 * MiB;
constexpr size_t WS_WD = WS_WGU + 32 * MiB;
constexpr size_t WS_WEND = WS_WD + 16 * MiB;
static_assert(WS_WEND <= 81 * MiB, "weights");
constexpr size_t WS_XB = 81 * MiB;
constexpr size_t R0 = 113 * MiB;
constexpr size_t WS_CQ = R0, WS_CKV = R0 + 8 * MiB, WS_KROPE = R0 + 16 * MiB, WS_QK = R0 + 18 * MiB  , WS_VT = R0 + 82 * MiB  ;
constexpr size_t WS_QMLA = R0 + 114 * MiB, WS_KNOPE = R0 + 138 * MiB, WS_VMLAT = R0 + 154 * MiB, WS_OABC = R0 + 170 * MiB  ;
constexpr size_t WS_GSCR = R0, WS_MB = R0 + 96 * MiB;
constexpr size_t WS_QX = R0, WS_OX = R0 + 32 * MiB;
constexpr size_t WS_XG = R0, WS_ACT = R0 + 80 * MiB, WS_Y = R0 + 100 * MiB;
constexpr size_t WS_END = R0 + 234 * MiB;
static_assert(WS_MB + 32 * MiB <= WS_OABC && WS_Y + 80 * MiB <= WS_END && WS_OABC + 64 * MiB <= WS_END, "region map");
constexpr int CW_BAR = 1024, CW_Q = 8192, CW_KN = 16384, CW_F1 = 24576;
constexpr int RING_BYTES = 131072, LDSCTL_OFF = RING_BYTES, MISC_OFF = LDSCTL_OFF + 320, TSTART_OFF = LDSCTL_OFF + 1024, HIST_OFF = LDSCTL_OFF + 2048;
constexpr int LDS_BYTES = 147456;

#define LDS_WAIT() asm volatile("s_waitcnt lgkmcnt(0)" ::: "memory")
__device__ __forceinline__ float wave_sum(float v) {
#pragma unroll
    for (int o = 1; o < 64; o <<= 1) v += __shfl_xor(v, o);
    return v;
}
__device__ __forceinline__ unsigned pk2(float lo, float hi) { return pg8::pk2(lo, hi); }
__device__ __forceinline__ int lane_id() { int r; asm volatile("v_mbcnt_lo_u32_b32 %0, -1, 0\n\tv_mbcnt_hi_u32_b32 %0, -1, %0" : "=v"(r)); return r; }
#define XB_TMO      128
#define XB_XCNT(j)  (256  + 64 * (j))
#define XB_XSUB(j)  (1280 + 64 * (j))
#define XB_XGEN(j)  (2304 + 64 * (j))
#define XB_TOP      3328
#define XB_TOPGEN   3392
#define XCD_BAR_WORDS 3456
#define XB_SPIN_CAP (1u << 18)

__device__ __forceinline__ unsigned xb_ld(unsigned* p)              { return __hip_atomic_load(p, __ATOMIC_RELAXED, __HIP_MEMORY_SCOPE_AGENT); }
__device__ __forceinline__ unsigned xb_add(unsigned* p, unsigned v) { return __hip_atomic_fetch_add(p, v, __ATOMIC_RELAXED, __HIP_MEMORY_SCOPE_AGENT); }
__device__ __forceinline__ unsigned xb_xcc_id() { return (unsigned)__builtin_amdgcn_s_getreg((3 << 11) | 20) & 0xFu; }
#define XB_SPIN(cond, bar) do { unsigned _sp = 0; while (cond) { __builtin_amdgcn_s_sleep(1); \
    if ((++_sp & 255u) == 0u) { if (xb_ld(&(bar)[XB_TMO])) break; if (_sp > XB_SPIN_CAP) { atomicAdd(&(bar)[XB_TMO], 1u); break; } } } } while (0)

struct XcdBarrier {
    unsigned* bar; unsigned x; int wid;
    volatile LAS unsigned* st;
};

__device__ __forceinline__ XcdBarrier xcd_barrier_post(unsigned* bar, volatile LAS unsigned* st, int wid) {
    XcdBarrier b; b.bar = bar; b.x = xb_xcc_id(); b.st = st; b.wid = wid;
    if (wid == 0 && lane_id() == 0) (void)xb_add(&bar[XB_XCNT(b.x)], 1u);
    return b;
}
__device__ __forceinline__ void xcd_barrier_complete(unsigned* bar, unsigned x, unsigned& nloc, unsigned& nx) {
    const unsigned G = gridDim.x * gridDim.y * gridDim.z;
    unsigned sum, cnt, mine, sp = 0u;
    for (;;) {
        sum = 0u; cnt = 0u; mine = 0u;
#pragma unroll 1
        for (unsigned j = 0; j < 16; ++j) { const unsigned c = xb_ld(&bar[XB_XCNT(j)]); sum += c; cnt += (c > 0u) ? 1u : 0u; mine = (j == x) ? c : mine; }
        if (sum == G) break;
        __builtin_amdgcn_s_sleep(1);
        if ((++sp & 255u) == 0u) { if (xb_ld(&bar[XB_TMO])) break; if (sp > XB_SPIN_CAP) { atomicAdd(&bar[XB_TMO], 1u); break; } }
    }
    nloc = mine > 0u ? mine : 1u; nx = cnt > 0u ? cnt : 1u;
}

__device__ __forceinline__ void xcd_barrier(const XcdBarrier& b) {
    asm volatile("s_waitcnt vmcnt(0)" ::: "memory");
    __syncthreads();
    if (b.wid == 0 && lane_id() == 0) {
        unsigned* bar = b.bar; asm volatile("" : "+s"(bar));
        __builtin_amdgcn_s_waitcnt(0);
        unsigned nloc = b.st[0], nx = b.st[1];
        if (nloc == 0u) { xcd_barrier_complete(bar, b.x, nloc, nx); b.st[0] = nloc; b.st[1] = nx; }
        const unsigned old = xb_add(&bar[XB_XSUB(b.x)], 1u);
        const unsigned gen = old / nloc;
        if (old + 1u == (gen + 1u) * nloc) {
            __builtin_amdgcn_fence(__ATOMIC_RELEASE, "agent");
            asm volatile("s_waitcnt vmcnt(0)" ::: "memory");
            const unsigned og = xb_add(&bar[XB_TOP], 1u);
            const unsigned tg = og / nx;
            if (og + 1u == (tg + 1u) * nx) xb_add(&bar[XB_TOPGEN], 1u);
            else XB_SPIN(xb_ld(&bar[XB_TOPGEN]) == tg, bar);
            __builtin_amdgcn_fence(__ATOMIC_ACQUIRE, "agent");
            xb_add(&bar[XB_XGEN(b.x)], 1u);
            asm volatile("s_waitcnt vmcnt(0)" ::: "memory");
        } else {
            XB_SPIN(xb_ld(&bar[XB_XGEN(b.x)]) == gen, bar);
            __builtin_amdgcn_fence(__ATOMIC_ACQUIRE, "agent");
            asm volatile("s_waitcnt vmcnt(0)" ::: "memory");
        }
    }
    __syncthreads();
}
struct TrJob { const GAS float* src; const GAS float* gain; GAS bf16* dst; int ldn, col0, k0, K, row0, dk; };
__device__ __forceinline__ void tr_load(const TrJob& j, f32x4 (&v)[8], int lane) {
    const int kr = lane >> 3, nq = lane & 7;
    if (j.col0 >= 0) {
#pragma unroll
        for (int i = 0; i < 8; ++i) v[i] = *(const GAS f32x4*)(j.src + (size_t)(j.k0 + 8 * i + kr) * j.ldn + j.col0 + 4 * nq);
    } else {
#pragma unroll
        for (int i = 0; i < 8; ++i) v[i] = (f32x4){0.f, 0.f, 0.f, 0.f};
    }
}
__device__ __forceinline__ void tr_finish(const TrJob& j, const f32x4 (&v)[8], LAS float* scr, int lane) {
    const int kr = lane >> 3, nq = lane & 7;
#pragma unroll
    for (int i = 0; i < 8; ++i) { const int kk = 8 * i + kr; const float g = j.gain ? j.gain[j.k0 + kk] : 1.f; LAS float* s = scr + kk * 33 + 4 * nq;
        s[0] = v[i][0] * g; s[1] = v[i][1] * g; s[2] = v[i][2] * g; s[3] = v[i][3] * g; }
    LDS_WAIT(); asm volatile("" ::: "memory");
    const int c = lane & 7;
#pragma unroll
    for (int q = 0; q < 4; ++q) { const int n = (lane >> 3) + 8 * q; const LAS float* s = scr + (8 * c) * 33 + n;
        u32x4 o; o.x = pk2(s[0 * 33], s[1 * 33]); o.y = pk2(s[2 * 33], s[3 * 33]); o.z = pk2(s[4 * 33], s[5 * 33]); o.w = pk2(s[6 * 33], s[7 * 33]);
        *(GAS u32x4*)(j.dst + (size_t)(j.row0 + n) * j.K + j.dk + j.k0 + 8 * c) = o; }
    LDS_WAIT(); asm volatile("" ::: "memory");
}
__device__ __forceinline__ void row_load(const GAS float* xrow, f32x4 (&v)[4], int lane) {
    const GAS f32x4* xr = (const GAS f32x4*)xrow + lane;
#pragma unroll
    for (int j = 0; j < 4; ++j) v[j] = xr[64 * j];
}
__device__ __forceinline__ void row_finish(const f32x4 (&v)[4], GAS bf16* orow, GAS float* ssq16, int lane) {
    float s = 0.f;
#pragma unroll
    for (int j = 0; j < 4; ++j) s += (v[j][0] * v[j][0] + v[j][1] * v[j][1]) + (v[j][2] * v[j][2] + v[j][3] * v[j][3]);
    s = wave_sum(s);
    GAS u32x2* o8 = (GAS u32x2*)orow + lane;
#pragma unroll
    for (int j = 0; j < 4; ++j) { u32x2 w; w.x = pk2(v[j][0], v[j][1]); w.y = pk2(v[j][2], v[j][3]); o8[64 * j] = w; }
    if (lane < 16) ssq16[lane] = (lane == 0) ? s : 0.f;
}
__device__ __forceinline__ void row_to_bf16(const GAS float* xrow, GAS bf16* orow, GAS float* ssq16, int lane) {
    const GAS f32x4* xr = (const GAS f32x4*)xrow + lane; f32x4 v[4]; float s = 0.f;
#pragma unroll
    for (int j = 0; j < 4; ++j) { v[j] = xr[64 * j]; s += (v[j][0] * v[j][0] + v[j][1] * v[j][1]) + (v[j][2] * v[j][2] + v[j][3] * v[j][3]); }
    s = wave_sum(s);
    GAS u32x2* o8 = (GAS u32x2*)orow + lane;
#pragma unroll
    for (int j = 0; j < 4; ++j) { u32x2 w; w.x = pk2(v[j][0], v[j][1]); w.y = pk2(v[j][2], v[j][3]); o8[64 * j] = w; }
    if (lane < 16) ssq16[lane] = (lane == 0) ? s : 0.f;
}

struct Args { const float* in[26]; float* out; unsigned char* ws; };
__device__ __forceinline__ int opq(int i) { asm volatile("" : "+s"(i)); return i; }
__device__ __forceinline__ GAS unsigned char* opqp(unsigned char* p0) { GAS unsigned char* p = (GAS unsigned char*)p0; asm volatile("" : "+s"(p)); return p; }
#define INP(i) ((const GAS float*)args.in[opq(i)])
#define WSB(off) (opqp(args.ws) + (off))
#define X_IN INP(0)
#define OUTP ((GAS float*)args.out)
#define XB ((GAS bf16*)WSB(WS_XB))
#define SSQ ((GAS float*)WSB(WS_SSQ))
#define SSQCQ ((GAS float*)WSB(WS_SSQCQ))
#define SSQCKV ((GAS float*)WSB(WS_SSQCKV))
#define SSQMEM ((GAS float*)WSB(WS_SSQMEM))
#define MEMN ((GAS bf16*)WSB(WS_MEMN))
#define XK ((GAS bf16*)WSB(WS_XK))
#define XVT ((GAS bf16*)WSB(WS_XVT))
#define WIN ((GAS bf16*)WSB(WS_WIN))
#define WV ((GAS bf16*)WSB(WS_WV))
#define WG ((GAS bf16*)WSB(WS_WG))
#define WUQ ((GAS bf16*)WSB(WS_WUQ))
#define WUKN ((GAS bf16*)WSB(WS_WUKN))
#define WUV ((GAS bf16*)WSB(WS_WUV))
#define WB ((GAS bf16*)WSB(WS_WB))
#define WOUT ((GAS bf16*)WSB(WS_WOUT))
#define WXQ ((GAS bf16*)WSB(WS_WXQ))
#define WXK ((GAS bf16*)WSB(WS_WXK))
#define WXV ((GAS bf16*)WSB(WS_WXV))
#define WXO ((GAS bf16*)WSB(WS_WXO))
#define WGU ((GAS bf16*)WSB(WS_WGU))
#define WD ((GAS bf16*)WSB(WS_WD))
#define WRH ((GAS bf16*)WSB(WS_WRH))
#define WRL ((GAS bf16*)WSB(WS_WRL))
#define CQ ((GAS bf16*)WSB(WS_CQ))
#define CKV ((GAS bf16*)WSB(WS_CKV))
#define KROPE ((GAS bf16*)WSB(WS_KROPE))
#define QK ((GAS bf16*)WSB(WS_QK))
#define VT ((GAS bf16*)WSB(WS_VT))
#define QMLA ((GAS bf16*)WSB(WS_QMLA))
#define KNOPE ((GAS bf16*)WSB(WS_KNOPE))
#define VMLAT ((GAS bf16*)WSB(WS_VMLAT))
#define OABC ((GAS bf16*)WSB(WS_OABC))
#define GSCR ((GAS unsigned char*)WSB(WS_GSCR))
#define MB ((GAS bf16*)WSB(WS_MB))
#define QX ((GAS bf16*)WSB(WS_QX))
#define OX ((GAS bf16*)WSB(WS_OX))
#define XG ((GAS bf16*)WSB(WS_XG))
#define ACT ((GAS bf16*)WSB(WS_ACT))
#define YB ((GAS bf16*)WSB(WS_Y))
#define TOKE ((GAS int*)WSB(WS_TOKE))
#define TOKW ((GAS float*)WSB(WS_TOKW))
#define HIST ((GAS int*)WSB(WS_HIST))
#define SLOT ((GAS int*)WSB(WS_SLOT))
#define STOK ((GAS int*)WSB(WS_STOK))
#define SW ((GAS float*)WSB(WS_SW))
#define SRSTD ((GAS float*)WSB(WS_SRSTD))


__global__ void __launch_bounds__(NTHREADS, 2) fwd(Args args) {
    extern __shared__ __attribute__((aligned(16))) unsigned char lds_raw[];
    LAS unsigned char* lds = (LAS unsigned char*)lds_raw;
    volatile LAS unsigned* MISC = (volatile LAS unsigned*)(lds + MISC_OFF);
    LAS int* TSTART = (LAS int*)(lds + TSTART_OFF);
    const int tid0 = threadIdx.x; const int wv = __builtin_amdgcn_readfirstlane(tid0 >> 6);
#define PH_BEGIN int tid_ = wv * 64 + lane_id(); asm volatile("" : "+v"(tid_)); const int tid = tid_, lane = tid & 63, wave = wv, gw = vcu * NWAVES + wave; (void)lane; (void)gw
    const int G = gridDim.x, bx = blockIdx.x, vcu = (G % 8 == 0) ? (bx % 8) * (G / 8) + bx / 8 : bx;
    unsigned* ctl = (unsigned*)(void*)(args.ws + WS_CTL);
    for (int u = tid0; u < (LDS_BYTES - LDSCTL_OFF) / 4; u += NTHREADS) ((LAS unsigned*)(lds + LDSCTL_OFF))[u] = 0u;
    __syncthreads();
    XcdBarrier bar = xcd_barrier_post(ctl + CW_BAR, MISC + 8, wv);
    const int NGW = G * NWAVES;

    constexpr float L2E = 1.4426950408889634f;

    constexpr int I_IN = 88 * 16, I_V = 32 * 16, I_G = 96 * 16, I_UQ = 24 * 4, I_UK = 16 * 4, I_B = 3 * 32 * 8, I_O = 32 * 16, I_XQ = 16 * 16, I_XO = 32 * 8, I_GU = 512 * 16, I_D = 1024 * 4;
    constexpr int NITEMS = I_IN + I_V + I_G + I_UQ + 2 * I_UK + I_B + I_O + 3 * I_XQ + I_XO + I_GU + I_D, NITEMS_P0 = NITEMS - I_GU - I_D;
    for (int l = 0; l < DEPTH; ++l) {
        for (int rp_ = 0; rp_ < RP_P0; ++rp_) {
#if PH_P0
        { PH_BEGIN;
            LAS float* scr = (LAS float*)(lds + wave * 16384);
#define w_in (INP(3) + (size_t)l * D * IN_COLS)
#define g_attn (INP(2) + l * D)
#define w_uq (INP(5) + (size_t)l * 256 * 768)
#define g_q (INP(4) + l * 256)
#define w_ukv (INP(7) + (size_t)l * 256 * 1024)
#define g_kv (INP(6) + l * 256)
#define w_br (INP(10) + (size_t)l * 3 * 512 * 1024)
#define w_out (INP(11) + (size_t)l * D * D)
#define g_cross (INP(12) + l * D)
#define g_mem (INP(13))
#define w_xq (INP(14) + (size_t)l * D * 512)
#define w_xkv (INP(15) + (size_t)l * D * 1024)
#define w_xo (INP(16) + (size_t)l * 512 * D)
#define g_ffn (INP(17) + l * D)
#define w_eg (INP(22) + (size_t)l * 32 * D * 256)
#define w_eu (INP(23) + (size_t)l * 32 * D * 256)
#define w_ed (INP(24) + (size_t)l * 32 * 256 * D)
#define TR_DECODE(itx) do { int r = (itx); \
                if (r < I_IN) { const int nb = r >> 4, kb = r & 15, n0 = nb * 32; int col; \
                    if (n0 < 544) col = 3072 + n0; else if (n0 < 768) col = -1; else if (n0 < 1792) col = 3616 + (n0 - 768); else col = 5152 + (n0 - 1792); \
                    jb = TrJob{w_in, g_attn, WIN, IN_COLS, col, kb * 64, 1024, n0, 0}; break; } r -= I_IN; \
                if (r < I_V) { const int nb = r >> 4, kb = r & 15, n0 = nb * 32; const int col = n0 < 512 ? 4640 + n0 : 6176 + (n0 - 512); \
                    jb = TrJob{w_in, g_attn, WV, IN_COLS, col, kb * 64, 1024, n0, 0}; break; } r -= I_V; \
                if (r < I_G) { const int nb = r >> 4, kb = r & 15; jb = TrJob{w_in, g_attn, WG, IN_COLS, nb * 32, kb * 64, 1024, nb * 32, 0}; break; } r -= I_G; \
                if (r < I_UQ) { const int nb = r >> 2, kb = r & 3, n0 = nb * 32; const int col = n0 < 512 ? 96 * (n0 >> 6) + (n0 & 63) : 96 * ((n0 - 512) >> 5) + 64; \
                    jb = TrJob{w_uq, g_q, WUQ, 768, col, kb * 64, 256, n0, 0}; break; } r -= I_UQ; \
                if (r < I_UK) { const int nb = r >> 2, kb = r & 3, n0 = nb * 32; jb = TrJob{w_ukv, g_kv, WUKN, 1024, 128 * (n0 >> 6) + (n0 & 63), kb * 64, 256, n0, 0}; break; } r -= I_UK; \
                if (r < I_UK) { const int nb = r >> 2, kb = r & 3, n0 = nb * 32; jb = TrJob{w_ukv, g_kv, WUV, 1024, 128 * (n0 >> 6) + 64 + (n0 & 63), kb * 64, 256, n0, 0}; break; } r -= I_UK; \
                if (r < I_B) { const int z = r / 256, q = r % 256, nb = q >> 3, kb = q & 7; jb = TrJob{w_br + (size_t)z * 512 * 1024, nullptr, WB + (size_t)(z >> 1) * 1024 * 1024, 1024, nb * 32, kb * 64, 1024, nb * 32, (z & 1) * 512}; break; } r -= I_B; \
                if (r < I_O) { const int nb = r >> 4, kb = r & 15; jb = TrJob{w_out, nullptr, WOUT, 1024, nb * 32, kb * 64, 1024, nb * 32, 0}; break; } r -= I_O; \
                if (r < I_XQ) { const int nb = r >> 4, kb = r & 15; jb = TrJob{w_xq, g_cross, WXQ, 512, nb * 32, kb * 64, 1024, nb * 32, 0}; break; } r -= I_XQ; \
                if (r < I_XQ) { const int nb = r >> 4, kb = r & 15; jb = TrJob{w_xkv, g_mem, WXK, 1024, nb * 32, kb * 64, 1024, nb * 32, 0}; break; } r -= I_XQ; \
                if (r < I_XQ) { const int nb = r >> 4, kb = r & 15; jb = TrJob{w_xkv, g_mem, WXV, 1024, 512 + nb * 32, kb * 64, 1024, nb * 32, 0}; break; } r -= I_XQ; \
                if (r < I_XO) { const int nb = r >> 3, kb = r & 7; jb = TrJob{w_xo, nullptr, WXO, 1024, nb * 32, kb * 64, 512, nb * 32, 0}; break; } r -= I_XO; \
                if (r < I_GU) { const int nb = r >> 4, kb = r & 15, n0 = nb * 32, e = n0 >> 9, rr = n0 & 511, t = rr >> 8, j = rr & 255; \
                    const GAS float* src = (j < 128 ? w_eg : w_eu) + (size_t)e * D * 256; jb = TrJob{src, g_ffn, WGU, 256, 128 * t + (j & 127), kb * 64, 1024, n0, 0}; break; } r -= I_GU; \
                { const int nb = r >> 2, kb = r & 3, n0 = nb * 32, e = n0 >> 10; jb = TrJob{w_ed + (size_t)e * 256 * 1024, nullptr, WD, 1024, n0 & 1023, kb * 64, 256, n0, 0}; } } while (0)
            for (int it = gw; it < NITEMS_P0; it += NGW) {
                TrJob jb{};
                TR_DECODE(it);
                f32x4 va[8];
                tr_load(jb, va, lane);
                tr_finish(jb, va, scr, lane);
            }
            { const GAS float* wrg = INP(18) + (size_t)l * D * 4; const GAS float* wre = INP(20) + (size_t)l * D * 32; GAS bf16* wh = WRH; GAS bf16* wl = WRL;
              for (int i = bx * NTHREADS + tid; i < 48 * 1024; i += G * NTHREADS) { const int c = i >> 10, k = i & 1023;
                  const float w = c < 36 ? (c < 4 ? wrg[k * 4 + c] : wre[k * 32 + (c - 4)]) * g_ffn[k] : 0.f; const unsigned h = pk2(w, 0.f) & 0xffffu;
                  wh[i] = (bf16)h; wl[i] = (bf16)(pk2(w - __builtin_bit_cast(float, h << 16), 0.f) & 0xffffu); } }
            if (l == 0) {
                for (int m = gw; m < M; m += 2 * NGW) {
                    const int m1 = m + NGW < M ? m + NGW : m;
                    f32x4 v0[4], v1[4]; row_load(X_IN + (size_t)m * D, v0, lane); row_load(X_IN + (size_t)m1 * D, v1, lane);
                    row_finish(v0, XB + (size_t)m * D, SSQ + (size_t)m * 16, lane); row_finish(v1, XB + (size_t)m1 * D, SSQ + (size_t)m1 * 16, lane); }
                for (int m = gw; m < 512; m += NGW) row_to_bf16(INP(1) + (size_t)m * D, MEMN + (size_t)m * D, SSQMEM + (size_t)m * 16, lane);
            }
        }
#endif
        xcd_barrier(bar);
        }
                for (int rp_ = 0; rp_ < RP_A; ++rp_) {
#if PH_A
        {
            { pg8::Gemm g{XB, WIN, M, 2816, D, D, nullptr}; pg8::StaticOrder S; S.init(M, 2816, G, bx);
              pg8::EpiA E{SSQ, CQ, CKV, KROPE, QK, SSQCQ, SSQCKV, 0.125f * L2E, (GAS unsigned*)(opqp(args.ws) + WS_CTL) + CW_KN + l * 4096, rp_ ? A_ABL : 0};
              pg8::gemm_phase<pg8::EpiA, pg8::StaticOrder, true, true>(lds, g, S, E, wv); }
            { pg8::Gemm g{WV, XB, 1024, M, D, D, nullptr}; pg8::StaticOrder S; S.init(1024, M, G, (bx + 64) % G);
              pg8::EpiVT E{VT, M, SSQ, 4, 1.f / 1024.f};
              pg8::gemm_phase<pg8::EpiVT, pg8::StaticOrder, true, true>(lds, g, S, E, wv); }
            { pg8::Gemm g{MEMN, WXK, 512, 512, D, D, nullptr}; pg8::StaticOrder S; S.init(512, 512, G, (bx + 8) % G);
              pg8::EpiRS E{XK, 512, SSQMEM, 4, 1.f / 1024.f, 1.f, 0xffff, 31, 0};
              pg8::gemm_phase<pg8::EpiRS, pg8::StaticOrder, true, true>(lds, g, S, E, wv); }
            { pg8::Gemm g{WXV, MEMN, 512, 512, D, D, nullptr}; pg8::StaticOrder S; S.init(512, 512, G, (bx + 16) % G);
              pg8::EpiVT E{XVT, 512, SSQMEM, 4, 1.f / 1024.f};
              pg8::gemm_phase<pg8::EpiVT, pg8::StaticOrder, true, true>(lds, g, S, E, wv); }
        }
#endif
        xcd_barrier(bar);
        }
                for (int rp_ = 0; rp_ < RP_B; ++rp_) {
#if PH_B
        {
#if PH_B1
            { pg8::Gemm g{CQ, WUQ, M, 768, opq(256), opq(256), nullptr}; pg8::StaticOrder S; S.init(M, 768, G, bx);
              pg8::EpiQ E{QMLA, SSQCQ, 0.10206207261596577f * L2E};
              pg8::gemm_phase<pg8::EpiQ, pg8::StaticOrder, true, true>(lds, g, S, E, wv); }
#endif
#if PH_B2
            { pg8::Gemm g{CKV, WUKN, M, 512, opq(256), opq(256), nullptr}; pg8::StaticOrder S; S.init(M, 512, G, (bx + 64) % G);
              pg8::EpiRS E{KNOPE, 512, SSQCKV, 1, 1.f / 256.f, 1.f, 0xffff, 31, 0};
              pg8::gemm_phase<pg8::EpiRS, pg8::StaticOrder, true, true>(lds, g, S, E, wv); }
#endif
#if PH_B3
            { pg8::Gemm g{WUV, CKV, 512, M, opq(256), opq(256), nullptr}; pg8::StaticOrder S; S.init(512, M, G, (bx + 128) % G);
              pg8::EpiVT E{VMLAT, M, SSQCKV, 1, 1.f / 256.f};
              pg8::gemm_phase<pg8::EpiVT, pg8::StaticOrder, true, true>(lds, g, S, E, wv); }
#endif
        }
#endif
        xcd_barrier(bar);
        }
                for (int rp_ = 0; rp_ < RP_C; ++rp_) {
#if PH_C
        {
            unsigned* qhead = ctl + CW_Q + 64 * (l + 2 * rp_);
            for (;;) {
                if (wv == 0 && lane_id() == 0) MISC[0] = __hip_atomic_fetch_add(qhead, 1u, __ATOMIC_RELAXED, __HIP_MEMORY_SCOPE_AGENT);
                __syncthreads();
                const int idx = (int)MISC[0];
                __syncthreads();
                if (idx >= 32 * 48 + 256) break;
                if (idx >= 32 * 48) {
                    if (rp_ == 0) { const int wl = lane_id(); LAS float* scr = (LAS float*)(lds + wv * 16384);
                        for (int j = 0; j < 6; ++j) { const int it = NITEMS_P0 + (idx - 32 * 48) * 48 + j * 8 + wv; TrJob jb{}; TR_DECODE(it); f32x4 va[8]; tr_load(jb, va, wl); tr_finish(jb, va, scr, wl); } }
                    continue; }
                const int qb = 31 - idx / 48, r = idx % 48, q0 = qb * 256;
                int tu = wv * 64 + lane_id(); asm volatile("" : "+v"(tu));
#if PH_C_DIFF
                if (r < 16 && (rp_ == 0 || (C_REP_MASK & 1))) att::diff_unit(lds, tu, r >> 3, (r >> 1) & 3, r & 1, q0, QK + (size_t)2 * M * 512, QK + (size_t)3 * M * 512, VT, (r & 1) ? CQ : OABC + (size_t)M * 1024, (r & 1) ? 512 : 1024,
                                                                             (const GAS unsigned*)(opqp(args.ws) + WS_CTL) + CW_KN + l * 4096, rp_ ? C_ABL : 0);
#endif
#if PH_C_SB
                if (r >= 16 && r < 32 && (rp_ == 0 || (C_REP_MASK & 2))) att::sb_unit(lds, tu, (r - 16) >> 3, (r - 16) & 7, q0, QK, QK + (size_t)M * 512, VT, OABC + 512);
#endif
#if PH_C_MLA
                if (r >= 32 && (rp_ == 0 || (C_REP_MASK & 4))) att::mla_unit(lds, tu, (r - 32) >> 3, (r - 32) & 7, q0, QMLA, KNOPE, KROPE, VMLAT, OABC, rp_ ? C_ABL : 0);
#endif
            }
        }
#endif
        xcd_barrier(bar);
        }
        #undef TR_DECODE
#undef w_in
#undef g_attn
#undef w_uq
#undef g_q
#undef w_ukv
#undef g_kv
#undef w_br
#undef w_out
#undef g_cross
#undef g_mem
#undef w_xq
#undef w_xkv
#undef w_xo
#undef g_ffn
#undef w_eg
#undef w_eu
#undef w_ed
#if PH_C
        { PH_BEGIN;
          float lam, post; att::diff_lambda(INP(8) + l * 256, l, lam, post);
          for (int it = gw; it < M * 4; it += 4 * NGW) att::diff_combine4(it, NGW, lane, OABC + (size_t)M * 1024, CQ, lam, post, INP(9) + l * 128); }
        xcd_barrier(bar);
#endif
        for (int rp_ = 0; rp_ < RP_D1; ++rp_) {
#if PH_D1
        { pg8::Gemm g{XB, WG, M, 1024, 512, 1024, nullptr}; pg8::D1Order S; S.so.init(M, 1024, G, bx);
          const GAS char* xb_ = (const GAS char*)XB; const GAS char* oab_ = (const GAS char*)OABC; const GAS char* wg_ = (const GAS char*)WG; const GAS char* wb_ = (const GAS char*)WB;
          S.dA = (size_t)(oab_ - xb_); S.dB = (size_t)(wb_ - wg_);
          pg8::EpiD1 E{GSCR, MB, SSQ};
          pg8::gemm_phase<pg8::EpiD1, pg8::D1Order, true, true>(lds, g, S, E, wv); }
#endif
        xcd_barrier(bar);
        }
        #if PH_D2
        { pg8::Gemm g{MB, WOUT, M, 1024, D, D, nullptr}; pg8::StaticOrder S; S.init(M, 1024, G, bx);
          pg8::EpiRes E{XB, SSQ};
          pg8::gemm_phase<pg8::EpiRes, pg8::StaticOrder, true, true>(lds, g, S, E, wv); }
#endif
        xcd_barrier(bar);
                for (int rp_ = 0; rp_ < RP_E1; ++rp_) {
#if PH_E1
        { pg8::Gemm g{XB, WXQ, M, 512, 512, 1024, nullptr}; pg8::SplitK2Order S; S.so.init(M, 1024, G, bx); S.tstep = (size_t)256 * 1024 * 2;
          pg8::EpiRS E{QX, 512, SSQ, 4, 1.f / 1024.f, 0.08838834764831845f * L2E, 1, 1, (size_t)M * 512};
          pg8::gemm_phase<pg8::EpiRS, pg8::SplitK2Order, true, true>(lds, g, S, E, wv); }
#endif
        xcd_barrier(bar);
        }
                for (int rp_ = 0; rp_ < RP_E2; ++rp_) {
#if PH_E2
        { PH_BEGIN; for (int u = vcu; u < 256; u += G) att::cross_unit(lds, tid, u >> 7, (u >> 5) & 3, (u & 31) * 256, QX, XK, XVT, OX); }
#endif
        xcd_barrier(bar);
        }
        #if PH_E3
        { pg8::Gemm g{OX, WXO, M, 1024, 512, 512, nullptr}; pg8::StaticOrder S; S.init(M, 1024, G, bx);
          pg8::EpiRes E{XB, SSQ};
          pg8::gemm_phase<pg8::EpiRes, pg8::StaticOrder, true, true>(lds, g, S, E, wv); }
#endif
        xcd_barrier(bar);
                for (int rp_ = 0; rp_ < RP_F0A; ++rp_) {
#if PH_F0A
        { PH_BEGIN;
            typedef short bf16x8 __attribute__((ext_vector_type(8)));
            const GAS float* brg = INP(19) + l * 4; const GAS float* bre = INP(21) + l * 32;
            LAS float* part = (LAS float*)lds;
            const int rb = wave & 3, kh = wave >> 2, r16 = lane & 15, kq = lane >> 4;
            for (int grp = bx; grp < 256; grp += G) {
                const GAS bf16* xrow = XB + (size_t)(grp * 64 + 16 * rb + r16) * D + 512 * kh + 8 * kq;
                const GAS bf16* wh = WRH + (size_t)r16 * 1024 + 512 * kh + 8 * kq; const GAS bf16* wl = WRL + (size_t)r16 * 1024 + 512 * kh + 8 * kq;
                f32x4 acc[3];
#pragma unroll
                for (int cb = 0; cb < 3; ++cb) acc[cb] = (f32x4){0.f, 0.f, 0.f, 0.f};
#pragma unroll 8
                for (int st = 0; st < 16; ++st) {
                    const bf16x8 ah = *(const GAS bf16x8*)(xrow + 32 * st);
#pragma unroll
                    for (int cb = 0; cb < 3; ++cb) {
                        const bf16x8 bh = *(const GAS bf16x8*)(wh + (size_t)cb * 16 * 1024 + 32 * st), bl = *(const GAS bf16x8*)(wl + (size_t)cb * 16 * 1024 + 32 * st);
                        acc[cb] = __builtin_amdgcn_mfma_f32_16x16x32_bf16(ah, bh, acc[cb], 0, 0, 0);
                        acc[cb] = __builtin_amdgcn_mfma_f32_16x16x32_bf16(ah, bl, acc[cb], 0, 0, 0);
                    }
                }
                __syncthreads();
#pragma unroll
                for (int cb = 0; cb < 3; ++cb)
#pragma unroll
                    for (int r = 0; r < 4; ++r) part[(kh * 64 + 16 * rb + 4 * kq + r) * 49 + 16 * cb + r16] = acc[cb][r];
                __syncthreads();
                if (wave == 0) {
                    const int tok = grp * 64 + lane; const float rs = pg8::rstd_parts(SSQ, (unsigned)(tok * 16), 4, 1.f / 1024.f);
                    const LAS float* p0 = part + lane * 49; const LAS float* p1 = part + (64 + lane) * 49;
                    float gl[4];
#pragma unroll
                    for (int c = 0; c < 4; ++c) gl[c] = (p0[c] + p1[c]) * rs + brg[c];
                    int gs = 0; float gm = gl[0];
#pragma unroll
                    for (int c = 1; c < 4; ++c) if (gl[c] > gm) { gm = gl[c]; gs = c; }
                    float den = 0.f;
#pragma unroll
                    for (int c = 0; c < 4; ++c) den += expf(gl[c] - gm);
                    const float pg = 1.0f / den;
                    float el[8];
#pragma unroll
                    for (int j = 0; j < 8; ++j) el[j] = (p0[4 + gs * 8 + j] + p1[4 + gs * 8 + j]) * rs + bre[gs * 8 + j];
                    int i0 = 0; float v0 = el[0];
#pragma unroll
                    for (int j = 1; j < 8; ++j) if (el[j] > v0) { v0 = el[j]; i0 = j; }
                    int i1 = -1; float v1 = -INFINITY;
#pragma unroll
                    for (int j = 0; j < 8; ++j) if (j != i0 && el[j] > v1) { v1 = el[j]; i1 = j; }
                    const float e1 = expf(v1 - v0), w0 = pg / (1.f + e1), w1 = pg * e1 / (1.f + e1);
                    const int ea = gs * 8 + i0, eb = gs * 8 + i1;
                    TOKE[tok * 2] = ea; TOKE[tok * 2 + 1] = eb; TOKW[tok * 2] = w0; TOKW[tok * 2 + 1] = w1;
                    int mycnt = 0;
#pragma unroll 1
                    for (int e = 0; e < 32; ++e) { const int c = __popcll(__ballot(ea == e)) + __popcll(__ballot(eb == e)); if (lane == e) mycnt = c; }
                    if (lane < 32) HIST[grp * 32 + lane] = mycnt;
                }
            }
            __syncthreads();
        }
#endif
        xcd_barrier(bar);
        }
                for (int rp_ = 0; rp_ < RP_F0B; ++rp_) {
#if PH_F0B
        { PH_BEGIN;
            LAS int* cnt = (LAS int*)(lds + HIST_OFF);
            for (int grp = bx; grp < 256; grp += G) {
                __syncthreads();
                { const int e = tid & 31, ch = tid >> 5; int tot = 0, before = 0;
#pragma unroll
                  for (int j = 0; j < 16; ++j) { const int g2 = ch * 16 + j; const int hv = HIST[g2 * 32 + e]; tot += hv; before += (g2 < grp) ? hv : 0; }
                  cnt[128 + ch * 32 + e] = tot; cnt[640 + ch * 32 + e] = before; }
                __syncthreads();
                if (tid < 32) { int tot = 0, before = 0;
                    for (int ch = 0; ch < 16; ++ch) { tot += cnt[128 + ch * 32 + tid]; before += cnt[640 + ch * 32 + tid]; }
                    cnt[tid] = tot; cnt[32 + tid] = before; }
                __syncthreads();
                if (tid == 0) { int ts = 0; for (int e = 0; e < 32; ++e) { TSTART[e] = ts; ts += (cnt[e] + 255) >> 8; } TSTART[32] = ts; }
                __syncthreads();
                if (wave == 0) {
                    const int tok = grp * 64 + lane; const int ea = TOKE[tok * 2], eb = TOKE[tok * 2 + 1];
                    int ra = 0, rb = 0; const unsigned long long lt = (1ull << lane) - 1ull;
#pragma unroll 1
                    for (int e = 0; e < 32; ++e) { const unsigned long long ma = __ballot(ea == e), mb = __ballot(eb == e); const int c = __popcll((ma | mb) & lt); if (ea == e) ra = c; if (eb == e) rb = c; }
                    const int sa = TSTART[ea] * 256 + cnt[32 + ea] + ra, sb = TSTART[eb] * 256 + cnt[32 + eb] + rb;
                    const float rsd = pg8::rstd_parts(SSQ, (unsigned)(tok * 16), 4, 1.f / 1024.f);
                    SLOT[tok * 2] = sa; SLOT[tok * 2 + 1] = sb;
                    STOK[sa] = tok; STOK[sb] = tok; SW[sa] = TOKW[tok * 2]; SW[sb] = TOKW[tok * 2 + 1]; SRSTD[sa] = rsd; SRSTD[sb] = rsd;
                    MISC[16 + lane] = (unsigned)sa; MISC[80 + lane] = (unsigned)sb;
                }
                __syncthreads();
                if (grp < 32) { const int beg = TSTART[grp] * 256 + cnt[grp], end = TSTART[grp + 1] * 256;
                    for (int s = beg + tid; s < end; s += NTHREADS) { STOK[s] = 0; SW[s] = 0.f; SRSTD[s] = 0.f; } }
            }
            if (G > 256 || bx >= 256) {
                __syncthreads();
                if (tid < 32) { int tot = 0; for (int g2 = 0; g2 < 256; ++g2) tot += HIST[g2 * 32 + tid]; cnt[tid] = tot; }
                __syncthreads();
                if (tid == 0) { int ts = 0; for (int e = 0; e < 32; ++e) { TSTART[e] = ts; ts += (cnt[e] + 255) >> 8; } TSTART[32] = ts; }
            }
            __syncthreads();
        }
#endif
        xcd_barrier(bar);
        }
                for (int rp_ = 0; rp_ < RP_F1; ++rp_) {
#if PH_F1
        { pg8::Gemm g{XB, WGU, SROWS, 32 * 512, D, D, STOK}; pg8::MoeOrderP S{(const LAS int*)TSTART, (GAS unsigned*)(opqp(args.ws) + WS_CTL) + CW_F1 + l * 256, G, vcu};
          pg8::EpiAct E{ACT, SRSTD, SW};
          pg8::gemm_phase<pg8::EpiAct, pg8::MoeOrderP, true, true, true>(lds, g, S, E, wv); }
#endif
        }
                for (int rp_ = 0; rp_ < RP_F2; ++rp_) {
#if PH_F2
        { pg8::Gemm g{ACT, WD, SROWS, 32 * 1024, opq(256), opq(256), nullptr}; pg8::MoeOrderC S{(const LAS int*)TSTART, (const GAS unsigned*)(opqp(args.ws) + WS_CTL) + CW_F1 + l * 256, G, vcu, wv};
          pg8::EpiRS E{YB, 1024, nullptr, 0, 0.f, 1.f, 3, 31, 0};
          pg8::gemm_phase<pg8::EpiRS, pg8::MoeOrderC, true, true>(lds, g, S, E, wv); }
#endif
        xcd_barrier(bar);
        }
#if PH_F3
        { PH_BEGIN;
            const GAS float* g_fin = INP(25);
            int s0n = SLOT[gw * 2], s1n = SLOT[gw * 2 + 1];
            for (int m = gw; m < M; m += NGW) {
                GAS u32x2* xr = (GAS u32x2*)(XB + (size_t)m * D) + lane; const int s0 = s0n, s1 = s1n;
                if (m + NGW < M) { s0n = SLOT[(m + NGW) * 2]; s1n = SLOT[(m + NGW) * 2 + 1]; }
                const GAS u32x2* y0 = (const GAS u32x2*)(YB + (size_t)s0 * D) + lane; const GAS u32x2* y1 = (const GAS u32x2*)(YB + (size_t)s1 * D) + lane;
                f32x4 v[4]; float s = 0.f;
#pragma unroll
                for (int j = 0; j < 4; ++j) { const u32x2 a = y0[64 * j], b2 = y1[64 * j], xw = xr[64 * j];
                    v[j][0] = pg8::bflo(xw.x) + (pg8::bflo(a.x) + pg8::bflo(b2.x)); v[j][1] = pg8::bfhi(xw.x) + (pg8::bfhi(a.x) + pg8::bfhi(b2.x));
                    v[j][2] = pg8::bflo(xw.y) + (pg8::bflo(a.y) + pg8::bflo(b2.y)); v[j][3] = pg8::bfhi(xw.y) + (pg8::bfhi(a.y) + pg8::bfhi(b2.y));
                    s += (v[j][0] * v[j][0] + v[j][1] * v[j][1]) + (v[j][2] * v[j][2] + v[j][3] * v[j][3]); }
                s = wave_sum(s);
                if (l == DEPTH - 1) { const float rsd = 1.0f / sqrtf(s * (1.f / 1024.f) + 1e-6f); GAS f32x4* orow = (GAS f32x4*)(OUTP + (size_t)m * D) + lane;
#pragma unroll
                    for (int j = 0; j < 4; ++j) { const f32x4 gg = ((const GAS f32x4*)g_fin)[lane + 64 * j]; orow[64 * j] = v[j] * rsd * gg; }
                } else {
#pragma unroll
                    for (int j = 0; j < 4; ++j) { u32x2 w; w.x = pk2(v[j][0], v[j][1]); w.y = pk2(v[j][2], v[j][3]); xr[64 * j] = w; }
                    if (lane < 16) SSQ[(size_t)m * 16 + lane] = (lane == 0) ? s : 0.f;
                }
            }
        }
#endif
    }
}

extern "C" void kernel_launch(void* const* d_in, const int* in_sizes, int n_in, void* d_out, int out_size, void* d_ws, size_t ws_size, hipStream_t stream) {
    static int grid = 0;
    if (grid == 0) {
        if (n_in != 26 || in_sizes[0] != M * D || out_size != M * D || ws_size < WS_END) { fprintf(stderr, "kernel_launch: unexpected shapes (n_in %d, in0 %d, out %d, ws %zu < %zu)\n", n_in, n_in > 0 ? in_sizes[0] : -1, out_size, ws_size, (size_t)WS_END); grid = -1; return; }
        int dev = 0, cus = 0;
        if (hipGetDevice(&dev) != hipSuccess || hipDeviceGetAttribute(&cus, hipDeviceAttributeMultiprocessorCount, dev) != hipSuccess) { grid = -1; return; }
        if (hipFuncSetAttribute((const void*)fwd, hipFuncAttributeMaxDynamicSharedMemorySize, LDS_BYTES) != hipSuccess) { fprintf(stderr, "kernel_launch: hipFuncSetAttribute failed\n"); grid = -1; return; }
        int per_cu = 0;
        if (hipOccupancyMaxActiveBlocksPerMultiprocessor(&per_cu, (const void*)fwd, NTHREADS, LDS_BYTES) != hipSuccess || per_cu < 1) fprintf(stderr, "kernel_launch: occupancy query says %d\n", per_cu);
        (void)hipGetLastError();
        grid = cus < 256 ? (cus / 8) * 8 : 256;
    }
    if (grid <= 0) return;
    if (hipMemsetAsync((char*)d_ws + WS_CTL, 0, CTL_ZERO_BYTES, stream) != hipSuccess) return;
    Args a{};
    for (int i = 0; i < 26; ++i) a.in[i] = (const float*)d_in[i];
    a.out = (float*)d_out; a.ws = (unsigned char*)d_ws;
    hipLaunchKernelGGL(fwd, dim3(grid), dim3(NTHREADS), LDS_BYTES, stream, a);
}
```

```cpp
#include <hip/hip_runtime.h>
#include <cstdio>
#include <cstdint>
#define LAS __attribute__((address_space(3)))
#define GAS __attribute__((address_space(1)))
#ifndef PH_A
#define PH_A 1
#endif
#ifndef PH_B
#define PH_B 1
#endif
#ifndef PH_C
#define PH_C 1
#endif
#ifndef PH_D1
#define PH_D1 1
#endif
#ifndef PH_D2
#define PH_D2 1
#endif
#ifndef PH_E1
#define PH_E1 1
#endif
#ifndef PH_E2
#define PH_E2 1
#endif
#ifndef PH_E3
#define PH_E3 1
#endif
#ifndef PH_F0A
#define PH_F0A 1
#endif
#ifndef PH_F0B
#define PH_F0B 1
#endif
#ifndef PH_F1
#define PH_F1 1
#endif
#ifndef PH_F2
#define PH_F2 1
#endif
#ifndef PH_P0
#define PH_P0 1
#endif
#ifndef PH_F3
#define PH_F3 1
#endif
#ifndef PH_C_DIFF
#define PH_C_DIFF 1
#endif
#ifndef PH_C_SB
#define PH_C_SB 1
#endif
#ifndef PH_C_MLA
#define PH_C_MLA 1
#endif
#ifndef PH_B1
#define PH_B1 1
#endif
#ifndef PH_B2
#define PH_B2 1
#endif
#ifndef PH_B3
#define PH_B3 1
#endif
#ifndef RP_A
#define RP_A 1
#endif
#ifndef RP_B
#define RP_B 1
#endif
#ifndef RP_C
#define RP_C 1
#endif
#ifndef RP_D1
#define RP_D1 1
#endif
#ifndef RP_E1
#define RP_E1 1
#endif
#ifndef RP_E2
#define RP_E2 1
#endif
#ifndef RP_F0A
#define RP_F0A 1
#endif
#ifndef RP_F0B
#define RP_F0B 1
#endif
#ifndef RP_F1
#define RP_F1 1
#endif
#ifndef RP_F2
#define RP_F2 1
#endif
#ifndef RP_P0
#define RP_P0 1
#endif
#ifndef C_REP_MASK
#define C_REP_MASK 7
#endif
#ifndef A_ABL
#define A_ABL 0
#endif
#ifndef C_ABL
#define C_ABL 0
#endif
namespace pg8 {
#define PG8_LAS __attribute__((address_space(3)))
typedef unsigned short bf16_t;
typedef short bf16x8 __attribute__((ext_vector_type(8)));
typedef float f32x4 __attribute__((ext_vector_type(4)));
typedef unsigned u32x4 __attribute__((ext_vector_type(4)));
constexpr int BM = 256, BK = 64, HALF = 128, HTB = HALF * BK * 2  , STAGE_BYTES = 8 * HTB, NXCD = 8, WGM = 8;

__host__ __device__ __forceinline__ int lds_byte(int r, int c) { const int st = (r >> 4) * 2 + (c >> 5), rr = r & 15, cc = c & 31, ob = rr * 64 + cc * 2; return st * 1024 + (ob ^ (((ob >> 9) & 1) << 5)); }
__host__ __device__ __forceinline__ void stage_rc(int b, int& R, int& C) { const int st = b / 1024, sb = b % 1024, swz = sb ^ (((sb >> 9) & 1) << 5); R = (st >> 1) * 16 + swz / 64; C = (st & 1) * 32 + (swz % 64) / 2; }
__host__ __device__ __forceinline__ int perm32(int rho) { const int n = rho >> 4, i = rho & 15; return 8 * (i >> 2) + 4 * n + (i & 3); }

struct Unit { int pm, pn, sel; };
struct Gemm { const GAS bf16_t* A; const GAS bf16_t* Bt; int M, N, K, ld; const GAS int* rowidx; };

struct StaticOrder {
    int nM, nN, nwg, G, c;
    __host__ __device__ void init(int M, int N, int G_, int c_) { nM = M / BM; nN = N / BM; nwg = nM * nN; G = G_; c = c_; }
    __host__ __device__ bool next(int i, Unit& u) const {
        const long L = (long)i * G + c; if (L >= nwg) return false;
        int wgid = (int)L; { const int q = nwg / NXCD, r = nwg % NXCD, xcd = wgid % NXCD, off = wgid / NXCD; wgid = (xcd < r ? xcd * (q + 1) : r * (q + 1) + (xcd - r) * q) + off; }
        const int nig = WGM * nN, gid = wgid / nig, fm = gid * WGM, gsz = (nM - fm) < WGM ? (nM - fm) : WGM;
        u.pm = fm + ((wgid % nig) % gsz); u.pn = (wgid % nig) / gsz; u.sel = 0; return true;
    }
    __device__ __forceinline__ void a_ready(const Unit&) const {}
    __device__ __forceinline__ void done(const Unit&) const {}
    __device__ __forceinline__ size_t a_off(const Unit&) const { return 0; }
    __device__ __forceinline__ size_t b_off(const Unit&) const { return 0; }
    __device__ __forceinline__ bool keep(const Unit&) const { return false; }
};

__device__ __forceinline__ unsigned cvt_pk_bf16(float lo, float hi) { unsigned r; asm volatile("v_cvt_pk_bf16_f32 %0, %1, %2" : "=v"(r) : "v"(lo), "v"(hi)); return r; }
template <class T, class = void> struct HasScale { static constexpr bool v = false; };
template <class T> struct HasScale<T, decltype((void)T::SCALE)> { static constexpr bool v = true; };
template <class Epi, class Sched, bool ALIGN_EPI = false, bool SP2 = false, bool GATHER = false>
__device__ __forceinline__ void gemm_phase(PG8_LAS unsigned char* lds, const Gemm g, const Sched& S, const Epi& E, const int wave_idx) {
    int tid_; asm volatile("v_mbcnt_lo_u32_b32 %0, -1, 0\n\tv_mbcnt_hi_u32_b32 %0, -1, %0" : "=v"(tid_)); tid_ += wave_idx * 64;
    const int tid = tid_, wid = __builtin_amdgcn_readfirstlane(tid >> 6), lane = tid & 63, wr = wid >> 2, wc = wid & 3, fr = lane & 15, fq = lane >> 4;
    const int K = g.K, nt = K / BK, LD = g.ld;
    unsigned voffA[2], voffB[2];
#pragma unroll
    for (int i = 0; i < 2; ++i) { int R, C; stage_rc(tid * 16 + i * 8192, R, C); const int Rb = Epi::PERM ? ((R & ~31) + perm32(R & 31)) : R;
        voffA[i] = (unsigned)(R * LD + C) * 2u; voffB[i] = (unsigned)(Rb * LD + C) * 2u; }
    const size_t kstep = (size_t)(BK * 2);
    const size_t hstep = (size_t)HALF * LD * 2;
    const size_t tstep = 2 * hstep;
    const unsigned ldsw = (unsigned)wid * 1024u;
    const int aoff = lds_byte(wr * 64 + fr, fq * 8), boff = lds_byte(wc * 32 + fr, fq * 8);
#define PG8_SA(b, h) (((b) * 2 + (h)) * HTB)
#define PG8_SB(b, h) ((4 + (b) * 2 + (h)) * HTB)
#define PG8_STAGE(bufoff, gbase, voff) do { _Pragma("unroll") for (int _i = 0; _i < 2; ++_i) \
        __builtin_amdgcn_global_load_lds((const GAS unsigned*)((const GAS char*)(gbase) + (voff)[_i]), (PG8_LAS unsigned*)(lds + (bufoff) + ldsw + _i * 8192), 16, 0, 0); } while (0)
#define PG8_LDA(dst, b, h) do { _Pragma("unroll") for (int m = 0; m < 4; ++m) _Pragma("unroll") for (int k = 0; k < 2; ++k) dst[m][k] = *(const PG8_LAS bf16x8*)(lds + PG8_SA(b, h) + aoff + m * 2048 + k * 1024); } while (0)
#define PG8_LDB(dst, b, h) do { _Pragma("unroll") for (int n = 0; n < 2; ++n) _Pragma("unroll") for (int k = 0; k < 2; ++k) dst[n][k] = *(const PG8_LAS bf16x8*)(lds + PG8_SB(b, h) + boff + n * 2048 + k * 1024); } while (0)
#define PG8_MMA(ai, bj, At, Bt) do { __builtin_amdgcn_s_setprio(1); _Pragma("unroll") for (int m = 0; m < 4; ++m) _Pragma("unroll") for (int n = 0; n < 2; ++n) _Pragma("unroll") for (int k = 0; k < 2; ++k) \
        acc[ai][bj][m][n] = __builtin_amdgcn_mfma_f32_16x16x32_bf16(Bt[n][k], At[m][k], acc[ai][bj][m][n], 0, 0, 0); __builtin_amdgcn_s_setprio(0); } while (0)
#define PG8_WAIT_V(n) asm volatile("s_waitcnt vmcnt(" #n ")" ::: "memory")
#define PG8_WAIT_L(n) asm volatile("s_waitcnt lgkmcnt(" #n ")" ::: "memory")
#define PG8_BAR __builtin_amdgcn_s_barrier()
#define PG8_SCHED __builtin_amdgcn_sched_barrier(0)
    Unit cur, nxt; int ui = 0;
    if (!S.next(0, cur)) return;
    f32x4 acc[2][2][4][2];
#pragma unroll
    for (int a = 0; a < 2; ++a)
#pragma unroll
        for (int b = 0; b < 2; ++b)
#pragma unroll
            for (int m = 0; m < 4; ++m)
#pragma unroll
                for (int n = 0; n < 2; ++n) acc[a][b][m][n] = (f32x4){0.f, 0.f, 0.f, 0.f};
    bf16x8 At[4][2], B0[2][2], B1[2][2];
    const GAS char* cA = (const GAS char*)g.A + (GATHER ? (size_t)0 : (size_t)cur.pm * tstep + S.a_off(cur)); const GAS char* cB = (const GAS char*)g.Bt + (size_t)cur.pn * tstep + S.b_off(cur);
    unsigned vC[2][2], vN[2][2];
    if constexpr (GATHER) {
#pragma unroll
        for (int h = 0; h < 2; ++h)
#pragma unroll
            for (int i = 0; i < 2; ++i) { int R, C; stage_rc(tid * 16 + i * 8192, R, C); vC[h][i] = (unsigned)(g.rowidx[cur.pm * BM + h * HALF + R] * LD + C) * 2u; vN[h][i] = vC[h][i]; }
    }
#define PG8_STAGE_A(bufoff, gb, h, nx) do { if constexpr (GATHER) { unsigned vs_[2] = {(nx) ? vN[h][0] : vC[h][0], (nx) ? vN[h][1] : vC[h][1]}; PG8_STAGE(bufoff, gb, vs_); } \
        else { PG8_STAGE(bufoff, (gb) + (h) * hstep, voffA); } } while (0)
    S.a_ready(cur);
    if constexpr (SP2) {
        PG8_STAGE(PG8_SB(0, 0), cB, voffB); PG8_STAGE(PG8_SB(0, 1), cB + hstep, voffB); PG8_STAGE_A(PG8_SA(0, 0), cA, 0, false); PG8_STAGE_A(PG8_SA(0, 1), cA, 1, false);
        if (wr == 1) PG8_BAR;
        PG8_WAIT_V(2); PG8_BAR;
        PG8_STAGE(PG8_SB(1, 0), cB + kstep, voffB); PG8_STAGE_A(PG8_SA(1, 0), cA + kstep, 0, false); PG8_STAGE(PG8_SB(1, 1), cB + hstep + kstep, voffB);
        PG8_WAIT_V(6); PG8_BAR;
    } else {
        PG8_STAGE(PG8_SB(0, 0), cB, voffB); PG8_STAGE(PG8_SA(0, 0), cA, voffA); PG8_STAGE(PG8_SB(0, 1), cB + hstep, voffB); PG8_STAGE(PG8_SA(0, 1), cA + hstep, voffA);
        if (wr == 1) PG8_BAR;
        PG8_WAIT_V(4); PG8_BAR;
        PG8_STAGE(PG8_SB(1, 0), cB + kstep, voffB); PG8_STAGE(PG8_SA(1, 0), cA + kstep, voffA); PG8_STAGE(PG8_SB(1, 1), cB + hstep + kstep, voffB);
        PG8_WAIT_V(6); PG8_BAR;
    }
    for (;;) {
        const bool has_next = S.next(ui + 1, nxt);
        if constexpr (GATHER) { if (has_next) {
#pragma unroll
            for (int h = 0; h < 2; ++h)
#pragma unroll
                for (int i = 0; i < 2; ++i) { int R, C; stage_rc(tid * 16 + i * 8192, R, C); vN[h][i] = (unsigned)(g.rowidx[nxt.pm * BM + h * HALF + R] * LD + C) * 2u; } } }
        const GAS char* nA = GATHER ? cA : has_next ? (const GAS char*)g.A + (size_t)nxt.pm * tstep + S.a_off(nxt) : cA; const GAS char* nB = has_next ? (const GAS char*)g.Bt + (size_t)nxt.pn * tstep + S.b_off(nxt) : cB;
        for (int t = 0; t < nt; t += 2) {
            const bool last = (t == nt - 2);
            const GAS char* a1 = cA + (size_t)(t + 1) * kstep;
            const GAS char* a2 = last ? nA : cA + (size_t)(t + 2) * kstep; const GAS char* b2 = last ? nB : cB + (size_t)(t + 2) * kstep;
            const GAS char* a3 = a2 + kstep; const GAS char* b3 = b2 + kstep;
            if (last && has_next) S.a_ready(nxt);
            if constexpr (SP2) {
            PG8_LDB(B0, 0, 0); PG8_LDB(B1, 0, 1); PG8_SCHED; PG8_LDA(At, 0, 0); PG8_STAGE_A(PG8_SA(1, 1), a1, 1, false);
            PG8_WAIT_V(8); PG8_WAIT_L(0); PG8_BAR; PG8_MMA(0, 0, At, B0); PG8_MMA(0, 1, At, B1); PG8_BAR; PG8_SCHED;
            PG8_LDA(At, 0, 1); PG8_STAGE(PG8_SB(0, 0), b2, voffB); PG8_STAGE(PG8_SB(0, 1), b2 + hstep, voffB); PG8_STAGE_A(PG8_SA(0, 0), a2, 0, last);
            PG8_WAIT_V(8); PG8_WAIT_L(0); PG8_BAR; PG8_MMA(1, 0, At, B0); PG8_MMA(1, 1, At, B1); PG8_BAR; PG8_SCHED;
            PG8_LDB(B0, 1, 0); PG8_LDB(B1, 1, 1); PG8_SCHED; PG8_LDA(At, 1, 0); PG8_STAGE_A(PG8_SA(0, 1), a2, 1, last);
            PG8_WAIT_V(8); PG8_WAIT_L(0); PG8_BAR; PG8_MMA(0, 0, At, B0); PG8_MMA(0, 1, At, B1); PG8_BAR; PG8_SCHED;
            PG8_LDA(At, 1, 1); PG8_STAGE(PG8_SB(1, 0), b3, voffB); PG8_STAGE(PG8_SB(1, 1), b3 + hstep, voffB); PG8_STAGE_A(PG8_SA(1, 0), a3, 0, last);
            PG8_WAIT_V(8); PG8_WAIT_L(0); PG8_BAR; PG8_MMA(1, 0, At, B0); PG8_MMA(1, 1, At, B1); PG8_BAR; PG8_SCHED;
            } else {
            PG8_LDB(B0, 0, 0); PG8_SCHED; PG8_LDA(At, 0, 0); PG8_STAGE(PG8_SA(1, 1), a1 + hstep, voffA);
            PG8_WAIT_L(8); PG8_BAR; PG8_WAIT_L(0); PG8_MMA(0, 0, At, B0); PG8_BAR; PG8_SCHED;
            PG8_LDB(B1, 0, 1); PG8_STAGE(PG8_SB(0, 0), b2, voffB);
            PG8_BAR; PG8_WAIT_L(0); PG8_MMA(0, 1, At, B1); PG8_BAR;
            PG8_LDA(At, 0, 1); PG8_STAGE(PG8_SA(0, 0), a2, voffA);
            PG8_BAR; PG8_WAIT_L(0); PG8_MMA(1, 0, At, B0); PG8_BAR; PG8_SCHED;
            PG8_STAGE(PG8_SB(0, 1), b2 + hstep, voffB);
            PG8_WAIT_V(6); PG8_BAR; PG8_MMA(1, 1, At, B1); PG8_BAR;
            PG8_LDB(B0, 1, 0); PG8_SCHED; PG8_LDA(At, 1, 0); PG8_STAGE(PG8_SA(0, 1), a2 + hstep, voffA);
            PG8_WAIT_L(8); PG8_BAR; PG8_WAIT_L(0); PG8_MMA(0, 0, At, B0); PG8_BAR; PG8_SCHED;
            PG8_LDB(B1, 1, 1); PG8_STAGE(PG8_SB(1, 0), b3, voffB);
            PG8_BAR; PG8_WAIT_L(0); PG8_MMA(0, 1, At, B1); PG8_BAR;
            PG8_LDA(At, 1, 1); PG8_STAGE(PG8_SA(1, 0), a3, voffA);
            PG8_BAR; PG8_WAIT_L(0); PG8_MMA(1, 0, At, B0); PG8_BAR; PG8_SCHED;
            PG8_STAGE(PG8_SB(1, 1), b3 + hstep, voffB);
            PG8_WAIT_V(6); PG8_BAR; PG8_MMA(1, 1, At, B1); PG8_BAR;
            }
        }
        if constexpr (ALIGN_EPI) { if (wr == 0) PG8_BAR; }
        const int keep_ = (int)S.keep(cur);
        if constexpr (HasScale<Epi>::v) { if (keep_ == 2) E.scale(acc, cur, wr, wc, fr, fq); }
        if constexpr (!Epi::AFTER_DRAIN) { if (keep_ == 0) { E(acc, cur, wr, wc, fr, fq); S.done(cur); } }
        if (!has_next) break;
        if (keep_ == 0) {
#pragma unroll
        for (int a = 0; a < 2; ++a)
#pragma unroll
            for (int b = 0; b < 2; ++b)
#pragma unroll
                for (int m = 0; m < 4; ++m)
#pragma unroll
                    for (int n = 0; n < 2; ++n) acc[a][b][m][n] = (f32x4){0.f, 0.f, 0.f, 0.f}; }
        cur = nxt; cA = nA; cB = nB; ++ui;
        if constexpr (GATHER) { vC[0][0] = vN[0][0]; vC[0][1] = vN[0][1]; vC[1][0] = vN[1][0]; vC[1][1] = vN[1][1]; }
        if constexpr (ALIGN_EPI) { if (wr == 1) PG8_BAR; }
    }
    PG8_WAIT_V(0);
    if constexpr (!ALIGN_EPI) { if (wr == 0) PG8_BAR; }
    PG8_BAR;
    if constexpr (Epi::AFTER_DRAIN) { E.fused(acc, cur, wr, wc, fr, fq, lds, wid, lane); S.done(cur); }
#undef PG8_SA
#undef PG8_SB
#undef PG8_STAGE
#undef PG8_STAGE_A
#undef PG8_LDA
#undef PG8_LDB
#undef PG8_MMA
#undef PG8_WAIT_V
#undef PG8_WAIT_L
#undef PG8_BAR
#undef PG8_SCHED
}
typedef unsigned u32x2 __attribute__((ext_vector_type(2)));
typedef float f32x2v __attribute__((ext_vector_type(2)));
typedef __bf16 bf16x2v __attribute__((ext_vector_type(2)));
__device__ __forceinline__ unsigned pk2(float lo, float hi) { f32x2v v = {lo, hi}; bf16x2v b = __builtin_convertvector(v, bf16x2v); return __builtin_bit_cast(unsigned, b); }
__device__ __forceinline__ float bflo(unsigned w) { return __builtin_bit_cast(float, w << 16); }
__device__ __forceinline__ float bfhi(unsigned w) { return __builtin_bit_cast(float, w & 0xffff0000u); }
__device__ __forceinline__ float rstd_parts(const GAS float* base, unsigned eoff, int n4, float inv_n) {
    float s = 0.f; const GAS char* p = (const GAS char*)base + (size_t)(eoff * 4u);
    for (int i = 0; i < n4; ++i) { const f32x4 v = *(const GAS f32x4*)(p + 16 * i); s += (v[0] + v[1]) + (v[2] + v[3]); }
    return __builtin_amdgcn_rsqf(s * inv_n + 1e-6f);
}
__device__ __forceinline__ __amdgpu_buffer_rsrc_t wt_rsrc(GAS void* base) { return __builtin_amdgcn_make_buffer_rsrc((void*)base, 0, 0x7fffffff, 0x00020000); }
__device__ __forceinline__ void st16_wt(__amdgpu_buffer_rsrc_t r, unsigned byteoff, u32x4 v) { __builtin_amdgcn_raw_buffer_store_b128(v, r, byteoff, 0, 16); }
__device__ __forceinline__ float rows4_sum(float s) {
    const unsigned u = __builtin_bit_cast(unsigned, s);
    auto r = __builtin_amdgcn_permlane16_swap(u, u, false, false);
    const float t = __builtin_bit_cast(float, (unsigned)r[0]) + __builtin_bit_cast(float, (unsigned)r[1]);
    const unsigned v = __builtin_bit_cast(unsigned, t);
    auto q = __builtin_amdgcn_permlane32_swap(v, v, false, false);
    return __builtin_bit_cast(float, (unsigned)q[0]) + __builtin_bit_cast(float, (unsigned)q[1]);
}
__device__ __forceinline__ float rstd16_coop(const GAS float* base, unsigned row, int fq, float inv_n) {
    const f32x4 v = *(const GAS f32x4*)((const GAS char*)base + (size_t)((row * 16u + (unsigned)fq * 4u) * 4u));
    return __builtin_amdgcn_rsqf(rows4_sum((v[0] + v[1]) + (v[2] + v[3])) * inv_n + 1e-6f);
}
__device__ __forceinline__ void swap16(unsigned& a, unsigned& b) { auto r = __builtin_amdgcn_permlane16_swap(a, b, false, false); a = r[0]; b = r[1]; }
__device__ __forceinline__ int swz8(int fq) { return 8 * (((fq & 1) << 1) | (fq >> 1)); }
__device__ const double kRopeRev[16] = {0.15915494309189535, 0.08949940160889101, 0.050329212104487035, 0.0283021958306234, 0.015915494309189534, 0.008949940160889102, 0.005032921210448704, 0.00283021958306234,
                                        0.0015915494309189536, 0.0008949940160889102, 0.0005032921210448703, 0.00028302195830623395, 0.00015915494309189535, 8.949940160889102e-05, 5.0329212104487035e-05, 2.8302195830623396e-05};
__device__ __forceinline__ void rope_cs(int pos, int i, float& cs, float& sn) {
    double a = (double)pos * kRopeRev[i]; a -= __builtin_floor(a);
    const float r = (float)a; sn = __builtin_amdgcn_sinf(r); cs = __builtin_amdgcn_cosf(r);
}
#define PG8_L2E 1.4426950408889634f

struct EpiA {
    static constexpr bool PERM = false, AFTER_DRAIN = false;
    const GAS float* ssq; GAS bf16_t *cq, *ckv, *krope, *qk; GAS float *ssq_cq, *ssq_ckv; float c2; GAS unsigned* kn; int skip;
    __device__ __forceinline__ void operator()(const f32x4 (&acc)[2][2][4][2], const Unit& u, int wr, int wc, int fr, int fq) const {
        if (skip) return;
        const int pn = u.pn, row0 = u.pm * BM + wr * 64 + fr;
        float rs[2][4];
#pragma unroll
        for (int ai = 0; ai < 2; ++ai)
#pragma unroll
            for (int m = 0; m < 4; ++m) rs[ai][m] = rstd16_coop(ssq, (unsigned)(row0 + ai * HALF + m * 16), fq, 1.f / 1024.f);
        if (pn < 2) {
            GAS bf16_t* dst = pn == 0 ? cq : ckv; GAS float* sq = pn == 0 ? ssq_cq : ssq_ckv;
#pragma unroll
            for (int ai = 0; ai < 2; ++ai)
#pragma unroll
                for (int m = 0; m < 4; ++m) { const int row = row0 + ai * HALF + m * 16; const float r = rs[ai][m]; float s2 = 0.f;
#pragma unroll
                    for (int bj = 0; bj < 2; ++bj) { const f32x4 v = acc[ai][bj][m][0] * r, v2 = acc[ai][bj][m][1] * r;
                        s2 += ((v[0] * v[0] + v[1] * v[1]) + (v[2] * v[2] + v[3] * v[3])) + ((v2[0] * v2[0] + v2[1] * v2[1]) + (v2[2] * v2[2] + v2[3] * v2[3]));
                        unsigned wx = pk2(v[0], v[1]), wy = pk2(v[2], v[3]), wz = pk2(v2[0], v2[1]), ww = pk2(v2[2], v2[3]); swap16(wx, wz); swap16(wy, ww); const u32x4 w = {wx, wy, wz, ww};
                        *(GAS u32x4*)(dst + (size_t)row * 256 + bj * HALF + wc * 32 + swz8(fq)) = w; }
                    s2 = rows4_sum(s2);
                    if (fq == 0) sq[(size_t)row * 4 + wc] = s2; }
        } else if (pn == 2) {
            if (wc == 0) {
#pragma unroll
                for (int ai = 0; ai < 2; ++ai)
#pragma unroll
                    for (int m = 0; m < 4; ++m) { const int row = row0 + ai * HALF + m * 16, pos = row & 8191; const float r = rs[ai][m];
                        const f32x4 v0 = acc[ai][0][m][0] * r, v1 = acc[ai][0][m][1] * r; float o0[4], o1[4];
#pragma unroll
                        for (int e = 0; e < 4; ++e) { float cs, sn; rope_cs(pos, 4 * fq + e, cs, sn); o0[e] = v0[e] * cs - v1[e] * sn; o1[e] = v0[e] * sn + v1[e] * cs; }
                        u32x2 w0, w1; w0.x = pk2(o0[0], o0[1]); w0.y = pk2(o0[2], o0[3]); w1.x = pk2(o1[0], o1[1]); w1.y = pk2(o1[2], o1[3]);
                        *(GAS u32x2*)(krope + (size_t)row * 32 + 4 * fq) = w0; *(GAS u32x2*)(krope + (size_t)row * 32 + 16 + 4 * fq) = w1; }
            }
        } else {
            const int t = pn - 3, buf = t >> 1, half = t & 1; GAS bf16_t* dst = qk + (size_t)buf * 16384 * 512; const float sc = (buf & 1) ? 1.f : c2;
#pragma unroll
            for (int ai = 0; ai < 2; ++ai)
#pragma unroll
                for (int bj = 0; bj < 2; ++bj) { float kmx = 0.f;
#pragma unroll
                    for (int m = 0; m < 4; ++m) { const int row = row0 + ai * HALF + m * 16; const float r = rs[ai][m] * sc;
                        const f32x4 v = acc[ai][bj][m][0] * r, v2 = acc[ai][bj][m][1] * r;
                        const float s2 = ((v[0] * v[0] + v[1] * v[1]) + (v[2] * v[2] + v[3] * v[3])) + ((v2[0] * v2[0] + v2[1] * v2[1]) + (v2[2] * v2[2] + v2[3] * v2[3]));
                        unsigned wx = pk2(v[0], v[1]), wy = pk2(v[2], v[3]), wz = pk2(v2[0], v2[1]), ww = pk2(v2[2], v2[3]); swap16(wx, wz); swap16(wy, ww); const u32x4 w = {wx, wy, wz, ww};
                        *(GAS u32x4*)(dst + (size_t)row * 512 + half * 256 + bj * HALF + wc * 32 + swz8(fq)) = w;
                        kmx = fmaxf(kmx, s2); }
                    if (pn >= 9) {
                        float s = kmx; const float q1 = __shfl_xor(s, 16), q2 = __shfl_xor(s, 32), q3 = __shfl_xor(q1, 32); s = (s + q1) + (q2 + q3);
                        s = fmaxf(s, __shfl_xor(s, 1)); s = fmaxf(s, __shfl_xor(s, 2)); s = fmaxf(s, __shfl_xor(s, 4)); s = fmaxf(s, __shfl_xor(s, 8));
                        if ((fr | fq) == 0) __hip_atomic_fetch_max(kn + (((size_t)(4 * u.pm + 2 * ai + wr) * 8 + 4 * (pn - 9) + 2 * bj + (wc >> 1)) * 2 + (wc & 1)), __builtin_bit_cast(unsigned, s), __ATOMIC_RELAXED, __HIP_MEMORY_SCOPE_AGENT); } }
        }
    }
};
struct EpiVT {
    static constexpr bool PERM = true, AFTER_DRAIN = false;
    GAS bf16_t* out; int ld; const GAS float* ssq; int n4; float inv_n;
    __device__ __forceinline__ void operator()(const f32x4 (&acc)[2][2][4][2], const Unit& u, int wr, int wc, int fr, int fq) const {
        const int col0 = u.pn * BM + wc * 32 + 8 * fq, row0 = u.pm * BM + wr * 64 + fr;
        float cs[2][8];
        { const int ln = fq * 16 + fr;
          const float mine = rstd_parts(ssq, (unsigned)((u.pn * BM + wc * 32 + (ln >> 5) * HALF + ((ln >> 3) & 3) * 8 + (ln & 7)) * (4 * n4)), n4, inv_n);
#pragma unroll
          for (int bj = 0; bj < 2; ++bj)
#pragma unroll
            for (int j = 0; j < 8; ++j) cs[bj][j] = __shfl(mine, bj * 32 + fq * 8 + j); }
#pragma unroll
        for (int ai = 0; ai < 2; ++ai)
#pragma unroll
            for (int m = 0; m < 4; ++m) { GAS bf16_t* rowp = out + (size_t)(row0 + ai * HALF + m * 16) * ld + col0;
#pragma unroll
                for (int bj = 0; bj < 2; ++bj) { const f32x4 v0 = acc[ai][bj][m][0], v1 = acc[ai][bj][m][1]; u32x4 w;
                    w.x = pk2(v0[0] * cs[bj][0], v0[1] * cs[bj][1]); w.y = pk2(v0[2] * cs[bj][2], v0[3] * cs[bj][3]);
                    w.z = pk2(v1[0] * cs[bj][4], v1[1] * cs[bj][5]); w.w = pk2(v1[2] * cs[bj][6], v1[3] * cs[bj][7]);
                    *(GAS u32x4*)(rowp + bj * HALF) = w; } }
    }
};
struct EpiRS {
    static constexpr bool PERM = true, AFTER_DRAIN = false;
    GAS bf16_t* out; int ld; const GAS float* ssq; int n4; float inv_n; float scale; int pnmask; int pnshift; size_t zstride;
    __device__ __forceinline__ void operator()(const f32x4 (&acc)[2][2][4][2], const Unit& u, int wr, int wc, int fr, int fq) const {
        const int col0 = (u.pn & pnmask) * BM + wc * 32 + 8 * fq, row0 = u.pm * BM + wr * 64 + fr;
        float rr[2][4];
#pragma unroll
        for (int ai = 0; ai < 2; ++ai)
#pragma unroll
            for (int m = 0; m < 4; ++m) rr[ai][m] = (n4 ? rstd_parts(ssq, (unsigned)((row0 + ai * HALF + m * 16) * (4 * n4)), n4, inv_n) : 1.f) * scale;
#pragma unroll
        for (int ai = 0; ai < 2; ++ai)
#pragma unroll
            for (int m = 0; m < 4; ++m) { const int row = row0 + ai * HALF + m * 16; const float r = rr[ai][m];
                GAS bf16_t* rowp = out + (size_t)(u.pn >> pnshift) * zstride + (size_t)row * ld + col0;
#pragma unroll
                for (int bj = 0; bj < 2; ++bj) { const f32x4 v0 = acc[ai][bj][m][0] * r, v1 = acc[ai][bj][m][1] * r; u32x4 w;
                    w.x = pk2(v0[0], v0[1]); w.y = pk2(v0[2], v0[3]); w.z = pk2(v1[0], v1[1]); w.w = pk2(v1[2], v1[3]); *(GAS u32x4*)(rowp + bj * HALF) = w; } }
    }
};
struct EpiQ {
    static constexpr bool PERM = false, AFTER_DRAIN = false;
    GAS bf16_t* q; const GAS float* ssq_cq; float c2;
    __device__ __forceinline__ void operator()(const f32x4 (&acc)[2][2][4][2], const Unit& u, int wr, int wc, int fr, int fq) const {
        const int pn = u.pn, row0 = u.pm * BM + wr * 64 + fr;
        float rr[2][4];
#pragma unroll
        for (int ai = 0; ai < 2; ++ai)
#pragma unroll
            for (int m = 0; m < 4; ++m) rr[ai][m] = rstd_parts(ssq_cq, (unsigned)((row0 + ai * HALF + m * 16) * 4), 1, 1.f / 256.f) * c2;
#pragma unroll
        for (int ai = 0; ai < 2; ++ai)
#pragma unroll
            for (int m = 0; m < 4; ++m) { const int row = row0 + ai * HALF + m * 16; const float r = rr[ai][m];
                if (pn < 2) {
#pragma unroll
                    for (int bj = 0; bj < 2; ++bj) { const f32x4 v = acc[ai][bj][m][0] * r, v2 = acc[ai][bj][m][1] * r;
                        unsigned wx = pk2(v[0], v[1]), wy = pk2(v[2], v[3]), wz = pk2(v2[0], v2[1]), ww = pk2(v2[2], v2[3]); swap16(wx, wz); swap16(wy, ww); const u32x4 w = {wx, wy, wz, ww};
                        *(GAS u32x4*)(q + (size_t)row * 768 + pn * 256 + bj * HALF + wc * 32 + swz8(fq)) = w; }
                } else { const int pos = row & 8191; float cs[4], sn[4];
#pragma unroll
                    for (int e = 0; e < 4; ++e) rope_cs(pos, 4 * fq + e, cs[e], sn[e]);
#pragma unroll
                    for (int bj = 0; bj < 2; ++bj) { const f32x4 v0 = acc[ai][bj][m][0] * r, v1 = acc[ai][bj][m][1] * r; float o0[4], o1[4];
#pragma unroll
                        for (int e = 0; e < 4; ++e) { o0[e] = v0[e] * cs[e] - v1[e] * sn[e]; o1[e] = v0[e] * sn[e] + v1[e] * cs[e]; }
                        u32x2 w0, w1; w0.x = pk2(o0[0], o0[1]); w0.y = pk2(o0[2], o0[3]); w1.x = pk2(o1[0], o1[1]); w1.y = pk2(o1[2], o1[3]);
                        GAS bf16_t* p = q + (size_t)row * 768 + 512 + (4 * bj + wc) * 32 + 4 * fq; *(GAS u32x2*)p = w0; *(GAS u32x2*)(p + 16) = w1; }
                } }
    }
};
struct D1Order {
    StaticOrder so; size_t dA, dB;
    __device__ __forceinline__ bool next(int i, Unit& u) const { if (i >= 9) return false; if (!so.next(0, u)) return false; u.sel = i; return true; }
    __device__ __forceinline__ void a_ready(const Unit&) const {}
    __device__ __forceinline__ void done(const Unit&) const {}
    __device__ __forceinline__ size_t a_off(const Unit& u) const { const int z = u.sel - 6; return u.sel >= 6 ? dA + (size_t)(z >> 1) * 16384 * 2048 + (size_t)(z & 1) * 1024 : (size_t)(u.sel & 1) * 1024; }
    __device__ __forceinline__ size_t b_off(const Unit& u) const { const int z = u.sel - 6; return u.sel >= 6 ? dB + (size_t)(z >> 1) * 1024 * 2048 + (size_t)(z & 1) * 1024 : (size_t)(u.sel >> 1) * 1024 * 2048 + (size_t)(u.sel & 1) * 1024; }
    __device__ __forceinline__ int keep(const Unit& u) const { return u.sel < 6 ? ((u.sel & 1) ? 0 : 1) : (u.sel < 8 ? 2 : 0); }
};
struct EpiD1 {
    static constexpr bool PERM = true, AFTER_DRAIN = false, SCALE = true;
    GAS unsigned char* g; GAS bf16_t* mb; const GAS float* ssq;
    __device__ __forceinline__ void scale(f32x4 (&acc)[2][2][4][2], const Unit& u, int wr, int wc, int fr, int fq) const {
        const unsigned toff = (unsigned)(((wr * 4 + wc) * 64 + fq * 16 + fr) * 16), tile8 = (unsigned)(u.pm * 4 + u.pn) * 8u;
        const GAS unsigned char* ga = g + (size_t)((unsigned)(u.sel - 6) * 2048u + tile8) * 8192u + toff;
        const GAS unsigned char* gb = ga + (size_t)2048 * 8192;
#pragma unroll
        for (int ai = 0; ai < 2; ++ai) {
            u32x4 wa[2][2], wb[2][2];
#pragma unroll
            for (int bj = 0; bj < 2; ++bj)
#pragma unroll
                for (int mp = 0; mp < 2; ++mp) { wa[bj][mp] = *(const GAS u32x4*)(ga + ((ai * 2 + bj) * 2 + mp) * 8192); wb[bj][mp] = *(const GAS u32x4*)(gb + ((ai * 2 + bj) * 2 + mp) * 8192); }
#pragma unroll
            for (int bj = 0; bj < 2; ++bj)
#pragma unroll
                for (int mp = 0; mp < 2; ++mp)
#pragma unroll
                    for (int k = 0; k < 4; ++k) { const int m = 2 * mp + (k >> 1), n = k & 1; const unsigned qa = wa[bj][mp][k], qb = wb[bj][mp][k];
#pragma unroll
                        for (int e2 = 0; e2 < 4; ++e2) acc[ai][bj][m][n][e2] *= ((float)((qa >> (8 * e2)) & 0xffu) + 0.5f) * __builtin_amdgcn_rcpf((float)((qb >> (8 * e2)) & 0xffu) + 0.5f); }
        }
    }
    __device__ __forceinline__ void operator()(const f32x4 (&acc)[2][2][4][2], const Unit& u, int wr, int wc, int fr, int fq) const {
        const int col0 = u.pn * BM + wc * 32 + 8 * fq, row0 = u.pm * BM + wr * 64 + fr;
        const unsigned toff = (unsigned)(((wr * 4 + wc) * 64 + fq * 16 + fr) * 16), tile8 = (unsigned)(u.pm * 4 + u.pn) * 8u;
        if (u.sel < 6) {
            GAS unsigned char* gz = g + (size_t)((unsigned)(u.sel >> 1) * 2048u + tile8) * 8192u + toff;
            float rr[2][4];
#pragma unroll
            for (int ai = 0; ai < 2; ++ai)
#pragma unroll
                for (int m = 0; m < 4; ++m) rr[ai][m] = -PG8_L2E * rstd16_coop(ssq, (unsigned)(row0 + ai * HALF + m * 16), fq, 1.f / 1024.f);
#pragma unroll
            for (int ai = 0; ai < 2; ++ai)
#pragma unroll
                for (int bj = 0; bj < 2; ++bj)
#pragma unroll
                    for (int mp = 0; mp < 2; ++mp) { u32x4 w;
#pragma unroll
                        for (int k = 0; k < 4; ++k) { const int m = 2 * mp + (k >> 1), n = k & 1; const float r = rr[ai][m]; unsigned pk = 0u;
#pragma unroll
                            for (int e2 = 0; e2 < 4; ++e2) { const float sg = __builtin_amdgcn_rcpf(1.f + __builtin_amdgcn_exp2f(acc[ai][bj][m][n][e2] * r));
                                pk = __builtin_amdgcn_cvt_pk_u8_f32(fminf(sg * 256.f - 0.5f, 255.f), e2, pk); }
                            w[k] = pk; }
                        *(GAS u32x4*)(gz + ((ai * 2 + bj) * 2 + mp) * 8192) = w; }
        } else {
            const GAS unsigned char* ga = g + (size_t)(2u * 2048u + tile8) * 8192u + toff;
#pragma unroll
            for (int ai = 0; ai < 2; ++ai) {
                u32x4 wa[2][2];
#pragma unroll
                for (int bj = 0; bj < 2; ++bj)
#pragma unroll
                    for (int mp = 0; mp < 2; ++mp) wa[bj][mp] = *(const GAS u32x4*)(ga + ((ai * 2 + bj) * 2 + mp) * 8192);
#pragma unroll
                for (int m = 0; m < 4; ++m)
#pragma unroll
                    for (int bj = 0; bj < 2; ++bj) { const size_t o = (size_t)(row0 + ai * HALF + m * 16) * 1024 + col0 + bj * HALF; float v[8];
#pragma unroll
                        for (int j = 0; j < 8; ++j) { const unsigned qa = wa[bj][m >> 1][(m & 1) * 2 + (j >> 2)];
                            v[j] = acc[ai][bj][m][j >> 2][j & 3] * (((float)((qa >> (8 * (j & 3))) & 0xffu) + 0.5f) * (1.f / 256.f)); }
                        u32x4 w; w.x = pk2(v[0], v[1]); w.y = pk2(v[2], v[3]); w.z = pk2(v[4], v[5]); w.w = pk2(v[6], v[7]); *(GAS u32x4*)(mb + o) = w; } }
        }
    }
};
struct EpiRes {
    static constexpr bool PERM = true, AFTER_DRAIN = false;
    GAS bf16_t* xb; GAS float* ssq;
    __device__ __forceinline__ void operator()(const f32x4 (&acc)[2][2][4][2], const Unit& u, int wr, int wc, int fr, int fq) const {
        const int col0 = u.pn * BM + wc * 32 + 8 * fq, row0 = u.pm * BM + wr * 64 + fr;
#pragma unroll
        for (int ai = 0; ai < 2; ++ai) {
            u32x4 xv[4][2];
#pragma unroll
            for (int m = 0; m < 4; ++m)
#pragma unroll
                for (int bj = 0; bj < 2; ++bj) xv[m][bj] = *(const GAS u32x4*)(xb + (size_t)(row0 + ai * HALF + m * 16) * 1024 + col0 + bj * HALF);
#pragma unroll
            for (int m = 0; m < 4; ++m) { const int row = row0 + ai * HALF + m * 16; const size_t rb = (size_t)row * 1024 + col0; float s2 = 0.f;
#pragma unroll
                for (int bj = 0; bj < 2; ++bj) { const u32x4 xw = xv[m][bj]; const f32x4 a0 = acc[ai][bj][m][0], a1 = acc[ai][bj][m][1];
                    const float v0 = bflo(xw.x) + a0[0], v1 = bfhi(xw.x) + a0[1], v2 = bflo(xw.y) + a0[2], v3 = bfhi(xw.y) + a0[3];
                    const float v4 = bflo(xw.z) + a1[0], v5 = bfhi(xw.z) + a1[1], v6 = bflo(xw.w) + a1[2], v7 = bfhi(xw.w) + a1[3];
                    u32x4 w; w.x = pk2(v0, v1); w.y = pk2(v2, v3); w.z = pk2(v4, v5); w.w = pk2(v6, v7);
                    *(GAS u32x4*)(xb + rb + bj * HALF) = w;
                    s2 += ((v0 * v0 + v1 * v1) + (v2 * v2 + v3 * v3)) + ((v4 * v4 + v5 * v5) + (v6 * v6 + v7 * v7)); }
                s2 += __shfl_xor(s2, 16); s2 += __shfl_xor(s2, 32);
                if (fq == 0) ssq[(size_t)row * 16 + u.pn * 4 + wc] = s2; } }
    }
};
struct EpiAct {
    static constexpr bool PERM = true, AFTER_DRAIN = false;
    GAS bf16_t* act; const GAS float* s_rstd; const GAS float* s_w;
    __device__ __forceinline__ void operator()(const f32x4 (&acc)[2][2][4][2], const Unit& u, int wr, int wc, int fr, int fq) const {
        const int t = u.pn & 1, row0 = u.pm * BM + wr * 64 + fr;
        const __amdgpu_buffer_rsrc_t rsrc = __builtin_amdgcn_make_buffer_rsrc((void*)act, 0, 40960 * 256 * 2, 0x00020000);
        float rr[2][4], ww[2][4];
#pragma unroll
        for (int ai = 0; ai < 2; ++ai)
#pragma unroll
            for (int m = 0; m < 4; ++m) { rr[ai][m] = s_rstd[row0 + ai * HALF + m * 16]; ww[ai][m] = s_w[row0 + ai * HALF + m * 16]; }
#pragma unroll
        for (int ai = 0; ai < 2; ++ai)
#pragma unroll
            for (int m = 0; m < 4; ++m) { const int row = row0 + ai * HALF + m * 16; const float rs = rr[ai][m], w = ww[ai][m]; float o[8];
#pragma unroll
                for (int j = 0; j < 8; ++j) { const float a = acc[ai][0][m][j >> 2][j & 3] * rs, b = acc[ai][1][m][j >> 2][j & 3] * rs;
                    const float v = a * __builtin_amdgcn_rcpf(1.f + __builtin_amdgcn_exp2f(-PG8_L2E * a)) * b * w; o[j] = (w != 0.f) ? v : 0.f; }
                u32x4 pw; pw.x = pk2(o[0], o[1]); pw.y = pk2(o[2], o[3]); pw.z = pk2(o[4], o[5]); pw.w = pk2(o[6], o[7]);
                __builtin_amdgcn_raw_buffer_store_b128(pw, rsrc, (unsigned)(row * 256 + t * 128 + wc * 32 + 8 * fq) * 2u, 0,   16); }
    }
};
struct SplitK2Order {
    StaticOrder so; size_t tstep;
    __device__ __forceinline__ bool next(int i, Unit& u) const { return so.next(i, u); }
    __device__ __forceinline__ void a_ready(const Unit&) const {}
    __device__ __forceinline__ void done(const Unit&) const {}
    __device__ __forceinline__ size_t a_off(const Unit& u) const { return (size_t)(u.pn >> 1) * 1024; }
    __device__ __forceinline__ size_t b_off(const Unit& u) const { return (size_t)(u.pn >> 1) * 1024 - (size_t)(u.pn >> 1) * 2 * tstep; }
    __device__ __forceinline__ bool keep(const Unit&) const { return false; }
};
struct MoeOrder {
    const PG8_LAS int* tstart; int per, G, v;
    __device__ __forceinline__ bool next(int i, Unit& u) const {
        const int idx = i * G + v, tot = tstart[32] * per; if (idx >= tot) return false;
        const int ti = idx / per, ct = idx - ti * per; int e = 0;
#pragma unroll 1
        for (int k = 1; k < 32; ++k) e += (tstart[k] <= ti) ? 1 : 0;
        u.pm = ti; u.pn = e * per + ct; u.sel = 0; return true;
    }
    __device__ __forceinline__ void a_ready(const Unit&) const {}
    __device__ __forceinline__ void done(const Unit&) const {}
    __device__ __forceinline__ size_t a_off(const Unit&) const { return 0; }
    __device__ __forceinline__ size_t b_off(const Unit&) const { return 0; }
    __device__ __forceinline__ bool keep(const Unit&) const { return false; }
};
struct MoeOrderP {
    const PG8_LAS int* tstart; GAS unsigned* cnt; int G, v;
    __device__ __forceinline__ bool next(int i, Unit& u) const {
        const int idx = i * G + v, tot = tstart[32] * 2; if (idx >= tot) return false;
        const int ti = idx >> 1, ct = idx & 1; int e = 0;
#pragma unroll 1
        for (int k = 1; k < 32; ++k) e += (tstart[k] <= ti) ? 1 : 0;
        u.pm = ti; u.pn = e * 2 + ct; u.sel = 0; return true;
    }
    __device__ __forceinline__ void a_ready(const Unit&) const {}
    __device__ __forceinline__ void done(const Unit& u) const {
        asm volatile("s_waitcnt vmcnt(0)" ::: "memory");
        int ln; asm volatile("v_mbcnt_lo_u32_b32 %0, -1, 0\n\tv_mbcnt_hi_u32_b32 %0, -1, %0" : "=v"(ln));
        if (ln == 0) __hip_atomic_fetch_add(cnt + u.pm, 1u, __ATOMIC_RELAXED, __HIP_MEMORY_SCOPE_AGENT);
    }
    __device__ __forceinline__ size_t a_off(const Unit&) const { return 0; }
    __device__ __forceinline__ size_t b_off(const Unit&) const { return 0; }
    __device__ __forceinline__ bool keep(const Unit&) const { return false; }
};
struct MoeOrderC {
    const PG8_LAS int* tstart; const GAS unsigned* cnt; int G, v, wid;
    __device__ __forceinline__ bool next(int i, Unit& u) const {
        const int T = tstart[32], L = (2 * T > G) ? 2 * T - G : 0, R = G - L;
        const int idx = (v >= L) ? ((i < 2) ? i * R + (v - L) : 2 * R + (i - 2) * G + v) : 2 * R + i * G + v;
        if (idx >= 4 * T) return false;
        const int ti = idx >> 2, ct = idx & 3; int e = 0;
#pragma unroll 1
        for (int k = 1; k < 32; ++k) e += (tstart[k] <= ti) ? 1 : 0;
        u.pm = ti; u.pn = e * 4 + ct; u.sel = 0; return true;
    }
    __device__ __forceinline__ void a_ready(const Unit& u) const {
        if (wid == 0) {
            const GAS unsigned* c = cnt + u.pm; int spins = 0;
#pragma unroll 1
            while ((unsigned)__builtin_amdgcn_readfirstlane(__hip_atomic_load(c, __ATOMIC_RELAXED, __HIP_MEMORY_SCOPE_AGENT)) < 16u && ++spins < (1 << 22)) __builtin_amdgcn_s_sleep(2);
            __builtin_amdgcn_fence(__ATOMIC_ACQUIRE, "agent");
            asm volatile("s_waitcnt vmcnt(0)" ::: "memory");
        }
        __builtin_amdgcn_s_barrier();
    }
    __device__ __forceinline__ void done(const Unit&) const {}
    __device__ __forceinline__ size_t a_off(const Unit&) const { return 0; }
    __device__ __forceinline__ size_t b_off(const Unit&) const { return 0; }
    __device__ __forceinline__ bool keep(const Unit&) const { return false; }
};
}
namespace att {
typedef unsigned short bf16;
typedef short bf16x8 __attribute__((ext_vector_type(8)));
typedef short s16x4 __attribute__((ext_vector_type(4)));
typedef float f32x16 __attribute__((ext_vector_type(16)));
typedef float f32x4 __attribute__((ext_vector_type(4)));
typedef unsigned u32x4 __attribute__((ext_vector_type(4)));
typedef unsigned u32x2 __attribute__((ext_vector_type(2)));
typedef float f32x2v __attribute__((ext_vector_type(2)));
typedef __bf16 bf16x2v __attribute__((ext_vector_type(2)));
__device__ __forceinline__ unsigned pk2(float lo, float hi) { f32x2v v = {lo, hi}; bf16x2v b = __builtin_convertvector(v, bf16x2v); return __builtin_bit_cast(unsigned, b); }
__device__ __forceinline__ float bflo(unsigned w) { return __builtin_bit_cast(float, w << 16); }
__device__ __forceinline__ float bfhi(unsigned w) { return __builtin_bit_cast(float, w & 0xffff0000u); }
__device__ __forceinline__ int crow(int r, int hi) { return (r & 3) + 8 * (r >> 2) + 4 * hi; }
__device__ __forceinline__ float xhalf(float v) {
    const unsigned u = __builtin_bit_cast(unsigned, v);
    auto rr = __builtin_amdgcn_permlane32_swap(u, u, false, false);
    const unsigned o = (rr[0] != u) ? rr[0] : rr[1];
    return __builtin_bit_cast(float, o);
}
__device__ __forceinline__ bf16x8 mk8(unsigned a, unsigned b, unsigned c, unsigned d) { u32x4 w = {a, b, c, d}; return __builtin_bit_cast(bf16x8, w); }

constexpr int VPB = 144;
template <int DK> struct KLay { static constexpr int KPB = (DK + 8) * 2, KBUF = 64 * KPB; };

template <int DK, int DV, bool KROPE> struct Stage {
    static constexpr int NK = KROPE ? 1 : DK / 64, NV = DV / 64;
    u32x4 kr[NK]; u32x4 kr2; u32x4 vr[NV];
    __device__ __forceinline__ void loadK(int tid, const GAS bf16* Kg, int ldk, const GAS bf16* K2g, int kv0) {
        const GAS char* kbase = (const GAS char*)(Kg + (size_t)kv0 * ldk);
        if constexpr (KROPE) {
            kr[0] = *(const GAS u32x4*)(kbase + (unsigned)(((tid >> 3) * ldk + 8 * (tid & 7)) * 2));
            if (tid < 256) kr2 = *(const GAS u32x4*)((const GAS char*)(K2g + (size_t)kv0 * 32) + (unsigned)(tid * 16));
        } else {
#pragma unroll
            for (int i = 0; i < NK; ++i) { const int p = tid + 512 * i, row = p / (DK / 8), ch = p % (DK / 8); kr[i] = *(const GAS u32x4*)(kbase + (unsigned)((row * ldk + 8 * ch) * 2)); }
        }
    }
    __device__ __forceinline__ void loadV(int tid, const GAS bf16* Vg, int ldv, int kv0) {
        const GAS char* vbase = (const GAS char*)(Vg + kv0);
#pragma unroll
        for (int i = 0; i < NV; ++i) { const int p = tid + 512 * i, dd = p >> 3, ch = p & 7; vr[i] = *(const GAS u32x4*)(vbase + (unsigned)((dd * ldv + 8 * ch) * 2)); }
    }
    __device__ __forceinline__ void storeK(int tid, LAS unsigned char* kb) const {
        constexpr int KPB = KLay<DK>::KPB;
        if constexpr (KROPE) {
            *(LAS u32x4*)(kb + (tid >> 3) * KPB + 16 * (tid & 7)) = kr[0];
            if (tid < 256) *(LAS u32x4*)(kb + (tid >> 2) * KPB + 128 + 16 * (tid & 3)) = kr2;
        } else {
#pragma unroll
            for (int i = 0; i < NK; ++i) { const int p = tid + 512 * i, row = p / (DK / 8), ch = p % (DK / 8); *(LAS u32x4*)(kb + row * KPB + 16 * ch) = kr[i]; }
        }
    }
    __device__ __forceinline__ void storeV(int tid, LAS unsigned char* vb) const {
#pragma unroll
        for (int i = 0; i < NV; ++i) { const int p = tid + 512 * i, dd = p >> 3, ch = p & 7; LAS unsigned char* q = vb + dd * VPB + 32 * (ch >> 1) + 8 * (ch & 1);
            *(LAS u32x2*)q = (u32x2){vr[i].x, vr[i].y}; *(LAS u32x2*)(q + 16) = (u32x2){vr[i].z, vr[i].w}; }
    }
    __device__ __forceinline__ void load(int tid, const GAS bf16* Kg, int ldk, const GAS bf16* K2g, const GAS bf16* Vg, int ldv, int kv0) { loadK(tid, Kg, ldk, K2g, kv0); loadV(tid, Vg, ldv, kv0); }
    __device__ __forceinline__ void store(int tid, LAS unsigned char* kb, LAS unsigned char* vb) const { storeK(tid, kb); storeV(tid, vb); }
};

template <int DK> __device__ __forceinline__ void qkt(f32x16& p0, f32x16& p1, const LAS unsigned char* kb, const bf16x8 (&qf)[DK / 16], int r32, int hi) {
    constexpr int KPB = KLay<DK>::KPB;
    const LAS unsigned char* k0 = kb + r32 * KPB + hi * 16;
#pragma unroll
    for (int d0 = 0; d0 < DK / 16; ++d0) {
        const bf16x8 a0 = *(const LAS bf16x8*)(k0 + d0 * 32), a1 = *(const LAS bf16x8*)(k0 + 32 * KPB + d0 * 32);
        p0 = __builtin_amdgcn_mfma_f32_32x32x16_bf16(a0, qf[d0], p0, 0, 0, 0);
        p1 = __builtin_amdgcn_mfma_f32_32x32x16_bf16(a1, qf[d0], p1, 0, 0, 0);
    }
}
template <int DK> __device__ __forceinline__ void qkt_qmem(f32x16& p0, f32x16& p1, const LAS unsigned char* kb, const bf16x8* qf, const LAS unsigned char* qlds, int r32, int hi) {
    constexpr int KPB = KLay<DK>::KPB, QR = DK / 32;
    const LAS unsigned char* k0 = kb + r32 * KPB + hi * 16;
#pragma unroll
    for (int d0 = 0; d0 < DK / 16; ++d0) {
        bf16x8 q; if (d0 < QR) q = qf[d0]; else q = *(const LAS bf16x8*)(qlds + (d0 - QR) * 1024);
        const bf16x8 a0 = *(const LAS bf16x8*)(k0 + d0 * 32), a1 = *(const LAS bf16x8*)(k0 + 32 * KPB + d0 * 32);
        p0 = __builtin_amdgcn_mfma_f32_32x32x16_bf16(a0, q, p0, 0, 0, 0);
        p1 = __builtin_amdgcn_mfma_f32_32x32x16_bf16(a1, q, p1, 0, 0, 0);
        if ((d0 & 3) == 3) __builtin_amdgcn_sched_barrier(0);
    }
}
template <int DV> __device__ __forceinline__ void pv(f32x16 (&o)[DV / 32], const LAS unsigned char* vb, const bf16x8 (&pf)[4], int r32, int hi) {
#pragma unroll
    for (int db = 0; db < DV / 32; ++db) {
        const LAS unsigned char* v0 = vb + (32 * db + r32) * VPB + 16 * hi;
#pragma unroll
        for (int s = 0; s < 4; ++s) {
            const bf16x8 vf = *(const LAS bf16x8*)(v0 + 32 * s);
            o[db] = __builtin_amdgcn_mfma_f32_32x32x16_bf16(vf, pf[s], o[db], 0, 0, 0);
        }
        if (DV > 64) __builtin_amdgcn_sched_barrier(0);
    }
}
__device__ __forceinline__ void pack_p(bf16x8 (&pf)[4], const f32x16& p0, const f32x16& p1) {
    pf[0] = mk8(pk2(p0[0], p0[1]), pk2(p0[2], p0[3]), pk2(p0[4], p0[5]), pk2(p0[6], p0[7]));
    pf[1] = mk8(pk2(p0[8], p0[9]), pk2(p0[10], p0[11]), pk2(p0[12], p0[13]), pk2(p0[14], p0[15]));
    pf[2] = mk8(pk2(p1[0], p1[1]), pk2(p1[2], p1[3]), pk2(p1[4], p1[5]), pk2(p1[6], p1[7]));
    pf[3] = mk8(pk2(p1[8], p1[9]), pk2(p1[10], p1[11]), pk2(p1[12], p1[13]), pk2(p1[14], p1[15]));
}

template <bool ALIBI> __device__ __forceinline__ void fl_init(f32x16& p0, f32x16& p1, float slope2, int kv0, int hi, int qrow) {
    if (ALIBI) {
        const float s2 = slope2 + slope2, s4 = s2 + s2, s8 = s4 + s4, s32 = (s8 + s8) + (s8 + s8);
        float g = slope2 * (float)(kv0 + 4 * hi - qrow);
#pragma unroll
        for (int c = 0; c < 4; ++c) { float v = g;
#pragma unroll
            for (int e = 0; e < 4; ++e) { p0[4 * c + e] = v; p1[4 * c + e] = v + s32; v += slope2; }
            g += s8; } }
    else {
#pragma unroll
        for (int r = 0; r < 16; ++r) { p0[r] = 0.f; p1[r] = 0.f; } }
}
__device__ __forceinline__ void fl_mask(f32x16& p0, f32x16& p1, int kv0, int hi, int qrow) {
    const int thr = qrow - kv0 - 4 * hi;
#pragma unroll
    for (int r = 0; r < 16; ++r) { const int c = (r & 3) + 8 * (r >> 2); if (c > thr) p0[r] = -INFINITY; if (c + 32 > thr) p1[r] = -INFINITY; }
}
__device__ __forceinline__ void fl_start(const f32x16& p0, const f32x16& p1, float& m, float& alpha) {
    float mx = fmaxf(p0[0], p1[0]);
#pragma unroll
    for (int r = 1; r < 16; ++r) mx = fmaxf(fmaxf(mx, p0[r]), p1[r]);
    mx = fmaxf(mx, xhalf(mx));
    const float mn = fmaxf(m, mx); alpha = __builtin_amdgcn_exp2f(m - mn); m = mn;
}
__device__ __forceinline__ void fl_finish(f32x16& p0, f32x16& p1, float m, float& l, bf16x8 (&pf)[4]) {
    float s0 = 0.f, s1 = 0.f;
#pragma unroll
    for (int r = 0; r < 16; ++r) { p0[r] = __builtin_amdgcn_exp2f(p0[r] - m); p1[r] = __builtin_amdgcn_exp2f(p1[r] - m); s0 += p0[r]; s1 += p1[r]; }
    l += s0 + s1;
    pack_p(pf, p0, p1);
}

#define FL_EL(P0, P1, e) ((e) < 16 ? P0[(e) & 15] : P1[(e) & 15])
template <int DK, bool QMEM> __device__ __forceinline__ void fl_blockX(f32x16& n0, f32x16& n1, const LAS unsigned char* kb, const bf16x8* qf, const LAS unsigned char* qlds, int r32, int hi,
                                                                         f32x16& c0, f32x16& c1, float m, float& l, bf16x8 (&pf)[4]) {
    constexpr int KPB = KLay<DK>::KPB, NS = DK / 16, CH = ((32 + NS - 1) / NS + 1) & ~1;
    const LAS unsigned char* k0 = kb + r32 * KPB + hi * 16;
    float s0 = 0.f, s1 = 0.f; unsigned pw[16];
#define FLX_K0(s) (*(const LAS bf16x8*)(k0 + ((s) < NS ? (s) : NS - 1) * 32))
#define FLX_K1(s) (*(const LAS bf16x8*)(k0 + 32 * KPB + ((s) < NS ? (s) : NS - 1) * 32))
    bf16x8 a0 = FLX_K0(0), a1 = FLX_K1(0), b0 = FLX_K0(1), b1 = FLX_K1(1), e0 = FLX_K0(2), e1 = FLX_K1(2);
    bf16x8 q, qb, qe; if constexpr (QMEM) { q = *(const LAS bf16x8*)(qlds); qb = *(const LAS bf16x8*)(qlds + (NS > 1 ? 1024 : 0)); qe = *(const LAS bf16x8*)(qlds + (NS > 2 ? 2048 : 0)); } else { q = qf[0]; qb = qf[NS > 1 ? 1 : 0]; qe = qf[NS > 2 ? 2 : 0]; }
#pragma unroll
    for (int d0 = 0; d0 < NS; ++d0) {
        bf16x8 c0n = e0, c1n = e1, qc = qe;
        if (d0 + 3 < NS) { c0n = FLX_K0(d0 + 3); c1n = FLX_K1(d0 + 3);
            if constexpr (QMEM) qc = *(const LAS bf16x8*)(qlds + (d0 + 3) * 1024); else qc = qf[d0 + 3]; }
        n0 = __builtin_amdgcn_mfma_f32_32x32x16_bf16(a0, q, n0, 0, 0, 0);
        n1 = __builtin_amdgcn_mfma_f32_32x32x16_bf16(a1, q, n1, 0, 0, 0);
#pragma unroll
        for (int e = d0 * CH; e < (d0 + 1) * CH && e < 32; e += 2) {
            float x, y;
            if (e < 16) { x = __builtin_amdgcn_exp2f(c0[e] - m); y = __builtin_amdgcn_exp2f(c0[e + 1] - m); s0 += x; s1 += y; }
            else { x = __builtin_amdgcn_exp2f(c1[e - 16] - m); y = __builtin_amdgcn_exp2f(c1[e - 15] - m); s0 += x; s1 += y; }
            pw[e >> 1] = pk2(x, y); asm volatile("" : "+v"(pw[e >> 1])); }
        asm volatile("" : "+v"(s0), "+v"(s1));
        __builtin_amdgcn_sched_barrier(0);
        a0 = b0; a1 = b1; q = qb; b0 = e0; b1 = e1; qb = qe; e0 = c0n; e1 = c1n; qe = qc;
    }
#undef FLX_K0
#undef FLX_K1
    l += s0 + s1;
    pf[0] = mk8(pw[0], pw[1], pw[2], pw[3]); pf[1] = mk8(pw[4], pw[5], pw[6], pw[7]); pf[2] = mk8(pw[8], pw[9], pw[10], pw[11]); pf[3] = mk8(pw[12], pw[13], pw[14], pw[15]);
}
template <int DV> __device__ __forceinline__ void fl_blockY(f32x16 (&o)[DV / 32], const LAS unsigned char* vb, const bf16x8 (&pf)[4], int r32, int hi, const f32x16& n0, const f32x16& n1, float& m, float& alpha) {
    constexpr int NS = DV / 8, CH = 32 / NS;
    float mx0 = -INFINITY, mx1 = -INFINITY;
    const LAS unsigned char* v0 = vb + r32 * VPB + 16 * hi;
    bf16x8 vf = *(const LAS bf16x8*)(v0), vg = *(const LAS bf16x8*)(v0 + 32);
#pragma unroll
    for (int st = 0; st < NS; ++st) {
        const int db = st >> 2, s = st & 3;
        bf16x8 vn = vg;
        if (st + 2 < NS) vn = *(const LAS bf16x8*)(v0 + ((st + 2) >> 2) * 32 * VPB + 32 * ((st + 2) & 3));
        o[db] = __builtin_amdgcn_mfma_f32_32x32x16_bf16(vf, pf[s], o[db], 0, 0, 0);
#pragma unroll
        for (int e = st * CH; e < (st + 1) * CH; ++e) { if (e < 16) mx0 = fmaxf(mx0, n0[e]); else mx1 = fmaxf(mx1, n1[e - 16]); }
        asm volatile("" : "+v"(mx0), "+v"(mx1));
        __builtin_amdgcn_sched_barrier(0);
        vf = vg; vg = vn;
    }
    float mx = fmaxf(mx0, mx1); mx = fmaxf(mx, xhalf(mx));
    const float mn = fmaxf(m, mx); alpha = __builtin_amdgcn_exp2f(m - mn); m = mn;
}

template <int DK, int DV, bool CAUSAL, bool ALIBI, bool KROPE, bool QMEM = false, bool DESC = false>
__device__ __forceinline__ void flash_pass(LAS unsigned char* lds, int tid, const GAS bf16* Qrow, const GAS bf16* Qrow2, const GAS bf16* Kg, int ldk, const GAS bf16* K2g, const GAS bf16* Vg, int ldv,
                                           int NT, int ntw, int qrow, float slope2, f32x16 (&o)[DV / 32], float& lsum, const GAS unsigned* kn = nullptr, int abl = 0) {
    constexpr int KBUF = KLay<DK>::KBUF, VBUF = DV * VPB, QOFF = 2 * KBUF + 2 * VBUF, XOFF = QOFF + 8 * (DK / 16) * 1024;
    constexpr bool CUT = DESC && ALIBI;
    const int lane = tid & 63, r32 = lane & 31, hi = lane >> 5, wid = tid >> 6;
#define FL_TI(i) (DESC ? NT - 1 - (i) : (i))
    bf16x8 qf[QMEM ? 1 : DK / 16];
    LAS unsigned char* qlds = lds + QOFF + wid * (DK / 16) * 1024 + lane * 16;
    float qn2 = 0.f;
#pragma unroll
    for (int d0 = 0; d0 < DK / 16; ++d0) {
        bf16x8 v;
        if (KROPE && d0 >= 4) v = *(const GAS bf16x8*)(Qrow2 + 16 * (d0 - 4) + 8 * hi);
        else v = *(const GAS bf16x8*)(Qrow + 16 * d0 + 8 * hi);
        if constexpr (CUT) {
#pragma unroll
            for (int j = 0; j < 8; ++j) { const float f = __builtin_bit_cast(float, (unsigned)(unsigned short)v[j] << 16); qn2 += f * f; } }
        if constexpr (QMEM) *(LAS bf16x8*)(qlds + d0 * 1024) = v; else qf[d0] = v;
    }
    volatile LAS float* kpre = (volatile LAS float*)(lds + XOFF);
    volatile LAS unsigned* dflag = (volatile LAS unsigned*)(lds + XOFF + 512);
    float qn = 0.f;
    if constexpr (CUT) {
        qn2 += xhalf(qn2); qn = sqrtf(qn2);
        if (wid == 0) {
            float v0 = 0.f, v1 = 0.f;
            if (lane < NT) v0 = sqrtf(__builtin_bit_cast(float, kn[(size_t)lane * 16]) + __builtin_bit_cast(float, kn[(size_t)lane * 16 + 1])) * 1.01f;
            if (lane + 64 < NT) v1 = sqrtf(__builtin_bit_cast(float, kn[(size_t)(lane + 64) * 16]) + __builtin_bit_cast(float, kn[(size_t)(lane + 64) * 16 + 1])) * 1.01f;
#pragma unroll
            for (int dd = 1; dd < 64; dd <<= 1) { const float u0 = __shfl_up(v0, dd), u1 = __shfl_up(v1, dd); if (lane >= dd) { v0 = fmaxf(v0, u0); v1 = fmaxf(v1, u1); } }
            v1 = fmaxf(v1, __shfl(v0, 63));
            kpre[lane] = v0; kpre[lane + 64] = v1;
        }
    }
#pragma unroll
    for (int db = 0; db < DV / 32; ++db)
#pragma unroll
        for (int r = 0; r < 16; ++r) o[db][r] = 0.f;
    float m = -INFINITY, l = 0.f, alpha = 1.0f;
    int cut = NT;
    Stage<DK, DV, KROPE> st;
    st.loadK(tid, Kg, ldk, K2g, 64 * FL_TI(0)); st.loadV(tid, Vg, ldv, 64 * FL_TI(0));
    st.storeK(tid, lds); st.storeV(tid, lds + 2 * KBUF);
    if (NT > 1) { st.loadK(tid, Kg, ldk, K2g, 64 * FL_TI(1)); st.storeK(tid, lds + KBUF); }
    __syncthreads();
    if (NT > 2) st.loadK(tid, Kg, ldk, K2g, 64 * FL_TI(2));
    if (NT > 1) st.loadV(tid, Vg, ldv, 64 * FL_TI(1));
    f32x16 pa0, pa1, pb0, pb1;
#define FL_QKT(P0, P1, KB) do { if constexpr (QMEM) { bf16x8 qt_[DK / 16]; _Pragma("unroll") for (int d0 = 0; d0 < DK / 16; ++d0) qt_[d0] = *(const LAS bf16x8*)(qlds + d0 * 1024); qkt<DK>(P0, P1, KB, qt_, r32, hi); } else qkt<DK>(P0, P1, KB, qf, r32, hi); } while (0)
#define FL_FIRST(P0, P1, KB, TILE) do { const int kv_ = 64 * (TILE); fl_init<ALIBI>(P0, P1, slope2, kv_, hi, qrow); FL_QKT(P0, P1, KB); \
        if (CAUSAL && kv_ + 63 > qrow - r32) fl_mask(P0, P1, kv_, hi, qrow); fl_start(P0, P1, m, alpha); } while (0)
    if (FL_TI(0) < ntw) FL_FIRST(pa0, pa1, lds, FL_TI(0));
    __syncthreads();
    for (int i = 0; i < NT; ++i) {
        int tq_ = tid; asm volatile("" : "+v"(tq_));
        if (!(abl & 1)) {
            if (i + 2 < NT) st.storeK(tq_, lds + (i & 1) * KBUF);
            if (i + 1 < NT) st.storeV(tq_, lds + 2 * KBUF + ((i + 1) & 1) * VBUF);
            if (i + 3 < NT) st.loadK(tq_, Kg, ldk, K2g, 64 * FL_TI(i + 3));
            if (i + 2 < NT) st.loadV(tq_, Vg, ldv, 64 * FL_TI(i + 2)); }
        const int tc = FL_TI(i), tn = FL_TI(i + 1);
        const bool ac = tc < ntw && i < cut && !(abl & 2);
        bool an = i + 1 < NT && tn < ntw && i + 1 < cut && !(abl & 2);
        if constexpr (CUT) {
            if (ac && an) {
                const bool dead = qn * kpre[tn] + slope2 * (float)(64 * tn + 63 - qrow) < m - 64.f;
                if (__all(dead)) { cut = i + 1; an = false; } } }
        const LAS unsigned char* kn_ = lds + ((i + 1) & 1) * KBUF; const LAS unsigned char* vc_ = lds + 2 * KBUF + (i & 1) * VBUF;
        if (ac) {
            l *= alpha;
            if (__any(alpha != 1.0f)) {
#pragma unroll
                for (int db = 0; db < DV / 32; ++db) asm volatile("" : "+v"(o[db]));
#pragma unroll
                for (int db = 0; db < DV / 32; ++db)
#pragma unroll
                    for (int r = 0; r < 16; ++r) o[db][r] *= alpha;
#pragma unroll
                for (int db = 0; db < DV / 32; ++db) asm volatile("" : "+v"(o[db])); }
            bf16x8 pf[4];
            if (an) {
                const int kv1_ = 64 * tn;
                const bool diag_ = CAUSAL && (kv1_ + 63 > qrow - r32);
                fl_init<ALIBI>(pb0, pb1, slope2, kv1_, hi, qrow);
                fl_blockX<DK, QMEM>(pb0, pb1, kn_, qf, qlds, r32, hi, pa0, pa1, m, l, pf);
                if (!diag_) { fl_blockY<DV>(o, vc_, pf, r32, hi, pb0, pb1, m, alpha); }
                else { pv<DV>(o, vc_, pf, r32, hi); fl_mask(pb0, pb1, kv1_, hi, qrow); fl_start(pb0, pb1, m, alpha); }
            } else {
                fl_finish(pa0, pa1, m, l, pf); pv<DV>(o, vc_, pf, r32, hi);
            }
        } else if (an) { FL_FIRST(pb0, pb1, kn_, tn); }
        if constexpr (CUT) { if (lane == 0) dflag[(i & 1) * 8 + wid] = (i + 1 >= cut) ? 1u : 0u; }
        if (!(abl & 4)) __syncthreads();
        if constexpr (CUT) { unsigned alld = 1u;
#pragma unroll
            for (int w = 0; w < 8; ++w) alld &= dflag[(i & 1) * 8 + w];
            if (alld) break; }
        if (!(abl & 8)) { pa0 = pb0; pa1 = pb1; }
    }
#undef FL_FIRST
#undef FL_QKT
#undef FL_TI
    lsum = l + xhalf(l);
}

template <int DK, int DV, bool CAUSAL, bool ALIBI, bool KROPE, bool QMEM = false>
__device__ __forceinline__ void flash_pass_simple(LAS unsigned char* lds, int tid, const GAS bf16* Qrow, const GAS bf16* Qrow2, const GAS bf16* Kg, int ldk, const GAS bf16* K2g, const GAS bf16* Vg, int ldv,
                                           int NT, int ntw, int qrow, float slope2, f32x16 (&o)[DV / 32], float& lsum) {
    constexpr int KBUF = KLay<DK>::KBUF, VBUF = DV * VPB;
    const int lane = tid & 63, r32 = lane & 31, hi = lane >> 5;
    constexpr int QR = QMEM ? DK / 32 : DK / 16;
    bf16x8 qf[QR];
    LAS unsigned char* qlds = lds + 2 * KBUF + 2 * VBUF + (tid >> 6) * (DK / 16 - QR + 1) * 1024 + lane * 16;
#pragma unroll
    for (int d0 = 0; d0 < DK / 16; ++d0) {
        bf16x8 v;
        if (KROPE && d0 >= 4) v = *(const GAS bf16x8*)(Qrow2 + 16 * (d0 - 4) + 8 * hi);
        else v = *(const GAS bf16x8*)(Qrow + 16 * d0 + 8 * hi);
        if constexpr (!KROPE && QMEM) {
            const bf16x8 w2 = *(const GAS bf16x8*)(Qrow2 + 16 * d0 + 8 * hi); const u32x4 a4 = __builtin_bit_cast(u32x4, v), b4 = __builtin_bit_cast(u32x4, w2); u32x4 r4;
            r4.x = pk2(bflo(a4.x) + bflo(b4.x), bfhi(a4.x) + bfhi(b4.x)); r4.y = pk2(bflo(a4.y) + bflo(b4.y), bfhi(a4.y) + bfhi(b4.y));
            r4.z = pk2(bflo(a4.z) + bflo(b4.z), bfhi(a4.z) + bfhi(b4.z)); r4.w = pk2(bflo(a4.w) + bflo(b4.w), bfhi(a4.w) + bfhi(b4.w)); v = __builtin_bit_cast(bf16x8, r4); }
        if (d0 < QR) qf[d0] = v; else *(LAS bf16x8*)(qlds + (d0 - QR) * 1024) = v;
    }
#pragma unroll
    for (int db = 0; db < DV / 32; ++db)
#pragma unroll
        for (int r = 0; r < 16; ++r) o[db][r] = 0.f;
    float m = -INFINITY, l = 0.f;
    Stage<DK, DV, KROPE> st;
    st.load(tid, Kg, ldk, K2g, Vg, ldv, 0);
    st.store(tid, lds, lds + 2 * KBUF);
    __syncthreads();
    for (int t = 0; t < NT; ++t) {
        const int cur = t & 1, kv0 = 64 * t;
        if (t + 1 < NT) st.load(tid, Kg, ldk, K2g, Vg, ldv, kv0 + 64);
        if (t < ntw) {
            const LAS unsigned char* kb = lds + cur * KBUF; const LAS unsigned char* vb = lds + 2 * KBUF + cur * VBUF;
            f32x16 p0, p1;
            if (ALIBI) { const float base = slope2 * (float)(kv0 + 4 * hi - qrow);
#pragma unroll
                for (int r = 0; r < 16; ++r) { p0[r] = __builtin_fmaf(slope2, (float)((r & 3) + 8 * (r >> 2)), base); p1[r] = __builtin_fmaf(slope2, (float)(32 + (r & 3) + 8 * (r >> 2)), base); } }
            else {
#pragma unroll
                for (int r = 0; r < 16; ++r) { p0[r] = 0.f; p1[r] = 0.f; } }
            if constexpr (QMEM) qkt_qmem<DK>(p0, p1, kb, qf, qlds, r32, hi); else qkt<DK>(p0, p1, kb, qf, r32, hi);
            if (CAUSAL && kv0 + 63 > qrow - r32) {
#pragma unroll
                for (int r = 0; r < 16; ++r) { const int kv = kv0 + crow(r, hi); if (kv > qrow) p0[r] = -INFINITY; if (kv + 32 > qrow) p1[r] = -INFINITY; } }
            float mx = p0[0];
#pragma unroll
            for (int r = 1; r < 16; ++r) mx = fmaxf(mx, p0[r]);
#pragma unroll
            for (int r = 0; r < 16; ++r) mx = fmaxf(mx, p1[r]);
            mx = fmaxf(mx, xhalf(mx));
            const float mn = fmaxf(m, mx), alpha = __builtin_amdgcn_exp2f(m - mn); m = mn;
            l *= alpha;
            if (__any(alpha != 1.0f)) {
#pragma unroll
                for (int db = 0; db < DV / 32; ++db)
#pragma unroll
                    for (int r = 0; r < 16; ++r) o[db][r] *= alpha; }
            float s = 0.f;
#pragma unroll
            for (int r = 0; r < 16; ++r) { p0[r] = __builtin_amdgcn_exp2f(p0[r] - mn); p1[r] = __builtin_amdgcn_exp2f(p1[r] - mn); s += p0[r] + p1[r]; }
            l += s;
            bf16x8 pf[4]; pack_p(pf, p0, p1);
            pv<DV>(o, vb, pf, r32, hi);
        }
        if (t + 1 < NT) st.store(tid, lds + (cur ^ 1) * KBUF, lds + 2 * KBUF + (cur ^ 1) * VBUF);
        __syncthreads();
    }
    lsum = l + xhalf(l);
}


template <int DV> __device__ __forceinline__ void store_o(GAS bf16* Orow, const f32x16 (&o)[DV / 32], float sc, int hi) {
#pragma unroll
    for (int db = 0; db < DV / 32; ++db)
#pragma unroll
        for (int c = 0; c < 4; ++c) { u32x2 w; w.x = pk2(o[db][4 * c] * sc, o[db][4 * c + 1] * sc); w.y = pk2(o[db][4 * c + 2] * sc, o[db][4 * c + 3] * sc);
            *(GAS u32x2*)(Orow + 32 * db + 8 * c + 4 * hi) = w; }
}

__device__ __forceinline__ void mla_unit(LAS unsigned char* lds, int tid, int b, int h, int q0, const GAS bf16* qmla, const GAS bf16* knope, const GAS bf16* krope, const GAS bf16* vT, GAS bf16* out, int abl) {
    const int lane = tid & 63, wid = tid >> 6, r32 = lane & 31, hi = lane >> 5;
    const size_t tb = (size_t)b * 8192; const int qrow = q0 + 32 * wid + r32;
    const GAS bf16* Qr = qmla + (tb + qrow) * 768;
    f32x16 o[2]; float l;
    flash_pass<96, 64, true, false, true>(lds, tid, Qr + h * 64, Qr + 512 + h * 32, knope + tb * 512 + h * 64, 512, krope + tb * 32, vT + (size_t)(h * 64) * 16384 + tb, 16384,
                                          q0 / 64 + 4, (q0 + 32 * wid + 31) / 64 + 1, qrow, 0.f, o, l, nullptr, abl);
    if (abl == 0 || l == 12345.678f) store_o<64>(out + (tb + qrow) * 1024 + h * 64, o, 1.0f / l, hi);
}
__device__ __forceinline__ void cross_unit(LAS unsigned char* lds, int tid, int b, int h, int q0, const GAS bf16* qx, const GAS bf16* xk, const GAS bf16* xvT, GAS bf16* out) {
    const int lane = tid & 63, wid = tid >> 6, r32 = lane & 31, hi = lane >> 5;
    const size_t tb = (size_t)b * 8192; const int qrow = q0 + 32 * wid + r32;
    f32x16 o[4]; float l;
    int nt = 4; asm volatile("" : "+s"(nt));
    flash_pass_simple<128, 128, false, false, false, true>(lds, tid, qx + (tb + qrow) * 512 + h * 128, qx + (size_t)16384 * 512 + (tb + qrow) * 512 + h * 128, xk + (size_t)(b * 256) * 512 + h * 128, 512, nullptr, xvT + (size_t)(h * 128) * 512 + b * 256, 512,
                                              nt, nt, qrow, 0.f, o, l);
    store_o<128>(out + (tb + qrow) * 512 + h * 128, o, 1.0f / l, hi);
}
__device__ __forceinline__ void diff_unit(LAS unsigned char* lds, int tid, int b, int h, int hf, int q0, const GAS bf16* dq, const GAS bf16* dk, const GAS bf16* vT, GAS bf16* out, int ldo, const GAS unsigned* knl, int abl) {
    const int lane = tid & 63, wid = tid >> 6, r32 = lane & 31, hi = lane >> 5;
    const size_t tb = (size_t)b * 8192; const int qrow = q0 + 32 * wid + r32;
    const float slope2 = __builtin_amdgcn_exp2f(-2.0f * (float)(h + 1)) * 1.4426950408889634f;
    const int NT = q0 / 64 + 4, ntw = (q0 + 32 * wid + 31) / 64 + 1;
    f32x16 o[4]; float l;
    flash_pass<64, 128, true, true, false, true, true>(lds, tid, dq + (tb + qrow) * 512 + h * 128 + hf * 64, nullptr, dk + tb * 512 + h * 128 + hf * 64, 512, nullptr, vT + (size_t)(512 + h * 128) * 16384 + tb, 16384,
                                                      NT, ntw, qrow, slope2, o, l, knl + ((size_t)(b * 128) * 8 + 2 * h + hf) * 2, abl);
    if (abl == 0 || l == 12345.678f) store_o<128>(out + (tb + qrow) * (size_t)ldo + h * 128, o, 1.0f / l, hi);
}
__device__ __forceinline__ void diff_lambda(const GAS float* lp, int layer, float& lam, float& post) {
    float q1 = 0.f, q2 = 0.f;
    for (int i = 0; i < 64; ++i) { q1 += lp[i] * lp[64 + i]; q2 += lp[128 + i] * lp[192 + i]; }
    const float lam_init = (layer == 0) ? 0.2f : 0.35550906759f;
    lam = expf(q1) - expf(q2) + lam_init; post = 1.f - lam_init;
}
__device__ __forceinline__ void diff_combine4(int item0, int stride, int lane, GAS bf16* o0, const GAS bf16* o1, float lam, float post, const GAS float* subln) {
    unsigned a[4], c[4]; size_t off[4];
#pragma unroll
    for (int k = 0; k < 4; ++k) { const int item = item0 + k * stride; off[k] = (size_t)(item >> 2) * 1024 + (item & 3) * 128 + 2 * lane;
        a[k] = *(const GAS unsigned*)(o0 + off[k]); c[k] = *(const GAS unsigned*)(o1 + (size_t)item * 128 + 2 * lane); }
    const f32x2v g = *(const GAS f32x2v*)(subln + 2 * lane);
#pragma unroll
    for (int k = 0; k < 4; ++k) {
        const float x = bflo(a[k]) - lam * bflo(c[k]), y = bfhi(a[k]) - lam * bfhi(c[k]);
        float s2 = x * x + y * y;
#pragma unroll
        for (int dd = 1; dd < 64; dd <<= 1) s2 += __shfl_xor(s2, dd);
        const float rs = __builtin_amdgcn_rsqf(s2 * (1.f / 128.f) + 1e-6f) * post;
        *(GAS unsigned*)(o0 + off[k]) = pk2(x * rs * g[0], y * rs * g[1]); }
}
__device__ __forceinline__ void sb_unit(LAS unsigned char* lds, int tid, int b, int h, int q0, const GAS bf16* sq, const GAS bf16* sk, const GAS bf16* vT, GAS bf16* out) {
    constexpr int KBUF = KLay<64>::KBUF, VBUF = 64 * VPB;
    const int lane = tid & 63, wid = tid >> 6, r32 = lane & 31, hi = lane >> 5;
    const size_t tb = (size_t)b * 8192; const int qrow = q0 + 32 * wid + r32;
    const GAS bf16* Kg = sk + tb * 512 + h * 64; const GAS bf16* Vg = vT + (size_t)(h * 64) * 16384 + tb;
    const int NT = q0 / 64 + 4, ntw = (q0 + 32 * wid + 30) / 64 + 1;
    bf16x8 qf[4];
#pragma unroll
    for (int d0 = 0; d0 < 4; ++d0) qf[d0] = *(const GAS bf16x8*)(sq + (tb + qrow) * 512 + h * 64 + 16 * d0 + 8 * hi);
    f32x16 o[2];
#pragma unroll
    for (int r = 0; r < 16; ++r) { o[0][r] = 0.f; o[1][r] = 0.f; }
    float R = 1.0f;
    volatile LAS unsigned* dflag = (volatile LAS unsigned*)(lds + 4 * KBUF + 1024);
    Stage<64, 64, false> st;
    st.load(tid, Kg, 512, nullptr, Vg, 16384, 64 * (NT - 1));
    st.store(tid, lds, lds + 2 * KBUF);
    __syncthreads();
    for (int i = 0; i < NT; ++i) {
        const int t = NT - 1 - i, cur = i & 1, kv0 = 64 * t;
        if (t > 0) st.load(tid, Kg, 512, nullptr, Vg, 16384, kv0 - 64);
        if (t < ntw && __any(R != 0.f)) {
            const LAS unsigned char* kb = lds + cur * KBUF; const LAS unsigned char* vb = lds + 2 * KBUF + cur * VBUF;
            f32x16 k0, k1;
#pragma unroll
            for (int r = 0; r < 16; ++r) { k0[r] = 0.f; k1[r] = 0.f; }
            qkt<64>(k0, k1, kb, qf, r32, hi);
            f32x16 b0, b1;
#pragma unroll
            for (int r = 0; r < 16; ++r) {
                const float e0 = __builtin_amdgcn_exp2f(fminf(k0[r], 115.f)), e1 = __builtin_amdgcn_exp2f(fminf(k1[r], 115.f));
                const float r0 = __builtin_amdgcn_rcpf(1.f + e0), r1 = __builtin_amdgcn_rcpf(1.f + e1);
                k0[r] = r0; b0[r] = e0 * r0; k1[r] = r1; b1[r] = e1 * r1; }
            if (kv0 + 63 >= qrow - r32) {
                const int thr = qrow - kv0 - 4 * hi;
#pragma unroll
                for (int r = 0; r < 16; ++r) { const int c = (r & 3) + 8 * (r >> 2); if (c >= thr) { k0[r] = 1.f; b0[r] = 0.f; } if (c + 32 >= thr) { k1[r] = 1.f; b1[r] = 0.f; } } }
            float gp[8], go[8];
#pragma unroll
            for (int c = 0; c < 4; ++c) { gp[c] = (k0[4 * c] * k0[4 * c + 1]) * (k0[4 * c + 2] * k0[4 * c + 3]); gp[4 + c] = (k1[4 * c] * k1[4 * c + 1]) * (k1[4 * c + 2] * k1[4 * c + 3]); }
#pragma unroll
            for (int g = 0; g < 8; ++g) go[g] = xhalf(gp[g]);
            float sp = R;
#pragma unroll
            for (int g = 7; g >= 0; --g) {
                float s = sp * (hi ? 1.0f : go[g]);
                if (g >= 4) { const int c = g - 4;
                    b1[4 * c + 3] *= s; s *= k1[4 * c + 3]; b1[4 * c + 2] *= s; s *= k1[4 * c + 2]; b1[4 * c + 1] *= s; s *= k1[4 * c + 1]; b1[4 * c] *= s; }
                else { const int c = g;
                    b0[4 * c + 3] *= s; s *= k0[4 * c + 3]; b0[4 * c + 2] *= s; s *= k0[4 * c + 2]; b0[4 * c + 1] *= s; s *= k0[4 * c + 1]; b0[4 * c] *= s; }
                sp *= gp[g] * go[g];
            }
            R = sp;
            bf16x8 pf[4]; pack_p(pf, b0, b1);
            pv<64>(o, vb, pf, r32, hi);
        }
        if (t > 0) st.store(tid, lds + (cur ^ 1) * KBUF, lds + 2 * KBUF + (cur ^ 1) * VBUF);
        if (lane == 0) dflag[(i & 1) * 8 + wid] = (t < ntw && !__any(R != 0.f)) ? 1u : 0u;
        __syncthreads();
        { unsigned alld = 1u;
#pragma unroll
          for (int w = 0; w < 8; ++w) alld &= dflag[(i & 1) * 8 + w];
          if (alld) break; }
    }
    store_o<64>(out + (tb + qrow) * 1024 + h * 64, o, 1.0f, hi);
}
}
typedef unsigned short bf16;
typedef float f32x4 __attribute__((ext_vector_type(4)));
typedef unsigned u32x4 __attribute__((ext_vector_type(4)));
typedef unsigned u32x2 __attribute__((ext_vector_type(2)));
constexpr int NWAVES = 8, NTHREADS = 512;
constexpr int M = 16384, D = 1024, SEQ = 8192, DEPTH = 2, IN_COLS = 6688;
constexpr int SROWS = 40960;
constexpr size_t MiB = 1u << 20;
constexpr size_t WS_CTL = 0, CTL_ZERO_BYTES = 128 * 1024;
constexpr size_t WS_SSQ = 1 * MiB;
constexpr size_t WS_SSQCQ = 2 * MiB, WS_SSQCKV = WS_SSQCQ + 256 * 1024, WS_SSQMEM = WS_SSQCKV + 256 * 1024;
constexpr size_t WS_TOKE = 3 * MiB, WS_TOKW = WS_TOKE + 128 * 1024, WS_HIST = WS_TOKW + 128 * 1024, WS_SLOT = WS_HIST + 64 * 1024;
constexpr size_t WS_STOK = 4 * MiB, WS_SW = WS_STOK + 256 * 1024, WS_SRSTD = WS_SW + 256 * 1024;
constexpr size_t WS_WR = 5 * MiB;
constexpr size_t WS_WRH = 5 * MiB + 256 * 1024, WS_WRL = WS_WRH + 128 * 1024;
constexpr size_t WS_MEMN = 6 * MiB, WS_XK = 7 * MiB, WS_XVT = WS_XK + 512 * 1024;
constexpr size_t WS_WIN = 8 * MiB;
constexpr size_t WS_WV = WS_WIN + (size_t)2816 * 1024 * 2;
constexpr size_t WS_WG = WS_WV + 2 * MiB;
constexpr size_t WS_WUQ = WS_WG + 6 * MiB;
constexpr size_t WS_WUKN = WS_WUQ + 768 * 256 * 2;
constexpr size_t WS_WUV = WS_WUKN + 512 * 256 * 2;
constexpr size_t WS_WB = WS_WUV + 512 * 256 * 2;
constexpr size_t WS_WOUT = WS_WB + 4 * MiB;
constexpr size_t WS_WXQ = WS_WOUT + 2 * MiB;
constexpr size_t WS_WXK = WS_WXQ + 1 * MiB, WS_WXV = WS_WXK + 1 * MiB;
constexpr size_t WS_WXO = WS_WXV + 1 * MiB;
constexpr size_t WS_WGU = WS_WXO + 1 * MiB;
constexpr size_t WS_WD = WS_WGU + 32 * MiB;
constexpr size_t WS_WEND = WS_WD + 16 * MiB;
static_assert(WS_WEND <= 81 * MiB, "weights");
constexpr size_t WS_XB = 81 * MiB;
constexpr size_t R0 = 113 * MiB;
constexpr size_t WS_CQ = R0, WS_CKV = R0 + 8 * MiB, WS_KROPE = R0 + 16 * MiB, WS_QK = R0 + 18 * MiB  , WS_VT = R0 + 82 * MiB  ;
constexpr size_t WS_QMLA = R0 + 114 * MiB, WS_KNOPE = R0 + 138 * MiB, WS_VMLAT = R0 + 154 * MiB, WS_OABC = R0 + 170 * MiB  ;
constexpr size_t WS_GSCR = R0, WS_MB = R0 + 96 * MiB;
constexpr size_t WS_QX = R0, WS_OX = R0 + 32 * MiB;
constexpr size_t WS_XG = R0, WS_ACT = R0 + 80 * MiB, WS_Y = R0 + 100 * MiB;
constexpr size_t WS_END = R0 + 234 * MiB;
static_assert(WS_MB + 32 * MiB <= WS_OABC && WS_Y + 80 * MiB <= WS_END && WS_OABC + 64 * MiB <= WS_END, "region map");
constexpr int CW_BAR = 1024, CW_Q = 8192, CW_KN = 16384, CW_F1 = 24576;
constexpr int RING_BYTES = 131072, LDSCTL_OFF = RING_BYTES, MISC_OFF = LDSCTL_OFF + 320, TSTART_OFF = LDSCTL_OFF + 1024, HIST_OFF = LDSCTL_OFF + 2048;
constexpr int LDS_BYTES = 147456;

#define LDS_WAIT() asm volatile("s_waitcnt lgkmcnt(0)" ::: "memory")
__device__ __forceinline__ float wave_sum(float v) {
#pragma unroll
    for (int o = 1; o < 64; o <<= 1) v += __shfl_xor(v, o);
    return v;
}
__device__ __forceinline__ unsigned pk2(float lo, float hi) { return pg8::pk2(lo, hi); }
__device__ __forceinline__ int lane_id() { int r; asm volatile("v_mbcnt_lo_u32_b32 %0, -1, 0\n\tv_mbcnt_hi_u32_b32 %0, -1, %0" : "=v"(r)); return r; }
#define XB_TMO      128
#define XB_XCNT(j)  (256  + 64 * (j))
#define XB_XSUB(j)  (1280 + 64 * (j))
#define XB_XGEN(j)  (2304 + 64 * (j))
#define XB_TOP      3328
#define XB_TOPGEN   3392
#define XCD_BAR_WORDS 3456
#define XB_SPIN_CAP (1u << 18)

__device__ __forceinline__ unsigned xb_ld(unsigned* p)              { return __hip_atomic_load(p, __ATOMIC_RELAXED, __HIP_MEMORY_SCOPE_AGENT); }
__device__ __forceinline__ unsigned xb_add(unsigned* p, unsigned v) { return __hip_atomic_fetch_add(p, v, __ATOMIC_RELAXED, __HIP_MEMORY_SCOPE_AGENT); }
__device__ __forceinline__ unsigned xb_xcc_id() { return (unsigned)__builtin_amdgcn_s_getreg((3 << 11) | 20) & 0xFu; }
#define XB_SPIN(cond, bar) do { unsigned _sp = 0; while (cond) { __builtin_amdgcn_s_sleep(1); \
    if ((++_sp & 255u) == 0u) { if (xb_ld(&(bar)[XB_TMO])) break; if (_sp > XB_SPIN_CAP) { atomicAdd(&(bar)[XB_TMO], 1u); break; } } } } while (0)

struct XcdBarrier {
    unsigned* bar; unsigned x; int wid;
    volatile LAS unsigned* st;
};

__device__ __forceinline__ XcdBarrier xcd_barrier_post(unsigned* bar, volatile LAS unsigned* st, int wid) {
    XcdBarrier b; b.bar = bar; b.x = xb_xcc_id(); b.st = st; b.wid = wid;
    if (wid == 0 && lane_id() == 0) (void)xb_add(&bar[XB_XCNT(b.x)], 1u);
    return b;
}
__device__ __forceinline__ void xcd_barrier_complete(unsigned* bar, unsigned x, unsigned& nloc, unsigned& nx) {
    const unsigned G = gridDim.x * gridDim.y * gridDim.z;
    unsigned sum, cnt, mine, sp = 0u;
    for (;;) {
        sum = 0u; cnt = 0u; mine = 0u;
#pragma unroll 1
        for (unsigned j = 0; j < 16; ++j) { const unsigned c = xb_ld(&bar[XB_XCNT(j)]); sum += c; cnt += (c > 0u) ? 1u : 0u; mine = (j == x) ? c : mine; }
        if (sum == G) break;
        __builtin_amdgcn_s_sleep(1);
        if ((++sp & 255u) == 0u) { if (xb_ld(&bar[XB_TMO])) break; if (sp > XB_SPIN_CAP) { atomicAdd(&bar[XB_TMO], 1u); break; } }
    }
    nloc = mine > 0u ? mine : 1u; nx = cnt > 0u ? cnt : 1u;
}

__device__ __forceinline__ void xcd_barrier(const XcdBarrier& b) {
    asm volatile("s_waitcnt vmcnt(0)" ::: "memory");
    __syncthreads();
    if (b.wid == 0 && lane_id() == 0) {
        unsigned* bar = b.bar; asm volatile("" : "+s"(bar));
        __builtin_amdgcn_s_waitcnt(0);
        unsigned nloc = b.st[0], nx = b.st[1];
        if (nloc == 0u) { xcd_barrier_complete(bar, b.x, nloc, nx); b.st[0] = nloc; b.st[1] = nx; }
        const unsigned old = xb_add(&bar[XB_XSUB(b.x)], 1u);
        const unsigned gen = old / nloc;
        if (old + 1u == (gen + 1u) * nloc) {
            __builtin_amdgcn_fence(__ATOMIC_RELEASE, "agent");
            asm volatile("s_waitcnt vmcnt(0)" ::: "memory");
            const unsigned og = xb_add(&bar[XB_TOP], 1u);
            const unsigned tg = og / nx;
            if (og + 1u == (tg + 1u) * nx) xb_add(&bar[XB_TOPGEN], 1u);
            else XB_SPIN(xb_ld(&bar[XB_TOPGEN]) == tg, bar);
            __builtin_amdgcn_fence(__ATOMIC_ACQUIRE, "agent");
            xb_add(&bar[XB_XGEN(b.x)], 1u);
            asm volatile("s_waitcnt vmcnt(0)" ::: "memory");
        } else {
            XB_SPIN(xb_ld(&bar[XB_XGEN(b.x)]) == gen, bar);
            __builtin_amdgcn_fence(__ATOMIC_ACQUIRE, "agent");
            asm volatile("s_waitcnt vmcnt(0)" ::: "memory");
        }
    }
    __syncthreads();
}
struct TrJob { const GAS float* src; const GAS float* gain; GAS bf16* dst; int ldn, col0, k0, K, row0, dk; };
__device__ __forceinline__ void tr_load(const TrJob& j, f32x4 (&v)[8], int lane) {
    const int kr = lane >> 3, nq = lane & 7;
    if (j.col0 >= 0) {
#pragma unroll
        for (int i = 0; i < 8; ++i) v[i] = *(const GAS f32x4*)(j.src + (size_t)(j.k0 + 8 * i + kr) * j.ldn + j.col0 + 4 * nq);
    } else {
#pragma unroll
        for (int i = 0; i < 8; ++i) v[i] = (f32x4){0.f, 0.f, 0.f, 0.f};
    }
}
__device__ __forceinline__ void tr_finish(const TrJob& j, const f32x4 (&v)[8], LAS float* scr, int lane) {
    const int kr = lane >> 3, nq = lane & 7;
#pragma unroll
    for (int i = 0; i < 8; ++i) { const int kk = 8 * i + kr; const float g = j.gain ? j.gain[j.k0 + kk] : 1.f; LAS float* s = scr + kk * 33 + 4 * nq;
        s[0] = v[i][0] * g; s[1] = v[i][1] * g; s[2] = v[i][2] * g; s[3] = v[i][3] * g; }
    LDS_WAIT(); asm volatile("" ::: "memory");
    const int c = lane & 7;
#pragma unroll
    for (int q = 0; q < 4; ++q) { const int n = (lane >> 3) + 8 * q; const LAS float* s = scr + (8 * c) * 33 + n;
        u32x4 o; o.x = pk2(s[0 * 33], s[1 * 33]); o.y = pk2(s[2 * 33], s[3 * 33]); o.z = pk2(s[4 * 33], s[5 * 33]); o.w = pk2(s[6 * 33], s[7 * 33]);
        *(GAS u32x4*)(j.dst + (size_t)(j.row0 + n) * j.K + j.dk + j.k0 + 8 * c) = o; }
    LDS_WAIT(); asm volatile("" ::: "memory");
}
__device__ __forceinline__ void row_load(const GAS float* xrow, f32x4 (&v)[4], int lane) {
    const GAS f32x4* xr = (const GAS f32x4*)xrow + lane;
#pragma unroll
    for (int j = 0; j < 4; ++j) v[j] = xr[64 * j];
}
__device__ __forceinline__ void row_finish(const f32x4 (&v)[4], GAS bf16* orow, GAS float* ssq16, int lane) {
    float s = 0.f;
#pragma unroll
    for (int j = 0; j < 4; ++j) s += (v[j][0] * v[j][0] + v[j][1] * v[j][1]) + (v[j][2] * v[j][2] + v[j][3] * v[j][3]);
    s = wave_sum(s);
    GAS u32x2* o8 = (GAS u32x2*)orow + lane;
#pragma unroll
    for (int j = 0; j < 4; ++j) { u32x2 w; w.x = pk2(v[j][0], v[j][1]); w.y = pk2(v[j][2], v[j][3]); o8[64 * j] = w; }
    if (lane < 16) ssq16[lane] = (lane == 0) ? s : 0.f;
}
__device__ __forceinline__ void row_to_bf16(const GAS float* xrow, GAS bf16* orow, GAS float* ssq16, int lane) {
    const GAS f32x4* xr = (const GAS f32x4*)xrow + lane; f32x4 v[4]; float s = 0.f;
#pragma unroll
    for (int j = 0; j < 4; ++j) { v[j] = xr[64 * j]; s += (v[j][0] * v[j][0] + v[j][1] * v[j][1]) + (v[j][2] * v[j][2] + v[j][3] * v[j][3]); }
    s = wave_sum(s);
    GAS u32x2* o8 = (GAS u32x2*)orow + lane;
#pragma unroll
    for (int j = 0; j < 4; ++j) { u32x2 w; w.x = pk2(v[j][0], v[j][1]); w.y = pk2(v[j][2], v[j][3]); o8[64 * j] = w; }
    if (lane < 16) ssq16[lane] = (lane == 0) ? s : 0.f;
}

struct Args { const float* in[26]; float* out; unsigned char* ws; };
__device__ __forceinline__ int opq(int i) { asm volatile("" : "+s"(i)); return i; }
__device__ __forceinline__ GAS unsigned char* opqp(unsigned char* p0) { GAS unsigned char* p = (GAS unsigned char*)p0; asm volatile("" : "+s"(p)); return p; }
#define INP(i) ((const GAS float*)args.in[opq(i)])
#define WSB(off) (opqp(args.ws) + (off))
#define X_IN INP(0)
#define OUTP ((GAS float*)args.out)
#define XB ((GAS bf16*)WSB(WS_XB))
#define SSQ ((GAS float*)WSB(WS_SSQ))
#define SSQCQ ((GAS float*)WSB(WS_SSQCQ))
#define SSQCKV ((GAS float*)WSB(WS_SSQCKV))
#define SSQMEM ((GAS float*)WSB(WS_SSQMEM))
#define MEMN ((GAS bf16*)WSB(WS_MEMN))
#define XK ((GAS bf16*)WSB(WS_XK))
#define XVT ((GAS bf16*)WSB(WS_XVT))
#define WIN ((GAS bf16*)WSB(WS_WIN))
#define WV ((GAS bf16*)WSB(WS_WV))
#define WG ((GAS bf16*)WSB(WS_WG))
#define WUQ ((GAS bf16*)WSB(WS_WUQ))
#define WUKN ((GAS bf16*)WSB(WS_WUKN))
#define WUV ((GAS bf16*)WSB(WS_WUV))
#define WB ((GAS bf16*)WSB(WS_WB))
#define WOUT ((GAS bf16*)WSB(WS_WOUT))
#define WXQ ((GAS bf16*)WSB(WS_WXQ))
#define WXK ((GAS bf16*)WSB(WS_WXK))
#define WXV ((GAS bf16*)WSB(WS_WXV))
#define WXO ((GAS bf16*)WSB(WS_WXO))
#define WGU ((GAS bf16*)WSB(WS_WGU))
#define WD ((GAS bf16*)WSB(WS_WD))
#define WRH ((GAS bf16*)WSB(WS_WRH))
#define WRL ((GAS bf16*)WSB(WS_WRL))
#define CQ ((GAS bf16*)WSB(WS_CQ))
#define CKV ((GAS bf16*)WSB(WS_CKV))
#define KROPE ((GAS bf16*)WSB(WS_KROPE))
#define QK ((GAS bf16*)WSB(WS_QK))
#define VT ((GAS bf16*)WSB(WS_VT))
#define QMLA ((GAS bf16*)WSB(WS_QMLA))
#define KNOPE ((GAS bf16*)WSB(WS_KNOPE))
#define VMLAT ((GAS bf16*)WSB(WS_VMLAT))
#define OABC ((GAS bf16*)WSB(WS_OABC))
#define GSCR ((GAS unsigned char*)WSB(WS_GSCR))
#define MB ((GAS bf16*)WSB(WS_MB))
#define QX ((GAS bf16*)WSB(WS_QX))
#define OX ((GAS bf16*)WSB(WS_OX))
#define XG ((GAS bf16*)WSB(WS_XG))
#define ACT ((GAS bf16*)WSB(WS_ACT))
#define YB ((GAS bf16*)WSB(WS_Y))
#define TOKE ((GAS int*)WSB(WS_TOKE))
#define TOKW ((GAS float*)WSB(WS_TOKW))
#define HIST ((GAS int*)WSB(WS_HIST))
#define SLOT ((GAS int*)WSB(WS_SLOT))
#define STOK ((GAS int*)WSB(WS_STOK))
#define SW ((GAS float*)WSB(WS_SW))
#define SRSTD ((GAS float*)WSB(WS_SRSTD))


__global__ void __launch_bounds__(NTHREADS, 2) fwd(Args args) {
    extern __shared__ __attribute__((aligned(16))) unsigned char lds_raw[];
    LAS unsigned char* lds = (LAS unsigned char*)lds_raw;
    volatile LAS unsigned* MISC = (volatile LAS unsigned*)(lds + MISC_OFF);
    LAS int* TSTART = (LAS int*)(lds + TSTART_OFF);
    const int tid0 = threadIdx.x; const int wv = __builtin_amdgcn_readfirstlane(tid0 >> 6);
#define PH_BEGIN int tid_ = wv * 64 + lane_id(); asm volatile("" : "+v"(tid_)); const int tid = tid_, lane = tid & 63, wave = wv, gw = vcu * NWAVES + wave; (void)lane; (void)gw
    const int G = gridDim.x, bx = blockIdx.x, vcu = (G % 8 == 0) ? (bx % 8) * (G / 8) + bx / 8 : bx;
    unsigned* ctl = (unsigned*)(void*)(args.ws + WS_CTL);
    for (int u = tid0; u < (LDS_BYTES - LDSCTL_OFF) / 4; u += NTHREADS) ((LAS unsigned*)(lds + LDSCTL_OFF))[u] = 0u;
    __syncthreads();
    XcdBarrier bar = xcd_barrier_post(ctl + CW_BAR, MISC + 8, wv);
    const int NGW = G * NWAVES;

    constexpr float L2E = 1.4426950408889634f;

    constexpr int I_IN = 88 * 16, I_V = 32 * 16, I_G = 96 * 16, I_UQ = 24 * 4, I_UK = 16 * 4, I_B = 3 * 32 * 8, I_O = 32 * 16, I_XQ = 16 * 16, I_XO = 32 * 8, I_GU = 512 * 16, I_D = 1024 * 4;
    constexpr int NITEMS = I_IN + I_V + I_G + I_UQ + 2 * I_UK + I_B + I_O + 3 * I_XQ + I_XO + I_GU + I_D, NITEMS_P0 = NITEMS - I_GU - I_D;
    for (int l = 0; l < DEPTH; ++l) {
        for (int rp_ = 0; rp_ < RP_P0; ++rp_) {
#if PH_P0
        { PH_BEGIN;
            LAS float* scr = (LAS float*)(lds + wave * 16384);
#define w_in (INP(3) + (size_t)l * D * IN_COLS)
#define g_attn (INP(2) + l * D)
#define w_uq (INP(5) + (size_t)l * 256 * 768)
#define g_q (INP(4) + l * 256)
#define w_ukv (INP(7) + (size_t)l * 256 * 1024)
#define g_kv (INP(6) + l * 256)
#define w_br (INP(10) + (size_t)l * 3 * 512 * 1024)
#define w_out (INP(11) + (size_t)l * D * D)
#define g_cross (INP(12) + l * D)
#define g_mem (INP(13))
#define w_xq (INP(14) + (size_t)l * D * 512)
#define w_xkv (INP(15) + (size_t)l * D * 1024)
#define w_xo (INP(16) + (size_t)l * 512 * D)
#define g_ffn (INP(17) + l * D)
#define w_eg (INP(22) + (size_t)l * 32 * D * 256)
#define w_eu (INP(23) + (size_t)l * 32 * D * 256)
#define w_ed (INP(24) + (size_t)l * 32 * 256 * D)
#define TR_DECODE(itx) do { int r = (itx); \
                if (r < I_IN) { const int nb = r >> 4, kb = r & 15, n0 = nb * 32; int col; \
                    if (n0 < 544) col = 3072 + n0; else if (n0 < 768) col = -1; else if (n0 < 1792) col = 3616 + (n0 - 768); else col = 5152 + (n0 - 1792); \
                    jb = TrJob{w_in, g_attn, WIN, IN_COLS, col, kb * 64, 1024, n0, 0}; break; } r -= I_IN; \
                if (r < I_V) { const int nb = r >> 4, kb = r & 15, n0 = nb * 32; const int col = n0 < 512 ? 4640 + n0 : 6176 + (n0 - 512); \
                    jb = TrJob{w_in, g_attn, WV, IN_COLS, col, kb * 64, 1024, n0, 0}; break; } r -= I_V; \
                if (r < I_G) { const int nb = r >> 4, kb = r & 15; jb = TrJob{w_in, g_attn, WG, IN_COLS, nb * 32, kb * 64, 1024, nb * 32, 0}; break; } r -= I_G; \
                if (r < I_UQ) { const int nb = r >> 2, kb = r & 3, n0 = nb * 32; const int col = n0 < 512 ? 96 * (n0 >> 6) + (n0 & 63) : 96 * ((n0 - 512) >> 5) + 64; \
                    jb = TrJob{w_uq, g_q, WUQ, 768, col, kb * 64, 256, n0, 0}; break; } r -= I_UQ; \
                if (r < I_UK) { const int nb = r >> 2, kb = r & 3, n0 = nb * 32; jb = TrJob{w_ukv, g_kv, WUKN, 1024, 128 * (n0 >> 6) + (n0 & 63), kb * 64, 256, n0, 0}; break; } r -= I_UK; \
                if (r < I_UK) { const int nb = r >> 2, kb = r & 3, n0 = nb * 32; jb = TrJob{w_ukv, g_kv, WUV, 1024, 128 * (n0 >> 6) + 64 + (n0 & 63), kb * 64, 256, n0, 0}; break; } r -= I_UK; \
                if (r < I_B) { const int z = r / 256, q = r % 256, nb = q >> 3, kb = q & 7; jb = TrJob{w_br + (size_t)z * 512 * 1024, nullptr, WB + (size_t)(z >> 1) * 1024 * 1024, 1024, nb * 32, kb * 64, 1024, nb * 32, (z & 1) * 512}; break; } r -= I_B; \
                if (r < I_O) { const int nb = r >> 4, kb = r & 15; jb = TrJob{w_out, nullptr, WOUT, 1024, nb * 32, kb * 64, 1024, nb * 32, 0}; break; } r -= I_O; \
                if (r < I_XQ) { const int nb = r >> 4, kb = r & 15; jb = TrJob{w_xq, g_cross, WXQ, 512, nb * 32, kb * 64, 1024, nb * 32, 0}; break; } r -= I_XQ; \
                if (r < I_XQ) { const int nb = r >> 4, kb = r & 15; jb = TrJob{w_xkv, g_mem, WXK, 1024, nb * 32, kb * 64, 1024, nb * 32, 0}; break; } r -= I_XQ; \
                if (r < I_XQ) { const int nb = r >> 4, kb = r & 15; jb = TrJob{w_xkv, g_mem, WXV, 1024, 512 + nb * 32, kb * 64, 1024, nb * 32, 0}; break; } r -= I_XQ; \
                if (r < I_XO) { const int nb = r >> 3, kb = r & 7; jb = TrJob{w_xo, nullptr, WXO, 1024, nb * 32, kb * 64, 512, nb * 32, 0}; break; } r -= I_XO; \
                if (r < I_GU) { const int nb = r >> 4, kb = r & 15, n0 = nb * 32, e = n0 >> 9, rr = n0 & 511, t = rr >> 8, j = rr & 255; \
                    const GAS float* src = (j < 128 ? w_eg : w_eu) + (size_t)e * D * 256; jb = TrJob{src, g_ffn, WGU, 256, 128 * t + (j & 127), kb * 64, 1024, n0, 0}; break; } r -= I_GU; \
                { const int nb = r >> 2, kb = r & 3, n0 = nb * 32, e = n0 >> 10; jb = TrJob{w_ed + (size_t)e * 256 * 1024, nullptr, WD, 1024, n0 & 1023, kb * 64, 256, n0, 0}; } } while (0)
            for (int it = gw; it < NITEMS_P0; it += NGW) {
                TrJob jb{};
                TR_DECODE(it);
                f32x4 va[8];
                tr_load(jb, va, lane);
                tr_finish(jb, va, scr, lane);
            }
            { const GAS float* wrg = INP(18) + (size_t)l * D * 4; const GAS float* wre = INP(20) + (size_t)l * D * 32; GAS bf16* wh = WRH; GAS bf16* wl = WRL;
              for (int i = bx * NTHREADS + tid; i < 48 * 1024; i += G * NTHREADS) { const int c = i >> 10, k = i & 1023;
                  const float w = c < 36 ? (c < 4 ? wrg[k * 4 + c] : wre[k * 32 + (c - 4)]) * g_ffn[k] : 0.f; const unsigned h = pk2(w, 0.f) & 0xffffu;
                  wh[i] = (bf16)h; wl[i] = (bf16)(pk2(w - __builtin_bit_cast(float, h << 16), 0.f) & 0xffffu); } }
            if (l == 0) {
                for (int m = gw; m < M; m += 2 * NGW) {
                    const int m1 = m + NGW < M ? m + NGW : m;
                    f32x4 v0[4], v1[4]; row_load(X_IN + (size_t)m * D, v0, lane); row_load(X_IN + (size_t)m1 * D, v1, lane);
                    row_finish(v0, XB + (size_t)m * D, SSQ + (size_t)m * 16, lane); row_finish(v1, XB + (size_t)m1 * D, SSQ + (size_t)m1 * 16, lane); }
                for (int m = gw; m < 512; m += NGW) row_to_bf16(INP(1) + (size_t)m * D, MEMN + (size_t)m * D, SSQMEM + (size_t)m * 16, lane);
            }
        }
#endif
        xcd_barrier(bar);
        }
                for (int rp_ = 0; rp_ < RP_A; ++rp_) {
#if PH_A
        {
            { pg8::Gemm g{XB, WIN, M, 2816, D, D, nullptr}; pg8::StaticOrder S; S.init(M, 2816, G, bx);
              pg8::EpiA E{SSQ, CQ, CKV, KROPE, QK, SSQCQ, SSQCKV, 0.125f * L2E, (GAS unsigned*)(opqp(args.ws) + WS_CTL) + CW_KN + l * 4096, rp_ ? A_ABL : 0};
              pg8::gemm_phase<pg8::EpiA, pg8::StaticOrder, true, true>(lds, g, S, E, wv); }
            { pg8::Gemm g{WV, XB, 1024, M, D, D, nullptr}; pg8::StaticOrder S; S.init(1024, M, G, (bx + 64) % G);
              pg8::EpiVT E{VT, M, SSQ, 4, 1.f / 1024.f};
              pg8::gemm_phase<pg8::EpiVT, pg8::StaticOrder, true, true>(lds, g, S, E, wv); }
            { pg8::Gemm g{MEMN, WXK, 512, 512, D, D, nullptr}; pg8::StaticOrder S; S.init(512, 512, G, (bx + 8) % G);
              pg8::EpiRS E{XK, 512, SSQMEM, 4, 1.f / 1024.f, 1.f, 0xffff, 31, 0};
              pg8::gemm_phase<pg8::EpiRS, pg8::StaticOrder, true, true>(lds, g, S, E, wv); }
            { pg8::Gemm g{WXV, MEMN, 512, 512, D, D, nullptr}; pg8::StaticOrder S; S.init(512, 512, G, (bx + 16) % G);
              pg8::EpiVT E{XVT, 512, SSQMEM, 4, 1.f / 1024.f};
              pg8::gemm_phase<pg8::EpiVT, pg8::StaticOrder, true, true>(lds, g, S, E, wv); }
        }
#endif
        xcd_barrier(bar);
        }
                for (int rp_ = 0; rp_ < RP_B; ++rp_) {
#if PH_B
        {
#if PH_B1
            { pg8::Gemm g{CQ, WUQ, M, 768, opq(256), opq(256), nullptr}; pg8::StaticOrder S; S.init(M, 768, G, bx);
              pg8::EpiQ E{QMLA, SSQCQ, 0.10206207261596577f * L2E};
              pg8::gemm_phase<pg8::EpiQ, pg8::StaticOrder, true, true>(lds, g, S, E, wv); }
#endif
#if PH_B2
            { pg8::Gemm g{CKV, WUKN, M, 512, opq(256), opq(256), nullptr}; pg8::StaticOrder S; S.init(M, 512, G, (bx + 64) % G);
              pg8::EpiRS E{KNOPE, 512, SSQCKV, 1, 1.f / 256.f, 1.f, 0xffff, 31, 0};
              pg8::gemm_phase<pg8::EpiRS, pg8::StaticOrder, true, true>(lds, g, S, E, wv); }
#endif
#if PH_B3
            { pg8::Gemm g{WUV, CKV, 512, M, opq(256), opq(256), nullptr}; pg8::StaticOrder S; S.init(512, M, G, (bx + 128) % G);
              pg8::EpiVT E{VMLAT, M, SSQCKV, 1, 1.f / 256.f};
              pg8::gemm_phase<pg8::EpiVT, pg8::StaticOrder, true, true>(lds, g, S, E, wv); }
#endif
        }
#endif
        xcd_barrier(bar);
        }
                for (int rp_ = 0; rp_ < RP_C; ++rp_) {
#if PH_C
        {
            unsigned* qhead = ctl + CW_Q + 64 * (l + 2 * rp_);
            for (;;) {
                if (wv == 0 && lane_id() == 0) MISC[0] = __hip_atomic_fetch_add(qhead, 1u, __ATOMIC_RELAXED, __HIP_MEMORY_SCOPE_AGENT);
                __syncthreads();
                const int idx = (int)MISC[0];
                __syncthreads();
                if (idx >= 32 * 48 + 256) break;
                if (idx >= 32 * 48) {
                    if (rp_ == 0) { const int wl = lane_id(); LAS float* scr = (LAS float*)(lds + wv * 16384);
                        for (int j = 0; j < 6; ++j) { const int it = NITEMS_P0 + (idx - 32 * 48) * 48 + j * 8 + wv; TrJob jb{}; TR_DECODE(it); f32x4 va[8]; tr_load(jb, va, wl); tr_finish(jb, va, scr, wl); } }
                    continue; }
                const int qb = 31 - idx / 48, r = idx % 48, q0 = qb * 256;
                int tu = wv * 64 + lane_id(); asm volatile("" : "+v"(tu));
#if PH_C_DIFF
                if (r < 16 && (rp_ == 0 || (C_REP_MASK & 1))) att::diff_unit(lds, tu, r >> 3, (r >> 1) & 3, r & 1, q0, QK + (size_t)2 * M * 512, QK + (size_t)3 * M * 512, VT, (r & 1) ? CQ : OABC + (size_t)M * 1024, (r & 1) ? 512 : 1024,
                                                                             (const GAS unsigned*)(opqp(args.ws) + WS_CTL) + CW_KN + l * 4096, rp_ ? C_ABL : 0);
#endif
#if PH_C_SB
                if (r >= 16 && r < 32 && (rp_ == 0 || (C_REP_MASK & 2))) att::sb_unit(lds, tu, (r - 16) >> 3, (r - 16) & 7, q0, QK, QK + (size_t)M * 512, VT, OABC + 512);
#endif
#if PH_C_MLA
                if (r >= 32 && (rp_ == 0 || (C_REP_MASK & 4))) att::mla_unit(lds, tu, (r - 32) >> 3, (r - 32) & 7, q0, QMLA, KNOPE, KROPE, VMLAT, OABC, rp_ ? C_ABL : 0);
#endif
            }
        }
#endif
        xcd_barrier(bar);
        }
        #undef TR_DECODE
#undef w_in
#undef g_attn
#undef w_uq
#undef g_q
#undef w_ukv
#undef g_kv
#undef w_br
#undef w_out
#undef g_cross
#undef g_mem
#undef w_xq
#undef w_xkv
#undef w_xo
#undef g_ffn
#undef w_eg
#undef w_eu
#undef w_ed
#if PH_C
        { PH_BEGIN;
          float lam, post; att::diff_lambda(INP(8) + l * 256, l, lam, post);
          for (int it = gw; it < M * 4; it += 4 * NGW) att::diff_combine4(it, NGW, lane, OABC + (size_t)M * 1024, CQ, lam, post, INP(9) + l * 128); }
        xcd_barrier(bar);
#endif
        for (int rp_ = 0; rp_ < RP_D1; ++rp_) {
#if PH_D1
        { pg8::Gemm g{XB, WG, M, 1024, 512, 1024, nullptr}; pg8::D1Order S; S.so.init(M, 1024, G, bx);
          const GAS char* xb_ = (const GAS char*)XB; const GAS char* oab_ = (const GAS char*)OABC; const GAS char* wg_ = (const GAS char*)WG; const GAS char* wb_ = (const GAS char*)WB;
          S.dA = (size_t)(oab_ - xb_); S.dB = (size_t)(wb_ - wg_);
          pg8::EpiD1 E{GSCR, MB, SSQ};
          pg8::gemm_phase<pg8::EpiD1, pg8::D1Order, true, true>(lds, g, S, E, wv); }
#endif
        xcd_barrier(bar);
        }
        #if PH_D2
        { pg8::Gemm g{MB, WOUT, M, 1024, D, D, nullptr}; pg8::StaticOrder S; S.init(M, 1024, G, bx);
          pg8::EpiRes E{XB, SSQ};
          pg8::gemm_phase<pg8::EpiRes, pg8::StaticOrder, true, true>(lds, g, S, E, wv); }
#endif
        xcd_barrier(bar);
                for (int rp_ = 0; rp_ < RP_E1; ++rp_) {
#if PH_E1
        { pg8::Gemm g{XB, WXQ, M, 512, 512, 1024, nullptr}; pg8::SplitK2Order S; S.so.init(M, 1024, G, bx); S.tstep = (size_t)256 * 1024 * 2;
          pg8::EpiRS E{QX, 512, SSQ, 4, 1.f / 1024.f, 0.08838834764831845f * L2E, 1, 1, (size_t)M * 512};
          pg8::gemm_phase<pg8::EpiRS, pg8::SplitK2Order, true, true>(lds, g, S, E, wv); }
#endif
        xcd_barrier(bar);
        }
                for (int rp_ = 0; rp_ < RP_E2; ++rp_) {
#if PH_E2
        { PH_BEGIN; for (int u = vcu; u < 256; u += G) att::cross_unit(lds, tid, u >> 7, (u >> 5) & 3, (u & 31) * 256, QX, XK, XVT, OX); }
#endif
        xcd_barrier(bar);
        }
        #if PH_E3
        { pg8::Gemm g{OX, WXO, M, 1024, 512, 512, nullptr}; pg8::StaticOrder S; S.init(M, 1024, G, bx);
          pg8::EpiRes E{XB, SSQ};
          pg8::gemm_phase<pg8::EpiRes, pg8::StaticOrder, true, true>(lds, g, S, E, wv); }
#endif
        xcd_barrier(bar);
                for (int rp_ = 0; rp_ < RP_F0A; ++rp_) {
#if PH_F0A
        { PH_BEGIN;
            typedef short bf16x8 __attribute__((ext_vector_type(8)));
            const GAS float* brg = INP(19) + l * 4; const GAS float* bre = INP(21) + l * 32;
            LAS float* part = (LAS float*)lds;
            const int rb = wave & 3, kh = wave >> 2, r16 = lane & 15, kq = lane >> 4;
            for (int grp = bx; grp < 256; grp += G) {
                const GAS bf16* xrow = XB + (size_t)(grp * 64 + 16 * rb + r16) * D + 512 * kh + 8 * kq;
                const GAS bf16* wh = WRH + (size_t)r16 * 1024 + 512 * kh + 8 * kq; const GAS bf16* wl = WRL + (size_t)r16 * 1024 + 512 * kh + 8 * kq;
                f32x4 acc[3];
#pragma unroll
                for (int cb = 0; cb < 3; ++cb) acc[cb] = (f32x4){0.f, 0.f, 0.f, 0.f};
#pragma unroll 8
                for (int st = 0; st < 16; ++st) {
                    const bf16x8 ah = *(const GAS bf16x8*)(xrow + 32 * st);
#pragma unroll
                    for (int cb = 0; cb < 3; ++cb) {
                        const bf16x8 bh = *(const GAS bf16x8*)(wh + (size_t)cb * 16 * 1024 + 32 * st), bl = *(const GAS bf16x8*)(wl + (size_t)cb * 16 * 1024 + 32 * st);
                        acc[cb] = __builtin_amdgcn_mfma_f32_16x16x32_bf16(ah, bh, acc[cb], 0, 0, 0);
                        acc[cb] = __builtin_amdgcn_mfma_f32_16x16x32_bf16(ah, bl, acc[cb], 0, 0, 0);
                    }
                }
                __syncthreads();
#pragma unroll
                for (int cb = 0; cb < 3; ++cb)
#pragma unroll
                    for (int r = 0; r < 4; ++r) part[(kh * 64 + 16 * rb + 4 * kq + r) * 49 + 16 * cb + r16] = acc[cb][r];
                __syncthreads();
                if (wave == 0) {
                    const int tok = grp * 64 + lane; const float rs = pg8::rstd_parts(SSQ, (unsigned)(tok * 16), 4, 1.f / 1024.f);
                    const LAS float* p0 = part + lane * 49; const LAS float* p1 = part + (64 + lane) * 49;
                    float gl[4];
#pragma unroll
                    for (int c = 0; c < 4; ++c) gl[c] = (p0[c] + p1[c]) * rs + brg[c];
                    int gs = 0; float gm = gl[0];
#pragma unroll
                    for (int c = 1; c < 4; ++c) if (gl[c] > gm) { gm = gl[c]; gs = c; }
                    float den = 0.f;
#pragma unroll
                    for (int c = 0; c < 4; ++c) den += expf(gl[c] - gm);
                    const float pg = 1.0f / den;
                    float el[8];
#pragma unroll
                    for (int j = 0; j < 8; ++j) el[j] = (p0[4 + gs * 8 + j] + p1[4 + gs * 8 + j]) * rs + bre[gs * 8 + j];
                    int i0 = 0; float v0 = el[0];
#pragma unroll
                    for (int j = 1; j < 8; ++j) if (el[j] > v0) { v0 = el[j]; i0 = j; }
                    int i1 = -1; float v1 = -INFINITY;
#pragma unroll
                    for (int j = 0; j < 8; ++j) if (j != i0 && el[j] > v1) { v1 = el[j]; i1 = j; }
                    const float e1 = expf(v1 - v0), w0 = pg / (1.f + e1), w1 = pg * e1 / (1.f + e1);
                    const int ea = gs * 8 + i0, eb = gs * 8 + i1;
                    TOKE[tok * 2] = ea; TOKE[tok * 2 + 1] = eb; TOKW[tok * 2] = w0; TOKW[tok * 2 + 1] = w1;
                    int mycnt = 0;
#pragma unroll 1
                    for (int e = 0; e < 32; ++e) { const int c = __popcll(__ballot(ea == e)) + __popcll(__ballot(eb == e)); if (lane == e) mycnt = c; }
                    if (lane < 32) HIST[grp * 32 + lane] = mycnt;
                }
            }
            __syncthreads();
        }
#endif
        xcd_barrier(bar);
        }
                for (int rp_ = 0; rp_ < RP_F0B; ++rp_) {
#if PH_F0B
        { PH_BEGIN;
            LAS int* cnt = (LAS int*)(lds + HIST_OFF);
            for (int grp = bx; grp < 256; grp += G) {
                __syncthreads();
                { const int e = tid & 31, ch = tid >> 5; int tot = 0, before = 0;
#pragma unroll
                  for (int j = 0; j < 16; ++j) { const int g2 = ch * 16 + j; const int hv = HIST[g2 * 32 + e]; tot += hv; before += (g2 < grp) ? hv : 0; }
                  cnt[128 + ch * 32 + e] = tot; cnt[640 + ch * 32 + e] = before; }
                __syncthreads();
                if (tid < 32) { int tot = 0, before = 0;
                    for (int ch = 0; ch < 16; ++ch) { tot += cnt[128 + ch * 32 + tid]; before += cnt[640 + ch * 32 + tid]; }
                    cnt[tid] = tot; cnt[32 + tid] = before; }
                __syncthreads();
                if (tid == 0) { int ts = 0; for (int e = 0; e < 32; ++e) { TSTART[e] = ts; ts += (cnt[e] + 255) >> 8; } TSTART[32] = ts; }
                __syncthreads();
                if (wave == 0) {
                    const int tok = grp * 64 + lane; const int ea = TOKE[tok * 2], eb = TOKE[tok * 2 + 1];
                    int ra = 0, rb = 0; const unsigned long long lt = (1ull << lane) - 1ull;
#pragma unroll 1
                    for (int e = 0; e < 32; ++e) { const unsigned long long ma = __ballot(ea == e), mb = __ballot(eb == e); const int c = __popcll((ma | mb) & lt); if (ea == e) ra = c; if (eb == e) rb = c; }
                    const int sa = TSTART[ea] * 256 + cnt[32 + ea] + ra, sb = TSTART[eb] * 256 + cnt[32 + eb] + rb;
                    const float rsd = pg8::rstd_parts(SSQ, (unsigned)(tok * 16), 4, 1.f / 1024.f);
                    SLOT[tok * 2] = sa; SLOT[tok * 2 + 1] = sb;
                    STOK[sa] = tok; STOK[sb] = tok; SW[sa] = TOKW[tok * 2]; SW[sb] = TOKW[tok * 2 + 1]; SRSTD[sa] = rsd; SRSTD[sb] = rsd;
                    MISC[16 + lane] = (unsigned)sa; MISC[80 + lane] = (unsigned)sb;
                }
                __syncthreads();
                if (grp < 32) { const int beg = TSTART[grp] * 256 + cnt[grp], end = TSTART[grp + 1] * 256;
                    for (int s = beg + tid; s < end; s += NTHREADS) { STOK[s] = 0; SW[s] = 0.f; SRSTD[s] = 0.f; } }
            }
            if (G > 256 || bx >= 256) {
                __syncthreads();
                if (tid < 32) { int tot = 0; for (int g2 = 0; g2 < 256; ++g2) tot += HIST[g2 * 32 + tid]; cnt[tid] = tot; }
                __syncthreads();
                if (tid == 0) { int ts = 0; for (int e = 0; e < 32; ++e) { TSTART[e] = ts; ts += (cnt[e] + 255) >> 8; } TSTART[32] = ts; }
            }
            __syncthreads();
        }
#endif
        xcd_barrier(bar);
        }
                for (int rp_ = 0; rp_ < RP_F1; ++rp_) {
#if PH_F1
        { pg8::Gemm g{XB, WGU, SROWS, 32 * 512, D, D, STOK}; pg8::MoeOrderP S{(const LAS int*)TSTART, (GAS unsigned*)(opqp(args.ws) + WS_CTL) + CW_F1 + l * 256, G, vcu};
          pg8::EpiAct E{ACT, SRSTD, SW};
          pg8::gemm_phase<pg8::EpiAct, pg8::MoeOrderP, true, true, true>(lds, g, S, E, wv); }
#endif
        }
                for (int rp_ = 0; rp_ < RP_F2; ++rp_) {
#if PH_F2
        { pg8::Gemm g{ACT, WD, SROWS, 32 * 1024, opq(256), opq(256), nullptr}; pg8::MoeOrderC S{(const LAS int*)TSTART, (const GAS unsigned*)(opqp(args.ws) + WS_CTL) + CW_F1 + l * 256, G, vcu, wv};
          pg8::EpiRS E{YB, 1024, nullptr, 0, 0.f, 1.f, 3, 31, 0};
          pg8::gemm_phase<pg8::EpiRS, pg8::MoeOrderC, true, true>(lds, g, S, E, wv); }
#endif
        xcd_barrier(bar);
        }
#if PH_F3
        { PH_BEGIN;
            const GAS float* g_fin = INP(25);
            int s0n = SLOT[gw * 2], s1n = SLOT[gw * 2 + 1];
            for (int m = gw; m < M; m += NGW) {
                GAS u32x2* xr = (GAS u32x2*)(XB + (size_t)m * D) + lane; const int s0 = s0n, s1 = s1n;
                if (m + NGW < M) { s0n = SLOT[(m + NGW) * 2]; s1n = SLOT[(m + NGW) * 2 + 1]; }
                const GAS u32x2* y0 = (const GAS u32x2*)(YB + (size_t)s0 * D) + lane; const GAS u32x2* y1 = (const GAS u32x2*)(YB + (size_t)s1 * D) + lane;
                f32x4 v[4]; float s = 0.f;
#pragma unroll
                for (int j = 0; j < 4; ++j) { const u32x2 a = y0[64 * j], b2 = y1[64 * j], xw = xr[64 * j];
                    v[j][0] = pg8::bflo(xw.x) + (pg8::bflo(a.x) + pg8::bflo(b2.x)); v[j][1] = pg8::bfhi(xw.x) + (pg8::bfhi(a.x) + pg8::bfhi(b2.x));
                    v[j][2] = pg8::bflo(xw.y) + (pg8::bflo(a.y) + pg8::bflo(b2.y)); v[j][3] = pg8::bfhi(xw.y) + (pg8::bfhi(a.y) + pg8::bfhi(b2.y));
                    s += (v[j][0] * v[j][0] + v[j][1] * v[j][1]) + (v[j][2] * v[j][2] + v[j][3] * v[j][3]); }
                s = wave_sum(s);
                if (l == DEPTH - 1) { const float rsd = 1.0f / sqrtf(s * (1.f / 1024.f) + 1e-6f); GAS f32x4* orow = (GAS f32x4*)(OUTP + (size_t)m * D) + lane;
#pragma unroll
                    for (int j = 0; j < 4; ++j) { const f32x4 gg = ((const GAS f32x4*)g_fin)[lane + 64 * j]; orow[64 * j] = v[j] * rsd * gg; }
                } else {
#pragma unroll
                    for (int j = 0; j < 4; ++j) { u32x2 w; w.x = pk2(v[j][0], v[j][1]); w.y = pk2(v[j][2], v[j][3]); xr[64 * j] = w; }
                    if (lane < 16) SSQ[(size_t)m * 16 + lane] = (lane == 0) ? s : 0.f;
                }
            }
        }
#endif
    }
}

extern "C" void kernel_launch(void* const* d_in, const int* in_sizes, int n_in, void* d_out, int out_size, void* d_ws, size_t ws_size, hipStream_t stream) {
    static int grid = 0;
    if (grid == 0) {
        if (n_in != 26 || in_sizes[0] != M * D || out_size != M * D || ws_size < WS_END) { fprintf(stderr, "kernel_launch: unexpected shapes (n_in %d, in0 %d, out %d, ws %zu < %zu)\n", n_in, n_in > 0 ? in_sizes[0] : -1, out_size, ws_size, (size_t)WS_END); grid = -1; return; }
        int dev = 0, cus = 0;
        if (hipGetDevice(&dev) != hipSuccess || hipDeviceGetAttribute(&cus, hipDeviceAttributeMultiprocessorCount, dev) != hipSuccess) { grid = -1; return; }
        if (hipFuncSetAttribute((const void*)fwd, hipFuncAttributeMaxDynamicSharedMemorySize, LDS_BYTES) != hipSuccess) { fprintf(stderr, "kernel_launch: hipFuncSetAttribute failed\n"); grid = -1; return; }
        int per_cu = 0;
        if (hipOccupancyMaxActiveBlocksPerMultiprocessor(&per_cu, (const void*)fwd, NTHREADS, LDS_BYTES) != hipSuccess || per_cu < 1) fprintf(stderr, "kernel_launch: occupancy query says %d\n", per_cu);
        (void)hipGetLastError();
        grid = cus < 256 ? (cus / 8) * 8 : 256;
    }
    if (grid <= 0) return;
    if (hipMemsetAsync((char*)d_ws + WS_CTL, 0, CTL_ZERO_BYTES, stream) != hipSuccess) return;
    Args a{};
    for (int i = 0; i < 26; ++i) a.in[i] = (const float*)d_in[i];
    a.out = (float*)d_out; a.ws = (unsigned char*)d_ws;
    hipLaunchKernelGGL(fwd, dim3(grid), dim3(NTHREADS), LDS_BYTES, stream, a);
}
```

```cpp
#include <hip/hip_runtime.h>
#include <cstdio>
#include <cstdint>
#define LAS __attribute__((address_space(3)))
#define GAS __attribute__((address_space(1)))
#ifndef PH_A
#define PH_A 1
#endif
#ifndef PH_B
#define PH_B 1
#endif
#ifndef PH_C
#define PH_C 1
#endif
#ifndef PH_D1
#define PH_D1 1
#endif
#ifndef PH_D2
#define PH_D2 1
#endif
#ifndef PH_E1
#define PH_E1 1
#endif
#ifndef PH_E2
#define PH_E2 1
#endif
#ifndef PH_E3
#define PH_E3 1
#endif
#ifndef PH_F0A
#define PH_F0A 1
#endif
#ifndef PH_F0B
#define PH_F0B 1
#endif
#ifndef PH_F1
#define PH_F1 1
#endif
#ifndef PH_F2
#define PH_F2 1
#endif
#ifndef PH_P0
#define PH_P0 1
#endif
#ifndef PH_F3
#define PH_F3 1
#endif
#ifndef PH_C_DIFF
#define PH_C_DIFF 1
#endif
#ifndef PH_C_SB
#define PH_C_SB 1
#endif
#ifndef PH_C_MLA
#define PH_C_MLA 1
#endif
#ifndef PH_B1
#define PH_B1 1
#endif
#ifndef PH_B2
#define PH_B2 1
#endif
#ifndef PH_B3
#define PH_B3 1
#endif
#ifndef RP_A
#define RP_A 1
#endif
#ifndef RP_B
#define RP_B 1
#endif
#ifndef RP_C
#define RP_C 1
#endif
#ifndef RP_D1
#define RP_D1 1
#endif
#ifndef RP_E1
#define RP_E1 1
#endif
#ifndef RP_E2
#define RP_E2 1
#endif
#ifndef RP_F0A
#define RP_F0A 1
#endif
#ifndef RP_F0B
#define RP_F0B 1
#endif
#ifndef RP_F1
#define RP_F1 1
#endif
#ifndef RP_F2
#define RP_F2 1
#endif
#ifndef RP_P0
#define RP_P0 1
#endif
#ifndef C_REP_MASK
#define C_REP_MASK 7
#endif
#ifndef A_ABL
#define A_ABL 0
#endif
#ifndef C_ABL
#define C_ABL 0
#endif
namespace pg8 {
#define PG8_LAS __attribute__((address_space(3)))
typedef unsigned short bf16_t;
typedef short bf16x8 __attribute__((ext_vector_type(8)));
typedef float f32x4 __attribute__((ext_vector_type(4)));
typedef unsigned u32x4 __attribute__((ext_vector_type(4)));
constexpr int BM = 256, BK = 64, HALF = 128, HTB = HALF * BK * 2  , STAGE_BYTES = 8 * HTB, NXCD = 8, WGM = 8;

__host__ __device__ __forceinline__ int lds_byte(int r, int c) { const int st = (r >> 4) * 2 + (c >> 5), rr = r & 15, cc = c & 31, ob = rr * 64 + cc * 2; return st * 1024 + (ob ^ (((ob >> 9) & 1) << 5)); }
__host__ __device__ __forceinline__ void stage_rc(int b, int& R, int& C) { const int st = b / 1024, sb = b % 1024, swz = sb ^ (((sb >> 9) & 1) << 5); R = (st >> 1) * 16 + swz / 64; C = (st & 1) * 32 + (swz % 64) / 2; }
__host__ __device__ __forceinline__ int perm32(int rho) { const int n = rho >> 4, i = rho & 15; return 8 * (i >> 2) + 4 * n + (i & 3); }

struct Unit { int pm, pn, sel; };
struct Gemm { const GAS bf16_t* A; const GAS bf16_t* Bt; int M, N, K, ld; const GAS int* rowidx; };

struct StaticOrder {
    int nM, nN, nwg, G, c;
    __host__ __device__ void init(int M, int N, int G_, int c_) { nM = M / BM; nN = N / BM; nwg = nM * nN; G = G_; c = c_; }
    __host__ __device__ bool next(int i, Unit& u) const {
        const long L = (long)i * G + c; if (L >= nwg) return false;
        int wgid = (int)L; { const int q = nwg / NXCD, r = nwg % NXCD, xcd = wgid % NXCD, off = wgid / NXCD; wgid = (xcd < r ? xcd * (q + 1) : r * (q + 1) + (xcd - r) * q) + off; }
        const int nig = WGM * nN, gid = wgid / nig, fm = gid * WGM, gsz = (nM - fm) < WGM ? (nM - fm) : WGM;
        u.pm = fm + ((wgid % nig) % gsz); u.pn = (wgid % nig) / gsz; u.sel = 0; return true;
    }
    __device__ __forceinline__ void a_ready(const Unit&) const {}
    __device__ __forceinline__ void done(const Unit&) const {}
    __device__ __forceinline__ size_t a_off(const Unit&) const { return 0; }
    __device__ __forceinline__ size_t b_off(const Unit&) const { return 0; }
    __device__ __forceinline__ bool keep(const Unit&) const { return false; }
};

__device__ __forceinline__ unsigned cvt_pk_bf16(float lo, float hi) { unsigned r; asm volatile("v_cvt_pk_bf16_f32 %0, %1, %2" : "=v"(r) : "v"(lo), "v"(hi)); return r; }
template <class T, class = void> struct HasScale { static constexpr bool v = false; };
template <class T> struct HasScale<T, decltype((void)T::SCALE)> { static constexpr bool v = true; };
template <class Epi, class Sched, bool ALIGN_EPI = false, bool SP2 = false, bool GATHER = false>
__device__ __forceinline__ void gemm_phase(PG8_LAS unsigned char* lds, const Gemm g, const Sched& S, const Epi& E, const int wave_idx) {
    int tid_; asm volatile("v_mbcnt_lo_u32_b32 %0, -1, 0\n\tv_mbcnt_hi_u32_b32 %0, -1, %0" : "=v"(tid_)); tid_ += wave_idx * 64;
    const int tid = tid_, wid = __builtin_amdgcn_readfirstlane(tid >> 6), lane = tid & 63, wr = wid >> 2, wc = wid & 3, fr = lane & 15, fq = lane >> 4;
    const int K = g.K, nt = K / BK, LD = g.ld;
    unsigned voffA[2], voffB[2];
#pragma unroll
    for (int i = 0; i < 2; ++i) { int R, C; stage_rc(tid * 16 + i * 8192, R, C); const int Rb = Epi::PERM ? ((R & ~31) + perm32(R & 31)) : R;
        voffA[i] = (unsigned)(R * LD + C) * 2u; voffB[i] = (unsigned)(Rb * LD + C) * 2u; }
    const size_t kstep = (size_t)(BK * 2);
    const size_t hstep = (size_t)HALF * LD * 2;
    const size_t tstep = 2 * hstep;
    const unsigned ldsw = (unsigned)wid * 1024u;
    const int aoff = lds_byte(wr * 64 + fr, fq * 8), boff = lds_byte(wc * 32 + fr, fq * 8);
#define PG8_SA(b, h) (((b) * 2 + (h)) * HTB)
#define PG8_SB(b, h) ((4 + (b) * 2 + (h)) * HTB)
#define PG8_STAGE(bufoff, gbase, voff) do { _Pragma("unroll") for (int _i = 0; _i < 2; ++_i) \
        __builtin_amdgcn_global_load_lds((const GAS unsigned*)((const GAS char*)(gbase) + (voff)[_i]), (PG8_LAS unsigned*)(lds + (bufoff) + ldsw + _i * 8192), 16, 0, 0); } while (0)
#define PG8_LDA(dst, b, h) do { _Pragma("unroll") for (int m = 0; m < 4; ++m) _Pragma("unroll") for (int k = 0; k < 2; ++k) dst[m][k] = *(const PG8_LAS bf16x8*)(lds + PG8_SA(b, h) + aoff + m * 2048 + k * 1024); } while (0)
#define PG8_LDB(dst, b, h) do { _Pragma("unroll") for (int n = 0; n < 2; ++n) _Pragma("unroll") for (int k = 0; k < 2; ++k) dst[n][k] = *(const PG8_LAS bf16x8*)(lds + PG8_SB(b, h) + boff + n * 2048 + k * 1024); } while (0)
#define PG8_MMA(ai, bj, At, Bt) do { __builtin_amdgcn_s_setprio(1); _Pragma("unroll") for (int m = 0; m < 4; ++m) _Pragma("unroll") for (int n = 0; n < 2; ++n) _Pragma("unroll") for (int k = 0; k < 2; ++k) \
        acc[ai][bj][m][n] = __builtin_amdgcn_mfma_f32_16x16x32_bf16(Bt[n][k], At[m][k], acc[ai][bj][m][n], 0, 0, 0); __builtin_amdgcn_s_setprio(0); } while (0)
#define PG8_WAIT_V(n) asm volatile("s_waitcnt vmcnt(" #n ")" ::: "memory")
#define PG8_WAIT_L(n) asm volatile("s_waitcnt lgkmcnt(" #n ")" ::: "memory")
#define PG8_BAR __builtin_amdgcn_s_barrier()
#define PG8_SCHED __builtin_amdgcn_sched_barrier(0)
    Unit cur, nxt; int ui = 0;
    if (!S.next(0, cur)) return;
    f32x4 acc[2][2][4][2];
#pragma unroll
    for (int a = 0; a < 2; ++a)
#pragma unroll
        for (int b = 0; b < 2; ++b)
#pragma unroll
            for (int m = 0; m < 4; ++m)
#pragma unroll
                for (int n = 0; n < 2; ++n) acc[a][b][m][n] = (f32x4){0.f, 0.f, 0.f, 0.f};
    bf16x8 At[4][2], B0[2][2], B1[2][2];
    const GAS char* cA = (const GAS char*)g.A + (GATHER ? (size_t)0 : (size_t)cur.pm * tstep + S.a_off(cur)); const GAS char* cB = (const GAS char*)g.Bt + (size_t)cur.pn * tstep + S.b_off(cur);
    unsigned vC[2][2], vN[2][2];
    if constexpr (GATHER) {
#pragma unroll
        for (int h = 0; h < 2; ++h)
#pragma unroll
            for (int i = 0; i < 2; ++i) { int R, C; stage_rc(tid * 16 + i * 8192, R, C); vC[h][i] = (unsigned)(g.rowidx[cur.pm * BM + h * HALF + R] * LD + C) * 2u; vN[h][i] = vC[h][i]; }
    }
#define PG8_STAGE_A(bufoff, gb, h, nx) do { if constexpr (GATHER) { unsigned vs_[2] = {(nx) ? vN[h][0] : vC[h][0], (nx) ? vN[h][1] : vC[h][1]}; PG8_STAGE(bufoff, gb, vs_); } \
        else { PG8_STAGE(bufoff, (gb) + (h) * hstep, voffA); } } while (0)
    S.a_ready(cur);
    if constexpr (SP2) {
        PG8_STAGE(PG8_SB(0, 0), cB, voffB); PG8_STAGE(PG8_SB(0, 1), cB + hstep, voffB); PG8_STAGE_A(PG8_SA(0, 0), cA, 0, false); PG8_STAGE_A(PG8_SA(0, 1), cA, 1, false);
        if (wr == 1) PG8_BAR;
        PG8_WAIT_V(2); PG8_BAR;
        PG8_STAGE(PG8_SB(1, 0), cB + kstep, voffB); PG8_STAGE_A(PG8_SA(1, 0), cA + kstep, 0, false); PG8_STAGE(PG8_SB(1, 1), cB + hstep + kstep, voffB);
        PG8_WAIT_V(6); PG8_BAR;
    } else {
        PG8_STAGE(PG8_SB(0, 0), cB, voffB); PG8_STAGE(PG8_SA(0, 0), cA, voffA); PG8_STAGE(PG8_SB(0, 1), cB + hstep, voffB); PG8_STAGE(PG8_SA(0, 1), cA + hstep, voffA);
        if (wr == 1) PG8_BAR;
        PG8_WAIT_V(4); PG8_BAR;
        PG8_STAGE(PG8_SB(1, 0), cB + kstep, voffB); PG8_STAGE(PG8_SA(1, 0), cA + kstep, voffA); PG8_STAGE(PG8_SB(1, 1), cB + hstep + kstep, voffB);
        PG8_WAIT_V(6); PG8_BAR;
    }
    for (;;) {
        const bool has_next = S.next(ui + 1, nxt);
        if constexpr (GATHER) { if (has_next) {
#pragma unroll
            for (int h = 0; h < 2; ++h)
#pragma unroll
                for (int i = 0; i < 2; ++i) { int R, C; stage_rc(tid * 16 + i * 8192, R, C); vN[h][i] = (unsigned)(g.rowidx[nxt.pm * BM + h * HALF + R] * LD + C) * 2u; } } }
        const GAS char* nA = GATHER ? cA : has_next ? (const GAS char*)g.A + (size_t)nxt.pm * tstep + S.a_off(nxt) : cA; const GAS char* nB = has_next ? (const GAS char*)g.Bt + (size_t)nxt.pn * tstep + S.b_off(nxt) : cB;
        for (int t = 0; t < nt; t += 2) {
            const bool last = (t == nt - 2);
            const GAS char* a1 = cA + (size_t)(t + 1) * kstep;
            const GAS char* a2 = last ? nA : cA + (size_t)(t + 2) * kstep; const GAS char* b2 = last ? nB : cB + (size_t)(t + 2) * kstep;
            const GAS char* a3 = a2 + kstep; const GAS char* b3 = b2 + kstep;
            if (last && has_next) S.a_ready(nxt);
            if constexpr (SP2) {
            PG8_LDB(B0, 0, 0); PG8_LDB(B1, 0, 1); PG8_SCHED; PG8_LDA(At, 0, 0); PG8_STAGE_A(PG8_SA(1, 1), a1, 1, false);
            PG8_WAIT_V(8); PG8_WAIT_L(0); PG8_BAR; PG8_MMA(0, 0, At, B0); PG8_MMA(0, 1, At, B1); PG8_BAR; PG8_SCHED;
            PG8_LDA(At, 0, 1); PG8_STAGE(PG8_SB(0, 0), b2, voffB); PG8_STAGE(PG8_SB(0, 1), b2 + hstep, voffB); PG8_STAGE_A(PG8_SA(0, 0), a2, 0, last);
            PG8_WAIT_V(8); PG8_WAIT_L(0); PG8_BAR; PG8_MMA(1, 0, At, B0); PG8_MMA(1, 1, At, B1); PG8_BAR; PG8_SCHED;
            PG8_LDB(B0, 1, 0); PG8_LDB(B1, 1, 1); PG8_SCHED; PG8_LDA(At, 1, 0); PG8_STAGE_A(PG8_SA(0, 1), a2, 1, last);
            PG8_WAIT_V(8); PG8_WAIT_L(0); PG8_BAR; PG8_MMA(0, 0, At, B0); PG8_MMA(0, 1, At, B1); PG8_BAR; PG8_SCHED;
            PG8_LDA(At, 1, 1); PG8_STAGE(PG8_SB(1, 0), b3, voffB); PG8_STAGE(PG8_SB(1, 1), b3 + hstep, voffB); PG8_STAGE_A(PG8_SA(1, 0), a3, 0, last);
            PG8_WAIT_V(8); PG8_WAIT_L(0); PG8_BAR; PG8_MMA(1, 0, At, B0); PG8_MMA(1, 1, At, B1); PG8_BAR; PG8_SCHED;
            } else {
            PG8_LDB(B0, 0, 0); PG8_SCHED; PG8_LDA(At, 0, 0); PG8_STAGE(PG8_SA(1, 1), a1 + hstep, voffA);
            PG8_WAIT_L(8); PG8_BAR; PG8_WAIT_L(0); PG8_MMA(0, 0, At, B0); PG8_BAR; PG8_SCHED;
            PG8_LDB(B1, 0, 1); PG8_STAGE(PG8_SB(0, 0), b2, voffB);
            PG8_BAR; PG8_WAIT_L(0); PG8_MMA(0, 1, At, B1); PG8_BAR;
            PG8_LDA(At, 0, 1); PG8_STAGE(PG8_SA(0, 0), a2, voffA);
            PG8_BAR; PG8_WAIT_L(0); PG8_MMA(1, 0, At, B0); PG8_BAR; PG8_SCHED;
            PG8_STAGE(PG8_SB(0, 1), b2 + hstep, voffB);
            PG8_WAIT_V(6); PG8_BAR; PG8_MMA(1, 1, At, B1); PG8_BAR;
            PG8_LDB(B0, 1, 0); PG8_SCHED; PG8_LDA(At, 1, 0); PG8_STAGE(PG8_SA(0, 1), a2 + hstep, voffA);
            PG8_WAIT_L(8); PG8_BAR; PG8_WAIT_L(0); PG8_MMA(0, 0, At, B0); PG8_BAR; PG8_SCHED;
            PG8_LDB(B1, 1, 1); PG8_STAGE(PG8_SB(1, 0), b3, voffB);
            PG8_BAR; PG8_WAIT_L(0); PG8_MMA(0, 1, At, B1); PG8_BAR;
            PG8_LDA(At, 1, 1); PG8_STAGE(PG8_SA(1, 0), a3, voffA);
            PG8_BAR; PG8_WAIT_L(0); PG8_MMA(1, 0, At, B0); PG8_BAR; PG8_SCHED;
            PG8_STAGE(PG8_SB(1, 1), b3 + hstep, voffB);
            PG8_WAIT_V(6); PG8_BAR; PG8_MMA(1, 1, At, B1); PG8_BAR;
            }
        }
        if constexpr (ALIGN_EPI) { if (wr == 0) PG8_BAR; }
        const int keep_ = (int)S.keep(cur);
        if constexpr (HasScale<Epi>::v) { if (keep_ == 2) E.scale(acc, cur, wr, wc, fr, fq); }
        if constexpr (!Epi::AFTER_DRAIN) { if (keep_ == 0) { E(acc, cur, wr, wc, fr, fq); S.done(cur); } }
        if (!has_next) break;
        if (keep_ == 0) {
#pragma unroll
        for (int a = 0; a < 2; ++a)
#pragma unroll
            for (int b = 0; b < 2; ++b)
#pragma unroll
                for (int m = 0; m < 4; ++m)
#pragma unroll
                    for (int n = 0; n < 2; ++n) acc[a][b][m][n] = (f32x4){0.f, 0.f, 0.f, 0.f}; }
        cur = nxt; cA = nA; cB = nB; ++ui;
        if constexpr (GATHER) { vC[0][0] = vN[0][0]; vC[0][1] = vN[0][1]; vC[1][0] = vN[1][0]; vC[1][1] = vN[1][1]; }
        if constexpr (ALIGN_EPI) { if (wr == 1) PG8_BAR; }
    }
    PG8_WAIT_V(0);
    if constexpr (!ALIGN_EPI) { if (wr == 0) PG8_BAR; }
    PG8_BAR;
    if constexpr (Epi::AFTER_DRAIN) { E.fused(acc, cur, wr, wc, fr, fq, lds, wid, lane); S.done(cur); }
#undef PG8_SA
#undef PG8_SB
#undef PG8_STAGE
#undef PG8_STAGE_A
#undef PG8_LDA
#undef PG8_LDB
#undef PG8_MMA
#undef PG8_WAIT_V
#undef PG8_WAIT_L
#undef PG8_BAR
#undef PG8_SCHED
}
typedef unsigned u32x2 __attribute__((ext_vector_type(2)));
typedef float f32x2v __attribute__((ext_vector_type(2)));
typedef __bf16 bf16x2v __attribute__((ext_vector_type(2)));
__device__ __forceinline__ unsigned pk2(float lo, float hi) { f32x2v v = {lo, hi}; bf16x2v b = __builtin_convertvector(v, bf16x2v); return __builtin_bit_cast(unsigned, b); }
__device__ __forceinline__ float bflo(unsigned w) { return __builtin_bit_cast(float, w << 16); }
__device__ __forceinline__ float bfhi(unsigned w) { return __builtin_bit_cast(float, w & 0xffff0000u); }
__device__ __forceinline__ float rstd_parts(const GAS float* base, unsigned eoff, int n4, float inv_n) {
    float s = 0.f; const GAS char* p = (const GAS char*)base + (size_t)(eoff * 4u);
    for (int i = 0; i < n4; ++i) { const f32x4 v = *(const GAS f32x4*)(p + 16 * i); s += (v[0] + v[1]) + (v[2] + v[3]); }
    return __builtin_amdgcn_rsqf(s * inv_n + 1e-6f);
}
__device__ __forceinline__ __amdgpu_buffer_rsrc_t wt_rsrc(GAS void* base) { return __builtin_amdgcn_make_buffer_rsrc((void*)base, 0, 0x7fffffff, 0x00020000); }
__device__ __forceinline__ void st16_wt(__amdgpu_buffer_rsrc_t r, unsigned byteoff, u32x4 v) { __builtin_amdgcn_raw_buffer_store_b128(v, r, byteoff, 0, 16); }
__device__ __forceinline__ float rows4_sum(float s) {
    const unsigned u = __builtin_bit_cast(unsigned, s);
    auto r = __builtin_amdgcn_permlane16_swap(u, u, false, false);
    const float t = __builtin_bit_cast(float, (unsigned)r[0]) + __builtin_bit_cast(float, (unsigned)r[1]);
    const unsigned v = __builtin_bit_cast(unsigned, t);
    auto q = __builtin_amdgcn_permlane32_swap(v, v, false, false);
    return __builtin_bit_cast(float, (unsigned)q[0]) + __builtin_bit_cast(float, (unsigned)q[1]);
}
__device__ __forceinline__ float rstd16_coop(const GAS float* base, unsigned row, int fq, float inv_n) {
    const f32x4 v = *(const GAS f32x4*)((const GAS char*)base + (size_t)((row * 16u + (unsigned)fq * 4u) * 4u));
    return __builtin_amdgcn_rsqf(rows4_sum((v[0] + v[1]) + (v[2] + v[3])) * inv_n + 1e-6f);
}
__device__ __forceinline__ void swap16(unsigned& a, unsigned& b) { auto r = __builtin_amdgcn_permlane16_swap(a, b, false, false); a = r[0]; b = r[1]; }
__device__ __forceinline__ int swz8(int fq) { return 8 * (((fq & 1) << 1) | (fq >> 1)); }
__device__ const double kRopeRev[16] = {0.15915494309189535, 0.08949940160889101, 0.050329212104487035, 0.0283021958306234, 0.015915494309189534, 0.008949940160889102, 0.005032921210448704, 0.00283021958306234,
                                        0.0015915494309189536, 0.0008949940160889102, 0.0005032921210448703, 0.00028302195830623395, 0.00015915494309189535, 8.949940160889102e-05, 5.0329212104487035e-05, 2.8302195830623396e-05};
__device__ __forceinline__ void rope_cs(int pos, int i, float& cs, float& sn) {
    double a = (double)pos * kRopeRev[i]; a -= __builtin_floor(a);
    const float r = (float)a; sn = __builtin_amdgcn_sinf(r); cs = __builtin_amdgcn_cosf(r);
}
#define PG8_L2E 1.4426950408889634f

struct EpiA {
    static constexpr bool PERM = false, AFTER_DRAIN = false;
    const GAS float* ssq; GAS bf16_t *cq, *ckv, *krope, *qk; GAS float *ssq_cq, *ssq_ckv; float c2; GAS unsigned* kn; int skip;
    __device__ __forceinline__ void operator()(const f32x4 (&acc)[2][2][4][2], const Unit& u, int wr, int wc, int fr, int fq) const {
        if (skip) return;
        const int pn = u.pn, row0 = u.pm * BM + wr * 64 + fr;
        float rs[2][4];
#pragma unroll
        for (int ai = 0; ai < 2; ++ai)
#pragma unroll
            for (int m = 0; m < 4; ++m) rs[ai][m] = rstd16_coop(ssq, (unsigned)(row0 + ai * HALF + m * 16), fq, 1.f / 1024.f);
        if (pn < 2) {
            GAS bf16_t* dst = pn == 0 ? cq : ckv; GAS float* sq = pn == 0 ? ssq_cq : ssq_ckv;
#pragma unroll
            for (int ai = 0; ai < 2; ++ai)
#pragma unroll
                for (int m = 0; m < 4; ++m) { const int row = row0 + ai * HALF + m * 16; const float r = rs[ai][m]; float s2 = 0.f;
#pragma unroll
                    for (int bj = 0; bj < 2; ++bj) { const f32x4 v = acc[ai][bj][m][0] * r, v2 = acc[ai][bj][m][1] * r;
                        s2 += ((v[0] * v[0] + v[1] * v[1]) + (v[2] * v[2] + v[3] * v[3])) + ((v2[0] * v2[0] + v2[1] * v2[1]) + (v2[2] * v2[2] + v2[3] * v2[3]));
                        unsigned wx = pk2(v[0], v[1]), wy = pk2(v[2], v[3]), wz = pk2(v2[0], v2[1]), ww = pk2(v2[2], v2[3]); swap16(wx, wz); swap16(wy, ww); const u32x4 w = {wx, wy, wz, ww};
                        *(GAS u32x4*)(dst + (size_t)row * 256 + bj * HALF + wc * 32 + swz8(fq)) = w; }
                    s2 = rows4_sum(s2);
                    if (fq == 0) sq[(size_t)row * 4 + wc] = s2; }
        } else if (pn == 2) {
            if (wc == 0) {
#pragma unroll
                for (int ai = 0; ai < 2; ++ai)
#pragma unroll
                    for (int m = 0; m < 4; ++m) { const int row = row0 + ai * HALF + m * 16, pos = row & 8191; const float r = rs[ai][m];
                        const f32x4 v0 = acc[ai][0][m][0] * r, v1 = acc[ai][0][m][1] * r; float o0[4], o1[4];
#pragma unroll
                        for (int e = 0; e < 4; ++e) { float cs, sn; rope_cs(pos, 4 * fq + e, cs, sn); o0[e] = v0[e] * cs - v1[e] * sn; o1[e] = v0[e] * sn + v1[e] * cs; }
                        u32x2 w0, w1; w0.x = pk2(o0[0], o0[1]); w0.y = pk2(o0[2], o0[3]); w1.x = pk2(o1[0], o1[1]); w1.y = pk2(o1[2], o1[3]);
                        *(GAS u32x2*)(krope + (size_t)row * 32 + 4 * fq) = w0; *(GAS u32x2*)(krope + (size_t)row * 32 + 16 + 4 * fq) = w1; }
            }
        } else {
            const int t = pn - 3, buf = t >> 1, half = t & 1; GAS bf16_t* dst = qk + (size_t)buf * 16384 * 512; const float sc = (buf & 1) ? 1.f : c2;
#pragma unroll
            for (int ai = 0; ai < 2; ++ai)
#pragma unroll
                for (int bj = 0; bj < 2; ++bj) { float kmx = 0.f;
#pragma unroll
                    for (int m = 0; m < 4; ++m) { const int row = row0 + ai * HALF + m * 16; const float r = rs[ai][m] * sc;
                        const f32x4 v = acc[ai][bj][m][0] * r, v2 = acc[ai][bj][m][1] * r;
                        const float s2 = ((v[0] * v[0] + v[1] * v[1]) + (v[2] * v[2] + v[3] * v[3])) + ((v2[0] * v2[0] + v2[1] * v2[1]) + (v2[2] * v2[2] + v2[3] * v2[3]));
                        unsigned wx = pk2(v[0], v[1]), wy = pk2(v[2], v[3]), wz = pk2(v2[0], v2[1]), ww = pk2(v2[2], v2[3]); swap16(wx, wz); swap16(wy, ww); const u32x4 w = {wx, wy, wz, ww};
                        *(GAS u32x4*)(dst + (size_t)row * 512 + half * 256 + bj * HALF + wc * 32 + swz8(fq)) = w;
                        kmx = fmaxf(kmx, s2); }
                    if (pn >= 9) {
                        float s = kmx; const float q1 = __shfl_xor(s, 16), q2 = __shfl_xor(s, 32), q3 = __shfl_xor(q1, 32); s = (s + q1) + (q2 + q3);
                        s = fmaxf(s, __shfl_xor(s, 1)); s = fmaxf(s, __shfl_xor(s, 2)); s = fmaxf(s, __shfl_xor(s, 4)); s = fmaxf(s, __shfl_xor(s, 8));
                        if ((fr | fq) == 0) __hip_atomic_fetch_max(kn + (((size_t)(4 * u.pm + 2 * ai + wr) * 8 + 4 * (pn - 9) + 2 * bj + (wc >> 1)) * 2 + (wc & 1)), __builtin_bit_cast(unsigned, s), __ATOMIC_RELAXED, __HIP_MEMORY_SCOPE_AGENT); } }
        }
    }
};
struct EpiVT {
    static constexpr bool PERM = true, AFTER_DRAIN = false;
    GAS bf16_t* out; int ld; const GAS float* ssq; int n4; float inv_n;
    __device__ __forceinline__ void operator()(const f32x4 (&acc)[2][2][4][2], const Unit& u, int wr, int wc, int fr, int fq) const {
        const int col0 = u.pn * BM + wc * 32 + 8 * fq, row0 = u.pm * BM + wr * 64 + fr;
        float cs[2][8];
        { const int ln = fq * 16 + fr;
          const float mine = rstd_parts(ssq, (unsigned)((u.pn * BM + wc * 32 + (ln >> 5) * HALF + ((ln >> 3) & 3) * 8 + (ln & 7)) * (4 * n4)), n4, inv_n);
#pragma unroll
          for (int bj = 0; bj < 2; ++bj)
#pragma unroll
            for (int j = 0; j < 8; ++j) cs[bj][j] = __shfl(mine, bj * 32 + fq * 8 + j); }
#pragma unroll
        for (int ai = 0; ai < 2; ++ai)
#pragma unroll
            for (int m = 0; m < 4; ++m) { GAS bf16_t* rowp = out + (size_t)(row0 + ai * HALF + m * 16) * ld + col0;
#pragma unroll
                for (int bj = 0; bj < 2; ++bj) { const f32x4 v0 = acc[ai][bj][m][0], v1 = acc[ai][bj][m][1]; u32x4 w;
                    w.x = pk2(v0[0] * cs[bj][0], v0[1] * cs[bj][1]); w.y = pk2(v0[2] * cs[bj][2], v0[3] * cs[bj][3]);
                    w.z = pk2(v1[0] * cs[bj][4], v1[1] * cs[bj][5]); w.w = pk2(v1[2] * cs[bj][6], v1[3] * cs[bj][7]);
                    *(GAS u32x4*)(rowp + bj * HALF) = w; } }
    }
};
struct EpiRS {
    static constexpr bool PERM = true, AFTER_DRAIN = false;
    GAS bf16_t* out; int ld; const GAS float* ssq; int n4; float inv_n; float scale; int pnmask; int pnshift; size_t zstride;
    __device__ __forceinline__ void operator()(const f32x4 (&acc)[2][2][4][2], const Unit& u, int wr, int wc, int fr, int fq) const {
        const int col0 = (u.pn & pnmask) * BM + wc * 32 + 8 * fq, row0 = u.pm * BM + wr * 64 + fr;
        float rr[2][4];
#pragma unroll
        for (int ai = 0; ai < 2; ++ai)
#pragma unroll
            for (int m = 0; m < 4; ++m) rr[ai][m] = (n4 ? rstd_parts(ssq, (unsigned)((row0 + ai * HALF + m * 16) * (4 * n4)), n4, inv_n) : 1.f) * scale;
#pragma unroll
        for (int ai = 0; ai < 2; ++ai)
#pragma unroll
            for (int m = 0; m < 4; ++m) { const int row = row0 + ai * HALF + m * 16; const float r = rr[ai][m];
                GAS bf16_t* rowp = out + (size_t)(u.pn >> pnshift) * zstride + (size_t)row * ld + col0;
#pragma unroll
                for (int bj = 0; bj < 2; ++bj) { const f32x4 v0 = acc[ai][bj][m][0] * r, v1 = acc[ai][bj][m][1] * r; u32x4 w;
                    w.x = pk2(v0[0], v0[1]); w.y = pk2(v0[2], v0[3]); w.z = pk2(v1[0], v1[1]); w.w = pk2(v1[2], v1[3]); *(GAS u32x4*)(rowp + bj * HALF) = w; } }
    }
};
struct EpiQ {
    static constexpr bool PERM = false, AFTER_DRAIN = false;
    GAS bf16_t* q; const GAS float* ssq_cq; float c2;
    __device__ __forceinline__ void operator()(const f32x4 (&acc)[2][2][4][2], const Unit& u, int wr, int wc, int fr, int fq) const {
        const int pn = u.pn, row0 = u.pm * BM + wr * 64 + fr;
        float rr[2][4];
#pragma unroll
        for (int ai = 0; ai < 2; ++ai)
#pragma unroll
            for (int m = 0; m < 4; ++m) rr[ai][m] = rstd_parts(ssq_cq, (unsigned)((row0 + ai * HALF + m * 16) * 4), 1, 1.f / 256.f) * c2;
#pragma unroll
        for (int ai = 0; ai < 2; ++ai)
#pragma unroll
            for (int m = 0; m < 4; ++m) { const int row = row0 + ai * HALF + m * 16; const float r = rr[ai][m];
                if (pn < 2) {
#pragma unroll
                    for (int bj = 0; bj < 2; ++bj) { const f32x4 v = acc[ai][bj][m][0] * r, v2 = acc[ai][bj][m][1] * r;
                        unsigned wx = pk2(v[0], v[1]), wy = pk2(v[2], v[3]), wz = pk2(v2[0], v2[1]), ww = pk2(v2[2], v2[3]); swap16(wx, wz); swap16(wy, ww); const u32x4 w = {wx, wy, wz, ww};
                        *(GAS u32x4*)(q + (size_t)row * 768 + pn * 256 + bj * HALF + wc * 32 + swz8(fq)) = w; }
                } else { const int pos = row & 8191; float cs[4], sn[4];
#pragma unroll
                    for (int e = 0; e < 4; ++e) rope_cs(pos, 4 * fq + e, cs[e], sn[e]);
#pragma unroll
                    for (int bj = 0; bj < 2; ++bj) { const f32x4 v0 = acc[ai][bj][m][0] * r, v1 = acc[ai][bj][m][1] * r; float o0[4], o1[4];
#pragma unroll
                        for (int e = 0; e < 4; ++e) { o0[e] = v0[e] * cs[e] - v1[e] * sn[e]; o1[e] = v0[e] * sn[e] + v1[e] * cs[e]; }
                        u32x2 w0, w1; w0.x = pk2(o0[0], o0[1]); w0.y = pk2(o0[2], o0[3]); w1.x = pk2(o1[0], o1[1]); w1.y = pk2(o1[2], o1[3]);
                        GAS bf16_t* p = q + (size_t)row * 768 + 512 + (4 * bj + wc) * 32 + 4 * fq; *(GAS u32x2*)p = w0; *(GAS u32x2*)(p + 16) = w1; }
                } }
    }
};
struct D1Order {
    StaticOrder so; size_t dA, dB;
    __device__ __forceinline__ bool next(int i, Unit& u) const { if (i >= 9) return false; if (!so.next(0, u)) return false; u.sel = i; return true; }
    __device__ __forceinline__ void a_ready(const Unit&) const {}
    __device__ __forceinline__ void done(const Unit&) const {}
    __device__ __forceinline__ size_t a_off(const Unit& u) const { const int z = u.sel - 6; return u.sel >= 6 ? dA + (size_t)(z >> 1) * 16384 * 2048 + (size_t)(z & 1) * 1024 : (size_t)(u.sel & 1) * 1024; }
    __device__ __forceinline__ size_t b_off(const Unit& u) const { const int z = u.sel - 6; return u.sel >= 6 ? dB + (size_t)(z >> 1) * 1024 * 2048 + (size_t)(z & 1) * 1024 : (size_t)(u.sel >> 1) * 1024 * 2048 + (size_t)(u.sel & 1) * 1024; }
    __device__ __forceinline__ int keep(const Unit& u) const { return u.sel < 6 ? ((u.sel & 1) ? 0 : 1) : (u.sel < 8 ? 2 : 0); }
};
struct EpiD1 {
    static constexpr bool PERM = true, AFTER_DRAIN = false, SCALE = true;
    GAS unsigned char* g; GAS bf16_t* mb; const GAS float* ssq;
    __device__ __forceinline__ void scale(f32x4 (&acc)[2][2][4][2], const Unit& u, int wr, int wc, int fr, int fq) const {
        const unsigned toff = (unsigned)(((wr * 4 + wc) * 64 + fq * 16 + fr) * 16), tile8 = (unsigned)(u.pm * 4 + u.pn) * 8u;
        const GAS unsigned char* ga = g + (size_t)((unsigned)(u.sel - 6) * 2048u + tile8) * 8192u + toff;
        const GAS unsigned char* gb = ga + (size_t)2048 * 8192;
#pragma unroll
        for (int ai = 0; ai < 2; ++ai) {
            u32x4 wa[2][2], wb[2][2];
#pragma unroll
            for (int bj = 0; bj < 2; ++bj)
#pragma unroll
                for (int mp = 0; mp < 2; ++mp) { wa[bj][mp] = *(const GAS u32x4*)(ga + ((ai * 2 + bj) * 2 + mp) * 8192); wb[bj][mp] = *(const GAS u32x4*)(gb + ((ai * 2 + bj) * 2 + mp) * 8192); }
#pragma unroll
            for (int bj = 0; bj < 2; ++bj)
#pragma unroll
                for (int mp = 0; mp < 2; ++mp)
#pragma unroll
                    for (int k = 0; k < 4; ++k) { const int m = 2 * mp + (k >> 1), n = k & 1; const unsigned qa = wa[bj][mp][k], qb = wb[bj][mp][k];
#pragma unroll
                        for (int e2 = 0; e2 < 4; ++e2) acc[ai][bj][m][n][e2] *= ((float)((qa >> (8 * e2)) & 0xffu) + 0.5f) * __builtin_amdgcn_rcpf((float)((qb >> (8 * e2)) & 0xffu) + 0.5f); }
        }
    }
    __device__ __forceinline__ void operator()(const f32x4 (&acc)[2][2][4][2], const Unit& u, int wr, int wc, int fr, int fq) const {
        const int col0 = u.pn * BM + wc * 32 + 8 * fq, row0 = u.pm * BM + wr * 64 + fr;
        const unsigned toff = (unsigned)(((wr * 4 + wc) * 64 + fq * 16 + fr) * 16), tile8 = (unsigned)(u.pm * 4 + u.pn) * 8u;
        if (u.sel < 6) {
            GAS unsigned char* gz = g + (size_t)((unsigned)(u.sel >> 1) * 2048u + tile8) * 8192u + toff;
            float rr[2][4];
#pragma unroll
            for (int ai = 0; ai < 2; ++ai)
#pragma unroll
                for (int m = 0; m < 4; ++m) rr[ai][m] = -PG8_L2E * rstd16_coop(ssq, (unsigned)(row0 + ai * HALF + m * 16), fq, 1.f / 1024.f);
#pragma unroll
            for (int ai = 0; ai < 2; ++ai)
#pragma unroll
                for (int bj = 0; bj < 2; ++bj)
#pragma unroll
                    for (int mp = 0; mp < 2; ++mp) { u32x4 w;
#pragma unroll
                        for (int k = 0; k < 4; ++k) { const int m = 2 * mp + (k >> 1), n = k & 1; const float r = rr[ai][m]; unsigned pk = 0u;
#pragma unroll
                            for (int e2 = 0; e2 < 4; ++e2) { const float sg = __builtin_amdgcn_rcpf(1.f + __builtin_amdgcn_exp2f(acc[ai][bj][m][n][e2] * r));
                                pk = __builtin_amdgcn_cvt_pk_u8_f32(fminf(sg * 256.f - 0.5f, 255.f), e2, pk); }
                            w[k] = pk; }
                        *(GAS u32x4*)(gz + ((ai * 2 + bj) * 2 + mp) * 8192) = w; }
        } else {
            const GAS unsigned char* ga = g + (size_t)(2u * 2048u + tile8) * 8192u + toff;
#pragma unroll
            for (int ai = 0; ai < 2; ++ai) {
                u32x4 wa[2][2];
#pragma unroll
                for (int bj = 0; bj < 2; ++bj)
#pragma unroll
                    for (int mp = 0; mp < 2; ++mp) wa[bj][mp] = *(const GAS u32x4*)(ga + ((ai * 2 + bj) * 2 + mp) * 8192);
#pragma unroll
                for (int m = 0; m < 4; ++m)
#pragma unroll
                    for (int bj = 0; bj < 2; ++bj) { const size_t o = (size_t)(row0 + ai * HALF + m * 16) * 1024 + col0 + bj * HALF; float v[8];
#pragma unroll
                        for (int j = 0; j < 8; ++j) { const unsigned qa = wa[bj][m >> 1][(m & 1) * 2 + (j >> 2)];
                            v[j] = acc[ai][bj][m][j >> 2][j & 3] * (((float)((qa >> (8 * (j & 3))) & 0xffu) + 0.5f) * (1.f / 256.f)); }
                        u32x4 w; w.x = pk2(v[0], v[1]); w.y = pk2(v[2], v[3]); w.z = pk2(v[4], v[5]); w.w = pk2(v[6], v[7]); *(GAS u32x4*)(mb + o) = w; } }
        }
    }
};
struct EpiRes {
    static constexpr bool PERM = true, AFTER_DRAIN = false;
    GAS bf16_t* xb; GAS float* ssq;
    __device__ __forceinline__ void operator()(const f32x4 (&acc)[2][2][4][2], const Unit& u, int wr, int wc, int fr, int fq) const {
        const int col0 = u.pn * BM + wc * 32 + 8 * fq, row0 = u.pm * BM + wr * 64 + fr;
#pragma unroll
        for (int ai = 0; ai < 2; ++ai) {
            u32x4 xv[4][2];
#pragma unroll
            for (int m = 0; m < 4; ++m)
#pragma unroll
                for (int bj = 0; bj < 2; ++bj) xv[m][bj] = *(const GAS u32x4*)(xb + (size_t)(row0 + ai * HALF + m * 16) * 1024 + col0 + bj * HALF);
#pragma unroll
            for (int m = 0; m < 4; ++m) { const int row = row0 + ai * HALF + m * 16; const size_t rb = (size_t)row * 1024 + col0; float s2 = 0.f;
#pragma unroll
                for (int bj = 0; bj < 2; ++bj) { const u32x4 xw = xv[m][bj]; const f32x4 a0 = acc[ai][bj][m][0], a1 = acc[ai][bj][m][1];
                    const float v0 = bflo(xw.x) + a0[0], v1 = bfhi(xw.x) + a0[1], v2 = bflo(xw.y) + a0[2], v3 = bfhi(xw.y) + a0[3];
                    const float v4 = bflo(xw.z) + a1[0], v5 = bfhi(xw.z) + a1[1], v6 = bflo(xw.w) + a1[2], v7 = bfhi(xw.w) + a1[3];
                    u32x4 w; w.x = pk2(v0, v1); w.y = pk2(v2, v3); w.z = pk2(v4, v5); w.w = pk2(v6, v7);
                    *(GAS u32x4*)(xb + rb + bj * HALF) = w;
                    s2 += ((v0 * v0 + v1 * v1) + (v2 * v2 + v3 * v3)) + ((v4 * v4 + v5 * v5) + (v6 * v6 + v7 * v7)); }
                s2 += __shfl_xor(s2, 16); s2 += __shfl_xor(s2, 32);
                if (fq == 0) ssq[(size_t)row * 16 + u.pn * 4 + wc] = s2; } }
    }
};
struct EpiAct {
    static constexpr bool PERM = true, AFTER_DRAIN = false;
    GAS bf16_t* act; const GAS float* s_rstd; const GAS float* s_w;
    __device__ __forceinline__ void operator()(const f32x4 (&acc)[2][2][4][2], const Unit& u, int wr, int wc, int fr, int fq) const {
        const int t = u.pn & 1, row0 = u.pm * BM + wr * 64 + fr;
        const __amdgpu_buffer_rsrc_t rsrc = __builtin_amdgcn_make_buffer_rsrc((void*)act, 0, 40960 * 256 * 2, 0x00020000);
        float rr[2][4], ww[2][4];
#pragma unroll
        for (int ai = 0; ai < 2; ++ai)
#pragma unroll
            for (int m = 0; m < 4; ++m) { rr[ai][m] = s_rstd[row0 + ai * HALF + m * 16]; ww[ai][m] = s_w[row0 + ai * HALF + m * 16]; }
#pragma unroll
        for (int ai = 0; ai < 2; ++ai)
#pragma unroll
            for (int m = 0; m < 4; ++m) { const int row = row0 + ai * HALF + m * 16; const float rs = rr[ai][m], w = ww[ai][m]; float o[8];
#pragma unroll
                for (int j = 0; j < 8; ++j) { const float a = acc[ai][0][m][j >> 2][j & 3] * rs, b = acc[ai][1][m][j >> 2][j & 3] * rs;
                    const float v = a * __builtin_amdgcn_rcpf(1.f + __builtin_amdgcn_exp2f(-PG8_L2E * a)) * b * w; o[j] = (w != 0.f) ? v : 0.f; }
                u32x4 pw; pw.x = pk2(o[0], o[1]); pw.y = pk2(o[2], o[3]); pw.z = pk2(o[4], o[5]); pw.w = pk2(o[6], o[7]);
                __builtin_amdgcn_raw_buffer_store_b128(pw, rsrc, (unsigned)(row * 256 + t * 128 + wc * 32 + 8 * fq) * 2u, 0,   16); }
    }
};
struct SplitK2Order {
    StaticOrder so; size_t tstep;
    __device__ __forceinline__ bool next(int i, Unit& u) const { return so.next(i, u); }
    __device__ __forceinline__ void a_ready(const Unit&) const {}
    __device__ __forceinline__ void done(const Unit&) const {}
    __device__ __forceinline__ size_t a_off(const Unit& u) const { return (size_t)(u.pn >> 1) * 1024; }
    __device__ __forceinline__ size_t b_off(const Unit& u) const { return (size_t)(u.pn >> 1) * 1024 - (size_t)(u.pn >> 1) * 2 * tstep; }
    __device__ __forceinline__ bool keep(const Unit&) const { return false; }
};
struct MoeOrder {
    const PG8_LAS int* tstart; int per, G, v;
    __device__ __forceinline__ bool next(int i, Unit& u) const {
        const int idx = i * G + v, tot = tstart[32] * per; if (idx >= tot) return false;
        const int ti = idx / per, ct = idx - ti * per; int e = 0;
#pragma unroll 1
        for (int k = 1; k < 32; ++k) e += (tstart[k] <= ti) ? 1 : 0;
        u.pm = ti; u.pn = e * per + ct; u.sel = 0; return true;
    }
    __device__ __forceinline__ void a_ready(const Unit&) const {}
    __device__ __forceinline__ void done(const Unit&) const {}
    __device__ __forceinline__ size_t a_off(const Unit&) const { return 0; }
    __device__ __forceinline__ size_t b_off(const Unit&) const { return 0; }
    __device__ __forceinline__ bool keep(const Unit&) const { return false; }
};
struct MoeOrderP {
    const PG8_LAS int* tstart; GAS unsigned* cnt; int G, v;
    __device__ __forceinline__ bool next(int i, Unit& u) const {
        const int idx = i * G + v, tot = tstart[32] * 2; if (idx >= tot) return false;
        const int ti = idx >> 1, ct = idx & 1; int e = 0;
#pragma unroll 1
        for (int k = 1; k < 32; ++k) e += (tstart[k] <= ti) ? 1 : 0;
        u.pm = ti; u.pn = e * 2 + ct; u.sel = 0; return true;
    }
    __device__ __forceinline__ void a_ready(const Unit&) const {}
    __device__ __forceinline__ void done(const Unit& u) const {
        asm volatile("s_waitcnt vmcnt(0)" ::: "memory");
        int ln; asm volatile("v_mbcnt_lo_u32_b32 %0, -1, 0\n\tv_mbcnt_hi_u32_b32 %0, -1, %0" : "=v"(ln));
        if (ln == 0) __hip_atomic_fetch_add(cnt + u.pm, 1u, __ATOMIC_RELAXED, __HIP_MEMORY_SCOPE_AGENT);
    }
    __device__ __forceinline__ size_t a_off(const Unit&) const { return 0; }
    __device__ __forceinline__ size_t b_off(const Unit&) const { return 0; }
    __device__ __forceinline__ bool keep(const Unit&) const { return false; }
};
struct MoeOrderC {
    const PG8_LAS int* tstart; const GAS unsigned* cnt; int G, v, wid;
    __device__ __forceinline__ bool next(int i, Unit& u) const {
        const int T = tstart[32], L = (2 * T > G) ? 2 * T - G : 0, R = G - L;
        const int idx = (v >= L) ? ((i < 2) ? i * R + (v - L) : 2 * R + (i - 2) * G + v) : 2 * R + i * G + v;
        if (idx >= 4 * T) return false;
        const int ti = idx >> 2, ct = idx & 3; int e = 0;
#pragma unroll 1
        for (int k = 1; k < 32; ++k) e += (tstart[k] <= ti) ? 1 : 0;
        u.pm = ti; u.pn = e * 4 + ct; u.sel = 0; return true;
    }
    __device__ __forceinline__ void a_ready(const Unit& u) const {
        if (wid == 0) {
            const GAS unsigned* c = cnt + u.pm; int spins = 0;
#pragma unroll 1
            while ((unsigned)__builtin_amdgcn_readfirstlane(__hip_atomic_load(c, __ATOMIC_RELAXED, __HIP_MEMORY_SCOPE_AGENT)) < 16u && ++spins < (1 << 22)) __builtin_amdgcn_s_sleep(2);
            __builtin_amdgcn_fence(__ATOMIC_ACQUIRE, "agent");
            asm volatile("s_waitcnt vmcnt(0)" ::: "memory");
        }
        __builtin_amdgcn_s_barrier();
    }
    __device__ __forceinline__ void done(const Unit&) const {}
    __device__ __forceinline__ size_t a_off(const Unit&) const { return 0; }
    __device__ __forceinline__ size_t b_off(const Unit&) const { return 0; }
    __device__ __forceinline__ bool keep(const Unit&) const { return false; }
};
}
namespace att {
typedef unsigned short bf16;
typedef short bf16x8 __attribute__((ext_vector_type(8)));
typedef short s16x4 __attribute__((ext_vector_type(4)));
typedef float f32x16 __attribute__((ext_vector_type(16)));
typedef float f32x4 __attribute__((ext_vector_type(4)));
typedef unsigned u32x4 __attribute__((ext_vector_type(4)));
typedef unsigned u32x2 __attribute__((ext_vector_type(2)));
typedef float f32x2v __attribute__((ext_vector_type(2)));
typedef __bf16 bf16x2v __attribute__((ext_vector_type(2)));
__device__ __forceinline__ unsigned pk2(float lo, float hi) { f32x2v v = {lo, hi}; bf16x2v b = __builtin_convertvector(v, bf16x2v); return __builtin_bit_cast(unsigned, b); }
__device__ __forceinline__ float bflo(unsigned w) { return __builtin_bit_cast(float, w << 16); }
__device__ __forceinline__ float bfhi(unsigned w) { return __builtin_bit_cast(float, w & 0xffff0000u); }
__device__ __forceinline__ int crow(int r, int hi) { return (r & 3) + 8 * (r >> 2) + 4 * hi; }
__device__ __forceinline__ float xhalf(float v) {
    const unsigned u = __builtin_bit_cast(unsigned, v);
    auto rr = __builtin_amdgcn_permlane32_swap(u, u, false, false);
    const unsigned o = (rr[0] != u) ? rr[0] : rr[1];
    return __builtin_bit_cast(float, o);
}
__device__ __forceinline__ bf16x8 mk8(unsigned a, unsigned b, unsigned c, unsigned d) { u32x4 w = {a, b, c, d}; return __builtin_bit_cast(bf16x8, w); }

constexpr int VPB = 144;
template <int DK> struct KLay { static constexpr int KPB = (DK + 8) * 2, KBUF = 64 * KPB; };

template <int DK, int DV, bool KROPE> struct Stage {
    static constexpr int NK = KROPE ? 1 : DK / 64, NV = DV / 64;
    u32x4 kr[NK]; u32x4 kr2; u32x4 vr[NV];
    __device__ __forceinline__ void loadK(int tid, const GAS bf16* Kg, int ldk, const GAS bf16* K2g, int kv0) {
        const GAS char* kbase = (const GAS char*)(Kg + (size_t)kv0 * ldk);
        if constexpr (KROPE) {
            kr[0] = *(const GAS u32x4*)(kbase + (unsigned)(((tid >> 3) * ldk + 8 * (tid & 7)) * 2));
            if (tid < 256) kr2 = *(const GAS u32x4*)((const GAS char*)(K2g + (size_t)kv0 * 32) + (unsigned)(tid * 16));
        } else {
#pragma unroll
            for (int i = 0; i < NK; ++i) { const int p = tid + 512 * i, row = p / (DK / 8), ch = p % (DK / 8); kr[i] = *(const GAS u32x4*)(kbase + (unsigned)((row * ldk + 8 * ch) * 2)); }
        }
    }
    __device__ __forceinline__ void loadV(int tid, const GAS bf16* Vg, int ldv, int kv0) {
        const GAS char* vbase = (const GAS char*)(Vg + kv0);
#pragma unroll
        for (int i = 0; i < NV; ++i) { const int p = tid + 512 * i, dd = p >> 3, ch = p & 7; vr[i] = *(const GAS u32x4*)(vbase + (unsigned)((dd * ldv + 8 * ch) * 2)); }
    }
    __device__ __forceinline__ void storeK(int tid, LAS unsigned char* kb) const {
        constexpr int KPB = KLay<DK>::KPB;
        if constexpr (KROPE) {
            *(LAS u32x4*)(kb + (tid >> 3) * KPB + 16 * (tid & 7)) = kr[0];
            if (tid < 256) *(LAS u32x4*)(kb + (tid >> 2) * KPB + 128 + 16 * (tid & 3)) = kr2;
        } else {
#pragma unroll
            for (int i = 0; i < NK; ++i) { const int p = tid + 512 * i, row = p / (DK / 8), ch = p % (DK / 8); *(LAS u32x4*)(kb + row * KPB + 16 * ch) = kr[i]; }
        }
    }
    __device__ __forceinline__ void storeV(int tid, LAS unsigned char* vb) const {
#pragma unroll
        for (int i = 0; i < NV; ++i) { const int p = tid + 512 * i, dd = p >> 3, ch = p & 7; LAS unsigned char* q = vb + dd * VPB + 32 * (ch >> 1) + 8 * (ch & 1);
            *(LAS u32x2*)q = (u32x2){vr[i].x, vr[i].y}; *(LAS u32x2*)(q + 16) = (u32x2){vr[i].z, vr[i].w}; }
    }
    __device__ __forceinline__ void load(int tid, const GAS bf16* Kg, int ldk, const GAS bf16* K2g, const GAS bf16* Vg, int ldv, int kv0) { loadK(tid, Kg, ldk, K2g, kv0); loadV(tid, Vg, ldv, kv0); }
    __device__ __forceinline__ void store(int tid, LAS unsigned char* kb, LAS unsigned char* vb) const { storeK(tid, kb); storeV(tid, vb); }
};

template <int DK> __device__ __forceinline__ void qkt(f32x16& p0, f32x16& p1, const LAS unsigned char* kb, const bf16x8 (&qf)[DK / 16], int r32, int hi) {
    constexpr int KPB = KLay<DK>::KPB;
    const LAS unsigned char* k0 = kb + r32 * KPB + hi * 16;
#pragma unroll
    for (int d0 = 0; d0 < DK / 16; ++d0) {
        const bf16x8 a0 = *(const LAS bf16x8*)(k0 + d0 * 32), a1 = *(const LAS bf16x8*)(k0 + 32 * KPB + d0 * 32);
        p0 = __builtin_amdgcn_mfma_f32_32x32x16_bf16(a0, qf[d0], p0, 0, 0, 0);
        p1 = __builtin_amdgcn_mfma_f32_32x32x16_bf16(a1, qf[d0], p1, 0, 0, 0);
    }
}
template <int DK> __device__ __forceinline__ void qkt_qmem(f32x16& p0, f32x16& p1, const LAS unsigned char* kb, const bf16x8* qf, const LAS unsigned char* qlds, int r32, int hi) {
    constexpr int KPB = KLay<DK>::KPB, QR = DK / 32;
    const LAS unsigned char* k0 = kb + r32 * KPB + hi * 16;
#pragma unroll
    for (int d0 = 0; d0 < DK / 16; ++d0) {
        bf16x8 q; if (d0 < QR) q = qf[d0]; else q = *(const LAS bf16x8*)(qlds + (d0 - QR) * 1024);
        const bf16x8 a0 = *(const LAS bf16x8*)(k0 + d0 * 32), a1 = *(const LAS bf16x8*)(k0 + 32 * KPB + d0 * 32);
        p0 = __builtin_amdgcn_mfma_f32_32x32x16_bf16(a0, q, p0, 0, 0, 0);
        p1 = __builtin_amdgcn_mfma_f32_32x32x16_bf16(a1, q, p1, 0, 0, 0);
        if ((d0 & 3) == 3) __builtin_amdgcn_sched_barrier(0);
    }
}
template <int DV> __device__ __forceinline__ void pv(f32x16 (&o)[DV / 32], const LAS unsigned char* vb, const bf16x8 (&pf)[4], int r32, int hi) {
#pragma unroll
    for (int db = 0; db < DV / 32; ++db) {
        const LAS unsigned char* v0 = vb + (32 * db + r32) * VPB + 16 * hi;
#pragma unroll
        for (int s = 0; s < 4; ++s) {
            const bf16x8 vf = *(const LAS bf16x8*)(v0 + 32 * s);
            o[db] = __builtin_amdgcn_mfma_f32_32x32x16_bf16(vf, pf[s], o[db], 0, 0, 0);
        }
        if (DV > 64) __builtin_amdgcn_sched_barrier(0);
    }
}
__device__ __forceinline__ void pack_p(bf16x8 (&pf)[4], const f32x16& p0, const f32x16& p1) {
    pf[0] = mk8(pk2(p0[0], p0[1]), pk2(p0[2], p0[3]), pk2(p0[4], p0[5]), pk2(p0[6], p0[7]));
    pf[1] = mk8(pk2(p0[8], p0[9]), pk2(p0[10], p0[11]), pk2(p0[12], p0[13]), pk2(p0[14], p0[15]));
    pf[2] = mk8(pk2(p1[0], p1[1]), pk2(p1[2], p1[3]), pk2(p1[4], p1[5]), pk2(p1[6], p1[7]));
    pf[3] = mk8(pk2(p1[8], p1[9]), pk2(p1[10], p1[11]), pk2(p1[12], p1[13]), pk2(p1[14], p1[15]));
}

template <bool ALIBI> __device__ __forceinline__ void fl_init(f32x16& p0, f32x16& p1, float slope2, int kv0, int hi, int qrow) {
    if (ALIBI) {
        const float s2 = slope2 + slope2, s4 = s2 + s2, s8 = s4 + s4, s32 = (s8 + s8) + (s8 + s8);
        float g = slope2 * (float)(kv0 + 4 * hi - qrow);
#pragma unroll
        for (int c = 0; c < 4; ++c) { float v = g;
#pragma unroll
            for (int e = 0; e < 4; ++e) { p0[4 * c + e] = v; p1[4 * c + e] = v + s32; v += slope2; }
            g += s8; } }
    else {
#pragma unroll
        for (int r = 0; r < 16; ++r) { p0[r] = 0.f; p1[r] = 0.f; } }
}
__device__ __forceinline__ void fl_mask(f32x16& p0, f32x16& p1, int kv0, int hi, int qrow) {
    const int thr = qrow - kv0 - 4 * hi;
#pragma unroll
    for (int r = 0; r < 16; ++r) { const int c = (r & 3) + 8 * (r >> 2); if (c > thr) p0[r] = -INFINITY; if (c + 32 > thr) p1[r] = -INFINITY; }
}
__device__ __forceinline__ void fl_start(const f32x16& p0, const f32x16& p1, float& m, float& alpha) {
    float mx = fmaxf(p0[0], p1[0]);
#pragma unroll
    for (int r = 1; r < 16; ++r) mx = fmaxf(fmaxf(mx, p0[r]), p1[r]);
    mx = fmaxf(mx, xhalf(mx));
    const float mn = fmaxf(m, mx); alpha = __builtin_amdgcn_exp2f(m - mn); m = mn;
}
__device__ __forceinline__ void fl_finish(f32x16& p0, f32x16& p1, float m, float& l, bf16x8 (&pf)[4]) {
    float s0 = 0.f, s1 = 0.f;
#pragma unroll
    for (int r = 0; r < 16; ++r) { p0[r] = __builtin_amdgcn_exp2f(p0[r] - m); p1[r] = __builtin_amdgcn_exp2f(p1[r] - m); s0 += p0[r]; s1 += p1[r]; }
    l += s0 + s1;
    pack_p(pf, p0, p1);
}

#define FL_EL(P0, P1, e) ((e) < 16 ? P0[(e) & 15] : P1[(e) & 15])
template <int DK, bool QMEM> __device__ __forceinline__ void fl_blockX(f32x16& n0, f32x16& n1, const LAS unsigned char* kb, const bf16x8* qf, const LAS unsigned char* qlds, int r32, int hi,
                                                                         f32x16& c0, f32x16& c1, float m, float& l, bf16x8 (&pf)[4]) {
    constexpr int KPB = KLay<DK>::KPB, NS = DK / 16, CH = ((32 + NS - 1) / NS + 1) & ~1;
    const LAS unsigned char* k0 = kb + r32 * KPB + hi * 16;
    float s0 = 0.f, s1 = 0.f; unsigned pw[16];
#define FLX_K0(s) (*(const LAS bf16x8*)(k0 + ((s) < NS ? (s) : NS - 1) * 32))
#define FLX_K1(s) (*(const LAS bf16x8*)(k0 + 32 * KPB + ((s) < NS ? (s) : NS - 1) * 32))
    bf16x8 a0 = FLX_K0(0), a1 = FLX_K1(0), b0 = FLX_K0(1), b1 = FLX_K1(1), e0 = FLX_K0(2), e1 = FLX_K1(2);
    bf16x8 q, qb, qe; if constexpr (QMEM) { q = *(const LAS bf16x8*)(qlds); qb = *(const LAS bf16x8*)(qlds + (NS > 1 ? 1024 : 0)); qe = *(const LAS bf16x8*)(qlds + (NS > 2 ? 2048 : 0)); } else { q = qf[0]; qb = qf[NS > 1 ? 1 : 0]; qe = qf[NS > 2 ? 2 : 0]; }
#pragma unroll
    for (int d0 = 0; d0 < NS; ++d0) {
        bf16x8 c0n = e0, c1n = e1, qc = qe;
        if (d0 + 3 < NS) { c0n = FLX_K0(d0 + 3); c1n = FLX_K1(d0 + 3);
            if constexpr (QMEM) qc = *(const LAS bf16x8*)(qlds + (d0 + 3) * 1024); else qc = qf[d0 + 3]; }
        n0 = __builtin_amdgcn_mfma_f32_32x32x16_bf16(a0, q, n0, 0, 0, 0);
        n1 = __builtin_amdgcn_mfma_f32_32x32x16_bf16(a1, q, n1, 0, 0, 0);
#pragma unroll
        for (int e = d0 * CH; e < (d0 + 1) * CH && e < 32; e += 2) {
            float x, y;
            if (e < 16) { x = __builtin_amdgcn_exp2f(c0[e] - m); y = __builtin_amdgcn_exp2f(c0[e + 1] - m); s0 += x; s1 += y; }
            else { x = __builtin_amdgcn_exp2f(c1[e - 16] - m); y = __builtin_amdgcn_exp2f(c1[e - 15] - m); s0 += x; s1 += y; }
            pw[e >> 1] = pk2(x, y); asm volatile("" : "+v"(pw[e >> 1])); }
        asm volatile("" : "+v"(s0), "+v"(s1));
        __builtin_amdgcn_sched_barrier(0);
        a0 = b0; a1 = b1; q = qb; b0 = e0; b1 = e1; qb = qe; e0 = c0n; e1 = c1n; qe = qc;
    }
#undef FLX_K0
#undef FLX_K1
    l += s0 + s1;
    pf[0] = mk8(pw[0], pw[1], pw[2], pw[3]); pf[1] = mk8(pw[4], pw[5], pw[6], pw[7]); pf[2] = mk8(pw[8], pw[9], pw[10], pw[11]); pf[3] = mk8(pw[12], pw[13], pw[14], pw[15]);
}
template <int DV> __device__ __forceinline__ void fl_blockY(f32x16 (&o)[DV / 32], const LAS unsigned char* vb, const bf16x8 (&pf)[4], int r32, int hi, const f32x16& n0, const f32x16& n1, float& m, float& alpha) {
    constexpr int NS = DV / 8, CH = 32 / NS;
    float mx0 = -INFINITY, mx1 = -INFINITY;
    const LAS unsigned char* v0 = vb + r32 * VPB + 16 * hi;
    bf16x8 vf = *(const LAS bf16x8*)(v0), vg = *(const LAS bf16x8*)(v0 + 32);
#pragma unroll
    for (int st = 0; st < NS; ++st) {
        const int db = st >> 2, s = st & 3;
        bf16x8 vn = vg;
        if (st + 2 < NS) vn = *(const LAS bf16x8*)(v0 + ((st + 2) >> 2) * 32 * VPB + 32 * ((st + 2) & 3));
        o[db] = __builtin_amdgcn_mfma_f32_32x32x16_bf16(vf, pf[s], o[db], 0, 0, 0);
#pragma unroll
        for (int e = st * CH; e < (st + 1) * CH; ++e) { if (e < 16) mx0 = fmaxf(mx0, n0[e]); else mx1 = fmaxf(mx1, n1[e - 16]); }
        asm volatile("" : "+v"(mx0), "+v"(mx1));
        __builtin_amdgcn_sched_barrier(0);
        vf = vg; vg = vn;
    }
    float mx = fmaxf(mx0, mx1); mx = fmaxf(mx, xhalf(mx));
    const float mn = fmaxf(m, mx); alpha = __builtin_amdgcn_exp2f(m - mn); m = mn;
}

template <int DK, int DV, bool CAUSAL, bool ALIBI, bool KROPE, bool QMEM = false, bool DESC = false>
__device__ __forceinline__ void flash_pass(LAS unsigned char* lds, int tid, const GAS bf16* Qrow, const GAS bf16* Qrow2, const GAS bf16* Kg, int ldk, const GAS bf16* K2g, const GAS bf16* Vg, int ldv,
                                           int NT, int ntw, int qrow, float slope2, f32x16 (&o)[DV / 32], float& lsum, const GAS unsigned* kn = nullptr, int abl = 0) {
    constexpr int KBUF = KLay<DK>::KBUF, VBUF = DV * VPB, QOFF = 2 * KBUF + 2 * VBUF, XOFF = QOFF + 8 * (DK / 16) * 1024;
    constexpr bool CUT = DESC && ALIBI;
    const int lane = tid & 63, r32 = lane & 31, hi = lane >> 5, wid = tid >> 6;
#define FL_TI(i) (DESC ? NT - 1 - (i) : (i))
    bf16x8 qf[QMEM ? 1 : DK / 16];
    LAS unsigned char* qlds = lds + QOFF + wid * (DK / 16) * 1024 + lane * 16;
    float qn2 = 0.f;
#pragma unroll
    for (int d0 = 0; d0 < DK / 16; ++d0) {
        bf16x8 v;
        if (KROPE && d0 >= 4) v = *(const GAS bf16x8*)(Qrow2 + 16 * (d0 - 4) + 8 * hi);
        else v = *(const GAS bf16x8*)(Qrow + 16 * d0 + 8 * hi);
        if constexpr (CUT) {
#pragma unroll
            for (int j = 0; j < 8; ++j) { const float f = __builtin_bit_cast(float, (unsigned)(unsigned short)v[j] << 16); qn2 += f * f; } }
        if constexpr (QMEM) *(LAS bf16x8*)(qlds + d0 * 1024) = v; else qf[d0] = v;
    }
    volatile LAS float* kpre = (volatile LAS float*)(lds + XOFF);
    volatile LAS unsigned* dflag = (volatile LAS unsigned*)(lds + XOFF + 512);
    float qn = 0.f;
    if constexpr (CUT) {
        qn2 += xhalf(qn2); qn = sqrtf(qn2);
        if (wid == 0) {
            float v0 = 0.f, v1 = 0.f;
            if (lane < NT) v0 = sqrtf(__builtin_bit_cast(float, kn[(size_t)lane * 16]) + __builtin_bit_cast(float, kn[(size_t)lane * 16 + 1])) * 1.01f;
            if (lane + 64 < NT) v1 = sqrtf(__builtin_bit_cast(float, kn[(size_t)(lane + 64) * 16]) + __builtin_bit_cast(float, kn[(size_t)(lane + 64) * 16 + 1])) * 1.01f;
#pragma unroll
            for (int dd = 1; dd < 64; dd <<= 1) { const float u0 = __shfl_up(v0, dd), u1 = __shfl_up(v1, dd); if (lane >= dd) { v0 = fmaxf(v0, u0); v1 = fmaxf(v1, u1); } }
            v1 = fmaxf(v1, __shfl(v0, 63));
            kpre[lane] = v0; kpre[lane + 64] = v1;
        }
    }
#pragma unroll
    for (int db = 0; db < DV / 32; ++db)
#pragma unroll
        for (int r = 0; r < 16; ++r) o[db][r] = 0.f;
    float m = -INFINITY, l = 0.f, alpha = 1.0f;
    int cut = NT;
    Stage<DK, DV, KROPE> st;
    st.loadK(tid, Kg, ldk, K2g, 64 * FL_TI(0)); st.loadV(tid, Vg, ldv, 64 * FL_TI(0));
    st.storeK(tid, lds); st.storeV(tid, lds + 2 * KBUF);
    if (NT > 1) { st.loadK(tid, Kg, ldk, K2g, 64 * FL_TI(1)); st.storeK(tid, lds + KBUF); }
    __syncthreads();
    if (NT > 2) st.loadK(tid, Kg, ldk, K2g, 64 * FL_TI(2));
    if (NT > 1) st.loadV(tid, Vg, ldv, 64 * FL_TI(1));
    f32x16 pa0, pa1, pb0, pb1;
#define FL_QKT(P0, P1, KB) do { if constexpr (QMEM) { bf16x8 qt_[DK / 16]; _Pragma("unroll") for (int d0 = 0; d0 < DK / 16; ++d0) qt_[d0] = *(const LAS bf16x8*)(qlds + d0 * 1024); qkt<DK>(P0, P1, KB, qt_, r32, hi); } else qkt<DK>(P0, P1, KB, qf, r32, hi); } while (0)
#define FL_FIRST(P0, P1, KB, TILE) do { const int kv_ = 64 * (TILE); fl_init<ALIBI>(P0, P1, slope2, kv_, hi, qrow); FL_QKT(P0, P1, KB); \
        if (CAUSAL && kv_ + 63 > qrow - r32) fl_mask(P0, P1, kv_, hi, qrow); fl_start(P0, P1, m, alpha); } while (0)
    if (FL_TI(0) < ntw) FL_FIRST(pa0, pa1, lds, FL_TI(0));
    __syncthreads();
    for (int i = 0; i < NT; ++i) {
        int tq_ = tid; asm volatile("" : "+v"(tq_));
        if (!(abl & 1)) {
            if (i + 2 < NT) st.storeK(tq_, lds + (i & 1) * KBUF);
            if (i + 1 < NT) st.storeV(tq_, lds + 2 * KBUF + ((i + 1) & 1) * VBUF);
            if (i + 3 < NT) st.loadK(tq_, Kg, ldk, K2g, 64 * FL_TI(i + 3));
            if (i + 2 < NT) st.loadV(tq_, Vg, ldv, 64 * FL_TI(i + 2)); }
        const int tc = FL_TI(i), tn = FL_TI(i + 1);
        const bool ac = tc < ntw && i < cut && !(abl & 2);
        bool an = i + 1 < NT && tn < ntw && i + 1 < cut && !(abl & 2);
        if constexpr (CUT) {
            if (ac && an) {
                const bool dead = qn * kpre[tn] + slope2 * (float)(64 * tn + 63 - qrow) < m - 64.f;
                if (__all(dead)) { cut = i + 1; an = false; } } }
        const LAS unsigned char* kn_ = lds + ((i + 1) & 1) * KBUF; const LAS unsigned char* vc_ = lds + 2 * KBUF + (i & 1) * VBUF;
        if (ac) {
            l *= alpha;
            if (__any(alpha != 1.0f)) {
#pragma unroll
                for (int db = 0; db < DV / 32; ++db) asm volatile("" : "+v"(o[db]));
#pragma unroll
                for (int db = 0; db < DV / 32; ++db)
#pragma unroll
                    for (int r = 0; r < 16; ++r) o[db][r] *= alpha;
#pragma unroll
                for (int db = 0; db < DV / 32; ++db) asm volatile("" : "+v"(o[db])); }
            bf16x8 pf[4];
            if (an) {
                const int kv1_ = 64 * tn;
                const bool diag_ = CAUSAL && (kv1_ + 63 > qrow - r32);
                fl_init<ALIBI>(pb0, pb1, slope2, kv1_, hi, qrow);
                fl_blockX<DK, QMEM>(pb0, pb1, kn_, qf, qlds, r32, hi, pa0, pa1, m, l, pf);
                if (!diag_) { fl_blockY<DV>(o, vc_, pf, r32, hi, pb0, pb1, m, alpha); }
                else { pv<DV>(o, vc_, pf, r32, hi); fl_mask(pb0, pb1, kv1_, hi, qrow); fl_start(pb0, pb1, m, alpha); }
            } else {
                fl_finish(pa0, pa1, m, l, pf); pv<DV>(o, vc_, pf, r32, hi);
            }
        } else if (an) { FL_FIRST(pb0, pb1, kn_, tn); }
        if constexpr (CUT) { if (lane == 0) dflag[(i & 1) * 8 + wid] = (i + 1 >= cut) ? 1u : 0u; }
        if (!(abl & 4)) __syncthreads();
        if constexpr (CUT) { unsigned alld = 1u;
#pragma unroll
            for (int w = 0; w < 8; ++w) alld &= dflag[(i & 1) * 8 + w];
            if (alld) break; }
        if (!(abl & 8)) { pa0 = pb0; pa1 = pb1; }
    }
#undef FL_FIRST
#undef FL_QKT
#undef FL_TI
    lsum = l + xhalf(l);
}

template <int DK, int DV, bool CAUSAL, bool ALIBI, bool KROPE, bool QMEM = false>
__device__ __forceinline__ void flash_pass_simple(LAS unsigned char* lds, int tid, const GAS bf16* Qrow, const GAS bf16* Qrow2, const GAS bf16* Kg, int ldk, const GAS bf16* K2g, const GAS bf16* Vg, int ldv,
                                           int NT, int ntw, int qrow, float slope2, f32x16 (&o)[DV / 32], float& lsum) {
    constexpr int KBUF = KLay<DK>::KBUF, VBUF = DV * VPB;
    const int lane = tid & 63, r32 = lane & 31, hi = lane >> 5;
    constexpr int QR = QMEM ? DK / 32 : DK / 16;
    bf16x8 qf[QR];
    LAS unsigned char* qlds = lds + 2 * KBUF + 2 * VBUF + (tid >> 6) * (DK / 16 - QR + 1) * 1024 + lane * 16;
#pragma unroll
    for (int d0 = 0; d0 < DK / 16; ++d0) {
        bf16x8 v;
        if (KROPE && d0 >= 4) v = *(const GAS bf16x8*)(Qrow2 + 16 * (d0 - 4) + 8 * hi);
        else v = *(const GAS bf16x8*)(Qrow + 16 * d0 + 8 * hi);
        if constexpr (!KROPE && QMEM) {
            const bf16x8 w2 = *(const GAS bf16x8*)(Qrow2 + 16 * d0 + 8 * hi); const u32x4 a4 = __builtin_bit_cast(u32x4, v), b4 = __builtin_bit_cast(u32x4, w2); u32x4 r4;
            r4.x = pk2(bflo(a4.x) + bflo(b4.x), bfhi(a4.x) + bfhi(b4.x)); r4.y = pk2(bflo(a4.y) + bflo(b4.y), bfhi(a4.y) + bfhi(b4.y));
            r4.z = pk2(bflo(a4.z) + bflo(b4.z), bfhi(a4.z) + bfhi(b4.z)); r4.w = pk2(bflo(a4.w) + bflo(b4.w), bfhi(a4.w) + bfhi(b4.w)); v = __builtin_bit_cast(bf16x8, r4); }
        if (d0 < QR) qf[d0] = v; else *(LAS bf16x8*)(qlds + (d0 - QR) * 1024) = v;
    }
#pragma unroll
    for (int db = 0; db < DV / 32; ++db)
#pragma unroll
        for (int r = 0; r < 16; ++r) o[db][r] = 0.f;
    float m = -INFINITY, l = 0.f;
    Stage<DK, DV, KROPE> st;
    st.load(tid, Kg, ldk, K2g, Vg, ldv, 0);
    st.store(tid, lds, lds + 2 * KBUF);
    __syncthreads();
    for (int t = 0; t < NT; ++t) {
        const int cur = t & 1, kv0 = 64 * t;
        if (t + 1 < NT) st.load(tid, Kg, ldk, K2g, Vg, ldv, kv0 + 64);
        if (t < ntw) {
            const LAS unsigned char* kb = lds + cur * KBUF; const LAS unsigned char* vb = lds + 2 * KBUF + cur * VBUF;
            f32x16 p0, p1;
            if (ALIBI) { const float base = slope2 * (float)(kv0 + 4 * hi - qrow);
#pragma unroll
                for (int r = 0; r < 16; ++r) { p0[r] = __builtin_fmaf(slope2, (float)((r & 3) + 8 * (r >> 2)), base); p1[r] = __builtin_fmaf(slope2, (float)(32 + (r & 3) + 8 * (r >> 2)), base); } }
            else {
#pragma unroll
                for (int r = 0; r < 16; ++r) { p0[r] = 0.f; p1[r] = 0.f; } }
            if constexpr (QMEM) qkt_qmem<DK>(p0, p1, kb, qf, qlds, r32, hi); else qkt<DK>(p0, p1, kb, qf, r32, hi);
            if (CAUSAL && kv0 + 63 > qrow - r32) {
#pragma unroll
                for (int r = 0; r < 16; ++r) { const int kv = kv0 + crow(r, hi); if (kv > qrow) p0[r] = -INFINITY; if (kv + 32 > qrow) p1[r] = -INFINITY; } }
            float mx = p0[0];
#pragma unroll
            for (int r = 1; r < 16; ++r) mx = fmaxf(mx, p0[r]);
#pragma unroll
            for (int r = 0; r < 16; ++r) mx = fmaxf(mx, p1[r]);
            mx = fmaxf(mx, xhalf(mx));
            const float mn = fmaxf(m, mx), alpha = __builtin_amdgcn_exp2f(m - mn); m = mn;
            l *= alpha;
            if (__any(alpha != 1.0f)) {
#pragma unroll
                for (int db = 0; db < DV / 32; ++db)
#pragma unroll
                    for (int r = 0; r < 16; ++r) o[db][r] *= alpha; }
            float s = 0.f;
#pragma unroll
            for (int r = 0; r < 16; ++r) { p0[r] = __builtin_amdgcn_exp2f(p0[r] - mn); p1[r] = __builtin_amdgcn_exp2f(p1[r] - mn); s += p0[r] + p1[r]; }
            l += s;
            bf16x8 pf[4]; pack_p(pf, p0, p1);
            pv<DV>(o, vb, pf, r32, hi);
        }
        if (t + 1 < NT) st.store(tid, lds + (cur ^ 1) * KBUF, lds + 2 * KBUF + (cur ^ 1) * VBUF);
        __syncthreads();
    }
    lsum = l + xhalf(l);
}


template <int DV> __device__ __forceinline__ void store_o(GAS bf16* Orow, const f32x16 (&o)[DV / 32], float sc, int hi) {
#pragma unroll
    for (int db = 0; db < DV / 32; ++db)
#pragma unroll
        for (int c = 0; c < 4; ++c) { u32x2 w; w.x = pk2(o[db][4 * c] * sc, o[db][4 * c + 1] * sc); w.y = pk2(o[db][4 * c + 2] * sc, o[db][4 * c + 3] * sc);
            *(GAS u32x2*)(Orow + 32 * db + 8 * c + 4 * hi) = w; }
}

__device__ __forceinline__ void mla_unit(LAS unsigned char* lds, int tid, int b, int h, int q0, const GAS bf16* qmla, const GAS bf16* knope, const GAS bf16* krope, const GAS bf16* vT, GAS bf16* out, int abl) {
    const int lane = tid & 63, wid = tid >> 6, r32 = lane & 31, hi = lane >> 5;
    const size_t tb = (size_t)b * 8192; const int qrow = q0 + 32 * wid + r32;
    const GAS bf16* Qr = qmla + (tb + qrow) * 768;
    f32x16 o[2]; float l;
    flash_pass<96, 64, true, false, true>(lds, tid, Qr + h * 64, Qr + 512 + h * 32, knope + tb * 512 + h * 64, 512, krope + tb * 32, vT + (size_t)(h * 64) * 16384 + tb, 16384,
                                          q0 / 64 + 4, (q0 + 32 * wid + 31) / 64 + 1, qrow, 0.f, o, l, nullptr, abl);
    if (abl == 0 || l == 12345.678f) store_o<64>(out + (tb + qrow) * 1024 + h * 64, o, 1.0f / l, hi);
}
__device__ __forceinline__ void cross_unit(LAS unsigned char* lds, int tid, int b, int h, int q0, const GAS bf16* qx, const GAS bf16* xk, const GAS bf16* xvT, GAS bf16* out) {
    const int lane = tid & 63, wid = tid >> 6, r32 = lane & 31, hi = lane >> 5;
    const size_t tb = (size_t)b * 8192; const int qrow = q0 + 32 * wid + r32;
    f32x16 o[4]; float l;
    int nt = 4; asm volatile("" : "+s"(nt));
    flash_pass_simple<128, 128, false, false, false, true>(lds, tid, qx + (tb + qrow) * 512 + h * 128, qx + (size_t)16384 * 512 + (tb + qrow) * 512 + h * 128, xk + (size_t)(b * 256) * 512 + h * 128, 512, nullptr, xvT + (size_t)(h * 128) * 512 + b * 256, 512,
                                              nt, nt, qrow, 0.f, o, l);
    store_o<128>(out + (tb + qrow) * 512 + h * 128, o, 1.0f / l, hi);
}
__device__ __forceinline__ void diff_unit(LAS unsigned char* lds, int tid, int b, int h, int hf, int q0, const GAS bf16* dq, const GAS bf16* dk, const GAS bf16* vT, GAS bf16* out, int ldo, const GAS unsigned* knl, int abl) {
    const int lane = tid & 63, wid = tid >> 6, r32 = lane & 31, hi = lane >> 5;
    const size_t tb = (size_t)b * 8192; const int qrow = q0 + 32 * wid + r32;
    const float slope2 = __builtin_amdgcn_exp2f(-2.0f * (float)(h + 1)) * 1.4426950408889634f;
    const int NT = q0 / 64 + 4, ntw = (q0 + 32 * wid + 31) / 64 + 1;
    f32x16 o[4]; float l;
    flash_pass<64, 128, true, true, false, true, true>(lds, tid, dq + (tb + qrow) * 512 + h * 128 + hf * 64, nullptr, dk + tb * 512 + h * 128 + hf * 64, 512, nullptr, vT + (size_t)(512 + h * 128) * 16384 + tb, 16384,
                                                      NT, ntw, qrow, slope2, o, l, knl + ((size_t)(b * 128) * 8 + 2 * h + hf) * 2, abl);
    if (abl == 0 || l == 12345.678f) store_o<128>(out + (tb + qrow) * (size_t)ldo + h * 128, o, 1.0f / l, hi);
}
__device__ __forceinline__ void diff_lambda(const GAS float* lp, int layer, float& lam, float& post) {
    float q1 = 0.f, q2 = 0.f;
    for (int i = 0; i < 64; ++i) { q1 += lp[i] * lp[64 + i]; q2 += lp[128 + i] * lp[192 + i]; }
    const float lam_init = (layer == 0) ? 0.2f : 0.35550906759f;
    lam = expf(q1) - expf(q2) + lam_init; post = 1.f - lam_init;
}
__device__ __forceinline__ void diff_combine8(int tok0, int ntok, int lane, GAS bf16* o0, const GAS bf16* o1, float lam, float post, const GAS float* subln) {
    u32x4 a[8], c[8];
#pragma unroll
    for (int j = 0; j < 8; ++j) { const int tok = tok0 + (j < ntok ? j : 0);
        a[j] = *(const GAS u32x4*)(o0 + (size_t)tok * 1024 + 8 * lane); c[j] = *(const GAS u32x4*)(o1 + (size_t)tok * 512 + 8 * lane); }
    const f32x4 g0 = *(const GAS f32x4*)(subln + 8 * (lane & 15)), g1 = *(const GAS f32x4*)(subln + 8 * (lane & 15) + 4);
#pragma unroll
    for (int j = 0; j < 8; ++j) {
        float x[8];
#pragma unroll
        for (int w = 0; w < 4; ++w) { x[2 * w] = bflo(a[j][w]) - lam * bflo(c[j][w]); x[2 * w + 1] = bfhi(a[j][w]) - lam * bfhi(c[j][w]); }
        float s2 = ((x[0] * x[0] + x[1] * x[1]) + (x[2] * x[2] + x[3] * x[3])) + ((x[4] * x[4] + x[5] * x[5]) + (x[6] * x[6] + x[7] * x[7]));
#pragma unroll
        for (int dd = 1; dd < 16; dd <<= 1) s2 += __shfl_xor(s2, dd);
        const float rs = __builtin_amdgcn_rsqf(s2 * (1.f / 128.f) + 1e-6f) * post;
        u32x4 w4; w4.x = pk2(x[0] * rs * g0[0], x[1] * rs * g0[1]); w4.y = pk2(x[2] * rs * g0[2], x[3] * rs * g0[3]); w4.z = pk2(x[4] * rs * g1[0], x[5] * rs * g1[1]); w4.w = pk2(x[6] * rs * g1[2], x[7] * rs * g1[3]);
        if (j < ntok) *(GAS u32x4*)(o0 + (size_t)(tok0 + j) * 1024 + 8 * lane) = w4; }
}
__device__ __forceinline__ void sb_unit(LAS unsigned char* lds, int tid, int b, int h, int q0, const GAS bf16* sq, const GAS bf16* sk, const GAS bf16* vT, GAS bf16* out) {
    constexpr int KBUF = KLay<64>::KBUF, VBUF = 64 * VPB;
    const int lane = tid & 63, wid = tid >> 6, r32 = lane & 31, hi = lane >> 5;
    const size_t tb = (size_t)b * 8192; const int qrow = q0 + 32 * wid + r32;
    const GAS bf16* Kg = sk + tb * 512 + h * 64; const GAS bf16* Vg = vT + (size_t)(h * 64) * 16384 + tb;
    const int NT = q0 / 64 + 4, ntw = (q0 + 32 * wid + 30) / 64 + 1;
    bf16x8 qf[4];
#pragma unroll
    for (int d0 = 0; d0 < 4; ++d0) qf[d0] = *(const GAS bf16x8*)(sq + (tb + qrow) * 512 + h * 64 + 16 * d0 + 8 * hi);
    f32x16 o[2];
#pragma unroll
    for (int r = 0; r < 16; ++r) { o[0][r] = 0.f; o[1][r] = 0.f; }
    float R = 1.0f;
    volatile LAS unsigned* dflag = (volatile LAS unsigned*)(lds + 4 * KBUF + 1024);
    Stage<64, 64, false> st;
    st.load(tid, Kg, 512, nullptr, Vg, 16384, 64 * (NT - 1));
    st.store(tid, lds, lds + 2 * KBUF);
    __syncthreads();
    for (int i = 0; i < NT; ++i) {
        const int t = NT - 1 - i, cur = i & 1, kv0 = 64 * t;
        if (t > 0) st.load(tid, Kg, 512, nullptr, Vg, 16384, kv0 - 64);
        if (t < ntw && __any(R != 0.f)) {
            const LAS unsigned char* kb = lds + cur * KBUF; const LAS unsigned char* vb = lds + 2 * KBUF + cur * VBUF;
            f32x16 k0, k1;
#pragma unroll
            for (int r = 0; r < 16; ++r) { k0[r] = 0.f; k1[r] = 0.f; }
            qkt<64>(k0, k1, kb, qf, r32, hi);
            f32x16 b0, b1;
#pragma unroll
            for (int r = 0; r < 16; ++r) {
                const float e0 = __builtin_amdgcn_exp2f(fminf(k0[r], 115.f)), e1 = __builtin_amdgcn_exp2f(fminf(k1[r], 115.f));
                const float r0 = __builtin_amdgcn_rcpf(1.f + e0), r1 = __builtin_amdgcn_rcpf(1.f + e1);
                k0[r] = r0; b0[r] = e0 * r0; k1[r] = r1; b1[r] = e1 * r1; }
            if (kv0 + 63 >= qrow - r32) {
                const int thr = qrow - kv0 - 4 * hi;
#pragma unroll
                for (int r = 0; r < 16; ++r) { const int c = (r & 3) + 8 * (r >> 2); if (c >= thr) { k0[r] = 1.f; b0[r] = 0.f; } if (c + 32 >= thr) { k1[r] = 1.f; b1[r] = 0.f; } } }
            float gp[8], go[8];
#pragma unroll
            for (int c = 0; c < 4; ++c) { gp[c] = (k0[4 * c] * k0[4 * c + 1]) * (k0[4 * c + 2] * k0[4 * c + 3]); gp[4 + c] = (k1[4 * c] * k1[4 * c + 1]) * (k1[4 * c + 2] * k1[4 * c + 3]); }
#pragma unroll
            for (int g = 0; g < 8; ++g) go[g] = xhalf(gp[g]);
            float sp = R;
#pragma unroll
            for (int g = 7; g >= 0; --g) {
                float s = sp * (hi ? 1.0f : go[g]);
                if (g >= 4) { const int c = g - 4;
                    b1[4 * c + 3] *= s; s *= k1[4 * c + 3]; b1[4 * c + 2] *= s; s *= k1[4 * c + 2]; b1[4 * c + 1] *= s; s *= k1[4 * c + 1]; b1[4 * c] *= s; }
                else { const int c = g;
                    b0[4 * c + 3] *= s; s *= k0[4 * c + 3]; b0[4 * c + 2] *= s; s *= k0[4 * c + 2]; b0[4 * c + 1] *= s; s *= k0[4 * c + 1]; b0[4 * c] *= s; }
                sp *= gp[g] * go[g];
            }
            R = sp;
            bf16x8 pf[4]; pack_p(pf, b0, b1);
            pv<64>(o, vb, pf, r32, hi);
        }
        if (t > 0) st.store(tid, lds + (cur ^ 1) * KBUF, lds + 2 * KBUF + (cur ^ 1) * VBUF);
        if (lane == 0) dflag[(i & 1) * 8 + wid] = (t < ntw && !__any(R != 0.f)) ? 1u : 0u;
        __syncthreads();
        { unsigned alld = 1u;
#pragma unroll
          for (int w = 0; w < 8; ++w) alld &= dflag[(i & 1) * 8 + w];
          if (alld) break; }
    }
    store_o<64>(out + (tb + qrow) * 1024 + h * 64, o, 1.0f, hi);
}
}
typedef unsigned short bf16;
typedef float f32x4 __attribute__((ext_vector_type(4)));
typedef unsigned u32x4 __attribute__((ext_vector_type(4)));
typedef unsigned u32x2 __attribute__((ext_vector_type(2)));
constexpr int NWAVES = 8, NTHREADS = 512;
constexpr int M = 16384, D = 1024, SEQ = 8192, DEPTH = 2, IN_COLS = 6688;
constexpr int SROWS = 40960;
constexpr size_t MiB = 1u << 20;
constexpr size_t WS_CTL = 0, CTL_ZERO_BYTES = 128 * 1024;
constexpr size_t WS_SSQ = 1 * MiB;
constexpr size_t WS_SSQCQ = 2 * MiB, WS_SSQCKV = WS_SSQCQ + 256 * 1024, WS_SSQMEM = WS_SSQCKV + 256 * 1024;
constexpr size_t WS_TOKE = 3 * MiB, WS_TOKW = WS_TOKE + 128 * 1024, WS_HIST = WS_TOKW + 128 * 1024, WS_SLOT = WS_HIST + 64 * 1024;
constexpr size_t WS_STOK = 4 * MiB, WS_SW = WS_STOK + 256 * 1024, WS_SRSTD = WS_SW + 256 * 1024;
constexpr size_t WS_WR = 5 * MiB;
constexpr size_t WS_WRH = 5 * MiB + 256 * 1024, WS_WRL = WS_WRH + 128 * 1024;
constexpr size_t WS_MEMN = 6 * MiB, WS_XK = 7 * MiB, WS_XVT = WS_XK + 512 * 1024;
constexpr size_t WS_WIN = 8 * MiB;
constexpr size_t WS_WV = WS_WIN + (size_t)2816 * 1024 * 2;
constexpr size_t WS_WG = WS_WV + 2 * MiB;
constexpr size_t WS_WUQ = WS_WG + 6 * MiB;
constexpr size_t WS_WUKN = WS_WUQ + 768 * 256 * 2;
constexpr size_t WS_WUV = WS_WUKN + 512 * 256 * 2;
constexpr size_t WS_WB = WS_WUV + 512 * 256 * 2;
constexpr size_t WS_WOUT = WS_WB + 4 * MiB;
constexpr size_t WS_WXQ = WS_WOUT + 2 * MiB;
constexpr size_t WS_WXK = WS_WXQ + 1 * MiB, WS_WXV = WS_WXK + 1 * MiB;
constexpr size_t WS_WXO = WS_WXV + 1 * MiB;
constexpr size_t WS_WGU = WS_WXO + 1 * MiB;
constexpr size_t WS_WD = WS_WGU + 32 * MiB;
constexpr size_t WS_WEND = WS_WD + 16 * MiB;
static_assert(WS_WEND <= 81 * MiB, "weights");
constexpr size_t WS_XB = 81 * MiB;
constexpr size_t R0 = 113 * MiB;
constexpr size_t WS_CQ = R0, WS_CKV = R0 + 8 * MiB, WS_KROPE = R0 + 16 * MiB, WS_QK = R0 + 18 * MiB  , WS_VT = R0 + 82 * MiB  ;
constexpr size_t WS_QMLA = R0 + 114 * MiB, WS_KNOPE = R0 + 138 * MiB, WS_VMLAT = R0 + 154 * MiB, WS_OABC = R0 + 170 * MiB  ;
constexpr size_t WS_GSCR = R0, WS_MB = R0 + 96 * MiB;
constexpr size_t WS_QX = R0, WS_OX = R0 + 32 * MiB;
constexpr size_t WS_XG = R0, WS_ACT = R0 + 80 * MiB, WS_Y = R0 + 100 * MiB;
constexpr size_t WS_END = R0 + 234 * MiB;
static_assert(WS_MB + 32 * MiB <= WS_OABC && WS_Y + 80 * MiB <= WS_END && WS_OABC + 64 * MiB <= WS_END, "region map");
constexpr int CW_BAR = 1024, CW_Q = 8192, CW_KN = 16384, CW_F1 = 24576;
constexpr int RING_BYTES = 131072, LDSCTL_OFF = RING_BYTES, MISC_OFF = LDSCTL_OFF + 320, TSTART_OFF = LDSCTL_OFF + 1024, HIST_OFF = LDSCTL_OFF + 2048;
constexpr int LDS_BYTES = 147456;

#define LDS_WAIT() asm volatile("s_waitcnt lgkmcnt(0)" ::: "memory")
__device__ __forceinline__ float wave_sum(float v) {
#pragma unroll
    for (int o = 1; o < 64; o <<= 1) v += __shfl_xor(v, o);
    return v;
}
__device__ __forceinline__ unsigned pk2(float lo, float hi) { return pg8::pk2(lo, hi); }
__device__ __forceinline__ int lane_id() { int r; asm volatile("v_mbcnt_lo_u32_b32 %0, -1, 0\n\tv_mbcnt_hi_u32_b32 %0, -1, %0" : "=v"(r)); return r; }
#define XB_TMO      128
#define XB_XCNT(j)  (256  + 64 * (j))
#define XB_XSUB(j)  (1280 + 64 * (j))
#define XB_XGEN(j)  (2304 + 64 * (j))
#define XB_TOP      3328
#define XB_TOPGEN   3392
#define XCD_BAR_WORDS 3456
#define XB_SPIN_CAP (1u << 18)

__device__ __forceinline__ unsigned xb_ld(unsigned* p)              { return __hip_atomic_load(p, __ATOMIC_RELAXED, __HIP_MEMORY_SCOPE_AGENT); }
__device__ __forceinline__ unsigned xb_add(unsigned* p, unsigned v) { return __hip_atomic_fetch_add(p, v, __ATOMIC_RELAXED, __HIP_MEMORY_SCOPE_AGENT); }
__device__ __forceinline__ unsigned xb_xcc_id() { return (unsigned)__builtin_amdgcn_s_getreg((3 << 11) | 20) & 0xFu; }
#define XB_SPIN(cond, bar) do { unsigned _sp = 0; while (cond) { __builtin_amdgcn_s_sleep(1); \
    if ((++_sp & 255u) == 0u) { if (xb_ld(&(bar)[XB_TMO])) break; if (_sp > XB_SPIN_CAP) { atomicAdd(&(bar)[XB_TMO], 1u); break; } } } } while (0)

struct XcdBarrier {
    unsigned* bar; unsigned x; int wid;
    volatile LAS unsigned* st;
};

__device__ __forceinline__ XcdBarrier xcd_barrier_post(unsigned* bar, volatile LAS unsigned* st, int wid) {
    XcdBarrier b; b.bar = bar; b.x = xb_xcc_id(); b.st = st; b.wid = wid;
    if (wid == 0 && lane_id() == 0) (void)xb_add(&bar[XB_XCNT(b.x)], 1u);
    return b;
}
__device__ __forceinline__ void xcd_barrier_complete(unsigned* bar, unsigned x, unsigned& nloc, unsigned& nx) {
    const unsigned G = gridDim.x * gridDim.y * gridDim.z;
    unsigned sum, cnt, mine, sp = 0u;
    for (;;) {
        sum = 0u; cnt = 0u; mine = 0u;
#pragma unroll 1
        for (unsigned j = 0; j < 16; ++j) { const unsigned c = xb_ld(&bar[XB_XCNT(j)]); sum += c; cnt += (c > 0u) ? 1u : 0u; mine = (j == x) ? c : mine; }
        if (sum == G) break;
        __builtin_amdgcn_s_sleep(1);
        if ((++sp & 255u) == 0u) { if (xb_ld(&bar[XB_TMO])) break; if (sp > XB_SPIN_CAP) { atomicAdd(&bar[XB_TMO], 1u); break; } }
    }
    nloc = mine > 0u ? mine : 1u; nx = cnt > 0u ? cnt : 1u;
}

__device__ __forceinline__ void xcd_barrier(const XcdBarrier& b) {
    asm volatile("s_waitcnt vmcnt(0)" ::: "memory");
    __syncthreads();
    if (b.wid == 0 && lane_id() == 0) {
        unsigned* bar = b.bar; asm volatile("" : "+s"(bar));
        __builtin_amdgcn_s_waitcnt(0);
        unsigned nloc = b.st[0], nx = b.st[1];
        if (nloc == 0u) { xcd_barrier_complete(bar, b.x, nloc, nx); b.st[0] = nloc; b.st[1] = nx; }
        const unsigned old = xb_add(&bar[XB_XSUB(b.x)], 1u);
        const unsigned gen = old / nloc;
        if (old + 1u == (gen + 1u) * nloc) {
            __builtin_amdgcn_fence(__ATOMIC_RELEASE, "agent");
            asm volatile("s_waitcnt vmcnt(0)" ::: "memory");
            const unsigned og = xb_add(&bar[XB_TOP], 1u);
            const unsigned tg = og / nx;
            if (og + 1u == (tg + 1u) * nx) xb_add(&bar[XB_TOPGEN], 1u);
            else XB_SPIN(xb_ld(&bar[XB_TOPGEN]) == tg, bar);
            __builtin_amdgcn_fence(__ATOMIC_ACQUIRE, "agent");
            xb_add(&bar[XB_XGEN(b.x)], 1u);
            asm volatile("s_waitcnt vmcnt(0)" ::: "memory");
        } else {
            XB_SPIN(xb_ld(&bar[XB_XGEN(b.x)]) == gen, bar);
            __builtin_amdgcn_fence(__ATOMIC_ACQUIRE, "agent");
            asm volatile("s_waitcnt vmcnt(0)" ::: "memory");
        }
    }
    __syncthreads();
}
struct TrJob { const GAS float* src; const GAS float* gain; GAS bf16* dst; int ldn, col0, k0, K, row0, dk; };
__device__ __forceinline__ void tr_load(const TrJob& j, f32x4 (&v)[8], int lane) {
    const int kr = lane >> 3, nq = lane & 7;
    if (j.col0 >= 0) {
#pragma unroll
        for (int i = 0; i < 8; ++i) v[i] = *(const GAS f32x4*)(j.src + (size_t)(j.k0 + 8 * i + kr) * j.ldn + j.col0 + 4 * nq);
    } else {
#pragma unroll
        for (int i = 0; i < 8; ++i) v[i] = (f32x4){0.f, 0.f, 0.f, 0.f};
    }
}
__device__ __forceinline__ void tr_finish(const TrJob& j, const f32x4 (&v)[8], LAS float* scr, int lane) {
    const int kr = lane >> 3, nq = lane & 7;
#pragma unroll
    for (int i = 0; i < 8; ++i) { const int kk = 8 * i + kr; const float g = j.gain ? j.gain[j.k0 + kk] : 1.f; LAS float* s = scr + kk * 33 + 4 * nq;
        s[0] = v[i][0] * g; s[1] = v[i][1] * g; s[2] = v[i][2] * g; s[3] = v[i][3] * g; }
    LDS_WAIT(); asm volatile("" ::: "memory");
    const int c = lane & 7;
#pragma unroll
    for (int q = 0; q < 4; ++q) { const int n = (lane >> 3) + 8 * q; const LAS float* s = scr + (8 * c) * 33 + n;
        u32x4 o; o.x = pk2(s[0 * 33], s[1 * 33]); o.y = pk2(s[2 * 33], s[3 * 33]); o.z = pk2(s[4 * 33], s[5 * 33]); o.w = pk2(s[6 * 33], s[7 * 33]);
        *(GAS u32x4*)(j.dst + (size_t)(j.row0 + n) * j.K + j.dk + j.k0 + 8 * c) = o; }
    LDS_WAIT(); asm volatile("" ::: "memory");
}
__device__ __forceinline__ void row_load(const GAS float* xrow, f32x4 (&v)[4], int lane) {
    const GAS f32x4* xr = (const GAS f32x4*)xrow + lane;
#pragma unroll
    for (int j = 0; j < 4; ++j) v[j] = xr[64 * j];
}
__device__ __forceinline__ void row_finish(const f32x4 (&v)[4], GAS bf16* orow, GAS float* ssq16, int lane) {
    float s = 0.f;
#pragma unroll
    for (int j = 0; j < 4; ++j) s += (v[j][0] * v[j][0] + v[j][1] * v[j][1]) + (v[j][2] * v[j][2] + v[j][3] * v[j][3]);
    s = wave_sum(s);
    GAS u32x2* o8 = (GAS u32x2*)orow + lane;
#pragma unroll
    for (int j = 0; j < 4; ++j) { u32x2 w; w.x = pk2(v[j][0], v[j][1]); w.y = pk2(v[j][2], v[j][3]); o8[64 * j] = w; }
    if (lane < 16) ssq16[lane] = (lane == 0) ? s : 0.f;
}
__device__ __forceinline__ void row_to_bf16(const GAS float* xrow, GAS bf16* orow, GAS float* ssq16, int lane) {
    const GAS f32x4* xr = (const GAS f32x4*)xrow + lane; f32x4 v[4]; float s = 0.f;
#pragma unroll
    for (int j = 0; j < 4; ++j) { v[j] = xr[64 * j]; s += (v[j][0] * v[j][0] + v[j][1] * v[j][1]) + (v[j][2] * v[j][2] + v[j][3] * v[j][3]); }
    s = wave_sum(s);
    GAS u32x2* o8 = (GAS u32x2*)orow + lane;
#pragma unroll
    for (int j = 0; j < 4; ++j) { u32x2 w; w.x = pk2(v[j][0], v[j][1]); w.y = pk2(v[j][2], v[j][3]); o8[64 * j] = w; }
    if (lane < 16) ssq16[lane] = (lane == 0) ? s : 0.f;
}

struct Args { const float* in[26]; float* out; unsigned char* ws; };
__device__ __forceinline__ int opq(int i) { asm volatile("" : "+s"(i)); return i; }
__device__ __forceinline__ GAS unsigned char* opqp(unsigned char* p0) { GAS unsigned char* p = (GAS unsigned char*)p0; asm volatile("" : "+s"(p)); return p; }
#define INP(i) ((const GAS float*)args.in[opq(i)])
#define WSB(off) (opqp(args.ws) + (off))
#define X_IN INP(0)
#define OUTP ((GAS float*)args.out)
#define XB ((GAS bf16*)WSB(WS_XB))
#define SSQ ((GAS float*)WSB(WS_SSQ))
#define SSQCQ ((GAS float*)WSB(WS_SSQCQ))
#define SSQCKV ((GAS float*)WSB(WS_SSQCKV))
#define SSQMEM ((GAS float*)WSB(WS_SSQMEM))
#define MEMN ((GAS bf16*)WSB(WS_MEMN))
#define XK ((GAS bf16*)WSB(WS_XK))
#define XVT ((GAS bf16*)WSB(WS_XVT))
#define WIN ((GAS bf16*)WSB(WS_WIN))
#define WV ((GAS bf16*)WSB(WS_WV))
#define WG ((GAS bf16*)WSB(WS_WG))
#define WUQ ((GAS bf16*)WSB(WS_WUQ))
#define WUKN ((GAS bf16*)WSB(WS_WUKN))
#define WUV ((GAS bf16*)WSB(WS_WUV))
#define WB ((GAS bf16*)WSB(WS_WB))
#define WOUT ((GAS bf16*)WSB(WS_WOUT))
#define WXQ ((GAS bf16*)WSB(WS_WXQ))
#define WXK ((GAS bf16*)WSB(WS_WXK))
#define WXV ((GAS bf16*)WSB(WS_WXV))
#define WXO ((GAS bf16*)WSB(WS_WXO))
#define WGU ((GAS bf16*)WSB(WS_WGU))
#define WD ((GAS bf16*)WSB(WS_WD))
#define WRH ((GAS bf16*)WSB(WS_WRH))
#define WRL ((GAS bf16*)WSB(WS_WRL))
#define CQ ((GAS bf16*)WSB(WS_CQ))
#define CKV ((GAS bf16*)WSB(WS_CKV))
#define KROPE ((GAS bf16*)WSB(WS_KROPE))
#define QK ((GAS bf16*)WSB(WS_QK))
#define VT ((GAS bf16*)WSB(WS_VT))
#define QMLA ((GAS bf16*)WSB(WS_QMLA))
#define KNOPE ((GAS bf16*)WSB(WS_KNOPE))
#define VMLAT ((GAS bf16*)WSB(WS_VMLAT))
#define OABC ((GAS bf16*)WSB(WS_OABC))
#define GSCR ((GAS unsigned char*)WSB(WS_GSCR))
#define MB ((GAS bf16*)WSB(WS_MB))
#define QX ((GAS bf16*)WSB(WS_QX))
#define OX ((GAS bf16*)WSB(WS_OX))
#define XG ((GAS bf16*)WSB(WS_XG))
#define ACT ((GAS bf16*)WSB(WS_ACT))
#define YB ((GAS bf16*)WSB(WS_Y))
#define TOKE ((GAS int*)WSB(WS_TOKE))
#define TOKW ((GAS float*)WSB(WS_TOKW))
#define HIST ((GAS int*)WSB(WS_HIST))
#define SLOT ((GAS int*)WSB(WS_SLOT))
#define STOK ((GAS int*)WSB(WS_STOK))
#define SW ((GAS float*)WSB(WS_SW))
#define SRSTD ((GAS float*)WSB(WS_SRSTD))


__global__ void __launch_bounds__(NTHREADS, 2) fwd(Args args) {
    extern __shared__ __attribute__((aligned(16))) unsigned char lds_raw[];
    LAS unsigned char* lds = (LAS unsigned char*)lds_raw;
    volatile LAS unsigned* MISC = (volatile LAS unsigned*)(lds + MISC_OFF);
    LAS int* TSTART = (LAS int*)(lds + TSTART_OFF);
    const int tid0 = threadIdx.x; const int wv = __builtin_amdgcn_readfirstlane(tid0 >> 6);
#define PH_BEGIN int tid_ = wv * 64 + lane_id(); asm volatile("" : "+v"(tid_)); const int tid = tid_, lane = tid & 63, wave = wv, gw = vcu * NWAVES + wave; (void)lane; (void)gw
    const int G = gridDim.x, bx = blockIdx.x, vcu = (G % 8 == 0) ? (bx % 8) * (G / 8) + bx / 8 : bx;
    unsigned* ctl = (unsigned*)(void*)(args.ws + WS_CTL);
    for (int u = tid0; u < (LDS_BYTES - LDSCTL_OFF) / 4; u += NTHREADS) ((LAS unsigned*)(lds + LDSCTL_OFF))[u] = 0u;
    __syncthreads();
    XcdBarrier bar = xcd_barrier_post(ctl + CW_BAR, MISC + 8, wv);
    const int NGW = G * NWAVES;

    constexpr float L2E = 1.4426950408889634f;

    constexpr int I_IN = 88 * 16, I_V = 32 * 16, I_G = 96 * 16, I_UQ = 24 * 4, I_UK = 16 * 4, I_B = 3 * 32 * 8, I_O = 32 * 16, I_XQ = 16 * 16, I_XO = 32 * 8, I_GU = 512 * 16, I_D = 1024 * 4;
    constexpr int NITEMS = I_IN + I_V + I_G + I_UQ + 2 * I_UK + I_B + I_O + 3 * I_XQ + I_XO + I_GU + I_D, NITEMS_P0 = NITEMS - I_GU - I_D;
    for (int l = 0; l < DEPTH; ++l) {
        for (int rp_ = 0; rp_ < RP_P0; ++rp_) {
#if PH_P0
        { PH_BEGIN;
            LAS float* scr = (LAS float*)(lds + wave * 16384);
#define w_in (INP(3) + (size_t)l * D * IN_COLS)
#define g_attn (INP(2) + l * D)
#define w_uq (INP(5) + (size_t)l * 256 * 768)
#define g_q (INP(4) + l * 256)
#define w_ukv (INP(7) + (size_t)l * 256 * 1024)
#define g_kv (INP(6) + l * 256)
#define w_br (INP(10) + (size_t)l * 3 * 512 * 1024)
#define w_out (INP(11) + (size_t)l * D * D)
#define g_cross (INP(12) + l * D)
#define g_mem (INP(13))
#define w_xq (INP(14) + (size_t)l * D * 512)
#define w_xkv (INP(15) + (size_t)l * D * 1024)
#define w_xo (INP(16) + (size_t)l * 512 * D)
#define g_ffn (INP(17) + l * D)
#define w_eg (INP(22) + (size_t)l * 32 * D * 256)
#define w_eu (INP(23) + (size_t)l * 32 * D * 256)
#define w_ed (INP(24) + (size_t)l * 32 * 256 * D)
#define TR_DECODE(itx) do { int r = (itx); \
                if (r < I_IN) { const int nb = r >> 4, kb = r & 15, n0 = nb * 32; int col; \
                    if (n0 < 544) col = 3072 + n0; else if (n0 < 768) col = -1; else if (n0 < 1792) col = 3616 + (n0 - 768); else col = 5152 + (n0 - 1792); \
                    jb = TrJob{w_in, g_attn, WIN, IN_COLS, col, kb * 64, 1024, n0, 0}; break; } r -= I_IN; \
                if (r < I_V) { const int nb = r >> 4, kb = r & 15, n0 = nb * 32; const int col = n0 < 512 ? 4640 + n0 : 6176 + (n0 - 512); \
                    jb = TrJob{w_in, g_attn, WV, IN_COLS, col, kb * 64, 1024, n0, 0}; break; } r -= I_V; \
                if (r < I_G) { const int nb = r >> 4, kb = r & 15; jb = TrJob{w_in, g_attn, WG, IN_COLS, nb * 32, kb * 64, 1024, nb * 32, 0}; break; } r -= I_G; \
                if (r < I_UQ) { const int nb = r >> 2, kb = r & 3, n0 = nb * 32; const int col = n0 < 512 ? 96 * (n0 >> 6) + (n0 & 63) : 96 * ((n0 - 512) >> 5) + 64; \
                    jb = TrJob{w_uq, g_q, WUQ, 768, col, kb * 64, 256, n0, 0}; break; } r -= I_UQ; \
                if (r < I_UK) { const int nb = r >> 2, kb = r & 3, n0 = nb * 32; jb = TrJob{w_ukv, g_kv, WUKN, 1024, 128 * (n0 >> 6) + (n0 & 63), kb * 64, 256, n0, 0}; break; } r -= I_UK; \
                if (r < I_UK) { const int nb = r >> 2, kb = r & 3, n0 = nb * 32; jb = TrJob{w_ukv, g_kv, WUV, 1024, 128 * (n0 >> 6) + 64 + (n0 & 63), kb * 64, 256, n0, 0}; break; } r -= I_UK; \
                if (r < I_B) { const int z = r / 256, q = r % 256, nb = q >> 3, kb = q & 7; jb = TrJob{w_br + (size_t)z * 512 * 1024, nullptr, WB + (size_t)(z >> 1) * 1024 * 1024, 1024, nb * 32, kb * 64, 1024, nb * 32, (z & 1) * 512}; break; } r -= I_B; \
                if (r < I_O) { const int nb = r >> 4, kb = r & 15; jb = TrJob{w_out, nullptr, WOUT, 1024, nb * 32, kb * 64, 1024, nb * 32, 0}; break; } r -= I_O; \
                if (r < I_XQ) { const int nb = r >> 4, kb = r & 15; jb = TrJob{w_xq, g_cross, WXQ, 512, nb * 32, kb * 64, 1024, nb * 32, 0}; break; } r -= I_XQ; \
                if (r < I_XQ) { const int nb = r >> 4, kb = r & 15; jb = TrJob{w_xkv, g_mem, WXK, 1024, nb * 32, kb * 64, 1024, nb * 32, 0}; break; } r -= I_XQ; \
                if (r < I_XQ) { const int nb = r >> 4, kb = r & 15; jb = TrJob{w_xkv, g_mem, WXV, 1024, 512 + nb * 32, kb * 64, 1024, nb * 32, 0}; break; } r -= I_XQ; \
                if (r < I_XO) { const int nb = r >> 3, kb = r & 7; jb = TrJob{w_xo, nullptr, WXO, 1024, nb * 32, kb * 64, 512, nb * 32, 0}; break; } r -= I_XO; \
                if (r < I_GU) { const int nb = r >> 4, kb = r & 15, n0 = nb * 32, e = n0 >> 9, rr = n0 & 511, t = rr >> 8, j = rr & 255; \
                    const GAS float* src = (j < 128 ? w_eg : w_eu) + (size_t)e * D * 256; jb = TrJob{src, g_ffn, WGU, 256, 128 * t + (j & 127), kb * 64, 1024, n0, 0}; break; } r -= I_GU; \
                { const int nb = r >> 2, kb = r & 3, n0 = nb * 32, e = n0 >> 10; jb = TrJob{w_ed + (size_t)e * 256 * 1024, nullptr, WD, 1024, n0 & 1023, kb * 64, 256, n0, 0}; } } while (0)
            for (int it = gw; it < NITEMS_P0; it += NGW) {
                TrJob jb{};
                TR_DECODE(it);
                f32x4 va[8];
                tr_load(jb, va, lane);
                tr_finish(jb, va, scr, lane);
            }
            { const GAS float* wrg = INP(18) + (size_t)l * D * 4; const GAS float* wre = INP(20) + (size_t)l * D * 32; GAS bf16* wh = WRH; GAS bf16* wl = WRL;
              for (int i = bx * NTHREADS + tid; i < 48 * 1024; i += G * NTHREADS) { const int c = i >> 10, k = i & 1023;
                  const float w = c < 36 ? (c < 4 ? wrg[k * 4 + c] : wre[k * 32 + (c - 4)]) * g_ffn[k] : 0.f; const unsigned h = pk2(w, 0.f) & 0xffffu;
                  wh[i] = (bf16)h; wl[i] = (bf16)(pk2(w - __builtin_bit_cast(float, h << 16), 0.f) & 0xffffu); } }
            if (l == 0) {
                for (int m = gw; m < M; m += 2 * NGW) {
                    const int m1 = m + NGW < M ? m + NGW : m;
                    f32x4 v0[4], v1[4]; row_load(X_IN + (size_t)m * D, v0, lane); row_load(X_IN + (size_t)m1 * D, v1, lane);
                    row_finish(v0, XB + (size_t)m * D, SSQ + (size_t)m * 16, lane); row_finish(v1, XB + (size_t)m1 * D, SSQ + (size_t)m1 * 16, lane); }
                for (int m = gw; m < 512; m += NGW) row_to_bf16(INP(1) + (size_t)m * D, MEMN + (size_t)m * D, SSQMEM + (size_t)m * 16, lane);
            }
        }
#endif
        xcd_barrier(bar);
        }
                for (int rp_ = 0; rp_ < RP_A; ++rp_) {
#if PH_A
        {
            { pg8::Gemm g{XB, WIN, M, 2816, D, D, nullptr}; pg8::StaticOrder S; S.init(M, 2816, G, bx);
              pg8::EpiA E{SSQ, CQ, CKV, KROPE, QK, SSQCQ, SSQCKV, 0.125f * L2E, (GAS unsigned*)(opqp(args.ws) + WS_CTL) + CW_KN + l * 4096, rp_ ? A_ABL : 0};
              pg8::gemm_phase<pg8::EpiA, pg8::StaticOrder, true, true>(lds, g, S, E, wv); }
            { pg8::Gemm g{WV, XB, 1024, M, D, D, nullptr}; pg8::StaticOrder S; S.init(1024, M, G, (bx + 64) % G);
              pg8::EpiVT E{VT, M, SSQ, 4, 1.f / 1024.f};
              pg8::gemm_phase<pg8::EpiVT, pg8::StaticOrder, true, true>(lds, g, S, E, wv); }
            { pg8::Gemm g{MEMN, WXK, 512, 512, D, D, nullptr}; pg8::StaticOrder S; S.init(512, 512, G, (bx + 8) % G);
              pg8::EpiRS E{XK, 512, SSQMEM, 4, 1.f / 1024.f, 1.f, 0xffff, 31, 0};
              pg8::gemm_phase<pg8::EpiRS, pg8::StaticOrder, true, true>(lds, g, S, E, wv); }
            { pg8::Gemm g{WXV, MEMN, 512, 512, D, D, nullptr}; pg8::StaticOrder S; S.init(512, 512, G, (bx + 16) % G);
              pg8::EpiVT E{XVT, 512, SSQMEM, 4, 1.f / 1024.f};
              pg8::gemm_phase<pg8::EpiVT, pg8::StaticOrder, true, true>(lds, g, S, E, wv); }
        }
#endif
        xcd_barrier(bar);
        }
                for (int rp_ = 0; rp_ < RP_B; ++rp_) {
#if PH_B
        {
#if PH_B1
            { pg8::Gemm g{CQ, WUQ, M, 768, opq(256), opq(256), nullptr}; pg8::StaticOrder S; S.init(M, 768, G, bx);
              pg8::EpiQ E{QMLA, SSQCQ, 0.10206207261596577f * L2E};
              pg8::gemm_phase<pg8::EpiQ, pg8::StaticOrder, true, true>(lds, g, S, E, wv); }
#endif
#if PH_B2
            { pg8::Gemm g{CKV, WUKN, M, 512, opq(256), opq(256), nullptr}; pg8::StaticOrder S; S.init(M, 512, G, (bx + 64) % G);
              pg8::EpiRS E{KNOPE, 512, SSQCKV, 1, 1.f / 256.f, 1.f, 0xffff, 31, 0};
              pg8::gemm_phase<pg8::EpiRS, pg8::StaticOrder, true, true>(lds, g, S, E, wv); }
#endif
#if PH_B3
            { pg8::Gemm g{WUV, CKV, 512, M, opq(256), opq(256), nullptr}; pg8::StaticOrder S; S.init(512, M, G, (bx + 128) % G);
              pg8::EpiVT E{VMLAT, M, SSQCKV, 1, 1.f / 256.f};
              pg8::gemm_phase<pg8::EpiVT, pg8::StaticOrder, true, true>(lds, g, S, E, wv); }
#endif
        }
#endif
        xcd_barrier(bar);
        }
                for (int rp_ = 0; rp_ < RP_C; ++rp_) {
#if PH_C
        {
            unsigned* qhead = ctl + CW_Q + 64 * (l + 2 * rp_);
            for (;;) {
                if (wv == 0 && lane_id() == 0) MISC[0] = __hip_atomic_fetch_add(qhead, 1u, __ATOMIC_RELAXED, __HIP_MEMORY_SCOPE_AGENT);
                __syncthreads();
                const int idx = (int)MISC[0];
                __syncthreads();
                if (idx >= 32 * 48 + 256) break;
                if (idx >= 32 * 48) {
                    if (rp_ == 0) { const int wl = lane_id(); LAS float* scr = (LAS float*)(lds + wv * 16384);
                        for (int j = 0; j < 6; ++j) { const int it = NITEMS_P0 + (idx - 32 * 48) * 48 + j * 8 + wv; TrJob jb{}; TR_DECODE(it); f32x4 va[8]; tr_load(jb, va, wl); tr_finish(jb, va, scr, wl); } }
                    continue; }
                const int qb = 31 - idx / 48, r = idx % 48, q0 = qb * 256;
                int tu = wv * 64 + lane_id(); asm volatile("" : "+v"(tu));
#if PH_C_DIFF
                if (r < 16 && (rp_ == 0 || (C_REP_MASK & 1))) att::diff_unit(lds, tu, r >> 3, (r >> 1) & 3, r & 1, q0, QK + (size_t)2 * M * 512, QK + (size_t)3 * M * 512, VT, (r & 1) ? CQ : OABC + (size_t)M * 1024, (r & 1) ? 512 : 1024,
                                                                             (const GAS unsigned*)(opqp(args.ws) + WS_CTL) + CW_KN + l * 4096, rp_ ? C_ABL : 0);
#endif
#if PH_C_SB
                if (r >= 16 && r < 32 && (rp_ == 0 || (C_REP_MASK & 2))) att::sb_unit(lds, tu, (r - 16) >> 3, (r - 16) & 7, q0, QK, QK + (size_t)M * 512, VT, OABC + 512);
#endif
#if PH_C_MLA
                if (r >= 32 && (rp_ == 0 || (C_REP_MASK & 4))) att::mla_unit(lds, tu, (r - 32) >> 3, (r - 32) & 7, q0, QMLA, KNOPE, KROPE, VMLAT, OABC, rp_ ? C_ABL : 0);
#endif
            }
        }
#endif
        xcd_barrier(bar);
        }
        #undef TR_DECODE
#undef w_in
#undef g_attn
#undef w_uq
#undef g_q
#undef w_ukv
#undef g_kv
#undef w_br
#undef w_out
#undef g_cross
#undef g_mem
#undef w_xq
#undef w_xkv
#undef w_xo
#undef g_ffn
#undef w_eg
#undef w_eu
#undef w_ed
#if PH_C
        { PH_BEGIN;
          float lam, post; att::diff_lambda(INP(8) + l * 256, l, lam, post);
          for (int t0 = gw * 8; t0 < M; t0 += NGW * 8) att::diff_combine8(t0, M - t0 < 8 ? M - t0 : 8, lane, OABC + (size_t)M * 1024, CQ, lam, post, INP(9) + l * 128); }
        xcd_barrier(bar);
#endif
        for (int rp_ = 0; rp_ < RP_D1; ++rp_) {
#if PH_D1
        { pg8::Gemm g{XB, WG, M, 1024, 512, 1024, nullptr}; pg8::D1Order S; S.so.init(M, 1024, G, bx);
          const GAS char* xb_ = (const GAS char*)XB; const GAS char* oab_ = (const GAS char*)OABC; const GAS char* wg_ = (const GAS char*)WG; const GAS char* wb_ = (const GAS char*)WB;
          S.dA = (size_t)(oab_ - xb_); S.dB = (size_t)(wb_ - wg_);
          pg8::EpiD1 E{GSCR, MB, SSQ};
          pg8::gemm_phase<pg8::EpiD1, pg8::D1Order, true, true>(lds, g, S, E, wv); }
#endif
        xcd_barrier(bar);
        }
        #if PH_D2
        { pg8::Gemm g{MB, WOUT, M, 1024, D, D, nullptr}; pg8::StaticOrder S; S.init(M, 1024, G, bx);
          pg8::EpiRes E{XB, SSQ};
          pg8::gemm_phase<pg8::EpiRes, pg8::StaticOrder, true, true>(lds, g, S, E, wv); }
#endif
        xcd_barrier(bar);
                for (int rp_ = 0; rp_ < RP_E1; ++rp_) {
#if PH_E1
        { pg8::Gemm g{XB, WXQ, M, 512, 512, 1024, nullptr}; pg8::SplitK2Order S; S.so.init(M, 1024, G, bx); S.tstep = (size_t)256 * 1024 * 2;
          pg8::EpiRS E{QX, 512, SSQ, 4, 1.f / 1024.f, 0.08838834764831845f * L2E, 1, 1, (size_t)M * 512};
          pg8::gemm_phase<pg8::EpiRS, pg8::SplitK2Order, true, true>(lds, g, S, E, wv); }
#endif
        xcd_barrier(bar);
        }
                for (int rp_ = 0; rp_ < RP_E2; ++rp_) {
#if PH_E2
        { PH_BEGIN; for (int u = vcu; u < 256; u += G) att::cross_unit(lds, tid, u >> 7, (u >> 5) & 3, (u & 31) * 256, QX, XK, XVT, OX); }
#endif
        xcd_barrier(bar);
        }
        #if PH_E3
        { pg8::Gemm g{OX, WXO, M, 1024, 512, 512, nullptr}; pg8::StaticOrder S; S.init(M, 1024, G, bx);
          pg8::EpiRes E{XB, SSQ};
          pg8::gemm_phase<pg8::EpiRes, pg8::StaticOrder, true, true>(lds, g, S, E, wv); }
#endif
        xcd_barrier(bar);
                for (int rp_ = 0; rp_ < RP_F0A; ++rp_) {
#if PH_F0A
        { PH_BEGIN;
            typedef short bf16x8 __attribute__((ext_vector_type(8)));
            const GAS float* brg = INP(19) + l * 4; const GAS float* bre = INP(21) + l * 32;
            LAS float* part = (LAS float*)lds;
            const int rb = wave & 3, kh = wave >> 2, r16 = lane & 15, kq = lane >> 4;
            for (int grp = bx; grp < 256; grp += G) {
                const GAS bf16* xrow = XB + (size_t)(grp * 64 + 16 * rb + r16) * D + 512 * kh + 8 * kq;
                const GAS bf16* wh = WRH + (size_t)r16 * 1024 + 512 * kh + 8 * kq; const GAS bf16* wl = WRL + (size_t)r16 * 1024 + 512 * kh + 8 * kq;
                f32x4 acc[3];
#pragma unroll
                for (int cb = 0; cb < 3; ++cb) acc[cb] = (f32x4){0.f, 0.f, 0.f, 0.f};
#pragma unroll 8
                for (int st = 0; st < 16; ++st) {
                    const bf16x8 ah = *(const GAS bf16x8*)(xrow + 32 * st);
#pragma unroll
                    for (int cb = 0; cb < 3; ++cb) {
                        const bf16x8 bh = *(const GAS bf16x8*)(wh + (size_t)cb * 16 * 1024 + 32 * st), bl = *(const GAS bf16x8*)(wl + (size_t)cb * 16 * 1024 + 32 * st);
                        acc[cb] = __builtin_amdgcn_mfma_f32_16x16x32_bf16(ah, bh, acc[cb], 0, 0, 0);
                        acc[cb] = __builtin_amdgcn_mfma_f32_16x16x32_bf16(ah, bl, acc[cb], 0, 0, 0);
                    }
                }
                __syncthreads();
#pragma unroll
                for (int cb = 0; cb < 3; ++cb)
#pragma unroll
                    for (int r = 0; r < 4; ++r) part[(kh * 64 + 16 * rb + 4 * kq + r) * 49 + 16 * cb + r16] = acc[cb][r];
                __syncthreads();
                if (wave == 0) {
                    const int tok = grp * 64 + lane; const float rs = pg8::rstd_parts(SSQ, (unsigned)(tok * 16), 4, 1.f / 1024.f);
                    const LAS float* p0 = part + lane * 49; const LAS float* p1 = part + (64 + lane) * 49;
                    float gl[4];
#pragma unroll
                    for (int c = 0; c < 4; ++c) gl[c] = (p0[c] + p1[c]) * rs + brg[c];
                    int gs = 0; float gm = gl[0];
#pragma unroll
                    for (int c = 1; c < 4; ++c) if (gl[c] > gm) { gm = gl[c]; gs = c; }
                    float den = 0.f;
#pragma unroll
                    for (int c = 0; c < 4; ++c) den += expf(gl[c] - gm);
                    const float pg = 1.0f / den;
                    float el[8];
#pragma unroll
                    for (int j = 0; j < 8; ++j) el[j] = (p0[4 + gs * 8 + j] + p1[4 + gs * 8 + j]) * rs + bre[gs * 8 + j];
                    int i0 = 0; float v0 = el[0];
#pragma unroll
                    for (int j = 1; j < 8; ++j) if (el[j] > v0) { v0 = el[j]; i0 = j; }
                    int i1 = -1; float v1 = -INFINITY;
#pragma unroll
                    for (int j = 0; j < 8; ++j) if (j != i0 && el[j] > v1) { v1 = el[j]; i1 = j; }
                    const float e1 = expf(v1 - v0), w0 = pg / (1.f + e1), w1 = pg * e1 / (1.f + e1);
                    const int ea = gs * 8 + i0, eb = gs * 8 + i1;
                    TOKE[tok * 2] = ea; TOKE[tok * 2 + 1] = eb; TOKW[tok * 2] = w0; TOKW[tok * 2 + 1] = w1;
                    int mycnt = 0;
#pragma unroll 1
                    for (int e = 0; e < 32; ++e) { const int c = __popcll(__ballot(ea == e)) + __popcll(__ballot(eb == e)); if (lane == e) mycnt = c; }
                    if (lane < 32) HIST[grp * 32 + lane] = mycnt;
                }
            }
            __syncthreads();
        }
#endif
        xcd_barrier(bar);
        }
                for (int rp_ = 0; rp_ < RP_F0B; ++rp_) {
#if PH_F0B
        { PH_BEGIN;
            LAS int* cnt = (LAS int*)(lds + HIST_OFF);
            for (int grp = bx; grp < 256; grp += G) {
                __syncthreads();
                { const int e = tid & 31, ch = tid >> 5; int tot = 0, before = 0;
#pragma unroll
                  for (int j = 0; j < 16; ++j) { const int g2 = ch * 16 + j; const int hv = HIST[g2 * 32 + e]; tot += hv; before += (g2 < grp) ? hv : 0; }
                  cnt[128 + ch * 32 + e] = tot; cnt[640 + ch * 32 + e] = before; }
                __syncthreads();
                if (tid < 32) { int tot = 0, before = 0;
                    for (int ch = 0; ch < 16; ++ch) { tot += cnt[128 + ch * 32 + tid]; before += cnt[640 + ch * 32 + tid]; }
                    cnt[tid] = tot; cnt[32 + tid] = before; }
                __syncthreads();
                if (tid == 0) { int ts = 0; for (int e = 0; e < 32; ++e) { TSTART[e] = ts; ts += (cnt[e] + 255) >> 8; } TSTART[32] = ts; }
                __syncthreads();
                if (wave == 0) {
                    const int tok = grp * 64 + lane; const int ea = TOKE[tok * 2], eb = TOKE[tok * 2 + 1];
                    int ra = 0, rb = 0; const unsigned long long lt = (1ull << lane) - 1ull;
#pragma unroll 1
                    for (int e = 0; e < 32; ++e) { const unsigned long long ma = __ballot(ea == e), mb = __ballot(eb == e); const int c = __popcll((ma | mb) & lt); if (ea == e) ra = c; if (eb == e) rb = c; }
                    const int sa = TSTART[ea] * 256 + cnt[32 + ea] + ra, sb = TSTART[eb] * 256 + cnt[32 + eb] + rb;
                    const float rsd = pg8::rstd_parts(SSQ, (unsigned)(tok * 16), 4, 1.f / 1024.f);
                    SLOT[tok * 2] = sa; SLOT[tok * 2 + 1] = sb;
                    STOK[sa] = tok; STOK[sb] = tok; SW[sa] = TOKW[tok * 2]; SW[sb] = TOKW[tok * 2 + 1]; SRSTD[sa] = rsd; SRSTD[sb] = rsd;
                    MISC[16 + lane] = (unsigned)sa; MISC[80 + lane] = (unsigned)sb;
                }
                __syncthreads();
                if (grp < 32) { const int beg = TSTART[grp] * 256 + cnt[grp], end = TSTART[grp + 1] * 256;
                    for (int s = beg + tid; s < end; s += NTHREADS) { STOK[s] = 0; SW[s] = 0.f; SRSTD[s] = 0.f; } }
            }
            if (G > 256 || bx >= 256) {
                __syncthreads();
                if (tid < 32) { int tot = 0; for (int g2 = 0; g2 < 256; ++g2) tot += HIST[g2 * 32 + tid]; cnt[tid] = tot; }
                __syncthreads();
                if (tid == 0) { int ts = 0; for (int e = 0; e < 32; ++e) { TSTART[e] = ts; ts += (cnt[e] + 255) >> 8; } TSTART[32] = ts; }
            }
            __syncthreads();
        }
#endif
        xcd_barrier(bar);
        }
                for (int rp_ = 0; rp_ < RP_F1; ++rp_) {
#if PH_F1
        { pg8::Gemm g{XB, WGU, SROWS, 32 * 512, D, D, STOK}; pg8::MoeOrderP S{(const LAS int*)TSTART, (GAS unsigned*)(opqp(args.ws) + WS_CTL) + CW_F1 + l * 256, G, vcu};
          pg8::EpiAct E{ACT, SRSTD, SW};
          pg8::gemm_phase<pg8::EpiAct, pg8::MoeOrderP, true, true, true>(lds, g, S, E, wv); }
#endif
        }
                for (int rp_ = 0; rp_ < RP_F2; ++rp_) {
#if PH_F2
        { pg8::Gemm g{ACT, WD, SROWS, 32 * 1024, opq(256), opq(256), nullptr}; pg8::MoeOrderC S{(const LAS int*)TSTART, (const GAS unsigned*)(opqp(args.ws) + WS_CTL) + CW_F1 + l * 256, G, vcu, wv};
          pg8::EpiRS E{YB, 1024, nullptr, 0, 0.f, 1.f, 3, 31, 0};
          pg8::gemm_phase<pg8::EpiRS, pg8::MoeOrderC, true, true>(lds, g, S, E, wv); }
#endif
        xcd_barrier(bar);
        }
#if PH_F3
        { PH_BEGIN;
            const GAS float* g_fin = INP(25);
            int sn[4]; { const int m1 = gw + NGW < M ? gw + NGW : gw; sn[0] = SLOT[gw * 2]; sn[1] = SLOT[gw * 2 + 1]; sn[2] = SLOT[m1 * 2]; sn[3] = SLOT[m1 * 2 + 1]; }
            for (int m = gw; m < M; m += 2 * NGW) {
                const int mr[2] = {m, m + NGW < M ? m + NGW : m}; const int sl[4] = {sn[0], sn[1], sn[2], sn[3]};
                if (m + 2 * NGW < M) { const int n0 = m + 2 * NGW, n1 = n0 + NGW < M ? n0 + NGW : n0; sn[0] = SLOT[n0 * 2]; sn[1] = SLOT[n0 * 2 + 1]; sn[2] = SLOT[n1 * 2]; sn[3] = SLOT[n1 * 2 + 1]; }
                u32x4 ya[2][2], yb[2][2], xw[2][2];
#pragma unroll
                for (int r = 0; r < 2; ++r)
#pragma unroll
                    for (int j = 0; j < 2; ++j) { ya[r][j] = ((const GAS u32x4*)(YB + (size_t)sl[2 * r] * D))[lane + 64 * j]; yb[r][j] = ((const GAS u32x4*)(YB + (size_t)sl[2 * r + 1] * D))[lane + 64 * j];
                        xw[r][j] = ((const GAS u32x4*)(XB + (size_t)mr[r] * D))[lane + 64 * j]; }
#pragma unroll
                for (int r = 0; r < 2; ++r) {
                    float v[2][8]; float s = 0.f;
#pragma unroll
                    for (int j = 0; j < 2; ++j)
#pragma unroll
                        for (int w = 0; w < 4; ++w) { v[j][2 * w] = pg8::bflo(xw[r][j][w]) + (pg8::bflo(ya[r][j][w]) + pg8::bflo(yb[r][j][w])); v[j][2 * w + 1] = pg8::bfhi(xw[r][j][w]) + (pg8::bfhi(ya[r][j][w]) + pg8::bfhi(yb[r][j][w]));
                            s += v[j][2 * w] * v[j][2 * w] + v[j][2 * w + 1] * v[j][2 * w + 1]; }
                    s = wave_sum(s);
                    if (l == DEPTH - 1) { const float rsd = 1.0f / sqrtf(s * (1.f / 1024.f) + 1e-6f); GAS f32x4* orow = (GAS f32x4*)(OUTP + (size_t)mr[r] * D);
#pragma unroll
                        for (int j = 0; j < 2; ++j) { const f32x4 ga = ((const GAS f32x4*)g_fin)[2 * (lane + 64 * j)], gb = ((const GAS f32x4*)g_fin)[2 * (lane + 64 * j) + 1];
                            const f32x4 oa = {v[j][0] * rsd * ga[0], v[j][1] * rsd * ga[1], v[j][2] * rsd * ga[2], v[j][3] * rsd * ga[3]}, ob = {v[j][4] * rsd * gb[0], v[j][5] * rsd * gb[1], v[j][6] * rsd * gb[2], v[j][7] * rsd * gb[3]};
                            orow[2 * (lane + 64 * j)] = oa; orow[2 * (lane + 64 * j) + 1] = ob; }
                    } else {
#pragma unroll
                        for (int j = 0; j < 2; ++j) { u32x4 w4; w4.x = pk2(v[j][0], v[j][1]); w4.y = pk2(v[j][2], v[j][3]); w4.z = pk2(v[j][4], v[j][5]); w4.w = pk2(v[j][6], v[j][7]);
                            ((GAS u32x4*)(XB + (size_t)mr[r] * D))[lane + 64 * j] = w4; }
                        if (lane < 16) SSQ[(size_t)mr[r] * 16 + lane] = (lane == 0) ? s : 0.f;
                    }
                }
            }
        }
#endif
    }
}

extern "C" void kernel_launch(void* const* d_in, const int* in_sizes, int n_in, void* d_out, int out_size, void* d_ws, size_t ws_size, hipStream_t stream) {
    static int grid = 0;
    if (grid == 0) {
        if (n_in != 26 || in_sizes[0] != M * D || out_size != M * D || ws_size < WS_END) { fprintf(stderr, "kernel_launch: unexpected shapes (n_in %d, in0 %d, out %d, ws %zu < %zu)\n", n_in, n_in > 0 ? in_sizes[0] : -1, out_size, ws_size, (size_t)WS_END); grid = -1; return; }
        int dev = 0, cus = 0;
        if (hipGetDevice(&dev) != hipSuccess || hipDeviceGetAttribute(&cus, hipDeviceAttributeMultiprocessorCount, dev) != hipSuccess) { grid = -1; return; }
        if (hipFuncSetAttribute((const void*)fwd, hipFuncAttributeMaxDynamicSharedMemorySize, LDS_BYTES) != hipSuccess) { fprintf(stderr, "kernel_launch: hipFuncSetAttribute failed\n"); grid = -1; return; }
        int per_cu = 0;
        if (hipOccupancyMaxActiveBlocksPerMultiprocessor(&per_cu, (const void*)fwd, NTHREADS, LDS_BYTES) != hipSuccess || per_cu < 1) fprintf(stderr, "kernel_launch: occupancy query says %d\n", per_cu);
        (void)hipGetLastError();
        grid = cus < 256 ? (cus / 8) * 8 : 256;
    }
    if (grid <= 0) return;
    if (hipMemsetAsync((char*)d_ws + WS_CTL, 0, CTL_ZERO_BYTES, stream) != hipSuccess) return;
    Args a{};
    for (int i = 0; i < 26; ++i) a.in[i] = (const float*)d_in[i];
    a.out = (float*)d_out; a.ws = (unsigned char*)d_ws;
    hipLaunchKernelGGL(fwd, dim3(grid), dim3(NTHREADS), LDS_BYTES, stream, a);
}
```

```cpp
#include <hip/hip_runtime.h>
#include <cstdio>
#include <cstdint>
#define LAS __attribute__((address_space(3)))
#define GAS __attribute__((address_space(1)))
#ifndef PH_A
#define PH_A 1
#endif
#ifndef PH_B
#define PH_B 1
#endif
#ifndef PH_C
#define PH_C 1
#endif
#ifndef PH_D1
#define PH_D1 1
#endif
#ifndef PH_D2
#define PH_D2 1
#endif
#ifndef PH_E1
#define PH_E1 1
#endif
#ifndef PH_E2
#define PH_E2 1
#endif
#ifndef PH_E3
#define PH_E3 1
#endif
#ifndef PH_F0A
#define PH_F0A 1
#endif
#ifndef PH_F0B
#define PH_F0B 1
#endif
#ifndef PH_F1
#define PH_F1 1
#endif
#ifndef PH_F2
#define PH_F2 1
#endif
#ifndef PH_P0
#define PH_P0 1
#endif
#ifndef PH_F3
#define PH_F3 1
#endif
#ifndef PH_C_DIFF
#define PH_C_DIFF 1
#endif
#ifndef PH_C_SB
#define PH_C_SB 1
#endif
#ifndef PH_C_MLA
#define PH_C_MLA 1
#endif
#ifndef PH_B1
#define PH_B1 1
#endif
#ifndef PH_B2
#define PH_B2 1
#endif
#ifndef PH_B3
#define PH_B3 1
#endif
#ifndef RP_A
#define RP_A 1
#endif
#ifndef RP_B
#define RP_B 1
#endif
#ifndef RP_C
#define RP_C 1
#endif
#ifndef RP_D1
#define RP_D1 1
#endif
#ifndef RP_E1
#define RP_E1 1
#endif
#ifndef RP_E2
#define RP_E2 1
#endif
#ifndef RP_F0A
#define RP_F0A 1
#endif
#ifndef RP_F0B
#define RP_F0B 1
#endif
#ifndef RP_F1
#define RP_F1 1
#endif
#ifndef RP_F2
#define RP_F2 1
#endif
#ifndef RP_P0
#define RP_P0 1
#endif
#ifndef C_REP_MASK
#define C_REP_MASK 7
#endif
#ifndef A_ABL
#define A_ABL 0
#endif
#ifndef C_ABL
#define C_ABL 0
#endif
namespace pg8 {
#define PG8_LAS __attribute__((address_space(3)))
typedef unsigned short bf16_t;
typedef short bf16x8 __attribute__((ext_vector_type(8)));
typedef float f32x4 __attribute__((ext_vector_type(4)));
typedef unsigned u32x4 __attribute__((ext_vector_type(4)));
constexpr int BM = 256, BK = 64, HALF = 128, HTB = HALF * BK * 2  , STAGE_BYTES = 8 * HTB, NXCD = 8, WGM = 8;

__host__ __device__ __forceinline__ int lds_byte(int r, int c) { const int st = (r >> 4) * 2 + (c >> 5), rr = r & 15, cc = c & 31, ob = rr * 64 + cc * 2; return st * 1024 + (ob ^ (((ob >> 9) & 1) << 5)); }
__host__ __device__ __forceinline__ void stage_rc(int b, int& R, int& C) { const int st = b / 1024, sb = b % 1024, swz = sb ^ (((sb >> 9) & 1) << 5); R = (st >> 1) * 16 + swz / 64; C = (st & 1) * 32 + (swz % 64) / 2; }
__host__ __device__ __forceinline__ int perm32(int rho) { const int n = rho >> 4, i = rho & 15; return 8 * (i >> 2) + 4 * n + (i & 3); }

struct Unit { int pm, pn, sel; };
struct Gemm { const GAS bf16_t* A; const GAS bf16_t* Bt; int M, N, K, ld; const GAS int* rowidx; };

struct StaticOrder {
    int nM, nN, nwg, G, c;
    __host__ __device__ void init(int M, int N, int G_, int c_) { nM = M / BM; nN = N / BM; nwg = nM * nN; G = G_; c = c_; }
    __host__ __device__ bool next(int i, Unit& u) const {
        const long L = (long)i * G + c; if (L >= nwg) return false;
        int wgid = (int)L; { const int q = nwg / NXCD, r = nwg % NXCD, xcd = wgid % NXCD, off = wgid / NXCD; wgid = (xcd < r ? xcd * (q + 1) : r * (q + 1) + (xcd - r) * q) + off; }
        const int nig = WGM * nN, gid = wgid / nig, fm = gid * WGM, gsz = (nM - fm) < WGM ? (nM - fm) : WGM;
        u.pm = fm + ((wgid % nig) % gsz); u.pn = (wgid % nig) / gsz; u.sel = 0; return true;
    }
    __device__ __forceinline__ void a_ready(const Unit&) const {}
    __device__ __forceinline__ void done(const Unit&) const {}
    __device__ __forceinline__ size_t a_off(const Unit&) const { return 0; }
    __device__ __forceinline__ size_t b_off(const Unit&) const { return 0; }
    __device__ __forceinline__ bool keep(const Unit&) const { return false; }
};

__device__ __forceinline__ unsigned cvt_pk_bf16(float lo, float hi) { unsigned r; asm volatile("v_cvt_pk_bf16_f32 %0, %1, %2" : "=v"(r) : "v"(lo), "v"(hi)); return r; }
template <class T, class = void> struct HasScale { static constexpr bool v = false; };
template <class T> struct HasScale<T, decltype((void)T::SCALE)> { static constexpr bool v = true; };
template <class Epi, class Sched, bool ALIGN_EPI = false, bool SP2 = false, bool GATHER = false>
__device__ __forceinline__ void gemm_phase(PG8_LAS unsigned char* lds, const Gemm g, const Sched& S, const Epi& E, const int wave_idx) {
    int tid_; asm volatile("v_mbcnt_lo_u32_b32 %0, -1, 0\n\tv_mbcnt_hi_u32_b32 %0, -1, %0" : "=v"(tid_)); tid_ += wave_idx * 64;
    const int tid = tid_, wid = __builtin_amdgcn_readfirstlane(tid >> 6), lane = tid & 63, wr = wid >> 2, wc = wid & 3, fr = lane & 15, fq = lane >> 4;
    const int K = g.K, nt = K / BK, LD = g.ld;
    unsigned voffA[2], voffB[2];
#pragma unroll
    for (int i = 0; i < 2; ++i) { int R, C; stage_rc(tid * 16 + i * 8192, R, C); const int Rb = Epi::PERM ? ((R & ~31) + perm32(R & 31)) : R;
        voffA[i] = (unsigned)(R * LD + C) * 2u; voffB[i] = (unsigned)(Rb * LD + C) * 2u; }
    const size_t kstep = (size_t)(BK * 2);
    const size_t hstep = (size_t)HALF * LD * 2;
    const size_t tstep = 2 * hstep;
    const unsigned ldsw = (unsigned)wid * 1024u;
    const int aoff = lds_byte(wr * 64 + fr, fq * 8), boff = lds_byte(wc * 32 + fr, fq * 8);
#define PG8_SA(b, h) (((b) * 2 + (h)) * HTB)
#define PG8_SB(b, h) ((4 + (b) * 2 + (h)) * HTB)
#define PG8_STAGE(bufoff, gbase, voff) do { _Pragma("unroll") for (int _i = 0; _i < 2; ++_i) \
        __builtin_amdgcn_global_load_lds((const GAS unsigned*)((const GAS char*)(gbase) + (voff)[_i]), (PG8_LAS unsigned*)(lds + (bufoff) + ldsw + _i * 8192), 16, 0, 0); } while (0)
#define PG8_LDA(dst, b, h) do { _Pragma("unroll") for (int m = 0; m < 4; ++m) _Pragma("unroll") for (int k = 0; k < 2; ++k) dst[m][k] = *(const PG8_LAS bf16x8*)(lds + PG8_SA(b, h) + aoff + m * 2048 + k * 1024); } while (0)
#define PG8_LDB(dst, b, h) do { _Pragma("unroll") for (int n = 0; n < 2; ++n) _Pragma("unroll") for (int k = 0; k < 2; ++k) dst[n][k] = *(const PG8_LAS bf16x8*)(lds + PG8_SB(b, h) + boff + n * 2048 + k * 1024); } while (0)
#define PG8_MMA(ai, bj, At, Bt) do { __builtin_amdgcn_s_setprio(1); _Pragma("unroll") for (int m = 0; m < 4; ++m) _Pragma("unroll") for (int n = 0; n < 2; ++n) _Pragma("unroll") for (int k = 0; k < 2; ++k) \
        acc[ai][bj][m][n] = __builtin_amdgcn_mfma_f32_16x16x32_bf16(Bt[n][k], At[m][k], acc[ai][bj][m][n], 0, 0, 0); __builtin_amdgcn_s_setprio(0); } while (0)
#define PG8_WAIT_V(n) asm volatile("s_waitcnt vmcnt(" #n ")" ::: "memory")
#define PG8_WAIT_L(n) asm volatile("s_waitcnt lgkmcnt(" #n ")" ::: "memory")
#define PG8_BAR __builtin_amdgcn_s_barrier()
#define PG8_SCHED __builtin_amdgcn_sched_barrier(0)
    Unit cur, nxt; int ui = 0;
    if (!S.next(0, cur)) return;
    f32x4 acc[2][2][4][2];
#pragma unroll
    for (int a = 0; a < 2; ++a)
#pragma unroll
        for (int b = 0; b < 2; ++b)
#pragma unroll
            for (int m = 0; m < 4; ++m)
#pragma unroll
                for (int n = 0; n < 2; ++n) acc[a][b][m][n] = (f32x4){0.f, 0.f, 0.f, 0.f};
    bf16x8 At[4][2], B0[2][2], B1[2][2];
    const GAS char* cA = (const GAS char*)g.A + (GATHER ? (size_t)0 : (size_t)cur.pm * tstep + S.a_off(cur)); const GAS char* cB = (const GAS char*)g.Bt + (size_t)cur.pn * tstep + S.b_off(cur);
    unsigned vC[2][2], vN[2][2];
    if constexpr (GATHER) {
#pragma unroll
        for (int h = 0; h < 2; ++h)
#pragma unroll
            for (int i = 0; i < 2; ++i) { int R, C; stage_rc(tid * 16 + i * 8192, R, C); vC[h][i] = (unsigned)(g.rowidx[cur.pm * BM + h * HALF + R] * LD + C) * 2u; vN[h][i] = vC[h][i]; }
    }
#define PG8_STAGE_A(bufoff, gb, h, nx) do { if constexpr (GATHER) { unsigned vs_[2] = {(nx) ? vN[h][0] : vC[h][0], (nx) ? vN[h][1] : vC[h][1]}; PG8_STAGE(bufoff, gb, vs_); } \
        else { PG8_STAGE(bufoff, (gb) + (h) * hstep, voffA); } } while (0)
    S.a_ready(cur);
    if constexpr (SP2) {
        PG8_STAGE(PG8_SB(0, 0), cB, voffB); PG8_STAGE(PG8_SB(0, 1), cB + hstep, voffB); PG8_STAGE_A(PG8_SA(0, 0), cA, 0, false); PG8_STAGE_A(PG8_SA(0, 1), cA, 1, false);
        if (wr == 1) PG8_BAR;
        PG8_WAIT_V(2); PG8_BAR;
        PG8_STAGE(PG8_SB(1, 0), cB + kstep, voffB); PG8_STAGE_A(PG8_SA(1, 0), cA + kstep, 0, false); PG8_STAGE(PG8_SB(1, 1), cB + hstep + kstep, voffB);
        PG8_WAIT_V(6); PG8_BAR;
    } else {
        PG8_STAGE(PG8_SB(0, 0), cB, voffB); PG8_STAGE(PG8_SA(0, 0), cA, voffA); PG8_STAGE(PG8_SB(0, 1), cB + hstep, voffB); PG8_STAGE(PG8_SA(0, 1), cA + hstep, voffA);
        if (wr == 1) PG8_BAR;
        PG8_WAIT_V(4); PG8_BAR;
        PG8_STAGE(PG8_SB(1, 0), cB + kstep, voffB); PG8_STAGE(PG8_SA(1, 0), cA + kstep, voffA); PG8_STAGE(PG8_SB(1, 1), cB + hstep + kstep, voffB);
        PG8_WAIT_V(6); PG8_BAR;
    }
    for (;;) {
        const bool has_next = S.next(ui + 1, nxt);
        if constexpr (GATHER) { if (has_next) {
#pragma unroll
            for (int h = 0; h < 2; ++h)
#pragma unroll
                for (int i = 0; i < 2; ++i) { int R, C; stage_rc(tid * 16 + i * 8192, R, C); vN[h][i] = (unsigned)(g.rowidx[nxt.pm * BM + h * HALF + R] * LD + C) * 2u; } } }
        const GAS char* nA = GATHER ? cA : has_next ? (const GAS char*)g.A + (size_t)nxt.pm * tstep + S.a_off(nxt) : cA; const GAS char* nB = has_next ? (const GAS char*)g.Bt + (size_t)nxt.pn * tstep + S.b_off(nxt) : cB;
        for (int t = 0; t < nt; t += 2) {
            const bool last = (t == nt - 2);
            const GAS char* a1 = cA + (size_t)(t + 1) * kstep;
            const GAS char* a2 = last ? nA : cA + (size_t)(t + 2) * kstep; const GAS char* b2 = last ? nB : cB + (size_t)(t + 2) * kstep;
            const GAS char* a3 = a2 + kstep; const GAS char* b3 = b2 + kstep;
            if (last && has_next) S.a_ready(nxt);
            if constexpr (SP2) {
            PG8_LDB(B0, 0, 0); PG8_LDB(B1, 0, 1); PG8_SCHED; PG8_LDA(At, 0, 0); PG8_STAGE_A(PG8_SA(1, 1), a1, 1, false);
            PG8_WAIT_V(8); PG8_WAIT_L(0); PG8_BAR; PG8_MMA(0, 0, At, B0); PG8_MMA(0, 1, At, B1); PG8_BAR; PG8_SCHED;
            PG8_LDA(At, 0, 1); PG8_STAGE(PG8_SB(0, 0), b2, voffB); PG8_STAGE(PG8_SB(0, 1), b2 + hstep, voffB); PG8_STAGE_A(PG8_SA(0, 0), a2, 0, last);
            PG8_WAIT_V(8); PG8_WAIT_L(0); PG8_BAR; PG8_MMA(1, 0, At, B0); PG8_MMA(1, 1, At, B1); PG8_BAR; PG8_SCHED;
            PG8_LDB(B0, 1, 0); PG8_LDB(B1, 1, 1); PG8_SCHED; PG8_LDA(At, 1, 0); PG8_STAGE_A(PG8_SA(0, 1), a2, 1, last);
            PG8_WAIT_V(8); PG8_WAIT_L(0); PG8_BAR; PG8_MMA(0, 0, At, B0); PG8_MMA(0, 1, At, B1); PG8_BAR; PG8_SCHED;
            PG8_LDA(At, 1, 1); PG8_STAGE(PG8_SB(1, 0), b3, voffB); PG8_STAGE(PG8_SB(1, 1), b3 + hstep, voffB); PG8_STAGE_A(PG8_SA(1, 0), a3, 0, last);
            PG8_WAIT_V(8); PG8_WAIT_L(0); PG8_BAR; PG8_MMA(1, 0, At, B0); PG8_MMA(1, 1, At, B1); PG8_BAR; PG8_SCHED;
            } else {
            PG8_LDB(B0, 0, 0); PG8_SCHED; PG8_LDA(At, 0, 0); PG8_STAGE(PG8_SA(1, 1), a1 + hstep, voffA);
            PG8_WAIT_L(8); PG8_BAR; PG8_WAIT_L(0); PG8_MMA(0, 0, At, B0); PG8_BAR; PG8_SCHED;
            PG8_LDB(B1, 0, 1); PG8_STAGE(PG8_SB(0, 0), b2, voffB);
            PG8_BAR; PG8_WAIT_L(0); PG8_MMA(0, 1, At, B1); PG8_BAR;
            PG8_LDA(At, 0, 1); PG8_STAGE(PG8_SA(0, 0), a2, voffA);
            PG8_BAR; PG8_WAIT_L(0); PG8_MMA(1, 0, At, B0); PG8_BAR; PG8_SCHED;
            PG8_STAGE(PG8_SB(0, 1), b2 + hstep, voffB);
            PG8_WAIT_V(6); PG8_BAR; PG8_MMA(1, 1, At, B1); PG8_BAR;
            PG8_LDB(B0, 1, 0); PG8_SCHED; PG8_LDA(At, 1, 0); PG8_STAGE(PG8_SA(0, 1), a2 + hstep, voffA);
            PG8_WAIT_L(8); PG8_BAR; PG8_WAIT_L(0); PG8_MMA(0, 0, At, B0); PG8_BAR; PG8_SCHED;
            PG8_LDB(B1, 1, 1); PG8_STAGE(PG8_SB(1, 0), b3, voffB);
            PG8_BAR; PG8_WAIT_L(0); PG8_MMA(0, 1, At, B1); PG8_BAR;
            PG8_LDA(At, 1, 1); PG8_STAGE(PG8_SA(1, 0), a3, voffA);
            PG8_BAR; PG8_WAIT_L(0); PG8_MMA(1, 0, At, B0); PG8_BAR; PG8_SCHED;
            PG8_STAGE(PG8_SB(1, 1), b3 + hstep, voffB);
            PG8_WAIT_V(6); PG8_BAR; PG8_MMA(1, 1, At, B1); PG8_BAR;
            }
        }
        if constexpr (ALIGN_EPI) { if (wr == 0) PG8_BAR; }
        const int keep_ = (int)S.keep(cur);
        if constexpr (HasScale<Epi>::v) { if (keep_ == 2) E.scale(acc, cur, wr, wc, fr, fq); }
        if constexpr (!Epi::AFTER_DRAIN) { if (keep_ == 0) { E(acc, cur, wr, wc, fr, fq); S.done(cur); } }
        if (!has_next) break;
        if (keep_ == 0) {
#pragma unroll
        for (int a = 0; a < 2; ++a)
#pragma unroll
            for (int b = 0; b < 2; ++b)
#pragma unroll
                for (int m = 0; m < 4; ++m)
#pragma unroll
                    for (int n = 0; n < 2; ++n) acc[a][b][m][n] = (f32x4){0.f, 0.f, 0.f, 0.f}; }
        cur = nxt; cA = nA; cB = nB; ++ui;
        if constexpr (GATHER) { vC[0][0] = vN[0][0]; vC[0][1] = vN[0][1]; vC[1][0] = vN[1][0]; vC[1][1] = vN[1][1]; }
        if constexpr (ALIGN_EPI) { if (wr == 1) PG8_BAR; }
    }
    PG8_WAIT_V(0);
    if constexpr (!ALIGN_EPI) { if (wr == 0) PG8_BAR; }
    PG8_BAR;
    if constexpr (Epi::AFTER_DRAIN) { E.fused(acc, cur, wr, wc, fr, fq, lds, wid, lane); S.done(cur); }
#undef PG8_SA
#undef PG8_SB
#undef PG8_STAGE
#undef PG8_STAGE_A
#undef PG8_LDA
#undef PG8_LDB
#undef PG8_MMA
#undef PG8_WAIT_V
#undef PG8_WAIT_L
#undef PG8_BAR
#undef PG8_SCHED
}
typedef unsigned u32x2 __attribute__((ext_vector_type(2)));
typedef float f32x2v __attribute__((ext_vector_type(2)));
typedef __bf16 bf16x2v __attribute__((ext_vector_type(2)));
__device__ __forceinline__ unsigned pk2(float lo, float hi) { f32x2v v = {lo, hi}; bf16x2v b = __builtin_convertvector(v, bf16x2v); return __builtin_bit_cast(unsigned, b); }
__device__ __forceinline__ float bflo(unsigned w) { return __builtin_bit_cast(float, w << 16); }
__device__ __forceinline__ float bfhi(unsigned w) { return __builtin_bit_cast(float, w & 0xffff0000u); }
__device__ __forceinline__ float rstd_parts(const GAS float* base, unsigned eoff, int n4, float inv_n) {
    float s = 0.f; const GAS char* p = (const GAS char*)base + (size_t)(eoff * 4u);
    for (int i = 0; i < n4; ++i) { const f32x4 v = *(const GAS f32x4*)(p + 16 * i); s += (v[0] + v[1]) + (v[2] + v[3]); }
    return __builtin_amdgcn_rsqf(s * inv_n + 1e-6f);
}
__device__ __forceinline__ __amdgpu_buffer_rsrc_t wt_rsrc(GAS void* base) { return __builtin_amdgcn_make_buffer_rsrc((void*)base, 0, 0x7fffffff, 0x00020000); }
__device__ __forceinline__ void st16_wt(__amdgpu_buffer_rsrc_t r, unsigned byteoff, u32x4 v) { __builtin_amdgcn_raw_buffer_store_b128(v, r, byteoff, 0, 16); }
__device__ __forceinline__ float rows4_sum(float s) {
    const unsigned u = __builtin_bit_cast(unsigned, s);
    auto r = __builtin_amdgcn_permlane16_swap(u, u, false, false);
    const float t = __builtin_bit_cast(float, (unsigned)r[0]) + __builtin_bit_cast(float, (unsigned)r[1]);
    const unsigned v = __builtin_bit_cast(unsigned, t);
    auto q = __builtin_amdgcn_permlane32_swap(v, v, false, false);
    return __builtin_bit_cast(float, (unsigned)q[0]) + __builtin_bit_cast(float, (unsigned)q[1]);
}
__device__ __forceinline__ float rstd16_coop(const GAS float* base, unsigned row, int fq, float inv_n) {
    const f32x4 v = *(const GAS f32x4*)((const GAS char*)base + (size_t)((row * 16u + (unsigned)fq * 4u) * 4u));
    return __builtin_amdgcn_rsqf(rows4_sum((v[0] + v[1]) + (v[2] + v[3])) * inv_n + 1e-6f);
}
__device__ __forceinline__ void swap16(unsigned& a, unsigned& b) { auto r = __builtin_amdgcn_permlane16_swap(a, b, false, false); a = r[0]; b = r[1]; }
__device__ __forceinline__ int swz8(int fq) { return 8 * (((fq & 1) << 1) | (fq >> 1)); }
__device__ const double kRopeRev[16] = {0.15915494309189535, 0.08949940160889101, 0.050329212104487035, 0.0283021958306234, 0.015915494309189534, 0.008949940160889102, 0.005032921210448704, 0.00283021958306234,
                                        0.0015915494309189536, 0.0008949940160889102, 0.0005032921210448703, 0.00028302195830623395, 0.00015915494309189535, 8.949940160889102e-05, 5.0329212104487035e-05, 2.8302195830623396e-05};
__device__ __forceinline__ void rope_cs(int pos, int i, float& cs, float& sn) {
    double a = (double)pos * kRopeRev[i]; a -= __builtin_floor(a);
    const float r = (float)a; sn = __builtin_amdgcn_sinf(r); cs = __builtin_amdgcn_cosf(r);
}
#define PG8_L2E 1.4426950408889634f

struct EpiA {
    static constexpr bool PERM = false, AFTER_DRAIN = false;
    const GAS float* ssq; GAS bf16_t *cq, *ckv, *krope, *qk; GAS float *ssq_cq, *ssq_ckv; float c2; GAS unsigned* kn; int skip;
    __device__ __forceinline__ void operator()(const f32x4 (&acc)[2][2][4][2], const Unit& u, int wr, int wc, int fr, int fq) const {
        if (skip) return;
        const int pn = u.pn, row0 = u.pm * BM + wr * 64 + fr;
        float rs[2][4];
#pragma unroll
        for (int ai = 0; ai < 2; ++ai)
#pragma unroll
            for (int m = 0; m < 4; ++m) rs[ai][m] = rstd16_coop(ssq, (unsigned)(row0 + ai * HALF + m * 16), fq, 1.f / 1024.f);
        if (pn < 2) {
            GAS bf16_t* dst = pn == 0 ? cq : ckv; GAS float* sq = pn == 0 ? ssq_cq : ssq_ckv;
#pragma unroll
            for (int ai = 0; ai < 2; ++ai)
#pragma unroll
                for (int m = 0; m < 4; ++m) { const int row = row0 + ai * HALF + m * 16; const float r = rs[ai][m]; float s2 = 0.f;
#pragma unroll
                    for (int bj = 0; bj < 2; ++bj) { const f32x4 v = acc[ai][bj][m][0] * r, v2 = acc[ai][bj][m][1] * r;
                        s2 += ((v[0] * v[0] + v[1] * v[1]) + (v[2] * v[2] + v[3] * v[3])) + ((v2[0] * v2[0] + v2[1] * v2[1]) + (v2[2] * v2[2] + v2[3] * v2[3]));
                        unsigned wx = pk2(v[0], v[1]), wy = pk2(v[2], v[3]), wz = pk2(v2[0], v2[1]), ww = pk2(v2[2], v2[3]); swap16(wx, wz); swap16(wy, ww); const u32x4 w = {wx, wy, wz, ww};
                        *(GAS u32x4*)(dst + (size_t)row * 256 + bj * HALF + wc * 32 + swz8(fq)) = w; }
                    s2 = rows4_sum(s2);
                    if (fq == 0) sq[(size_t)row * 4 + wc] = s2; }
        } else if (pn == 2) {
            if (wc == 0) {
#pragma unroll
                for (int ai = 0; ai < 2; ++ai)
#pragma unroll
                    for (int m = 0; m < 4; ++m) { const int row = row0 + ai * HALF + m * 16, pos = row & 8191; const float r = rs[ai][m];
                        const f32x4 v0 = acc[ai][0][m][0] * r, v1 = acc[ai][0][m][1] * r; float o0[4], o1[4];
#pragma unroll
                        for (int e = 0; e < 4; ++e) { float cs, sn; rope_cs(pos, 4 * fq + e, cs, sn); o0[e] = v0[e] * cs - v1[e] * sn; o1[e] = v0[e] * sn + v1[e] * cs; }
                        u32x2 w0, w1; w0.x = pk2(o0[0], o0[1]); w0.y = pk2(o0[2], o0[3]); w1.x = pk2(o1[0], o1[1]); w1.y = pk2(o1[2], o1[3]);
                        *(GAS u32x2*)(krope + (size_t)row * 32 + 4 * fq) = w0; *(GAS u32x2*)(krope + (size_t)row * 32 + 16 + 4 * fq) = w1; }
            }
        } else {
            const int t = pn - 3, buf = t >> 1, half = t & 1; GAS bf16_t* dst = qk + (size_t)buf * 16384 * 512; const float sc = (buf & 1) ? 1.f : c2;
#pragma unroll
            for (int ai = 0; ai < 2; ++ai)
#pragma unroll
                for (int bj = 0; bj < 2; ++bj) { float kmx = 0.f;
#pragma unroll
                    for (int m = 0; m < 4; ++m) { const int row = row0 + ai * HALF + m * 16; const float r = rs[ai][m] * sc;
                        const f32x4 v = acc[ai][bj][m][0] * r, v2 = acc[ai][bj][m][1] * r;
                        const float s2 = ((v[0] * v[0] + v[1] * v[1]) + (v[2] * v[2] + v[3] * v[3])) + ((v2[0] * v2[0] + v2[1] * v2[1]) + (v2[2] * v2[2] + v2[3] * v2[3]));
                        unsigned wx = pk2(v[0], v[1]), wy = pk2(v[2], v[3]), wz = pk2(v2[0], v2[1]), ww = pk2(v2[2], v2[3]); swap16(wx, wz); swap16(wy, ww); const u32x4 w = {wx, wy, wz, ww};
                        *(GAS u32x4*)(dst + (size_t)row * 512 + half * 256 + bj * HALF + wc * 32 + swz8(fq)) = w;
                        kmx = fmaxf(kmx, s2); }
                    if (pn >= 9) {
                        float s = kmx; const float q1 = __shfl_xor(s, 16), q2 = __shfl_xor(s, 32), q3 = __shfl_xor(q1, 32); s = (s + q1) + (q2 + q3);
                        s = fmaxf(s, __shfl_xor(s, 1)); s = fmaxf(s, __shfl_xor(s, 2)); s = fmaxf(s, __shfl_xor(s, 4)); s = fmaxf(s, __shfl_xor(s, 8));
                        if ((fr | fq) == 0) __hip_atomic_fetch_max(kn + (((size_t)(4 * u.pm + 2 * ai + wr) * 8 + 4 * (pn - 9) + 2 * bj + (wc >> 1)) * 2 + (wc & 1)), __builtin_bit_cast(unsigned, s), __ATOMIC_RELAXED, __HIP_MEMORY_SCOPE_AGENT); } }
        }
    }
};
struct EpiVT {
    static constexpr bool PERM = true, AFTER_DRAIN = false;
    GAS bf16_t* out; int ld; const GAS float* ssq; int n4; float inv_n;
    __device__ __forceinline__ void operator()(const f32x4 (&acc)[2][2][4][2], const Unit& u, int wr, int wc, int fr, int fq) const {
        const int col0 = u.pn * BM + wc * 32 + 8 * fq, row0 = u.pm * BM + wr * 64 + fr;
        float cs[2][8];
        { const int ln = fq * 16 + fr;
          const float mine = rstd_parts(ssq, (unsigned)((u.pn * BM + wc * 32 + (ln >> 5) * HALF + ((ln >> 3) & 3) * 8 + (ln & 7)) * (4 * n4)), n4, inv_n);
#pragma unroll
          for (int bj = 0; bj < 2; ++bj)
#pragma unroll
            for (int j = 0; j < 8; ++j) cs[bj][j] = __shfl(mine, bj * 32 + fq * 8 + j); }
#pragma unroll
        for (int ai = 0; ai < 2; ++ai)
#pragma unroll
            for (int m = 0; m < 4; ++m) { GAS bf16_t* rowp = out + (size_t)(row0 + ai * HALF + m * 16) * ld + col0;
#pragma unroll
                for (int bj = 0; bj < 2; ++bj) { const f32x4 v0 = acc[ai][bj][m][0], v1 = acc[ai][bj][m][1]; u32x4 w;
                    w.x = pk2(v0[0] * cs[bj][0], v0[1] * cs[bj][1]); w.y = pk2(v0[2] * cs[bj][2], v0[3] * cs[bj][3]);
                    w.z = pk2(v1[0] * cs[bj][4], v1[1] * cs[bj][5]); w.w = pk2(v1[2] * cs[bj][6], v1[3] * cs[bj][7]);
                    *(GAS u32x4*)(rowp + bj * HALF) = w; } }
    }
};
struct EpiRS {
    static constexpr bool PERM = true, AFTER_DRAIN = false;
    GAS bf16_t* out; int ld; const GAS float* ssq; int n4; float inv_n; float scale; int pnmask; int pnshift; size_t zstride;
    __device__ __forceinline__ void operator()(const f32x4 (&acc)[2][2][4][2], const Unit& u, int wr, int wc, int fr, int fq) const {
        const int col0 = (u.pn & pnmask) * BM + wc * 32 + 8 * fq, row0 = u.pm * BM + wr * 64 + fr;
        float rr[2][4];
#pragma unroll
        for (int ai = 0; ai < 2; ++ai)
#pragma unroll
            for (int m = 0; m < 4; ++m) rr[ai][m] = (n4 ? rstd_parts(ssq, (unsigned)((row0 + ai * HALF + m * 16) * (4 * n4)), n4, inv_n) : 1.f) * scale;
#pragma unroll
        for (int ai = 0; ai < 2; ++ai)
#pragma unroll
            for (int m = 0; m < 4; ++m) { const int row = row0 + ai * HALF + m * 16; const float r = rr[ai][m];
                GAS bf16_t* rowp = out + (size_t)(u.pn >> pnshift) * zstride + (size_t)row * ld + col0;
#pragma unroll
                for (int bj = 0; bj < 2; ++bj) { const f32x4 v0 = acc[ai][bj][m][0] * r, v1 = acc[ai][bj][m][1] * r; u32x4 w;
                    w.x = pk2(v0[0], v0[1]); w.y = pk2(v0[2], v0[3]); w.z = pk2(v1[0], v1[1]); w.w = pk2(v1[2], v1[3]); *(GAS u32x4*)(rowp + bj * HALF) = w; } }
    }
};
struct EpiQ {
    static constexpr bool PERM = false, AFTER_DRAIN = false;
    GAS bf16_t* q; const GAS float* ssq_cq; float c2;
    __device__ __forceinline__ void operator()(const f32x4 (&acc)[2][2][4][2], const Unit& u, int wr, int wc, int fr, int fq) const {
        const int pn = u.pn, row0 = u.pm * BM + wr * 64 + fr;
        float rr[2][4];
#pragma unroll
        for (int ai = 0; ai < 2; ++ai)
#pragma unroll
            for (int m = 0; m < 4; ++m) rr[ai][m] = rstd_parts(ssq_cq, (unsigned)((row0 + ai * HALF + m * 16) * 4), 1, 1.f / 256.f) * c2;
#pragma unroll
        for (int ai = 0; ai < 2; ++ai)
#pragma unroll
            for (int m = 0; m < 4; ++m) { const int row = row0 + ai * HALF + m * 16; const float r = rr[ai][m];
                if (pn < 2) {
#pragma unroll
                    for (int bj = 0; bj < 2; ++bj) { const f32x4 v = acc[ai][bj][m][0] * r, v2 = acc[ai][bj][m][1] * r;
                        unsigned wx = pk2(v[0], v[1]), wy = pk2(v[2], v[3]), wz = pk2(v2[0], v2[1]), ww = pk2(v2[2], v2[3]); swap16(wx, wz); swap16(wy, ww); const u32x4 w = {wx, wy, wz, ww};
                        *(GAS u32x4*)(q + (size_t)row * 768 + pn * 256 + bj * HALF + wc * 32 + swz8(fq)) = w; }
                } else { const int pos = row & 8191; float cs[4], sn[4];
#pragma unroll
                    for (int e = 0; e < 4; ++e) rope_cs(pos, 4 * fq + e, cs[e], sn[e]);
#pragma unroll
                    for (int bj = 0; bj < 2; ++bj) { const f32x4 v0 = acc[ai][bj][m][0] * r, v1 = acc[ai][bj][m][1] * r; float o0[4], o1[4];
#pragma unroll
                        for (int e = 0; e < 4; ++e) { o0[e] = v0[e] * cs[e] - v1[e] * sn[e]; o1[e] = v0[e] * sn[e] + v1[e] * cs[e]; }
                        u32x2 w0, w1; w0.x = pk2(o0[0], o0[1]); w0.y = pk2(o0[2], o0[3]); w1.x = pk2(o1[0], o1[1]); w1.y = pk2(o1[2], o1[3]);
                        GAS bf16_t* p = q + (size_t)row * 768 + 512 + (4 * bj + wc) * 32 + 4 * fq; *(GAS u32x2*)p = w0; *(GAS u32x2*)(p + 16) = w1; }
                } }
    }
};
struct D1Order {
    StaticOrder so; size_t dA, dB;
    __device__ __forceinline__ bool next(int i, Unit& u) const { if (i >= 9) return false; if (!so.next(0, u)) return false; u.sel = i; return true; }
    __device__ __forceinline__ void a_ready(const Unit&) const {}
    __device__ __forceinline__ void done(const Unit&) const {}
    __device__ __forceinline__ size_t a_off(const Unit& u) const { const int z = u.sel - 6; return u.sel >= 6 ? dA + (size_t)(z >> 1) * 16384 * 2048 + (size_t)(z & 1) * 1024 : (size_t)(u.sel & 1) * 1024; }
    __device__ __forceinline__ size_t b_off(const Unit& u) const { const int z = u.sel - 6; return u.sel >= 6 ? dB + (size_t)(z >> 1) * 1024 * 2048 + (size_t)(z & 1) * 1024 : (size_t)(u.sel >> 1) * 1024 * 2048 + (size_t)(u.sel & 1) * 1024; }
    __device__ __forceinline__ int keep(const Unit& u) const { return u.sel < 6 ? ((u.sel & 1) ? 0 : 1) : (u.sel < 8 ? 2 : 0); }
};
struct EpiD1 {
    static constexpr bool PERM = true, AFTER_DRAIN = false, SCALE = true;
    GAS unsigned char* g; GAS bf16_t* mb; const GAS float* ssq;
    __device__ __forceinline__ void scale(f32x4 (&acc)[2][2][4][2], const Unit& u, int wr, int wc, int fr, int fq) const {
        const unsigned toff = (unsigned)(((wr * 4 + wc) * 64 + fq * 16 + fr) * 16), tile8 = (unsigned)(u.pm * 4 + u.pn) * 8u;
        const GAS unsigned char* ga = g + (size_t)((unsigned)(u.sel - 6) * 2048u + tile8) * 8192u + toff;
        const GAS unsigned char* gb = ga + (size_t)2048 * 8192;
#pragma unroll
        for (int ai = 0; ai < 2; ++ai) {
            u32x4 wa[2][2], wb[2][2];
#pragma unroll
            for (int bj = 0; bj < 2; ++bj)
#pragma unroll
                for (int mp = 0; mp < 2; ++mp) { wa[bj][mp] = *(const GAS u32x4*)(ga + ((ai * 2 + bj) * 2 + mp) * 8192); wb[bj][mp] = *(const GAS u32x4*)(gb + ((ai * 2 + bj) * 2 + mp) * 8192); }
#pragma unroll
            for (int bj = 0; bj < 2; ++bj)
#pragma unroll
                for (int mp = 0; mp < 2; ++mp)
#pragma unroll
                    for (int k = 0; k < 4; ++k) { const int m = 2 * mp + (k >> 1), n = k & 1; const unsigned qa = wa[bj][mp][k], qb = wb[bj][mp][k];
#pragma unroll
                        for (int e2 = 0; e2 < 4; ++e2) acc[ai][bj][m][n][e2] *= ((float)((qa >> (8 * e2)) & 0xffu) + 0.5f) * __builtin_amdgcn_rcpf((float)((qb >> (8 * e2)) & 0xffu) + 0.5f); }
        }
    }
    __device__ __forceinline__ void operator()(const f32x4 (&acc)[2][2][4][2], const Unit& u, int wr, int wc, int fr, int fq) const {
        const int col0 = u.pn * BM + wc * 32 + 8 * fq, row0 = u.pm * BM + wr * 64 + fr;
        const unsigned toff = (unsigned)(((wr * 4 + wc) * 64 + fq * 16 + fr) * 16), tile8 = (unsigned)(u.pm * 4 + u.pn) * 8u;
        if (u.sel < 6) {
            GAS unsigned char* gz = g + (size_t)((unsigned)(u.sel >> 1) * 2048u + tile8) * 8192u + toff;
            float rr[2][4];
#pragma unroll
            for (int ai = 0; ai < 2; ++ai)
#pragma unroll
                for (int m = 0; m < 4; ++m) rr[ai][m] = -PG8_L2E * rstd16_coop(ssq, (unsigned)(row0 + ai * HALF + m * 16), fq, 1.f / 1024.f);
#pragma unroll
            for (int ai = 0; ai < 2; ++ai)
#pragma unroll
                for (int bj = 0; bj < 2; ++bj)
#pragma unroll
                    for (int mp = 0; mp < 2; ++mp) { u32x4 w;
#pragma unroll
                        for (int k = 0; k < 4; ++k) { const int m = 2 * mp + (k >> 1), n = k & 1; const float r = rr[ai][m]; unsigned pk = 0u;
#pragma unroll
                            for (int e2 = 0; e2 < 4; ++e2) { const float sg = __builtin_amdgcn_rcpf(1.f + __builtin_amdgcn_exp2f(acc[ai][bj][m][n][e2] * r));
                                pk = __builtin_amdgcn_cvt_pk_u8_f32(fminf(sg * 256.f - 0.5f, 255.f), e2, pk); }
                            w[k] = pk; }
                        *(GAS u32x4*)(gz + ((ai * 2 + bj) * 2 + mp) * 8192) = w; }
        } else {
            const GAS unsigned char* ga = g + (size_t)(2u * 2048u + tile8) * 8192u + toff;
#pragma unroll
            for (int ai = 0; ai < 2; ++ai) {
                u32x4 wa[2][2];
#pragma unroll
                for (int bj = 0; bj < 2; ++bj)
#pragma unroll
                    for (int mp = 0; mp < 2; ++mp) wa[bj][mp] = *(const GAS u32x4*)(ga + ((ai * 2 + bj) * 2 + mp) * 8192);
#pragma unroll
                for (int m = 0; m < 4; ++m)
#pragma unroll
                    for (int bj = 0; bj < 2; ++bj) { const size_t o = (size_t)(row0 + ai * HALF + m * 16) * 1024 + col0 + bj * HALF; float v[8];
#pragma unroll
                        for (int j = 0; j < 8; ++j) { const unsigned qa = wa[bj][m >> 1][(m & 1) * 2 + (j >> 2)];
                            v[j] = acc[ai][bj][m][j >> 2][j & 3] * (((float)((qa >> (8 * (j & 3))) & 0xffu) + 0.5f) * (1.f / 256.f)); }
                        u32x4 w; w.x = pk2(v[0], v[1]); w.y = pk2(v[2], v[3]); w.z = pk2(v[4], v[5]); w.w = pk2(v[6], v[7]); *(GAS u32x4*)(mb + o) = w; } }
        }
    }
};
struct EpiRes {
    static constexpr bool PERM = true, AFTER_DRAIN = false;
    GAS bf16_t* xb; GAS float* ssq;
    __device__ __forceinline__ void operator()(const f32x4 (&acc)[2][2][4][2], const Unit& u, int wr, int wc, int fr, int fq) const {
        const int col0 = u.pn * BM + wc * 32 + 8 * fq, row0 = u.pm * BM + wr * 64 + fr;
#pragma unroll
        for (int ai = 0; ai < 2; ++ai) {
            u32x4 xv[4][2];
#pragma unroll
            for (int m = 0; m < 4; ++m)
#pragma unroll
                for (int bj = 0; bj < 2; ++bj) xv[m][bj] = *(const GAS u32x4*)(xb + (size_t)(row0 + ai * HALF + m * 16) * 1024 + col0 + bj * HALF);
#pragma unroll
            for (int m = 0; m < 4; ++m) { const int row = row0 + ai * HALF + m * 16; const size_t rb = (size_t)row * 1024 + col0; float s2 = 0.f;
#pragma unroll
                for (int bj = 0; bj < 2; ++bj) { const u32x4 xw = xv[m][bj]; const f32x4 a0 = acc[ai][bj][m][0], a1 = acc[ai][bj][m][1];
                    const float v0 = bflo(xw.x) + a0[0], v1 = bfhi(xw.x) + a0[1], v2 = bflo(xw.y) + a0[2], v3 = bfhi(xw.y) + a0[3];
                    const float v4 = bflo(xw.z) + a1[0], v5 = bfhi(xw.z) + a1[1], v6 = bflo(xw.w) + a1[2], v7 = bfhi(xw.w) + a1[3];
                    u32x4 w; w.x = pk2(v0, v1); w.y = pk2(v2, v3); w.z = pk2(v4, v5); w.w = pk2(v6, v7);
                    *(GAS u32x4*)(xb + rb + bj * HALF) = w;
                    s2 += ((v0 * v0 + v1 * v1) + (v2 * v2 + v3 * v3)) + ((v4 * v4 + v5 * v5) + (v6 * v6 + v7 * v7)); }
                s2 += __shfl_xor(s2, 16); s2 += __shfl_xor(s2, 32);
                if (fq == 0) ssq[(size_t)row * 16 + u.pn * 4 + wc] = s2; } }
    }
};
struct EpiAct {
    static constexpr bool PERM = true, AFTER_DRAIN = false;
    GAS bf16_t* act; const GAS float* s_rstd; const GAS float* s_w;
    __device__ __forceinline__ void operator()(const f32x4 (&acc)[2][2][4][2], const Unit& u, int wr, int wc, int fr, int fq) const {
        const int t = u.pn & 1, row0 = u.pm * BM + wr * 64 + fr;
        const __amdgpu_buffer_rsrc_t rsrc = __builtin_amdgcn_make_buffer_rsrc((void*)act, 0, 40960 * 256 * 2, 0x00020000);
        float rr[2][4], ww[2][4];
#pragma unroll
        for (int ai = 0; ai < 2; ++ai)
#pragma unroll
            for (int m = 0; m < 4; ++m) { rr[ai][m] = s_rstd[row0 + ai * HALF + m * 16]; ww[ai][m] = s_w[row0 + ai * HALF + m * 16]; }
#pragma unroll
        for (int ai = 0; ai < 2; ++ai)
#pragma unroll
            for (int m = 0; m < 4; ++m) { const int row = row0 + ai * HALF + m * 16; const float rs = rr[ai][m], w = ww[ai][m]; float o[8];
#pragma unroll
                for (int j = 0; j < 8; ++j) { const float a = acc[ai][0][m][j >> 2][j & 3] * rs, b = acc[ai][1][m][j >> 2][j & 3] * rs;
                    const float v = a * __builtin_amdgcn_rcpf(1.f + __builtin_amdgcn_exp2f(-PG8_L2E * a)) * b * w; o[j] = (w != 0.f) ? v : 0.f; }
                u32x4 pw; pw.x = pk2(o[0], o[1]); pw.y = pk2(o[2], o[3]); pw.z = pk2(o[4], o[5]); pw.w = pk2(o[6], o[7]);
                __builtin_amdgcn_raw_buffer_store_b128(pw, rsrc, (unsigned)(row * 256 + t * 128 + wc * 32 + 8 * fq) * 2u, 0,   16); }
    }
};
struct SplitK2Order {
    StaticOrder so; size_t tstep;
    __device__ __forceinline__ bool next(int i, Unit& u) const { return so.next(i, u); }
    __device__ __forceinline__ void a_ready(const Unit&) const {}
    __device__ __forceinline__ void done(const Unit&) const {}
    __device__ __forceinline__ size_t a_off(const Unit& u) const { return (size_t)(u.pn >> 1) * 1024; }
    __device__ __forceinline__ size_t b_off(const Unit& u) const { return (size_t)(u.pn >> 1) * 1024 - (size_t)(u.pn >> 1) * 2 * tstep; }
    __device__ __forceinline__ bool keep(const Unit&) const { return false; }
};
struct MoeOrder {
    const PG8_LAS int* tstart; int per, G, v;
    __device__ __forceinline__ bool next(int i, Unit& u) const {
        const int idx = i * G + v, tot = tstart[32] * per; if (idx >= tot) return false;
        const int ti = idx / per, ct = idx - ti * per; int e = 0;
#pragma unroll 1
        for (int k = 1; k < 32; ++k) e += (tstart[k] <= ti) ? 1 : 0;
        u.pm = ti; u.pn = e * per + ct; u.sel = 0; return true;
    }
    __device__ __forceinline__ void a_ready(const Unit&) const {}
    __device__ __forceinline__ void done(const Unit&) const {}
    __device__ __forceinline__ size_t a_off(const Unit&) const { return 0; }
    __device__ __forceinline__ size_t b_off(const Unit&) const { return 0; }
    __device__ __forceinline__ bool keep(const Unit&) const { return false; }
};
struct MoeOrderP {
    const PG8_LAS int* tstart; GAS unsigned* cnt; int G, v;
    __device__ __forceinline__ bool next(int i, Unit& u) const {
        const int idx = i * G + v, tot = tstart[32] * 2; if (idx >= tot) return false;
        const int ti = idx >> 1, ct = idx & 1; int e = 0;
#pragma unroll 1
        for (int k = 1; k < 32; ++k) e += (tstart[k] <= ti) ? 1 : 0;
        u.pm = ti; u.pn = e * 2 + ct; u.sel = 0; return true;
    }
    __device__ __forceinline__ void a_ready(const Unit&) const {}
    __device__ __forceinline__ void done(const Unit& u) const {
        asm volatile("s_waitcnt vmcnt(0)" ::: "memory");
        int ln; asm volatile("v_mbcnt_lo_u32_b32 %0, -1, 0\n\tv_mbcnt_hi_u32_b32 %0, -1, %0" : "=v"(ln));
        if (ln == 0) __hip_atomic_fetch_add(cnt + u.pm, 1u, __ATOMIC_RELAXED, __HIP_MEMORY_SCOPE_AGENT);
    }
    __device__ __forceinline__ size_t a_off(const Unit&) const { return 0; }
    __device__ __forceinline__ size_t b_off(const Unit&) const { return 0; }
    __device__ __forceinline__ bool keep(const Unit&) const { return false; }
};
struct MoeOrderC {
    const PG8_LAS int* tstart; const GAS unsigned* cnt; int G, v, wid;
    __device__ __forceinline__ bool next(int i, Unit& u) const {
        const int T = tstart[32], L = (2 * T > G) ? 2 * T - G : 0, R = G - L;
        const int idx = (v >= L) ? ((i < 2) ? i * R + (v - L) : 2 * R + (i - 2) * G + v) : 2 * R + i * G + v;
        if (idx >= 4 * T) return false;
        const int ti = idx >> 2, ct = idx & 3; int e = 0;
#pragma unroll 1
        for (int k = 1; k < 32; ++k) e += (tstart[k] <= ti) ? 1 : 0;
        u.pm = ti; u.pn = e * 4 + ct; u.sel = 0; return true;
    }
    __device__ __forceinline__ void a_ready(const Unit& u) const {
        if (wid == 0) {
            const GAS unsigned* c = cnt + u.pm; int spins = 0;
#pragma unroll 1
            while ((unsigned)__builtin_amdgcn_readfirstlane(__hip_atomic_load(c, __ATOMIC_RELAXED, __HIP_MEMORY_SCOPE_AGENT)) < 16u && ++spins < (1 << 22)) __builtin_amdgcn_s_sleep(2);
            __builtin_amdgcn_fence(__ATOMIC_ACQUIRE, "agent");
            asm volatile("s_waitcnt vmcnt(0)" ::: "memory");
        }
        __builtin_amdgcn_s_barrier();
    }
    __device__ __forceinline__ void done(const Unit&) const {}
    __device__ __forceinline__ size_t a_off(const Unit&) const { return 0; }
    __device__ __forceinline__ size_t b_off(const Unit&) const { return 0; }
    __device__ __forceinline__ bool keep(const Unit&) const { return false; }
};
}
namespace att {
typedef unsigned short bf16;
typedef short bf16x8 __attribute__((ext_vector_type(8)));
typedef short s16x4 __attribute__((ext_vector_type(4)));
typedef float f32x16 __attribute__((ext_vector_type(16)));
typedef float f32x4 __attribute__((ext_vector_type(4)));
typedef unsigned u32x4 __attribute__((ext_vector_type(4)));
typedef unsigned u32x2 __attribute__((ext_vector_type(2)));
typedef float f32x2v __attribute__((ext_vector_type(2)));
typedef __bf16 bf16x2v __attribute__((ext_vector_type(2)));
__device__ __forceinline__ unsigned pk2(float lo, float hi) { f32x2v v = {lo, hi}; bf16x2v b = __builtin_convertvector(v, bf16x2v); return __builtin_bit_cast(unsigned, b); }
__device__ __forceinline__ float bflo(unsigned w) { return __builtin_bit_cast(float, w << 16); }
__device__ __forceinline__ float bfhi(unsigned w) { return __builtin_bit_cast(float, w & 0xffff0000u); }
__device__ __forceinline__ int crow(int r, int hi) { return (r & 3) + 8 * (r >> 2) + 4 * hi; }
__device__ __forceinline__ float xhalf(float v) {
    const unsigned u = __builtin_bit_cast(unsigned, v);
    auto rr = __builtin_amdgcn_permlane32_swap(u, u, false, false);
    const unsigned o = (rr[0] != u) ? rr[0] : rr[1];
    return __builtin_bit_cast(float, o);
}
__device__ __forceinline__ bf16x8 mk8(unsigned a, unsigned b, unsigned c, unsigned d) { u32x4 w = {a, b, c, d}; return __builtin_bit_cast(bf16x8, w); }

constexpr int VPB = 144;
template <int DK> struct KLay { static constexpr int KPB = (DK + 8) * 2, KBUF = 64 * KPB; };

template <int DK, int DV, bool KROPE> struct Stage {
    static constexpr int NK = KROPE ? 1 : DK / 64, NV = DV / 64;
    u32x4 kr[NK]; u32x4 kr2; u32x4 vr[NV];
    __device__ __forceinline__ void loadK(int tid, const GAS bf16* Kg, int ldk, const GAS bf16* K2g, int kv0) {
        const GAS char* kbase = (const GAS char*)(Kg + (size_t)kv0 * ldk);
        if constexpr (KROPE) {
            kr[0] = *(const GAS u32x4*)(kbase + (unsigned)(((tid >> 3) * ldk + 8 * (tid & 7)) * 2));
            if (tid < 256) kr2 = *(const GAS u32x4*)((const GAS char*)(K2g + (size_t)kv0 * 32) + (unsigned)(tid * 16));
        } else {
#pragma unroll
            for (int i = 0; i < NK; ++i) { const int p = tid + 512 * i, row = p / (DK / 8), ch = p % (DK / 8); kr[i] = *(const GAS u32x4*)(kbase + (unsigned)((row * ldk + 8 * ch) * 2)); }
        }
    }
    __device__ __forceinline__ void loadV(int tid, const GAS bf16* Vg, int ldv, int kv0) {
        const GAS char* vbase = (const GAS char*)(Vg + kv0);
#pragma unroll
        for (int i = 0; i < NV; ++i) { const int p = tid + 512 * i, dd = p >> 3, ch = p & 7; vr[i] = *(const GAS u32x4*)(vbase + (unsigned)((dd * ldv + 8 * ch) * 2)); }
    }
    __device__ __forceinline__ void storeK(int tid, LAS unsigned char* kb) const {
        constexpr int KPB = KLay<DK>::KPB;
        if constexpr (KROPE) {
            *(LAS u32x4*)(kb + (tid >> 3) * KPB + 16 * (tid & 7)) = kr[0];
            if (tid < 256) *(LAS u32x4*)(kb + (tid >> 2) * KPB + 128 + 16 * (tid & 3)) = kr2;
        } else {
#pragma unroll
            for (int i = 0; i < NK; ++i) { const int p = tid + 512 * i, row = p / (DK / 8), ch = p % (DK / 8); *(LAS u32x4*)(kb + row * KPB + 16 * ch) = kr[i]; }
        }
    }
    __device__ __forceinline__ void storeV(int tid, LAS unsigned char* vb) const {
#pragma unroll
        for (int i = 0; i < NV; ++i) { const int p = tid + 512 * i, dd = p >> 3, ch = p & 7; LAS unsigned char* q = vb + dd * VPB + 32 * (ch >> 1) + 8 * (ch & 1);
            *(LAS u32x2*)q = (u32x2){vr[i].x, vr[i].y}; *(LAS u32x2*)(q + 16) = (u32x2){vr[i].z, vr[i].w}; }
    }
    __device__ __forceinline__ void load(int tid, const GAS bf16* Kg, int ldk, const GAS bf16* K2g, const GAS bf16* Vg, int ldv, int kv0) { loadK(tid, Kg, ldk, K2g, kv0); loadV(tid, Vg, ldv, kv0); }
    __device__ __forceinline__ void store(int tid, LAS unsigned char* kb, LAS unsigned char* vb) const { storeK(tid, kb); storeV(tid, vb); }
};

template <int DK> __device__ __forceinline__ void qkt(f32x16& p0, f32x16& p1, const LAS unsigned char* kb, const bf16x8 (&qf)[DK / 16], int r32, int hi) {
    constexpr int KPB = KLay<DK>::KPB;
    const LAS unsigned char* k0 = kb + r32 * KPB + hi * 16;
#pragma unroll
    for (int d0 = 0; d0 < DK / 16; ++d0) {
        const bf16x8 a0 = *(const LAS bf16x8*)(k0 + d0 * 32), a1 = *(const LAS bf16x8*)(k0 + 32 * KPB + d0 * 32);
        p0 = __builtin_amdgcn_mfma_f32_32x32x16_bf16(a0, qf[d0], p0, 0, 0, 0);
        p1 = __builtin_amdgcn_mfma_f32_32x32x16_bf16(a1, qf[d0], p1, 0, 0, 0);
    }
}
template <int DK> __device__ __forceinline__ void qkt_qmem(f32x16& p0, f32x16& p1, const LAS unsigned char* kb, const bf16x8* qf, const LAS unsigned char* qlds, int r32, int hi) {
    constexpr int KPB = KLay<DK>::KPB, QR = DK / 32;
    const LAS unsigned char* k0 = kb + r32 * KPB + hi * 16;
#pragma unroll
    for (int d0 = 0; d0 < DK / 16; ++d0) {
        bf16x8 q; if (d0 < QR) q = qf[d0]; else q = *(const LAS bf16x8*)(qlds + (d0 - QR) * 1024);
        const bf16x8 a0 = *(const LAS bf16x8*)(k0 + d0 * 32), a1 = *(const LAS bf16x8*)(k0 + 32 * KPB + d0 * 32);
        p0 = __builtin_amdgcn_mfma_f32_32x32x16_bf16(a0, q, p0, 0, 0, 0);
        p1 = __builtin_amdgcn_mfma_f32_32x32x16_bf16(a1, q, p1, 0, 0, 0);
        if ((d0 & 3) == 3) __builtin_amdgcn_sched_barrier(0);
    }
}
template <int DV> __device__ __forceinline__ void pv(f32x16 (&o)[DV / 32], const LAS unsigned char* vb, const bf16x8 (&pf)[4], int r32, int hi) {
#pragma unroll
    for (int db = 0; db < DV / 32; ++db) {
        const LAS unsigned char* v0 = vb + (32 * db + r32) * VPB + 16 * hi;
#pragma unroll
        for (int s = 0; s < 4; ++s) {
            const bf16x8 vf = *(const LAS bf16x8*)(v0 + 32 * s);
            o[db] = __builtin_amdgcn_mfma_f32_32x32x16_bf16(vf, pf[s], o[db], 0, 0, 0);
        }
        if (DV > 64) __builtin_amdgcn_sched_barrier(0);
    }
}
__device__ __forceinline__ void pack_p(bf16x8 (&pf)[4], const f32x16& p0, const f32x16& p1) {
    pf[0] = mk8(pk2(p0[0], p0[1]), pk2(p0[2], p0[3]), pk2(p0[4], p0[5]), pk2(p0[6], p0[7]));
    pf[1] = mk8(pk2(p0[8], p0[9]), pk2(p0[10], p0[11]), pk2(p0[12], p0[13]), pk2(p0[14], p0[15]));
    pf[2] = mk8(pk2(p1[0], p1[1]), pk2(p1[2], p1[3]), pk2(p1[4], p1[5]), pk2(p1[6], p1[7]));
    pf[3] = mk8(pk2(p1[8], p1[9]), pk2(p1[10], p1[11]), pk2(p1[12], p1[13]), pk2(p1[14], p1[15]));
}

template <bool ALIBI> __device__ __forceinline__ void fl_init(f32x16& p0, f32x16& p1, float slope2, int kv0, int hi, int qrow) {
    if (ALIBI) {
        const float s2 = slope2 + slope2, s4 = s2 + s2, s8 = s4 + s4, s32 = (s8 + s8) + (s8 + s8);
        float g = slope2 * (float)(kv0 + 4 * hi - qrow);
#pragma unroll
        for (int c = 0; c < 4; ++c) { float v = g;
#pragma unroll
            for (int e = 0; e < 4; ++e) { p0[4 * c + e] = v; p1[4 * c + e] = v + s32; v += slope2; }
            g += s8; } }
    else {
#pragma unroll
        for (int r = 0; r < 16; ++r) { p0[r] = 0.f; p1[r] = 0.f; } }
}
__device__ __forceinline__ void fl_mask(f32x16& p0, f32x16& p1, int kv0, int hi, int qrow) {
    const int thr = qrow - kv0 - 4 * hi;
#pragma unroll
    for (int r = 0; r < 16; ++r) { const int c = (r & 3) + 8 * (r >> 2); if (c > thr) p0[r] = -INFINITY; if (c + 32 > thr) p1[r] = -INFINITY; }
}
__device__ __forceinline__ void fl_start(const f32x16& p0, const f32x16& p1, float& m, float& alpha) {
    float mx = fmaxf(p0[0], p1[0]);
#pragma unroll
    for (int r = 1; r < 16; ++r) mx = fmaxf(fmaxf(mx, p0[r]), p1[r]);
    mx = fmaxf(mx, xhalf(mx));
    const float mn = fmaxf(m, mx); alpha = __builtin_amdgcn_exp2f(m - mn); m = mn;
}
__device__ __forceinline__ void fl_finish(f32x16& p0, f32x16& p1, float m, float& l, bf16x8 (&pf)[4]) {
    float s0 = 0.f, s1 = 0.f;
#pragma unroll
    for (int r = 0; r < 16; ++r) { p0[r] = __builtin_amdgcn_exp2f(p0[r] - m); p1[r] = __builtin_amdgcn_exp2f(p1[r] - m); s0 += p0[r]; s1 += p1[r]; }
    l += s0 + s1;
    pack_p(pf, p0, p1);
}

#define FL_EL(P0, P1, e) ((e) < 16 ? P0[(e) & 15] : P1[(e) & 15])
template <int DK, bool QMEM> __device__ __forceinline__ void fl_blockX(f32x16& n0, f32x16& n1, const LAS unsigned char* kb, const bf16x8* qf, const LAS unsigned char* qlds, int r32, int hi,
                                                                         f32x16& c0, f32x16& c1, float m, float& l, bf16x8 (&pf)[4]) {
    constexpr int KPB = KLay<DK>::KPB, NS = DK / 16, CH = ((32 + NS - 1) / NS + 1) & ~1;
    const LAS unsigned char* k0 = kb + r32 * KPB + hi * 16;
    float s0 = 0.f, s1 = 0.f; unsigned pw[16];
#define FLX_K0(s) (*(const LAS bf16x8*)(k0 + ((s) < NS ? (s) : NS - 1) * 32))
#define FLX_K1(s) (*(const LAS bf16x8*)(k0 + 32 * KPB + ((s) < NS ? (s) : NS - 1) * 32))
    bf16x8 a0 = FLX_K0(0), a1 = FLX_K1(0), b0 = FLX_K0(1), b1 = FLX_K1(1), e0 = FLX_K0(2), e1 = FLX_K1(2);
    bf16x8 q, qb, qe; if constexpr (QMEM) { q = *(const LAS bf16x8*)(qlds); qb = *(const LAS bf16x8*)(qlds + (NS > 1 ? 1024 : 0)); qe = *(const LAS bf16x8*)(qlds + (NS > 2 ? 2048 : 0)); } else { q = qf[0]; qb = qf[NS > 1 ? 1 : 0]; qe = qf[NS > 2 ? 2 : 0]; }
#pragma unroll
    for (int d0 = 0; d0 < NS; ++d0) {
        bf16x8 c0n = e0, c1n = e1, qc = qe;
        if (d0 + 3 < NS) { c0n = FLX_K0(d0 + 3); c1n = FLX_K1(d0 + 3);
            if constexpr (QMEM) qc = *(const LAS bf16x8*)(qlds + (d0 + 3) * 1024); else qc = qf[d0 + 3]; }
        n0 = __builtin_amdgcn_mfma_f32_32x32x16_bf16(a0, q, n0, 0, 0, 0);
        n1 = __builtin_amdgcn_mfma_f32_32x32x16_bf16(a1, q, n1, 0, 0, 0);
#pragma unroll
        for (int e = d0 * CH; e < (d0 + 1) * CH && e < 32; e += 2) {
            float x, y;
            if (e < 16) { x = __builtin_amdgcn_exp2f(c0[e] - m); y = __builtin_amdgcn_exp2f(c0[e + 1] - m); s0 += x; s1 += y; }
            else { x = __builtin_amdgcn_exp2f(c1[e - 16] - m); y = __builtin_amdgcn_exp2f(c1[e - 15] - m); s0 += x; s1 += y; }
            pw[e >> 1] = pk2(x, y); asm volatile("" : "+v"(pw[e >> 1])); }
        asm volatile("" : "+v"(s0), "+v"(s1));
        __builtin_amdgcn_sched_barrier(0);
        a0 = b0; a1 = b1; q = qb; b0 = e0; b1 = e1; qb = qe; e0 = c0n; e1 = c1n; qe = qc;
    }
#undef FLX_K0
#undef FLX_K1
    l += s0 + s1;
    pf[0] = mk8(pw[0], pw[1], pw[2], pw[3]); pf[1] = mk8(pw[4], pw[5], pw[6], pw[7]); pf[2] = mk8(pw[8], pw[9], pw[10], pw[11]); pf[3] = mk8(pw[12], pw[13], pw[14], pw[15]);
}
template <int DV> __device__ __forceinline__ void fl_blockY(f32x16 (&o)[DV / 32], const LAS unsigned char* vb, const bf16x8 (&pf)[4], int r32, int hi, const f32x16& n0, const f32x16& n1, float& m, float& alpha) {
    constexpr int NS = DV / 8, CH = 32 / NS;
    float mx0 = -INFINITY, mx1 = -INFINITY;
    const LAS unsigned char* v0 = vb + r32 * VPB + 16 * hi;
    bf16x8 vf = *(const LAS bf16x8*)(v0), vg = *(const LAS bf16x8*)(v0 + 32);
#pragma unroll
    for (int st = 0; st < NS; ++st) {
        const int db = st >> 2, s = st & 3;
        bf16x8 vn = vg;
        if (st + 2 < NS) vn = *(const LAS bf16x8*)(v0 + ((st + 2) >> 2) * 32 * VPB + 32 * ((st + 2) & 3));
        o[db] = __builtin_amdgcn_mfma_f32_32x32x16_bf16(vf, pf[s], o[db], 0, 0, 0);
#pragma unroll
        for (int e = st * CH; e < (st + 1) * CH; ++e) { if (e < 16) mx0 = fmaxf(mx0, n0[e]); else mx1 = fmaxf(mx1, n1[e - 16]); }
        asm volatile("" : "+v"(mx0), "+v"(mx1));
        __builtin_amdgcn_sched_barrier(0);
        vf = vg; vg = vn;
    }
    float mx = fmaxf(mx0, mx1); mx = fmaxf(mx, xhalf(mx));
    const float mn = fmaxf(m, mx); alpha = __builtin_amdgcn_exp2f(m - mn); m = mn;
}

template <int DK, int DV, bool CAUSAL, bool ALIBI, bool KROPE, bool QMEM = false, bool DESC = false>
__device__ __forceinline__ void flash_pass(LAS unsigned char* lds, int tid, const GAS bf16* Qrow, const GAS bf16* Qrow2, const GAS bf16* Kg, int ldk, const GAS bf16* K2g, const GAS bf16* Vg, int ldv,
                                           int NT, int ntw, int qrow, float slope2, f32x16 (&o)[DV / 32], float& lsum, const GAS unsigned* kn = nullptr, int abl = 0) {
    constexpr int KBUF = KLay<DK>::KBUF, VBUF = DV * VPB, QOFF = 2 * KBUF + 2 * VBUF, XOFF = QOFF + 8 * (DK / 16) * 1024;
    constexpr bool CUT = DESC && ALIBI;
    const int lane = tid & 63, r32 = lane & 31, hi = lane >> 5, wid = tid >> 6;
#define FL_TI(i) (DESC ? NT - 1 - (i) : (i))
    bf16x8 qf[QMEM ? 1 : DK / 16];
    LAS unsigned char* qlds = lds + QOFF + wid * (DK / 16) * 1024 + lane * 16;
    float qn2 = 0.f;
#pragma unroll
    for (int d0 = 0; d0 < DK / 16; ++d0) {
        bf16x8 v;
        if (KROPE && d0 >= 4) v = *(const GAS bf16x8*)(Qrow2 + 16 * (d0 - 4) + 8 * hi);
        else v = *(const GAS bf16x8*)(Qrow + 16 * d0 + 8 * hi);
        if constexpr (CUT) {
#pragma unroll
            for (int j = 0; j < 8; ++j) { const float f = __builtin_bit_cast(float, (unsigned)(unsigned short)v[j] << 16); qn2 += f * f; } }
        if constexpr (QMEM) *(LAS bf16x8*)(qlds + d0 * 1024) = v; else qf[d0] = v;
    }
    volatile LAS float* kpre = (volatile LAS float*)(lds + XOFF);
    volatile LAS unsigned* dflag = (volatile LAS unsigned*)(lds + XOFF + 512);
    float qn = 0.f;
    if constexpr (CUT) {
        qn2 += xhalf(qn2); qn = sqrtf(qn2);
        if (wid == 0) {
            float v0 = 0.f, v1 = 0.f;
            if (lane < NT) v0 = sqrtf(__builtin_bit_cast(float, kn[(size_t)lane * 16]) + __builtin_bit_cast(float, kn[(size_t)lane * 16 + 1])) * 1.01f;
            if (lane + 64 < NT) v1 = sqrtf(__builtin_bit_cast(float, kn[(size_t)(lane + 64) * 16]) + __builtin_bit_cast(float, kn[(size_t)(lane + 64) * 16 + 1])) * 1.01f;
#pragma unroll
            for (int dd = 1; dd < 64; dd <<= 1) { const float u0 = __shfl_up(v0, dd), u1 = __shfl_up(v1, dd); if (lane >= dd) { v0 = fmaxf(v0, u0); v1 = fmaxf(v1, u1); } }
            v1 = fmaxf(v1, __shfl(v0, 63));
            kpre[lane] = v0; kpre[lane + 64] = v1;
        }
    }
#pragma unroll
    for (int db = 0; db < DV / 32; ++db)
#pragma unroll
        for (int r = 0; r < 16; ++r) o[db][r] = 0.f;
    float m = -INFINITY, l = 0.f, alpha = 1.0f;
    int cut = NT;
    Stage<DK, DV, KROPE> st;
    st.loadK(tid, Kg, ldk, K2g, 64 * FL_TI(0)); st.loadV(tid, Vg, ldv, 64 * FL_TI(0));
    st.storeK(tid, lds); st.storeV(tid, lds + 2 * KBUF);
    if (NT > 1) { st.loadK(tid, Kg, ldk, K2g, 64 * FL_TI(1)); st.storeK(tid, lds + KBUF); }
    __syncthreads();
    if (NT > 2) st.loadK(tid, Kg, ldk, K2g, 64 * FL_TI(2));
    if (NT > 1) st.loadV(tid, Vg, ldv, 64 * FL_TI(1));
    f32x16 pa0, pa1, pb0, pb1;
#define FL_QKT(P0, P1, KB) do { if constexpr (QMEM) { bf16x8 qt_[DK / 16]; _Pragma("unroll") for (int d0 = 0; d0 < DK / 16; ++d0) qt_[d0] = *(const LAS bf16x8*)(qlds + d0 * 1024); qkt<DK>(P0, P1, KB, qt_, r32, hi); } else qkt<DK>(P0, P1, KB, qf, r32, hi); } while (0)
#define FL_FIRST(P0, P1, KB, TILE) do { const int kv_ = 64 * (TILE); fl_init<ALIBI>(P0, P1, slope2, kv_, hi, qrow); FL_QKT(P0, P1, KB); \
        if (CAUSAL && kv_ + 63 > qrow - r32) fl_mask(P0, P1, kv_, hi, qrow); fl_start(P0, P1, m, alpha); } while (0)
    if (FL_TI(0) < ntw) FL_FIRST(pa0, pa1, lds, FL_TI(0));
    __syncthreads();
    for (int i = 0; i < NT; ++i) {
        int tq_ = tid; asm volatile("" : "+v"(tq_));
        if (!(abl & 1)) {
            if (i + 2 < NT) st.storeK(tq_, lds + (i & 1) * KBUF);
            if (i + 1 < NT) st.storeV(tq_, lds + 2 * KBUF + ((i + 1) & 1) * VBUF);
            if (i + 3 < NT) st.loadK(tq_, Kg, ldk, K2g, 64 * FL_TI(i + 3));
            if (i + 2 < NT) st.loadV(tq_, Vg, ldv, 64 * FL_TI(i + 2)); }
        const int tc = FL_TI(i), tn = FL_TI(i + 1);
        const bool ac = tc < ntw && i < cut && !(abl & 2);
        bool an = i + 1 < NT && tn < ntw && i + 1 < cut && !(abl & 2);
        if constexpr (CUT) {
            if (ac && an) {
                const bool dead = qn * kpre[tn] + slope2 * (float)(64 * tn + 63 - qrow) < m - 64.f;
                if (__all(dead)) { cut = i + 1; an = false; } } }
        const LAS unsigned char* kn_ = lds + ((i + 1) & 1) * KBUF; const LAS unsigned char* vc_ = lds + 2 * KBUF + (i & 1) * VBUF;
        if (ac) {
            l *= alpha;
            if (__any(alpha != 1.0f)) {
#pragma unroll
                for (int db = 0; db < DV / 32; ++db) asm volatile("" : "+v"(o[db]));
#pragma unroll
                for (int db = 0; db < DV / 32; ++db)
#pragma unroll
                    for (int r = 0; r < 16; ++r) o[db][r] *= alpha;
#pragma unroll
                for (int db = 0; db < DV / 32; ++db) asm volatile("" : "+v"(o[db])); }
            bf16x8 pf[4];
            if (an) {
                const int kv1_ = 64 * tn;
                const bool diag_ = CAUSAL && (kv1_ + 63 > qrow - r32);
                fl_init<ALIBI>(pb0, pb1, slope2, kv1_, hi, qrow);
                fl_blockX<DK, QMEM>(pb0, pb1, kn_, qf, qlds, r32, hi, pa0, pa1, m, l, pf);
                if (!diag_) { fl_blockY<DV>(o, vc_, pf, r32, hi, pb0, pb1, m, alpha); }
                else { pv<DV>(o, vc_, pf, r32, hi); fl_mask(pb0, pb1, kv1_, hi, qrow); fl_start(pb0, pb1, m, alpha); }
            } else {
                fl_finish(pa0, pa1, m, l, pf); pv<DV>(o, vc_, pf, r32, hi);
            }
        } else if (an) { FL_FIRST(pb0, pb1, kn_, tn); }
        if constexpr (CUT) { if (lane == 0) dflag[(i & 1) * 8 + wid] = (i + 1 >= cut) ? 1u : 0u; }
        if (!(abl & 4)) __syncthreads();
        if constexpr (CUT) { unsigned alld = 1u;
#pragma unroll
            for (int w = 0; w < 8; ++w) alld &= dflag[(i & 1) * 8 + w];
            if (alld) break; }
        if (!(abl & 8)) { pa0 = pb0; pa1 = pb1; }
    }
#undef FL_FIRST
#undef FL_QKT
#undef FL_TI
    lsum = l + xhalf(l);
}

template <int DK, int DV, bool CAUSAL, bool ALIBI, bool KROPE, bool QMEM = false>
__device__ __forceinline__ void flash_pass_simple(LAS unsigned char* lds, int tid, const GAS bf16* Qrow, const GAS bf16* Qrow2, const GAS bf16* Kg, int ldk, const GAS bf16* K2g, const GAS bf16* Vg, int ldv,
                                           int NT, int ntw, int qrow, float slope2, f32x16 (&o)[DV / 32], float& lsum) {
    constexpr int KBUF = KLay<DK>::KBUF, VBUF = DV * VPB;
    const int lane = tid & 63, r32 = lane & 31, hi = lane >> 5;
    constexpr int QR = QMEM ? DK / 32 : DK / 16;
    bf16x8 qf[QR];
    LAS unsigned char* qlds = lds + 2 * KBUF + 2 * VBUF + (tid >> 6) * (DK / 16 - QR + 1) * 1024 + lane * 16;
#pragma unroll
    for (int d0 = 0; d0 < DK / 16; ++d0) {
        bf16x8 v;
        if (KROPE && d0 >= 4) v = *(const GAS bf16x8*)(Qrow2 + 16 * (d0 - 4) + 8 * hi);
        else v = *(const GAS bf16x8*)(Qrow + 16 * d0 + 8 * hi);
        if constexpr (!KROPE && QMEM) {
            const bf16x8 w2 = *(const GAS bf16x8*)(Qrow2 + 16 * d0 + 8 * hi); const u32x4 a4 = __builtin_bit_cast(u32x4, v), b4 = __builtin_bit_cast(u32x4, w2); u32x4 r4;
            r4.x = pk2(bflo(a4.x) + bflo(b4.x), bfhi(a4.x) + bfhi(b4.x)); r4.y = pk2(bflo(a4.y) + bflo(b4.y), bfhi(a4.y) + bfhi(b4.y));
            r4.z = pk2(bflo(a4.z) + bflo(b4.z), bfhi(a4.z) + bfhi(b4.z)); r4.w = pk2(bflo(a4.w) + bflo(b4.w), bfhi(a4.w) + bfhi(b4.w)); v = __builtin_bit_cast(bf16x8, r4); }
        if (d0 < QR) qf[d0] = v; else *(LAS bf16x8*)(qlds + (d0 - QR) * 1024) = v;
    }
#pragma unroll
    for (int db = 0; db < DV / 32; ++db)
#pragma unroll
        for (int r = 0; r < 16; ++r) o[db][r] = 0.f;
    float m = -INFINITY, l = 0.f;
    Stage<DK, DV, KROPE> st;
    st.load(tid, Kg, ldk, K2g, Vg, ldv, 0);
    st.store(tid, lds, lds + 2 * KBUF);
    __syncthreads();
    for (int t = 0; t < NT; ++t) {
        const int cur = t & 1, kv0 = 64 * t;
        if (t + 1 < NT) st.load(tid, Kg, ldk, K2g, Vg, ldv, kv0 + 64);
        if (t < ntw) {
            const LAS unsigned char* kb = lds + cur * KBUF; const LAS unsigned char* vb = lds + 2 * KBUF + cur * VBUF;
            f32x16 p0, p1;
            if (ALIBI) { const float base = slope2 * (float)(kv0 + 4 * hi - qrow);
#pragma unroll
                for (int r = 0; r < 16; ++r) { p0[r] = __builtin_fmaf(slope2, (float)((r & 3) + 8 * (r >> 2)), base); p1[r] = __builtin_fmaf(slope2, (float)(32 + (r & 3) + 8 * (r >> 2)), base); } }
            else {
#pragma unroll
                for (int r = 0; r < 16; ++r) { p0[r] = 0.f; p1[r] = 0.f; } }
            if constexpr (QMEM) qkt_qmem<DK>(p0, p1, kb, qf, qlds, r32, hi); else qkt<DK>(p0, p1, kb, qf, r32, hi);
            if (CAUSAL && kv0 + 63 > qrow - r32) {
#pragma unroll
                for (int r = 0; r < 16; ++r) { const int kv = kv0 + crow(r, hi); if (kv > qrow) p0[r] = -INFINITY; if (kv + 32 > qrow) p1[r] = -INFINITY; } }
            float mx = p0[0];
#pragma unroll
            for (int r = 1; r < 16; ++r) mx = fmaxf(mx, p0[r]);
#pragma unroll
            for (int r = 0; r < 16; ++r) mx = fmaxf(mx, p1[r]);
            mx = fmaxf(mx, xhalf(mx));
            const float mn = fmaxf(m, mx), alpha = __builtin_amdgcn_exp2f(m - mn); m = mn;
            l *= alpha;
            if (__any(alpha != 1.0f)) {
#pragma unroll
                for (int db = 0; db < DV / 32; ++db)
#pragma unroll
                    for (int r = 0; r < 16; ++r) o[db][r] *= alpha; }
            float s = 0.f;
#pragma unroll
            for (int r = 0; r < 16; ++r) { p0[r] = __builtin_amdgcn_exp2f(p0[r] - mn); p1[r] = __builtin_amdgcn_exp2f(p1[r] - mn); s += p0[r] + p1[r]; }
            l += s;
            bf16x8 pf[4]; pack_p(pf, p0, p1);
            pv<DV>(o, vb, pf, r32, hi);
        }
        if (t + 1 < NT) st.store(tid, lds + (cur ^ 1) * KBUF, lds + 2 * KBUF + (cur ^ 1) * VBUF);
        __syncthreads();
    }
    lsum = l + xhalf(l);
}


template <int DV> __device__ __forceinline__ void store_o(GAS bf16* Orow, const f32x16 (&o)[DV / 32], float sc, int hi) {
#pragma unroll
    for (int db = 0; db < DV / 32; ++db)
#pragma unroll
        for (int c = 0; c < 4; ++c) { u32x2 w; w.x = pk2(o[db][4 * c] * sc, o[db][4 * c + 1] * sc); w.y = pk2(o[db][4 * c + 2] * sc, o[db][4 * c + 3] * sc);
            *(GAS u32x2*)(Orow + 32 * db + 8 * c + 4 * hi) = w; }
}

__device__ __forceinline__ void mla_unit(LAS unsigned char* lds, int tid, int b, int h, int q0, const GAS bf16* qmla, const GAS bf16* knope, const GAS bf16* krope, const GAS bf16* vT, GAS bf16* out, int abl) {
    const int lane = tid & 63, wid = tid >> 6, r32 = lane & 31, hi = lane >> 5;
    const size_t tb = (size_t)b * 8192; const int qrow = q0 + 32 * wid + r32;
    const GAS bf16* Qr = qmla + (tb + qrow) * 768;
    f32x16 o[2]; float l;
    flash_pass<96, 64, true, false, true>(lds, tid, Qr + h * 64, Qr + 512 + h * 32, knope + tb * 512 + h * 64, 512, krope + tb * 32, vT + (size_t)(h * 64) * 16384 + tb, 16384,
                                          q0 / 64 + 4, (q0 + 32 * wid + 31) / 64 + 1, qrow, 0.f, o, l, nullptr, abl);
    if (abl == 0 || l == 12345.678f) store_o<64>(out + (tb + qrow) * 1024 + h * 64, o, 1.0f / l, hi);
}
__device__ __forceinline__ void cross_unit(LAS unsigned char* lds, int tid, int b, int h, int q0, const GAS bf16* qx, const GAS bf16* xk, const GAS bf16* xvT, GAS bf16* out) {
    const int lane = tid & 63, wid = tid >> 6, r32 = lane & 31, hi = lane >> 5;
    const size_t tb = (size_t)b * 8192; const int qrow = q0 + 32 * wid + r32;
    f32x16 o[4]; float l;
    int nt = 4; asm volatile("" : "+s"(nt));
    flash_pass_simple<128, 128, false, false, false, true>(lds, tid, qx + (tb + qrow) * 512 + h * 128, qx + (size_t)16384 * 512 + (tb + qrow) * 512 + h * 128, xk + (size_t)(b * 256) * 512 + h * 128, 512, nullptr, xvT + (size_t)(h * 128) * 512 + b * 256, 512,
                                              nt, nt, qrow, 0.f, o, l);
    store_o<128>(out + (tb + qrow) * 512 + h * 128, o, 1.0f / l, hi);
}
__device__ __forceinline__ void diff_unit(LAS unsigned char* lds, int tid, int b, int h, int hf, int q0, const GAS bf16* dq, const GAS bf16* dk, const GAS bf16* vT, GAS bf16* out, int ldo, const GAS unsigned* knl, int abl) {
    const int lane = tid & 63, wid = tid >> 6, r32 = lane & 31, hi = lane >> 5;
    const size_t tb = (size_t)b * 8192; const int qrow = q0 + 32 * wid + r32;
    const float slope2 = __builtin_amdgcn_exp2f(-2.0f * (float)(h + 1)) * 1.4426950408889634f;
    const int NT = q0 / 64 + 4, ntw = (q0 + 32 * wid + 31) / 64 + 1;
    f32x16 o[4]; float l;
    flash_pass<64, 128, true, true, false, true, true>(lds, tid, dq + (tb + qrow) * 512 + h * 128 + hf * 64, nullptr, dk + tb * 512 + h * 128 + hf * 64, 512, nullptr, vT + (size_t)(512 + h * 128) * 16384 + tb, 16384,
                                                      NT, ntw, qrow, slope2, o, l, knl + ((size_t)(b * 128) * 8 + 2 * h + hf) * 2, abl);
    if (abl == 0 || l == 12345.678f) store_o<128>(out + (tb + qrow) * (size_t)ldo + h * 128, o, 1.0f / l, hi);
}
__device__ __forceinline__ void diff_lambda(const GAS float* lp, int layer, float& lam, float& post) {
    float q1 = 0.f, q2 = 0.f;
    for (int i = 0; i < 64; ++i) { q1 += lp[i] * lp[64 + i]; q2 += lp[128 + i] * lp[192 + i]; }
    const float lam_init = (layer == 0) ? 0.2f : 0.35550906759f;
    lam = expf(q1) - expf(q2) + lam_init; post = 1.f - lam_init;
}
__device__ __forceinline__ void diff_combine8(int tok0, int ntok, int lane, GAS bf16* o0, const GAS bf16* o1, float lam, float post, const GAS float* subln) {
    u32x4 a[8], c[8];
#pragma unroll
    for (int j = 0; j < 8; ++j) { const int tok = tok0 + (j < ntok ? j : 0);
        a[j] = *(const GAS u32x4*)(o0 + (size_t)tok * 1024 + 8 * lane); c[j] = *(const GAS u32x4*)(o1 + (size_t)tok * 512 + 8 * lane); }
    const f32x4 g0 = *(const GAS f32x4*)(subln + 8 * (lane & 15)), g1 = *(const GAS f32x4*)(subln + 8 * (lane & 15) + 4);
#pragma unroll
    for (int j = 0; j < 8; ++j) {
        float x[8];
#pragma unroll
        for (int w = 0; w < 4; ++w) { x[2 * w] = bflo(a[j][w]) - lam * bflo(c[j][w]); x[2 * w + 1] = bfhi(a[j][w]) - lam * bfhi(c[j][w]); }
        float s2 = ((x[0] * x[0] + x[1] * x[1]) + (x[2] * x[2] + x[3] * x[3])) + ((x[4] * x[4] + x[5] * x[5]) + (x[6] * x[6] + x[7] * x[7]));
#pragma unroll
        for (int dd = 1; dd < 16; dd <<= 1) s2 += __shfl_xor(s2, dd);
        const float rs = __builtin_amdgcn_rsqf(s2 * (1.f / 128.f) + 1e-6f) * post;
        u32x4 w4; w4.x = pk2(x[0] * rs * g0[0], x[1] * rs * g0[1]); w4.y = pk2(x[2] * rs * g0[2], x[3] * rs * g0[3]); w4.z = pk2(x[4] * rs * g1[0], x[5] * rs * g1[1]); w4.w = pk2(x[6] * rs * g1[2], x[7] * rs * g1[3]);
        if (j < ntok) *(GAS u32x4*)(o0 + (size_t)(tok0 + j) * 1024 + 8 * lane) = w4; }
}
__device__ __forceinline__ void sb_unit(LAS unsigned char* lds, int tid, int b, int h, int q0, const GAS bf16* sq, const GAS bf16* sk, const GAS bf16* vT, GAS bf16* out) {
    constexpr int KBUF = KLay<64>::KBUF, VBUF = 64 * VPB;
    const int lane = tid & 63, wid = tid >> 6, r32 = lane & 31, hi = lane >> 5;
    const size_t tb = (size_t)b * 8192; const int qrow = q0 + 32 * wid + r32;
    const GAS bf16* Kg = sk + tb * 512 + h * 64; const GAS bf16* Vg = vT + (size_t)(h * 64) * 16384 + tb;
    const int NT = q0 / 64 + 4, ntw = (q0 + 32 * wid + 30) / 64 + 1;
    bf16x8 qf[4];
#pragma unroll
    for (int d0 = 0; d0 < 4; ++d0) qf[d0] = *(const GAS bf16x8*)(sq + (tb + qrow) * 512 + h * 64 + 16 * d0 + 8 * hi);
    f32x16 o[2];
#pragma unroll
    for (int r = 0; r < 16; ++r) { o[0][r] = 0.f; o[1][r] = 0.f; }
    float R = 1.0f;
    volatile LAS unsigned* dflag = (volatile LAS unsigned*)(lds + 4 * KBUF + 1024);
    Stage<64, 64, false> st;
    st.load(tid, Kg, 512, nullptr, Vg, 16384, 64 * (NT - 1));
    st.store(tid, lds, lds + 2 * KBUF);
    __syncthreads();
    for (int i = 0; i < NT; ++i) {
        const int t = NT - 1 - i, cur = i & 1, kv0 = 64 * t;
        if (t > 0) st.load(tid, Kg, 512, nullptr, Vg, 16384, kv0 - 64);
        if (t < ntw && __any(R != 0.f)) {
            const LAS unsigned char* kb = lds + cur * KBUF; const LAS unsigned char* vb = lds + 2 * KBUF + cur * VBUF;
            f32x16 k0, k1;
#pragma unroll
            for (int r = 0; r < 16; ++r) { k0[r] = 0.f; k1[r] = 0.f; }
            qkt<64>(k0, k1, kb, qf, r32, hi);
            f32x16 b0, b1;
#pragma unroll
            for (int r = 0; r < 16; ++r) {
                const float e0 = __builtin_amdgcn_exp2f(fminf(k0[r], 115.f)), e1 = __builtin_amdgcn_exp2f(fminf(k1[r], 115.f));
                const float r0 = __builtin_amdgcn_rcpf(1.f + e0), r1 = __builtin_amdgcn_rcpf(1.f + e1);
                k0[r] = r0; b0[r] = e0 * r0; k1[r] = r1; b1[r] = e1 * r1; }
            if (kv0 + 63 >= qrow - r32) {
                const int thr = qrow - kv0 - 4 * hi;
#pragma unroll
                for (int r = 0; r < 16; ++r) { const int c = (r & 3) + 8 * (r >> 2); if (c >= thr) { k0[r] = 1.f; b0[r] = 0.f; } if (c + 32 >= thr) { k1[r] = 1.f; b1[r] = 0.f; } } }
            float gp[8], go[8];
#pragma unroll
            for (int c = 0; c < 4; ++c) { gp[c] = (k0[4 * c] * k0[4 * c + 1]) * (k0[4 * c + 2] * k0[4 * c + 3]); gp[4 + c] = (k1[4 * c] * k1[4 * c + 1]) * (k1[4 * c + 2] * k1[4 * c + 3]); }
#pragma unroll
            for (int g = 0; g < 8; ++g) go[g] = xhalf(gp[g]);
            float sp = R;
#pragma unroll
            for (int g = 7; g >= 0; --g) {
                float s = sp * (hi ? 1.0f : go[g]);
                if (g >= 4) { const int c = g - 4;
                    b1[4 * c + 3] *= s; s *= k1[4 * c + 3]; b1[4 * c + 2] *= s; s *= k1[4 * c + 2]; b1[4 * c + 1] *= s; s *= k1[4 * c + 1]; b1[4 * c] *= s; }
                else { const int c = g;
                    b0[4 * c + 3] *= s; s *= k0[4 * c + 3]; b0[4 * c + 2] *= s; s *= k0[4 * c + 2]; b0[4 * c + 1] *= s; s *= k0[4 * c + 1]; b0[4 * c] *= s; }
                sp *= gp[g] * go[g];
            }
            R = sp;
            bf16x8 pf[4]; pack_p(pf, b0, b1);
            pv<64>(o, vb, pf, r32, hi);
        }
        if (t > 0) st.store(tid, lds + (cur ^ 1) * KBUF, lds + 2 * KBUF + (cur ^ 1) * VBUF);
        if (lane == 0) dflag[(i & 1) * 8 + wid] = (t < ntw && !__any(R != 0.f)) ? 1u : 0u;
        __syncthreads();
        { unsigned alld = 1u;
#pragma unroll
          for (int w = 0; w < 8; ++w) alld &= dflag[(i & 1) * 8 + w];
          if (alld) break; }
    }
    store_o<64>(out + (tb + qrow) * 1024 + h * 64, o, 1.0f, hi);
}
}
typedef unsigned short bf16;
typedef float f32x4 __attribute__((ext_vector_type(4)));
typedef unsigned u32x4 __attribute__((ext_vector_type(4)));
typedef unsigned u32x2 __attribute__((ext_vector_type(2)));
constexpr int NWAVES = 8, NTHREADS = 512;
constexpr int M = 16384, D = 1024, SEQ = 8192, DEPTH = 2, IN_COLS = 6688;
constexpr int SROWS = 40960;
constexpr size_t MiB = 1u << 20;
constexpr size_t WS_CTL = 0, CTL_ZERO_BYTES = 128 * 1024;
constexpr size_t WS_SSQ = 1 * MiB;
constexpr size_t WS_SSQCQ = 2 * MiB, WS_SSQCKV = WS_SSQCQ + 256 * 1024, WS_SSQMEM = WS_SSQCKV + 256 * 1024;
constexpr size_t WS_TOKE = 3 * MiB, WS_TOKW = WS_TOKE + 128 * 1024, WS_HIST = WS_TOKW + 128 * 1024, WS_SLOT = WS_HIST + 64 * 1024;
constexpr size_t WS_STOK = 4 * MiB, WS_SW = WS_STOK + 256 * 1024, WS_SRSTD = WS_SW + 256 * 1024;
constexpr size_t WS_WR = 5 * MiB;
constexpr size_t WS_WRH = 5 * MiB + 256 * 1024, WS_WRL = WS_WRH + 128 * 1024;
constexpr size_t WS_MEMN = 6 * MiB, WS_XK = 7 * MiB, WS_XVT = WS_XK + 512 * 1024;
constexpr size_t WS_WIN = 8 * MiB;
constexpr size_t WS_WV = WS_WIN + (size_t)2816 * 1024 * 2;
constexpr size_t WS_WG = WS_WV + 2 * MiB;
constexpr size_t WS_WUQ = WS_WG + 6 * MiB;
constexpr size_t WS_WUKN = WS_WUQ + 768 * 256 * 2;
constexpr size_t WS_WUV = WS_WUKN + 512 * 256 * 2;
constexpr size_t WS_WB = WS_WUV + 512 * 256 * 2;
constexpr size_t WS_WOUT = WS_WB + 4 * MiB;
constexpr size_t WS_WXQ = WS_WOUT + 2 * MiB;
constexpr size_t WS_WXK = WS_WXQ + 1 * MiB, WS_WXV = WS_WXK + 1 * MiB;
constexpr size_t WS_WXO = WS_WXV + 1 * MiB;
constexpr size_t WS_WGU = WS_WXO + 1 * MiB;
constexpr size_t WS_WD = WS_WGU + 32 * MiB;
constexpr size_t WS_WEND = WS_WD + 16 * MiB;
static_assert(WS_WEND <= 81 * MiB, "weights");
constexpr size_t WS_XB = 81 * MiB;
constexpr size_t R0 = 113 * MiB;
constexpr size_t WS_CQ = R0, WS_CKV = R0 + 8 * MiB, WS_KROPE = R0 + 16 * MiB, WS_QK = R0 + 18 * MiB  , WS_VT = R0 + 82 * MiB  ;
constexpr size_t WS_QMLA = R0 + 114 * MiB, WS_KNOPE = R0 + 138 * MiB, WS_VMLAT = R0 + 154 * MiB, WS_OABC = R0 + 170 * MiB  ;
constexpr size_t WS_GSCR = R0, WS_MB = R0 + 96 * MiB;
constexpr size_t WS_QX = R0, WS_OX = R0 + 32 * MiB;
constexpr size_t WS_XG = R0, WS_ACT = R0 + 80 * MiB, WS_Y = R0 + 100 * MiB;
constexpr size_t WS_END = R0 + 234 * MiB;
static_assert(WS_MB + 32 * MiB <= WS_OABC && WS_Y + 80 * MiB <= WS_END && WS_OABC + 64 * MiB <= WS_END, "region map");
constexpr int CW_BAR = 1024, CW_Q = 8192, CW_KN = 16384, CW_F1 = 24576;
constexpr int RING_BYTES = 131072, LDSCTL_OFF = RING_BYTES, MISC_OFF = LDSCTL_OFF + 320, TSTART_OFF = LDSCTL_OFF + 1024, HIST_OFF = LDSCTL_OFF + 2048;
constexpr int LDS_BYTES = 147456;

#define LDS_WAIT() asm volatile("s_waitcnt lgkmcnt(0)" ::: "memory")
__device__ __forceinline__ float wave_sum(float v) {
#pragma unroll
    for (int o = 1; o < 64; o <<= 1) v += __shfl_xor(v, o);
    return v;
}
__device__ __forceinline__ unsigned pk2(float lo, float hi) { return pg8::pk2(lo, hi); }
__device__ __forceinline__ int lane_id() { int r; asm volatile("v_mbcnt_lo_u32_b32 %0, -1, 0\n\tv_mbcnt_hi_u32_b32 %0, -1, %0" : "=v"(r)); return r; }
#define XB_TMO      128
#define XB_XCNT(j)  (256  + 64 * (j))
#define XB_XSUB(j)  (1280 + 64 * (j))
#define XB_XGEN(j)  (2304 + 64 * (j))
#define XB_TOP      3328
#define XB_TOPGEN   3392
#define XCD_BAR_WORDS 3456
#define XB_SPIN_CAP (1u << 18)

__device__ __forceinline__ unsigned xb_ld(unsigned* p)              { return __hip_atomic_load(p, __ATOMIC_RELAXED, __HIP_MEMORY_SCOPE_AGENT); }
__device__ __forceinline__ unsigned xb_add(unsigned* p, unsigned v) { return __hip_atomic_fetch_add(p, v, __ATOMIC_RELAXED, __HIP_MEMORY_SCOPE_AGENT); }
__device__ __forceinline__ unsigned xb_xcc_id() { return (unsigned)__builtin_amdgcn_s_getreg((3 << 11) | 20) & 0xFu; }
#define XB_SPIN(cond, bar) do { unsigned _sp = 0; while (cond) { __builtin_amdgcn_s_sleep(1); \
    if ((++_sp & 255u) == 0u) { if (xb_ld(&(bar)[XB_TMO])) break; if (_sp > XB_SPIN_CAP) { atomicAdd(&(bar)[XB_TMO], 1u); break; } } } } while (0)

struct XcdBarrier {
    unsigned* bar; unsigned x; int wid;
    volatile LAS unsigned* st;
};

__device__ __forceinline__ XcdBarrier xcd_barrier_post(unsigned* bar, volatile LAS unsigned* st, int wid) {
    XcdBarrier b; b.bar = bar; b.x = xb_xcc_id(); b.st = st; b.wid = wid;
    if (wid == 0 && lane_id() == 0) (void)xb_add(&bar[XB_XCNT(b.x)], 1u);
    return b;
}
__device__ __forceinline__ void xcd_barrier_complete(unsigned* bar, unsigned x, unsigned& nloc, unsigned& nx) {
    const unsigned G = gridDim.x * gridDim.y * gridDim.z;
    unsigned sum, cnt, mine, sp = 0u;
    for (;;) {
        sum = 0u; cnt = 0u; mine = 0u;
#pragma unroll 1
        for (unsigned j = 0; j < 16; ++j) { const unsigned c = xb_ld(&bar[XB_XCNT(j)]); sum += c; cnt += (c > 0u) ? 1u : 0u; mine = (j == x) ? c : mine; }
        if (sum == G) break;
        __builtin_amdgcn_s_sleep(1);
        if ((++sp & 255u) == 0u) { if (xb_ld(&bar[XB_TMO])) break; if (sp > XB_SPIN_CAP) { atomicAdd(&bar[XB_TMO], 1u); break; } }
    }
    nloc = mine > 0u ? mine : 1u; nx = cnt > 0u ? cnt : 1u;
}

__device__ __forceinline__ void xcd_barrier(const XcdBarrier& b) {
    asm volatile("s_waitcnt vmcnt(0)" ::: "memory");
    __syncthreads();
    if (b.wid == 0 && lane_id() == 0) {
        unsigned* bar = b.bar; asm volatile("" : "+s"(bar));
        __builtin_amdgcn_s_waitcnt(0);
        unsigned nloc = b.st[0], nx = b.st[1];
        if (nloc == 0u) { xcd_barrier_complete(bar, b.x, nloc, nx); b.st[0] = nloc; b.st[1] = nx; }
        const unsigned old = xb_add(&bar[XB_XSUB(b.x)], 1u);
        const unsigned gen = old / nloc;
        if (old + 1u == (gen + 1u) * nloc) {
            __builtin_amdgcn_fence(__ATOMIC_RELEASE, "agent");
            asm volatile("s_waitcnt vmcnt(0)" ::: "memory");
            const unsigned og = xb_add(&bar[XB_TOP], 1u);
            const unsigned tg = og / nx;
            if (og + 1u == (tg + 1u) * nx) xb_add(&bar[XB_TOPGEN], 1u);
            else XB_SPIN(xb_ld(&bar[XB_TOPGEN]) == tg, bar);
            __builtin_amdgcn_fence(__ATOMIC_ACQUIRE, "agent");
            xb_add(&bar[XB_XGEN(b.x)], 1u);
            asm volatile("s_waitcnt vmcnt(0)" ::: "memory");
        } else {
            XB_SPIN(xb_ld(&bar[XB_XGEN(b.x)]) == gen, bar);
            __builtin_amdgcn_fence(__ATOMIC_ACQUIRE, "agent");
            asm volatile("s_waitcnt vmcnt(0)" ::: "memory");
        }
    }
    __syncthreads();
}
struct TrJob { const GAS float* src; const GAS float* gain; GAS bf16* dst; int ldn, col0, k0, K, row0, dk; };
__device__ __forceinline__ void tr_load(const TrJob& j, f32x4 (&v)[8], int lane) {
    const int kr = lane >> 3, nq = lane & 7;
    if (j.col0 >= 0) {
#pragma unroll
        for (int i = 0; i < 8; ++i) v[i] = *(const GAS f32x4*)(j.src + (size_t)(j.k0 + 8 * i + kr) * j.ldn + j.col0 + 4 * nq);
    } else {
#pragma unroll
        for (int i = 0; i < 8; ++i) v[i] = (f32x4){0.f, 0.f, 0.f, 0.f};
    }
}
__device__ __forceinline__ void tr_finish(const TrJob& j, const f32x4 (&v)[8], LAS float* scr, int lane) {
    const int kr = lane >> 3, nq = lane & 7;
#pragma unroll
    for (int i = 0; i < 8; ++i) { const int kk = 8 * i + kr; const float g = j.gain ? j.gain[j.k0 + kk] : 1.f; LAS float* s = scr + kk * 33 + 4 * nq;
        s[0] = v[i][0] * g; s[1] = v[i][1] * g; s[2] = v[i][2] * g; s[3] = v[i][3] * g; }
    LDS_WAIT(); asm volatile("" ::: "memory");
    const int c = lane & 7;
#pragma unroll
    for (int q = 0; q < 4; ++q) { const int n = (lane >> 3) + 8 * q; const LAS float* s = scr + (8 * c) * 33 + n;
        u32x4 o; o.x = pk2(s[0 * 33], s[1 * 33]); o.y = pk2(s[2 * 33], s[3 * 33]); o.z = pk2(s[4 * 33], s[5 * 33]); o.w = pk2(s[6 * 33], s[7 * 33]);
        *(GAS u32x4*)(j.dst + (size_t)(j.row0 + n) * j.K + j.dk + j.k0 + 8 * c) = o; }
    LDS_WAIT(); asm volatile("" ::: "memory");
}
__device__ __forceinline__ void row_load(const GAS float* xrow, f32x4 (&v)[4], int lane) {
    const GAS f32x4* xr = (const GAS f32x4*)xrow + lane;
#pragma unroll
    for (int j = 0; j < 4; ++j) v[j] = xr[64 * j];
}
__device__ __forceinline__ void row_finish(const f32x4 (&v)[4], GAS bf16* orow, GAS float* ssq16, int lane) {
    float s = 0.f;
#pragma unroll
    for (int j = 0; j < 4; ++j) s += (v[j][0] * v[j][0] + v[j][1] * v[j][1]) + (v[j][2] * v[j][2] + v[j][3] * v[j][3]);
    s = wave_sum(s);
    GAS u32x2* o8 = (GAS u32x2*)orow + lane;
#pragma unroll
    for (int j = 0; j < 4; ++j) { u32x2 w; w.x = pk2(v[j][0], v[j][1]); w.y = pk2(v[j][2], v[j][3]); o8[64 * j] = w; }
    if (lane < 16) ssq16[lane] = (lane == 0) ? s : 0.f;
}
__device__ __forceinline__ void row_to_bf16(const GAS float* xrow, GAS bf16* orow, GAS float* ssq16, int lane) {
    const GAS f32x4* xr = (const GAS f32x4*)xrow + lane; f32x4 v[4]; float s = 0.f;
#pragma unroll
    for (int j = 0; j < 4; ++j) { v[j] = xr[64 * j]; s += (v[j][0] * v[j][0] + v[j][1] * v[j][1]) + (v[j][2] * v[j][2] + v[j][3] * v[j][3]); }
    s = wave_sum(s);
    GAS u32x2* o8 = (GAS u32x2*)orow + lane;
#pragma unroll
    for (int j = 0; j < 4; ++j) { u32x2 w; w.x = pk2(v[j][0], v[j][1]); w.y = pk2(v[j][2], v[j][3]); o8[64 * j] = w; }
    if (lane < 16) ssq16[lane] = (lane == 0) ? s : 0.f;
}

struct Args { const float* in[26]; float* out; unsigned char* ws; };
__device__ __forceinline__ int opq(int i) { asm volatile("" : "+s"(i)); return i; }
__device__ __forceinline__ GAS unsigned char* opqp(unsigned char* p0) { GAS unsigned char* p = (GAS unsigned char*)p0; asm volatile("" : "+s"(p)); return p; }
#define INP(i) ((const GAS float*)args.in[opq(i)])
#define WSB(off) (opqp(args.ws) + (off))
#define X_IN INP(0)
#define OUTP ((GAS float*)args.out)
#define XB ((GAS bf16*)WSB(WS_XB))
#define SSQ ((GAS float*)WSB(WS_SSQ))
#define SSQCQ ((GAS float*)WSB(WS_SSQCQ))
#define SSQCKV ((GAS float*)WSB(WS_SSQCKV))
#define SSQMEM ((GAS float*)WSB(WS_SSQMEM))
#define MEMN ((GAS bf16*)WSB(WS_MEMN))
#define XK ((GAS bf16*)WSB(WS_XK))
#define XVT ((GAS bf16*)WSB(WS_XVT))
#define WIN ((GAS bf16*)WSB(WS_WIN))
#define WV ((GAS bf16*)WSB(WS_WV))
#define WG ((GAS bf16*)WSB(WS_WG))
#define WUQ ((GAS bf16*)WSB(WS_WUQ))
#define WUKN ((GAS bf16*)WSB(WS_WUKN))
#define WUV ((GAS bf16*)WSB(WS_WUV))
#define WB ((GAS bf16*)WSB(WS_WB))
#define WOUT ((GAS bf16*)WSB(WS_WOUT))
#define WXQ ((GAS bf16*)WSB(WS_WXQ))
#define WXK ((GAS bf16*)WSB(WS_WXK))
#define WXV ((GAS bf16*)WSB(WS_WXV))
#define WXO ((GAS bf16*)WSB(WS_WXO))
#define WGU ((GAS bf16*)WSB(WS_WGU))
#define WD ((GAS bf16*)WSB(WS_WD))
#define WRH ((GAS bf16*)WSB(WS_WRH))
#define WRL ((GAS bf16*)WSB(WS_WRL))
#define CQ ((GAS bf16*)WSB(WS_CQ))
#define CKV ((GAS bf16*)WSB(WS_CKV))
#define KROPE ((GAS bf16*)WSB(WS_KROPE))
#define QK ((GAS bf16*)WSB(WS_QK))
#define VT ((GAS bf16*)WSB(WS_VT))
#define QMLA ((GAS bf16*)WSB(WS_QMLA))
#define KNOPE ((GAS bf16*)WSB(WS_KNOPE))
#define VMLAT ((GAS bf16*)WSB(WS_VMLAT))
#define OABC ((GAS bf16*)WSB(WS_OABC))
#define GSCR ((GAS unsigned char*)WSB(WS_GSCR))
#define MB ((GAS bf16*)WSB(WS_MB))
#define QX ((GAS bf16*)WSB(WS_QX))
#define OX ((GAS bf16*)WSB(WS_OX))
#define XG ((GAS bf16*)WSB(WS_XG))
#define ACT ((GAS bf16*)WSB(WS_ACT))
#define YB ((GAS bf16*)WSB(WS_Y))
#define TOKE ((GAS int*)WSB(WS_TOKE))
#define TOKW ((GAS float*)WSB(WS_TOKW))
#define HIST ((GAS int*)WSB(WS_HIST))
#define SLOT ((GAS int*)WSB(WS_SLOT))
#define STOK ((GAS int*)WSB(WS_STOK))
#define SW ((GAS float*)WSB(WS_SW))
#define SRSTD ((GAS float*)WSB(WS_SRSTD))


__global__ void __launch_bounds__(NTHREADS, 2) fwd(Args args) {
    extern __shared__ __attribute__((aligned(16))) unsigned char lds_raw[];
    LAS unsigned char* lds = (LAS unsigned char*)lds_raw;
    volatile LAS unsigned* MISC = (volatile LAS unsigned*)(lds + MISC_OFF);
    LAS int* TSTART = (LAS int*)(lds + TSTART_OFF);
    const int tid0 = threadIdx.x; const int wv = __builtin_amdgcn_readfirstlane(tid0 >> 6);
#define PH_BEGIN int tid_ = wv * 64 + lane_id(); asm volatile("" : "+v"(tid_)); const int tid = tid_, lane = tid & 63, wave = wv, gw = vcu * NWAVES + wave; (void)lane; (void)gw
    const int G = gridDim.x, bx = blockIdx.x, vcu = (G % 8 == 0) ? (bx % 8) * (G / 8) + bx / 8 : bx;
    unsigned* ctl = (unsigned*)(void*)(args.ws + WS_CTL);
    for (int u = tid0; u < (LDS_BYTES - LDSCTL_OFF) / 4; u += NTHREADS) ((LAS unsigned*)(lds + LDSCTL_OFF))[u] = 0u;
    __syncthreads();
    XcdBarrier bar = xcd_barrier_post(ctl + CW_BAR, MISC + 8, wv);
    const int NGW = G * NWAVES;

    constexpr float L2E = 1.4426950408889634f;

    constexpr int I_IN = 88 * 16, I_V = 32 * 16, I_G = 96 * 16, I_UQ = 24 * 4, I_UK = 16 * 4, I_B = 3 * 32 * 8, I_O = 32 * 16, I_XQ = 16 * 16, I_XO = 32 * 8, I_GU = 512 * 16, I_D = 1024 * 4;
    constexpr int NITEMS = I_IN + I_V + I_G + I_UQ + 2 * I_UK + I_B + I_O + 3 * I_XQ + I_XO + I_GU + I_D, NITEMS_P0 = NITEMS - I_GU - I_D;
    for (int l = 0; l < DEPTH; ++l) {
        for (int rp_ = 0; rp_ < RP_P0; ++rp_) {
#if PH_P0
        { PH_BEGIN;
            LAS float* scr = (LAS float*)(lds + wave * 16384);
#define w_in (INP(3) + (size_t)l * D * IN_COLS)
#define g_attn (INP(2) + l * D)
#define w_uq (INP(5) + (size_t)l * 256 * 768)
#define g_q (INP(4) + l * 256)
#define w_ukv (INP(7) + (size_t)l * 256 * 1024)
#define g_kv (INP(6) + l * 256)
#define w_br (INP(10) + (size_t)l * 3 * 512 * 1024)
#define w_out (INP(11) + (size_t)l * D * D)
#define g_cross (INP(12) + l * D)
#define g_mem (INP(13))
#define w_xq (INP(14) + (size_t)l * D * 512)
#define w_xkv (INP(15) + (size_t)l * D * 1024)
#define w_xo (INP(16) + (size_t)l * 512 * D)
#define g_ffn (INP(17) + l * D)
#define w_eg (INP(22) + (size_t)l * 32 * D * 256)
#define w_eu (INP(23) + (size_t)l * 32 * D * 256)
#define w_ed (INP(24) + (size_t)l * 32 * 256 * D)
#define TR_DECODE(itx) do { int r = (itx); \
                if (r < I_IN) { const int nb = r >> 4, kb = r & 15, n0 = nb * 32; int col; \
                    if (n0 < 544) col = 3072 + n0; else if (n0 < 768) col = -1; else if (n0 < 1792) col = 3616 + (n0 - 768); else col = 5152 + (n0 - 1792); \
                    jb = TrJob{w_in, g_attn, WIN, IN_COLS, col, kb * 64, 1024, n0, 0}; break; } r -= I_IN; \
                if (r < I_V) { const int nb = r >> 4, kb = r & 15, n0 = nb * 32; const int col = n0 < 512 ? 4640 + n0 : 6176 + (n0 - 512); \
                    jb = TrJob{w_in, g_attn, WV, IN_COLS, col, kb * 64, 1024, n0, 0}; break; } r -= I_V; \
                if (r < I_G) { const int nb = r >> 4, kb = r & 15; jb = TrJob{w_in, g_attn, WG, IN_COLS, nb * 32, kb * 64, 1024, nb * 32, 0}; break; } r -= I_G; \
                if (r < I_UQ) { const int nb = r >> 2, kb = r & 3, n0 = nb * 32; const int col = n0 < 512 ? 96 * (n0 >> 6) + (n0 & 63) : 96 * ((n0 - 512) >> 5) + 64; \
                    jb = TrJob{w_uq, g_q, WUQ, 768, col, kb * 64, 256, n0, 0}; break; } r -= I_UQ; \
                if (r < I_UK) { const int nb = r >> 2, kb = r & 3, n0 = nb * 32; jb = TrJob{w_ukv, g_kv, WUKN, 1024, 128 * (n0 >> 6) + (n0 & 63), kb * 64, 256, n0, 0}; break; } r -= I_UK; \
                if (r < I_UK) { const int nb = r >> 2, kb = r & 3, n0 = nb * 32; jb = TrJob{w_ukv, g_kv, WUV, 1024, 128 * (n0 >> 6) + 64 + (n0 & 63), kb * 64, 256, n0, 0}; break; } r -= I_UK; \
                if (r < I_B) { const int z = r / 256, q = r % 256, nb = q >> 3, kb = q & 7; jb = TrJob{w_br + (size_t)z * 512 * 1024, nullptr, WB + (size_t)(z >> 1) * 1024 * 1024, 1024, nb * 32, kb * 64, 1024, nb * 32, (z & 1) * 512}; break; } r -= I_B; \
                if (r < I_O) { const int nb = r >> 4, kb = r & 15; jb = TrJob{w_out, nullptr, WOUT, 1024, nb * 32, kb * 64, 1024, nb * 32, 0}; break; } r -= I_O; \
                if (r < I_XQ) { const int nb = r >> 4, kb = r & 15; jb = TrJob{w_xq, g_cross, WXQ, 512, nb * 32, kb * 64, 1024, nb * 32, 0}; break; } r -= I_XQ; \
                if (r < I_XQ) { const int nb = r >> 4, kb = r & 15; jb = TrJob{w_xkv, g_mem, WXK, 1024, nb * 32, kb * 64, 1024, nb * 32, 0}; break; } r -= I_XQ; \
                if (r < I_XQ) { const int nb = r >> 4, kb = r & 15; jb = TrJob{w_xkv, g_mem, WXV, 1024, 512 + nb * 32, kb * 64, 1024, nb * 32, 0}; break; } r -= I_XQ; \
                if (r < I_XO) { const int nb = r >> 3, kb = r & 7; jb = TrJob{w_xo, nullptr, WXO, 1024, nb * 32, kb * 64, 512, nb * 32, 0}; break; } r -= I_XO; \
                if (r < I_GU) { const int nb = r >> 4, kb = r & 15, n0 = nb * 32, e = n0 >> 9, rr = n0 & 511, t = rr >> 8, j = rr & 255; \
                    const GAS float* src = (j < 128 ? w_eg : w_eu) + (size_t)e * D * 256; jb = TrJob{src, g_ffn, WGU, 256, 128 * t + (j & 127), kb * 64, 1024, n0, 0}; break; } r -= I_GU; \
                { const int nb = r >> 2, kb = r & 3, n0 = nb * 32, e = n0 >> 10; jb = TrJob{w_ed + (size_t)e * 256 * 1024, nullptr, WD, 1024, n0 & 1023, kb * 64, 256, n0, 0}; } } while (0)
            for (int it = gw; it < NITEMS_P0; it += NGW) {
                TrJob jb{};
                TR_DECODE(it);
                f32x4 va[8];
                tr_load(jb, va, lane);
                tr_finish(jb, va, scr, lane);
            }
            { const GAS float* wrg = INP(18) + (size_t)l * D * 4; const GAS float* wre = INP(20) + (size_t)l * D * 32; GAS bf16* wh = WRH; GAS bf16* wl = WRL;
              for (int i = bx * NTHREADS + tid; i < 48 * 1024; i += G * NTHREADS) { const int c = i >> 10, k = i & 1023;
                  const float w = c < 36 ? (c < 4 ? wrg[k * 4 + c] : wre[k * 32 + (c - 4)]) * g_ffn[k] : 0.f; const unsigned h = pk2(w, 0.f) & 0xffffu;
                  wh[i] = (bf16)h; wl[i] = (bf16)(pk2(w - __builtin_bit_cast(float, h << 16), 0.f) & 0xffffu); } }
            if (l == 0) {
                for (int m = gw; m < M; m += 2 * NGW) {
                    const int m1 = m + NGW < M ? m + NGW : m;
                    f32x4 v0[4], v1[4]; row_load(X_IN + (size_t)m * D, v0, lane); row_load(X_IN + (size_t)m1 * D, v1, lane);
                    row_finish(v0, XB + (size_t)m * D, SSQ + (size_t)m * 16, lane); row_finish(v1, XB + (size_t)m1 * D, SSQ + (size_t)m1 * 16, lane); }
                for (int m = gw; m < 512; m += NGW) row_to_bf16(INP(1) + (size_t)m * D, MEMN + (size_t)m * D, SSQMEM + (size_t)m * 16, lane);
            }
        }
#endif
        xcd_barrier(bar);
        }
                for (int rp_ = 0; rp_ < RP_A; ++rp_) {
#if PH_A
        {
            { pg8::Gemm g{XB, WIN, M, 2816, D, D, nullptr}; pg8::StaticOrder S; S.init(M, 2816, G, bx);
              pg8::EpiA E{SSQ, CQ, CKV, KROPE, QK, SSQCQ, SSQCKV, 0.125f * L2E, (GAS unsigned*)(opqp(args.ws) + WS_CTL) + CW_KN + l * 4096, rp_ ? A_ABL : 0};
              pg8::gemm_phase<pg8::EpiA, pg8::StaticOrder, true, true>(lds, g, S, E, wv); }
            { pg8::Gemm g{WV, XB, 1024, M, D, D, nullptr}; pg8::StaticOrder S; S.init(1024, M, G, (bx + 64) % G);
              pg8::EpiVT E{VT, M, SSQ, 4, 1.f / 1024.f};
              pg8::gemm_phase<pg8::EpiVT, pg8::StaticOrder, true, true>(lds, g, S, E, wv); }
            { pg8::Gemm g{MEMN, WXK, 512, 512, D, D, nullptr}; pg8::StaticOrder S; S.init(512, 512, G, (bx + 8) % G);
              pg8::EpiRS E{XK, 512, SSQMEM, 4, 1.f / 1024.f, 1.f, 0xffff, 31, 0};
              pg8::gemm_phase<pg8::EpiRS, pg8::StaticOrder, true, true>(lds, g, S, E, wv); }
            { pg8::Gemm g{WXV, MEMN, 512, 512, D, D, nullptr}; pg8::StaticOrder S; S.init(512, 512, G, (bx + 16) % G);
              pg8::EpiVT E{XVT, 512, SSQMEM, 4, 1.f / 1024.f};
              pg8::gemm_phase<pg8::EpiVT, pg8::StaticOrder, true, true>(lds, g, S, E, wv); }
        }
#endif
        xcd_barrier(bar);
        }
                for (int rp_ = 0; rp_ < RP_B; ++rp_) {
#if PH_B
        {
#if PH_B1
            { pg8::Gemm g{CQ, WUQ, M, 768, opq(256), opq(256), nullptr}; pg8::StaticOrder S; S.init(M, 768, G, bx);
              pg8::EpiQ E{QMLA, SSQCQ, 0.10206207261596577f * L2E};
              pg8::gemm_phase<pg8::EpiQ, pg8::StaticOrder, true, true>(lds, g, S, E, wv); }
#endif
#if PH_B2
            { pg8::Gemm g{CKV, WUKN, M, 512, opq(256), opq(256), nullptr}; pg8::StaticOrder S; S.init(M, 512, G, (bx + 64) % G);
              pg8::EpiRS E{KNOPE, 512, SSQCKV, 1, 1.f / 256.f, 1.f, 0xffff, 31, 0};
              pg8::gemm_phase<pg8::EpiRS, pg8::StaticOrder, true, true>(lds, g, S, E, wv); }
#endif
#if PH_B3
            { pg8::Gemm g{WUV, CKV, 512, M, opq(256), opq(256), nullptr}; pg8::StaticOrder S; S.init(512, M, G, (bx + 128) % G);
              pg8::EpiVT E{VMLAT, M, SSQCKV, 1, 1.f / 256.f};
              pg8::gemm_phase<pg8::EpiVT, pg8::StaticOrder, true, true>(lds, g, S, E, wv); }
#endif
        }
#endif
        xcd_barrier(bar);
        }
                for (int rp_ = 0; rp_ < RP_C; ++rp_) {
#if PH_C
        {
            unsigned* qhead = ctl + CW_Q + 64 * (l + 2 * rp_);
            for (;;) {
                if (wv == 0 && lane_id() == 0) MISC[0] = __hip_atomic_fetch_add(qhead, 1u, __ATOMIC_RELAXED, __HIP_MEMORY_SCOPE_AGENT);
                __syncthreads();
                const int idx = (int)MISC[0];
                __syncthreads();
                if (idx >= 32 * 48 + 256) break;
                if (idx >= 32 * 48) {
                    if (rp_ == 0) { const int wl = lane_id(); LAS float* scr = (LAS float*)(lds + wv * 16384);
                        for (int j = 0; j < 6; ++j) { const int it = NITEMS_P0 + (idx - 32 * 48) * 48 + j * 8 + wv; TrJob jb{}; TR_DECODE(it); f32x4 va[8]; tr_load(jb, va, wl); tr_finish(jb, va, scr, wl); } }
                    continue; }
                const int qb = 31 - idx / 48, r = idx % 48, q0 = qb * 256;
                int tu = wv * 64 + lane_id(); asm volatile("" : "+v"(tu));
#if PH_C_DIFF
                if (r < 16 && (rp_ == 0 || (C_REP_MASK & 1))) att::diff_unit(lds, tu, r >> 3, (r >> 1) & 3, r & 1, q0, QK + (size_t)2 * M * 512, QK + (size_t)3 * M * 512, VT, (r & 1) ? CQ : OABC + (size_t)M * 1024, (r & 1) ? 512 : 1024,
                                                                             (const GAS unsigned*)(opqp(args.ws) + WS_CTL) + CW_KN + l * 4096, rp_ ? C_ABL : 0);
#endif
#if PH_C_SB
                if (r >= 16 && r < 32 && (rp_ == 0 || (C_REP_MASK & 2))) att::sb_unit(lds, tu, (r - 16) >> 3, (r - 16) & 7, q0, QK, QK + (size_t)M * 512, VT, OABC + 512);
#endif
#if PH_C_MLA
                if (r >= 32 && (rp_ == 0 || (C_REP_MASK & 4))) att::mla_unit(lds, tu, (r - 32) >> 3, (r - 32) & 7, q0, QMLA, KNOPE, KROPE, VMLAT, OABC, rp_ ? C_ABL : 0);
#endif
            }
        }
#endif
        xcd_barrier(bar);
        }
        #undef TR_DECODE
#undef w_in
#undef g_attn
#undef w_uq
#undef g_q
#undef w_ukv
#undef g_kv
#undef w_br
#undef w_out
#undef g_cross
#undef g_mem
#undef w_xq
#undef w_xkv
#undef w_xo
#undef g_ffn
#undef w_eg
#undef w_eu
#undef w_ed
#if PH_C
        { PH_BEGIN;
          float lam, post; att::diff_lambda(INP(8) + l * 256, l, lam, post);
          for (int t0 = gw * 8; t0 < M; t0 += NGW * 8) att::diff_combine8(t0, M - t0 < 8 ? M - t0 : 8, lane, OABC + (size_t)M * 1024, CQ, lam, post, INP(9) + l * 128); }
        xcd_barrier(bar);
#endif
        for (int rp_ = 0; rp_ < RP_D1; ++rp_) {
#if PH_D1
        { pg8::Gemm g{XB, WG, M, 1024, 512, 1024, nullptr}; pg8::D1Order S; S.so.init(M, 1024, G, bx);
          const GAS char* xb_ = (const GAS char*)XB; const GAS char* oab_ = (const GAS char*)OABC; const GAS char* wg_ = (const GAS char*)WG; const GAS char* wb_ = (const GAS char*)WB;
          S.dA = (size_t)(oab_ - xb_); S.dB = (size_t)(wb_ - wg_);
          pg8::EpiD1 E{GSCR, MB, SSQ};
          pg8::gemm_phase<pg8::EpiD1, pg8::D1Order, true, true>(lds, g, S, E, wv); }
#endif
        xcd_barrier(bar);
        }
        #if PH_D2
        { pg8::Gemm g{MB, WOUT, M, 1024, D, D, nullptr}; pg8::StaticOrder S; S.init(M, 1024, G, bx);
          pg8::EpiRes E{XB, SSQ};
          pg8::gemm_phase<pg8::EpiRes, pg8::StaticOrder, true, true>(lds, g, S, E, wv); }
#endif
        xcd_barrier(bar);
                for (int rp_ = 0; rp_ < RP_E1; ++rp_) {
#if PH_E1
        { pg8::Gemm g{XB, WXQ, M, 512, 512, 1024, nullptr}; pg8::SplitK2Order S; S.so.init(M, 1024, G, bx); S.tstep = (size_t)256 * 1024 * 2;
          pg8::EpiRS E{QX, 512, SSQ, 4, 1.f / 1024.f, 0.08838834764831845f * L2E, 1, 1, (size_t)M * 512};
          pg8::gemm_phase<pg8::EpiRS, pg8::SplitK2Order, true, true>(lds, g, S, E, wv); }
#endif
        xcd_barrier(bar);
        }
                for (int rp_ = 0; rp_ < RP_E2; ++rp_) {
#if PH_E2
        { PH_BEGIN; for (int u = vcu; u < 256; u += G) att::cross_unit(lds, tid, u >> 7, (u >> 5) & 3, (u & 31) * 256, QX, XK, XVT, OX); }
#endif
        xcd_barrier(bar);
        }
        #if PH_E3
        { pg8::Gemm g{OX, WXO, M, 1024, 512, 512, nullptr}; pg8::StaticOrder S; S.init(M, 1024, G, bx);
          pg8::EpiRes E{XB, SSQ};
          pg8::gemm_phase<pg8::EpiRes, pg8::StaticOrder, true, true>(lds, g, S, E, wv); }
#endif
        xcd_barrier(bar);
                for (int rp_ = 0; rp_ < RP_F0A; ++rp_) {
#if PH_F0A
        { PH_BEGIN;
            typedef short bf16x8 __attribute__((ext_vector_type(8)));
            const GAS float* brg = INP(19) + l * 4; const GAS float* bre = INP(21) + l * 32;
            LAS float* part = (LAS float*)lds;
            LAS unsigned* ST = (LAS unsigned*)(lds + 102400);
            const int r16 = lane & 15, kq = lane >> 4;
            int itn = 0;
            for (int grp = bx; grp < 256; grp += G, ++itn) {
                float rs = 0.f; if (wave == 0) rs = pg8::rstd_parts(SSQ, (unsigned)((grp * 64 + lane) * 16), 4, 1.f / 1024.f);
                const GAS bf16* xrow = XB + (size_t)(grp * 64 + r16) * D + 128 * wave + 8 * kq;
                const GAS bf16* wh = WRH + (size_t)r16 * 1024 + 128 * wave + 8 * kq; const GAS bf16* wl = WRL + (size_t)r16 * 1024 + 128 * wave + 8 * kq;
                f32x4 acc[4][3];
#pragma unroll
                for (int rb = 0; rb < 4; ++rb)
#pragma unroll
                    for (int cb = 0; cb < 3; ++cb) acc[rb][cb] = (f32x4){0.f, 0.f, 0.f, 0.f};
#pragma unroll
                for (int st = 0; st < 4; ++st) {
                    bf16x8 a[4];
#pragma unroll
                    for (int rb = 0; rb < 4; ++rb) a[rb] = *(const GAS bf16x8*)(xrow + (size_t)rb * 16 * D + 32 * st);
#pragma unroll
                    for (int cb = 0; cb < 3; ++cb) {
                        const bf16x8 bh = *(const GAS bf16x8*)(wh + (size_t)cb * 16 * 1024 + 32 * st), bl = *(const GAS bf16x8*)(wl + (size_t)cb * 16 * 1024 + 32 * st);
#pragma unroll
                        for (int rb = 0; rb < 4; ++rb) { acc[rb][cb] = __builtin_amdgcn_mfma_f32_16x16x32_bf16(a[rb], bh, acc[rb][cb], 0, 0, 0); acc[rb][cb] = __builtin_amdgcn_mfma_f32_16x16x32_bf16(a[rb], bl, acc[rb][cb], 0, 0, 0); }
                    }
                }
                __syncthreads();
#pragma unroll
                for (int rb = 0; rb < 4; ++rb)
#pragma unroll
                    for (int cb = 0; cb < 3; ++cb)
#pragma unroll
                        for (int r = 0; r < 4; ++r) part[(wave * 64 + 16 * rb + 4 * kq + r) * 49 + 16 * cb + r16] = acc[rb][cb][r];
                __syncthreads();
                if (wave == 0) {
                    const LAS float* p = part + lane * 49;
                    float gl[4];
#pragma unroll
                    for (int c = 0; c < 4; ++c) { float s = 0.f;
#pragma unroll
                        for (int w = 0; w < 8; ++w) s += p[w * 3136 + c];
                        gl[c] = s * rs + brg[c]; }
                    int gs = 0; float gm = gl[0];
#pragma unroll
                    for (int c = 1; c < 4; ++c) if (gl[c] > gm) { gm = gl[c]; gs = c; }
                    float den = 0.f;
#pragma unroll
                    for (int c = 0; c < 4; ++c) den += expf(gl[c] - gm);
                    const float pg = 1.0f / den;
                    float el[8];
#pragma unroll
                    for (int j = 0; j < 8; ++j) { float s = 0.f;
#pragma unroll
                        for (int w = 0; w < 8; ++w) s += p[w * 3136 + 4 + gs * 8 + j];
                        el[j] = s * rs + bre[gs * 8 + j]; }
                    int i0 = 0; float v0 = el[0];
#pragma unroll
                    for (int j = 1; j < 8; ++j) if (el[j] > v0) { v0 = el[j]; i0 = j; }
                    int i1 = -1; float v1 = -INFINITY;
#pragma unroll
                    for (int j = 0; j < 8; ++j) if (j != i0 && el[j] > v1) { v1 = el[j]; i1 = j; }
                    const float e1 = expf(v1 - v0), w0 = pg / (1.f + e1), w1 = pg * e1 / (1.f + e1);
                    const int ea = gs * 8 + i0, eb = gs * 8 + i1;
                    int mycnt = 0, ra = 0, rb2 = 0; const unsigned long long lt = (1ull << lane) - 1ull;
#pragma unroll 1
                    for (int e = 0; e < 32; ++e) { const unsigned long long ma = __ballot(ea == e), mb = __ballot(eb == e); const int c = __popcll(ma) + __popcll(mb), cl = __popcll((ma | mb) & lt);
                        if (lane == e) mycnt = c; if (ea == e) ra = cl; if (eb == e) rb2 = cl; }
                    if (lane < 32) HIST[grp * 32 + lane] = mycnt;
                    LAS unsigned* sp = ST + itn * 256 + lane * 4;
                    sp[0] = (unsigned)ea | ((unsigned)eb << 8) | ((unsigned)ra << 16) | ((unsigned)rb2 << 24); sp[1] = __builtin_bit_cast(unsigned, w0); sp[2] = __builtin_bit_cast(unsigned, w1); sp[3] = __builtin_bit_cast(unsigned, rs);
                }
            }
            __syncthreads();
        }
#endif
        xcd_barrier(bar);
        }
                for (int rp_ = 0; rp_ < RP_F0B; ++rp_) {
#if PH_F0B
        { PH_BEGIN;
            LAS int* cnt = (LAS int*)(lds + HIST_OFF);
            int itn = 0;
            for (int grp = bx; grp < 256; grp += G, ++itn) {
                __syncthreads();
                { const int e = tid & 31, ch = tid >> 5; int tot = 0, before = 0;
#pragma unroll
                  for (int j = 0; j < 16; ++j) { const int g2 = ch * 16 + j; const int hv = HIST[g2 * 32 + e]; tot += hv; before += (g2 < grp) ? hv : 0; }
                  cnt[128 + ch * 32 + e] = tot; cnt[640 + ch * 32 + e] = before; }
                __syncthreads();
                if (tid < 32) { int tot = 0, before = 0;
                    for (int ch = 0; ch < 16; ++ch) { tot += cnt[128 + ch * 32 + tid]; before += cnt[640 + ch * 32 + tid]; }
                    cnt[tid] = tot; cnt[32 + tid] = before; }
                __syncthreads();
                if (tid == 0) { int ts = 0; for (int e = 0; e < 32; ++e) { TSTART[e] = ts; ts += (cnt[e] + 255) >> 8; } TSTART[32] = ts; }
                __syncthreads();
                if (wave == 0) {
                    const int tok = grp * 64 + lane; const LAS unsigned* sp = (const LAS unsigned*)(lds + 102400) + itn * 256 + lane * 4;
                    const unsigned pk = sp[0]; const int ea = pk & 255u, eb = (pk >> 8) & 255u, ra = (pk >> 16) & 255u, rb = pk >> 24;
                    const int sa = TSTART[ea] * 256 + cnt[32 + ea] + ra, sb = TSTART[eb] * 256 + cnt[32 + eb] + rb;
                    const float rsd = __builtin_bit_cast(float, sp[3]);
                    SLOT[tok * 2] = sa; SLOT[tok * 2 + 1] = sb;
                    STOK[sa] = tok; STOK[sb] = tok; SW[sa] = __builtin_bit_cast(float, sp[1]); SW[sb] = __builtin_bit_cast(float, sp[2]); SRSTD[sa] = rsd; SRSTD[sb] = rsd;
                }
                __syncthreads();
                if (grp < 32) { const int beg = TSTART[grp] * 256 + cnt[grp], end = TSTART[grp + 1] * 256;
                    for (int s = beg + tid; s < end; s += NTHREADS) { STOK[s] = 0; SW[s] = 0.f; SRSTD[s] = 0.f; } }
            }
            if (G > 256 || bx >= 256) {
                __syncthreads();
                if (tid < 32) { int tot = 0; for (int g2 = 0; g2 < 256; ++g2) tot += HIST[g2 * 32 + tid]; cnt[tid] = tot; }
                __syncthreads();
                if (tid == 0) { int ts = 0; for (int e = 0; e < 32; ++e) { TSTART[e] = ts; ts += (cnt[e] + 255) >> 8; } TSTART[32] = ts; }
            }
            __syncthreads();
        }
#endif
        xcd_barrier(bar);
        }
                for (int rp_ = 0; rp_ < RP_F1; ++rp_) {
#if PH_F1
        { pg8::Gemm g{XB, WGU, SROWS, 32 * 512, D, D, STOK}; pg8::MoeOrderP S{(const LAS int*)TSTART, (GAS unsigned*)(opqp(args.ws) + WS_CTL) + CW_F1 + l * 256, G, vcu};
          pg8::EpiAct E{ACT, SRSTD, SW};
          pg8::gemm_phase<pg8::EpiAct, pg8::MoeOrderP, true, true, true>(lds, g, S, E, wv); }
#endif
        }
                for (int rp_ = 0; rp_ < RP_F2; ++rp_) {
#if PH_F2
        { pg8::Gemm g{ACT, WD, SROWS, 32 * 1024, opq(256), opq(256), nullptr}; pg8::MoeOrderC S{(const LAS int*)TSTART, (const GAS unsigned*)(opqp(args.ws) + WS_CTL) + CW_F1 + l * 256, G, vcu, wv};
          pg8::EpiRS E{YB, 1024, nullptr, 0, 0.f, 1.f, 3, 31, 0};
          pg8::gemm_phase<pg8::EpiRS, pg8::MoeOrderC, true, true>(lds, g, S, E, wv); }
#endif
        xcd_barrier(bar);
        }
#if PH_F3
        { PH_BEGIN;
            const GAS float* g_fin = INP(25);
            int sn[4]; { const int m1 = gw + NGW < M ? gw + NGW : gw; sn[0] = SLOT[gw * 2]; sn[1] = SLOT[gw * 2 + 1]; sn[2] = SLOT[m1 * 2]; sn[3] = SLOT[m1 * 2 + 1]; }
            for (int m = gw; m < M; m += 2 * NGW) {
                const int mr[2] = {m, m + NGW < M ? m + NGW : m}; const int sl[4] = {sn[0], sn[1], sn[2], sn[3]};
                if (m + 2 * NGW < M) { const int n0 = m + 2 * NGW, n1 = n0 + NGW < M ? n0 + NGW : n0; sn[0] = SLOT[n0 * 2]; sn[1] = SLOT[n0 * 2 + 1]; sn[2] = SLOT[n1 * 2]; sn[3] = SLOT[n1 * 2 + 1]; }
                u32x4 ya[2][2], yb[2][2], xw[2][2];
#pragma unroll
                for (int r = 0; r < 2; ++r)
#pragma unroll
                    for (int j = 0; j < 2; ++j) { ya[r][j] = ((const GAS u32x4*)(YB + (size_t)sl[2 * r] * D))[lane + 64 * j]; yb[r][j] = ((const GAS u32x4*)(YB + (size_t)sl[2 * r + 1] * D))[lane + 64 * j];
                        xw[r][j] = ((const GAS u32x4*)(XB + (size_t)mr[r] * D))[lane + 64 * j]; }
#pragma unroll
                for (int r = 0; r < 2; ++r) {
                    float v[2][8]; float s = 0.f;
#pragma unroll
                    for (int j = 0; j < 2; ++j)
#pragma unroll
                        for (int w = 0; w < 4; ++w) { v[j][2 * w] = pg8::bflo(xw[r][j][w]) + (pg8::bflo(ya[r][j][w]) + pg8::bflo(yb[r][j][w])); v[j][2 * w + 1] = pg8::bfhi(xw[r][j][w]) + (pg8::bfhi(ya[r][j][w]) + pg8::bfhi(yb[r][j][w]));
                            s += v[j][2 * w] * v[j][2 * w] + v[j][2 * w + 1] * v[j][2 * w + 1]; }
                    s = wave_sum(s);
                    if (l == DEPTH - 1) { const float rsd = 1.0f / sqrtf(s * (1.f / 1024.f) + 1e-6f); GAS f32x4* orow = (GAS f32x4*)(OUTP + (size_t)mr[r] * D);
#pragma unroll
                        for (int j = 0; j < 2; ++j) { const f32x4 ga = ((const GAS f32x4*)g_fin)[2 * (lane + 64 * j)], gb = ((const GAS f32x4*)g_fin)[2 * (lane + 64 * j) + 1];
                            const f32x4 oa = {v[j][0] * rsd * ga[0], v[j][1] * rsd * ga[1], v[j][2] * rsd * ga[2], v[j][3] * rsd * ga[3]}, ob = {v[j][4] * rsd * gb[0], v[j][5] * rsd * gb[1], v[j][6] * rsd * gb[2], v[j][7] * rsd * gb[3]};
                            orow[2 * (lane + 64 * j)] = oa; orow[2 * (lane + 64 * j) + 1] = ob; }
                    } else {
#pragma unroll
                        for (int j = 0; j < 2; ++j) { u32x4 w4; w4.x = pk2(v[j][0], v[j][1]); w4.y = pk2(v[j][2], v[j][3]); w4.z = pk2(v[j][4], v[j][5]); w4.w = pk2(v[j][6], v[j][7]);
                            ((GAS u32x4*)(XB + (size_t)mr[r] * D))[lane + 64 * j] = w4; }
                        if (lane < 16) SSQ[(size_t)mr[r] * 16 + lane] = (lane == 0) ? s : 0.f;
                    }
                }
            }
        }
#endif
    }
}

extern "C" void kernel_launch(void* const* d_in, const int* in_sizes, int n_in, void* d_out, int out_size, void* d_ws, size_t ws_size, hipStream_t stream) {
    static int grid = 0;
    if (grid == 0) {
        if (n_in != 26 || in_sizes[0] != M * D || out_size != M * D || ws_size < WS_END) { fprintf(stderr, "kernel_launch: unexpected shapes (n_in %d, in0 %d, out %d, ws %zu < %zu)\n", n_in, n_in > 0 ? in_sizes[0] : -1, out_size, ws_size, (size_t)WS_END); grid = -1; return; }
        int dev = 0, cus = 0;
        if (hipGetDevice(&dev) != hipSuccess || hipDeviceGetAttribute(&cus, hipDeviceAttributeMultiprocessorCount, dev) != hipSuccess) { grid = -1; return; }
        if (hipFuncSetAttribute((const void*)fwd, hipFuncAttributeMaxDynamicSharedMemorySize, LDS_BYTES) != hipSuccess) { fprintf(stderr, "kernel_launch: hipFuncSetAttribute failed\n"); grid = -1; return; }
        int per_cu = 0;
        if (hipOccupancyMaxActiveBlocksPerMultiprocessor(&per_cu, (const void*)fwd, NTHREADS, LDS_BYTES) != hipSuccess || per_cu < 1) fprintf(stderr, "kernel_launch: occupancy query says %d\n", per_cu);
        (void)hipGetLastError();
        grid = cus < 256 ? (cus / 8) * 8 : 256; if (grid < 16) { fprintf(stderr, "kernel_launch: %d CUs: too few\n", cus); grid = -1; return; }
    }
    if (grid <= 0) return;
    if (hipMemsetAsync((char*)d_ws + WS_CTL, 0, CTL_ZERO_BYTES, stream) != hipSuccess) return;
    Args a{};
    for (int i = 0; i < 26; ++i) a.in[i] = (const float*)d_in[i];
    a.out = (float*)d_out; a.ws = (unsigned char*)d_ws;
    hipLaunchKernelGGL(fwd, dim3(grid), dim3(NTHREADS), LDS_BYTES, stream, a);
}
```

```cpp
#include <hip/hip_runtime.h>
#include <cstdio>
#include <cstdint>
#define LAS __attribute__((address_space(3)))
#define GAS __attribute__((address_space(1)))
#ifndef PH_A
#define PH_A 1
#endif
#ifndef PH_B
#define PH_B 1
#endif
#ifndef PH_C
#define PH_C 1
#endif
#ifndef PH_D1
#define PH_D1 1
#endif
#ifndef PH_D2
#define PH_D2 1
#endif
#ifndef PH_E1
#define PH_E1 1
#endif
#ifndef PH_E2
#define PH_E2 1
#endif
#ifndef PH_E3
#define PH_E3 1
#endif
#ifndef PH_F0A
#define PH_F0A 1
#endif
#ifndef PH_F0B
#define PH_F0B 1
#endif
#ifndef PH_F1
#define PH_F1 1
#endif
#ifndef PH_F2
#define PH_F2 1
#endif
#ifndef PH_P0
#define PH_P0 1
#endif
#ifndef PH_F3
#define PH_F3 1
#endif
#ifndef PH_C_DIFF
#define PH_C_DIFF 1
#endif
#ifndef PH_C_SB
#define PH_C_SB 1
#endif
#ifndef PH_C_MLA
#define PH_C_MLA 1
#endif
#ifndef PH_B1
#define PH_B1 1
#endif
#ifndef PH_B2
#define PH_B2 1
#endif
#ifndef PH_B3
#define PH_B3 1
#endif
#ifndef RP_A
#define RP_A 1
#endif
#ifndef RP_B
#define RP_B 1
#endif
#ifndef RP_C
#define RP_C 1
#endif
#ifndef RP_D1
#define RP_D1 1
#endif
#ifndef RP_E1
#define RP_E1 1
#endif
#ifndef RP_E2
#define RP_E2 1
#endif
#ifndef RP_F0A
#define RP_F0A 1
#endif
#ifndef RP_F0B
#define RP_F0B 1
#endif
#ifndef RP_F1
#define RP_F1 1
#endif
#ifndef RP_F2
#define RP_F2 1
#endif
#ifndef RP_P0
#define RP_P0 1
#endif
#ifndef C_REP_MASK
#define C_REP_MASK 7
#endif
#ifndef A_ABL
#define A_ABL 0
#endif
#ifndef C_ABL
#define C_ABL 0
#endif
namespace pg8 {
#define PG8_LAS __attribute__((address_space(3)))
typedef unsigned short bf16_t;
typedef short bf16x8 __attribute__((ext_vector_type(8)));
typedef float f32x4 __attribute__((ext_vector_type(4)));
typedef unsigned u32x4 __attribute__((ext_vector_type(4)));
constexpr int BM = 256, BK = 64, HALF = 128, HTB = HALF * BK * 2  , STAGE_BYTES = 8 * HTB, NXCD = 8, WGM = 8;

__host__ __device__ __forceinline__ int lds_byte(int r, int c) { const int st = (r >> 4) * 2 + (c >> 5), rr = r & 15, cc = c & 31, ob = rr * 64 + cc * 2; return st * 1024 + (ob ^ (((ob >> 9) & 1) << 5)); }
__host__ __device__ __forceinline__ void stage_rc(int b, int& R, int& C) { const int st = b / 1024, sb = b % 1024, swz = sb ^ (((sb >> 9) & 1) << 5); R = (st >> 1) * 16 + swz / 64; C = (st & 1) * 32 + (swz % 64) / 2; }
__host__ __device__ __forceinline__ int perm32(int rho) { const int n = rho >> 4, i = rho & 15; return 8 * (i >> 2) + 4 * n + (i & 3); }

struct Unit { int pm, pn, sel; };
struct Gemm { const GAS bf16_t* A; const GAS bf16_t* Bt; int M, N, K, ld; const GAS int* rowidx; };

struct StaticOrder {
    int nM, nN, nwg, G, c;
    __host__ __device__ void init(int M, int N, int G_, int c_) { nM = M / BM; nN = N / BM; nwg = nM * nN; G = G_; c = c_; }
    __host__ __device__ bool next(int i, Unit& u) const {
        const long L = (long)i * G + c; if (L >= nwg) return false;
        int wgid = (int)L; { const int q = nwg / NXCD, r = nwg % NXCD, xcd = wgid % NXCD, off = wgid / NXCD; wgid = (xcd < r ? xcd * (q + 1) : r * (q + 1) + (xcd - r) * q) + off; }
        const int nig = WGM * nN, gid = wgid / nig, fm = gid * WGM, gsz = (nM - fm) < WGM ? (nM - fm) : WGM;
        u.pm = fm + ((wgid % nig) % gsz); u.pn = (wgid % nig) / gsz; u.sel = 0; return true;
    }
    __device__ __forceinline__ void a_ready(const Unit&) const {}
    __device__ __forceinline__ void done(const Unit&) const {}
    __device__ __forceinline__ size_t a_off(const Unit&) const { return 0; }
    __device__ __forceinline__ size_t b_off(const Unit&) const { return 0; }
    __device__ __forceinline__ bool keep(const Unit&) const { return false; }
};

__device__ __forceinline__ unsigned cvt_pk_bf16(float lo, float hi) { unsigned r; asm volatile("v_cvt_pk_bf16_f32 %0, %1, %2" : "=v"(r) : "v"(lo), "v"(hi)); return r; }
template <class T, class = void> struct HasScale { static constexpr bool v = false; };
template <class T> struct HasScale<T, decltype((void)T::SCALE)> { static constexpr bool v = true; };
template <class Epi, class Sched, bool ALIGN_EPI = false, bool SP2 = false, bool GATHER = false>
__device__ __forceinline__ void gemm_phase(PG8_LAS unsigned char* lds, const Gemm g, const Sched& S, const Epi& E, const int wave_idx) {
    int tid_; asm volatile("v_mbcnt_lo_u32_b32 %0, -1, 0\n\tv_mbcnt_hi_u32_b32 %0, -1, %0" : "=v"(tid_)); tid_ += wave_idx * 64;
    const int tid = tid_, wid = __builtin_amdgcn_readfirstlane(tid >> 6), lane = tid & 63, wr = wid >> 2, wc = wid & 3, fr = lane & 15, fq = lane >> 4;
    const int K = g.K, nt = K / BK, LD = g.ld;
    unsigned voffA[2], voffB[2];
#pragma unroll
    for (int i = 0; i < 2; ++i) { int R, C; stage_rc(tid * 16 + i * 8192, R, C); const int Rb = Epi::PERM ? ((R & ~31) + perm32(R & 31)) : R;
        voffA[i] = (unsigned)(R * LD + C) * 2u; voffB[i] = (unsigned)(Rb * LD + C) * 2u; }
    const size_t kstep = (size_t)(BK * 2);
    const size_t hstep = (size_t)HALF * LD * 2;
    const size_t tstep = 2 * hstep;
    const unsigned ldsw = (unsigned)wid * 1024u;
    const int aoff = lds_byte(wr * 64 + fr, fq * 8), boff = lds_byte(wc * 32 + fr, fq * 8);
#define PG8_SA(b, h) (((b) * 2 + (h)) * HTB)
#define PG8_SB(b, h) ((4 + (b) * 2 + (h)) * HTB)
#define PG8_STAGE(bufoff, gbase, voff) do { _Pragma("unroll") for (int _i = 0; _i < 2; ++_i) \
        __builtin_amdgcn_global_load_lds((const GAS unsigned*)((const GAS char*)(gbase) + (voff)[_i]), (PG8_LAS unsigned*)(lds + (bufoff) + ldsw + _i * 8192), 16, 0, 0); } while (0)
#define PG8_LDA(dst, b, h) do { _Pragma("unroll") for (int m = 0; m < 4; ++m) _Pragma("unroll") for (int k = 0; k < 2; ++k) dst[m][k] = *(const PG8_LAS bf16x8*)(lds + PG8_SA(b, h) + aoff + m * 2048 + k * 1024); } while (0)
#define PG8_LDB(dst, b, h) do { _Pragma("unroll") for (int n = 0; n < 2; ++n) _Pragma("unroll") for (int k = 0; k < 2; ++k) dst[n][k] = *(const PG8_LAS bf16x8*)(lds + PG8_SB(b, h) + boff + n * 2048 + k * 1024); } while (0)
#define PG8_MMA(ai, bj, At, Bt) do { __builtin_amdgcn_s_setprio(1); _Pragma("unroll") for (int m = 0; m < 4; ++m) _Pragma("unroll") for (int n = 0; n < 2; ++n) _Pragma("unroll") for (int k = 0; k < 2; ++k) \
        acc[ai][bj][m][n] = __builtin_amdgcn_mfma_f32_16x16x32_bf16(Bt[n][k], At[m][k], acc[ai][bj][m][n], 0, 0, 0); __builtin_amdgcn_s_setprio(0); } while (0)
#define PG8_WAIT_V(n) asm volatile("s_waitcnt vmcnt(" #n ")" ::: "memory")
#define PG8_WAIT_L(n) asm volatile("s_waitcnt lgkmcnt(" #n ")" ::: "memory")
#define PG8_BAR __builtin_amdgcn_s_barrier()
#define PG8_SCHED __builtin_amdgcn_sched_barrier(0)
    Unit cur, nxt; int ui = 0;
    if (!S.next(0, cur)) return;
    f32x4 acc[2][2][4][2];
#pragma unroll
    for (int a = 0; a < 2; ++a)
#pragma unroll
        for (int b = 0; b < 2; ++b)
#pragma unroll
            for (int m = 0; m < 4; ++m)
#pragma unroll
                for (int n = 0; n < 2; ++n) acc[a][b][m][n] = (f32x4){0.f, 0.f, 0.f, 0.f};
    bf16x8 At[4][2], B0[2][2], B1[2][2];
    const GAS char* cA = (const GAS char*)g.A + (GATHER ? (size_t)0 : (size_t)cur.pm * tstep + S.a_off(cur)); const GAS char* cB = (const GAS char*)g.Bt + (size_t)cur.pn * tstep + S.b_off(cur);
    unsigned vC[2][2], vN[2][2];
    if constexpr (GATHER) {
#pragma unroll
        for (int h = 0; h < 2; ++h)
#pragma unroll
            for (int i = 0; i < 2; ++i) { int R, C; stage_rc(tid * 16 + i * 8192, R, C); vC[h][i] = (unsigned)(g.rowidx[cur.pm * BM + h * HALF + R] * LD + C) * 2u; vN[h][i] = vC[h][i]; }
    }
#define PG8_STAGE_A(bufoff, gb, h, nx) do { if constexpr (GATHER) { unsigned vs_[2] = {(nx) ? vN[h][0] : vC[h][0], (nx) ? vN[h][1] : vC[h][1]}; PG8_STAGE(bufoff, gb, vs_); } \
        else { PG8_STAGE(bufoff, (gb) + (h) * hstep, voffA); } } while (0)
    S.a_ready(cur);
    if constexpr (SP2) {
        PG8_STAGE(PG8_SB(0, 0), cB, voffB); PG8_STAGE(PG8_SB(0, 1), cB + hstep, voffB); PG8_STAGE_A(PG8_SA(0, 0), cA, 0, false); PG8_STAGE_A(PG8_SA(0, 1), cA, 1, false);
        if (wr == 1) PG8_BAR;
        PG8_WAIT_V(2); PG8_BAR;
        PG8_STAGE(PG8_SB(1, 0), cB + kstep, voffB); PG8_STAGE_A(PG8_SA(1, 0), cA + kstep, 0, false); PG8_STAGE(PG8_SB(1, 1), cB + hstep + kstep, voffB);
        PG8_WAIT_V(6); PG8_BAR;
    } else {
        PG8_STAGE(PG8_SB(0, 0), cB, voffB); PG8_STAGE(PG8_SA(0, 0), cA, voffA); PG8_STAGE(PG8_SB(0, 1), cB + hstep, voffB); PG8_STAGE(PG8_SA(0, 1), cA + hstep, voffA);
        if (wr == 1) PG8_BAR;
        PG8_WAIT_V(4); PG8_BAR;
        PG8_STAGE(PG8_SB(1, 0), cB + kstep, voffB); PG8_STAGE(PG8_SA(1, 0), cA + kstep, voffA); PG8_STAGE(PG8_SB(1, 1), cB + hstep + kstep, voffB);
        PG8_WAIT_V(6); PG8_BAR;
    }
    for (;;) {
        const bool has_next = S.next(ui + 1, nxt);
        if constexpr (GATHER) { if (has_next) {
#pragma unroll
            for (int h = 0; h < 2; ++h)
#pragma unroll
                for (int i = 0; i < 2; ++i) { int R, C; stage_rc(tid * 16 + i * 8192, R, C); vN[h][i] = (unsigned)(g.rowidx[nxt.pm * BM + h * HALF + R] * LD + C) * 2u; } } }
        const GAS char* nA = GATHER ? cA : has_next ? (const GAS char*)g.A + (size_t)nxt.pm * tstep + S.a_off(nxt) : cA; const GAS char* nB = has_next ? (const GAS char*)g.Bt + (size_t)nxt.pn * tstep + S.b_off(nxt) : cB;
        for (int t = 0; t < nt; t += 2) {
            const bool last = (t == nt - 2);
            const GAS char* a1 = cA + (size_t)(t + 1) * kstep;
            const GAS char* a2 = last ? nA : cA + (size_t)(t + 2) * kstep; const GAS char* b2 = last ? nB : cB + (size_t)(t + 2) * kstep;
            const GAS char* a3 = a2 + kstep; const GAS char* b3 = b2 + kstep;
            if (last && has_next) S.a_ready(nxt);
            if constexpr (SP2) {
            PG8_LDB(B0, 0, 0); PG8_LDB(B1, 0, 1); PG8_SCHED; PG8_LDA(At, 0, 0); PG8_STAGE_A(PG8_SA(1, 1), a1, 1, false);
            PG8_WAIT_V(8); PG8_WAIT_L(0); PG8_BAR; PG8_MMA(0, 0, At, B0); PG8_MMA(0, 1, At, B1); PG8_BAR; PG8_SCHED;
            PG8_LDA(At, 0, 1); PG8_STAGE(PG8_SB(0, 0), b2, voffB); PG8_STAGE(PG8_SB(0, 1), b2 + hstep, voffB); PG8_STAGE_A(PG8_SA(0, 0), a2, 0, last);
            PG8_WAIT_V(8); PG8_WAIT_L(0); PG8_BAR; PG8_MMA(1, 0, At, B0); PG8_MMA(1, 1, At, B1); PG8_BAR; PG8_SCHED;
            PG8_LDB(B0, 1, 0); PG8_LDB(B1, 1, 1); PG8_SCHED; PG8_LDA(At, 1, 0); PG8_STAGE_A(PG8_SA(0, 1), a2, 1, last);
            PG8_WAIT_V(8); PG8_WAIT_L(0); PG8_BAR; PG8_MMA(0, 0, At, B0); PG8_MMA(0, 1, At, B1); PG8_BAR; PG8_SCHED;
            PG8_LDA(At, 1, 1); PG8_STAGE(PG8_SB(1, 0), b3, voffB); PG8_STAGE(PG8_SB(1, 1), b3 + hstep, voffB); PG8_STAGE_A(PG8_SA(1, 0), a3, 0, last);
            PG8_WAIT_V(8); PG8_WAIT_L(0); PG8_BAR; PG8_MMA(1, 0, At, B0); PG8_MMA(1, 1, At, B1); PG8_BAR; PG8_SCHED;
            } else {
            PG8_LDB(B0, 0, 0); PG8_SCHED; PG8_LDA(At, 0, 0); PG8_STAGE(PG8_SA(1, 1), a1 + hstep, voffA);
            PG8_WAIT_L(8); PG8_BAR; PG8_WAIT_L(0); PG8_MMA(0, 0, At, B0); PG8_BAR; PG8_SCHED;
            PG8_LDB(B1, 0, 1); PG8_STAGE(PG8_SB(0, 0), b2, voffB);
            PG8_BAR; PG8_WAIT_L(0); PG8_MMA(0, 1, At, B1); PG8_BAR;
            PG8_LDA(At, 0, 1); PG8_STAGE(PG8_SA(0, 0), a2, voffA);
            PG8_BAR; PG8_WAIT_L(0); PG8_MMA(1, 0, At, B0); PG8_BAR; PG8_SCHED;
            PG8_STAGE(PG8_SB(0, 1), b2 + hstep, voffB);
            PG8_WAIT_V(6); PG8_BAR; PG8_MMA(1, 1, At, B1); PG8_BAR;
            PG8_LDB(B0, 1, 0); PG8_SCHED; PG8_LDA(At, 1, 0); PG8_STAGE(PG8_SA(0, 1), a2 + hstep, voffA);
            PG8_WAIT_L(8); PG8_BAR; PG8_WAIT_L(0); PG8_MMA(0, 0, At, B0); PG8_BAR; PG8_SCHED;
            PG8_LDB(B1, 1, 1); PG8_STAGE(PG8_SB(1, 0), b3, voffB);
            PG8_BAR; PG8_WAIT_L(0); PG8_MMA(0, 1, At, B1); PG8_BAR;
            PG8_LDA(At, 1, 1); PG8_STAGE(PG8_SA(1, 0), a3, voffA);
            PG8_BAR; PG8_WAIT_L(0); PG8_MMA(1, 0, At, B0); PG8_BAR; PG8_SCHED;
            PG8_STAGE(PG8_SB(1, 1), b3 + hstep, voffB);
            PG8_WAIT_V(6); PG8_BAR; PG8_MMA(1, 1, At, B1); PG8_BAR;
            }
        }
        if constexpr (ALIGN_EPI) { if (wr == 0) PG8_BAR; }
        const int keep_ = (int)S.keep(cur);
        if constexpr (HasScale<Epi>::v) { if (keep_ == 2) E.scale(acc, cur, wr, wc, fr, fq); }
        if constexpr (!Epi::AFTER_DRAIN) { if (keep_ == 0) { E(acc, cur, wr, wc, fr, fq); S.done(cur); } }
        if (!has_next) break;
        if (keep_ == 0) {
#pragma unroll
        for (int a = 0; a < 2; ++a)
#pragma unroll
            for (int b = 0; b < 2; ++b)
#pragma unroll
                for (int m = 0; m < 4; ++m)
#pragma unroll
                    for (int n = 0; n < 2; ++n) acc[a][b][m][n] = (f32x4){0.f, 0.f, 0.f, 0.f}; }
        cur = nxt; cA = nA; cB = nB; ++ui;
        if constexpr (GATHER) { vC[0][0] = vN[0][0]; vC[0][1] = vN[0][1]; vC[1][0] = vN[1][0]; vC[1][1] = vN[1][1]; }
        if constexpr (ALIGN_EPI) { if (wr == 1) PG8_BAR; }
    }
    PG8_WAIT_V(0);
    if constexpr (!ALIGN_EPI) { if (wr == 0) PG8_BAR; }
    PG8_BAR;
    if constexpr (Epi::AFTER_DRAIN) { E.fused(acc, cur, wr, wc, fr, fq, lds, wid, lane); S.done(cur); }
#undef PG8_SA
#undef PG8_SB
#undef PG8_STAGE
#undef PG8_STAGE_A
#undef PG8_LDA
#undef PG8_LDB
#undef PG8_MMA
#undef PG8_WAIT_V
#undef PG8_WAIT_L
#undef PG8_BAR
#undef PG8_SCHED
}
typedef unsigned u32x2 __attribute__((ext_vector_type(2)));
typedef float f32x2v __attribute__((ext_vector_type(2)));
typedef __bf16 bf16x2v __attribute__((ext_vector_type(2)));
__device__ __forceinline__ unsigned pk2(float lo, float hi) { f32x2v v = {lo, hi}; bf16x2v b = __builtin_convertvector(v, bf16x2v); return __builtin_bit_cast(unsigned, b); }
__device__ __forceinline__ float bflo(unsigned w) { return __builtin_bit_cast(float, w << 16); }
__device__ __forceinline__ float bfhi(unsigned w) { return __builtin_bit_cast(float, w & 0xffff0000u); }
__device__ __forceinline__ float rstd_parts(const GAS float* base, unsigned eoff, int n4, float inv_n) {
    float s = 0.f; const GAS char* p = (const GAS char*)base + (size_t)(eoff * 4u);
    for (int i = 0; i < n4; ++i) { const f32x4 v = *(const GAS f32x4*)(p + 16 * i); s += (v[0] + v[1]) + (v[2] + v[3]); }
    return __builtin_amdgcn_rsqf(s * inv_n + 1e-6f);
}
__device__ __forceinline__ __amdgpu_buffer_rsrc_t wt_rsrc(GAS void* base) { return __builtin_amdgcn_make_buffer_rsrc((void*)base, 0, 0x7fffffff, 0x00020000); }
__device__ __forceinline__ void st16_wt(__amdgpu_buffer_rsrc_t r, unsigned byteoff, u32x4 v) { __builtin_amdgcn_raw_buffer_store_b128(v, r, byteoff, 0, 16); }
__device__ __forceinline__ float rows4_sum(float s) {
    const unsigned u = __builtin_bit_cast(unsigned, s);
    auto r = __builtin_amdgcn_permlane16_swap(u, u, false, false);
    const float t = __builtin_bit_cast(float, (unsigned)r[0]) + __builtin_bit_cast(float, (unsigned)r[1]);
    const unsigned v = __builtin_bit_cast(unsigned, t);
    auto q = __builtin_amdgcn_permlane32_swap(v, v, false, false);
    return __builtin_bit_cast(float, (unsigned)q[0]) + __builtin_bit_cast(float, (unsigned)q[1]);
}
__device__ __forceinline__ float rstd16_coop(const GAS float* base, unsigned row, int fq, float inv_n) {
    const f32x4 v = *(const GAS f32x4*)((const GAS char*)base + (size_t)((row * 16u + (unsigned)fq * 4u) * 4u));
    return __builtin_amdgcn_rsqf(rows4_sum((v[0] + v[1]) + (v[2] + v[3])) * inv_n + 1e-6f);
}
__device__ __forceinline__ void swap16(unsigned& a, unsigned& b) { auto r = __builtin_amdgcn_permlane16_swap(a, b, false, false); a = r[0]; b = r[1]; }
__device__ __forceinline__ int swz8(int fq) { return 8 * (((fq & 1) << 1) | (fq >> 1)); }
__device__ const double kRopeRev[16] = {0.15915494309189535, 0.08949940160889101, 0.050329212104487035, 0.0283021958306234, 0.015915494309189534, 0.008949940160889102, 0.005032921210448704, 0.00283021958306234,
                                        0.0015915494309189536, 0.0008949940160889102, 0.0005032921210448703, 0.00028302195830623395, 0.00015915494309189535, 8.949940160889102e-05, 5.0329212104487035e-05, 2.8302195830623396e-05};
__device__ __forceinline__ void rope_cs(int pos, int i, float& cs, float& sn) {
    double a = (double)pos * kRopeRev[i]; a -= __builtin_floor(a);
    const float r = (float)a; sn = __builtin_amdgcn_sinf(r); cs = __builtin_amdgcn_cosf(r);
}
#define PG8_L2E 1.4426950408889634f

struct EpiA {
    static constexpr bool PERM = false, AFTER_DRAIN = false;
    const GAS float* ssq; GAS bf16_t *cq, *ckv, *krope, *qk; GAS float *ssq_cq, *ssq_ckv; float c2; GAS unsigned* kn; int skip;
    __device__ __forceinline__ void operator()(const f32x4 (&acc)[2][2][4][2], const Unit& u, int wr, int wc, int fr, int fq) const {
        if (skip) return;
        const int pn = u.pn, row0 = u.pm * BM + wr * 64 + fr;
        float rs[2][4];
#pragma unroll
        for (int ai = 0; ai < 2; ++ai)
#pragma unroll
            for (int m = 0; m < 4; ++m) rs[ai][m] = rstd16_coop(ssq, (unsigned)(row0 + ai * HALF + m * 16), fq, 1.f / 1024.f);
        if (pn < 2) {
            GAS bf16_t* dst = pn == 0 ? cq : ckv; GAS float* sq = pn == 0 ? ssq_cq : ssq_ckv;
#pragma unroll
            for (int ai = 0; ai < 2; ++ai)
#pragma unroll
                for (int m = 0; m < 4; ++m) { const int row = row0 + ai * HALF + m * 16; const float r = rs[ai][m]; float s2 = 0.f;
#pragma unroll
                    for (int bj = 0; bj < 2; ++bj) { const f32x4 v = acc[ai][bj][m][0] * r, v2 = acc[ai][bj][m][1] * r;
                        s2 += ((v[0] * v[0] + v[1] * v[1]) + (v[2] * v[2] + v[3] * v[3])) + ((v2[0] * v2[0] + v2[1] * v2[1]) + (v2[2] * v2[2] + v2[3] * v2[3]));
                        unsigned wx = pk2(v[0], v[1]), wy = pk2(v[2], v[3]), wz = pk2(v2[0], v2[1]), ww = pk2(v2[2], v2[3]); swap16(wx, wz); swap16(wy, ww); const u32x4 w = {wx, wy, wz, ww};
                        *(GAS u32x4*)(dst + (size_t)row * 256 + bj * HALF + wc * 32 + swz8(fq)) = w; }
                    s2 = rows4_sum(s2);
                    if (fq == 0) sq[(size_t)row * 4 + wc] = s2; }
        } else if (pn == 2) {
            if (wc == 0) {
#pragma unroll
                for (int ai = 0; ai < 2; ++ai)
#pragma unroll
                    for (int m = 0; m < 4; ++m) { const int row = row0 + ai * HALF + m * 16, pos = row & 8191; const float r = rs[ai][m];
                        const f32x4 v0 = acc[ai][0][m][0] * r, v1 = acc[ai][0][m][1] * r; float o0[4], o1[4];
#pragma unroll
                        for (int e = 0; e < 4; ++e) { float cs, sn; rope_cs(pos, 4 * fq + e, cs, sn); o0[e] = v0[e] * cs - v1[e] * sn; o1[e] = v0[e] * sn + v1[e] * cs; }
                        u32x2 w0, w1; w0.x = pk2(o0[0], o0[1]); w0.y = pk2(o0[2], o0[3]); w1.x = pk2(o1[0], o1[1]); w1.y = pk2(o1[2], o1[3]);
                        *(GAS u32x2*)(krope + (size_t)row * 32 + 4 * fq) = w0; *(GAS u32x2*)(krope + (size_t)row * 32 + 16 + 4 * fq) = w1; }
            }
        } else {
            const int t = pn - 3, buf = t >> 1, half = t & 1; GAS bf16_t* dst = qk + (size_t)buf * 16384 * 512; const float sc = (buf & 1) ? 1.f : c2;
#pragma unroll
            for (int ai = 0; ai < 2; ++ai)
#pragma unroll
                for (int bj = 0; bj < 2; ++bj) { float kmx = 0.f;
#pragma unroll
                    for (int m = 0; m < 4; ++m) { const int row = row0 + ai * HALF + m * 16; const float r = rs[ai][m] * sc;
                        const f32x4 v = acc[ai][bj][m][0] * r, v2 = acc[ai][bj][m][1] * r;
                        const float s2 = ((v[0] * v[0] + v[1] * v[1]) + (v[2] * v[2] + v[3] * v[3])) + ((v2[0] * v2[0] + v2[1] * v2[1]) + (v2[2] * v2[2] + v2[3] * v2[3]));
                        unsigned wx = pk2(v[0], v[1]), wy = pk2(v[2], v[3]), wz = pk2(v2[0], v2[1]), ww = pk2(v2[2], v2[3]); swap16(wx, wz); swap16(wy, ww); const u32x4 w = {wx, wy, wz, ww};
                        *(GAS u32x4*)(dst + (size_t)row * 512 + half * 256 + bj * HALF + wc * 32 + swz8(fq)) = w;
                        kmx = fmaxf(kmx, s2); }
                    if (pn >= 9) {
                        float s = kmx; const float q1 = __shfl_xor(s, 16), q2 = __shfl_xor(s, 32), q3 = __shfl_xor(q1, 32); s = (s + q1) + (q2 + q3);
                        s = fmaxf(s, __shfl_xor(s, 1)); s = fmaxf(s, __shfl_xor(s, 2)); s = fmaxf(s, __shfl_xor(s, 4)); s = fmaxf(s, __shfl_xor(s, 8));
                        if ((fr | fq) == 0) __hip_atomic_fetch_max(kn + (((size_t)(4 * u.pm + 2 * ai + wr) * 8 + 4 * (pn - 9) + 2 * bj + (wc >> 1)) * 2 + (wc & 1)), __builtin_bit_cast(unsigned, s), __ATOMIC_RELAXED, __HIP_MEMORY_SCOPE_AGENT); } }
        }
    }
};
struct EpiVT {
    static constexpr bool PERM = true, AFTER_DRAIN = false;
    GAS bf16_t* out; int ld; const GAS float* ssq; int n4; float inv_n;
    __device__ __forceinline__ void operator()(const f32x4 (&acc)[2][2][4][2], const Unit& u, int wr, int wc, int fr, int fq) const {
        const int col0 = u.pn * BM + wc * 32 + 8 * fq, row0 = u.pm * BM + wr * 64 + fr;
        float cs[2][8];
        { const int ln = fq * 16 + fr;
          const float mine = rstd_parts(ssq, (unsigned)((u.pn * BM + wc * 32 + (ln >> 5) * HALF + ((ln >> 3) & 3) * 8 + (ln & 7)) * (4 * n4)), n4, inv_n);
#pragma unroll
          for (int bj = 0; bj < 2; ++bj)
#pragma unroll
            for (int j = 0; j < 8; ++j) cs[bj][j] = __shfl(mine, bj * 32 + fq * 8 + j); }
#pragma unroll
        for (int ai = 0; ai < 2; ++ai)
#pragma unroll
            for (int m = 0; m < 4; ++m) { GAS bf16_t* rowp = out + (size_t)(row0 + ai * HALF + m * 16) * ld + col0;
#pragma unroll
                for (int bj = 0; bj < 2; ++bj) { const f32x4 v0 = acc[ai][bj][m][0], v1 = acc[ai][bj][m][1]; u32x4 w;
                    w.x = pk2(v0[0] * cs[bj][0], v0[1] * cs[bj][1]); w.y = pk2(v0[2] * cs[bj][2], v0[3] * cs[bj][3]);
                    w.z = pk2(v1[0] * cs[bj][4], v1[1] * cs[bj][5]); w.w = pk2(v1[2] * cs[bj][6], v1[3] * cs[bj][7]);
                    *(GAS u32x4*)(rowp + bj * HALF) = w; } }
    }
};
struct EpiRS {
    static constexpr bool PERM = true, AFTER_DRAIN = false;
    GAS bf16_t* out; int ld; const GAS float* ssq; int n4; float inv_n; float scale; int pnmask; int pnshift; size_t zstride;
    __device__ __forceinline__ void operator()(const f32x4 (&acc)[2][2][4][2], const Unit& u, int wr, int wc, int fr, int fq) const {
        const int col0 = (u.pn & pnmask) * BM + wc * 32 + 8 * fq, row0 = u.pm * BM + wr * 64 + fr;
        float rr[2][4];
#pragma unroll
        for (int ai = 0; ai < 2; ++ai)
#pragma unroll
            for (int m = 0; m < 4; ++m) rr[ai][m] = (n4 ? rstd_parts(ssq, (unsigned)((row0 + ai * HALF + m * 16) * (4 * n4)), n4, inv_n) : 1.f) * scale;
#pragma unroll
        for (int ai = 0; ai < 2; ++ai)
#pragma unroll
            for (int m = 0; m < 4; ++m) { const int row = row0 + ai * HALF + m * 16; const float r = rr[ai][m];
                GAS bf16_t* rowp = out + (size_t)(u.pn >> pnshift) * zstride + (size_t)row * ld + col0;
#pragma unroll
                for (int bj = 0; bj < 2; ++bj) { const f32x4 v0 = acc[ai][bj][m][0] * r, v1 = acc[ai][bj][m][1] * r; u32x4 w;
                    w.x = pk2(v0[0], v0[1]); w.y = pk2(v0[2], v0[3]); w.z = pk2(v1[0], v1[1]); w.w = pk2(v1[2], v1[3]); *(GAS u32x4*)(rowp + bj * HALF) = w; } }
    }
};
struct EpiQ {
    static constexpr bool PERM = false, AFTER_DRAIN = false;
    GAS bf16_t* q; const GAS float* ssq_cq; float c2;
    __device__ __forceinline__ void operator()(const f32x4 (&acc)[2][2][4][2], const Unit& u, int wr, int wc, int fr, int fq) const {
        const int pn = u.pn, row0 = u.pm * BM + wr * 64 + fr;
        float rr[2][4];
#pragma unroll
        for (int ai = 0; ai < 2; ++ai)
#pragma unroll
            for (int m = 0; m < 4; ++m) rr[ai][m] = rstd_parts(ssq_cq, (unsigned)((row0 + ai * HALF + m * 16) * 4), 1, 1.f / 256.f) * c2;
#pragma unroll
        for (int ai = 0; ai < 2; ++ai)
#pragma unroll
            for (int m = 0; m < 4; ++m) { const int row = row0 + ai * HALF + m * 16; const float r = rr[ai][m];
                if (pn < 2) {
#pragma unroll
                    for (int bj = 0; bj < 2; ++bj) { const f32x4 v = acc[ai][bj][m][0] * r, v2 = acc[ai][bj][m][1] * r;
                        unsigned wx = pk2(v[0], v[1]), wy = pk2(v[2], v[3]), wz = pk2(v2[0], v2[1]), ww = pk2(v2[2], v2[3]); swap16(wx, wz); swap16(wy, ww); const u32x4 w = {wx, wy, wz, ww};
                        *(GAS u32x4*)(q + (size_t)row * 768 + pn * 256 + bj * HALF + wc * 32 + swz8(fq)) = w; }
                } else { const int pos = row & 8191; float cs[4], sn[4];
#pragma unroll
                    for (int e = 0; e < 4; ++e) rope_cs(pos, 4 * fq + e, cs[e], sn[e]);
#pragma unroll
                    for (int bj = 0; bj < 2; ++bj) { const f32x4 v0 = acc[ai][bj][m][0] * r, v1 = acc[ai][bj][m][1] * r; float o0[4], o1[4];
#pragma unroll
                        for (int e = 0; e < 4; ++e) { o0[e] = v0[e] * cs[e] - v1[e] * sn[e]; o1[e] = v0[e] * sn[e] + v1[e] * cs[e]; }
                        u32x2 w0, w1; w0.x = pk2(o0[0], o0[1]); w0.y = pk2(o0[2], o0[3]); w1.x = pk2(o1[0], o1[1]); w1.y = pk2(o1[2], o1[3]);
                        GAS bf16_t* p = q + (size_t)row * 768 + 512 + (4 * bj + wc) * 32 + 4 * fq; *(GAS u32x2*)p = w0; *(GAS u32x2*)(p + 16) = w1; }
                } }
    }
};
struct D1Order {
    StaticOrder so; size_t dA, dB;
    __device__ __forceinline__ bool next(int i, Unit& u) const { if (i >= 9) return false; if (!so.next(0, u)) return false; u.sel = i; return true; }
    __device__ __forceinline__ void a_ready(const Unit&) const {}
    __device__ __forceinline__ void done(const Unit&) const {}
    __device__ __forceinline__ size_t a_off(const Unit& u) const { const int z = u.sel - 6; return u.sel >= 6 ? dA + (size_t)(z >> 1) * 16384 * 2048 + (size_t)(z & 1) * 1024 : (size_t)(u.sel & 1) * 1024; }
    __device__ __forceinline__ size_t b_off(const Unit& u) const { const int z = u.sel - 6; return u.sel >= 6 ? dB + (size_t)(z >> 1) * 1024 * 2048 + (size_t)(z & 1) * 1024 : (size_t)(u.sel >> 1) * 1024 * 2048 + (size_t)(u.sel & 1) * 1024; }
    __device__ __forceinline__ int keep(const Unit& u) const { return u.sel < 6 ? ((u.sel & 1) ? 0 : 1) : (u.sel < 8 ? 2 : 0); }
};
struct EpiD1 {
    static constexpr bool PERM = true, AFTER_DRAIN = false, SCALE = true;
    GAS unsigned char* g; GAS bf16_t* mb; const GAS float* ssq;
    __device__ __forceinline__ void scale(f32x4 (&acc)[2][2][4][2], const Unit& u, int wr, int wc, int fr, int fq) const {
        const unsigned toff = (unsigned)(((wr * 4 + wc) * 64 + fq * 16 + fr) * 16), tile8 = (unsigned)(u.pm * 4 + u.pn) * 8u;
        const GAS unsigned char* ga = g + (size_t)((unsigned)(u.sel - 6) * 2048u + tile8) * 8192u + toff;
        const GAS unsigned char* gb = ga + (size_t)2048 * 8192;
#pragma unroll
        for (int ai = 0; ai < 2; ++ai) {
            u32x4 wa[2][2], wb[2][2];
#pragma unroll
            for (int bj = 0; bj < 2; ++bj)
#pragma unroll
                for (int mp = 0; mp < 2; ++mp) { wa[bj][mp] = *(const GAS u32x4*)(ga + ((ai * 2 + bj) * 2 + mp) * 8192); wb[bj][mp] = *(const GAS u32x4*)(gb + ((ai * 2 + bj) * 2 + mp) * 8192); }
#pragma unroll
            for (int bj = 0; bj < 2; ++bj)
#pragma unroll
                for (int mp = 0; mp < 2; ++mp)
#pragma unroll
                    for (int k = 0; k < 4; ++k) { const int m = 2 * mp + (k >> 1), n = k & 1; const unsigned qa = wa[bj][mp][k], qb = wb[bj][mp][k];
#pragma unroll
                        for (int e2 = 0; e2 < 4; ++e2) acc[ai][bj][m][n][e2] *= ((float)((qa >> (8 * e2)) & 0xffu) + 0.5f) * __builtin_amdgcn_rcpf((float)((qb >> (8 * e2)) & 0xffu) + 0.5f); }
        }
    }
    __device__ __forceinline__ void operator()(const f32x4 (&acc)[2][2][4][2], const Unit& u, int wr, int wc, int fr, int fq) const {
        const int col0 = u.pn * BM + wc * 32 + 8 * fq, row0 = u.pm * BM + wr * 64 + fr;
        const unsigned toff = (unsigned)(((wr * 4 + wc) * 64 + fq * 16 + fr) * 16), tile8 = (unsigned)(u.pm * 4 + u.pn) * 8u;
        if (u.sel < 6) {
            GAS unsigned char* gz = g + (size_t)((unsigned)(u.sel >> 1) * 2048u + tile8) * 8192u + toff;
            float rr[2][4];
#pragma unroll
            for (int ai = 0; ai < 2; ++ai)
#pragma unroll
                for (int m = 0; m < 4; ++m) rr[ai][m] = -PG8_L2E * rstd16_coop(ssq, (unsigned)(row0 + ai * HALF + m * 16), fq, 1.f / 1024.f);
#pragma unroll
            for (int ai = 0; ai < 2; ++ai)
#pragma unroll
                for (int bj = 0; bj < 2; ++bj)
#pragma unroll
                    for (int mp = 0; mp < 2; ++mp) { u32x4 w;
#pragma unroll
                        for (int k = 0; k < 4; ++k) { const int m = 2 * mp + (k >> 1), n = k & 1; const float r = rr[ai][m]; unsigned pk = 0u;
#pragma unroll
                            for (int e2 = 0; e2 < 4; ++e2) { const float sg = __builtin_amdgcn_rcpf(1.f + __builtin_amdgcn_exp2f(acc[ai][bj][m][n][e2] * r));
                                pk = __builtin_amdgcn_cvt_pk_u8_f32(fminf(sg * 256.f - 0.5f, 255.f), e2, pk); }
                            w[k] = pk; }
                        *(GAS u32x4*)(gz + ((ai * 2 + bj) * 2 + mp) * 8192) = w; }
        } else {
            const GAS unsigned char* ga = g + (size_t)(2u * 2048u + tile8) * 8192u + toff;
#pragma unroll
            for (int ai = 0; ai < 2; ++ai) {
                u32x4 wa[2][2];
#pragma unroll
                for (int bj = 0; bj < 2; ++bj)
#pragma unroll
                    for (int mp = 0; mp < 2; ++mp) wa[bj][mp] = *(const GAS u32x4*)(ga + ((ai * 2 + bj) * 2 + mp) * 8192);
#pragma unroll
                for (int m = 0; m < 4; ++m)
#pragma unroll
                    for (int bj = 0; bj < 2; ++bj) { const size_t o = (size_t)(row0 + ai * HALF + m * 16) * 1024 + col0 + bj * HALF; float v[8];
#pragma unroll
                        for (int j = 0; j < 8; ++j) { const unsigned qa = wa[bj][m >> 1][(m & 1) * 2 + (j >> 2)];
                            v[j] = acc[ai][bj][m][j >> 2][j & 3] * (((float)((qa >> (8 * (j & 3))) & 0xffu) + 0.5f) * (1.f / 256.f)); }
                        u32x4 w; w.x = pk2(v[0], v[1]); w.y = pk2(v[2], v[3]); w.z = pk2(v[4], v[5]); w.w = pk2(v[6], v[7]); *(GAS u32x4*)(mb + o) = w; } }
        }
    }
};
struct EpiRes {
    static constexpr bool PERM = true, AFTER_DRAIN = false;
    GAS bf16_t* xb; GAS float* ssq;
    __device__ __forceinline__ void operator()(const f32x4 (&acc)[2][2][4][2], const Unit& u, int wr, int wc, int fr, int fq) const {
        const int col0 = u.pn * BM + wc * 32 + 8 * fq, row0 = u.pm * BM + wr * 64 + fr;
#pragma unroll
        for (int ai = 0; ai < 2; ++ai) {
            u32x4 xv[4][2];
#pragma unroll
            for (int m = 0; m < 4; ++m)
#pragma unroll
                for (int bj = 0; bj < 2; ++bj) xv[m][bj] = *(const GAS u32x4*)(xb + (size_t)(row0 + ai * HALF + m * 16) * 1024 + col0 + bj * HALF);
#pragma unroll
            for (int m = 0; m < 4; ++m) { const int row = row0 + ai * HALF + m * 16; const size_t rb = (size_t)row * 1024 + col0; float s2 = 0.f;
#pragma unroll
                for (int bj = 0; bj < 2; ++bj) { const u32x4 xw = xv[m][bj]; const f32x4 a0 = acc[ai][bj][m][0], a1 = acc[ai][bj][m][1];
                    const float v0 = bflo(xw.x) + a0[0], v1 = bfhi(xw.x) + a0[1], v2 = bflo(xw.y) + a0[2], v3 = bfhi(xw.y) + a0[3];
                    const float v4 = bflo(xw.z) + a1[0], v5 = bfhi(xw.z) + a1[1], v6 = bflo(xw.w) + a1[2], v7 = bfhi(xw.w) + a1[3];
                    u32x4 w; w.x = pk2(v0, v1); w.y = pk2(v2, v3); w.z = pk2(v4, v5); w.w = pk2(v6, v7);
                    *(GAS u32x4*)(xb + rb + bj * HALF) = w;
                    s2 += ((v0 * v0 + v1 * v1) + (v2 * v2 + v3 * v3)) + ((v4 * v4 + v5 * v5) + (v6 * v6 + v7 * v7)); }
                s2 += __shfl_xor(s2, 16); s2 += __shfl_xor(s2, 32);
                if (fq == 0) ssq[(size_t)row * 16 + u.pn * 4 + wc] = s2; } }
    }
};
struct EpiAct {
    static constexpr bool PERM = true, AFTER_DRAIN = false;
    GAS bf16_t* act; const GAS float* s_rstd; const GAS float* s_w;
    __device__ __forceinline__ void operator()(const f32x4 (&acc)[2][2][4][2], const Unit& u, int wr, int wc, int fr, int fq) const {
        const int t = u.pn & 1, row0 = u.pm * BM + wr * 64 + fr;
        const __amdgpu_buffer_rsrc_t rsrc = __builtin_amdgcn_make_buffer_rsrc((void*)act, 0, 40960 * 256 * 2, 0x00020000);
        float rr[2][4], ww[2][4];
#pragma unroll
        for (int ai = 0; ai < 2; ++ai)
#pragma unroll
            for (int m = 0; m < 4; ++m) { rr[ai][m] = s_rstd[row0 + ai * HALF + m * 16]; ww[ai][m] = s_w[row0 + ai * HALF + m * 16]; }
#pragma unroll
        for (int ai = 0; ai < 2; ++ai)
#pragma unroll
            for (int m = 0; m < 4; ++m) { const int row = row0 + ai * HALF + m * 16; const float rs = rr[ai][m], w = ww[ai][m]; float o[8];
#pragma unroll
                for (int j = 0; j < 8; ++j) { const float a = acc[ai][0][m][j >> 2][j & 3] * rs, b = acc[ai][1][m][j >> 2][j & 3] * rs;
                    const float v = a * __builtin_amdgcn_rcpf(1.f + __builtin_amdgcn_exp2f(-PG8_L2E * a)) * b * w; o[j] = (w != 0.f) ? v : 0.f; }
                u32x4 pw; pw.x = pk2(o[0], o[1]); pw.y = pk2(o[2], o[3]); pw.z = pk2(o[4], o[5]); pw.w = pk2(o[6], o[7]);
                __builtin_amdgcn_raw_buffer_store_b128(pw, rsrc, (unsigned)(row * 256 + t * 128 + wc * 32 + 8 * fq) * 2u, 0,   16); }
    }
};
struct SplitK2Order {
    StaticOrder so; size_t tstep;
    __device__ __forceinline__ bool next(int i, Unit& u) const { return so.next(i, u); }
    __device__ __forceinline__ void a_ready(const Unit&) const {}
    __device__ __forceinline__ void done(const Unit&) const {}
    __device__ __forceinline__ size_t a_off(const Unit& u) const { return (size_t)(u.pn >> 1) * 1024; }
    __device__ __forceinline__ size_t b_off(const Unit& u) const { return (size_t)(u.pn >> 1) * 1024 - (size_t)(u.pn >> 1) * 2 * tstep; }
    __device__ __forceinline__ bool keep(const Unit&) const { return false; }
};
struct MoeOrder {
    const PG8_LAS int* tstart; int per, G, v;
    __device__ __forceinline__ bool next(int i, Unit& u) const {
        const int idx = i * G + v, tot = tstart[32] * per; if (idx >= tot) return false;
        const int ti = idx / per, ct = idx - ti * per; int e = 0;
#pragma unroll 1
        for (int k = 1; k < 32; ++k) e += (tstart[k] <= ti) ? 1 : 0;
        u.pm = ti; u.pn = e * per + ct; u.sel = 0; return true;
    }
    __device__ __forceinline__ void a_ready(const Unit&) const {}
    __device__ __forceinline__ void done(const Unit&) const {}
    __device__ __forceinline__ size_t a_off(const Unit&) const { return 0; }
    __device__ __forceinline__ size_t b_off(const Unit&) const { return 0; }
    __device__ __forceinline__ bool keep(const Unit&) const { return false; }
};
struct MoeOrderP {
    const PG8_LAS int* tstart; GAS unsigned* cnt; int G, v;
    __device__ __forceinline__ bool next(int i, Unit& u) const {
        const int idx = i * G + v, tot = tstart[32] * 2; if (idx >= tot) return false;
        const int ti = idx >> 1, ct = idx & 1; int e = 0;
#pragma unroll 1
        for (int k = 1; k < 32; ++k) e += (tstart[k] <= ti) ? 1 : 0;
        u.pm = ti; u.pn = e * 2 + ct; u.sel = 0; return true;
    }
    __device__ __forceinline__ void a_ready(const Unit&) const {}
    __device__ __forceinline__ void done(const Unit& u) const {
        asm volatile("s_waitcnt vmcnt(0)" ::: "memory");
        int ln; asm volatile("v_mbcnt_lo_u32_b32 %0, -1, 0\n\tv_mbcnt_hi_u32_b32 %0, -1, %0" : "=v"(ln));
        if (ln == 0) __hip_atomic_fetch_add(cnt + u.pm, 1u, __ATOMIC_RELAXED, __HIP_MEMORY_SCOPE_AGENT);
    }
    __device__ __forceinline__ size_t a_off(const Unit&) const { return 0; }
    __device__ __forceinline__ size_t b_off(const Unit&) const { return 0; }
    __device__ __forceinline__ bool keep(const Unit&) const { return false; }
};
struct MoeOrderC {
    const PG8_LAS int* tstart; const GAS unsigned* cnt; int G, v, wid;
    __device__ __forceinline__ bool next(int i, Unit& u) const {
        const int T = tstart[32], L = (2 * T > G) ? 2 * T - G : 0, R = G - L;
        const int idx = (v >= L) ? ((i < 2) ? i * R + (v - L) : 2 * R + (i - 2) * G + v) : 2 * R + i * G + v;
        if (idx >= 4 * T) return false;
        const int ti = idx >> 2, ct = idx & 3; int e = 0;
#pragma unroll 1
        for (int k = 1; k < 32; ++k) e += (tstart[k] <= ti) ? 1 : 0;
        u.pm = ti; u.pn = e * 4 + ct; u.sel = 0; return true;
    }
    __device__ __forceinline__ void a_ready(const Unit& u) const {
        if (wid == 0) {
            const GAS unsigned* c = cnt + u.pm; int spins = 0;
#pragma unroll 1
            while ((unsigned)__builtin_amdgcn_readfirstlane(__hip_atomic_load(c, __ATOMIC_RELAXED, __HIP_MEMORY_SCOPE_AGENT)) < 16u && ++spins < (1 << 22)) __builtin_amdgcn_s_sleep(2);
            __builtin_amdgcn_fence(__ATOMIC_ACQUIRE, "agent");
            asm volatile("s_waitcnt vmcnt(0)" ::: "memory");
        }
        __builtin_amdgcn_s_barrier();
    }
    __device__ __forceinline__ void done(const Unit&) const {}
    __device__ __forceinline__ size_t a_off(const Unit&) const { return 0; }
    __device__ __forceinline__ size_t b_off(const Unit&) const { return 0; }
    __device__ __forceinline__ bool keep(const Unit&) const { return false; }
};
}
namespace att {
typedef unsigned short bf16;
typedef short bf16x8 __attribute__((ext_vector_type(8)));
typedef short s16x4 __attribute__((ext_vector_type(4)));
typedef float f32x16 __attribute__((ext_vector_type(16)));
typedef float f32x4 __attribute__((ext_vector_type(4)));
typedef unsigned u32x4 __attribute__((ext_vector_type(4)));
typedef unsigned u32x2 __attribute__((ext_vector_type(2)));
typedef float f32x2v __attribute__((ext_vector_type(2)));
typedef __bf16 bf16x2v __attribute__((ext_vector_type(2)));
__device__ __forceinline__ unsigned pk2(float lo, float hi) { f32x2v v = {lo, hi}; bf16x2v b = __builtin_convertvector(v, bf16x2v); return __builtin_bit_cast(unsigned, b); }
__device__ __forceinline__ float bflo(unsigned w) { return __builtin_bit_cast(float, w << 16); }
__device__ __forceinline__ float bfhi(unsigned w) { return __builtin_bit_cast(float, w & 0xffff0000u); }
__device__ __forceinline__ int crow(int r, int hi) { return (r & 3) + 8 * (r >> 2) + 4 * hi; }
__device__ __forceinline__ float xhalf(float v) {
    const unsigned u = __builtin_bit_cast(unsigned, v);
    auto rr = __builtin_amdgcn_permlane32_swap(u, u, false, false);
    const unsigned o = (rr[0] != u) ? rr[0] : rr[1];
    return __builtin_bit_cast(float, o);
}
__device__ __forceinline__ bf16x8 mk8(unsigned a, unsigned b, unsigned c, unsigned d) { u32x4 w = {a, b, c, d}; return __builtin_bit_cast(bf16x8, w); }

constexpr int VPB = 144;
template <int DK> struct KLay { static constexpr int KPB = (DK + 8) * 2, KBUF = 64 * KPB; };

template <int DK, int DV, bool KROPE> struct Stage {
    static constexpr int NK = KROPE ? 1 : DK / 64, NV = DV / 64;
    u32x4 kr[NK]; u32x4 kr2; u32x4 vr[NV];
    __device__ __forceinline__ void loadK(int tid, const GAS bf16* Kg, int ldk, const GAS bf16* K2g, int kv0) {
        const GAS char* kbase = (const GAS char*)(Kg + (size_t)kv0 * ldk);
        if constexpr (KROPE) {
            kr[0] = *(const GAS u32x4*)(kbase + (unsigned)(((tid >> 3) * ldk + 8 * (tid & 7)) * 2));
            if (tid < 256) kr2 = *(const GAS u32x4*)((const GAS char*)(K2g + (size_t)kv0 * 32) + (unsigned)(tid * 16));
        } else {
#pragma unroll
            for (int i = 0; i < NK; ++i) { const int p = tid + 512 * i, row = p / (DK / 8), ch = p % (DK / 8); kr[i] = *(const GAS u32x4*)(kbase + (unsigned)((row * ldk + 8 * ch) * 2)); }
        }
    }
    __device__ __forceinline__ void loadV(int tid, const GAS bf16* Vg, int ldv, int kv0) {
        const GAS char* vbase = (const GAS char*)(Vg + kv0);
#pragma unroll
        for (int i = 0; i < NV; ++i) { const int p = tid + 512 * i, dd = p >> 3, ch = p & 7; vr[i] = *(const GAS u32x4*)(vbase + (unsigned)((dd * ldv + 8 * ch) * 2)); }
    }
    __device__ __forceinline__ void storeK(int tid, LAS unsigned char* kb) const {
        constexpr int KPB = KLay<DK>::KPB;
        if constexpr (KROPE) {
            *(LAS u32x4*)(kb + (tid >> 3) * KPB + 16 * (tid & 7)) = kr[0];
            if (tid < 256) *(LAS u32x4*)(kb + (tid >> 2) * KPB + 128 + 16 * (tid & 3)) = kr2;
        } else {
#pragma unroll
            for (int i = 0; i < NK; ++i) { const int p = tid + 512 * i, row = p / (DK / 8), ch = p % (DK / 8); *(LAS u32x4*)(kb + row * KPB + 16 * ch) = kr[i]; }
        }
    }
    __device__ __forceinline__ void storeV(int tid, LAS unsigned char* vb) const {
#pragma unroll
        for (int i = 0; i < NV; ++i) { const int p = tid + 512 * i, dd = p >> 3, ch = p & 7; LAS unsigned char* q = vb + dd * VPB + 32 * (ch >> 1) + 8 * (ch & 1);
            *(LAS u32x2*)q = (u32x2){vr[i].x, vr[i].y}; *(LAS u32x2*)(q + 16) = (u32x2){vr[i].z, vr[i].w}; }
    }
    __device__ __forceinline__ void load(int tid, const GAS bf16* Kg, int ldk, const GAS bf16* K2g, const GAS bf16* Vg, int ldv, int kv0) { loadK(tid, Kg, ldk, K2g, kv0); loadV(tid, Vg, ldv, kv0); }
    __device__ __forceinline__ void store(int tid, LAS unsigned char* kb, LAS unsigned char* vb) const { storeK(tid, kb); storeV(tid, vb); }
};

template <int DK> __device__ __forceinline__ void qkt(f32x16& p0, f32x16& p1, const LAS unsigned char* kb, const bf16x8 (&qf)[DK / 16], int r32, int hi) {
    constexpr int KPB = KLay<DK>::KPB;
    const LAS unsigned char* k0 = kb + r32 * KPB + hi * 16;
#pragma unroll
    for (int d0 = 0; d0 < DK / 16; ++d0) {
        const bf16x8 a0 = *(const LAS bf16x8*)(k0 + d0 * 32), a1 = *(const LAS bf16x8*)(k0 + 32 * KPB + d0 * 32);
        p0 = __builtin_amdgcn_mfma_f32_32x32x16_bf16(a0, qf[d0], p0, 0, 0, 0);
        p1 = __builtin_amdgcn_mfma_f32_32x32x16_bf16(a1, qf[d0], p1, 0, 0, 0);
    }
}
template <int DK> __device__ __forceinline__ void qkt_qmem(f32x16& p0, f32x16& p1, const LAS unsigned char* kb, const bf16x8* qf, const LAS unsigned char* qlds, int r32, int hi) {
    constexpr int KPB = KLay<DK>::KPB, QR = DK / 32;
    const LAS unsigned char* k0 = kb + r32 * KPB + hi * 16;
#pragma unroll
    for (int d0 = 0; d0 < DK / 16; ++d0) {
        bf16x8 q; if (d0 < QR) q = qf[d0]; else q = *(const LAS bf16x8*)(qlds + (d0 - QR) * 1024);
        const bf16x8 a0 = *(const LAS bf16x8*)(k0 + d0 * 32), a1 = *(const LAS bf16x8*)(k0 + 32 * KPB + d0 * 32);
        p0 = __builtin_amdgcn_mfma_f32_32x32x16_bf16(a0, q, p0, 0, 0, 0);
        p1 = __builtin_amdgcn_mfma_f32_32x32x16_bf16(a1, q, p1, 0, 0, 0);
        if ((d0 & 3) == 3) __builtin_amdgcn_sched_barrier(0);
    }
}
template <int DV> __device__ __forceinline__ void pv(f32x16 (&o)[DV / 32], const LAS unsigned char* vb, const bf16x8 (&pf)[4], int r32, int hi) {
#pragma unroll
    for (int db = 0; db < DV / 32; ++db) {
        const LAS unsigned char* v0 = vb + (32 * db + r32) * VPB + 16 * hi;
#pragma unroll
        for (int s = 0; s < 4; ++s) {
            const bf16x8 vf = *(const LAS bf16x8*)(v0 + 32 * s);
            o[db] = __builtin_amdgcn_mfma_f32_32x32x16_bf16(vf, pf[s], o[db], 0, 0, 0);
        }
        if (DV > 64) __builtin_amdgcn_sched_barrier(0);
    }
}
__device__ __forceinline__ void pack_p(bf16x8 (&pf)[4], const f32x16& p0, const f32x16& p1) {
    pf[0] = mk8(pk2(p0[0], p0[1]), pk2(p0[2], p0[3]), pk2(p0[4], p0[5]), pk2(p0[6], p0[7]));
    pf[1] = mk8(pk2(p0[8], p0[9]), pk2(p0[10], p0[11]), pk2(p0[12], p0[13]), pk2(p0[14], p0[15]));
    pf[2] = mk8(pk2(p1[0], p1[1]), pk2(p1[2], p1[3]), pk2(p1[4], p1[5]), pk2(p1[6], p1[7]));
    pf[3] = mk8(pk2(p1[8], p1[9]), pk2(p1[10], p1[11]), pk2(p1[12], p1[13]), pk2(p1[14], p1[15]));
}

template <bool ALIBI> __device__ __forceinline__ void fl_init(f32x16& p0, f32x16& p1, float slope2, int kv0, int hi, int qrow) {
    if (ALIBI) {
        const float s2 = slope2 + slope2, s4 = s2 + s2, s8 = s4 + s4, s32 = (s8 + s8) + (s8 + s8);
        float g = slope2 * (float)(kv0 + 4 * hi - qrow);
#pragma unroll
        for (int c = 0; c < 4; ++c) { float v = g;
#pragma unroll
            for (int e = 0; e < 4; ++e) { p0[4 * c + e] = v; p1[4 * c + e] = v + s32; v += slope2; }
            g += s8; } }
    else {
#pragma unroll
        for (int r = 0; r < 16; ++r) { p0[r] = 0.f; p1[r] = 0.f; } }
}
__device__ __forceinline__ void fl_mask(f32x16& p0, f32x16& p1, int kv0, int hi, int qrow) {
    const int thr = qrow - kv0 - 4 * hi;
#pragma unroll
    for (int r = 0; r < 16; ++r) { const int c = (r & 3) + 8 * (r >> 2); if (c > thr) p0[r] = -INFINITY; if (c + 32 > thr) p1[r] = -INFINITY; }
}
__device__ __forceinline__ void fl_start(const f32x16& p0, const f32x16& p1, float& m, float& alpha) {
    float mx = fmaxf(p0[0], p1[0]);
#pragma unroll
    for (int r = 1; r < 16; ++r) mx = fmaxf(fmaxf(mx, p0[r]), p1[r]);
    mx = fmaxf(mx, xhalf(mx));
    if (__all(mx - m <= 8.f)) alpha = 1.0f;
    else { const float mn = fmaxf(m, mx); alpha = __builtin_amdgcn_exp2f(m - mn); m = mn; }
}
__device__ __forceinline__ void fl_finish(f32x16& p0, f32x16& p1, float m, float& l, bf16x8 (&pf)[4]) {
    float s0 = 0.f, s1 = 0.f;
#pragma unroll
    for (int r = 0; r < 16; ++r) { p0[r] = __builtin_amdgcn_exp2f(p0[r] - m); p1[r] = __builtin_amdgcn_exp2f(p1[r] - m); s0 += p0[r]; s1 += p1[r]; }
    l += s0 + s1;
    pack_p(pf, p0, p1);
}

#define FL_EL(P0, P1, e) ((e) < 16 ? P0[(e) & 15] : P1[(e) & 15])
template <int DK, bool QMEM, int FDV, class SA, class SB> __device__ __forceinline__ void fl_blockX(f32x16& n0, f32x16& n1, const LAS unsigned char* kb, const bf16x8* qf, const LAS unsigned char* qlds, int r32, int hi,
                                                                         f32x16& c0, f32x16& c1, float m, float& l, bf16x8 (&pf)[4], f32x16* of, const LAS unsigned char* vb, const SA& stage_a, const SB& stage_b) {
    constexpr int KPB = KLay<DK>::KPB, NS = DK / 16, CH = ((32 + NS - 1) / NS + 1) & ~1;
    const LAS unsigned char* k0 = kb + r32 * KPB + hi * 16;
    float s0 = 0.f, s1 = 0.f; unsigned pw[16];
    bf16x8 vv[8];
    const LAS unsigned char* vbase = (FDV != 0) ? vb + r32 * VPB + 16 * hi : nullptr;
    if constexpr (FDV == 64) {
#pragma unroll
        for (int st = 0; st < 8; ++st) vv[st] = *(const LAS bf16x8*)(vbase + (st >> 2) * 32 * VPB + 32 * (st & 3)); }
#define FLX_LDV(c) do { _Pragma("unroll") for (int db = 0; db < 4; ++db) vv[db] = *(const LAS bf16x8*)(vbase + db * 32 * VPB + 32 * (c)); } while (0)
#define FLX_PV4(c) do { const bf16x8 pc_ = mk8(pw[4 * (c)], pw[4 * (c) + 1], pw[4 * (c) + 2], pw[4 * (c) + 3]); \
        _Pragma("unroll") for (int db = 0; db < 4; ++db) of[db] = __builtin_amdgcn_mfma_f32_32x32x16_bf16(vv[db], pc_, of[db], 0, 0, 0); } while (0)
#define FLX_DONE(dd) ((dd) < 0 ? 0 : ((((dd) + 1) * CH < 32 ? ((dd) + 1) * CH : 32) / 8))
#define FLX_PV(c) do { const bf16x8 pc_ = mk8(pw[4 * (c)], pw[4 * (c) + 1], pw[4 * (c) + 2], pw[4 * (c) + 3]); \
        of[0] = __builtin_amdgcn_mfma_f32_32x32x16_bf16(vv[(c)], pc_, of[0], 0, 0, 0); of[1] = __builtin_amdgcn_mfma_f32_32x32x16_bf16(vv[4 + (c)], pc_, of[1], 0, 0, 0); } while (0)
#define FLX_K0(s) (*(const LAS bf16x8*)(k0 + ((s) < NS ? (s) : NS - 1) * 32))
#define FLX_K1(s) (*(const LAS bf16x8*)(k0 + 32 * KPB + ((s) < NS ? (s) : NS - 1) * 32))
    bf16x8 a0 = FLX_K0(0), a1 = FLX_K1(0), b0 = FLX_K0(1), b1 = FLX_K1(1), e0 = FLX_K0(2), e1 = FLX_K1(2);
    bf16x8 q, qb, qe; if constexpr (QMEM) { q = *(const LAS bf16x8*)(qlds); qb = *(const LAS bf16x8*)(qlds + (NS > 1 ? 1024 : 0)); qe = *(const LAS bf16x8*)(qlds + (NS > 2 ? 2048 : 0)); } else { q = qf[0]; qb = qf[NS > 1 ? 1 : 0]; qe = qf[NS > 2 ? 2 : 0]; }
#pragma unroll
    for (int d0 = 0; d0 < NS; ++d0) {
        bf16x8 c0n = e0, c1n = e1, qc = qe;
        if (d0 + 3 < NS) { c0n = FLX_K0(d0 + 3); c1n = FLX_K1(d0 + 3);
            if constexpr (QMEM) qc = *(const LAS bf16x8*)(qlds + (d0 + 3) * 1024); else qc = qf[d0 + 3]; }
        n0 = __builtin_amdgcn_mfma_f32_32x32x16_bf16(a0, q, n0, 0, 0, 0);
        n1 = __builtin_amdgcn_mfma_f32_32x32x16_bf16(a1, q, n1, 0, 0, 0);
        if constexpr (FDV == 64) {
#pragma unroll
            for (int c = 0; c < 4; ++c) if (c >= FLX_DONE(d0 - 2) && c < FLX_DONE(d0 - 1)) FLX_PV(c); }
        if constexpr (FDV == 128) {
#pragma unroll
            for (int c = 0; c < 4; ++c) if (c >= FLX_DONE(d0 - 2) && c < FLX_DONE(d0 - 1)) FLX_LDV(c); }
#pragma unroll
        for (int e = d0 * CH; e < (d0 + 1) * CH && e < 32; e += 2) {
            float x, y;
            float xi = e < 16 ? c0[e & 15] : c1[e & 15], yi = e < 16 ? c0[(e + 1) & 15] : c1[(e + 1) & 15];
            asm volatile("" : "+v"(xi), "+v"(yi));
            x = __builtin_amdgcn_exp2f(xi - m); y = __builtin_amdgcn_exp2f(yi - m); s0 += x; s1 += y;
            pw[e >> 1] = pk2(x, y); asm volatile("" : "+v"(pw[e >> 1])); }
        asm volatile("" : "+v"(s0), "+v"(s1));
        if constexpr (FDV == 128) {
#pragma unroll
            for (int c = 0; c < 4; ++c) if (c >= FLX_DONE(d0 - 2) && c < FLX_DONE(d0 - 1)) FLX_PV4(c); }
        if (d0 == 0) stage_a();
        if (d0 == 1) stage_b();
        __builtin_amdgcn_sched_barrier(0);
        a0 = b0; a1 = b1; q = qb; b0 = e0; b1 = e1; qb = qe; e0 = c0n; e1 = c1n; qe = qc;
    }
#undef FLX_K0
#undef FLX_K1
    if constexpr (FDV == 64) {
#pragma unroll
        for (int c = 0; c < 4; ++c) if (c >= FLX_DONE(NS - 2)) FLX_PV(c); }
    if constexpr (FDV == 128) {
#pragma unroll
        for (int c = 0; c < 4; ++c) if (c >= FLX_DONE(NS - 2)) { FLX_LDV(c); FLX_PV4(c); } }
#undef FLX_DONE
#undef FLX_PV
#undef FLX_PV4
#undef FLX_LDV
    l += s0 + s1;
    pf[0] = mk8(pw[0], pw[1], pw[2], pw[3]); pf[1] = mk8(pw[4], pw[5], pw[6], pw[7]); pf[2] = mk8(pw[8], pw[9], pw[10], pw[11]); pf[3] = mk8(pw[12], pw[13], pw[14], pw[15]);
}
template <int DV, bool NOMAX = false> __device__ __forceinline__ void fl_blockY(f32x16 (&o)[DV / 32], const LAS unsigned char* vb, const bf16x8 (&pf)[4], int r32, int hi, const f32x16& n0, const f32x16& n1, float& m, float& alpha) {
    constexpr int NS = DV / 8, CH = 32 / NS;
    float mx0 = -INFINITY, mx1 = -INFINITY;
    const LAS unsigned char* v0 = vb + r32 * VPB + 16 * hi;
    bf16x8 vf = *(const LAS bf16x8*)(v0), vg = *(const LAS bf16x8*)(v0 + 32);
#pragma unroll
    for (int st = 0; st < NS; ++st) {
        const int db = st >> 2, s = st & 3;
        bf16x8 vn = vg;
        if (st + 2 < NS) vn = *(const LAS bf16x8*)(v0 + ((st + 2) >> 2) * 32 * VPB + 32 * ((st + 2) & 3));
        o[db] = __builtin_amdgcn_mfma_f32_32x32x16_bf16(vf, pf[s], o[db], 0, 0, 0);
        if constexpr (!NOMAX) {
#pragma unroll
        for (int e = st * CH; e < (st + 1) * CH; ++e) { if (e < 16) mx0 = fmaxf(mx0, n0[e]); else mx1 = fmaxf(mx1, n1[e - 16]); }
        asm volatile("" : "+v"(mx0), "+v"(mx1)); }
        __builtin_amdgcn_sched_barrier(0);
        vf = vg; vg = vn;
    }
    if constexpr (NOMAX) return;
    float mx = fmaxf(mx0, mx1); mx = fmaxf(mx, xhalf(mx));
    if (__all(mx - m <= 8.f)) alpha = 1.0f;
    else { const float mn = fmaxf(m, mx); alpha = __builtin_amdgcn_exp2f(m - mn); m = mn; }
}

template <int DK, int DV, bool CAUSAL, bool ALIBI, bool KROPE, bool QMEM = false, bool DESC = false, bool NOMAX = false>
__device__ __forceinline__ void flash_pass(LAS unsigned char* lds, int tid, const GAS bf16* Qrow, const GAS bf16* Qrow2, const GAS bf16* Kg, int ldk, const GAS bf16* K2g, const GAS bf16* Vg, int ldv,
                                           int NT, int ntw, int qrow, float slope2, f32x16 (&o)[DV / 32], float& lsum, const GAS unsigned* kn = nullptr, int abl = 0) {
    constexpr int KBUF = KLay<DK>::KBUF, VBUF = DV * VPB, QOFF = 2 * KBUF + 2 * VBUF, XOFF = QOFF + 8 * (DK / 16) * 1024;
    constexpr bool CUT = DESC && ALIBI;
    const int lane = tid & 63, r32 = lane & 31, hi = lane >> 5, wid = tid >> 6;
#define FL_TI(i) (DESC ? NT - 1 - (i) : (i))
    bf16x8 qf[QMEM ? 1 : DK / 16];
    LAS unsigned char* qlds = lds + QOFF + wid * (DK / 16) * 1024 + lane * 16;
    float qn2 = 0.f;
#pragma unroll
    for (int d0 = 0; d0 < DK / 16; ++d0) {
        bf16x8 v;
        if (KROPE && d0 >= 4) v = *(const GAS bf16x8*)(Qrow2 + 16 * (d0 - 4) + 8 * hi);
        else v = *(const GAS bf16x8*)(Qrow + 16 * d0 + 8 * hi);
        if constexpr (CUT) {
#pragma unroll
            for (int j = 0; j < 8; ++j) { const float f = __builtin_bit_cast(float, (unsigned)(unsigned short)v[j] << 16); qn2 += f * f; } }
        if constexpr (QMEM) *(LAS bf16x8*)(qlds + d0 * 1024) = v; else qf[d0] = v;
    }
    volatile LAS float* kpre = (volatile LAS float*)(lds + XOFF);
    volatile LAS unsigned* dflag = (volatile LAS unsigned*)(lds + XOFF + 512);
    float qn = 0.f;
    if constexpr (CUT) {
        qn2 += xhalf(qn2); qn = sqrtf(qn2);
        if (wid == 0) {
            float v0 = 0.f, v1 = 0.f;
            if (lane < NT) v0 = sqrtf(__builtin_bit_cast(float, kn[(size_t)lane * 16]) + __builtin_bit_cast(float, kn[(size_t)lane * 16 + 1])) * 1.01f;
            if (lane + 64 < NT) v1 = sqrtf(__builtin_bit_cast(float, kn[(size_t)(lane + 64) * 16]) + __builtin_bit_cast(float, kn[(size_t)(lane + 64) * 16 + 1])) * 1.01f;
#pragma unroll
            for (int dd = 1; dd < 64; dd <<= 1) { const float u0 = __shfl_up(v0, dd), u1 = __shfl_up(v1, dd); if (lane >= dd) { v0 = fmaxf(v0, u0); v1 = fmaxf(v1, u1); } }
            v1 = fmaxf(v1, __shfl(v0, 63));
            kpre[lane] = v0; kpre[lane + 64] = v1;
        }
    }
#pragma unroll
    for (int db = 0; db < DV / 32; ++db)
#pragma unroll
        for (int r = 0; r < 16; ++r) o[db][r] = 0.f;
    float m = NOMAX ? 0.f : -INFINITY, l = 0.f, alpha = 1.0f;
    int cut = NT;
    Stage<DK, DV, KROPE> st;
    st.loadK(tid, Kg, ldk, K2g, 64 * FL_TI(0)); st.loadV(tid, Vg, ldv, 64 * FL_TI(0));
    st.storeK(tid, lds); st.storeV(tid, lds + 2 * KBUF);
    if (NT > 1) { st.loadK(tid, Kg, ldk, K2g, 64 * FL_TI(1)); st.storeK(tid, lds + KBUF); }
    __syncthreads();
    { int tp_ = tid; asm volatile("" : "+v"(tp_));
      if (NT > 2) st.loadK(tp_, Kg, ldk, K2g, 64 * FL_TI(2));
      if (NT > 1) st.loadV(tp_, Vg, ldv, 64 * FL_TI(1)); }
    f32x16 pa0, pa1, pb0, pb1;
#define FL_QKT(P0, P1, KB) do { if constexpr (QMEM) { bf16x8 qt_[DK / 16]; _Pragma("unroll") for (int d0 = 0; d0 < DK / 16; ++d0) qt_[d0] = *(const LAS bf16x8*)(qlds + d0 * 1024); qkt<DK>(P0, P1, KB, qt_, r32, hi); } else qkt<DK>(P0, P1, KB, qf, r32, hi); } while (0)
#define FL_FIRST(P0, P1, KB, TILE) do { const int kv_ = 64 * (TILE); fl_init<ALIBI>(P0, P1, slope2, kv_, hi, qrow); FL_QKT(P0, P1, KB); \
        if (CAUSAL && kv_ + 63 > qrow - r32) fl_mask(P0, P1, kv_, hi, qrow); if constexpr (!NOMAX) fl_start(P0, P1, m, alpha); } while (0)
    if (FL_TI(0) < ntw) FL_FIRST(pa0, pa1, lds, FL_TI(0));
    __syncthreads();
    for (int i = 0; i < NT; ++i) {
        auto stage_a = [&]() { int tq_ = tid; asm volatile("" : "+v"(tq_)); if (!(abl & 1)) {
            if (i + 2 < NT) st.storeK(tq_, lds + (i & 1) * KBUF);
            if (i + 1 < NT) st.storeV(tq_, lds + 2 * KBUF + ((i + 1) & 1) * VBUF); } };
        auto stage_b = [&]() { int tq_ = tid; asm volatile("" : "+v"(tq_)); if (!(abl & 1)) {
            if (i + 3 < NT) st.loadK(tq_, Kg, ldk, K2g, 64 * FL_TI(i + 3));
            if (i + 2 < NT) st.loadV(tq_, Vg, ldv, 64 * FL_TI(i + 2)); } };
        const int tc = FL_TI(i), tn = FL_TI(i + 1);
        const bool ac = tc < ntw && i < cut && !(abl & 2);
        bool an = i + 1 < NT && tn < ntw && i + 1 < cut && !(abl & 2);
        if constexpr (CUT) {
            if (ac && an) {
                const float ref_ = NOMAX ? __builtin_amdgcn_logf(l) : m;
                const bool dead = __builtin_fmaf(qn, kpre[tn], __builtin_fmaf(slope2, (float)(64 * tn + 63 - qrow), 64.f)) < ref_;
                if (__all(dead)) { cut = i + 1; an = false; } } }
        const LAS unsigned char* kn_ = lds + ((i + 1) & 1) * KBUF; const LAS unsigned char* vc_ = lds + 2 * KBUF + (i & 1) * VBUF;
        if (!(ac && an)) { stage_a(); stage_b(); }
        if (ac) {
            if constexpr (!NOMAX) l *= alpha;
            if (!NOMAX && __any(alpha != 1.0f)) {
#pragma unroll
                for (int db = 0; db < DV / 32; ++db) asm volatile("" : "+v"(o[db]));
#pragma unroll
                for (int db = 0; db < DV / 32; ++db)
#pragma unroll
                    for (int r = 0; r < 16; ++r) o[db][r] *= alpha;
#pragma unroll
                for (int db = 0; db < DV / 32; ++db) asm volatile("" : "+v"(o[db])); }
            bf16x8 pf[4];
            if (an) {
                const int kv1_ = 64 * tn;
                const bool diag_ = CAUSAL && (kv1_ + 63 > qrow - r32);
                fl_init<ALIBI>(pb0, pb1, slope2, kv1_, hi, qrow);
                constexpr bool FUSE = NOMAX;
                fl_blockX<DK, QMEM, FUSE ? DV : 0>(pb0, pb1, kn_, qf, qlds, r32, hi, pa0, pa1, m, l, pf, &o[0], vc_, stage_a, stage_b);
                if constexpr (FUSE) { if (diag_) { asm volatile("");     fl_mask(pb0, pb1, kv1_, hi, qrow); } }
                else {
                if (!diag_) { fl_blockY<DV, NOMAX>(o, vc_, pf, r32, hi, pb0, pb1, m, alpha); }
                else { pv<DV>(o, vc_, pf, r32, hi); fl_mask(pb0, pb1, kv1_, hi, qrow); if constexpr (!NOMAX) fl_start(pb0, pb1, m, alpha); } }
            } else {
                fl_finish(pa0, pa1, m, l, pf); pv<DV>(o, vc_, pf, r32, hi);
            }
        } else if (an) { FL_FIRST(pb0, pb1, kn_, tn); }
        if constexpr (CUT) { if (lane == 0) dflag[(i & 1) * 8 + wid] = (i + 1 >= cut) ? 1u : 0u; }
        if (!(abl & 4)) __syncthreads();
        if constexpr (CUT) { unsigned alld = 1u;
#pragma unroll
            for (int w = 0; w < 8; ++w) alld &= dflag[(i & 1) * 8 + w];
            if (alld) break; }
        if (!(abl & 8)) { pa0 = pb0; pa1 = pb1; }
    }
#undef FL_FIRST
#undef FL_QKT
#undef FL_TI
    lsum = l + xhalf(l);
}

template <int DK, int DV, bool CAUSAL, bool ALIBI, bool KROPE, bool QMEM = false>
__device__ __forceinline__ void flash_pass_simple(LAS unsigned char* lds, int tid, const GAS bf16* Qrow, const GAS bf16* Qrow2, const GAS bf16* Kg, int ldk, const GAS bf16* K2g, const GAS bf16* Vg, int ldv,
                                           int NT, int ntw, int qrow, float slope2, f32x16 (&o)[DV / 32], float& lsum) {
    constexpr int KBUF = KLay<DK>::KBUF, VBUF = DV * VPB;
    const int lane = tid & 63, r32 = lane & 31, hi = lane >> 5;
    constexpr int QR = QMEM ? DK / 32 : DK / 16;
    bf16x8 qf[QR];
    LAS unsigned char* qlds = lds + 2 * KBUF + 2 * VBUF + (tid >> 6) * (DK / 16 - QR + 1) * 1024 + lane * 16;
#pragma unroll
    for (int d0 = 0; d0 < DK / 16; ++d0) {
        bf16x8 v;
        if (KROPE && d0 >= 4) v = *(const GAS bf16x8*)(Qrow2 + 16 * (d0 - 4) + 8 * hi);
        else v = *(const GAS bf16x8*)(Qrow + 16 * d0 + 8 * hi);
        if constexpr (!KROPE && QMEM) {
            const bf16x8 w2 = *(const GAS bf16x8*)(Qrow2 + 16 * d0 + 8 * hi); const u32x4 a4 = __builtin_bit_cast(u32x4, v), b4 = __builtin_bit_cast(u32x4, w2); u32x4 r4;
            r4.x = pk2(bflo(a4.x) + bflo(b4.x), bfhi(a4.x) + bfhi(b4.x)); r4.y = pk2(bflo(a4.y) + bflo(b4.y), bfhi(a4.y) + bfhi(b4.y));
            r4.z = pk2(bflo(a4.z) + bflo(b4.z), bfhi(a4.z) + bfhi(b4.z)); r4.w = pk2(bflo(a4.w) + bflo(b4.w), bfhi(a4.w) + bfhi(b4.w)); v = __builtin_bit_cast(bf16x8, r4); }
        if (d0 < QR) qf[d0] = v; else *(LAS bf16x8*)(qlds + (d0 - QR) * 1024) = v;
    }
#pragma unroll
    for (int db = 0; db < DV / 32; ++db)
#pragma unroll
        for (int r = 0; r < 16; ++r) o[db][r] = 0.f;
    float m = -INFINITY, l = 0.f;
    Stage<DK, DV, KROPE> st;
    st.load(tid, Kg, ldk, K2g, Vg, ldv, 0);
    st.store(tid, lds, lds + 2 * KBUF);
    __syncthreads();
    for (int t = 0; t < NT; ++t) {
        const int cur = t & 1, kv0 = 64 * t;
        if (t + 1 < NT) st.load(tid, Kg, ldk, K2g, Vg, ldv, kv0 + 64);
        if (t < ntw) {
            const LAS unsigned char* kb = lds + cur * KBUF; const LAS unsigned char* vb = lds + 2 * KBUF + cur * VBUF;
            f32x16 p0, p1;
            if (ALIBI) { const float base = slope2 * (float)(kv0 + 4 * hi - qrow);
#pragma unroll
                for (int r = 0; r < 16; ++r) { p0[r] = __builtin_fmaf(slope2, (float)((r & 3) + 8 * (r >> 2)), base); p1[r] = __builtin_fmaf(slope2, (float)(32 + (r & 3) + 8 * (r >> 2)), base); } }
            else {
#pragma unroll
                for (int r = 0; r < 16; ++r) { p0[r] = 0.f; p1[r] = 0.f; } }
            if constexpr (QMEM) qkt_qmem<DK>(p0, p1, kb, qf, qlds, r32, hi); else qkt<DK>(p0, p1, kb, qf, r32, hi);
            if (CAUSAL && kv0 + 63 > qrow - r32) {
#pragma unroll
                for (int r = 0; r < 16; ++r) { const int kv = kv0 + crow(r, hi); if (kv > qrow) p0[r] = -INFINITY; if (kv + 32 > qrow) p1[r] = -INFINITY; } }
            float mx = p0[0];
#pragma unroll
            for (int r = 1; r < 16; ++r) mx = fmaxf(mx, p0[r]);
#pragma unroll
            for (int r = 0; r < 16; ++r) mx = fmaxf(mx, p1[r]);
            mx = fmaxf(mx, xhalf(mx));
            const float mn = fmaxf(m, mx), alpha = __builtin_amdgcn_exp2f(m - mn); m = mn;
            l *= alpha;
            if (__any(alpha != 1.0f)) {
#pragma unroll
                for (int db = 0; db < DV / 32; ++db)
#pragma unroll
                    for (int r = 0; r < 16; ++r) o[db][r] *= alpha; }
            float s = 0.f;
#pragma unroll
            for (int r = 0; r < 16; ++r) { p0[r] = __builtin_amdgcn_exp2f(p0[r] - mn); p1[r] = __builtin_amdgcn_exp2f(p1[r] - mn); s += p0[r] + p1[r]; }
            l += s;
            bf16x8 pf[4]; pack_p(pf, p0, p1);
            pv<DV>(o, vb, pf, r32, hi);
        }
        if (t + 1 < NT) st.store(tid, lds + (cur ^ 1) * KBUF, lds + 2 * KBUF + (cur ^ 1) * VBUF);
        __syncthreads();
    }
    lsum = l + xhalf(l);
}


template <int DV> __device__ __forceinline__ void store_o(GAS bf16* Orow, const f32x16 (&o)[DV / 32], float sc, int hi) {
#pragma unroll
    for (int db = 0; db < DV / 32; ++db)
#pragma unroll
        for (int c = 0; c < 4; c += 2) {
            unsigned ax = pk2(o[db][4 * c] * sc, o[db][4 * c + 1] * sc), ay = pk2(o[db][4 * c + 2] * sc, o[db][4 * c + 3] * sc);
            unsigned bx = pk2(o[db][4 * c + 4] * sc, o[db][4 * c + 5] * sc), by = pk2(o[db][4 * c + 6] * sc, o[db][4 * c + 7] * sc);
            { auto r = __builtin_amdgcn_permlane32_swap(ax, bx, false, false); ax = r[0]; bx = r[1]; }
            { auto r = __builtin_amdgcn_permlane32_swap(ay, by, false, false); ay = r[0]; by = r[1]; }
            const u32x4 w = {ax, ay, bx, by};
            *(GAS u32x4*)(Orow + 32 * db + 8 * c + 8 * hi) = w; }
}

__device__ __forceinline__ void mla_unit(LAS unsigned char* lds, int tid, int b, int h, int q0, const GAS bf16* qmla, const GAS bf16* knope, const GAS bf16* krope, const GAS bf16* vT, GAS bf16* out, int abl) {
    const int lane = tid & 63, wid = tid >> 6, r32 = lane & 31, hi = lane >> 5;
    const size_t tb = (size_t)b * 8192; const int qrow = q0 + 32 * wid + r32;
    const GAS bf16* Qr = qmla + (tb + qrow) * 768;
    f32x16 o[2]; float l;
    flash_pass<96, 64, true, false, true, false, false, true>(lds, tid, Qr + h * 64, Qr + 512 + h * 32, knope + tb * 512 + h * 64, 512, krope + tb * 32, vT + (size_t)(h * 64) * 16384 + tb, 16384,
                                          q0 / 64 + 4, (q0 + 32 * wid + 31) / 64 + 1, qrow, 0.f, o, l, nullptr, abl);
    { float chk = 0.f;
#pragma unroll
      for (int r = 0; r < 16; ++r) chk += fabsf(o[0][r]) + fabsf(o[1][r]);
      const bool ok = l > 1.0e-18f && l < 3.0e38f && chk < 3.0e38f;
      volatile LAS unsigned* flg = (volatile LAS unsigned*)lds;
      if (tid == 0) flg[0] = 0u;
      __syncthreads();
      if (__any(!ok) && lane == 0) flg[0] = 1u;
      __syncthreads();
      const unsigned redo = flg[0];
      __syncthreads();
      if (redo) flash_pass<96, 64, true, false, true>(lds, tid, Qr + h * 64, Qr + 512 + h * 32, knope + tb * 512 + h * 64, 512, krope + tb * 32, vT + (size_t)(h * 64) * 16384 + tb, 16384,
                                          q0 / 64 + 4, (q0 + 32 * wid + 31) / 64 + 1, qrow, 0.f, o, l, nullptr, abl); }
    if (abl == 0 || l == 12345.678f) store_o<64>(out + (tb + qrow) * 1024 + h * 64, o, 1.0f / l, hi);
}
__device__ __forceinline__ void cross_unit(LAS unsigned char* lds, int tid, int b, int h, int q0, const GAS bf16* qx, const GAS bf16* xk, const GAS bf16* xvT, GAS bf16* out) {
    const int lane = tid & 63, wid = tid >> 6, r32 = lane & 31, hi = lane >> 5;
    const size_t tb = (size_t)b * 8192; const int qrow = q0 + 32 * wid + r32;
    f32x16 o[4]; float l;
    int nt = 4; asm volatile("" : "+s"(nt));
    flash_pass_simple<128, 128, false, false, false, true>(lds, tid, qx + (tb + qrow) * 512 + h * 128, qx + (size_t)16384 * 512 + (tb + qrow) * 512 + h * 128, xk + (size_t)(b * 256) * 512 + h * 128, 512, nullptr, xvT + (size_t)(h * 128) * 512 + b * 256, 512,
                                              nt, nt, qrow, 0.f, o, l);
    store_o<128>(out + (tb + qrow) * 512 + h * 128, o, 1.0f / l, hi);
}
__device__ __forceinline__ void diff_unit(LAS unsigned char* lds, int tid, int b, int h, int hf, int q0, const GAS bf16* dq, const GAS bf16* dk, const GAS bf16* vT, GAS bf16* out, int ldo, const GAS unsigned* knl, int abl) {
    const int lane = tid & 63, wid = tid >> 6, r32 = lane & 31, hi = lane >> 5;
    const size_t tb = (size_t)b * 8192; const int qrow = q0 + 32 * wid + r32;
    const float slope2 = __builtin_amdgcn_exp2f(-2.0f * (float)(h + 1)) * 1.4426950408889634f;
    const int NT = q0 / 64 + 4, ntw = (q0 + 32 * wid + 31) / 64 + 1;
    f32x16 o[4]; float l;
    flash_pass<64, 128, true, true, false, true, true, true>(lds, tid, dq + (tb + qrow) * 512 + h * 128 + hf * 64, nullptr, dk + tb * 512 + h * 128 + hf * 64, 512, nullptr, vT + (size_t)(512 + h * 128) * 16384 + tb, 16384,
                                                      NT, ntw, qrow, slope2, o, l, knl + ((size_t)(b * 128) * 8 + 2 * h + hf) * 2, abl);
    { float chk = 0.f;
#pragma unroll
      for (int db = 0; db < 4; ++db)
#pragma unroll
          for (int r = 0; r < 16; ++r) chk += fabsf(o[db][r]);
      const bool ok = l > 1.0e-18f && l < 3.0e38f && chk < 3.0e38f;
      volatile LAS unsigned* flg = (volatile LAS unsigned*)lds;
      if (tid == 0) flg[0] = 0u;
      __syncthreads();
      if (__any(!ok) && lane == 0) flg[0] = 1u;
      __syncthreads();
      const unsigned redo = flg[0];
      __syncthreads();
      if (redo) flash_pass<64, 128, true, true, false, true, true>(lds, tid, dq + (tb + qrow) * 512 + h * 128 + hf * 64, nullptr, dk + tb * 512 + h * 128 + hf * 64, 512, nullptr, vT + (size_t)(512 + h * 128) * 16384 + tb, 16384,
                                                      NT, ntw, qrow, slope2, o, l, knl + ((size_t)(b * 128) * 8 + 2 * h + hf) * 2, abl); }
    if (abl == 0 || l == 12345.678f) store_o<128>(out + (tb + qrow) * (size_t)ldo + h * 128, o, 1.0f / l, hi);
}
__device__ __forceinline__ void diff_lambda(const GAS float* lp, int layer, float& lam, float& post) {
    float q1 = 0.f, q2 = 0.f;
    for (int i = 0; i < 64; ++i) { q1 += lp[i] * lp[64 + i]; q2 += lp[128 + i] * lp[192 + i]; }
    const float lam_init = (layer == 0) ? 0.2f : 0.35550906759f;
    lam = expf(q1) - expf(q2) + lam_init; post = 1.f - lam_init;
}
__device__ __forceinline__ void diff_combine8(int tok0, int ntok, int lane, GAS bf16* o0, const GAS bf16* o1, float lam, float post, const GAS float* subln) {
    u32x4 a[8], c[8];
#pragma unroll
    for (int j = 0; j < 8; ++j) { const int tok = tok0 + (j < ntok ? j : 0);
        a[j] = *(const GAS u32x4*)(o0 + (size_t)tok * 1024 + 8 * lane); c[j] = *(const GAS u32x4*)(o1 + (size_t)tok * 512 + 8 * lane); }
    const f32x4 g0 = *(const GAS f32x4*)(subln + 8 * (lane & 15)), g1 = *(const GAS f32x4*)(subln + 8 * (lane & 15) + 4);
#pragma unroll
    for (int j = 0; j < 8; ++j) {
        float x[8];
#pragma unroll
        for (int w = 0; w < 4; ++w) { x[2 * w] = bflo(a[j][w]) - lam * bflo(c[j][w]); x[2 * w + 1] = bfhi(a[j][w]) - lam * bfhi(c[j][w]); }
        float s2 = ((x[0] * x[0] + x[1] * x[1]) + (x[2] * x[2] + x[3] * x[3])) + ((x[4] * x[4] + x[5] * x[5]) + (x[6] * x[6] + x[7] * x[7]));
#pragma unroll
        for (int dd = 1; dd < 16; dd <<= 1) s2 += __shfl_xor(s2, dd);
        const float rs = __builtin_amdgcn_rsqf(s2 * (1.f / 128.f) + 1e-6f) * post;
        u32x4 w4; w4.x = pk2(x[0] * rs * g0[0], x[1] * rs * g0[1]); w4.y = pk2(x[2] * rs * g0[2], x[3] * rs * g0[3]); w4.z = pk2(x[4] * rs * g1[0], x[5] * rs * g1[1]); w4.w = pk2(x[6] * rs * g1[2], x[7] * rs * g1[3]);
        if (j < ntok) *(GAS u32x4*)(o0 + (size_t)(tok0 + j) * 1024 + 8 * lane) = w4; }
}
__device__ __forceinline__ void sb_unit(LAS unsigned char* lds, int tid, int b, int h, int q0, const GAS bf16* sq, const GAS bf16* sk, const GAS bf16* vT, GAS bf16* out) {
    constexpr int KBUF = KLay<64>::KBUF, VBUF = 64 * VPB;
    const int lane = tid & 63, wid = tid >> 6, r32 = lane & 31, hi = lane >> 5;
    const size_t tb = (size_t)b * 8192; const int qrow = q0 + 32 * wid + r32;
    const GAS bf16* Kg = sk + tb * 512 + h * 64; const GAS bf16* Vg = vT + (size_t)(h * 64) * 16384 + tb;
    const int NT = q0 / 64 + 4, ntw = (q0 + 32 * wid + 30) / 64 + 1;
    bf16x8 qf[4];
#pragma unroll
    for (int d0 = 0; d0 < 4; ++d0) qf[d0] = *(const GAS bf16x8*)(sq + (tb + qrow) * 512 + h * 64 + 16 * d0 + 8 * hi);
    f32x16 o[2];
#pragma unroll
    for (int r = 0; r < 16; ++r) { o[0][r] = 0.f; o[1][r] = 0.f; }
    float R = 1.0f;
    volatile LAS unsigned* dflag = (volatile LAS unsigned*)(lds + 4 * KBUF + 1024);
    Stage<64, 64, false> st;
    st.load(tid, Kg, 512, nullptr, Vg, 16384, 64 * (NT - 1));
    st.store(tid, lds, lds + 2 * KBUF);
    __syncthreads();
    for (int i = 0; i < NT; ++i) {
        const int t = NT - 1 - i, cur = i & 1, kv0 = 64 * t;
        if (t > 0) st.load(tid, Kg, 512, nullptr, Vg, 16384, kv0 - 64);
        if (t < ntw && __any(R != 0.f)) {
            const LAS unsigned char* kb = lds + cur * KBUF; const LAS unsigned char* vb = lds + 2 * KBUF + cur * VBUF;
            f32x16 k0, k1;
#pragma unroll
            for (int r = 0; r < 16; ++r) { k0[r] = 0.f; k1[r] = 0.f; }
            qkt<64>(k0, k1, kb, qf, r32, hi);
            f32x16 b0, b1;
#pragma unroll
            for (int r = 0; r < 16; ++r) {
                const float e0 = __builtin_amdgcn_exp2f(fminf(k0[r], 115.f)), e1 = __builtin_amdgcn_exp2f(fminf(k1[r], 115.f));
                const float r0 = __builtin_amdgcn_rcpf(1.f + e0), r1 = __builtin_amdgcn_rcpf(1.f + e1);
                k0[r] = r0; b0[r] = e0 * r0; k1[r] = r1; b1[r] = e1 * r1; }
            if (kv0 + 63 >= qrow - r32) {
                const int thr = qrow - kv0 - 4 * hi;
#pragma unroll
                for (int r = 0; r < 16; ++r) { const int c = (r & 3) + 8 * (r >> 2); if (c >= thr) { k0[r] = 1.f; b0[r] = 0.f; } if (c + 32 >= thr) { k1[r] = 1.f; b1[r] = 0.f; } } }
            float gp[8], go[8];
#pragma unroll
            for (int c = 0; c < 4; ++c) { gp[c] = (k0[4 * c] * k0[4 * c + 1]) * (k0[4 * c + 2] * k0[4 * c + 3]); gp[4 + c] = (k1[4 * c] * k1[4 * c + 1]) * (k1[4 * c + 2] * k1[4 * c + 3]); }
#pragma unroll
            for (int g = 0; g < 8; ++g) go[g] = xhalf(gp[g]);
            float sp = R;
#pragma unroll
            for (int g = 7; g >= 0; --g) {
                float s = sp * (hi ? 1.0f : go[g]);
                if (g >= 4) { const int c = g - 4;
                    b1[4 * c + 3] *= s; s *= k1[4 * c + 3]; b1[4 * c + 2] *= s; s *= k1[4 * c + 2]; b1[4 * c + 1] *= s; s *= k1[4 * c + 1]; b1[4 * c] *= s; }
                else { const int c = g;
                    b0[4 * c + 3] *= s; s *= k0[4 * c + 3]; b0[4 * c + 2] *= s; s *= k0[4 * c + 2]; b0[4 * c + 1] *= s; s *= k0[4 * c + 1]; b0[4 * c] *= s; }
                sp *= gp[g] * go[g];
            }
            R = sp;
            bf16x8 pf[4]; pack_p(pf, b0, b1);
            pv<64>(o, vb, pf, r32, hi);
        }
        if (t > 0) st.store(tid, lds + (cur ^ 1) * KBUF, lds + 2 * KBUF + (cur ^ 1) * VBUF);
        if (lane == 0) dflag[(i & 1) * 8 + wid] = (t < ntw && !__any(R != 0.f)) ? 1u : 0u;
        __syncthreads();
        { unsigned alld = 1u;
#pragma unroll
          for (int w = 0; w < 8; ++w) alld &= dflag[(i & 1) * 8 + w];
          if (alld) break; }
    }
    store_o<64>(out + (tb + qrow) * 1024 + h * 64, o, 1.0f, hi);
}
}
typedef unsigned short bf16;
typedef float f32x4 __attribute__((ext_vector_type(4)));
typedef unsigned u32x4 __attribute__((ext_vector_type(4)));
typedef unsigned u32x2 __attribute__((ext_vector_type(2)));
constexpr int NWAVES = 8, NTHREADS = 512;
constexpr int M = 16384, D = 1024, SEQ = 8192, DEPTH = 2, IN_COLS = 6688;
constexpr int SROWS = 40960;
constexpr size_t MiB = 1u << 20;
constexpr size_t WS_CTL = 0, CTL_ZERO_BYTES = 128 * 1024;
constexpr size_t WS_SSQ = 1 * MiB;
constexpr size_t WS_SSQCQ = 2 * MiB, WS_SSQCKV = WS_SSQCQ + 256 * 1024, WS_SSQMEM = WS_SSQCKV + 256 * 1024;
constexpr size_t WS_TOKE = 3 * MiB, WS_TOKW = WS_TOKE + 128 * 1024, WS_HIST = WS_TOKW + 128 * 1024, WS_SLOT = WS_HIST + 64 * 1024;
constexpr size_t WS_STOK = 4 * MiB, WS_SW = WS_STOK + 256 * 1024, WS_SRSTD = WS_SW + 256 * 1024;
constexpr size_t WS_WR = 5 * MiB;
constexpr size_t WS_WRH = 5 * MiB + 256 * 1024, WS_WRL = WS_WRH + 128 * 1024;
constexpr size_t WS_MEMN = 6 * MiB, WS_XK = 7 * MiB, WS_XVT = WS_XK + 512 * 1024;
constexpr size_t WS_WIN = 8 * MiB;
constexpr size_t WS_WV = WS_WIN + (size_t)2816 * 1024 * 2;
constexpr size_t WS_WG = WS_WV + 2 * MiB;
constexpr size_t WS_WUQ = WS_WG + 6 * MiB;
constexpr size_t WS_WUKN = WS_WUQ + 768 * 256 * 2;
constexpr size_t WS_WUV = WS_WUKN + 512 * 256 * 2;
constexpr size_t WS_WB = WS_WUV + 512 * 256 * 2;
constexpr size_t WS_WOUT = WS_WB + 4 * MiB;
constexpr size_t WS_WXQ = WS_WOUT + 2 * MiB;
constexpr size_t WS_WXK = WS_WXQ + 1 * MiB, WS_WXV = WS_WXK + 1 * MiB;
constexpr size_t WS_WXO = WS_WXV + 1 * MiB;
constexpr size_t WS_WGU = WS_WXO + 1 * MiB;
constexpr size_t WS_WD = WS_WGU + 32 * MiB;
constexpr size_t WS_WEND = WS_WD + 16 * MiB;
static_assert(WS_WEND <= 81 * MiB, "weights");
constexpr size_t WS_XB = 81 * MiB;
constexpr size_t R0 = 113 * MiB;
constexpr size_t WS_CQ = R0, WS_CKV = R0 + 8 * MiB, WS_KROPE = R0 + 16 * MiB, WS_QK = R0 + 18 * MiB  , WS_VT = R0 + 82 * MiB  ;
constexpr size_t WS_QMLA = R0 + 114 * MiB, WS_KNOPE = R0 + 138 * MiB, WS_VMLAT = R0 + 154 * MiB, WS_OABC = R0 + 170 * MiB  ;
constexpr size_t WS_GSCR = R0, WS_MB = R0 + 96 * MiB;
constexpr size_t WS_QX = R0, WS_OX = R0 + 32 * MiB;
constexpr size_t WS_XG = R0, WS_ACT = R0 + 80 * MiB, WS_Y = R0 + 100 * MiB;
constexpr size_t WS_END = R0 + 234 * MiB;
static_assert(WS_MB + 32 * MiB <= WS_OABC && WS_Y + 80 * MiB <= WS_END && WS_OABC + 64 * MiB <= WS_END, "region map");
constexpr int CW_BAR = 1024, CW_Q = 8192, CW_KN = 16384, CW_F1 = 24576;
constexpr int RING_BYTES = 131072, LDSCTL_OFF = RING_BYTES, MISC_OFF = LDSCTL_OFF + 320, TSTART_OFF = LDSCTL_OFF + 1024, HIST_OFF = LDSCTL_OFF + 2048;
constexpr int LDS_BYTES = 147456;

#define LDS_WAIT() asm volatile("s_waitcnt lgkmcnt(0)" ::: "memory")
__device__ __forceinline__ float wave_sum(float v) {
#pragma unroll
    for (int o = 1; o < 64; o <<= 1) v += __shfl_xor(v, o);
    return v;
}
__device__ __forceinline__ unsigned pk2(float lo, float hi) { return pg8::pk2(lo, hi); }
__device__ __forceinline__ int lane_id() { int r; asm volatile("v_mbcnt_lo_u32_b32 %0, -1, 0\n\tv_mbcnt_hi_u32_b32 %0, -1, %0" : "=v"(r)); return r; }
#define XB_TMO      128
#define XB_XCNT(j)  (256  + 64 * (j))
#define XB_XSUB(j)  (1280 + 64 * (j))
#define XB_XGEN(j)  (2304 + 64 * (j))
#define XB_TOP      3328
#define XB_TOPGEN   3392
#define XCD_BAR_WORDS 3456
#define XB_SPIN_CAP (1u << 18)

__device__ __forceinline__ unsigned xb_ld(unsigned* p)              { return __hip_atomic_load(p, __ATOMIC_RELAXED, __HIP_MEMORY_SCOPE_AGENT); }
__device__ __forceinline__ unsigned xb_add(unsigned* p, unsigned v) { return __hip_atomic_fetch_add(p, v, __ATOMIC_RELAXED, __HIP_MEMORY_SCOPE_AGENT); }
__device__ __forceinline__ unsigned xb_xcc_id() { return (unsigned)__builtin_amdgcn_s_getreg((3 << 11) | 20) & 0xFu; }
#define XB_SPIN(cond, bar) do { unsigned _sp = 0; while (cond) { __builtin_amdgcn_s_sleep(1); \
    if ((++_sp & 255u) == 0u) { if (xb_ld(&(bar)[XB_TMO])) break; if (_sp > XB_SPIN_CAP) { atomicAdd(&(bar)[XB_TMO], 1u); break; } } } } while (0)

struct XcdBarrier {
    unsigned* bar; unsigned x; int wid;
    volatile LAS unsigned* st;
};

__device__ __forceinline__ XcdBarrier xcd_barrier_post(unsigned* bar, volatile LAS unsigned* st, int wid) {
    XcdBarrier b; b.bar = bar; b.x = xb_xcc_id(); b.st = st; b.wid = wid;
    if (wid == 0 && lane_id() == 0) (void)xb_add(&bar[XB_XCNT(b.x)], 1u);
    return b;
}
__device__ __forceinline__ void xcd_barrier_complete(unsigned* bar, unsigned x, unsigned& nloc, unsigned& nx) {
    const unsigned G = gridDim.x * gridDim.y * gridDim.z;
    unsigned sum, cnt, mine, sp = 0u;
    for (;;) {
        sum = 0u; cnt = 0u; mine = 0u;
#pragma unroll 1
        for (unsigned j = 0; j < 16; ++j) { const unsigned c = xb_ld(&bar[XB_XCNT(j)]); sum += c; cnt += (c > 0u) ? 1u : 0u; mine = (j == x) ? c : mine; }
        if (sum == G) break;
        __builtin_amdgcn_s_sleep(1);
        if ((++sp & 255u) == 0u) { if (xb_ld(&bar[XB_TMO])) break; if (sp > XB_SPIN_CAP) { atomicAdd(&bar[XB_TMO], 1u); break; } }
    }
    nloc = mine > 0u ? mine : 1u; nx = cnt > 0u ? cnt : 1u;
}

__device__ __forceinline__ void xcd_barrier(const XcdBarrier& b) {
    asm volatile("s_waitcnt vmcnt(0)" ::: "memory");
    __syncthreads();
    if (b.wid == 0 && lane_id() == 0) {
        unsigned* bar = b.bar; asm volatile("" : "+s"(bar));
        __builtin_amdgcn_s_waitcnt(0);
        unsigned nloc = b.st[0], nx = b.st[1];
        if (nloc == 0u) { xcd_barrier_complete(bar, b.x, nloc, nx); b.st[0] = nloc; b.st[1] = nx; }
        const unsigned old = xb_add(&bar[XB_XSUB(b.x)], 1u);
        const unsigned gen = old / nloc;
        if (old + 1u == (gen + 1u) * nloc) {
            __builtin_amdgcn_fence(__ATOMIC_RELEASE, "agent");
            asm volatile("s_waitcnt vmcnt(0)" ::: "memory");
            const unsigned og = xb_add(&bar[XB_TOP], 1u);
            const unsigned tg = og / nx;
            if (og + 1u == (tg + 1u) * nx) xb_add(&bar[XB_TOPGEN], 1u);
            else XB_SPIN(xb_ld(&bar[XB_TOPGEN]) == tg, bar);
            __builtin_amdgcn_fence(__ATOMIC_ACQUIRE, "agent");
            xb_add(&bar[XB_XGEN(b.x)], 1u);
            asm volatile("s_waitcnt vmcnt(0)" ::: "memory");
        } else {
            XB_SPIN(xb_ld(&bar[XB_XGEN(b.x)]) == gen, bar);
            __builtin_amdgcn_fence(__ATOMIC_ACQUIRE, "agent");
            asm volatile("s_waitcnt vmcnt(0)" ::: "memory");
        }
    }
    __syncthreads();
}
struct TrJob { const GAS float* src; const GAS float* gain; GAS bf16* dst; int ldn, col0, k0, K, row0, dk; };
__device__ __forceinline__ void tr_load(const TrJob& j, f32x4 (&v)[8], int lane) {
    const int kr = lane >> 3, nq = lane & 7;
    if (j.col0 >= 0) {
#pragma unroll
        for (int i = 0; i < 8; ++i) v[i] = __builtin_nontemporal_load((const GAS f32x4*)(j.src + (size_t)(j.k0 + 8 * i + kr) * j.ldn + j.col0 + 4 * nq));
    } else {
#pragma unroll
        for (int i = 0; i < 8; ++i) v[i] = (f32x4){0.f, 0.f, 0.f, 0.f};
    }
}
__device__ __forceinline__ void tr_finish(const TrJob& j, const f32x4 (&v)[8], LAS float* scr, int lane) {
    const int kr = lane >> 3, nq = lane & 7;
#pragma unroll
    for (int i = 0; i < 8; ++i) { const int kk = 8 * i + kr; const float g = j.gain ? j.gain[j.k0 + kk] : 1.f; LAS float* s = scr + kk * 33 + 4 * nq;
        s[0] = v[i][0] * g; s[1] = v[i][1] * g; s[2] = v[i][2] * g; s[3] = v[i][3] * g; }
    LDS_WAIT(); asm volatile("" ::: "memory");
    const int c = lane & 7;
#pragma unroll
    for (int q = 0; q < 4; ++q) { const int n = (lane >> 3) + 8 * q; const LAS float* s = scr + (8 * c) * 33 + n;
        u32x4 o; o.x = pk2(s[0 * 33], s[1 * 33]); o.y = pk2(s[2 * 33], s[3 * 33]); o.z = pk2(s[4 * 33], s[5 * 33]); o.w = pk2(s[6 * 33], s[7 * 33]);
        *(GAS u32x4*)(j.dst + (size_t)(j.row0 + n) * j.K + j.dk + j.k0 + 8 * c) = o; }
    LDS_WAIT(); asm volatile("" ::: "memory");
}
__device__ __forceinline__ void row_load(const GAS float* xrow, f32x4 (&v)[4], int lane) {
    const GAS f32x4* xr = (const GAS f32x4*)xrow + lane;
#pragma unroll
    for (int j = 0; j < 4; ++j) v[j] = __builtin_nontemporal_load(xr + 64 * j);
}
__device__ __forceinline__ void row_finish(const f32x4 (&v)[4], GAS bf16* orow, GAS float* ssq16, int lane) {
    float s = 0.f;
#pragma unroll
    for (int j = 0; j < 4; ++j) s += (v[j][0] * v[j][0] + v[j][1] * v[j][1]) + (v[j][2] * v[j][2] + v[j][3] * v[j][3]);
    s = wave_sum(s);
    GAS u32x2* o8 = (GAS u32x2*)orow + lane;
#pragma unroll
    for (int j = 0; j < 4; ++j) { u32x2 w; w.x = pk2(v[j][0], v[j][1]); w.y = pk2(v[j][2], v[j][3]); o8[64 * j] = w; }
    if (lane < 16) ssq16[lane] = (lane == 0) ? s : 0.f;
}
__device__ __forceinline__ void row_to_bf16(const GAS float* xrow, GAS bf16* orow, GAS float* ssq16, int lane) {
    const GAS f32x4* xr = (const GAS f32x4*)xrow + lane; f32x4 v[4]; float s = 0.f;
#pragma unroll
    for (int j = 0; j < 4; ++j) { v[j] = xr[64 * j]; s += (v[j][0] * v[j][0] + v[j][1] * v[j][1]) + (v[j][2] * v[j][2] + v[j][3] * v[j][3]); }
    s = wave_sum(s);
    GAS u32x2* o8 = (GAS u32x2*)orow + lane;
#pragma unroll
    for (int j = 0; j < 4; ++j) { u32x2 w; w.x = pk2(v[j][0], v[j][1]); w.y = pk2(v[j][2], v[j][3]); o8[64 * j] = w; }
    if (lane < 16) ssq16[lane] = (lane == 0) ? s : 0.f;
}

struct Args { const float* in[26]; float* out; unsigned char* ws; };
__device__ __forceinline__ int opq(int i) { asm volatile("" : "+s"(i)); return i; }
__device__ __forceinline__ GAS unsigned char* opqp(unsigned char* p0) { GAS unsigned char* p = (GAS unsigned char*)p0; asm volatile("" : "+s"(p)); return p; }
#define INP(i) ((const GAS float*)args.in[opq(i)])
#define WSB(off) (opqp(args.ws) + (off))
#define X_IN INP(0)
#define OUTP ((GAS float*)args.out)
#define XB ((GAS bf16*)WSB(WS_XB))
#define SSQ ((GAS float*)WSB(WS_SSQ))
#define SSQCQ ((GAS float*)WSB(WS_SSQCQ))
#define SSQCKV ((GAS float*)WSB(WS_SSQCKV))
#define SSQMEM ((GAS float*)WSB(WS_SSQMEM))
#define MEMN ((GAS bf16*)WSB(WS_MEMN))
#define XK ((GAS bf16*)WSB(WS_XK))
#define XVT ((GAS bf16*)WSB(WS_XVT))
#define WIN ((GAS bf16*)WSB(WS_WIN))
#define WV ((GAS bf16*)WSB(WS_WV))
#define WG ((GAS bf16*)WSB(WS_WG))
#define WUQ ((GAS bf16*)WSB(WS_WUQ))
#define WUKN ((GAS bf16*)WSB(WS_WUKN))
#define WUV ((GAS bf16*)WSB(WS_WUV))
#define WB ((GAS bf16*)WSB(WS_WB))
#define WOUT ((GAS bf16*)WSB(WS_WOUT))
#define WXQ ((GAS bf16*)WSB(WS_WXQ))
#define WXK ((GAS bf16*)WSB(WS_WXK))
#define WXV ((GAS bf16*)WSB(WS_WXV))
#define WXO ((GAS bf16*)WSB(WS_WXO))
#define WGU ((GAS bf16*)WSB(WS_WGU))
#define WD ((GAS bf16*)WSB(WS_WD))
#define WRH ((GAS bf16*)WSB(WS_WRH))
#define WRL ((GAS bf16*)WSB(WS_WRL))
#define CQ ((GAS bf16*)WSB(WS_CQ))
#define CKV ((GAS bf16*)WSB(WS_CKV))
#define KROPE ((GAS bf16*)WSB(WS_KROPE))
#define QK ((GAS bf16*)WSB(WS_QK))
#define VT ((GAS bf16*)WSB(WS_VT))
#define QMLA ((GAS bf16*)WSB(WS_QMLA))
#define KNOPE ((GAS bf16*)WSB(WS_KNOPE))
#define VMLAT ((GAS bf16*)WSB(WS_VMLAT))
#define OABC ((GAS bf16*)WSB(WS_OABC))
#define GSCR ((GAS unsigned char*)WSB(WS_GSCR))
#define MB ((GAS bf16*)WSB(WS_MB))
#define QX ((GAS bf16*)WSB(WS_QX))
#define OX ((GAS bf16*)WSB(WS_OX))
#define XG ((GAS bf16*)WSB(WS_XG))
#define ACT ((GAS bf16*)WSB(WS_ACT))
#define YB ((GAS bf16*)WSB(WS_Y))
#define TOKE ((GAS int*)WSB(WS_TOKE))
#define TOKW ((GAS float*)WSB(WS_TOKW))
#define HIST ((GAS int*)WSB(WS_HIST))
#define SLOT ((GAS int*)WSB(WS_SLOT))
#define STOK ((GAS int*)WSB(WS_STOK))
#define SW ((GAS float*)WSB(WS_SW))
#define SRSTD ((GAS float*)WSB(WS_SRSTD))


__global__ void __launch_bounds__(NTHREADS, 2) fwd(Args args) {
    extern __shared__ __attribute__((aligned(16))) unsigned char lds_raw[];
    LAS unsigned char* lds = (LAS unsigned char*)lds_raw;
    volatile LAS unsigned* MISC = (volatile LAS unsigned*)(lds + MISC_OFF);
    LAS int* TSTART = (LAS int*)(lds + TSTART_OFF);
    const int tid0 = threadIdx.x; const int wv = __builtin_amdgcn_readfirstlane(tid0 >> 6);
#define PH_BEGIN int tid_ = wv * 64 + lane_id(); asm volatile("" : "+v"(tid_)); const int tid = tid_, lane = tid & 63, wave = wv, gw = vcu * NWAVES + wave; (void)lane; (void)gw
    const int G = gridDim.x, bx = blockIdx.x, vcu = (G % 8 == 0) ? (bx % 8) * (G / 8) + bx / 8 : bx;
    unsigned* ctl = (unsigned*)(void*)(args.ws + WS_CTL);
    for (int u = tid0; u < (LDS_BYTES - LDSCTL_OFF) / 4; u += NTHREADS) ((LAS unsigned*)(lds + LDSCTL_OFF))[u] = 0u;
    __syncthreads();
    XcdBarrier bar = xcd_barrier_post(ctl + CW_BAR, MISC + 8, wv);
    const int NGW = G * NWAVES;

    constexpr float L2E = 1.4426950408889634f;

    constexpr int I_IN = 88 * 16, I_V = 32 * 16, I_G = 96 * 16, I_UQ = 24 * 4, I_UK = 16 * 4, I_B = 3 * 32 * 8, I_O = 32 * 16, I_XQ = 16 * 16, I_XO = 32 * 8, I_GU = 512 * 16, I_D = 1024 * 4;
    constexpr int NITEMS = I_IN + I_V + I_G + I_UQ + 2 * I_UK + I_B + I_O + 3 * I_XQ + I_XO + I_GU + I_D, NITEMS_P0 = NITEMS - I_GU - I_D;
    for (int l = 0; l < DEPTH; ++l) {
        for (int rp_ = 0; rp_ < RP_P0; ++rp_) {
#if PH_P0
        { PH_BEGIN;
            LAS float* scr = (LAS float*)(lds + wave * 16384);
#define w_in (INP(3) + (size_t)l * D * IN_COLS)
#define g_attn (INP(2) + l * D)
#define w_uq (INP(5) + (size_t)l * 256 * 768)
#define g_q (INP(4) + l * 256)
#define w_ukv (INP(7) + (size_t)l * 256 * 1024)
#define g_kv (INP(6) + l * 256)
#define w_br (INP(10) + (size_t)l * 3 * 512 * 1024)
#define w_out (INP(11) + (size_t)l * D * D)
#define g_cross (INP(12) + l * D)
#define g_mem (INP(13))
#define w_xq (INP(14) + (size_t)l * D * 512)
#define w_xkv (INP(15) + (size_t)l * D * 1024)
#define w_xo (INP(16) + (size_t)l * 512 * D)
#define g_ffn (INP(17) + l * D)
#define w_eg (INP(22) + (size_t)l * 32 * D * 256)
#define w_eu (INP(23) + (size_t)l * 32 * D * 256)
#define w_ed (INP(24) + (size_t)l * 32 * 256 * D)
#define TR_DECODE(itx) do { int r = (itx); \
                if (r < I_IN) { const int nb = r >> 4, kb = r & 15, n0 = nb * 32; int col; \
                    if (n0 < 544) col = 3072 + n0; else if (n0 < 768) col = -1; else if (n0 < 1792) col = 3616 + (n0 - 768); else col = 5152 + (n0 - 1792); \
                    jb = TrJob{w_in, g_attn, WIN, IN_COLS, col, kb * 64, 1024, n0, 0}; break; } r -= I_IN; \
                if (r < I_V) { const int nb = r >> 4, kb = r & 15, n0 = nb * 32; const int col = n0 < 512 ? 4640 + n0 : 6176 + (n0 - 512); \
                    jb = TrJob{w_in, g_attn, WV, IN_COLS, col, kb * 64, 1024, n0, 0}; break; } r -= I_V; \
                if (r < I_G) { const int nb = r >> 4, kb = r & 15; jb = TrJob{w_in, g_attn, WG, IN_COLS, nb * 32, kb * 64, 1024, nb * 32, 0}; break; } r -= I_G; \
                if (r < I_UQ) { const int nb = r >> 2, kb = r & 3, n0 = nb * 32; const int col = n0 < 512 ? 96 * (n0 >> 6) + (n0 & 63) : 96 * ((n0 - 512) >> 5) + 64; \
                    jb = TrJob{w_uq, g_q, WUQ, 768, col, kb * 64, 256, n0, 0}; break; } r -= I_UQ; \
                if (r < I_UK) { const int nb = r >> 2, kb = r & 3, n0 = nb * 32; jb = TrJob{w_ukv, g_kv, WUKN, 1024, 128 * (n0 >> 6) + (n0 & 63), kb * 64, 256, n0, 0}; break; } r -= I_UK; \
                if (r < I_UK) { const int nb = r >> 2, kb = r & 3, n0 = nb * 32; jb = TrJob{w_ukv, g_kv, WUV, 1024, 128 * (n0 >> 6) + 64 + (n0 & 63), kb * 64, 256, n0, 0}; break; } r -= I_UK; \
                if (r < I_B) { const int z = r / 256, q = r % 256, nb = q >> 3, kb = q & 7; jb = TrJob{w_br + (size_t)z * 512 * 1024, nullptr, WB + (size_t)(z >> 1) * 1024 * 1024, 1024, nb * 32, kb * 64, 1024, nb * 32, (z & 1) * 512}; break; } r -= I_B; \
                if (r < I_O) { const int nb = r >> 4, kb = r & 15; jb = TrJob{w_out, nullptr, WOUT, 1024, nb * 32, kb * 64, 1024, nb * 32, 0}; break; } r -= I_O; \
                if (r < I_XQ) { const int nb = r >> 4, kb = r & 15; jb = TrJob{w_xq, g_cross, WXQ, 512, nb * 32, kb * 64, 1024, nb * 32, 0}; break; } r -= I_XQ; \
                if (r < I_XQ) { const int nb = r >> 4, kb = r & 15; jb = TrJob{w_xkv, g_mem, WXK, 1024, nb * 32, kb * 64, 1024, nb * 32, 0}; break; } r -= I_XQ; \
                if (r < I_XQ) { const int nb = r >> 4, kb = r & 15; jb = TrJob{w_xkv, g_mem, WXV, 1024, 512 + nb * 32, kb * 64, 1024, nb * 32, 0}; break; } r -= I_XQ; \
                if (r < I_XO) { const int nb = r >> 3, kb = r & 7; jb = TrJob{w_xo, nullptr, WXO, 1024, nb * 32, kb * 64, 512, nb * 32, 0}; break; } r -= I_XO; \
                if (r < I_GU) { const int nb = r >> 4, kb = r & 15, n0 = nb * 32, e = n0 >> 9, rr = n0 & 511, t = rr >> 8, j = rr & 255; \
                    const GAS float* src = (j < 128 ? w_eg : w_eu) + (size_t)e * D * 256; jb = TrJob{src, g_ffn, WGU, 256, 128 * t + (j & 127), kb * 64, 1024, n0, 0}; break; } r -= I_GU; \
                { const int nb = r >> 2, kb = r & 3, n0 = nb * 32, e = n0 >> 10; jb = TrJob{w_ed + (size_t)e * 256 * 1024, nullptr, WD, 1024, n0 & 1023, kb * 64, 256, n0, 0}; } } while (0)
            for (int it = gw; it < NITEMS_P0; it += NGW) {
                TrJob jb{};
                TR_DECODE(it);
                f32x4 va[8];
                tr_load(jb, va, lane);
                tr_finish(jb, va, scr, lane);
            }
            { const GAS float* wrg = INP(18) + (size_t)l * D * 4; const GAS float* wre = INP(20) + (size_t)l * D * 32; GAS bf16* wh = WRH; GAS bf16* wl = WRL;
              for (int i = bx * NTHREADS + tid; i < 48 * 1024; i += G * NTHREADS) { const int c = i >> 10, k = i & 1023;
                  const float w = c < 36 ? (c < 4 ? wrg[k * 4 + c] : wre[k * 32 + (c - 4)]) * g_ffn[k] : 0.f; const unsigned h = pk2(w, 0.f) & 0xffffu;
                  wh[i] = (bf16)h; wl[i] = (bf16)(pk2(w - __builtin_bit_cast(float, h << 16), 0.f) & 0xffffu); } }
            if (l == 0) {
                for (int m = gw; m < M; m += 2 * NGW) {
                    const int m1 = m + NGW < M ? m + NGW : m;
                    f32x4 v0[4], v1[4]; row_load(X_IN + (size_t)m * D, v0, lane); row_load(X_IN + (size_t)m1 * D, v1, lane);
                    row_finish(v0, XB + (size_t)m * D, SSQ + (size_t)m * 16, lane); row_finish(v1, XB + (size_t)m1 * D, SSQ + (size_t)m1 * 16, lane); }
                for (int m = gw; m < 512; m += NGW) row_to_bf16(INP(1) + (size_t)m * D, MEMN + (size_t)m * D, SSQMEM + (size_t)m * 16, lane);
            }
        }
#endif
        xcd_barrier(bar);
        }
                for (int rp_ = 0; rp_ < RP_A; ++rp_) {
#if PH_A
        {
            { pg8::Gemm g{XB, WIN, M, 2816, D, D, nullptr}; pg8::StaticOrder S; S.init(M, 2816, G, bx);
              pg8::EpiA E{SSQ, CQ, CKV, KROPE, QK, SSQCQ, SSQCKV, 0.125f * L2E, (GAS unsigned*)(opqp(args.ws) + WS_CTL) + CW_KN + l * 4096, rp_ ? A_ABL : 0};
              pg8::gemm_phase<pg8::EpiA, pg8::StaticOrder, true, true>(lds, g, S, E, wv); }
            { pg8::Gemm g{WV, XB, 1024, M, D, D, nullptr}; pg8::StaticOrder S; S.init(1024, M, G, (bx + 64) % G);
              pg8::EpiVT E{VT, M, SSQ, 4, 1.f / 1024.f};
              pg8::gemm_phase<pg8::EpiVT, pg8::StaticOrder, true, true>(lds, g, S, E, wv); }
            { pg8::Gemm g{MEMN, WXK, 512, 512, D, D, nullptr}; pg8::StaticOrder S; S.init(512, 512, G, (bx + 8) % G);
              pg8::EpiRS E{XK, 512, SSQMEM, 4, 1.f / 1024.f, 1.f, 0xffff, 31, 0};
              pg8::gemm_phase<pg8::EpiRS, pg8::StaticOrder, true, true>(lds, g, S, E, wv); }
            { pg8::Gemm g{WXV, MEMN, 512, 512, D, D, nullptr}; pg8::StaticOrder S; S.init(512, 512, G, (bx + 16) % G);
              pg8::EpiVT E{XVT, 512, SSQMEM, 4, 1.f / 1024.f};
              pg8::gemm_phase<pg8::EpiVT, pg8::StaticOrder, true, true>(lds, g, S, E, wv); }
        }
#endif
        xcd_barrier(bar);
        }
                for (int rp_ = 0; rp_ < RP_B; ++rp_) {
#if PH_B
        {
#if PH_B1
            { pg8::Gemm g{CQ, WUQ, M, 768, opq(256), opq(256), nullptr}; pg8::StaticOrder S; S.init(M, 768, G, bx);
              pg8::EpiQ E{QMLA, SSQCQ, 0.10206207261596577f * L2E};
              pg8::gemm_phase<pg8::EpiQ, pg8::StaticOrder, true, true>(lds, g, S, E, wv); }
#endif
#if PH_B2
            { pg8::Gemm g{CKV, WUKN, M, 512, opq(256), opq(256), nullptr}; pg8::StaticOrder S; S.init(M, 512, G, (bx + 64) % G);
              pg8::EpiRS E{KNOPE, 512, SSQCKV, 1, 1.f / 256.f, 1.f, 0xffff, 31, 0};
              pg8::gemm_phase<pg8::EpiRS, pg8::StaticOrder, true, true>(lds, g, S, E, wv); }
#endif
#if PH_B3
            { pg8::Gemm g{WUV, CKV, 512, M, opq(256), opq(256), nullptr}; pg8::StaticOrder S; S.init(512, M, G, (bx + 128) % G);
              pg8::EpiVT E{VMLAT, M, SSQCKV, 1, 1.f / 256.f};
              pg8::gemm_phase<pg8::EpiVT, pg8::StaticOrder, true, true>(lds, g, S, E, wv); }
#endif
        }
#endif
        xcd_barrier(bar);
        }
                for (int rp_ = 0; rp_ < RP_C; ++rp_) {
#if PH_C
        {
            unsigned* qhead = ctl + CW_Q + 64 * (l + 2 * rp_);
            for (;;) {
                if (wv == 0 && lane_id() == 0) MISC[0] = __hip_atomic_fetch_add(qhead, 1u, __ATOMIC_RELAXED, __HIP_MEMORY_SCOPE_AGENT);
                __syncthreads();
                const int idx = (int)MISC[0];
                __syncthreads();
                if (idx >= 32 * 48 + 256) break;
                if (idx >= 32 * 48) {
                    if (rp_ == 0) { const int wl = lane_id(); LAS float* scr = (LAS float*)(lds + wv * 16384);
                        for (int j = 0; j < 6; ++j) { const int it = NITEMS_P0 + (idx - 32 * 48) * 48 + j * 8 + wv; TrJob jb{}; TR_DECODE(it); f32x4 va[8]; tr_load(jb, va, wl); tr_finish(jb, va, scr, wl); } }
                    continue; }
                const int half_ = idx >= 768 ? 1 : 0, k_ = idx - 768 * half_, qb = 31 - k_ / 24, j_ = k_ % 24, q0 = qb * 256;
                int r;
                if (half_ == 0) r = j_ < 16 ? 32 + j_ : ((j_ - 16) & 2) * 4 + (j_ < 20 ? 6 : 4) + (j_ & 1);
                else r = j_ < 8 ? (j_ & 2) * 4 + (j_ < 4 ? 2 : 0) + (j_ & 1) : 16 + (j_ - 8);
                int tu = wv * 64 + lane_id(); asm volatile("" : "+v"(tu));
#if PH_C_DIFF
                if (r < 16 && (rp_ == 0 || (C_REP_MASK & 1))) att::diff_unit(lds, tu, r >> 3, (r >> 1) & 3, r & 1, q0, QK + (size_t)2 * M * 512, QK + (size_t)3 * M * 512, VT, (r & 1) ? CQ : OABC + (size_t)M * 1024, (r & 1) ? 512 : 1024,
                                                                             (const GAS unsigned*)(opqp(args.ws) + WS_CTL) + CW_KN + l * 4096, rp_ ? C_ABL : 0);
#endif
#if PH_C_SB
                if (r >= 16 && r < 32 && (rp_ == 0 || (C_REP_MASK & 2))) att::sb_unit(lds, tu, (r - 16) >> 3, (r - 16) & 7, q0, QK, QK + (size_t)M * 512, VT, OABC + 512);
#endif
#if PH_C_MLA
                if (r >= 32 && (rp_ == 0 || (C_REP_MASK & 4))) att::mla_unit(lds, tu, (r - 32) >> 3, (r - 32) & 7, q0, QMLA, KNOPE, KROPE, VMLAT, OABC, rp_ ? C_ABL : 0);
#endif
            }
        }
#endif
        xcd_barrier(bar);
        }
        #undef TR_DECODE
#undef w_in
#undef g_attn
#undef w_uq
#undef g_q
#undef w_ukv
#undef g_kv
#undef w_br
#undef w_out
#undef g_cross
#undef g_mem
#undef w_xq
#undef w_xkv
#undef w_xo
#undef g_ffn
#undef w_eg
#undef w_eu
#undef w_ed
#if PH_C
        { PH_BEGIN;
          float lam, post; att::diff_lambda(INP(8) + l * 256, l, lam, post);
          for (int t0 = gw * 8; t0 < M; t0 += NGW * 8) att::diff_combine8(t0, M - t0 < 8 ? M - t0 : 8, lane, OABC + (size_t)M * 1024, CQ, lam, post, INP(9) + l * 128); }
        xcd_barrier(bar);
#endif
        for (int rp_ = 0; rp_ < RP_D1; ++rp_) {
#if PH_D1
        { pg8::Gemm g{XB, WG, M, 1024, 512, 1024, nullptr}; pg8::D1Order S; S.so.init(M, 1024, G, bx);
          const GAS char* xb_ = (const GAS char*)XB; const GAS char* oab_ = (const GAS char*)OABC; const GAS char* wg_ = (const GAS char*)WG; const GAS char* wb_ = (const GAS char*)WB;
          S.dA = (size_t)(oab_ - xb_); S.dB = (size_t)(wb_ - wg_);
          pg8::EpiD1 E{GSCR, MB, SSQ};
          pg8::gemm_phase<pg8::EpiD1, pg8::D1Order, true, true>(lds, g, S, E, wv); }
#endif
        xcd_barrier(bar);
        }
        #if PH_D2
        { pg8::Gemm g{MB, WOUT, M, 1024, D, D, nullptr}; pg8::StaticOrder S; S.init(M, 1024, G, bx);
          pg8::EpiRes E{XB, SSQ};
          pg8::gemm_phase<pg8::EpiRes, pg8::StaticOrder, true, true>(lds, g, S, E, wv); }
#endif
        xcd_barrier(bar);
                for (int rp_ = 0; rp_ < RP_E1; ++rp_) {
#if PH_E1
        { pg8::Gemm g{XB, WXQ, M, 512, 512, 1024, nullptr}; pg8::SplitK2Order S; S.so.init(M, 1024, G, bx); S.tstep = (size_t)256 * 1024 * 2;
          pg8::EpiRS E{QX, 512, SSQ, 4, 1.f / 1024.f, 0.08838834764831845f * L2E, 1, 1, (size_t)M * 512};
          pg8::gemm_phase<pg8::EpiRS, pg8::SplitK2Order, true, true>(lds, g, S, E, wv); }
#endif
        xcd_barrier(bar);
        }
                for (int rp_ = 0; rp_ < RP_E2; ++rp_) {
#if PH_E2
        { PH_BEGIN; for (int u = vcu; u < 256; u += G) att::cross_unit(lds, tid, u >> 7, (u >> 5) & 3, (u & 31) * 256, QX, XK, XVT, OX); }
#endif
        xcd_barrier(bar);
        }
        #if PH_E3
        { pg8::Gemm g{OX, WXO, M, 1024, 512, 512, nullptr}; pg8::StaticOrder S; S.init(M, 1024, G, bx);
          pg8::EpiRes E{XB, SSQ};
          pg8::gemm_phase<pg8::EpiRes, pg8::StaticOrder, true, true>(lds, g, S, E, wv); }
#endif
        xcd_barrier(bar);
                for (int rp_ = 0; rp_ < RP_F0A; ++rp_) {
#if PH_F0A
        { PH_BEGIN;
            typedef short bf16x8 __attribute__((ext_vector_type(8)));
            const GAS float* brg = INP(19) + l * 4; const GAS float* bre = INP(21) + l * 32;
            LAS float* part = (LAS float*)lds;
            LAS unsigned* ST = (LAS unsigned*)(lds + 102400);
            const int r16 = lane & 15, kq = lane >> 4;
            int itn = 0;
            for (int grp = bx; grp < 256; grp += G, ++itn) {
                float rs = 0.f; if (wave == 0) rs = pg8::rstd_parts(SSQ, (unsigned)((grp * 64 + lane) * 16), 4, 1.f / 1024.f);
                const GAS bf16* xrow = XB + (size_t)(grp * 64 + r16) * D + 128 * wave + 8 * kq;
                const GAS bf16* wh = WRH + (size_t)r16 * 1024 + 128 * wave + 8 * kq; const GAS bf16* wl = WRL + (size_t)r16 * 1024 + 128 * wave + 8 * kq;
                f32x4 acc[4][3];
#pragma unroll
                for (int rb = 0; rb < 4; ++rb)
#pragma unroll
                    for (int cb = 0; cb < 3; ++cb) acc[rb][cb] = (f32x4){0.f, 0.f, 0.f, 0.f};
#pragma unroll
                for (int st = 0; st < 4; ++st) {
                    bf16x8 a[4];
#pragma unroll
                    for (int rb = 0; rb < 4; ++rb) a[rb] = *(const GAS bf16x8*)(xrow + (size_t)rb * 16 * D + 32 * st);
#pragma unroll
                    for (int cb = 0; cb < 3; ++cb) {
                        const bf16x8 bh = *(const GAS bf16x8*)(wh + (size_t)cb * 16 * 1024 + 32 * st), bl = *(const GAS bf16x8*)(wl + (size_t)cb * 16 * 1024 + 32 * st);
#pragma unroll
                        for (int rb = 0; rb < 4; ++rb) { acc[rb][cb] = __builtin_amdgcn_mfma_f32_16x16x32_bf16(a[rb], bh, acc[rb][cb], 0, 0, 0); acc[rb][cb] = __builtin_amdgcn_mfma_f32_16x16x32_bf16(a[rb], bl, acc[rb][cb], 0, 0, 0); }
                    }
                }
                __syncthreads();
#pragma unroll
                for (int rb = 0; rb < 4; ++rb)
#pragma unroll
                    for (int cb = 0; cb < 3; ++cb)
#pragma unroll
                        for (int r = 0; r < 4; ++r) part[(wave * 64 + 16 * rb + 4 * kq + r) * 49 + 16 * cb + r16] = acc[rb][cb][r];
                __syncthreads();
                if (wave == 0) {
                    const LAS float* p = part + lane * 49;
                    float gl[4];
#pragma unroll
                    for (int c = 0; c < 4; ++c) { float s = 0.f;
#pragma unroll
                        for (int w = 0; w < 8; ++w) s += p[w * 3136 + c];
                        gl[c] = s * rs + brg[c]; }
                    int gs = 0; float gm = gl[0];
#pragma unroll
                    for (int c = 1; c < 4; ++c) if (gl[c] > gm) { gm = gl[c]; gs = c; }
                    float den = 0.f;
#pragma unroll
                    for (int c = 0; c < 4; ++c) den += expf(gl[c] - gm);
                    const float pg = 1.0f / den;
                    float el[8];
#pragma unroll
                    for (int j = 0; j < 8; ++j) { float s = 0.f;
#pragma unroll
                        for (int w = 0; w < 8; ++w) s += p[w * 3136 + 4 + gs * 8 + j];
                        el[j] = s * rs + bre[gs * 8 + j]; }
                    int i0 = 0; float v0 = el[0];
#pragma unroll
                    for (int j = 1; j < 8; ++j) if (el[j] > v0) { v0 = el[j]; i0 = j; }
                    int i1 = -1; float v1 = -INFINITY;
#pragma unroll
                    for (int j = 0; j < 8; ++j) if (j != i0 && el[j] > v1) { v1 = el[j]; i1 = j; }
                    const float e1 = expf(v1 - v0), w0 = pg / (1.f + e1), w1 = pg * e1 / (1.f + e1);
                    const int ea = gs * 8 + i0, eb = gs * 8 + i1;
                    int mycnt = 0, ra = 0, rb2 = 0; const unsigned long long lt = (1ull << lane) - 1ull;
#pragma unroll 1
                    for (int e = 0; e < 32; ++e) { const unsigned long long ma = __ballot(ea == e), mb = __ballot(eb == e); const int c = __popcll(ma) + __popcll(mb), cl = __popcll((ma | mb) & lt);
                        if (lane == e) mycnt = c; if (ea == e) ra = cl; if (eb == e) rb2 = cl; }
                    if (lane < 32) HIST[grp * 32 + lane] = mycnt;
                    LAS unsigned* sp = ST + itn * 256 + lane * 4;
                    sp[0] = (unsigned)ea | ((unsigned)eb << 8) | ((unsigned)ra << 16) | ((unsigned)rb2 << 24); sp[1] = __builtin_bit_cast(unsigned, w0); sp[2] = __builtin_bit_cast(unsigned, w1); sp[3] = __builtin_bit_cast(unsigned, rs);
                }
            }
            __syncthreads();
        }
#endif
        xcd_barrier(bar);
        }
                for (int rp_ = 0; rp_ < RP_F0B; ++rp_) {
#if PH_F0B
        { PH_BEGIN;
            LAS int* cnt = (LAS int*)(lds + HIST_OFF);
            int itn = 0;
            for (int grp = bx; grp < 256; grp += G, ++itn) {
                __syncthreads();
                { const int e = tid & 31, ch = tid >> 5; int tot = 0, before = 0;
#pragma unroll
                  for (int j = 0; j < 16; ++j) { const int g2 = ch * 16 + j; const int hv = HIST[g2 * 32 + e]; tot += hv; before += (g2 < grp) ? hv : 0; }
                  cnt[128 + ch * 32 + e] = tot; cnt[640 + ch * 32 + e] = before; }
                __syncthreads();
                if (tid < 32) { int tot = 0, before = 0;
                    for (int ch = 0; ch < 16; ++ch) { tot += cnt[128 + ch * 32 + tid]; before += cnt[640 + ch * 32 + tid]; }
                    cnt[tid] = tot; cnt[32 + tid] = before; }
                __syncthreads();
                if (tid == 0) { int ts = 0; for (int e = 0; e < 32; ++e) { TSTART[e] = ts; ts += (cnt[e] + 255) >> 8; } TSTART[32] = ts; }
                __syncthreads();
                if (wave == 0) {
                    const int tok = grp * 64 + lane; const LAS unsigned* sp = (const LAS unsigned*)(lds + 102400) + itn * 256 + lane * 4;
                    const unsigned pk = sp[0]; const int ea = pk & 255u, eb = (pk >> 8) & 255u, ra = (pk >> 16) & 255u, rb = pk >> 24;
                    const int sa = TSTART[ea] * 256 + cnt[32 + ea] + ra, sb = TSTART[eb] * 256 + cnt[32 + eb] + rb;
                    const float rsd = __builtin_bit_cast(float, sp[3]);
                    SLOT[tok * 2] = sa; SLOT[tok * 2 + 1] = sb;
                    STOK[sa] = tok; STOK[sb] = tok; SW[sa] = __builtin_bit_cast(float, sp[1]); SW[sb] = __builtin_bit_cast(float, sp[2]); SRSTD[sa] = rsd; SRSTD[sb] = rsd;
                }
                __syncthreads();
                if (grp < 32) { const int beg = TSTART[grp] * 256 + cnt[grp], end = TSTART[grp + 1] * 256;
                    for (int s = beg + tid; s < end; s += NTHREADS) { STOK[s] = 0; SW[s] = 0.f; SRSTD[s] = 0.f; } }
            }
            if (G > 256 || bx >= 256) {
                __syncthreads();
                if (tid < 32) { int tot = 0; for (int g2 = 0; g2 < 256; ++g2) tot += HIST[g2 * 32 + tid]; cnt[tid] = tot; }
                __syncthreads();
                if (tid == 0) { int ts = 0; for (int e = 0; e < 32; ++e) { TSTART[e] = ts; ts += (cnt[e] + 255) >> 8; } TSTART[32] = ts; }
            }
            __syncthreads();
        }
#endif
        xcd_barrier(bar);
        }
                for (int rp_ = 0; rp_ < RP_F1; ++rp_) {
#if PH_F1
        { pg8::Gemm g{XB, WGU, SROWS, 32 * 512, D, D, STOK}; pg8::MoeOrderP S{(const LAS int*)TSTART, (GAS unsigned*)(opqp(args.ws) + WS_CTL) + CW_F1 + l * 256, G, vcu};
          pg8::EpiAct E{ACT, SRSTD, SW};
          pg8::gemm_phase<pg8::EpiAct, pg8::MoeOrderP, true, true, true>(lds, g, S, E, wv); }
#endif
        }
                for (int rp_ = 0; rp_ < RP_F2; ++rp_) {
#if PH_F2
        { pg8::Gemm g{ACT, WD, SROWS, 32 * 1024, opq(256), opq(256), nullptr}; pg8::MoeOrderC S{(const LAS int*)TSTART, (const GAS unsigned*)(opqp(args.ws) + WS_CTL) + CW_F1 + l * 256, G, vcu, wv};
          pg8::EpiRS E{YB, 1024, nullptr, 0, 0.f, 1.f, 3, 31, 0};
          pg8::gemm_phase<pg8::EpiRS, pg8::MoeOrderC, true, true>(lds, g, S, E, wv); }
#endif
        xcd_barrier(bar);
        }
#if PH_F3
        { PH_BEGIN;
            const GAS float* g_fin = INP(25);
            int sn[4]; { const int m1 = gw + NGW < M ? gw + NGW : gw; sn[0] = SLOT[gw * 2]; sn[1] = SLOT[gw * 2 + 1]; sn[2] = SLOT[m1 * 2]; sn[3] = SLOT[m1 * 2 + 1]; }
            for (int m = gw; m < M; m += 2 * NGW) {
                const int mr[2] = {m, m + NGW < M ? m + NGW : m}; const int sl[4] = {sn[0], sn[1], sn[2], sn[3]};
                if (m + 2 * NGW < M) { const int n0 = m + 2 * NGW, n1 = n0 + NGW < M ? n0 + NGW : n0; sn[0] = SLOT[n0 * 2]; sn[1] = SLOT[n0 * 2 + 1]; sn[2] = SLOT[n1 * 2]; sn[3] = SLOT[n1 * 2 + 1]; }
                u32x4 ya[2][2], yb[2][2], xw[2][2];
#pragma unroll
                for (int r = 0; r < 2; ++r)
#pragma unroll
                    for (int j = 0; j < 2; ++j) { ya[r][j] = ((const GAS u32x4*)(YB + (size_t)sl[2 * r] * D))[lane + 64 * j]; yb[r][j] = ((const GAS u32x4*)(YB + (size_t)sl[2 * r + 1] * D))[lane + 64 * j];
                        xw[r][j] = ((const GAS u32x4*)(XB + (size_t)mr[r] * D))[lane + 64 * j]; }
#pragma unroll
                for (int r = 0; r < 2; ++r) {
                    float v[2][8]; float s = 0.f;
#pragma unroll
                    for (int j = 0; j < 2; ++j)
#pragma unroll
                        for (int w = 0; w < 4; ++w) { v[j][2 * w] = pg8::bflo(xw[r][j][w]) + (pg8::bflo(ya[r][j][w]) + pg8::bflo(yb[r][j][w])); v[j][2 * w + 1] = pg8::bfhi(xw[r][j][w]) + (pg8::bfhi(ya[r][j][w]) + pg8::bfhi(yb[r][j][w]));
                            s += v[j][2 * w] * v[j][2 * w] + v[j][2 * w + 1] * v[j][2 * w + 1]; }
                    s = wave_sum(s);
                    if (l == DEPTH - 1) { const float rsd = 1.0f / sqrtf(s * (1.f / 1024.f) + 1e-6f); GAS f32x4* orow = (GAS f32x4*)(OUTP + (size_t)mr[r] * D);
#pragma unroll
                        for (int j = 0; j < 2; ++j) { const f32x4 ga = ((const GAS f32x4*)g_fin)[2 * (lane + 64 * j)], gb = ((const GAS f32x4*)g_fin)[2 * (lane + 64 * j) + 1];
                            const f32x4 oa = {v[j][0] * rsd * ga[0], v[j][1] * rsd * ga[1], v[j][2] * rsd * ga[2], v[j][3] * rsd * ga[3]}, ob = {v[j][4] * rsd * gb[0], v[j][5] * rsd * gb[1], v[j][6] * rsd * gb[2], v[j][7] * rsd * gb[3]};
                            orow[2 * (lane + 64 * j)] = oa; orow[2 * (lane + 64 * j) + 1] = ob; }
                    } else {
#pragma unroll
                        for (int j = 0; j < 2; ++j) { u32x4 w4; w4.x = pk2(v[j][0], v[j][1]); w4.y = pk2(v[j][2], v[j][3]); w4.z = pk2(v[j][4], v[j][5]); w4.w = pk2(v[j][6], v[j][7]);
                            ((GAS u32x4*)(XB + (size_t)mr[r] * D))[lane + 64 * j] = w4; }
                        if (lane < 16) SSQ[(size_t)mr[r] * 16 + lane] = (lane == 0) ? s : 0.f;
                    }
                }
            }
        }
#endif
    }
}

extern "C" void kernel_launch(void* const* d_in, const int* in_sizes, int n_in, void* d_out, int out_size, void* d_ws, size_t ws_size, hipStream_t stream) {
    static int grid = 0;
    if (grid == 0) {
        if (n_in != 26 || in_sizes[0] != M * D || out_size != M * D || ws_size < WS_END) { fprintf(stderr, "kernel_launch: unexpected shapes (n_in %d, in0 %d, out %d, ws %zu < %zu)\n", n_in, n_in > 0 ? in_sizes[0] : -1, out_size, ws_size, (size_t)WS_END); grid = -1; return; }
        int dev = 0, cus = 0;
        if (hipGetDevice(&dev) != hipSuccess || hipDeviceGetAttribute(&cus, hipDeviceAttributeMultiprocessorCount, dev) != hipSuccess) { grid = -1; return; }
        if (hipFuncSetAttribute((const void*)fwd, hipFuncAttributeMaxDynamicSharedMemorySize, LDS_BYTES) != hipSuccess) { fprintf(stderr, "kernel_launch: hipFuncSetAttribute failed\n"); grid = -1; return; }
        int per_cu = 0;
        if (hipOccupancyMaxActiveBlocksPerMultiprocessor(&per_cu, (const void*)fwd, NTHREADS, LDS_BYTES) != hipSuccess || per_cu < 1) fprintf(stderr, "kernel_launch: occupancy query says %d\n", per_cu);
        (void)hipGetLastError();
        grid = cus < 256 ? (cus / 8) * 8 : 256; if (grid < 16) { fprintf(stderr, "kernel_launch: %d CUs: too few\n", cus); grid = -1; return; }
    }
    if (grid <= 0) return;
    if (hipMemsetAsync((char*)d_ws + WS_CTL, 0, CTL_ZERO_BYTES, stream) != hipSuccess) return;
    Args a{};
    for (int i = 0; i < 26; ++i) a.in[i] = (const float*)d_in[i];
    a.out = (float*)d_out; a.ws = (unsigned char*)d_ws;
    hipLaunchKernelGGL(fwd, dim3(grid), dim3(NTHREADS), LDS_BYTES, stream, a);
}
```
